# Optimizing an MI355X kernel written in HIP

```python
import jax, jax.numpy as jnp
from jax import lax
import numpy as np

D_MODEL = 1024
BATCH = 4
SEQ = 8192
DEPTH = 2

GRID_W = 64
CTX_LEN = 256
HEAD_DIM = 64
BRANCH_W = 512
N_BRANCH = 3
A_HEADS = 8
A_KV_HEADS = 2
A_GROUP = A_HEADS // A_KV_HEADS
WINDOW = 128
A_KV_W = A_KV_HEADS * HEAD_DIM
CONV_K = 3
NA_HEADS = 8
NA_ROWS_MAX = 8
NA_COLS = 16
ROPE_BASE = 10000.0
IN_SIZES = (BRANCH_W, A_KV_W, A_KV_W, BRANCH_W, BRANCH_W, BRANCH_W, BRANCH_W, BRANCH_W, BRANCH_W, N_BRANCH * D_MODEL)
IN_COLS = sum(IN_SIZES)
FFN_DENSE = 2816
N_EXPERTS = 8
TOP_K = 2
FFN_EXPERT = 3584
MOE_BLOCK = 128
N_DENSE = (DEPTH + 1) // 2
N_MOE = DEPTH // 2
RMS_EPS = 1e-6

kernel_name = "hybrid_gated_window_conv_natten_moe_dit"


def rmsnorm(x, g):
    xf = x.astype(jnp.float32)
    y = xf * lax.rsqrt(jnp.mean(xf * xf, axis=-1, keepdims=True) + RMS_EPS)
    return (y * g.astype(jnp.float32)).astype(x.dtype)


def modulate(h, shift, scale):
    return h * (1 + scale) + shift


def split_cols(z):
    parts, off = [], 0
    for n in IN_SIZES:
        parts.append(z[..., off:off + n])
        off += n
    return parts


def to_heads(t, n_heads):
    return t.reshape(t.shape[0], t.shape[1], n_heads, HEAD_DIM)


def axial_rope_tables(n_tokens, dtype):
    pos = jnp.arange(n_tokens)
    row = (pos // GRID_W).astype(jnp.float32)
    col = (pos % GRID_W).astype(jnp.float32)
    half = HEAD_DIM // 2
    inv = 1.0 / (ROPE_BASE ** (jnp.arange(0, half, 2, dtype=jnp.float32) / half))
    ar = row[:, None] * inv[None]
    ac = col[:, None] * inv[None]
    ang = jnp.concatenate([ar, ar, ac, ac], axis=-1)[:, None, :]
    return jnp.cos(ang).astype(dtype), jnp.sin(ang).astype(dtype)


def axial_rope(t, cos, sin):
    half, quarter = HEAD_DIM // 2, HEAD_DIM // 4
    def rot(u):
        return jnp.concatenate([-u[..., quarter:], u[..., :quarter]], axis=-1)
    rotated = jnp.concatenate([rot(t[..., :half]), rot(t[..., half:])], axis=-1)
    return t * cos + rotated * sin


def joint_softmax(parts, sink=None):
    m = parts[0].max(axis=-1, keepdims=True)
    for s in parts[1:]:
        m = jnp.maximum(m, s.max(axis=-1, keepdims=True))
    if sink is not None:
        m = jnp.maximum(m, sink)
    es = [jnp.exp(s - m) for s in parts]
    den = es[0].sum(axis=-1, keepdims=True)
    for e in es[1:]:
        den = den + e.sum(axis=-1, keepdims=True)
    if sink is not None:
        den = den + jnp.exp(sink - m)
    return [e / den for e in es]


def window_gqa(q, k, v, kc, vc, sink):
    b, s = q.shape[:2]
    nb = s // WINDOW
    scale = HEAD_DIM ** -0.5
    qb = q.reshape(b, nb, WINDOW, A_KV_HEADS, A_GROUP, HEAD_DIM)
    def band(t):
        tp = jnp.pad(t.reshape(b, nb, WINDOW, A_KV_HEADS, HEAD_DIM), ((0, 0), (1, 1), (0, 0), (0, 0), (0, 0)))
        return jnp.concatenate([tp[:, :-2], tp[:, 1:-1], tp[:, 2:]], axis=2)
    kb, vb = band(k), band(v)
    qpos = jnp.arange(s).reshape(nb, WINDOW)
    kpos = (jnp.arange(nb)[:, None] - 1) * WINDOW + jnp.arange(3 * WINDOW)[None]
    valid = ((jnp.abs(qpos[:, :, None] - kpos[:, None, :]) <= WINDOW)
             & (kpos[:, None, :] >= 0) & (kpos[:, None, :] < s))
    s_win = jnp.einsum('bnqkgd,bnjkd->bnkgqj', qb, kb, preferred_element_type=jnp.float32) * scale
    s_win = jnp.where(valid[None, :, None, None], s_win, -jnp.inf)
    s_ctx = jnp.einsum('bnqkgd,bjkd->bnkgqj', qb, kc, preferred_element_type=jnp.float32) * scale
    sk = sink.astype(jnp.float32).reshape(A_KV_HEADS, A_GROUP)[:, :, None, None]
    p_win, p_ctx = joint_softmax([s_win, s_ctx], sk)
    o = (jnp.einsum('bnkgqj,bnjkd->bnqkgd', p_win.astype(vb.dtype), vb)
         + jnp.einsum('bnkgqj,bjkd->bnqkgd', p_ctx.astype(vc.dtype), vc))
    return o.reshape(b, s, A_HEADS * HEAD_DIM)


def context_gqa(q, k, v, sink):
    b, n = q.shape[:2]
    qg = q.reshape(b, n, A_KV_HEADS, A_GROUP, HEAD_DIM)
    s = jnp.einsum('blkgd,bjkd->bkglj', qg, k, preferred_element_type=jnp.float32) * HEAD_DIM ** -0.5
    sk = sink.astype(jnp.float32).reshape(A_KV_HEADS, A_GROUP)[:, :, None, None]
    (p,) = joint_softmax([s], sk)
    o = jnp.einsum('bkglj,bjkd->blkgd', p.astype(v.dtype), v)
    return o.reshape(b, n, A_HEADS * HEAD_DIM)


def short_conv(x_in, gate_b, gate_c, w):
    u = gate_c * x_in
    v = lax.conv_general_dilated(u, w[:, None, :].astype(u.dtype), window_strides=(1,),
                                 padding=((CONV_K // 2, CONV_K // 2),),
                                 dimension_numbers=('NWC', 'WIO', 'NWC'),
                                 feature_group_count=u.shape[-1])
    return gate_b * v


def neighbourhood_attn(q, k, v, kc, vc, rpb):
    b, s = q.shape[:2]
    rows = s // GRID_W
    kr = min(NA_ROWS_MAX, rows)
    kcn = NA_COLS
    scale = HEAD_DIM ** -0.5
    qg = q.reshape(b, rows, GRID_W, NA_HEADS, HEAD_DIM)
    kg = k.reshape(b, rows, GRID_W, NA_HEADS, HEAD_DIM)
    vg = v.reshape(b, rows, GRID_W, NA_HEADS, HEAD_DIM)
    r = jnp.arange(rows)
    row_idx = jnp.clip(r - kr // 2, 0, rows - kr)[:, None] + jnp.arange(kr)[None]
    k_rows = kg[:, row_idx]
    v_rows = vg[:, row_idx]
    col = jnp.arange(GRID_W)
    col_start = jnp.clip(col - kcn // 2, 0, GRID_W - kcn)
    col_ok = (col[None, :] >= col_start[:, None]) & (col[None, :] < col_start[:, None] + kcn)
    dr = row_idx - r[:, None] + NA_ROWS_MAX - 1
    dc = jnp.clip(col[None, :] - col[:, None], -(kcn - 1), kcn - 1) + kcn - 1
    bias = rpb.astype(jnp.float32)[:, dr[:, None, :, None], dc[None, :, None, :]]
    bias = jnp.where(col_ok[None, None, :, None, :], bias, -jnp.inf).transpose(1, 0, 2, 3, 4)
    s_nb = jnp.einsum('brqhd,brkjhd->brhqkj', qg, k_rows, preferred_element_type=jnp.float32) * scale + bias[None]
    s_nb = s_nb.reshape(b, rows, NA_HEADS, GRID_W, kr * GRID_W)
    s_ctx = jnp.einsum('brqhd,bjhd->brhqj', qg, kc, preferred_element_type=jnp.float32) * scale
    p_nb, p_ctx = joint_softmax([s_nb, s_ctx])
    p_nb = p_nb.reshape(b, rows, NA_HEADS, GRID_W, kr, GRID_W)
    o = (jnp.einsum('brhqkj,brkjhd->brqhd', p_nb.astype(v_rows.dtype), v_rows)
         + jnp.einsum('brhqj,bjhd->brqhd', p_ctx.astype(vc.dtype), vc))
    return o.reshape(b, s, NA_HEADS * HEAD_DIM)


def context_mha(q, k, v):
    s = jnp.einsum('blhd,bjhd->bhlj', q, k, preferred_element_type=jnp.float32) * HEAD_DIM ** -0.5
    (p,) = joint_softmax([s])
    o = jnp.einsum('bhlj,bjhd->blhd', p.astype(v.dtype), v)
    return o.reshape(q.shape[0], q.shape[1], NA_HEADS * HEAD_DIM)


def branch_merge(o_a, o_b, o_c, gate_pre, b_gate, w_branch, w_out):
    o = jnp.stack([o_a, o_b, o_c], axis=-2)
    proj = jnp.einsum('bnrc,rcd->bnrd', o, w_branch)
    g = jax.nn.sigmoid(gate_pre.reshape(*gate_pre.shape[:-1], N_BRANCH, D_MODEL) + b_gate.reshape(N_BRANCH, D_MODEL))
    return jnp.sum(g * proj, axis=-2) @ w_out


def mixer_sublayer(hx, hc, cos, sin, w_in, b_gate, sink, conv_w, rpb, w_branch, w_out, with_ctx_out):
    qa, ka, va, ux, gbx, gcx, qn, kn, vn, gx = split_cols(hx @ w_in)
    qa_c, ka_c, va_c, uc, gbc, gcc, qn_c, kn_c, vn_c, gc = split_cols(hc @ w_in)
    ka_c, va_c = to_heads(ka_c, A_KV_HEADS), to_heads(va_c, A_KV_HEADS)
    kn_c, vn_c = to_heads(kn_c, NA_HEADS), to_heads(vn_c, NA_HEADS)
    o_a = window_gqa(axial_rope(to_heads(qa, A_HEADS), cos, sin), axial_rope(to_heads(ka, A_KV_HEADS), cos, sin),
                     to_heads(va, A_KV_HEADS), ka_c, va_c, sink)
    o_b = short_conv(ux, gbx, gcx, conv_w)
    o_c = neighbourhood_attn(to_heads(qn, NA_HEADS), to_heads(kn, NA_HEADS), to_heads(vn, NA_HEADS), kn_c, vn_c, rpb)
    y_x = branch_merge(o_a, o_b, o_c, gx, b_gate, w_branch, w_out)
    if not with_ctx_out:
        return y_x, None
    o_a_c = context_gqa(to_heads(qa_c, A_HEADS), ka_c, va_c, sink)
    o_b_c = short_conv(uc, gbc, gcc, conv_w)
    o_c_c = context_mha(to_heads(qn_c, NA_HEADS), kn_c, vn_c)
    y_c = branch_merge(o_a_c, o_b_c, o_c_c, gc, b_gate, w_branch, w_out)
    return y_x, y_c


def swiglu(h, w_gu, w_dn):
    g, u = jnp.split(h @ w_gu, 2, axis=-1)
    return (jax.nn.silu(g) * u) @ w_dn


def moe_swiglu(xt, w_router, b_router, w_gu, w_dn):
    t = xt.shape[0]
    logits = (xt @ w_router).astype(jnp.float32) + b_router.astype(jnp.float32)
    top_v, top_e = lax.top_k(logits, TOP_K)
    gates = jax.nn.softmax(top_v, axis=-1)
    n_assign = t * TOP_K
    e_flat = top_e.reshape(-1)
    tok_flat = jnp.repeat(jnp.arange(t, dtype=jnp.int32), TOP_K)
    g_flat = gates.reshape(-1)
    order = jnp.argsort(e_flat)
    e_s, tok_s, g_s = e_flat[order], tok_flat[order], g_flat[order]
    counts = jnp.bincount(e_flat, length=N_EXPERTS)
    padded = (counts + MOE_BLOCK - 1) // MOE_BLOCK * MOE_BLOCK
    start = jnp.cumsum(counts) - counts
    ends = jnp.cumsum(padded)
    pstart = ends - padded
    dest = pstart[e_s] + jnp.arange(n_assign) - start[e_s]
    n_blocks = -(-n_assign // MOE_BLOCK) + N_EXPERTS
    n_rows = n_blocks * MOE_BLOCK
    row_tok = jnp.full((n_rows,), t, jnp.int32).at[dest].set(tok_s)
    row_gate = jnp.zeros((n_rows,), jnp.float32).at[dest].set(g_s)
    block_e = jnp.clip(jnp.searchsorted(ends, jnp.arange(n_blocks) * MOE_BLOCK, side='right'), 0, N_EXPERTS - 1)
    x_pad = jnp.concatenate([xt, jnp.zeros((1, xt.shape[1]), xt.dtype)], axis=0)
    xb = x_pad[row_tok].reshape(n_blocks, MOE_BLOCK, xt.shape[1])
    def expert_block(args):
        xblk, e = args
        g, u = jnp.split(xblk @ w_gu[e], 2, axis=-1)
        return (jax.nn.silu(g) * u) @ w_dn[e]
    yb = lax.map(expert_block, (xb, block_e)).reshape(n_rows, xt.shape[1])
    yb = yb * row_gate[:, None].astype(yb.dtype)
    return jnp.zeros((t + 1, xt.shape[1]), yb.dtype).at[row_tok].add(yb)[:t]


def channel_mixer(h, layer, w_gu_dense, w_dn_dense, w_router, b_router, w_gu_moe, w_dn_moe):
    if layer % 2 == 0:
        return swiglu(h, w_gu_dense[layer // 2], w_dn_dense[layer // 2])
    b, n, d = h.shape
    i = layer // 2
    return moe_swiglu(h.reshape(b * n, d), w_router[i], b_router[i], w_gu_moe[i], w_dn_moe[i]).reshape(b, n, d)


def setup_inputs(seed: int = 0) -> dict:
    key = jax.random.key(seed)
    ks = jax.random.split(key, 24)
    D = D_MODEL
    def nrm(k, shape, s):
        return jax.random.normal(k, shape, jnp.float32) * s
    return {
        "x": nrm(ks[0], (BATCH, SEQ, D), 1.0),
        "c": nrm(ks[1], (BATCH, D), 1.0),
        "ctx": nrm(ks[2], (BATCH, CTX_LEN, D), 1.0),
        "c_ctx": nrm(ks[3], (D,), 1.0),
        "w_ada": nrm(ks[4], (DEPTH, D, 6 * D), 0.5 * D ** -0.5),
        "b_ada": nrm(ks[5], (DEPTH, 6 * D), 0.02),
        "g_pre_mix": 1.0 + nrm(ks[6], (DEPTH, D), 0.02),
        "g_post_mix": 1.0 + nrm(ks[7], (DEPTH, D), 0.02),
        "g_pre_ffn": 1.0 + nrm(ks[8], (DEPTH, D), 0.02),
        "g_post_ffn": 1.0 + nrm(ks[9], (DEPTH, D), 0.02),
        "w_in": nrm(ks[10], (DEPTH, D, IN_COLS), D ** -0.5),
        "b_gate": nrm(ks[11], (DEPTH, N_BRANCH * D), 0.02),
        "sink": nrm(ks[12], (DEPTH, A_HEADS), 0.5),
        "conv_w": nrm(ks[13], (DEPTH, CONV_K, BRANCH_W), CONV_K ** -0.5),
        "rpb": nrm(ks[14], (DEPTH, NA_HEADS, 2 * NA_ROWS_MAX - 1, 2 * NA_COLS - 1), 0.1),
        "w_branch": nrm(ks[15], (DEPTH, N_BRANCH, BRANCH_W, D), BRANCH_W ** -0.5),
        "w_out": nrm(ks[16], (DEPTH, D, D), D ** -0.5),
        "w_gu_dense": nrm(ks[17], (N_DENSE, D, 2 * FFN_DENSE), D ** -0.5),
        "w_dn_dense": nrm(ks[18], (N_DENSE, FFN_DENSE, D), FFN_DENSE ** -0.5),
        "w_router": nrm(ks[19], (N_MOE, D, N_EXPERTS), D ** -0.5),
        "b_router": nrm(ks[20], (N_MOE, N_EXPERTS), 0.01),
        "w_gu_moe": nrm(ks[21], (N_MOE, N_EXPERTS, D, 2 * FFN_EXPERT), D ** -0.5),
        "w_dn_moe": nrm(ks[22], (N_MOE, N_EXPERTS, FFN_EXPERT, D), FFN_EXPERT ** -0.5),
    }


def reference(x, c, ctx, c_ctx, w_ada, b_ada, g_pre_mix, g_post_mix, g_pre_ffn, g_post_ffn, w_in, b_gate,
              sink, conv_w, rpb, w_branch, w_out, w_gu_dense, w_dn_dense, w_router, b_router, w_gu_moe, w_dn_moe):
    cos, sin = axial_rope_tables(x.shape[1], x.dtype)
    h_ctx = ctx
    for l in range(DEPTH):
        update_ctx = l < DEPTH - 1
        mod_x = (jax.nn.silu(c) @ w_ada[l] + b_ada[l])[:, None, :]
        mod_c = jax.nn.silu(c_ctx) @ w_ada[l] + b_ada[l]
        sh1, sc1, gt1, sh2, sc2, gt2 = jnp.split(mod_x, 6, axis=-1)
        csh1, csc1, cgt1, csh2, csc2, cgt2 = jnp.split(mod_c, 6, axis=-1)
        hx = modulate(rmsnorm(x, g_pre_mix[l]), sh1, sc1)
        hc = modulate(rmsnorm(h_ctx, g_pre_mix[l]), csh1, csc1)
        y_x, y_c = mixer_sublayer(hx, hc, cos, sin, w_in[l], b_gate[l], sink[l], conv_w[l], rpb[l],
                                  w_branch[l], w_out[l], update_ctx)
        x = x + gt1 * rmsnorm(y_x, g_post_mix[l])
        hx = modulate(rmsnorm(x, g_pre_ffn[l]), sh2, sc2)
        x = x + gt2 * rmsnorm(channel_mixer(hx, l, w_gu_dense, w_dn_dense, w_router, b_router, w_gu_moe, w_dn_moe), g_post_ffn[l])
        if update_ctx:
            h_ctx = h_ctx + cgt1 * rmsnorm(y_c, g_post_mix[l])
            hc = modulate(rmsnorm(h_ctx, g_pre_ffn[l]), csh2, csc2)
            h_ctx = h_ctx + cgt2 * rmsnorm(channel_mixer(hc, l, w_gu_dense, w_dn_dense, w_router, b_router, w_gu_moe, w_dn_moe), g_post_ffn[l])
    return x
```

```cpp
#include <hip/hip_runtime.h>
#include <cstdio>
#include <cstdint>
#ifndef MK_GATE_F8
#define MK_GATE_F8 1
#endif

namespace pg8 {
#define PG8_LAS __attribute__((address_space(3)))
typedef unsigned short bf16_t;
typedef short bf16x8 __attribute__((ext_vector_type(8)));
typedef float f32x4 __attribute__((ext_vector_type(4)));
typedef unsigned u32x4 __attribute__((ext_vector_type(4)));
typedef unsigned u32x2 __attribute__((ext_vector_type(2)));
typedef int v8i32 __attribute__((ext_vector_type(8)));
constexpr int BM = 256, BK = 64, HALF = 128, HTB = HALF * BK * 2  , STAGE_BYTES = 8 * HTB, NXCD = 8, WGM = 8;

__host__ __device__ __forceinline__ int lds_byte(int r, int c) { const int st = (r >> 4) * 2 + (c >> 5), rr = r & 15, cc = c & 31, ob = rr * 64 + cc * 2; return st * 1024 + (ob ^ (((ob >> 9) & 1) << 5)); }
__host__ __device__ __forceinline__ void stage_rc(int b, int& R, int& C) { const int st = b / 1024, sb = b % 1024, swz = sb ^ (((sb >> 9) & 1) << 5); R = (st >> 1) * 16 + swz / 64; C = (st & 1) * 32 + (swz % 64) / 2; }
__host__ __device__ __forceinline__ int perm32(int rho) { const int n = rho >> 4, i = rho & 15; return 8 * (i >> 2) + 4 * n + (i & 3); }

struct Unit { int pm, pn, pb; };
struct Gemm { const bf16_t* A; const bf16_t* Bt; int M, N, K; };

struct StaticOrder {
    int nM, nN, nwg, G, c, wgm;
    __host__ __device__ void init(int M, int N, int G_, int c_, int wgm_ = WGM) { nM = M / BM; nN = N / BM; nwg = nM * nN; G = G_; c = c_; wgm = wgm_; }
    __host__ __device__ bool next(int i, Unit& u) const {
        const long L = (long)i * G + c; if (L >= nwg) return false;
        int wgid = (int)L; { const int q = nwg / NXCD, r = nwg % NXCD, xcd = wgid % NXCD, off = wgid / NXCD; wgid = (xcd < r ? xcd * (q + 1) : r * (q + 1) + (xcd - r) * q) + off; }
        const int nig = wgm * nN, gid = wgid / nig, fm = gid * wgm, gsz = (nM - fm) < wgm ? (nM - fm) : wgm;
        u.pm = fm + ((wgid % nig) % gsz); u.pn = (wgid % nig) / gsz; u.pb = u.pn; return true;
    }
    __device__ __forceinline__ void a_ready(const Unit&) const {}
    __device__ __forceinline__ void done(const Unit&) const {}
};

__device__ __forceinline__ unsigned cvt_pk_bf16(float lo, float hi) { unsigned r; asm volatile("v_cvt_pk_bf16_f32 %0, %1, %2" : "=v"(r) : "v"(lo), "v"(hi)); return r; }
__device__ __forceinline__ float bf_lo(unsigned w) { return __uint_as_float(w << 16); }
__device__ __forceinline__ float bf_hi(unsigned w) { return __uint_as_float(w & 0xffff0000u); }
__device__ __forceinline__ float sigmoidf_(float x) { return __builtin_amdgcn_rcpf(1.0f + __builtin_amdgcn_exp2f(x * -1.4426950408889634f)); }

template <bool OPF8> struct EpiZT {
    static constexpr bool PERM = true, AFTER_DRAIN = false, HALFN = false, F8 = OPF8, RWACC = false;
    bf16_t* ZM; bf16_t* ZG; const float* rope; int n_lat_panels; const float* bgate; int pn_off; float gs;
    __device__ __forceinline__ void operator()(const f32x4 (&acc)[2][2][4][2], const Unit& u, int wr, int wc, int fr, int fq) const {
        const int row0 = u.pm * BM + wr * 64 + fr; int colt = (u.pn + pn_off) * BM; bf16_t* base = ZM; int ldc = 3840; bool isg = false;
        if (colt >= 3840) { base = ZG; colt -= 3840; ldc = 3072; isg = true; }
        const int col0 = colt + wc * 32 + 8 * fq;
        f32x4 gb[2][2];
        if (isg) {
#pragma unroll
            for (int bj = 0; bj < 2; ++bj) { gb[bj][0] = *(const f32x4*)(bgate + col0 + bj * HALF); gb[bj][1] = *(const f32x4*)(bgate + col0 + bj * HALF + 4); } }
        const int nrope = (u.pm < n_lat_panels) ? (u.pn + pn_off < 2 ? 2 : (u.pn + pn_off == 2 ? 1 : 0)) : 0;
#pragma unroll
        for (int ai = 0; ai < 2; ++ai)
#pragma unroll
            for (int m = 0; m < 4; ++m) { const int row = row0 + ai * HALF + m * 16; bf16_t* rowp = base + (size_t)row * ldc + col0;
                f32x4 cs[4];
                if (nrope) { const int s = row & 8191, pidx = (wc & 1) ? 128 + (s & 63) : (s >> 6); const f32x4* cp = (const f32x4*)(rope + (size_t)(pidx * 16 + 8 * (fq & 1)) * 2);
                    cs[0] = cp[0]; cs[1] = cp[1]; cs[2] = cp[2]; cs[3] = cp[3]; }
#pragma unroll
                for (int bj = 0; bj < 2; ++bj) { f32x4 v0 = acc[ai][bj][m][0], v1 = acc[ai][bj][m][1];
                    if (OPF8 && !isg) { v0 *= gs; v1 *= gs; }
                    if (isg) {
#pragma unroll
                        for (int j = 0; j < 4; ++j) { v0[j] = sigmoidf_(fminf(fmaxf(v0[j] * gs + gb[bj][0][j], -30.f), 30.f)); v1[j] = sigmoidf_(fminf(fmaxf(v1[j] * gs + gb[bj][1][j], -30.f), 30.f)); } }
                    if (bj < nrope) { const float sg = (fq >> 1) ? 1.f : -1.f;
                        float v[8] = {v0[0], v0[1], v0[2], v0[3], v1[0], v1[1], v1[2], v1[3]}, o[8];
#pragma unroll
                        for (int j = 0; j < 8; ++j) { const float pv = __shfl_xor(v[j], 32); const float c_ = cs[j >> 1][(j & 1) * 2], s_ = cs[j >> 1][(j & 1) * 2 + 1]; o[j] = v[j] * c_ + sg * pv * s_; }
                        v0 = (f32x4){o[0], o[1], o[2], o[3]}; v1 = (f32x4){o[4], o[5], o[6], o[7]}; }
                    u32x4 w; w.x = cvt_pk_bf16(v0[0], v0[1]); w.y = cvt_pk_bf16(v0[2], v0[3]); w.z = cvt_pk_bf16(v1[0], v1[1]); w.w = cvt_pk_bf16(v1[2], v1[3]);
                    *(u32x4*)(rowp + bj * HALF) = w; } }
    }
};
typedef EpiZT<false> EpiZ;
struct EpiBf16P {
    static constexpr bool PERM = true, AFTER_DRAIN = false, HALFN = false, F8 = false, RWACC = false;
    bf16_t* O; int ldc;
    __device__ __forceinline__ void operator()(const f32x4 (&acc)[2][2][4][2], const Unit& u, int wr, int wc, int fr, int fq) const {
        const int row0 = u.pm * BM + wr * 64 + fr; const int col0 = u.pn * BM + wc * 32 + 8 * fq;
#pragma unroll
        for (int ai = 0; ai < 2; ++ai)
#pragma unroll
            for (int m = 0; m < 4; ++m) { bf16_t* rowp = O + (size_t)(row0 + ai * HALF + m * 16) * ldc + col0;
#pragma unroll
                for (int bj = 0; bj < 2; ++bj) { const f32x4 v0 = acc[ai][bj][m][0], v1 = acc[ai][bj][m][1];
                    u32x4 w; w.x = cvt_pk_bf16(v0[0], v0[1]); w.y = cvt_pk_bf16(v0[2], v0[3]); w.z = cvt_pk_bf16(v1[0], v1[1]); w.w = cvt_pk_bf16(v1[2], v1[3]);
                    *(u32x4*)(rowp + bj * HALF) = w; } }
    }
};
struct EpiBranchAcc {
    static constexpr bool PERM = true, AFTER_DRAIN = false, HALFN = false, F8 = false, RWACC = true;
    bf16_t* MG; const bf16_t* ZG;
    __device__ __forceinline__ bool restart(const Unit& u) const { return u.pm >= 264; }
    __device__ __forceinline__ void rw(f32x4 (&acc)[2][2][4][2], const Unit& u, int wr, int wc, int fr, int fq) const {
        const int r = u.pm / 132, pmt = u.pm - 132 * r, rn = r < 2 ? r + 1 : r;
        const int row0 = pmt * BM + wr * 64 + fr, col0 = u.pn * BM + wc * 32 + 8 * fq;
        u32x4 gp[2][2], gn[2][2];
#define PG8_GLOAD(s, buf) do { const int bj_ = (s) >> 2, ai_ = ((s) >> 1) & 1, mb_ = ((s) & 1) * 2; _Pragma("unroll") for (int q_ = 0; q_ < 2; ++q_) { \
            const size_t row_ = (size_t)(row0 + ai_ * HALF + (mb_ + q_) * 16); const int col_ = col0 + bj_ * HALF; \
            gp[buf][q_] = *(const u32x4*)(ZG + row_ * 3072 + r * 1024 + col_); gn[buf][q_] = *(const u32x4*)(ZG + row_ * 3072 + rn * 1024 + col_); } } while (0)
        PG8_GLOAD(0, 0);
#pragma unroll
        for (int s = 0; s < 8; ++s) { const int bj = s >> 2, ai = (s >> 1) & 1, mb = (s & 1) * 2, col = col0 + bj * HALF;
            if (s + 1 < 8) PG8_GLOAD(s + 1, (s + 1) & 1);
            __builtin_amdgcn_sched_barrier(0);
#pragma unroll
            for (int q = 0; q < 2; ++q) { const int m = mb + q; const size_t row = (size_t)(row0 + ai * HALF + m * 16);
                const u32x4 g0 = gp[s & 1][q], g1 = gn[s & 1][q];
                const float x[8] = {bf_lo(g0.x), bf_hi(g0.x), bf_lo(g0.y), bf_hi(g0.y), bf_lo(g0.z), bf_hi(g0.z), bf_lo(g0.w), bf_hi(g0.w)};
                if (r < 2) {
                    const float y[8] = {bf_lo(g1.x), bf_hi(g1.x), bf_lo(g1.y), bf_hi(g1.y), bf_lo(g1.z), bf_hi(g1.z), bf_lo(g1.w), bf_hi(g1.w)};
#pragma unroll
                    for (int j = 0; j < 8; ++j) acc[ai][bj][m][j >> 2][j & 3] *= x[j] * __builtin_amdgcn_rcpf(y[j]);
                } else {
                    float v[8];
#pragma unroll
                    for (int j = 0; j < 8; ++j) v[j] = acc[ai][bj][m][j >> 2][j & 3] * x[j];
                    u32x4 w; w.x = cvt_pk_bf16(v[0], v[1]); w.y = cvt_pk_bf16(v[2], v[3]); w.z = cvt_pk_bf16(v[4], v[5]); w.w = cvt_pk_bf16(v[6], v[7]);
                    *(u32x4*)(MG + row * 1024 + col) = w;
                } }
        }
#undef PG8_GLOAD
    }
};
struct BranchOrder3 {
    StaticOrder so;
    __device__ __forceinline__ bool next(int i, Unit& u) const {
        const int ti = i / 3, r = i - 3 * ti; if (!so.next(ti, u)) return false;
        u.pb = 4 * r + u.pn; u.pm += 132 * r; return true;
    }
    __device__ __forceinline__ void a_ready(const Unit&) const {}
    __device__ __forceinline__ void done(const Unit&) const {}
};
struct EpiSwiglu {
    static constexpr bool PERM = true, AFTER_DRAIN = false, HALFN = false, F8 = false, RWACC = false;
    bf16_t* H; int ldh;
    __device__ __forceinline__ void operator()(const f32x4 (&acc)[2][2][4][2], const Unit& u, int wr, int wc, int fr, int fq) const {
        const int row0 = u.pm * BM + wr * 64 + fr; const int col0 = u.pn * HALF + wc * 32 + 8 * fq;
#pragma unroll
        for (int ai = 0; ai < 2; ++ai)
#pragma unroll
            for (int m = 0; m < 4; ++m) { bf16_t* rowp = H + (size_t)(row0 + ai * HALF + m * 16) * ldh + col0;
                float h[8];
#pragma unroll
                for (int n = 0; n < 2; ++n)
#pragma unroll
                    for (int j = 0; j < 4; ++j) { const float g = acc[ai][0][m][n][j], uu = acc[ai][1][m][n][j]; h[n * 4 + j] = g * sigmoidf_(g) * uu; }
                u32x4 w; w.x = cvt_pk_bf16(h[0], h[1]); w.y = cvt_pk_bf16(h[2], h[3]); w.z = cvt_pk_bf16(h[4], h[5]); w.w = cvt_pk_bf16(h[6], h[7]);
                *(u32x4*)rowp = w; }
    }
};
__device__ __forceinline__ unsigned pk4_fp8(float a, float b, float c, float d) { int w = __builtin_amdgcn_cvt_pk_fp8_f32(a, b, 0, false); w = __builtin_amdgcn_cvt_pk_fp8_f32(c, d, w, true); return (unsigned)w; }
__device__ __forceinline__ float clamp_fp8(float v) { return fminf(fmaxf(v, -448.0f), 448.0f); }
template <bool OPF8> struct EpiSwiglu8T {
    static constexpr bool PERM = true, AFTER_DRAIN = false, HALFN = false, F8 = OPF8, RWACC = false;
    unsigned char* H; int ldh; float sin, sout;
    __device__ __forceinline__ void operator()(const f32x4 (&acc)[2][2][4][2], const Unit& u, int wr, int wc, int fr, int fq) const {
        const int row0 = u.pm * BM + wr * 64 + fr; const int col0 = u.pn * HALF + wc * 32 + 8 * (fq & 2); const int odd = fq & 1;
#pragma unroll
        for (int ai = 0; ai < 2; ++ai)
#pragma unroll
            for (int mp = 0; mp < 2; ++mp) {
                unsigned w[2][2];
#pragma unroll
                for (int k = 0; k < 2; ++k) { const int m = 2 * mp + k; float h[8];
#pragma unroll
                    for (int n = 0; n < 2; ++n)
#pragma unroll
                        for (int j = 0; j < 4; ++j) { const float g = acc[ai][0][m][n][j] * sin, uu = acc[ai][1][m][n][j] * sin; h[n * 4 + j] = clamp_fp8(g * sigmoidf_(g) * uu * sout); }
                    w[k][0] = pk4_fp8(h[0], h[1], h[2], h[3]); w[k][1] = pk4_fp8(h[4], h[5], h[6], h[7]); }
                const unsigned s0 = odd ? w[0][0] : w[1][0], s1 = odd ? w[0][1] : w[1][1];
                const unsigned r0 = (unsigned)__shfl_xor((int)s0, 16), r1 = (unsigned)__shfl_xor((int)s1, 16);
                u32x4 st; if (odd) { st.x = r0; st.y = r1; st.z = w[1][0]; st.w = w[1][1]; } else { st.x = w[0][0]; st.y = w[0][1]; st.z = r0; st.w = r1; }
                *(u32x4*)(H + (size_t)(row0 + ai * HALF + (2 * mp + odd) * 16) * ldh + col0) = st; }
    }
};
typedef EpiSwiglu8T<true> EpiSwiglu8;
struct EpiBf16PS8 {
    static constexpr bool PERM = true, AFTER_DRAIN = false, HALFN = false, F8 = true, RWACC = false;
    bf16_t* O; int ldc; float s;
    __device__ __forceinline__ void operator()(const f32x4 (&acc)[2][2][4][2], const Unit& u, int wr, int wc, int fr, int fq) const {
        const int row0 = u.pm * BM + wr * 64 + fr; const int col0 = u.pn * BM + wc * 32 + 8 * fq;
#pragma unroll
        for (int ai = 0; ai < 2; ++ai)
#pragma unroll
            for (int m = 0; m < 4; ++m) { bf16_t* rowp = O + (size_t)(row0 + ai * HALF + m * 16) * ldc + col0;
#pragma unroll
                for (int bj = 0; bj < 2; ++bj) { const f32x4 v0 = acc[ai][bj][m][0] * s, v1 = acc[ai][bj][m][1] * s;
                    u32x4 w; w.x = cvt_pk_bf16(v0[0], v0[1]); w.y = cvt_pk_bf16(v0[2], v0[3]); w.z = cvt_pk_bf16(v1[0], v1[1]); w.w = cvt_pk_bf16(v1[2], v1[3]);
                    *(u32x4*)(rowp + bj * HALF) = w; } }
    }
};
struct MoeOrder {
    int nN, G, c, p_lo, np; int pc[8];
    __device__ __forceinline__ bool next(int i, Unit& u) const {
        const long L = (long)i * G + c; if (L >= (long)np * nN) return false;
        const int wgid = (int)L, nig = WGM * nN, gid = wgid / nig, fm = gid * WGM, gsz = (np - fm) < WGM ? (np - fm) : WGM;
        u.pm = p_lo + fm + ((wgid % nig) % gsz); u.pn = (wgid % nig) / gsz;
        int e = 0;
#pragma unroll
        for (int k = 1; k < 8; ++k) e += (u.pm >= pc[k]) ? 1 : 0;
        u.pb = e * nN + u.pn; return true;
    }
    __device__ __forceinline__ void a_ready(const Unit&) const {}
    __device__ __forceinline__ void done(const Unit&) const {}
};

template <class Epi, class Sched, bool ALIGN_EPI = false, bool SP2 = false>
__device__ __forceinline__ void gemm_phase(PG8_LAS unsigned char* lds, const Gemm g, const Sched& S, const Epi& E, int wv) {
    int tid_ = (wv << 6) | (int)__builtin_amdgcn_mbcnt_hi(~0u, __builtin_amdgcn_mbcnt_lo(~0u, 0u)); asm volatile("" : "+v"(tid_));
    const int tid = tid_, wid = __builtin_amdgcn_readfirstlane(tid >> 6), lane = tid & 63, wr = wid >> 2, wc = wid & 3, fr = lane & 15, fq = lane >> 4;
    constexpr bool HN = Epi::HALFN;
    constexpr bool F8 = Epi::F8;
    constexpr int ES = F8 ? 1 : 2;
    const int K = g.K, nt = K * ES / (BK * 2);
    unsigned voffA[2], voffB[2];
#pragma unroll
    for (int i = 0; i < 2; ++i) { int R, C; stage_rc(tid * 16 + i * 8192, R, C); const int Rb = Epi::PERM ? ((R & ~31) + perm32(R & 31)) : R;
        voffA[i] = (unsigned)(R * K * ES + C * 2); voffB[i] = (unsigned)(Rb * K * ES + C * 2); }
    const size_t kstep = (size_t)(BK * 2);
    const size_t hstep = (size_t)HALF * K * ES;
    const size_t tstep = 2 * hstep;
    const unsigned ldsw = (unsigned)wid * 1024u;
    const int aoff = lds_byte(wr * 64 + fr, fq * 8), boff = lds_byte(wc * 32 + fr, fq * 8);
#define PG8_SA(b, h) (((b) * 2 + (h)) * HTB)
#define PG8_SB(b, h) ((4 + (b) * 2 + (h)) * HTB)
#define PG8_STAGE(bufoff, gbase, voff) do { _Pragma("unroll") for (int _i = 0; _i < 2; ++_i) \
        __builtin_amdgcn_global_load_lds((const unsigned*)((const char*)(gbase) + (voff)[_i]), (PG8_LAS unsigned*)(lds + (bufoff) + ldsw + _i * 8192), 16, 0, 0); } while (0)
#define PG8_LDA(dst, b, h) do { if constexpr (F8) { _Pragma("unroll") for (int m = 0; m < 4; ++m) { const u32x4 lo_ = *(const PG8_LAS u32x4*)(lds + PG8_SA(b, h) + aoff + m * 2048), hi_ = *(const PG8_LAS u32x4*)(lds + PG8_SA(b, h) + aoff + m * 2048 + 1024); \
            dst##8[m] = __builtin_bit_cast(v8i32, __builtin_shufflevector(lo_, hi_, 0, 1, 2, 3, 4, 5, 6, 7)); } } \
        else { _Pragma("unroll") for (int m = 0; m < 4; ++m) _Pragma("unroll") for (int k = 0; k < 2; ++k) dst[m][k] = *(const PG8_LAS bf16x8*)(lds + PG8_SA(b, h) + aoff + m * 2048 + k * 1024); } } while (0)
#define PG8_LDB(dst, b, h) do { if constexpr (F8) { _Pragma("unroll") for (int n = 0; n < 2; ++n) { const u32x4 lo_ = *(const PG8_LAS u32x4*)(lds + PG8_SB(b, h) + boff + n * 2048), hi_ = *(const PG8_LAS u32x4*)(lds + PG8_SB(b, h) + boff + n * 2048 + 1024); \
            dst##8[n] = __builtin_bit_cast(v8i32, __builtin_shufflevector(lo_, hi_, 0, 1, 2, 3, 4, 5, 6, 7)); } } \
        else { _Pragma("unroll") for (int n = 0; n < 2; ++n) _Pragma("unroll") for (int k = 0; k < 2; ++k) dst[n][k] = *(const PG8_LAS bf16x8*)(lds + PG8_SB(b, h) + boff + n * 2048 + k * 1024); } } while (0)
#define PG8_MMA(ai, bj, At, Bt) do { __builtin_amdgcn_s_setprio(1); _Pragma("unroll") for (int m = 0; m < 4; ++m) _Pragma("unroll") for (int n = 0; n < 2; ++n) { \
        if constexpr (F8) { asm volatile("v_mfma_f32_16x16x128_f8f6f4 %0, %1, %2, %0" : "+v"(acc[ai][bj][m][n]) : "v"(Bt##8[n]), "v"(At##8[m])); } \
        else { _Pragma("unroll") for (int k = 0; k < 2; ++k) acc[ai][bj][m][n] = __builtin_amdgcn_mfma_f32_16x16x32_bf16(Bt[n][k], At[m][k], acc[ai][bj][m][n], 0, 0, 0); } } \
        __builtin_amdgcn_s_setprio(0); } while (0)
#define PG8_LDB1(dst, b, h) do { if constexpr (!HN) { PG8_LDB(dst, b, h); } } while (0)
#define PG8_MMA1(ai, bj, At, Bt) do { if constexpr (!HN) { PG8_MMA(ai, bj, At, Bt); } } while (0)
#define PG8_WAIT_V(n) asm volatile("s_waitcnt vmcnt(" #n ")" ::: "memory")
#define PG8_WAIT_L(n) asm volatile("s_waitcnt lgkmcnt(" #n ")" ::: "memory")
#define PG8_BAR __builtin_amdgcn_s_barrier()
#define PG8_SCHED __builtin_amdgcn_sched_barrier(0)
    Unit cur, nxt; int ui = 0;
    if (!S.next(0, cur)) return;
    f32x4 acc[2][2][4][2];
#pragma unroll
    for (int a = 0; a < 2; ++a)
#pragma unroll
        for (int b = 0; b < 2; ++b)
#pragma unroll
            for (int m = 0; m < 4; ++m)
#pragma unroll
                for (int n = 0; n < 2; ++n) acc[a][b][m][n] = (f32x4){0.f, 0.f, 0.f, 0.f};
    bf16x8 At[4][2], B0[2][2], B1[2][2];
    v8i32 At8[4], B08[2], B18[2];
    const char* cA = (const char*)g.A + (size_t)cur.pm * tstep; const char* cB = (const char*)g.Bt + (size_t)cur.pb * (HN ? hstep : tstep);
    S.a_ready(cur);
    if constexpr (SP2) {
        PG8_STAGE(PG8_SB(0, 0), cB, voffB); PG8_STAGE(PG8_SB(0, 1), cB + hstep, voffB); PG8_STAGE(PG8_SA(0, 0), cA, voffA); PG8_STAGE(PG8_SA(0, 1), cA + hstep, voffA);
        if (wr == 1) PG8_BAR;
        PG8_WAIT_V(2); PG8_BAR;
        PG8_STAGE(PG8_SB(1, 0), cB + kstep, voffB); PG8_STAGE(PG8_SA(1, 0), cA + kstep, voffA); PG8_STAGE(PG8_SB(1, 1), cB + hstep + kstep, voffB);
        PG8_WAIT_V(6); PG8_BAR;
    } else {
        PG8_STAGE(PG8_SB(0, 0), cB, voffB); PG8_STAGE(PG8_SA(0, 0), cA, voffA); PG8_STAGE(PG8_SB(0, 1), cB + hstep, voffB); PG8_STAGE(PG8_SA(0, 1), cA + hstep, voffA);
        if (wr == 1) PG8_BAR;
        PG8_WAIT_V(4); PG8_BAR;
        PG8_STAGE(PG8_SB(1, 0), cB + kstep, voffB); PG8_STAGE(PG8_SA(1, 0), cA + kstep, voffA); PG8_STAGE(PG8_SB(1, 1), cB + hstep + kstep, voffB);
        PG8_WAIT_V(6); PG8_BAR;
    }
    for (;;) {
        const bool has_next = S.next(ui + 1, nxt);
        const char* nA = has_next ? (const char*)g.A + (size_t)nxt.pm * tstep : cA; const char* nB = has_next ? (const char*)g.Bt + (size_t)nxt.pb * (HN ? hstep : tstep) : cB;
        for (int t = 0; t < nt; t += 2) {
            const bool last = (t == nt - 2);
            const char* a1 = cA + (size_t)(t + 1) * kstep;
            const char* a2 = last ? nA : cA + (size_t)(t + 2) * kstep; const char* b2 = last ? nB : cB + (size_t)(t + 2) * kstep;
            const char* a3 = a2 + kstep; const char* b3 = b2 + kstep;
            if (last && has_next) S.a_ready(nxt);
            if constexpr (SP2) {
            PG8_LDB(B0, 0, 0); PG8_LDB1(B1, 0, 1); PG8_SCHED; PG8_LDA(At, 0, 0); PG8_STAGE(PG8_SA(1, 1), a1 + hstep, voffA);
            PG8_WAIT_V(8); PG8_WAIT_L(0); PG8_BAR; PG8_MMA(0, 0, At, B0); PG8_MMA1(0, 1, At, B1); PG8_BAR; PG8_SCHED;
            PG8_LDA(At, 0, 1); PG8_STAGE(PG8_SB(0, 0), b2, voffB); PG8_STAGE(PG8_SB(0, 1), b2 + hstep, voffB); PG8_STAGE(PG8_SA(0, 0), a2, voffA);
            PG8_WAIT_V(8); PG8_WAIT_L(0); PG8_BAR; PG8_MMA(1, 0, At, B0); PG8_MMA1(1, 1, At, B1); PG8_BAR; PG8_SCHED;
            PG8_LDB(B0, 1, 0); PG8_LDB1(B1, 1, 1); PG8_SCHED; PG8_LDA(At, 1, 0); PG8_STAGE(PG8_SA(0, 1), a2 + hstep, voffA);
            PG8_WAIT_V(8); PG8_WAIT_L(0); PG8_BAR; PG8_MMA(0, 0, At, B0); PG8_MMA1(0, 1, At, B1); PG8_BAR; PG8_SCHED;
            PG8_LDA(At, 1, 1); PG8_STAGE(PG8_SB(1, 0), b3, voffB); PG8_STAGE(PG8_SB(1, 1), b3 + hstep, voffB); PG8_STAGE(PG8_SA(1, 0), a3, voffA);
            PG8_WAIT_V(8); PG8_WAIT_L(0); PG8_BAR; PG8_MMA(1, 0, At, B0); PG8_MMA1(1, 1, At, B1); PG8_BAR; PG8_SCHED;
            } else {
            PG8_LDB(B0, 0, 0); PG8_SCHED; PG8_LDA(At, 0, 0); PG8_STAGE(PG8_SA(1, 1), a1 + hstep, voffA);
            PG8_WAIT_L(8); PG8_BAR; PG8_WAIT_L(0); PG8_MMA(0, 0, At, B0); PG8_BAR; PG8_SCHED;
            PG8_LDB1(B1, 0, 1); PG8_STAGE(PG8_SB(0, 0), b2, voffB);
            PG8_BAR; PG8_WAIT_L(0); PG8_MMA1(0, 1, At, B1); PG8_BAR;
            PG8_LDA(At, 0, 1); PG8_STAGE(PG8_SA(0, 0), a2, voffA);
            PG8_BAR; PG8_WAIT_L(0); PG8_MMA(1, 0, At, B0); PG8_BAR; PG8_SCHED;
            PG8_STAGE(PG8_SB(0, 1), b2 + hstep, voffB);
            PG8_WAIT_V(6); PG8_BAR; PG8_MMA1(1, 1, At, B1); PG8_BAR;
            PG8_LDB(B0, 1, 0); PG8_SCHED; PG8_LDA(At, 1, 0); PG8_STAGE(PG8_SA(0, 1), a2 + hstep, voffA);
            PG8_WAIT_L(8); PG8_BAR; PG8_WAIT_L(0); PG8_MMA(0, 0, At, B0); PG8_BAR; PG8_SCHED;
            PG8_LDB1(B1, 1, 1); PG8_STAGE(PG8_SB(1, 0), b3, voffB);
            PG8_BAR; PG8_WAIT_L(0); PG8_MMA1(0, 1, At, B1); PG8_BAR;
            PG8_LDA(At, 1, 1); PG8_STAGE(PG8_SA(1, 0), a3, voffA);
            PG8_BAR; PG8_WAIT_L(0); PG8_MMA(1, 0, At, B0); PG8_BAR; PG8_SCHED;
            PG8_STAGE(PG8_SB(1, 1), b3 + hstep, voffB);
            PG8_WAIT_V(6); PG8_BAR; PG8_MMA1(1, 1, At, B1); PG8_BAR;
            }
        }
        if constexpr (F8) asm volatile("s_nop 15\n\ts_nop 15" ::: "memory");
        if constexpr (ALIGN_EPI) { if (wr == 0) PG8_BAR; }
        if constexpr (Epi::RWACC) { E.rw(acc, cur, wr, wc, fr, fq); S.done(cur); }
        else if constexpr (!Epi::AFTER_DRAIN) { E(acc, cur, wr, wc, fr, fq); S.done(cur); }
        if (!has_next) break;
        bool zero_acc = true; if constexpr (Epi::RWACC) zero_acc = E.restart(cur);
        if (zero_acc)
#pragma unroll
        for (int a = 0; a < 2; ++a)
#pragma unroll
            for (int b = 0; b < 2; ++b)
#pragma unroll
                for (int m = 0; m < 4; ++m)
#pragma unroll
                    for (int n = 0; n < 2; ++n) acc[a][b][m][n] = (f32x4){0.f, 0.f, 0.f, 0.f};
        cur = nxt; cA = nA; cB = nB; ++ui;
        if constexpr (ALIGN_EPI) { if (wr == 1) PG8_BAR; }
    }
    PG8_WAIT_V(0);
    if constexpr (!ALIGN_EPI) { if (wr == 0) PG8_BAR; }
    PG8_BAR;
    if constexpr (Epi::AFTER_DRAIN) { E.fused(acc, cur, wr, wc, fr, fq, lds, wid, lane); S.done(cur); }
#undef PG8_SA
#undef PG8_SB
#undef PG8_STAGE
#undef PG8_LDA
#undef PG8_LDB
#undef PG8_MMA
#undef PG8_LDB1
#undef PG8_MMA1
#undef PG8_WAIT_V
#undef PG8_WAIT_L
#undef PG8_BAR
#undef PG8_SCHED
}
}

#ifndef PG8_SP2
#define PG8_SP2 true
#endif
#ifndef PG8_ALIGN
#define PG8_ALIGN true
#endif
#ifndef MK_WGM
#define MK_WGM 4
#endif
#ifndef MK_DENSE_F8
#define MK_DENSE_F8 1
#endif
#ifndef MK_PER_PHASE
#define MK_PER_PHASE 0
#endif

constexpr int NWAVES = 8;
constexpr int D = 1024, BATCH = 4, SEQ = 8192, CTXL = 256, DEPTH = 2;
constexpr int TL = BATCH * SEQ, TC = BATCH * CTXL, TA = TL + TC;
constexpr int INC = 6912, ZMC = 3840, ZGC = 3072, BW = 512;
constexpr int FFD = 2816, FFE = 3584, NE = 8;
constexpr int MAXPAN = 264, PCH = 264, NCHUNK = 1;
constexpr float RMS_EPS = 1e-6f;
constexpr float SC_XG = 4.0f, SC_WGU = 32.0f, SC_H = 4.0f, SC_WDN = 64.0f;
constexpr int C_QA = 0, C_KA = 512, C_VA = 640, C_UX = 768, C_GB = 1280, C_GC = 1792, C_QN = 2304, C_KN = 2816, C_VN = 3328;

constexpr size_t MiB = 1u << 20;
constexpr size_t WS_CTL = 0, CTL_ZERO_BYTES = 1 * MiB;
constexpr size_t WS_MOD = 1 * MiB;
constexpr size_t WS_ROPE = WS_MOD + 256 * 1024;
constexpr size_t WS_SLABCNT = WS_MOD + 320 * 1024;
constexpr size_t WS_PCUM = WS_MOD + 384 * 1024;
constexpr size_t WS_TOKER = WS_MOD + 512 * 1024;
constexpr size_t WS_TOKG = WS_MOD + 768 * 1024;
constexpr size_t WS_TOKPOS = WS_MOD + 1024 * 1024;
constexpr size_t WS_HCTX = 4 * MiB;
constexpr size_t WS_WIN = 8 * MiB;
constexpr size_t WS_WBR = 35 * MiB;
constexpr size_t WS_WOUT = 41 * MiB;
constexpr size_t WS_WGUD = 45 * MiB;
constexpr size_t WS_WDND = 56 * MiB;
constexpr size_t WS_WGUM = 62 * MiB;
constexpr size_t WS_WDNM = 174 * MiB;
constexpr size_t WS_HX = 230 * MiB;
constexpr size_t WS_ZM = 296 * MiB;
constexpr size_t WS_ZG = 544 * MiB;
constexpr size_t WS_O = 742 * MiB;
constexpr size_t WS_XG = WS_ZM;
constexpr size_t WS_HM = WS_ZM + 132 * MiB;
constexpr size_t WS_XG8 = WS_O;
constexpr size_t WS_HX8 = 841 * MiB;
constexpr size_t WS_WING8 = 874 * MiB;
constexpr size_t WS_END = 880 * MiB;
static_assert(WS_WIN + (size_t)2 * INC * D * 2 <= WS_WBR && WS_WGUD + (size_t)2 * FFD * D * 2 <= WS_WDND && WS_WDND + (size_t)D * FFD * 2 <= WS_WGUM, "ws map (weights)");
static_assert(WS_WGUM + (size_t)NE * 2 * FFE * D * 2 <= WS_WDNM && WS_WDNM + (size_t)NE * D * FFE * 2 <= WS_HX, "ws map (moe weights)");
static_assert(WS_HX + (size_t)TA * D * 2 <= WS_ZM && WS_ZM + (size_t)TA * ZMC * 2 <= WS_ZG && WS_ZG + (size_t)TA * ZGC * 2 <= WS_O && WS_O + (size_t)3 * TA * BW * 2 <= WS_END, "ws map (activations)");
static_assert(WS_HM + (size_t)MAXPAN * 256 * FFE <= WS_O && WS_XG8 + (size_t)MAXPAN * 256 * D <= WS_END && (size_t)MAXPAN * 256 * D * 2 <= 132 * MiB && (size_t)TA * D * 4 <= 132 * MiB, "ws map (moe)");
constexpr int CW_BAR = 4096;

constexpr int RING_OFF = 0, RING_BYTES = 131072;
constexpr int LDSCTL_OFF = RING_BYTES, MISC_OFF = LDSCTL_OFF + 320;
constexpr int LDS_BYTES = 147456;

#define GAS __attribute__((address_space(1)))
#define LAS __attribute__((address_space(3)))
typedef unsigned short bf16;
typedef unsigned v4u __attribute__((ext_vector_type(4)));
typedef unsigned v2u __attribute__((ext_vector_type(2)));
typedef float f32x4 __attribute__((ext_vector_type(4)));
typedef float f32x2 __attribute__((ext_vector_type(2)));
#define LDS_WAIT() asm volatile("s_waitcnt lgkmcnt(0)" ::: "memory")
#define VM_WAIT() asm volatile("s_waitcnt vmcnt(0)" ::: "memory")
__device__ __forceinline__ unsigned f2bf(float f) { unsigned u = __builtin_bit_cast(unsigned, f); return (u + 0x7fffu + ((u >> 16) & 1u)) >> 16; }
__device__ __forceinline__ unsigned pk2(float lo, float hi) { return f2bf(lo) | (f2bf(hi) << 16); }
__device__ __forceinline__ float bflo(unsigned w) { return __uint_as_float(w << 16); }
__device__ __forceinline__ float bfhi(unsigned w) { return __uint_as_float(w & 0xffff0000u); }
__device__ __forceinline__ float bf2f(bf16 b) { return __uint_as_float(((unsigned)b) << 16); }

#define XB_TMO      128
#define XB_XCNT(j)  (256  + 64 * (j))
#define XB_XSUB(j)  (1280 + 64 * (j))
#define XB_XGEN(j)  (2304 + 64 * (j))
#define XB_TOP      3328
#define XB_TOPGEN   3392
#define XCD_BAR_WORDS 3456
#define XB_SPIN_CAP (1u << 21)

__device__ __forceinline__ unsigned xb_ld(unsigned* p)              { return __hip_atomic_load(p, __ATOMIC_RELAXED, __HIP_MEMORY_SCOPE_AGENT); }
__device__ __forceinline__ unsigned xb_add(unsigned* p, unsigned v) { return __hip_atomic_fetch_add(p, v, __ATOMIC_RELAXED, __HIP_MEMORY_SCOPE_AGENT); }
__device__ __forceinline__ unsigned xb_xcc_id() { return (unsigned)__builtin_amdgcn_s_getreg((3 << 11) | 20) & 0xFu; }
#define XB_SPIN(cond, bar) do { unsigned _sp = 0; while (cond) { __builtin_amdgcn_s_sleep(1); \
    if ((++_sp & 255u) == 0u) { if (xb_ld(&(bar)[XB_TMO])) break; if (_sp > XB_SPIN_CAP) { atomicAdd(&(bar)[XB_TMO], 1u); break; } } } } while (0)

struct XcdBarrier {
    unsigned* bar; unsigned x;
    volatile LAS unsigned* st;
    int w;
};

__device__ __forceinline__ XcdBarrier xcd_barrier_post(unsigned* bar, volatile LAS unsigned* st) {
    XcdBarrier b; b.bar = bar; b.x = xb_xcc_id(); b.st = st; b.w = 0;
    if (threadIdx.x == 0) (void)xb_add(&bar[XB_XCNT(b.x)], 1u);
    return b;
}
__device__ __forceinline__ void xcd_barrier_complete(unsigned* bar, unsigned x, unsigned& nloc, unsigned& nx) {
    const unsigned G = gridDim.x * gridDim.y * gridDim.z;
    unsigned sum, cnt, mine, sp = 0u;
    for (;;) {
        sum = 0u; cnt = 0u; mine = 0u;
#pragma unroll
        for (unsigned j = 0; j < 16; ++j) { const unsigned c = xb_ld(&bar[XB_XCNT(j)]); sum += c; cnt += (c > 0u) ? 1u : 0u; mine = (j == x) ? c : mine; }
        if (sum == G) break;
        __builtin_amdgcn_s_sleep(1);
        if ((++sp & 255u) == 0u) { if (xb_ld(&bar[XB_TMO])) break; if (sp > XB_SPIN_CAP) { atomicAdd(&bar[XB_TMO], 1u); break; } }
    }
    nloc = mine > 0u ? mine : 1u; nx = cnt > 0u ? cnt : 1u;
}

__device__ __forceinline__ void xcd_barrier(const XcdBarrier& b) {
    asm volatile("s_waitcnt vmcnt(0)" ::: "memory");
    __syncthreads();
    if (b.w == 0 && __builtin_amdgcn_mbcnt_hi(~0u, __builtin_amdgcn_mbcnt_lo(~0u, 0u)) == 0u) {
        unsigned* bar = b.bar; { GAS unsigned* bg_ = (GAS unsigned*)bar; asm volatile("" : "+s"(bg_)); bar = (unsigned*)bg_; }
        __builtin_amdgcn_s_waitcnt(0);
        unsigned nloc = b.st[0], nx = b.st[1];
        if (nloc == 0u) { xcd_barrier_complete(bar, b.x, nloc, nx); b.st[0] = nloc; b.st[1] = nx; }
        const unsigned old = xb_add(&bar[XB_XSUB(b.x)], 1u);
        const unsigned gen = old / nloc;
        if (old + 1u == (gen + 1u) * nloc) {
            __builtin_amdgcn_fence(__ATOMIC_RELEASE, "agent");
            asm volatile("s_waitcnt vmcnt(0)" ::: "memory");
            const unsigned og = xb_add(&bar[XB_TOP], 1u);
            const unsigned tg = og / nx;
            if (og + 1u == (tg + 1u) * nx) xb_add(&bar[XB_TOPGEN], 1u);
            else XB_SPIN(xb_ld(&bar[XB_TOPGEN]) == tg, bar);
            __builtin_amdgcn_fence(__ATOMIC_ACQUIRE, "agent");
            xb_add(&bar[XB_XGEN(b.x)], 1u);
            asm volatile("s_waitcnt vmcnt(0)" ::: "memory");
        } else {
            XB_SPIN(xb_ld(&bar[XB_XGEN(b.x)]) == gen, bar);
            __builtin_amdgcn_fence(__ATOMIC_ACQUIRE, "agent");
            asm volatile("s_waitcnt vmcnt(0)" ::: "memory");
        }
    }
    __syncthreads();
}

struct Frame {
    LAS unsigned char* lds;
    volatile LAS unsigned* MISC;
    unsigned* ctl;
    int vcu, G;
    int wv;
};
enum { I_X = 0, I_C, I_CTX, I_CCTX, I_WADA, I_BADA, I_GPREMIX, I_GPOSTMIX, I_GPREFFN, I_GPOSTFFN, I_WIN, I_BGATE, I_SINK, I_CONVW, I_RPB, I_WBRANCH, I_WOUT, I_WGUD, I_WDND, I_WROUTER, I_BROUTER, I_WGUM, I_WDNM };

__device__ __forceinline__ float wave_sum(float v) {
#pragma unroll
    for (int o = 1; o < 64; o <<= 1) v += __shfl_xor(v, o);
    return v;
}
__device__ __forceinline__ float wave_max(float v) {
#pragma unroll
    for (int o = 1; o < 64; o <<= 1) v = fmaxf(v, __shfl_xor(v, o));
    return v;
}

__device__ __forceinline__ void row_store_fp8(unsigned char* p, int lane, const f32x4 (&h)[4], float sc) {
#pragma unroll
    for (int c = 0; c < 2; ++c) { const f32x4 a = __builtin_elementwise_min(__builtin_elementwise_max(h[2 * c] * sc, (f32x4){-448.f, -448.f, -448.f, -448.f}), (f32x4){448.f, 448.f, 448.f, 448.f}), b = __builtin_elementwise_min(__builtin_elementwise_max(h[2 * c + 1] * sc, (f32x4){-448.f, -448.f, -448.f, -448.f}), (f32x4){448.f, 448.f, 448.f, 448.f});
        v2u w; w.x = pg8::pk4_fp8(a.x, a.y, a.z, a.w); w.y = pg8::pk4_fp8(b.x, b.y, b.z, b.w);
        *(v2u*)(p + 8 * (64 * c + lane)) = w; }
}

__device__ __forceinline__ void tr_item(const float* W, int N, int k0, int n0, bf16* WT, int Kd, int drow0, LAS float* scr, int lane) {
#pragma unroll
    for (int i = 0; i < 8; ++i) { const int kk = 8 * i + (lane >> 3), c4 = 4 * (lane & 7); const f32x4 v = *(const f32x4*)(W + (size_t)(k0 + kk) * N + n0 + c4);
        LAS float* d = scr + kk * 33 + c4; d[0] = v.x; d[1] = v.y; d[2] = v.z; d[3] = v.w; }
    LDS_WAIT(); asm volatile("" ::: "memory");
    const int c = lane & 7;
#pragma unroll
    for (int j = 0; j < 4; ++j) { const int n = (lane >> 3) + 8 * j; const LAS float* s = scr + (8 * c) * 33 + n;
        v4u o; o.x = pk2(s[0 * 33], s[1 * 33]); o.y = pk2(s[2 * 33], s[3 * 33]); o.z = pk2(s[4 * 33], s[5 * 33]); o.w = pk2(s[6 * 33], s[7 * 33]);
        *(v4u*)(WT + (size_t)(drow0 + n) * Kd + k0 + 8 * c) = o; }
    LDS_WAIT(); asm volatile("" ::: "memory");
}
__device__ __forceinline__ void tr_matrix_item(const float* W, int K, int N, int ff, bf16* WT, int item, LAS float* scr, int lane) {
    const int nblk = N / 32, kb = item / nblk, nb = item % nblk, n0 = 32 * nb;
    int drow0 = n0;
    if (ff > 0) { const int isu = n0 >= ff ? 1 : 0, nn = n0 - isu * ff; drow0 = 256 * (nn >> 7) + 128 * isu + (nn & 127); }
    tr_item(W, N, 64 * kb, n0, WT, K, drow0, scr, lane);
}

__device__ __forceinline__ void tr_item8(const float* W, int N, int k0, int n0, unsigned char* WT, int Kd, int drow0, float scale, LAS float* scr, int lane) {
#pragma unroll
    for (int i = 0; i < 8; ++i) { const int kk = 8 * i + (lane >> 3), c4 = 4 * (lane & 7); const f32x4 v = *(const f32x4*)(W + (size_t)(k0 + kk) * N + n0 + c4);
        LAS float* d = scr + kk * 33 + c4; d[0] = v.x; d[1] = v.y; d[2] = v.z; d[3] = v.w; }
    LDS_WAIT(); asm volatile("" ::: "memory");
    const int n = lane >> 1, kh = lane & 1; const LAS float* s = scr + (32 * kh) * 33 + n;
    unsigned w[8];
#pragma unroll
    for (int j = 0; j < 8; ++j) w[j] = pg8::pk4_fp8(s[(4 * j) * 33] * scale, s[(4 * j + 1) * 33] * scale, s[(4 * j + 2) * 33] * scale, s[(4 * j + 3) * 33] * scale);
    v4u* dst = (v4u*)(WT + (size_t)(drow0 + n) * Kd + k0 + 32 * kh);
    dst[0] = (v4u){w[0], w[1], w[2], w[3]}; dst[1] = (v4u){w[4], w[5], w[6], w[7]};
    LDS_WAIT(); asm volatile("" ::: "memory");
}
__device__ __forceinline__ void tr_matrix_item8(const float* W, int K, int N, int ff, unsigned char* WT, float scale, int item, LAS float* scr, int lane) {
    const int nblk = N / 32, kb = item / nblk, nb = item % nblk, n0 = 32 * nb;
    int drow0 = n0;
    if (ff > 0) { const int isu = n0 >= ff ? 1 : 0, nn = n0 - isu * ff; drow0 = 256 * (nn >> 7) + 128 * isu + (nn & 127); }
    tr_item8(W, N, 64 * kb, n0, WT, K, drow0, scale, scr, lane);
}

__device__ __forceinline__ void row_load(const float* p, int lane, f32x4 (&v)[4]) {
#pragma unroll
    for (int c = 0; c < 2; ++c) { const f32x4* r = (const f32x4*)(p + 8 * (64 * c + lane)); v[2 * c] = r[0]; v[2 * c + 1] = r[1]; }
}
__device__ __forceinline__ void row_load_bf16(const bf16* p, int lane, f32x4 (&v)[4]) {
#pragma unroll
    for (int c = 0; c < 2; ++c) { const v4u w = *(const v4u*)(p + 8 * (64 * c + lane));
        v[2 * c] = (f32x4){bflo(w.x), bfhi(w.x), bflo(w.y), bfhi(w.y)}; v[2 * c + 1] = (f32x4){bflo(w.z), bfhi(w.z), bflo(w.w), bfhi(w.w)}; }
}
__device__ __forceinline__ void row_store(float* p, int lane, const f32x4 (&v)[4]) {
#pragma unroll
    for (int c = 0; c < 2; ++c) { f32x4* r = (f32x4*)(p + 8 * (64 * c + lane)); r[0] = v[2 * c]; r[1] = v[2 * c + 1]; }
}
__device__ __forceinline__ float row_rrms(const f32x4 (&v)[4]) {
    float s = 0.f;
#pragma unroll
    for (int j = 0; j < 4; ++j) s += (v[j].x * v[j].x + v[j].y * v[j].y) + (v[j].z * v[j].z + v[j].w * v[j].w);
    return 1.0f / sqrtf(wave_sum(s) * (1.0f / D) + RMS_EPS);
}
__device__ __forceinline__ void vec_load(const float* p, int lane, f32x4 (&v)[4]) { row_load(p, lane, v); }
__device__ __forceinline__ void row_normmod(const f32x4 (&x)[4], float rr, const f32x4 (&g)[4], const f32x4 (&shift)[4], const f32x4 (&scale)[4], f32x4 (&h)[4]) {
#pragma unroll
    for (int j = 0; j < 4; ++j) h[j] = (x[j] * rr * g[j]) * (scale[j] + 1.0f) + shift[j];
}
__device__ __forceinline__ void row_store_bf16(bf16* p, int lane, const f32x4 (&h)[4]) {
#pragma unroll
    for (int c = 0; c < 2; ++c) { v4u w; w.x = pk2(h[2 * c].x, h[2 * c].y); w.y = pk2(h[2 * c].z, h[2 * c].w); w.z = pk2(h[2 * c + 1].x, h[2 * c + 1].y); w.w = pk2(h[2 * c + 1].z, h[2 * c + 1].w);
        *(v4u*)(p + 8 * (64 * c + lane)) = w; }
}

namespace at {
typedef short bf16x8 __attribute__((ext_vector_type(8)));
typedef short s16x4 __attribute__((ext_vector_type(4)));
typedef short v4i16_t __attribute__((ext_vector_type(4)));
typedef float f32x16 __attribute__((ext_vector_type(16)));
constexpr int NS = 4, PF = 3, SLOT = 16384;
constexpr int LDS_TAB = NS * SLOT + 1024;
constexpr int LDS_TT = LDS_TAB + 8 * 2048 + 1024;
constexpr int MAXT = 160;
constexpr float LOG2E = 1.4426950408889634f, C2 = 0.125f * LOG2E;
__device__ __forceinline__ unsigned cvtpk(float lo, float hi) { unsigned r; asm volatile("v_cvt_pk_bf16_f32 %0, %1, %2" : "=v"(r) : "v"(lo), "v"(hi)); return r; }
__device__ __forceinline__ float hmax(float v) { auto rr = __builtin_amdgcn_permlane32_swap(__float_as_uint(v), __float_as_uint(v), false, false); return fmaxf(__uint_as_float(rr[0]), __uint_as_float(rr[1])); }
__device__ __forceinline__ float hsum(float v) { auto rr = __builtin_amdgcn_permlane32_swap(__float_as_uint(v), __float_as_uint(v), false, false); return __uint_as_float(rr[0]) + __uint_as_float(rr[1]); }

__device__ __forceinline__ void glds16(const void* gsrc, unsigned lds_dst) { unsigned keep;
    asm volatile("s_mov_b32 %0, m0\n\ts_mov_b32 m0, %2\n\ts_nop 0\n\tglobal_load_lds_dwordx4 %1, off\n\ts_mov_b32 m0, %0" : "=&s"(keep) : "v"(gsrc), "s"(lds_dst) : "memory"); }
__device__ __forceinline__ void tile_issue(LAS unsigned char* slot, const bf16* ZMp, size_t row0, int kcol, int vcol, int wid, int lane) {
    const bf16* ksrc = ZMp + (row0 + lane) * ZMC + kcol + wid * 8;
    const bf16* vsrc = ZMp + (row0 + 16 * (wid & 3) + (lane >> 2)) * ZMC + vcol + (wid >> 2) * 32 + (lane & 3) * 8;
    const unsigned dst = (unsigned)__builtin_amdgcn_readfirstlane((int)(unsigned)(uintptr_t)slot + wid * 1024);
    glds16(ksrc, dst); glds16(vsrc, dst + 8192u);
}
__device__ __forceinline__ void qk_tile(f32x16& p0, f32x16& p1, const LAS unsigned char* Ks, const bf16x8 (&qr)[4], int r32, int hi) {
    const LAS unsigned char* kb = Ks + hi * 1024 + r32 * 16;
    bf16x8 kf[8];
#pragma unroll
    for (int d0 = 0; d0 < 4; ++d0) { kf[2 * d0] = *(const LAS bf16x8*)(kb + d0 * 2048); kf[2 * d0 + 1] = *(const LAS bf16x8*)(kb + d0 * 2048 + 512); }
    __builtin_amdgcn_sched_barrier(0);
#pragma unroll
    for (int r = 0; r < 16; ++r) { p0[r] = 0.f; p1[r] = 0.f; }
#pragma unroll
    for (int d0 = 0; d0 < 4; ++d0) {
        p0 = __builtin_amdgcn_mfma_f32_32x32x16_bf16(kf[2 * d0], qr[d0], p0, 0, 0, 0);
        p1 = __builtin_amdgcn_mfma_f32_32x32x16_bf16(kf[2 * d0 + 1], qr[d0], p1, 0, 0, 0);
    }
}
__device__ __forceinline__ s16x4 vtr(const LAS unsigned char* p) { return __builtin_bit_cast(s16x4, __builtin_amdgcn_ds_read_tr16_b64_v4i16((LAS v4i16_t*)p)); }
template <int LV> __device__ __forceinline__ constexpr bool live0(int r) { return LV == 2 ? r >= 12 : true; }
template <int LV> __device__ __forceinline__ constexpr bool live1(int r) { return LV == 1 ? r < 4 : true; }
template <bool RAW, int LV, int VAR = 0>
__device__ __forceinline__ void sm_pv(f32x16& x0, f32x16& x1, float& m, float& l, f32x16 (&o)[2], const LAS unsigned char* Vs, int lane, int hi) {
    if (VAR == 2) { l += x0[0] + x1[15];
        bf16x8 pw_[4]; unsigned w_[16];
#pragma unroll
        for (int i = 0; i < 8; ++i) { w_[i] = cvtpk(x0[2 * i], x0[2 * i + 1]); w_[8 + i] = cvtpk(x1[2 * i], x1[2 * i + 1]); }
#pragma unroll
        for (int k = 0; k < 4; ++k) { typedef unsigned u32x4_ __attribute__((ext_vector_type(4))); u32x4_ t; t.x = w_[4 * k]; t.y = w_[4 * k + 1]; t.z = w_[4 * k + 2]; t.w = w_[4 * k + 3]; pw_[k] = __builtin_bit_cast(bf16x8, t); }
        const LAS unsigned char* vb_ = Vs + ((lane >> 4) & 1) * 32 + (lane & 3) * 8 + (4 * hi + ((lane & 15) >> 2)) * 64;
#pragma unroll
        for (int d0 = 0; d0 < 2; ++d0)
#pragma unroll
            for (int ks = 0; ks < 4; ++ks) { if ((LV == 1 && ks == 3) || (LV == 2 && ks == 0)) continue;
                const s16x4 lo = vtr(vb_ + d0 * 4096 + ks * 1024), hh = vtr(vb_ + d0 * 4096 + ks * 1024 + 512);
                const bf16x8 vf = (bf16x8){lo[0], lo[1], lo[2], lo[3], hh[0], hh[1], hh[2], hh[3]};
                o[d0] = __builtin_amdgcn_mfma_f32_32x32x16_bf16(vf, pw_[ks], o[d0], 0, 0, 0); }
        return; }
    if (VAR == 3) { l += x0[0] + x1[15] + x0[7] + x1[3]; o[0][0] += x0[1]; o[1][0] += x1[1]; return; }
    float rm = -INFINITY;
#pragma unroll
    for (int r = 0; r < 16; ++r) { if (live0<LV>(r)) rm = fmaxf(rm, x0[r]); if (live1<LV>(r)) rm = fmaxf(rm, x1[r]); }
    rm = hmax(rm);
    const float mn = fmaxf(m, RAW ? rm * C2 : rm);
    { const float sc = __builtin_amdgcn_exp2f(m - mn); l *= sc;
#pragma unroll
      for (int r = 0; r < 16; ++r) { o[0][r] *= sc; o[1][r] *= sc; } }
    m = mn;
    float sum = 0.f;
#pragma unroll
    for (int r = 0; r < 16; ++r) {
        if (live0<LV>(r)) { x0[r] = __builtin_amdgcn_exp2f(RAW ? __builtin_fmaf(x0[r], C2, -mn) : x0[r] - mn); sum += x0[r]; } else x0[r] = 0.f;
        if (live1<LV>(r)) { x1[r] = __builtin_amdgcn_exp2f(RAW ? __builtin_fmaf(x1[r], C2, -mn) : x1[r] - mn); sum += x1[r]; } else x1[r] = 0.f;
    }
    l += sum;
    bf16x8 pw[4];
    { unsigned w[16];
#pragma unroll
      for (int i = 0; i < 8; ++i) { w[i] = cvtpk(x0[2 * i], x0[2 * i + 1]); w[8 + i] = cvtpk(x1[2 * i], x1[2 * i + 1]); }
#pragma unroll
      for (int k = 0; k < 4; ++k) { typedef unsigned u32x4_ __attribute__((ext_vector_type(4))); u32x4_ t; t.x = w[4 * k]; t.y = w[4 * k + 1]; t.z = w[4 * k + 2]; t.w = w[4 * k + 3]; pw[k] = __builtin_bit_cast(bf16x8, t); } }
    const LAS unsigned char* vb = Vs + ((lane >> 4) & 1) * 32 + (lane & 3) * 8 + (4 * hi + ((lane & 15) >> 2)) * 64;
    s16x4 vlo[8], vhh[8];
    __builtin_amdgcn_sched_barrier(0);
#pragma unroll
    for (int d0 = 0; d0 < 2; ++d0)
#pragma unroll
        for (int ks = 0; ks < 4; ++ks) { if ((LV == 1 && ks == 3) || (LV == 2 && ks == 0)) continue;
            vlo[d0 * 4 + ks] = vtr(vb + d0 * 4096 + ks * 1024); vhh[d0 * 4 + ks] = vtr(vb + d0 * 4096 + ks * 1024 + 512); }
    __builtin_amdgcn_sched_barrier(0);
#pragma unroll
    for (int d0 = 0; d0 < 2; ++d0)
#pragma unroll
        for (int ks = 0; ks < 4; ++ks) {
            if ((LV == 1 && ks == 3) || (LV == 2 && ks == 0)) continue;
            const s16x4 lo = vlo[d0 * 4 + ks], hh = vhh[d0 * 4 + ks];
            const bf16x8 vf = (bf16x8){lo[0], lo[1], lo[2], lo[3], hh[0], hh[1], hh[2], hh[3]};
            o[d0] = __builtin_amdgcn_mfma_f32_32x32x16_bf16(vf, pw[ks], o[d0], 0, 0, 0);
        }
}
__device__ __forceinline__ void o_store(const f32x16 (&o)[2], float l, bf16* orow, int hi) {
    const float inv = __builtin_amdgcn_rcpf(hsum(l));
#pragma unroll
    for (int d0 = 0; d0 < 2; ++d0)
#pragma unroll
        for (int gp = 0; gp < 2; ++gp) {
            unsigned w[2][2];
#pragma unroll
            for (int k = 0; k < 2; ++k) { const int g = 2 * gp + k; w[k][0] = cvtpk(o[d0][4 * g] * inv, o[d0][4 * g + 1] * inv); w[k][1] = cvtpk(o[d0][4 * g + 2] * inv, o[d0][4 * g + 3] * inv); }
            unsigned rcv[2];
#pragma unroll
            for (int i = 0; i < 2; ++i) { const unsigned snd = hi ? w[0][i] : w[1][i];
                auto rr = __builtin_amdgcn_permlane32_swap(snd, snd, false, false); rcv[i] = hi ? rr[0] : rr[1]; }
            v4u st; if (hi) { st.x = rcv[0]; st.y = rcv[1]; st.z = w[1][0]; st.w = w[1][1]; } else { st.x = w[0][0]; st.y = w[0][1]; st.z = rcv[0]; st.w = rcv[1]; }
            *(v4u*)(orow + 32 * d0 + 16 * gp + 8 * hi) = st;
        }
}
#define AT_WAIT_BAR(N) asm volatile("s_waitcnt vmcnt(" #N ")\n\ts_barrier" ::: "memory")

struct UDesc { int kind, b, hh, blk, cq, nw, lo; };
__device__ __forceinline__ UDesc unit_desc(int i, int vcu, int UPW, bool ctx_out) {
    UDesc d; d.kind = -1; d.b = 0; d.hh = 0; d.blk = 0; d.cq = 0; d.nw = 0; d.lo = 0;
    if (i < 2 * UPW) { const int u = vcu * UPW + (i < UPW ? i : i - UPW); if (u >= 1024) return d; d.kind = i < UPW ? 0 : 1; d.b = u >> 8;
        if (d.kind == 0) { d.hh = (u >> 5) & 7; d.blk = u & 31; } else { d.hh = (u >> 7) & 1; d.blk = u & 127; } }
    else if (i == 2 * UPW) { if (!ctx_out || vcu >= 64) return d; d.cq = 1;
        if (vcu < 32) { d.kind = 1; d.b = vcu >> 3; d.hh = (vcu >> 2) & 1; d.blk = vcu & 3; } else { d.kind = 0; d.b = (vcu - 32) >> 3; d.hh = (vcu - 32) & 7; d.blk = 0; } }
    else return d;
    if (!d.cq) {
        if (d.kind == 1) { d.lo = max(0, 2 - d.blk); d.nw = min(4, 129 - d.blk) - d.lo + 1; }
        else { d.lo = min(max(4 * d.blk - 4, 0), 120); d.nw = min(max(4 * d.blk - 1, 0), 120) + 7 - d.lo + 1; }
    }
    return d;
}
__device__ __forceinline__ void tile_src(const UDesc& d, int t, int& row0, int& cols) {
    const int kcol = d.kind == 1 ? C_KA + d.hh * 64 : C_KN + d.hh * 64, vcol = d.kind == 1 ? C_VA + d.hh * 64 : C_VN + d.hh * 64;
    cols = kcol | (vcol << 16);
    if (t < d.nw) row0 = d.kind == 1 ? d.b * SEQ + 64 * d.blk - 128 + 64 * (d.lo + t) : d.b * SEQ + 64 * (d.lo + t);
    else row0 = TL + d.b * CTXL + 64 * (t - d.nw);
}
__device__ __forceinline__ size_t q_row(const UDesc& d, int wid, int r32) {
    if (d.kind == 1) { const int qrel = 32 * (wid >> 2) + r32; return d.cq ? (size_t)TL + (size_t)d.b * CTXL + 64 * d.blk + qrel : (size_t)d.b * SEQ + 64 * d.blk + qrel; }
    const int pair = wid >> 1, c = 32 * (wid & 1) + r32;
    return d.cq ? (size_t)TL + (size_t)d.b * CTXL + 64 * pair + c : (size_t)d.b * SEQ + (size_t)(4 * d.blk + pair) * 64 + c;
}
__device__ __forceinline__ void q_load(const UDesc& d, const bf16* ZMp, int wid, int r32, int hi, bf16x8 (&qr)[4]) {
    const int qcol = d.kind == 1 ? C_QA + (d.hh * 4 + (wid & 3)) * 64 : C_QN + d.hh * 64;
    const bf16* p = ZMp + q_row(d, wid, r32) * ZMC + qcol + 8 * hi;
#pragma unroll
    for (int d0 = 0; d0 < 4; ++d0) qr[d0] = *(const bf16x8*)(p + 16 * d0);
}

template <int VAR = 0>
__device__ __forceinline__ void attn_phase(LAS unsigned char* lds, const bf16* ZMp, bf16* OAp, bf16* OCp, const float* sinkp, const float* rpbl, int vcu, int G, bool ctx_out, int tid, int wid, int lane) {
    const int r32 = lane & 31, hi = lane >> 5;
    const int UPW = (1024 + G - 1) / G, NU = 2 * UPW + 1;
    LAS int* tt = (LAS int*)(lds + LDS_TT);
    int Ttot = 0;
    for (int i = 0; i < NU; ++i) { const UDesc d = unit_desc(i, vcu, UPW, ctx_out); if (d.kind < 0) continue; const int nt = d.nw + 4;
        for (int t = tid; t < nt; t += NWAVES * 64) { int row0, cols; tile_src(d, t, row0, cols); if (Ttot + t < MAXT) { tt[2 * (Ttot + t)] = row0; tt[2 * (Ttot + t) + 1] = cols; } }
        Ttot += nt; }
    if (Ttot > MAXT) Ttot = MAXT;
    if (tid < 8) ((LAS float*)(lds + LDS_TT + MAXT * 8))[tid] = sinkp[tid] * LOG2E;
    for (int u = tid; u < 8 * 480; u += NWAVES * 64) { const int h = u / 480, e = u - 480 * h, dr = e >> 5, dc = e & 31; ((LAS float*)(lds + LDS_TAB))[h * 512 + e] = dc < 31 ? rpbl[(h * 15 + dr) * 31 + dc] * LOG2E : 0.f; }
    asm volatile("s_waitcnt lgkmcnt(0)\n\ts_barrier" ::: "memory");
#define AT_ISSUE(T) do { const int row0_ = __builtin_amdgcn_readfirstlane(tt[2 * (T)]), cols_ = __builtin_amdgcn_readfirstlane(tt[2 * (T) + 1]); \
        tile_issue(lds + ((T) & (NS - 1)) * SLOT, ZMp, (size_t)row0_, cols_ & 0xffff, cols_ >> 16, wid, lane); } while (0)
    for (int T = 0; T < PF && T < Ttot; ++T) AT_ISSUE(T);
    int Tb = 0;
    bf16x8 qn[4];
    { int i0 = 0; UDesc d0 = unit_desc(0, vcu, UPW, ctx_out); while (d0.kind < 0 && i0 + 1 < NU) { ++i0; d0 = unit_desc(i0, vcu, UPW, ctx_out); } if (d0.kind >= 0) q_load(d0, ZMp, wid, r32, hi, qn); }
    for (int i = 0; i < NU; ++i) {
        const UDesc d = unit_desc(i, vcu, UPW, ctx_out); if (d.kind < 0) continue;
        bf16x8 qr[4];
#pragma unroll
        for (int k = 0; k < 4; ++k) qr[k] = qn[k];
        { int j = i + 1; UDesc dn = unit_desc(j, vcu, UPW, ctx_out); while (dn.kind < 0 && j + 1 < NU) { ++j; dn = unit_desc(j, vcu, UPW, ctx_out); } if (dn.kind < 0) dn = d; q_load(dn, ZMp, wid, r32, hi, qn); }
        const int NT = d.nw + 4;
        f32x16 o[2];
#pragma unroll
        for (int r = 0; r < 16; ++r) { o[0][r] = 0.f; o[1][r] = 0.f; }
        float m, l;
        if (d.kind == 1) {
            const int head = d.hh * 4 + (wid & 3), qrel = 32 * (wid >> 2) + r32;
            m = ((const LAS float*)(lds + LDS_TT + MAXT * 8))[head]; l = (hi == 0) ? 1.0f : 0.0f;
            int t = 0;
            do {
                const int T = Tb + t, outst = min(Ttot, T + PF) - (T + 1);
                if (outst >= 2) AT_WAIT_BAR(4); else if (outst == 1) AT_WAIT_BAR(2); else AT_WAIT_BAR(0);
                if (t == NT - 1) asm volatile("" : "+v"(qn[0]), "+v"(qn[1]), "+v"(qn[2]), "+v"(qn[3]));
                if (VAR != 5 && T + PF < Ttot) AT_ISSUE(T + PF);
                const LAS unsigned char* sl = lds + (T & (NS - 1)) * SLOT;
                f32x16 x0, x1; if (VAR == 4) { for (int r_ = 0; r_ < 16; ++r_) { x0[r_] = __builtin_bit_cast(float, (int)qr[r_ & 3][0] << 16) ; x1[r_] = x0[r_] * 0.5f; } } else qk_tile(x0, x1, sl, qr, r32, hi);
                const int j = d.lo + t;
                if (t < d.nw && (j == 0 || j == 4)) {
                    const int dq = qrel + 128 - 64 * j - 4 * hi;
#pragma unroll
                    for (int r = 0; r < 16; ++r) { const int dd = dq - ((r & 3) + 8 * (r >> 2));
                        x0[r] = (dd <= 128 && dd >= -128) ? x0[r] * C2 : -INFINITY; x1[r] = (dd - 32 <= 128 && dd - 32 >= -128) ? x1[r] * C2 : -INFINITY; }
                    sm_pv<false, 0, VAR>(x0, x1, m, l, o, sl + 8192, lane, hi);
                } else sm_pv<true, 0, VAR>(x0, x1, m, l, o, sl + 8192, lane, hi);
            } while (++t < NT);
            o_store(o, l, OAp + q_row(d, wid, r32) * BW + head * 64, hi);
        } else {
            const int half = wid & 1, c = 32 * half + r32, r = 4 * d.blk + (wid >> 1);
            const int r0w = min(max(r - 4, 0), 120), c0 = min(max(c - 8, 0), 48);
            const LAS float* tab = (const LAS float*)(lds + LDS_TAB + d.hh * 2048);
            unsigned vm = 0u;
#pragma unroll
            for (int r_ = 0; r_ < 16; ++r_) { const int kc = (r_ & 3) + 8 * (r_ >> 2) + 4 * hi; vm |= ((unsigned)(kc - c0) < 16u ? 1u : 0u) << r_; vm |= ((unsigned)(kc + 32 - c0) < 16u ? 1u : 0u) << (16 + r_); }
            m = -1e30f; l = 0.f;
            int t = 0;
            do {
                const int T = Tb + t, outst = min(Ttot, T + PF) - (T + 1);
                if (outst >= 2) AT_WAIT_BAR(4); else if (outst == 1) AT_WAIT_BAR(2); else AT_WAIT_BAR(0);
                if (t == NT - 1) asm volatile("" : "+v"(qn[0]), "+v"(qn[1]), "+v"(qn[2]), "+v"(qn[3]));
                if (VAR != 5 && T + PF < Ttot) AT_ISSUE(T + PF);
                const int kr = d.lo + t;
                if (t < d.nw && (kr < r0w || kr > r0w + 7)) continue;
                const LAS unsigned char* sl = lds + (T & (NS - 1)) * SLOT;
                f32x16 x0, x1; if (VAR == 4) { for (int r_ = 0; r_ < 16; ++r_) { x0[r_] = __builtin_bit_cast(float, (int)qr[r_ & 3][0] << 16) ; x1[r_] = x0[r_] * 0.5f; } } else qk_tile(x0, x1, sl, qr, r32, hi);
                if (t < d.nw) {
                    const LAS float* tb = tab + (kr - r + 7) * 32 + (4 * hi - c + 15);
                    if (half == 0) {
                        float b0[16], b1[4];
#pragma unroll
                        for (int r_ = 0; r_ < 16; ++r_) { const int rr = (r_ & 3) + 8 * (r_ >> 2); b0[r_] = tb[rr]; if (r_ < 4) b1[r_] = tb[rr + 32]; }
#pragma unroll
                        for (int r_ = 0; r_ < 16; ++r_) {
                            x0[r_] = ((vm >> r_) & 1u) ? __builtin_fmaf(x0[r_], C2, b0[r_]) : -INFINITY;
                            if (r_ < 4) x1[r_] = ((vm >> (16 + r_)) & 1u) ? __builtin_fmaf(x1[r_], C2, b1[r_]) : -INFINITY; }
                        sm_pv<false, 1, VAR>(x0, x1, m, l, o, sl + 8192, lane, hi);
                    } else {
                        float b0[4], b1[16];
#pragma unroll
                        for (int r_ = 0; r_ < 16; ++r_) { const int rr = (r_ & 3) + 8 * (r_ >> 2); if (r_ >= 12) b0[r_ - 12] = tb[rr]; b1[r_] = tb[rr + 32]; }
#pragma unroll
                        for (int r_ = 0; r_ < 16; ++r_) {
                            if (r_ >= 12) x0[r_] = ((vm >> r_) & 1u) ? __builtin_fmaf(x0[r_], C2, b0[r_ - 12]) : -INFINITY;
                            x1[r_] = ((vm >> (16 + r_)) & 1u) ? __builtin_fmaf(x1[r_], C2, b1[r_]) : -INFINITY; }
                        sm_pv<false, 2, VAR>(x0, x1, m, l, o, sl + 8192, lane, hi);
                    }
                } else sm_pv<true, 0, VAR>(x0, x1, m, l, o, sl + 8192, lane, hi);
            } while (++t < NT);
            o_store(o, l, OCp + q_row(d, wid, r32) * BW + d.hh * 64, hi);
        }
        Tb += NT;
    }
    AT_WAIT_BAR(0);
#undef AT_ISSUE
}
}

constexpr int PH_PER_LAYER = 17, NPHASES = 1 + DEPTH * PH_PER_LAYER;
struct Args { const float* in[23]; float* out; unsigned char* ws; int ph_lo, ph_hi; };
typedef __attribute__((address_space(4))) const Args CArgs;
__global__ void __launch_bounds__(NWAVES * 64, 2) mk_fwd(Args args) {
    extern __shared__ __attribute__((aligned(16))) unsigned char lds[];
    Frame F;
    F.lds = (LAS unsigned char*)lds;
    F.MISC = (volatile LAS unsigned*)(F.lds + MISC_OFF);
    F.G = gridDim.x; { const int bx = blockIdx.x; F.vcu = (F.G % 8 == 0) ? (bx % 8) * (F.G / 8) + bx / 8 : bx; }
    F.ctl = (unsigned*)(args.ws + WS_CTL);
    for (int u = threadIdx.x; u < (LDS_BYTES - LDSCTL_OFF) / 4; u += NWAVES * 64) ((LAS unsigned*)(F.lds + LDSCTL_OFF))[u] = 0u;
    { int wv_ = __builtin_amdgcn_readfirstlane((int)(threadIdx.x >> 6)); asm volatile("" : "+s"(wv_)); F.wv = wv_; }
    __syncthreads();
    const int lo = args.ph_lo, hi = args.ph_hi;
    const bool fused = (hi - lo) > 1;
    XcdBarrier bar; bar.bar = F.ctl + CW_BAR; bar.x = 0; bar.st = nullptr; bar.w = F.wv;
    if (fused) { bar = xcd_barrier_post(F.ctl + CW_BAR, F.MISC + 8); bar.w = F.wv; }
#ifndef MK_MASK
#define MK_MASK 0xFFFFFFFFu
#endif
#define SLOT(k) ((k) == 0 ? 0 : (((k) - 1) % PH_PER_LAYER) + 1)
#define IN(k) (((MK_MASK >> SLOT(k)) & 1u) && lo <= (k) && (k) < hi)
#define GRID_BAR() do { if (fused) xcd_barrier(bar); } while (0)
    const int NGW = F.G * NWAVES;
#define PHASE_ENTER() GAS unsigned char* wsg_ = (GAS unsigned char*)args.ws; asm volatile("" : "+s"(wsg_)); unsigned char* ws = (unsigned char*)wsg_; float* outp = (float*)(GAS float*)args.out; (void)outp; const CArgs* ka = (const CArgs*)__builtin_amdgcn_kernarg_segment_ptr(); asm volatile("" : "+s"(ka)); \
    int tid_ = (F.wv << 6) | (int)__builtin_amdgcn_mbcnt_hi(~0u, __builtin_amdgcn_mbcnt_lo(~0u, 0u)); asm volatile("" : "+v"(tid_)); const int lane = tid_ & 63; const int wave = __builtin_amdgcn_readfirstlane(tid_ >> 6); const int gw = F.vcu * NWAVES + wave; (void)gw; (void)lane; (void)ws; (void)ka;
#define INP(i) ((const float*)(const GAS float*)ka->in[i])
#define MOD ((float*)(GAS float*)(ws + WS_MOD))
#define ROPE ((float*)(GAS float*)(ws + WS_ROPE))
#define SLABCNT ((int*)(GAS int*)(ws + WS_SLABCNT))
#define PCUM ((int*)(GAS int*)(ws + WS_PCUM))
#define TOKER ((int*)(GAS int*)(ws + WS_TOKER))
#define TOKG ((float*)(GAS float*)(ws + WS_TOKG))
#define TOKPOS ((int*)(GAS int*)(ws + WS_TOKPOS))
#define HCTX ((float*)(GAS float*)(ws + WS_HCTX))
#define W_IN ((bf16*)(GAS bf16*)(ws + WS_WIN))
#define W_BR ((bf16*)(GAS bf16*)(ws + WS_WBR))
#define W_OUT ((bf16*)(GAS bf16*)(ws + WS_WOUT))
#define W_GUD ((bf16*)(GAS bf16*)(ws + WS_WGUD))
#define W_DND ((bf16*)(GAS bf16*)(ws + WS_WDND))
#define W_GUM8 ((unsigned char*)(GAS unsigned char*)(ws + WS_WGUM))
#define W_DNM8 ((unsigned char*)(GAS unsigned char*)(ws + WS_WDNM))
#define HX ((bf16*)(GAS bf16*)(ws + WS_HX))
#define ZM ((bf16*)(GAS bf16*)(ws + WS_ZM))
#define ZG ((bf16*)(GAS bf16*)(ws + WS_ZG))
#define OA ((bf16*)(GAS bf16*)(ws + WS_O))
#define OB (OA + (size_t)TA * BW)
#define OC (OA + (size_t)2 * TA * BW)
#define SB ((float*)(GAS float*)(ws + WS_ZM))
#define Y16 ((bf16*)(GAS bf16*)(ws + WS_ZG))
#define HD ((bf16*)(GAS bf16*)(ws + WS_ZM))
#define XG ((bf16*)(GAS bf16*)(ws + WS_XG))
#define HM8 ((unsigned char*)(GAS unsigned char*)(ws + WS_HM))
#define XG8 ((unsigned char*)(GAS unsigned char*)(ws + WS_XG8))
#define HX8 ((unsigned char*)(GAS unsigned char*)(ws + WS_HX8))
#define W_ING8 ((unsigned char*)(GAS unsigned char*)(ws + WS_WING8))

    if (IN(0)) {
        PHASE_ENTER();
        {
            LAS float* scv = (LAS float*)(F.lds + RING_OFF);
            LAS float* red = scv + 5 * 1024;
            for (int u = tid_; u < 5 * 1024; u += NWAVES * 64) { const int bb = u >> 10, k = u & 1023; const float cv = bb < 4 ? INP(I_C)[bb * 1024 + k] : INP(I_CCTX)[k]; scv[u] = cv / (1.0f + __expf(-cv)); }
            __syncthreads();
            for (int it = blockIdx.x; it < 2 * 96; it += F.G) {
                const int l = it / 96, n = (it % 96) * 64 + lane;
                const float* wp = INP(I_WADA) + (size_t)l * D * 6144 + n;
                float a0 = 0.f, a1 = 0.f, a2 = 0.f, a3 = 0.f, a4 = 0.f;
                const int kb = wave * 128;
#pragma unroll 16
                for (int k = 0; k < 128; ++k) { const float w = wp[(size_t)(kb + k) * 6144];
                    a0 += scv[kb + k] * w; a1 += scv[1024 + kb + k] * w; a2 += scv[2048 + kb + k] * w; a3 += scv[3072 + kb + k] * w; a4 += scv[4096 + kb + k] * w; }
                red[(wave * 5 + 0) * 64 + lane] = a0; red[(wave * 5 + 1) * 64 + lane] = a1; red[(wave * 5 + 2) * 64 + lane] = a2; red[(wave * 5 + 3) * 64 + lane] = a3; red[(wave * 5 + 4) * 64 + lane] = a4;
                __syncthreads();
                if (tid_ < 320) { const int bb = tid_ >> 6, nn = tid_ & 63; float s = 0.f;
#pragma unroll
                    for (int w = 0; w < 8; ++w) s += red[(w * 5 + bb) * 64 + nn];
                    const int col = (it % 96) * 64 + nn;
                    MOD[((size_t)l * 5 + bb) * 6144 + col] = s + INP(I_BADA)[l * 6144 + col]; }
                __syncthreads();
            }
        }
        if (blockIdx.x == F.G - 1) {
            for (int u = tid_; u < 192 * 16; u += NWAVES * 64) { const int idx = u >> 4, i = u & 15; const float pos = (float)(idx < 128 ? idx : idx - 128);
                const float inv = 1.0f / powf(10000.0f, (float)(2 * i) / 32.0f); const float ang = pos * inv;
                ROPE[2 * u] = cosf(ang); ROPE[2 * u + 1] = sinf(ang); }
        }
        __syncthreads();
        {
            LAS float* scr = (LAS float*)(F.lds + RING_OFF + wave * 16384);
            constexpr int I_IN = (D / 64) * (INC / 32), I_BR = (BW / 64) * (D / 32), I_OUT = (D / 64) * (D / 32), I_GUD = (D / 64) * (2 * FFD / 32), I_DND = (FFD / 64) * (D / 32),
                          I_GUM = (D / 64) * (2 * FFE / 32), I_DNM = (FFE / 64) * (D / 32);
            constexpr int NITEMS = 2 * I_IN + 6 * I_BR + 2 * I_OUT + I_GUD + I_DND + NE * I_GUM + NE * I_DNM;
            for (int it = gw; it < NITEMS; it += NGW) {
                int r = it;
                if (r < 2 * I_IN) { const int l = r / I_IN, it2 = r % I_IN, n0 = 32 * (it2 % (INC / 32));
                    if (MK_GATE_F8 == 2) { tr_item8(INP(I_WIN) + (size_t)l * D * INC, INC, 64 * (it2 / (INC / 32)), n0, (unsigned char*)W_IN + (size_t)l * INC * D, D, n0, SC_WGU, scr, lane); continue; }
                    if (!MK_GATE_F8 || n0 < ZMC) tr_matrix_item(INP(I_WIN) + (size_t)l * D * INC, D, INC, 0, W_IN + (size_t)l * INC * D, it2, scr, lane);
                    if (MK_GATE_F8 && n0 >= ZMC) tr_item8(INP(I_WIN) + (size_t)l * D * INC, INC, 64 * (it2 / (INC / 32)), n0, W_ING8 + (size_t)l * ZGC * D, D, n0 - ZMC, SC_WGU, scr, lane);
                    continue; } r -= 2 * I_IN;
                if (r < 6 * I_BR) { const int q = r / I_BR; tr_matrix_item(INP(I_WBRANCH) + (size_t)q * BW * D, BW, D, 0, W_BR + (size_t)q * D * BW, r % I_BR, scr, lane); continue; } r -= 6 * I_BR;
                if (r < 2 * I_OUT) { const int l = r / I_OUT; tr_matrix_item(INP(I_WOUT) + (size_t)l * D * D, D, D, 0, W_OUT + (size_t)l * D * D, r % I_OUT, scr, lane); continue; } r -= 2 * I_OUT;
                if (r < I_GUD) { if (MK_DENSE_F8 >= 2) tr_matrix_item8(INP(I_WGUD), D, 2 * FFD, FFD, (unsigned char*)W_GUD, SC_WGU, r, scr, lane); else tr_matrix_item(INP(I_WGUD), D, 2 * FFD, FFD, W_GUD, r, scr, lane); continue; } r -= I_GUD;
                if (r < I_DND) { if (MK_DENSE_F8 >= 1) tr_matrix_item8(INP(I_WDND), FFD, D, 0, (unsigned char*)W_DND, SC_WDN, r, scr, lane); else tr_matrix_item(INP(I_WDND), FFD, D, 0, W_DND, r, scr, lane); continue; } r -= I_DND;
                if (r < NE * I_GUM) { const int e = r / I_GUM; tr_matrix_item8(INP(I_WGUM) + (size_t)e * D * 2 * FFE, D, 2 * FFE, FFE, W_GUM8 + (size_t)e * 2 * FFE * D, SC_WGU, r % I_GUM, scr, lane); continue; } r -= NE * I_GUM;
                { const int e = r / I_DNM; tr_matrix_item8(INP(I_WDNM) + (size_t)e * FFE * D, FFE, D, 0, W_DNM8 + (size_t)e * D * FFE, SC_WDN, r % I_DNM, scr, lane); }
            }
        }
        GRID_BAR();
    }

    for (int l = 0; l < DEPTH; ++l) {
        const int pb = 1 + l * PH_PER_LAYER;
        const bool ctx_out = (l < DEPTH - 1);
        const bool moe = (l & 1) != 0;
        const int rows_out = ctx_out ? TA : TL;
#define modl (MOD + (size_t)l * 5 * 6144)
#define xsrc_lat ((l == 0) ? INP(I_X) : (const float*)outp)
#define xsrc_ctx ((l == 0) ? INP(I_CTX) : (const float*)HCTX)

        if (IN(pb + 0) && l == 0) {
            PHASE_ENTER();
            const int chunk = (TL + NGW - 1) / NGW;
#define P1_ROW(t) do { const float* xr = (t) < TL ? xsrc_lat + (size_t)(t) * D : xsrc_ctx + (size_t)((t) - TL) * D; \
                f32x4 x[4], h[4]; row_load(xr, lane, x); const float rr = row_rrms(x); row_normmod(x, rr, gpre, sh, sc, h); if (MK_GATE_F8 < 2) row_store_bf16(HX + (size_t)(t) * D, lane, h); if (MK_GATE_F8) row_store_fp8(HX8 + (size_t)(t) * D, lane, h, SC_XG); } while (0)
            f32x4 gpre[4], sh[4], sc[4]; vec_load(INP(I_GPREMIX) + l * D, lane, gpre);
            for (int t0 = min(gw * chunk, TL), t1 = min(TL, t0 + chunk); t0 < t1; ) { const int bb = t0 >> 13, te = min(t1, (bb + 1) << 13); const float* md = modl + (size_t)bb * 6144;
                vec_load(md, lane, sh); vec_load(md + 1024, lane, sc);
                for (int t = t0; t < te; ++t) P1_ROW(t);
                t0 = te; }
            { const float* md = modl + (size_t)4 * 6144; vec_load(md, lane, sh); vec_load(md + 1024, lane, sc); for (int t = TL + gw; t < TA; t += NGW) P1_ROW(t); }
#undef P1_ROW
            GRID_BAR();
        }
        if (IN(pb + 1)) {
            PHASE_ENTER();
#if MK_GATE_F8 == 2
            {
                pg8::Gemm g{(const bf16*)HX8, (const bf16*)((unsigned char*)W_IN + (size_t)l * INC * D), TA, ZMC, D}; pg8::StaticOrder S; S.init(TA, ZMC, F.G, (int)blockIdx.x, MK_WGM);
                pg8::EpiZT<true> E{ZM, ZG, ROPE, TL / 256, INP(I_BGATE) + (size_t)l * 3 * D, 0, 1.0f / (SC_XG * SC_WGU)};
                pg8::gemm_phase<pg8::EpiZT<true>, pg8::StaticOrder, PG8_ALIGN, PG8_SP2>(F.lds + RING_OFF, g, S, E, F.wv);
            }
            {
                pg8::Gemm g{(const bf16*)HX8, (const bf16*)((unsigned char*)W_IN + (size_t)l * INC * D + (size_t)ZMC * D), rows_out, ZGC, D}; pg8::StaticOrder S; S.init(rows_out, ZGC, F.G, (int)blockIdx.x, MK_WGM);
                pg8::EpiZT<true> E{ZM, ZG, ROPE, TL / 256, INP(I_BGATE) + (size_t)l * 3 * D, ZMC / 256, 1.0f / (SC_XG * SC_WGU)};
                pg8::gemm_phase<pg8::EpiZT<true>, pg8::StaticOrder, PG8_ALIGN, PG8_SP2>(F.lds + RING_OFF, g, S, E, F.wv);
            }
#elif MK_GATE_F8
            {
                pg8::Gemm g{HX, W_IN + (size_t)l * INC * D, TA, ZMC, D}; pg8::StaticOrder S; S.init(TA, ZMC, F.G, (int)blockIdx.x, MK_WGM);
                pg8::EpiZ E{ZM, ZG, ROPE, TL / 256, INP(I_BGATE) + (size_t)l * 3 * D, 0, 1.0f};
                pg8::gemm_phase<pg8::EpiZ, pg8::StaticOrder, PG8_ALIGN, PG8_SP2>(F.lds + RING_OFF, g, S, E, F.wv);
            }
            {
                pg8::Gemm g{(const bf16*)HX8, (const bf16*)(W_ING8 + (size_t)l * ZGC * D), rows_out, ZGC, D}; pg8::StaticOrder S; S.init(rows_out, ZGC, F.G, (int)blockIdx.x, MK_WGM);
                pg8::EpiZT<true> E{ZM, ZG, ROPE, TL / 256, INP(I_BGATE) + (size_t)l * 3 * D, ZMC / 256, 1.0f / (SC_XG * SC_WGU)};
                pg8::gemm_phase<pg8::EpiZT<true>, pg8::StaticOrder, PG8_ALIGN, PG8_SP2>(F.lds + RING_OFF, g, S, E, F.wv);
            }
#else
            pg8::Gemm g{HX, W_IN + (size_t)l * INC * D, TA, INC, D}; pg8::StaticOrder S; S.init(TA, INC, F.G, (int)blockIdx.x, MK_WGM);
            pg8::EpiZ E{ZM, ZG, ROPE, TL / 256, INP(I_BGATE) + (size_t)l * 3 * D, 0, 1.0f};
            pg8::gemm_phase<pg8::EpiZ, pg8::StaticOrder, PG8_ALIGN, PG8_SP2>(F.lds + RING_OFF, g, S, E, F.wv);
#endif
            GRID_BAR();
        }
        if (IN(pb + 3)) {
            PHASE_ENTER();
            const float* sinkp = INP(I_SINK) + l * 8; const float* rpbp = INP(I_RPB) + (size_t)l * 8 * 15 * 31;
            const float* cw = INP(I_CONVW) + (size_t)l * 3 * BW;
            for (int t = gw; t < rows_out; t += NGW) {
                const bf16* zr = ZM + (size_t)t * ZMC;
                int s, len; size_t base;
                if (t < TL) { s = t & (SEQ - 1); len = SEQ; base = (size_t)(t - s); } else { s = (t - TL) & (CTXL - 1); len = CTXL; base = (size_t)(t - s); }
                const int ch = 8 * lane;
                float uu[3][8];
#pragma unroll
                for (int k = 0; k < 3; ++k) { const int sp = s + k - 1; const bool okk = (sp >= 0 && sp < len);
                    const bf16* zp = ZM + (base + (okk ? sp : s)) * ZMC; const v4u a = *(const v4u*)(zp + C_UX + ch), g = *(const v4u*)(zp + C_GC + ch); const float mk_ = okk ? 1.f : 0.f;
                    uu[k][0] = mk_ * bflo(a.x) * bflo(g.x); uu[k][1] = mk_ * bfhi(a.x) * bfhi(g.x); uu[k][2] = mk_ * bflo(a.y) * bflo(g.y); uu[k][3] = mk_ * bfhi(a.y) * bfhi(g.y);
                    uu[k][4] = mk_ * bflo(a.z) * bflo(g.z); uu[k][5] = mk_ * bfhi(a.z) * bfhi(g.z); uu[k][6] = mk_ * bflo(a.w) * bflo(g.w); uu[k][7] = mk_ * bfhi(a.w) * bfhi(g.w); }
                const v4u gbv = *(const v4u*)(zr + C_GB + ch);
                const float gb[8] = {bflo(gbv.x), bfhi(gbv.x), bflo(gbv.y), bfhi(gbv.y), bflo(gbv.z), bfhi(gbv.z), bflo(gbv.w), bfhi(gbv.w)};
                float o[8];
#pragma unroll
                for (int q = 0; q < 8; ++q) o[q] = gb[q] * (cw[ch + q] * uu[0][q] + cw[BW + ch + q] * uu[1][q] + cw[2 * BW + ch + q] * uu[2][q]);
                v4u w; w.x = pk2(o[0], o[1]); w.y = pk2(o[2], o[3]); w.z = pk2(o[4], o[5]); w.w = pk2(o[6], o[7]);
                *(v4u*)(OB + (size_t)t * BW + ch) = w;
            }
            at::attn_phase(F.lds + RING_OFF, ZM, OA, OC, sinkp, rpbp, F.vcu, F.G, ctx_out, tid_, wave, lane);
#ifdef MK_ATTN_PROBE
            at::attn_phase<MK_ATTN_PROBE>(F.lds + RING_OFF, ZM, (bf16*)(GAS bf16*)(ws + WS_HX), (bf16*)(GAS bf16*)(ws + WS_HX) + (size_t)TA * BW, sinkp, rpbp, F.vcu, F.G, ctx_out, tid_, wave, lane);
#endif
            GRID_BAR();
        }
        if (IN(pb + 4)) {
            PHASE_ENTER();
            pg8::Gemm g{OA, W_BR + (size_t)l * 3 * D * BW, rows_out, D, BW};
            pg8::BranchOrder3 S; S.so.init(rows_out, D, F.G, (int)blockIdx.x, MK_WGM);
            pg8::EpiBranchAcc E{HX, ZG};
            pg8::gemm_phase<pg8::EpiBranchAcc, pg8::BranchOrder3, PG8_ALIGN, PG8_SP2>(F.lds + RING_OFF, g, S, E, F.wv);
            GRID_BAR();
        }
        if (IN(pb + 5)) {
            PHASE_ENTER();
            pg8::Gemm g{HX, W_OUT + (size_t)l * D * D, rows_out, D, D}; pg8::StaticOrder S; S.init(rows_out, D, F.G, (int)blockIdx.x, MK_WGM);
            pg8::EpiBf16P E{Y16, D};
            pg8::gemm_phase<pg8::EpiBf16P, pg8::StaticOrder, PG8_ALIGN, PG8_SP2>(F.lds + RING_OFF, g, S, E, F.wv);
            GRID_BAR();
        }
        if (IN(pb + 6)) {
            PHASE_ENTER();
            if (!moe) {
                const int chunk = (TL + NGW - 1) / NGW;
#define P6_ROW(t) do { const float* xr = (t) < TL ? xsrc_lat + (size_t)(t) * D : xsrc_ctx + (size_t)((t) - TL) * D; float* xw = (t) < TL ? outp + (size_t)(t) * D : HCTX + (size_t)((t) - TL) * D; \
                    f32x4 x[4], y[4], h[4]; row_load(xr, lane, x); row_load_bf16(Y16 + (size_t)(t) * D, lane, y); const float ry = row_rrms(y); \
                    _Pragma("unroll") for (int j = 0; j < 4; ++j) x[j] = x[j] + gt[j] * (y[j] * ry * gpo[j]); \
                    row_store(xw, lane, x); const float rx = row_rrms(x); row_normmod(x, rx, gpre, sh, sc, h); \
                    if (MK_DENSE_F8 >= 2) row_store_fp8((unsigned char*)HX + (size_t)(t) * D, lane, h, SC_XG); else row_store_bf16(HX + (size_t)(t) * D, lane, h); } while (0)
                f32x4 gpo[4], gt[4], gpre[4], sh[4], sc[4]; vec_load(INP(I_GPOSTMIX) + l * D, lane, gpo); vec_load(INP(I_GPREFFN) + l * D, lane, gpre);
                for (int t0 = min(gw * chunk, TL), t1 = min(TL, t0 + chunk); t0 < t1; ) { const int bb = t0 >> 13, te = min(t1, (bb + 1) << 13); const float* md = modl + (size_t)bb * 6144;
                    vec_load(md + 2048, lane, gt); vec_load(md + 3072, lane, sh); vec_load(md + 4096, lane, sc);
                    for (int t = t0; t < te; ++t) P6_ROW(t);
                    t0 = te; }
                if (rows_out > TL) { const float* md = modl + (size_t)4 * 6144; vec_load(md + 2048, lane, gt); vec_load(md + 3072, lane, sh); vec_load(md + 4096, lane, sc); for (int t = TL + gw; t < rows_out; t += NGW) P6_ROW(t); }
#undef P6_ROW
            } else {
                LAS int* sel = (LAS int*)(F.lds + RING_OFF);
                LAS int* rnk = sel + 256;
                LAS f32x4* wrT = (LAS f32x4*)(F.lds + RING_OFF + 4096);
                const float* wr = INP(I_WROUTER) + (size_t)(l >> 1) * D * NE; const float* br = INP(I_BROUTER) + (l >> 1) * NE;
                for (int u = tid_; u < D * NE; u += NWAVES * 64) ((LAS float*)wrT)[(u & 7) * D + (u >> 3)] = wr[u];
                LDS_WAIT(); __syncthreads();
                f32x4 gpo[4], gt[4], gpre[4], sh[4], sc[4]; vec_load(INP(I_GPOSTMIX) + l * D, lane, gpo); vec_load(INP(I_GPREFFN) + l * D, lane, gpre);
                for (int slab = F.vcu; slab < TL / 128; slab += F.G) {
                    { const float* md = modl + (size_t)((slab * 128) >> 13) * 6144; vec_load(md + 2048, lane, gt); vec_load(md + 3072, lane, sh); vec_load(md + 4096, lane, sc); }
                    for (int i = 0; i < 16; ++i) {
                        const int tl_ = wave * 16 + i, t = slab * 128 + tl_;
                        f32x4 x[4], y[4], h[4]; row_load(xsrc_lat + (size_t)t * D, lane, x); row_load_bf16(Y16 + (size_t)t * D, lane, y);
                        const float ry = row_rrms(y);
#pragma unroll
                        for (int j = 0; j < 4; ++j) x[j] = x[j] + gt[j] * (y[j] * ry * gpo[j]);
                        row_store(outp + (size_t)t * D, lane, x);
                        const float rx = row_rrms(x);
                        row_normmod(x, rx, gpre, sh, sc, h);
                        row_store_bf16(HX + (size_t)t * D, lane, h);
                        float lg[8];
#pragma unroll
                        for (int e = 0; e < 8; ++e) lg[e] = 0.f;
#pragma unroll
                        for (int e = 0; e < 8; ++e)
#pragma unroll
                            for (int j = 0; j < 4; ++j) { const f32x4 w4 = wrT[e * (D / 4) + 2 * (64 * (j >> 1) + lane) + (j & 1)]; lg[e] += (h[j].x * w4.x + h[j].y * w4.y) + (h[j].z * w4.z + h[j].w * w4.w); }
#pragma unroll
                        for (int e = 0; e < 8; ++e) lg[e] = wave_sum(lg[e]) + br[e];
                        int e1 = 0; float v1 = lg[0];
#pragma unroll
                        for (int e = 1; e < 8; ++e) if (lg[e] > v1) { v1 = lg[e]; e1 = e; }
                        int e2 = -1; float v2 = -INFINITY;
#pragma unroll
                        for (int e = 0; e < 8; ++e) if (e != e1 && lg[e] > v2) { v2 = lg[e]; e2 = e; }
                        const float ex = __expf(v2 - v1), g1 = 1.0f / (1.0f + ex), g2 = ex / (1.0f + ex);
                        if (lane == 0) { sel[2 * tl_] = e1; sel[2 * tl_ + 1] = e2; TOKG[2 * (size_t)t] = g1; TOKG[2 * (size_t)t + 1] = g2; }
                    }
                    LDS_WAIT(); __syncthreads();
                    if (tid_ < 8) { int cnt = 0; for (int q = 0; q < 256; ++q) if (sel[q] == tid_) { rnk[q] = cnt; ++cnt; } SLABCNT[slab * 8 + tid_] = cnt; }
                    LDS_WAIT(); __syncthreads();
                    if (tid_ < 256) TOKER[(size_t)slab * 256 + tid_] = sel[tid_] | (rnk[tid_] << 8);
                    LDS_WAIT(); __syncthreads();
                }
            }
            GRID_BAR();
        }
        if (IN(pb + 7) && moe) {
            PHASE_ENTER();
            LAS int* scn = (LAS int*)(F.lds + RING_OFF);
            LAS int* pst = scn + 2048;
            for (int u = tid_; u < 2048; u += NWAVES * 64) scn[u] = SLABCNT[u];
            LDS_WAIT(); __syncthreads();
            if (tid_ < 8) { int run = 0; for (int q = 0; q < 256; ++q) { const int c = scn[q * 8 + tid_]; scn[q * 8 + tid_] = run; run += c; } pst[8 + tid_] = run; }
            LDS_WAIT(); __syncthreads();
            if (tid_ == 0) { int pan = 0; for (int e = 0; e < 8; ++e) { pst[e] = pan * 256; if (blockIdx.x == 0) PCUM[e] = pan; pan += (pst[8 + e] + 255) >> 8; } if (blockIdx.x == 0) PCUM[8] = pan; }
            LDS_WAIT(); __syncthreads();
            LAS int* posl = pst + 16;
            for (int slab = F.vcu; slab < TL / 128; slab += F.G) {
                if (tid_ < 256) { const int er = TOKER[(size_t)slab * 256 + tid_]; const int e = er & 255, rk = er >> 8; const int pos = pst[e] + scn[slab * 8 + e] + rk;
                    posl[tid_] = pos; TOKPOS[(size_t)slab * 256 + tid_] = pos; }
                LDS_WAIT(); __syncthreads();
                const v4u* srcb = (const v4u*)(HX + (size_t)slab * 128 * D);
#pragma unroll 4
                for (int i = 0; i < 16; ++i) { const int id = i * 512 + tid_, tk = id >> 6, chk = id & 63;
                    const v4u a = srcb[(size_t)tk * 128 + 2 * chk], b = srcb[(size_t)tk * 128 + 2 * chk + 1]; v4u o;
#define Q8(v) pg8::clamp_fp8((v) * SC_XG)
                    o.x = pg8::pk4_fp8(Q8(bflo(a.x)), Q8(bfhi(a.x)), Q8(bflo(a.y)), Q8(bfhi(a.y))); o.y = pg8::pk4_fp8(Q8(bflo(a.z)), Q8(bfhi(a.z)), Q8(bflo(a.w)), Q8(bfhi(a.w)));
                    o.z = pg8::pk4_fp8(Q8(bflo(b.x)), Q8(bfhi(b.x)), Q8(bflo(b.y)), Q8(bfhi(b.y))); o.w = pg8::pk4_fp8(Q8(bflo(b.z)), Q8(bfhi(b.z)), Q8(bflo(b.w)), Q8(bfhi(b.w)));
#undef Q8
                    ((v4u*)(XG8 + (size_t)posl[2 * tk] * D))[chk] = o; ((v4u*)(XG8 + (size_t)posl[2 * tk + 1] * D))[chk] = o; }
                LDS_WAIT(); __syncthreads();
            }
            GRID_BAR();
        }
        if (IN(pb + 8) && !moe) {
            PHASE_ENTER();
            pg8::Gemm g{HX, W_GUD, rows_out, 2 * FFD, D}; pg8::StaticOrder S; S.init(rows_out, 2 * FFD, F.G, (int)blockIdx.x, MK_WGM);
#if MK_DENSE_F8 >= 2
            pg8::EpiSwiglu8T<true> E{(unsigned char*)HD, FFD, 1.0f / (SC_XG * SC_WGU), SC_H};
            pg8::gemm_phase<pg8::EpiSwiglu8T<true>, pg8::StaticOrder, PG8_ALIGN, PG8_SP2>(F.lds + RING_OFF, g, S, E, F.wv);
#elif MK_DENSE_F8 == 1
            pg8::EpiSwiglu8T<false> E{(unsigned char*)HD, FFD, 1.0f, SC_H};
            pg8::gemm_phase<pg8::EpiSwiglu8T<false>, pg8::StaticOrder, PG8_ALIGN, PG8_SP2>(F.lds + RING_OFF, g, S, E, F.wv);
#else
            pg8::EpiSwiglu E{HD, FFD};
            pg8::gemm_phase<pg8::EpiSwiglu, pg8::StaticOrder, PG8_ALIGN, PG8_SP2>(F.lds + RING_OFF, g, S, E, F.wv);
#endif
            GRID_BAR();
        }
        if (IN(pb + 9) && !moe) {
            PHASE_ENTER();
            pg8::Gemm g{HD, W_DND, rows_out, D, FFD}; pg8::StaticOrder S; S.init(rows_out, D, F.G, (int)blockIdx.x, MK_WGM);
#if MK_DENSE_F8 >= 1
            pg8::EpiBf16PS8 E{Y16, D, 1.0f / (SC_H * SC_WDN)};
            pg8::gemm_phase<pg8::EpiBf16PS8, pg8::StaticOrder, PG8_ALIGN, PG8_SP2>(F.lds + RING_OFF, g, S, E, F.wv);
#else
            pg8::EpiBf16P E{Y16, D};
            pg8::gemm_phase<pg8::EpiBf16P, pg8::StaticOrder, PG8_ALIGN, PG8_SP2>(F.lds + RING_OFF, g, S, E, F.wv);
#endif
            GRID_BAR();
        }
        if (moe) {
            for (int ck = 0; ck < NCHUNK; ++ck) {
                if (IN(pb + 10 + 2 * ck)) {
                    PHASE_ENTER();
                    pg8::MoeOrder S; S.nN = 2 * FFE / 256; S.G = F.G; S.c = F.vcu; S.p_lo = ck * PCH;
#pragma unroll
                    for (int k = 0; k < 8; ++k) S.pc[k] = __builtin_amdgcn_readfirstlane(PCUM[k]);
                    const int ptot = __builtin_amdgcn_readfirstlane(PCUM[8]); S.np = min(max(ptot - ck * PCH, 0), PCH);
                    pg8::Gemm g{(const bf16*)XG8, (const bf16*)W_GUM8, 0, 2 * FFE, D};
                    pg8::EpiSwiglu8 E{HM8, FFE, 1.0f / (SC_XG * SC_WGU), SC_H};
                    pg8::gemm_phase<pg8::EpiSwiglu8, pg8::MoeOrder, PG8_ALIGN, PG8_SP2>(F.lds + RING_OFF, g, S, E, F.wv);
                    GRID_BAR();
                }
                if (IN(pb + 11 + 2 * ck)) {
                    PHASE_ENTER();
                    pg8::MoeOrder S; S.nN = D / 256; S.G = F.G; S.c = F.vcu; S.p_lo = ck * PCH;
#pragma unroll
                    for (int k = 0; k < 8; ++k) S.pc[k] = __builtin_amdgcn_readfirstlane(PCUM[k]);
                    const int ptot = __builtin_amdgcn_readfirstlane(PCUM[8]); S.np = min(max(ptot - ck * PCH, 0), PCH);
                    pg8::Gemm g{(const bf16*)HM8, (const bf16*)W_DNM8, 0, D, FFE};
                    pg8::EpiBf16PS8 E{XG, D, 1.0f / (SC_H * SC_WDN)};
                    pg8::gemm_phase<pg8::EpiBf16PS8, pg8::MoeOrder, PG8_ALIGN, PG8_SP2>(F.lds + RING_OFF, g, S, E, F.wv);
                    GRID_BAR();
                }
            }
        }
        if (IN(pb + 16)) {
            PHASE_ENTER();
            const int chunk = (TL + NGW - 1) / NGW; const bool nextl = (l + 1 < DEPTH);
#define P9_ROW(t) do { float* xw = (t) < TL ? outp + (size_t)(t) * D : HCTX + (size_t)((t) - TL) * D; \
                f32x4 x[4], y[4]; row_load(xw, lane, x); \
                if (!moe) row_load_bf16(Y16 + (size_t)(t) * D, lane, y); \
                else { const int p0 = TOKPOS[2 * (size_t)(t)], p1 = TOKPOS[2 * (size_t)(t) + 1]; const float g0 = TOKG[2 * (size_t)(t)], g1 = TOKG[2 * (size_t)(t) + 1]; \
                    f32x4 ya[4], yb[4]; row_load_bf16(XG + (size_t)p0 * D, lane, ya); row_load_bf16(XG + (size_t)p1 * D, lane, yb); \
                    _Pragma("unroll") for (int j = 0; j < 4; ++j) y[j] = ya[j] * g0 + yb[j] * g1; } \
                const float ry = row_rrms(y); \
                _Pragma("unroll") for (int j = 0; j < 4; ++j) x[j] = x[j] + gt[j] * (y[j] * ry * gpo[j]); \
                row_store(xw, lane, x); \
                if (nextl) { f32x4 h[4]; const float rx = row_rrms(x); row_normmod(x, rx, gpre, sh, sc, h); if (MK_GATE_F8 < 2) row_store_bf16(HX + (size_t)(t) * D, lane, h); if (MK_GATE_F8) row_store_fp8(HX8 + (size_t)(t) * D, lane, h, SC_XG); } } while (0)
            f32x4 gpo[4], gt[4], gpre[4], sh[4], sc[4]; vec_load(INP(I_GPOSTFFN) + l * D, lane, gpo); vec_load(INP(I_GPREMIX) + (nextl ? l + 1 : l) * D, lane, gpre);
            for (int t0 = min(gw * chunk, TL), t1 = min(TL, t0 + chunk); t0 < t1; ) { const int bb = t0 >> 13, te = min(t1, (bb + 1) << 13); const float* md = modl + (size_t)bb * 6144;
                vec_load(md + 5120, lane, gt); vec_load(md + (nextl ? 5 * 6144 : 0), lane, sh); vec_load(md + (nextl ? 5 * 6144 : 0) + 1024, lane, sc);
                for (int t = t0; t < te; ++t) P9_ROW(t);
                t0 = te; }
            if (rows_out > TL) { const float* md = modl + (size_t)4 * 6144; vec_load(md + 5120, lane, gt); vec_load(md + (nextl ? 5 * 6144 : 0), lane, sh); vec_load(md + (nextl ? 5 * 6144 : 0) + 1024, lane, sc);
                for (int t = TL + gw; t < rows_out; t += NGW) P9_ROW(t); }
#undef P9_ROW
            if (l + 1 < DEPTH) GRID_BAR();
        }
    }
#undef IN
#undef GRID_BAR
}

extern "C" void kernel_launch(void* const* d_in, const int* in_sizes, int n_in, void* d_out, int out_size, void* d_ws, size_t ws_size, hipStream_t stream) {
    static int grid = 0;
    if (grid == 0) {
        if (n_in != 23 || in_sizes[0] != TL * D || out_size != TL * D || ws_size < WS_END) { fprintf(stderr, "kernel_launch: unexpected shapes: n_in %d in0 %d out %d ws %zu (need %zu); nothing launched\n", n_in, n_in > 0 ? in_sizes[0] : -1, out_size, ws_size, (size_t)WS_END); grid = -1; return; }
        int dev = 0, cus = 0, per_cu = 0;
        if (hipGetDevice(&dev) != hipSuccess || hipDeviceGetAttribute(&cus, hipDeviceAttributeMultiprocessorCount, dev) != hipSuccess) { fprintf(stderr, "kernel_launch: device query failed\n"); grid = -1; return; }
        if (hipFuncSetAttribute((const void*)mk_fwd, hipFuncAttributeMaxDynamicSharedMemorySize, LDS_BYTES) != hipSuccess) { fprintf(stderr, "kernel_launch: hipFuncSetAttribute failed\n"); grid = -1; return; }
        if (hipOccupancyMaxActiveBlocksPerMultiprocessor(&per_cu, (const void*)mk_fwd, NWAVES * 64, LDS_BYTES) != hipSuccess || per_cu < 1) fprintf(stderr, "kernel_launch: note: occupancy query reports %d\n", per_cu);
        (void)hipGetLastError();
        grid = cus;
    }
    if (grid < 0) return;
    if (hipMemsetAsync((char*)d_ws + WS_CTL, 0, CTL_ZERO_BYTES, stream) != hipSuccess) { fprintf(stderr, "kernel_launch: memset failed\n"); return; }
    Args a{};
    for (int i = 0; i < 23; ++i) a.in[i] = (const float*)d_in[i];
    a.out = (float*)d_out; a.ws = (unsigned char*)d_ws;
#if MK_PER_PHASE
    for (int ph = 0; ph < NPHASES; ++ph) { a.ph_lo = ph; a.ph_hi = ph + 1; hipLaunchKernelGGL(mk_fwd, dim3(grid), dim3(NWAVES * 64), LDS_BYTES, stream, a); }
#else
    a.ph_lo = 0; a.ph_hi = NPHASES;
    hipLaunchKernelGGL(mk_fwd, dim3(grid), dim3(NWAVES * 64), LDS_BYTES, stream, a);
#endif
    const hipError_t le = hipPeekAtLastError();
    if (le != hipSuccess) fprintf(stderr, "kernel_launch: launch failed: %s\n", hipGetErrorName(le));
}
```

```cpp
#include <hip/hip_runtime.h>
#include <cstdio>
#include <cstdint>
#ifndef MK_GATE_F8
#define MK_GATE_F8 1
#endif

namespace pg8 {
#define PG8_LAS __attribute__((address_space(3)))
typedef unsigned short bf16_t;
typedef short bf16x8 __attribute__((ext_vector_type(8)));
typedef float f32x4 __attribute__((ext_vector_type(4)));
typedef unsigned u32x4 __attribute__((ext_vector_type(4)));
typedef unsigned u32x2 __attribute__((ext_vector_type(2)));
typedef int v8i32 __attribute__((ext_vector_type(8)));
constexpr int BM = 256, BK = 64, HALF = 128, HTB = HALF * BK * 2  , STAGE_BYTES = 8 * HTB, NXCD = 8, WGM = 8;

__host__ __device__ __forceinline__ int lds_byte(int r, int c) { const int st = (r >> 4) * 2 + (c >> 5), rr = r & 15, cc = c & 31, ob = rr * 64 + cc * 2; return st * 1024 + (ob ^ (((ob >> 9) & 1) << 5)); }
__host__ __device__ __forceinline__ void stage_rc(int b, int& R, int& C) { const int st = b / 1024, sb = b % 1024, swz = sb ^ (((sb >> 9) & 1) << 5); R = (st >> 1) * 16 + swz / 64; C = (st & 1) * 32 + (swz % 64) / 2; }
__host__ __device__ __forceinline__ int perm32(int rho) { const int n = rho >> 4, i = rho & 15; return 8 * (i >> 2) + 4 * n + (i & 3); }

struct Unit { int pm, pn, pb; };
struct Gemm { const bf16_t* A; const bf16_t* Bt; int M, N, K; };

struct StaticOrder {
    int nM, nN, nwg, G, c, wgm;
    __host__ __device__ void init(int M, int N, int G_, int c_, int wgm_ = WGM) { nM = M / BM; nN = N / BM; nwg = nM * nN; G = G_; c = c_; wgm = wgm_; }
    __host__ __device__ bool next(int i, Unit& u) const {
        const long L = (long)i * G + c; if (L >= nwg) return false;
        int wgid = (int)L; { const int q = nwg / NXCD, r = nwg % NXCD, xcd = wgid % NXCD, off = wgid / NXCD; wgid = (xcd < r ? xcd * (q + 1) : r * (q + 1) + (xcd - r) * q) + off; }
        const int nig = wgm * nN, gid = wgid / nig, fm = gid * wgm, gsz = (nM - fm) < wgm ? (nM - fm) : wgm;
        u.pm = fm + ((wgid % nig) % gsz); u.pn = (wgid % nig) / gsz; u.pb = u.pn; return true;
    }
    __device__ __forceinline__ void a_ready(const Unit&) const {}
    __device__ __forceinline__ void done(const Unit&) const {}
};

__device__ __forceinline__ unsigned cvt_pk_bf16(float lo, float hi) { unsigned r; asm volatile("v_cvt_pk_bf16_f32 %0, %1, %2" : "=v"(r) : "v"(lo), "v"(hi)); return r; }
__device__ __forceinline__ float bf_lo(unsigned w) { return __uint_as_float(w << 16); }
__device__ __forceinline__ float bf_hi(unsigned w) { return __uint_as_float(w & 0xffff0000u); }
__device__ __forceinline__ float sigmoidf_(float x) { return __builtin_amdgcn_rcpf(1.0f + __builtin_amdgcn_exp2f(x * -1.4426950408889634f)); }

template <bool OPF8> struct EpiZT {
    static constexpr bool PERM = true, AFTER_DRAIN = false, HALFN = false, F8 = OPF8, RWACC = false;
    bf16_t* ZM; bf16_t* ZG; const float* rope; int n_lat_panels; const float* bgate; int pn_off; float gs;
    __device__ __forceinline__ void operator()(const f32x4 (&acc)[2][2][4][2], const Unit& u, int wr, int wc, int fr, int fq) const {
        const int row0 = u.pm * BM + wr * 64 + fr; int colt = (u.pn + pn_off) * BM; bf16_t* base = ZM; int ldc = 3840; bool isg = false;
        if (colt >= 3840) { base = ZG; colt -= 3840; ldc = 3072; isg = true; }
        const int col0 = colt + wc * 32 + 8 * fq;
        f32x4 gb[2][2];
        if (isg) {
#pragma unroll
            for (int bj = 0; bj < 2; ++bj) { gb[bj][0] = *(const f32x4*)(bgate + col0 + bj * HALF); gb[bj][1] = *(const f32x4*)(bgate + col0 + bj * HALF + 4); } }
        const int nrope = (u.pm < n_lat_panels) ? (u.pn + pn_off < 2 ? 2 : (u.pn + pn_off == 2 ? 1 : 0)) : 0;
#pragma unroll
        for (int ai = 0; ai < 2; ++ai)
#pragma unroll
            for (int m = 0; m < 4; ++m) { const int row = row0 + ai * HALF + m * 16; bf16_t* rowp = base + (size_t)row * ldc + col0;
                f32x4 cs[4];
                if (nrope) { const int s = row & 8191, pidx = (wc & 1) ? 128 + (s & 63) : (s >> 6); const f32x4* cp = (const f32x4*)(rope + (size_t)(pidx * 16 + 8 * (fq & 1)) * 2);
                    cs[0] = cp[0]; cs[1] = cp[1]; cs[2] = cp[2]; cs[3] = cp[3]; }
#pragma unroll
                for (int bj = 0; bj < 2; ++bj) { f32x4 v0 = acc[ai][bj][m][0], v1 = acc[ai][bj][m][1];
                    if (OPF8 && !isg) { v0 *= gs; v1 *= gs; }
                    if (isg) {
#pragma unroll
                        for (int j = 0; j < 4; ++j) { v0[j] = sigmoidf_(fminf(fmaxf(v0[j] * gs + gb[bj][0][j], -30.f), 30.f)); v1[j] = sigmoidf_(fminf(fmaxf(v1[j] * gs + gb[bj][1][j], -30.f), 30.f)); } }
                    if (bj < nrope) { const float sg = (fq >> 1) ? 1.f : -1.f;
                        float v[8] = {v0[0], v0[1], v0[2], v0[3], v1[0], v1[1], v1[2], v1[3]}, o[8];
#pragma unroll
                        for (int j = 0; j < 8; ++j) { const float pv = __shfl_xor(v[j], 32); const float c_ = cs[j >> 1][(j & 1) * 2], s_ = cs[j >> 1][(j & 1) * 2 + 1]; o[j] = v[j] * c_ + sg * pv * s_; }
                        v0 = (f32x4){o[0], o[1], o[2], o[3]}; v1 = (f32x4){o[4], o[5], o[6], o[7]}; }
                    u32x4 w; w.x = cvt_pk_bf16(v0[0], v0[1]); w.y = cvt_pk_bf16(v0[2], v0[3]); w.z = cvt_pk_bf16(v1[0], v1[1]); w.w = cvt_pk_bf16(v1[2], v1[3]);
                    *(u32x4*)(rowp + bj * HALF) = w; } }
    }
};
typedef EpiZT<false> EpiZ;
struct EpiBf16P {
    static constexpr bool PERM = true, AFTER_DRAIN = false, HALFN = false, F8 = false, RWACC = false;
    bf16_t* O; int ldc;
    __device__ __forceinline__ void operator()(const f32x4 (&acc)[2][2][4][2], const Unit& u, int wr, int wc, int fr, int fq) const {
        const int row0 = u.pm * BM + wr * 64 + fr; const int col0 = u.pn * BM + wc * 32 + 8 * fq;
#pragma unroll
        for (int ai = 0; ai < 2; ++ai)
#pragma unroll
            for (int m = 0; m < 4; ++m) { bf16_t* rowp = O + (size_t)(row0 + ai * HALF + m * 16) * ldc + col0;
#pragma unroll
                for (int bj = 0; bj < 2; ++bj) { const f32x4 v0 = acc[ai][bj][m][0], v1 = acc[ai][bj][m][1];
                    u32x4 w; w.x = cvt_pk_bf16(v0[0], v0[1]); w.y = cvt_pk_bf16(v0[2], v0[3]); w.z = cvt_pk_bf16(v1[0], v1[1]); w.w = cvt_pk_bf16(v1[2], v1[3]);
                    *(u32x4*)(rowp + bj * HALF) = w; } }
    }
};
struct EpiBranchAcc {
    static constexpr bool PERM = true, AFTER_DRAIN = false, HALFN = false, F8 = false, RWACC = true;
    bf16_t* MG; const bf16_t* ZG;
    __device__ __forceinline__ bool restart(const Unit& u) const { return u.pm >= 264; }
    __device__ __forceinline__ void rw(f32x4 (&acc)[2][2][4][2], const Unit& u, int wr, int wc, int fr, int fq) const {
        const int r = u.pm / 132, pmt = u.pm - 132 * r, rn = r < 2 ? r + 1 : r;
        const int row0 = pmt * BM + wr * 64 + fr, col0 = u.pn * BM + wc * 32 + 8 * fq;
        u32x4 gp[2][2], gn[2][2];
#define PG8_GLOAD(s, buf) do { const int bj_ = (s) >> 2, ai_ = ((s) >> 1) & 1, mb_ = ((s) & 1) * 2; _Pragma("unroll") for (int q_ = 0; q_ < 2; ++q_) { \
            const size_t row_ = (size_t)(row0 + ai_ * HALF + (mb_ + q_) * 16); const int col_ = col0 + bj_ * HALF; \
            gp[buf][q_] = *(const u32x4*)(ZG + row_ * 3072 + r * 1024 + col_); gn[buf][q_] = *(const u32x4*)(ZG + row_ * 3072 + rn * 1024 + col_); } } while (0)
        PG8_GLOAD(0, 0);
#pragma unroll
        for (int s = 0; s < 8; ++s) { const int bj = s >> 2, ai = (s >> 1) & 1, mb = (s & 1) * 2, col = col0 + bj * HALF;
            if (s + 1 < 8) PG8_GLOAD(s + 1, (s + 1) & 1);
            __builtin_amdgcn_sched_barrier(0);
#pragma unroll
            for (int q = 0; q < 2; ++q) { const int m = mb + q; const size_t row = (size_t)(row0 + ai * HALF + m * 16);
                const u32x4 g0 = gp[s & 1][q], g1 = gn[s & 1][q];
                const float x[8] = {bf_lo(g0.x), bf_hi(g0.x), bf_lo(g0.y), bf_hi(g0.y), bf_lo(g0.z), bf_hi(g0.z), bf_lo(g0.w), bf_hi(g0.w)};
                if (r < 2) {
                    const float y[8] = {bf_lo(g1.x), bf_hi(g1.x), bf_lo(g1.y), bf_hi(g1.y), bf_lo(g1.z), bf_hi(g1.z), bf_lo(g1.w), bf_hi(g1.w)};
#pragma unroll
                    for (int j = 0; j < 8; ++j) acc[ai][bj][m][j >> 2][j & 3] *= x[j] * __builtin_amdgcn_rcpf(y[j]);
                } else {
                    float v[8];
#pragma unroll
                    for (int j = 0; j < 8; ++j) v[j] = acc[ai][bj][m][j >> 2][j & 3] * x[j];
                    u32x4 w; w.x = cvt_pk_bf16(v[0], v[1]); w.y = cvt_pk_bf16(v[2], v[3]); w.z = cvt_pk_bf16(v[4], v[5]); w.w = cvt_pk_bf16(v[6], v[7]);
                    *(u32x4*)(MG + row * 1024 + col) = w;
                } }
        }
#undef PG8_GLOAD
    }
};
struct BranchOrder3 {
    StaticOrder so;
    __device__ __forceinline__ bool next(int i, Unit& u) const {
        const int ti = i / 3, r = i - 3 * ti; if (!so.next(ti, u)) return false;
        u.pb = 4 * r + u.pn; u.pm += 132 * r; return true;
    }
    __device__ __forceinline__ void a_ready(const Unit&) const {}
    __device__ __forceinline__ void done(const Unit&) const {}
};
struct EpiSwiglu {
    static constexpr bool PERM = true, AFTER_DRAIN = false, HALFN = false, F8 = false, RWACC = false;
    bf16_t* H; int ldh;
    __device__ __forceinline__ void operator()(const f32x4 (&acc)[2][2][4][2], const Unit& u, int wr, int wc, int fr, int fq) const {
        const int row0 = u.pm * BM + wr * 64 + fr; const int col0 = u.pn * HALF + wc * 32 + 8 * fq;
#pragma unroll
        for (int ai = 0; ai < 2; ++ai)
#pragma unroll
            for (int m = 0; m < 4; ++m) { bf16_t* rowp = H + (size_t)(row0 + ai * HALF + m * 16) * ldh + col0;
                float h[8];
#pragma unroll
                for (int n = 0; n < 2; ++n)
#pragma unroll
                    for (int j = 0; j < 4; ++j) { const float g = acc[ai][0][m][n][j], uu = acc[ai][1][m][n][j]; h[n * 4 + j] = g * sigmoidf_(g) * uu; }
                u32x4 w; w.x = cvt_pk_bf16(h[0], h[1]); w.y = cvt_pk_bf16(h[2], h[3]); w.z = cvt_pk_bf16(h[4], h[5]); w.w = cvt_pk_bf16(h[6], h[7]);
                *(u32x4*)rowp = w; }
    }
};
__device__ __forceinline__ unsigned pk4_fp8(float a, float b, float c, float d) { int w = __builtin_amdgcn_cvt_pk_fp8_f32(a, b, 0, false); w = __builtin_amdgcn_cvt_pk_fp8_f32(c, d, w, true); return (unsigned)w; }
__device__ __forceinline__ float clamp_fp8(float v) { return fminf(fmaxf(v, -448.0f), 448.0f); }
template <bool OPF8> struct EpiSwiglu8T {
    static constexpr bool PERM = true, AFTER_DRAIN = false, HALFN = false, F8 = OPF8, RWACC = false;
    unsigned char* H; int ldh; float sin, sout;
    __device__ __forceinline__ void operator()(const f32x4 (&acc)[2][2][4][2], const Unit& u, int wr, int wc, int fr, int fq) const {
        const int row0 = u.pm * BM + wr * 64 + fr; const int col0 = u.pn * HALF + wc * 32 + 8 * (fq & 2); const int odd = fq & 1;
#pragma unroll
        for (int ai = 0; ai < 2; ++ai)
#pragma unroll
            for (int mp = 0; mp < 2; ++mp) {
                unsigned w[2][2];
#pragma unroll
                for (int k = 0; k < 2; ++k) { const int m = 2 * mp + k; float h[8];
#pragma unroll
                    for (int n = 0; n < 2; ++n)
#pragma unroll
                        for (int j = 0; j < 4; ++j) { const float g = acc[ai][0][m][n][j] * sin, uu = acc[ai][1][m][n][j] * sin; h[n * 4 + j] = clamp_fp8(g * sigmoidf_(g) * uu * sout); }
                    w[k][0] = pk4_fp8(h[0], h[1], h[2], h[3]); w[k][1] = pk4_fp8(h[4], h[5], h[6], h[7]); }
                const unsigned s0 = odd ? w[0][0] : w[1][0], s1 = odd ? w[0][1] : w[1][1];
                const unsigned r0 = (unsigned)__shfl_xor((int)s0, 16), r1 = (unsigned)__shfl_xor((int)s1, 16);
                u32x4 st; if (odd) { st.x = r0; st.y = r1; st.z = w[1][0]; st.w = w[1][1]; } else { st.x = w[0][0]; st.y = w[0][1]; st.z = r0; st.w = r1; }
                *(u32x4*)(H + (size_t)(row0 + ai * HALF + (2 * mp + odd) * 16) * ldh + col0) = st; }
    }
};
typedef EpiSwiglu8T<true> EpiSwiglu8;
struct EpiBf16PS8 {
    static constexpr bool PERM = true, AFTER_DRAIN = false, HALFN = false, F8 = true, RWACC = false;
    bf16_t* O; int ldc; float s;
    __device__ __forceinline__ void operator()(const f32x4 (&acc)[2][2][4][2], const Unit& u, int wr, int wc, int fr, int fq) const {
        const int row0 = u.pm * BM + wr * 64 + fr; const int col0 = u.pn * BM + wc * 32 + 8 * fq;
#pragma unroll
        for (int ai = 0; ai < 2; ++ai)
#pragma unroll
            for (int m = 0; m < 4; ++m) { bf16_t* rowp = O + (size_t)(row0 + ai * HALF + m * 16) * ldc + col0;
#pragma unroll
                for (int bj = 0; bj < 2; ++bj) { const f32x4 v0 = acc[ai][bj][m][0] * s, v1 = acc[ai][bj][m][1] * s;
                    u32x4 w; w.x = cvt_pk_bf16(v0[0], v0[1]); w.y = cvt_pk_bf16(v0[2], v0[3]); w.z = cvt_pk_bf16(v1[0], v1[1]); w.w = cvt_pk_bf16(v1[2], v1[3]);
                    *(u32x4*)(rowp + bj * HALF) = w; } }
    }
};
struct MoeOrder {
    int nN, G, c, p_lo, np; int pc[8];
    __device__ __forceinline__ bool next(int i, Unit& u) const {
        const long L = (long)i * G + c; if (L >= (long)np * nN) return false;
        const int wgid = (int)L, nig = WGM * nN, gid = wgid / nig, fm = gid * WGM, gsz = (np - fm) < WGM ? (np - fm) : WGM;
        u.pm = p_lo + fm + ((wgid % nig) % gsz); u.pn = (wgid % nig) / gsz;
        int e = 0;
#pragma unroll
        for (int k = 1; k < 8; ++k) e += (u.pm >= pc[k]) ? 1 : 0;
        u.pb = e * nN + u.pn; return true;
    }
    __device__ __forceinline__ void a_ready(const Unit&) const {}
    __device__ __forceinline__ void done(const Unit&) const {}
};

template <class Epi, class Sched, bool ALIGN_EPI = false, bool SP2 = false>
__device__ __forceinline__ void gemm_phase(PG8_LAS unsigned char* lds, const Gemm g, const Sched& S, const Epi& E, int wv) {
    int tid_ = (wv << 6) | (int)__builtin_amdgcn_mbcnt_hi(~0u, __builtin_amdgcn_mbcnt_lo(~0u, 0u)); asm volatile("" : "+v"(tid_));
    const int tid = tid_, wid = __builtin_amdgcn_readfirstlane(tid >> 6), lane = tid & 63, wr = wid >> 2, wc = wid & 3, fr = lane & 15, fq = lane >> 4;
    constexpr bool HN = Epi::HALFN;
    constexpr bool F8 = Epi::F8;
    constexpr int ES = F8 ? 1 : 2;
    const int K = g.K, nt = K * ES / (BK * 2);
    unsigned voffA[2], voffB[2];
#pragma unroll
    for (int i = 0; i < 2; ++i) { int R, C; stage_rc(tid * 16 + i * 8192, R, C); const int Rb = Epi::PERM ? ((R & ~31) + perm32(R & 31)) : R;
        voffA[i] = (unsigned)(R * K * ES + C * 2); voffB[i] = (unsigned)(Rb * K * ES + C * 2); }
    const size_t kstep = (size_t)(BK * 2);
    const size_t hstep = (size_t)HALF * K * ES;
    const size_t tstep = 2 * hstep;
    const unsigned ldsw = (unsigned)wid * 1024u;
    const int aoff = lds_byte(wr * 64 + fr, fq * 8), boff = lds_byte(wc * 32 + fr, fq * 8);
#define PG8_SA(b, h) (((b) * 2 + (h)) * HTB)
#define PG8_SB(b, h) ((4 + (b) * 2 + (h)) * HTB)
#define PG8_STAGE(bufoff, gbase, voff) do { _Pragma("unroll") for (int _i = 0; _i < 2; ++_i) \
        __builtin_amdgcn_global_load_lds((const unsigned*)((const char*)(gbase) + (voff)[_i]), (PG8_LAS unsigned*)(lds + (bufoff) + ldsw + _i * 8192), 16, 0, 0); } while (0)
#define PG8_LDA(dst, b, h) do { if constexpr (F8) { _Pragma("unroll") for (int m = 0; m < 4; ++m) { const u32x4 lo_ = *(const PG8_LAS u32x4*)(lds + PG8_SA(b, h) + aoff + m * 2048), hi_ = *(const PG8_LAS u32x4*)(lds + PG8_SA(b, h) + aoff + m * 2048 + 1024); \
            dst##8[m] = __builtin_bit_cast(v8i32, __builtin_shufflevector(lo_, hi_, 0, 1, 2, 3, 4, 5, 6, 7)); } } \
        else { _Pragma("unroll") for (int m = 0; m < 4; ++m) _Pragma("unroll") for (int k = 0; k < 2; ++k) dst[m][k] = *(const PG8_LAS bf16x8*)(lds + PG8_SA(b, h) + aoff + m * 2048 + k * 1024); } } while (0)
#define PG8_LDB(dst, b, h) do { if constexpr (F8) { _Pragma("unroll") for (int n = 0; n < 2; ++n) { const u32x4 lo_ = *(const PG8_LAS u32x4*)(lds + PG8_SB(b, h) + boff + n * 2048), hi_ = *(const PG8_LAS u32x4*)(lds + PG8_SB(b, h) + boff + n * 2048 + 1024); \
            dst##8[n] = __builtin_bit_cast(v8i32, __builtin_shufflevector(lo_, hi_, 0, 1, 2, 3, 4, 5, 6, 7)); } } \
        else { _Pragma("unroll") for (int n = 0; n < 2; ++n) _Pragma("unroll") for (int k = 0; k < 2; ++k) dst[n][k] = *(const PG8_LAS bf16x8*)(lds + PG8_SB(b, h) + boff + n * 2048 + k * 1024); } } while (0)
#define PG8_MMA(ai, bj, At, Bt) do { __builtin_amdgcn_s_setprio(1); _Pragma("unroll") for (int m = 0; m < 4; ++m) _Pragma("unroll") for (int n = 0; n < 2; ++n) { \
        if constexpr (F8) { asm volatile("v_mfma_f32_16x16x128_f8f6f4 %0, %1, %2, %0" : "+v"(acc[ai][bj][m][n]) : "v"(Bt##8[n]), "v"(At##8[m])); } \
        else { _Pragma("unroll") for (int k = 0; k < 2; ++k) acc[ai][bj][m][n] = __builtin_amdgcn_mfma_f32_16x16x32_bf16(Bt[n][k], At[m][k], acc[ai][bj][m][n], 0, 0, 0); } } \
        __builtin_amdgcn_s_setprio(0); } while (0)
#define PG8_LDB1(dst, b, h) do { if constexpr (!HN) { PG8_LDB(dst, b, h); } } while (0)
#define PG8_MMA1(ai, bj, At, Bt) do { if constexpr (!HN) { PG8_MMA(ai, bj, At, Bt); } } while (0)
#define PG8_WAIT_V(n) asm volatile("s_waitcnt vmcnt(" #n ")" ::: "memory")
#define PG8_WAIT_L(n) asm volatile("s_waitcnt lgkmcnt(" #n ")" ::: "memory")
#define PG8_BAR __builtin_amdgcn_s_barrier()
#define PG8_SCHED __builtin_amdgcn_sched_barrier(0)
    Unit cur, nxt; int ui = 0;
    if (!S.next(0, cur)) return;
    f32x4 acc[2][2][4][2];
#pragma unroll
    for (int a = 0; a < 2; ++a)
#pragma unroll
        for (int b = 0; b < 2; ++b)
#pragma unroll
            for (int m = 0; m < 4; ++m)
#pragma unroll
                for (int n = 0; n < 2; ++n) acc[a][b][m][n] = (f32x4){0.f, 0.f, 0.f, 0.f};
    bf16x8 At[4][2], B0[2][2], B1[2][2];
    v8i32 At8[4], B08[2], B18[2];
    const char* cA = (const char*)g.A + (size_t)cur.pm * tstep; const char* cB = (const char*)g.Bt + (size_t)cur.pb * (HN ? hstep : tstep);
    S.a_ready(cur);
    if constexpr (SP2) {
        PG8_STAGE(PG8_SB(0, 0), cB, voffB); PG8_STAGE(PG8_SB(0, 1), cB + hstep, voffB); PG8_STAGE(PG8_SA(0, 0), cA, voffA); PG8_STAGE(PG8_SA(0, 1), cA + hstep, voffA);
        if (wr == 1) PG8_BAR;
        PG8_WAIT_V(2); PG8_BAR;
        PG8_STAGE(PG8_SB(1, 0), cB + kstep, voffB); PG8_STAGE(PG8_SA(1, 0), cA + kstep, voffA); PG8_STAGE(PG8_SB(1, 1), cB + hstep + kstep, voffB);
        PG8_WAIT_V(6); PG8_BAR;
    } else {
        PG8_STAGE(PG8_SB(0, 0), cB, voffB); PG8_STAGE(PG8_SA(0, 0), cA, voffA); PG8_STAGE(PG8_SB(0, 1), cB + hstep, voffB); PG8_STAGE(PG8_SA(0, 1), cA + hstep, voffA);
        if (wr == 1) PG8_BAR;
        PG8_WAIT_V(4); PG8_BAR;
        PG8_STAGE(PG8_SB(1, 0), cB + kstep, voffB); PG8_STAGE(PG8_SA(1, 0), cA + kstep, voffA); PG8_STAGE(PG8_SB(1, 1), cB + hstep + kstep, voffB);
        PG8_WAIT_V(6); PG8_BAR;
    }
    for (;;) {
        const bool has_next = S.next(ui + 1, nxt);
        const char* nA = has_next ? (const char*)g.A + (size_t)nxt.pm * tstep : cA; const char* nB = has_next ? (const char*)g.Bt + (size_t)nxt.pb * (HN ? hstep : tstep) : cB;
        for (int t = 0; t < nt; t += 2) {
            const bool last = (t == nt - 2);
            const char* a1 = cA + (size_t)(t + 1) * kstep;
            const char* a2 = last ? nA : cA + (size_t)(t + 2) * kstep; const char* b2 = last ? nB : cB + (size_t)(t + 2) * kstep;
            const char* a3 = a2 + kstep; const char* b3 = b2 + kstep;
            if (last && has_next) S.a_ready(nxt);
            if constexpr (SP2) {
            PG8_LDB(B0, 0, 0); PG8_LDB1(B1, 0, 1); PG8_SCHED; PG8_LDA(At, 0, 0); PG8_STAGE(PG8_SA(1, 1), a1 + hstep, voffA);
            PG8_WAIT_V(8); PG8_WAIT_L(0); PG8_BAR; PG8_MMA(0, 0, At, B0); PG8_MMA1(0, 1, At, B1); PG8_BAR; PG8_SCHED;
            PG8_LDA(At, 0, 1); PG8_STAGE(PG8_SB(0, 0), b2, voffB); PG8_STAGE(PG8_SB(0, 1), b2 + hstep, voffB); PG8_STAGE(PG8_SA(0, 0), a2, voffA);
            PG8_WAIT_V(8); PG8_WAIT_L(0); PG8_BAR; PG8_MMA(1, 0, At, B0); PG8_MMA1(1, 1, At, B1); PG8_BAR; PG8_SCHED;
            PG8_LDB(B0, 1, 0); PG8_LDB1(B1, 1, 1); PG8_SCHED; PG8_LDA(At, 1, 0); PG8_STAGE(PG8_SA(0, 1), a2 + hstep, voffA);
            PG8_WAIT_V(8); PG8_WAIT_L(0); PG8_BAR; PG8_MMA(0, 0, At, B0); PG8_MMA1(0, 1, At, B1); PG8_BAR; PG8_SCHED;
            PG8_LDA(At, 1, 1); PG8_STAGE(PG8_SB(1, 0), b3, voffB); PG8_STAGE(PG8_SB(1, 1), b3 + hstep, voffB); PG8_STAGE(PG8_SA(1, 0), a3, voffA);
            PG8_WAIT_V(8); PG8_WAIT_L(0); PG8_BAR; PG8_MMA(1, 0, At, B0); PG8_MMA1(1, 1, At, B1); PG8_BAR; PG8_SCHED;
            } else {
            PG8_LDB(B0, 0, 0); PG8_SCHED; PG8_LDA(At, 0, 0); PG8_STAGE(PG8_SA(1, 1), a1 + hstep, voffA);
            PG8_WAIT_L(8); PG8_BAR; PG8_WAIT_L(0); PG8_MMA(0, 0, At, B0); PG8_BAR; PG8_SCHED;
            PG8_LDB1(B1, 0, 1); PG8_STAGE(PG8_SB(0, 0), b2, voffB);
            PG8_BAR; PG8_WAIT_L(0); PG8_MMA1(0, 1, At, B1); PG8_BAR;
            PG8_LDA(At, 0, 1); PG8_STAGE(PG8_SA(0, 0), a2, voffA);
            PG8_BAR; PG8_WAIT_L(0); PG8_MMA(1, 0, At, B0); PG8_BAR; PG8_SCHED;
            PG8_STAGE(PG8_SB(0, 1), b2 + hstep, voffB);
            PG8_WAIT_V(6); PG8_BAR; PG8_MMA1(1, 1, At, B1); PG8_BAR;
            PG8_LDB(B0, 1, 0); PG8_SCHED; PG8_LDA(At, 1, 0); PG8_STAGE(PG8_SA(0, 1), a2 + hstep, voffA);
            PG8_WAIT_L(8); PG8_BAR; PG8_WAIT_L(0); PG8_MMA(0, 0, At, B0); PG8_BAR; PG8_SCHED;
            PG8_LDB1(B1, 1, 1); PG8_STAGE(PG8_SB(1, 0), b3, voffB);
            PG8_BAR; PG8_WAIT_L(0); PG8_MMA1(0, 1, At, B1); PG8_BAR;
            PG8_LDA(At, 1, 1); PG8_STAGE(PG8_SA(1, 0), a3, voffA);
            PG8_BAR; PG8_WAIT_L(0); PG8_MMA(1, 0, At, B0); PG8_BAR; PG8_SCHED;
            PG8_STAGE(PG8_SB(1, 1), b3 + hstep, voffB);
            PG8_WAIT_V(6); PG8_BAR; PG8_MMA1(1, 1, At, B1); PG8_BAR;
            }
        }
        if constexpr (F8) asm volatile("s_nop 15\n\ts_nop 15" ::: "memory");
        if constexpr (ALIGN_EPI) { if (wr == 0) PG8_BAR; }
        if constexpr (Epi::RWACC) { E.rw(acc, cur, wr, wc, fr, fq); S.done(cur); }
        else if constexpr (!Epi::AFTER_DRAIN) { E(acc, cur, wr, wc, fr, fq); S.done(cur); }
        if (!has_next) break;
        bool zero_acc = true; if constexpr (Epi::RWACC) zero_acc = E.restart(cur);
        if (zero_acc)
#pragma unroll
        for (int a = 0; a < 2; ++a)
#pragma unroll
            for (int b = 0; b < 2; ++b)
#pragma unroll
                for (int m = 0; m < 4; ++m)
#pragma unroll
                    for (int n = 0; n < 2; ++n) acc[a][b][m][n] = (f32x4){0.f, 0.f, 0.f, 0.f};
        cur = nxt; cA = nA; cB = nB; ++ui;
        if constexpr (ALIGN_EPI) { if (wr == 1) PG8_BAR; }
    }
    PG8_WAIT_V(0);
    if constexpr (!ALIGN_EPI) { if (wr == 0) PG8_BAR; }
    PG8_BAR;
    if constexpr (Epi::AFTER_DRAIN) { E.fused(acc, cur, wr, wc, fr, fq, lds, wid, lane); S.done(cur); }
#undef PG8_SA
#undef PG8_SB
#undef PG8_STAGE
#undef PG8_LDA
#undef PG8_LDB
#undef PG8_MMA
#undef PG8_LDB1
#undef PG8_MMA1
#undef PG8_WAIT_V
#undef PG8_WAIT_L
#undef PG8_BAR
#undef PG8_SCHED
}
}

#ifndef PG8_SP2
#define PG8_SP2 true
#endif
#ifndef PG8_ALIGN
#define PG8_ALIGN true
#endif
#ifndef MK_WGM
#define MK_WGM 4
#endif
#ifndef MK_DENSE_F8
#define MK_DENSE_F8 1
#endif
#ifndef MK_PER_PHASE
#define MK_PER_PHASE 0
#endif

constexpr int NWAVES = 8;
constexpr int D = 1024, BATCH = 4, SEQ = 8192, CTXL = 256, DEPTH = 2;
constexpr int TL = BATCH * SEQ, TC = BATCH * CTXL, TA = TL + TC;
constexpr int INC = 6912, ZMC = 3840, ZGC = 3072, BW = 512;
constexpr int FFD = 2816, FFE = 3584, NE = 8;
constexpr int MAXPAN = 264, PCH = 264, NCHUNK = 1;
constexpr float RMS_EPS = 1e-6f;
constexpr float SC_XG = 4.0f, SC_WGU = 32.0f, SC_H = 4.0f, SC_WDN = 64.0f;
constexpr int C_QA = 0, C_KA = 512, C_VA = 640, C_UX = 768, C_GB = 1280, C_GC = 1792, C_QN = 2304, C_KN = 2816, C_VN = 3328;

constexpr size_t MiB = 1u << 20;
constexpr size_t WS_CTL = 0, CTL_ZERO_BYTES = 1 * MiB;
constexpr size_t WS_MOD = 1 * MiB;
constexpr size_t WS_ROPE = WS_MOD + 256 * 1024;
constexpr size_t WS_SLABCNT = WS_MOD + 320 * 1024;
constexpr size_t WS_PCUM = WS_MOD + 384 * 1024;
constexpr size_t WS_TOKER = WS_MOD + 512 * 1024;
constexpr size_t WS_TOKG = WS_MOD + 768 * 1024;
constexpr size_t WS_TOKPOS = WS_MOD + 1024 * 1024;
constexpr size_t WS_HCTX = 4 * MiB;
constexpr size_t WS_WIN = 8 * MiB;
constexpr size_t WS_WBR = 35 * MiB;
constexpr size_t WS_WOUT = 41 * MiB;
constexpr size_t WS_WGUD = 45 * MiB;
constexpr size_t WS_WDND = 56 * MiB;
constexpr size_t WS_WGUM = 62 * MiB;
constexpr size_t WS_WDNM = 118 * MiB;
constexpr size_t WS_RS = 146 * MiB;
constexpr size_t WS_HX = 230 * MiB;
constexpr size_t WS_ZM = 296 * MiB;
constexpr size_t WS_ZG = 544 * MiB;
constexpr size_t WS_O = 742 * MiB;
constexpr size_t WS_XG = WS_ZM;
constexpr size_t WS_HM = WS_ZM + 132 * MiB;
constexpr size_t WS_XG8 = WS_O;
constexpr size_t WS_HX8 = 841 * MiB;
constexpr size_t WS_WING8 = 874 * MiB;
constexpr size_t WS_END = 880 * MiB;
static_assert(WS_WIN + (size_t)2 * INC * D * 2 <= WS_WBR && WS_WGUD + (size_t)2 * FFD * D * 2 <= WS_WDND && WS_WDND + (size_t)D * FFD * 2 <= WS_WGUM, "ws map (weights)");
static_assert(WS_WGUM + (size_t)NE * 2 * FFE * D <= WS_WDNM && WS_WDNM + (size_t)NE * D * FFE <= WS_RS && WS_RS + (size_t)TA * D * 2 <= WS_HX, "ws map (moe weights, residual stream)");
static_assert(WS_HX + (size_t)TA * D * 2 <= WS_ZM && WS_ZM + (size_t)TA * ZMC * 2 <= WS_ZG && WS_ZG + (size_t)TA * ZGC * 2 <= WS_O && WS_O + (size_t)3 * TA * BW * 2 <= WS_END, "ws map (activations)");
static_assert(WS_HM + (size_t)MAXPAN * 256 * FFE <= WS_O && WS_XG8 + (size_t)MAXPAN * 256 * D <= WS_END && (size_t)MAXPAN * 256 * D * 2 <= 132 * MiB && (size_t)TA * D * 4 <= 132 * MiB, "ws map (moe)");
constexpr int CW_BAR = 4096;

constexpr int RING_OFF = 0, RING_BYTES = 131072;
constexpr int LDSCTL_OFF = RING_BYTES, MISC_OFF = LDSCTL_OFF + 320;
constexpr int LDS_BYTES = 147456;

#define GAS __attribute__((address_space(1)))
#define LAS __attribute__((address_space(3)))
typedef unsigned short bf16;
typedef unsigned v4u __attribute__((ext_vector_type(4)));
typedef unsigned v2u __attribute__((ext_vector_type(2)));
typedef float f32x4 __attribute__((ext_vector_type(4)));
typedef float f32x2 __attribute__((ext_vector_type(2)));
#define LDS_WAIT() asm volatile("s_waitcnt lgkmcnt(0)" ::: "memory")
#define VM_WAIT() asm volatile("s_waitcnt vmcnt(0)" ::: "memory")
__device__ __forceinline__ unsigned f2bf(float f) { unsigned u = __builtin_bit_cast(unsigned, f); return (u + 0x7fffu + ((u >> 16) & 1u)) >> 16; }
__device__ __forceinline__ unsigned pk2(float lo, float hi) { return f2bf(lo) | (f2bf(hi) << 16); }
__device__ __forceinline__ float bflo(unsigned w) { return __uint_as_float(w << 16); }
__device__ __forceinline__ float bfhi(unsigned w) { return __uint_as_float(w & 0xffff0000u); }
__device__ __forceinline__ float bf2f(bf16 b) { return __uint_as_float(((unsigned)b) << 16); }

#define XB_TMO      128
#define XB_XCNT(j)  (256  + 64 * (j))
#define XB_XSUB(j)  (1280 + 64 * (j))
#define XB_XGEN(j)  (2304 + 64 * (j))
#define XB_TOP      3328
#define XB_TOPGEN   3392
#define XCD_BAR_WORDS 3456
#define XB_SPIN_CAP (1u << 21)

__device__ __forceinline__ unsigned xb_ld(unsigned* p)              { return __hip_atomic_load(p, __ATOMIC_RELAXED, __HIP_MEMORY_SCOPE_AGENT); }
__device__ __forceinline__ unsigned xb_add(unsigned* p, unsigned v) { return __hip_atomic_fetch_add(p, v, __ATOMIC_RELAXED, __HIP_MEMORY_SCOPE_AGENT); }
__device__ __forceinline__ unsigned xb_xcc_id() { return (unsigned)__builtin_amdgcn_s_getreg((3 << 11) | 20) & 0xFu; }
#define XB_SPIN(cond, bar) do { unsigned _sp = 0; while (cond) { __builtin_amdgcn_s_sleep(1); \
    if ((++_sp & 255u) == 0u) { if (xb_ld(&(bar)[XB_TMO])) break; if (_sp > XB_SPIN_CAP) { atomicAdd(&(bar)[XB_TMO], 1u); break; } } } } while (0)

struct XcdBarrier {
    unsigned* bar; unsigned x;
    volatile LAS unsigned* st;
    int w;
};

__device__ __forceinline__ XcdBarrier xcd_barrier_post(unsigned* bar, volatile LAS unsigned* st) {
    XcdBarrier b; b.bar = bar; b.x = xb_xcc_id(); b.st = st; b.w = 0;
    if (threadIdx.x == 0) (void)xb_add(&bar[XB_XCNT(b.x)], 1u);
    return b;
}
__device__ __forceinline__ void xcd_barrier_complete(unsigned* bar, unsigned x, unsigned& nloc, unsigned& nx) {
    const unsigned G = gridDim.x * gridDim.y * gridDim.z;
    unsigned sum, cnt, mine, sp = 0u;
    for (;;) {
        sum = 0u; cnt = 0u; mine = 0u;
#pragma unroll
        for (unsigned j = 0; j < 16; ++j) { const unsigned c = xb_ld(&bar[XB_XCNT(j)]); sum += c; cnt += (c > 0u) ? 1u : 0u; mine = (j == x) ? c : mine; }
        if (sum == G) break;
        __builtin_amdgcn_s_sleep(1);
        if ((++sp & 255u) == 0u) { if (xb_ld(&bar[XB_TMO])) break; if (sp > XB_SPIN_CAP) { atomicAdd(&bar[XB_TMO], 1u); break; } }
    }
    nloc = mine > 0u ? mine : 1u; nx = cnt > 0u ? cnt : 1u;
}

__device__ __forceinline__ void xcd_barrier(const XcdBarrier& b) {
    asm volatile("s_waitcnt vmcnt(0)" ::: "memory");
    __syncthreads();
    if (b.w == 0 && __builtin_amdgcn_mbcnt_hi(~0u, __builtin_amdgcn_mbcnt_lo(~0u, 0u)) == 0u) {
        unsigned* bar = b.bar; { GAS unsigned* bg_ = (GAS unsigned*)bar; asm volatile("" : "+s"(bg_)); bar = (unsigned*)bg_; }
        __builtin_amdgcn_s_waitcnt(0);
        unsigned nloc = b.st[0], nx = b.st[1];
        if (nloc == 0u) { xcd_barrier_complete(bar, b.x, nloc, nx); b.st[0] = nloc; b.st[1] = nx; }
        const unsigned old = xb_add(&bar[XB_XSUB(b.x)], 1u);
        const unsigned gen = old / nloc;
        if (old + 1u == (gen + 1u) * nloc) {
            __builtin_amdgcn_fence(__ATOMIC_RELEASE, "agent");
            asm volatile("s_waitcnt vmcnt(0)" ::: "memory");
            const unsigned og = xb_add(&bar[XB_TOP], 1u);
            const unsigned tg = og / nx;
            if (og + 1u == (tg + 1u) * nx) xb_add(&bar[XB_TOPGEN], 1u);
            else XB_SPIN(xb_ld(&bar[XB_TOPGEN]) == tg, bar);
            __builtin_amdgcn_fence(__ATOMIC_ACQUIRE, "agent");
            xb_add(&bar[XB_XGEN(b.x)], 1u);
            asm volatile("s_waitcnt vmcnt(0)" ::: "memory");
        } else {
            XB_SPIN(xb_ld(&bar[XB_XGEN(b.x)]) == gen, bar);
            __builtin_amdgcn_fence(__ATOMIC_ACQUIRE, "agent");
            asm volatile("s_waitcnt vmcnt(0)" ::: "memory");
        }
    }
    __syncthreads();
}

struct Frame {
    LAS unsigned char* lds;
    volatile LAS unsigned* MISC;
    unsigned* ctl;
    int vcu, G;
    int wv;
};
enum { I_X = 0, I_C, I_CTX, I_CCTX, I_WADA, I_BADA, I_GPREMIX, I_GPOSTMIX, I_GPREFFN, I_GPOSTFFN, I_WIN, I_BGATE, I_SINK, I_CONVW, I_RPB, I_WBRANCH, I_WOUT, I_WGUD, I_WDND, I_WROUTER, I_BROUTER, I_WGUM, I_WDNM };

__device__ __forceinline__ float wave_sum(float v) {
#pragma unroll
    for (int o = 1; o < 64; o <<= 1) v += __shfl_xor(v, o);
    return v;
}
__device__ __forceinline__ float wave_max(float v) {
#pragma unroll
    for (int o = 1; o < 64; o <<= 1) v = fmaxf(v, __shfl_xor(v, o));
    return v;
}

__device__ __forceinline__ void row_store_fp8(unsigned char* p, int lane, const f32x4 (&h)[4], float sc) {
#pragma unroll
    for (int c = 0; c < 2; ++c) { const f32x4 a = __builtin_elementwise_min(__builtin_elementwise_max(h[2 * c] * sc, (f32x4){-448.f, -448.f, -448.f, -448.f}), (f32x4){448.f, 448.f, 448.f, 448.f}), b = __builtin_elementwise_min(__builtin_elementwise_max(h[2 * c + 1] * sc, (f32x4){-448.f, -448.f, -448.f, -448.f}), (f32x4){448.f, 448.f, 448.f, 448.f});
        v2u w; w.x = pg8::pk4_fp8(a.x, a.y, a.z, a.w); w.y = pg8::pk4_fp8(b.x, b.y, b.z, b.w);
        *(v2u*)(p + 8 * (64 * c + lane)) = w; }
}

__device__ __forceinline__ void tr_item(const float* W, int N, int k0, int n0, bf16* WT, int Kd, int drow0, LAS float* scr, int lane) {
#pragma unroll
    for (int i = 0; i < 8; ++i) { const int kk = 8 * i + (lane >> 3), c4 = 4 * (lane & 7); const f32x4 v = *(const f32x4*)(W + (size_t)(k0 + kk) * N + n0 + c4);
        LAS float* d = scr + kk * 33 + c4; d[0] = v.x; d[1] = v.y; d[2] = v.z; d[3] = v.w; }
    LDS_WAIT(); asm volatile("" ::: "memory");
    const int c = lane & 7;
#pragma unroll
    for (int j = 0; j < 4; ++j) { const int n = (lane >> 3) + 8 * j; const LAS float* s = scr + (8 * c) * 33 + n;
        v4u o; o.x = pk2(s[0 * 33], s[1 * 33]); o.y = pk2(s[2 * 33], s[3 * 33]); o.z = pk2(s[4 * 33], s[5 * 33]); o.w = pk2(s[6 * 33], s[7 * 33]);
        *(v4u*)(WT + (size_t)(drow0 + n) * Kd + k0 + 8 * c) = o; }
    LDS_WAIT(); asm volatile("" ::: "memory");
}
__device__ __forceinline__ void tr_matrix_item(const float* W, int K, int N, int ff, bf16* WT, int item, LAS float* scr, int lane) {
    const int nblk = N / 32, kb = item / nblk, nb = item % nblk, n0 = 32 * nb;
    int drow0 = n0;
    if (ff > 0) { const int isu = n0 >= ff ? 1 : 0, nn = n0 - isu * ff; drow0 = 256 * (nn >> 7) + 128 * isu + (nn & 127); }
    tr_item(W, N, 64 * kb, n0, WT, K, drow0, scr, lane);
}

__device__ __forceinline__ void tr_item8(const float* W, int N, int k0, int n0, unsigned char* WT, int Kd, int drow0, float scale, LAS float* scr, int lane) {
#pragma unroll
    for (int i = 0; i < 8; ++i) { const int kk = 8 * i + (lane >> 3), c4 = 4 * (lane & 7); const f32x4 v = *(const f32x4*)(W + (size_t)(k0 + kk) * N + n0 + c4);
        LAS float* d = scr + kk * 33 + c4; d[0] = v.x; d[1] = v.y; d[2] = v.z; d[3] = v.w; }
    LDS_WAIT(); asm volatile("" ::: "memory");
    const int n = lane >> 1, kh = lane & 1; const LAS float* s = scr + (32 * kh) * 33 + n;
    unsigned w[8];
#pragma unroll
    for (int j = 0; j < 8; ++j) w[j] = pg8::pk4_fp8(s[(4 * j) * 33] * scale, s[(4 * j + 1) * 33] * scale, s[(4 * j + 2) * 33] * scale, s[(4 * j + 3) * 33] * scale);
    v4u* dst = (v4u*)(WT + (size_t)(drow0 + n) * Kd + k0 + 32 * kh);
    dst[0] = (v4u){w[0], w[1], w[2], w[3]}; dst[1] = (v4u){w[4], w[5], w[6], w[7]};
    LDS_WAIT(); asm volatile("" ::: "memory");
}
__device__ __forceinline__ void tr_matrix_item8(const float* W, int K, int N, int ff, unsigned char* WT, float scale, int item, LAS float* scr, int lane) {
    const int nblk = N / 32, kb = item / nblk, nb = item % nblk, n0 = 32 * nb;
    int drow0 = n0;
    if (ff > 0) { const int isu = n0 >= ff ? 1 : 0, nn = n0 - isu * ff; drow0 = 256 * (nn >> 7) + 128 * isu + (nn & 127); }
    tr_item8(W, N, 64 * kb, n0, WT, K, drow0, scale, scr, lane);
}

__device__ __forceinline__ void row_load(const float* p, int lane, f32x4 (&v)[4]) {
#pragma unroll
    for (int c = 0; c < 2; ++c) { const f32x4* r = (const f32x4*)(p + 8 * (64 * c + lane)); v[2 * c] = r[0]; v[2 * c + 1] = r[1]; }
}
__device__ __forceinline__ void row_load_bf16(const bf16* p, int lane, f32x4 (&v)[4]) {
#pragma unroll
    for (int c = 0; c < 2; ++c) { const v4u w = *(const v4u*)(p + 8 * (64 * c + lane));
        v[2 * c] = (f32x4){bflo(w.x), bfhi(w.x), bflo(w.y), bfhi(w.y)}; v[2 * c + 1] = (f32x4){bflo(w.z), bfhi(w.z), bflo(w.w), bfhi(w.w)}; }
}
__device__ __forceinline__ void row_store(float* p, int lane, const f32x4 (&v)[4]) {
#pragma unroll
    for (int c = 0; c < 2; ++c) { f32x4* r = (f32x4*)(p + 8 * (64 * c + lane)); r[0] = v[2 * c]; r[1] = v[2 * c + 1]; }
}
__device__ __forceinline__ float row_rrms(const f32x4 (&v)[4]) {
    float s = 0.f;
#pragma unroll
    for (int j = 0; j < 4; ++j) s += (v[j].x * v[j].x + v[j].y * v[j].y) + (v[j].z * v[j].z + v[j].w * v[j].w);
    return 1.0f / sqrtf(wave_sum(s) * (1.0f / D) + RMS_EPS);
}
__device__ __forceinline__ void vec_load(const float* p, int lane, f32x4 (&v)[4]) { row_load(p, lane, v); }
__device__ __forceinline__ void row_normmod(const f32x4 (&x)[4], float rr, const f32x4 (&g)[4], const f32x4 (&shift)[4], const f32x4 (&scale)[4], f32x4 (&h)[4]) {
#pragma unroll
    for (int j = 0; j < 4; ++j) h[j] = (x[j] * rr * g[j]) * (scale[j] + 1.0f) + shift[j];
}
__device__ __forceinline__ void row_store_bf16(bf16* p, int lane, const f32x4 (&h)[4]) {
#pragma unroll
    for (int c = 0; c < 2; ++c) { v4u w; w.x = pk2(h[2 * c].x, h[2 * c].y); w.y = pk2(h[2 * c].z, h[2 * c].w); w.z = pk2(h[2 * c + 1].x, h[2 * c + 1].y); w.w = pk2(h[2 * c + 1].z, h[2 * c + 1].w);
        *(v4u*)(p + 8 * (64 * c + lane)) = w; }
}

namespace at {
typedef short bf16x8 __attribute__((ext_vector_type(8)));
typedef short s16x4 __attribute__((ext_vector_type(4)));
typedef short v4i16_t __attribute__((ext_vector_type(4)));
typedef float f32x16 __attribute__((ext_vector_type(16)));
constexpr int NS = 4, PF = 3, SLOT = 16384;
constexpr int LDS_TAB = NS * SLOT + 1024;
constexpr int LDS_TT = LDS_TAB + 8 * 2048 + 1024;
constexpr int MAXT = 160;
constexpr float LOG2E = 1.4426950408889634f, C2 = 0.125f * LOG2E;
__device__ __forceinline__ unsigned cvtpk(float lo, float hi) { unsigned r; asm volatile("v_cvt_pk_bf16_f32 %0, %1, %2" : "=v"(r) : "v"(lo), "v"(hi)); return r; }
__device__ __forceinline__ float hmax(float v) { auto rr = __builtin_amdgcn_permlane32_swap(__float_as_uint(v), __float_as_uint(v), false, false); return fmaxf(__uint_as_float(rr[0]), __uint_as_float(rr[1])); }
__device__ __forceinline__ float hsum(float v) { auto rr = __builtin_amdgcn_permlane32_swap(__float_as_uint(v), __float_as_uint(v), false, false); return __uint_as_float(rr[0]) + __uint_as_float(rr[1]); }

__device__ __forceinline__ void glds16(const void* gsrc, unsigned lds_dst) { unsigned keep;
    asm volatile("s_mov_b32 %0, m0\n\ts_mov_b32 m0, %2\n\ts_nop 0\n\tglobal_load_lds_dwordx4 %1, off\n\ts_mov_b32 m0, %0" : "=&s"(keep) : "v"(gsrc), "s"(lds_dst) : "memory"); }
__device__ __forceinline__ void tile_issue(LAS unsigned char* slot, const bf16* ZMp, size_t row0, int kcol, int vcol, int wid, int lane) {
    const bf16* ksrc = ZMp + (row0 + lane) * ZMC + kcol + wid * 8;
    const bf16* vsrc = ZMp + (row0 + 16 * (wid & 3) + (lane >> 2)) * ZMC + vcol + (wid >> 2) * 32 + (lane & 3) * 8;
    const unsigned dst = (unsigned)__builtin_amdgcn_readfirstlane((int)(unsigned)(uintptr_t)slot + wid * 1024);
    glds16(ksrc, dst); glds16(vsrc, dst + 8192u);
}
__device__ __forceinline__ void qk_tile(f32x16& p0, f32x16& p1, const LAS unsigned char* Ks, const bf16x8 (&qr)[4], int r32, int hi) {
    const LAS unsigned char* kb = Ks + hi * 1024 + r32 * 16;
    bf16x8 kf[8];
#pragma unroll
    for (int d0 = 0; d0 < 4; ++d0) { kf[2 * d0] = *(const LAS bf16x8*)(kb + d0 * 2048); kf[2 * d0 + 1] = *(const LAS bf16x8*)(kb + d0 * 2048 + 512); }
    __builtin_amdgcn_sched_barrier(0);
#pragma unroll
    for (int r = 0; r < 16; ++r) { p0[r] = 0.f; p1[r] = 0.f; }
#pragma unroll
    for (int d0 = 0; d0 < 4; ++d0) {
        p0 = __builtin_amdgcn_mfma_f32_32x32x16_bf16(kf[2 * d0], qr[d0], p0, 0, 0, 0);
        p1 = __builtin_amdgcn_mfma_f32_32x32x16_bf16(kf[2 * d0 + 1], qr[d0], p1, 0, 0, 0);
    }
}
__device__ __forceinline__ s16x4 vtr(const LAS unsigned char* p) { return __builtin_bit_cast(s16x4, __builtin_amdgcn_ds_read_tr16_b64_v4i16((LAS v4i16_t*)p)); }
template <int LV> __device__ __forceinline__ constexpr bool live0(int r) { return LV == 2 ? r >= 12 : true; }
template <int LV> __device__ __forceinline__ constexpr bool live1(int r) { return LV == 1 ? r < 4 : true; }
template <bool RAW, int LV, int VAR = 0>
__device__ __forceinline__ void sm_pv(f32x16& x0, f32x16& x1, float& m, float& l, f32x16 (&o)[2], const LAS unsigned char* Vs, int lane, int hi) {
    if (VAR == 2) { l += x0[0] + x1[15];
        bf16x8 pw_[4]; unsigned w_[16];
#pragma unroll
        for (int i = 0; i < 8; ++i) { w_[i] = cvtpk(x0[2 * i], x0[2 * i + 1]); w_[8 + i] = cvtpk(x1[2 * i], x1[2 * i + 1]); }
#pragma unroll
        for (int k = 0; k < 4; ++k) { typedef unsigned u32x4_ __attribute__((ext_vector_type(4))); u32x4_ t; t.x = w_[4 * k]; t.y = w_[4 * k + 1]; t.z = w_[4 * k + 2]; t.w = w_[4 * k + 3]; pw_[k] = __builtin_bit_cast(bf16x8, t); }
        const LAS unsigned char* vb_ = Vs + ((lane >> 4) & 1) * 32 + (lane & 3) * 8 + (4 * hi + ((lane & 15) >> 2)) * 64;
#pragma unroll
        for (int d0 = 0; d0 < 2; ++d0)
#pragma unroll
            for (int ks = 0; ks < 4; ++ks) { if ((LV == 1 && ks == 3) || (LV == 2 && ks == 0)) continue;
                const s16x4 lo = vtr(vb_ + d0 * 4096 + ks * 1024), hh = vtr(vb_ + d0 * 4096 + ks * 1024 + 512);
                const bf16x8 vf = (bf16x8){lo[0], lo[1], lo[2], lo[3], hh[0], hh[1], hh[2], hh[3]};
                o[d0] = __builtin_amdgcn_mfma_f32_32x32x16_bf16(vf, pw_[ks], o[d0], 0, 0, 0); }
        return; }
    if (VAR == 3) { l += x0[0] + x1[15] + x0[7] + x1[3]; o[0][0] += x0[1]; o[1][0] += x1[1]; return; }
    float rm = -INFINITY;
#pragma unroll
    for (int r = 0; r < 16; ++r) { if (live0<LV>(r)) rm = fmaxf(rm, x0[r]); if (live1<LV>(r)) rm = fmaxf(rm, x1[r]); }
    rm = hmax(rm);
    const float mn = fmaxf(m, RAW ? rm * C2 : rm);
    { const float sc = __builtin_amdgcn_exp2f(m - mn); l *= sc;
#pragma unroll
      for (int r = 0; r < 16; ++r) { o[0][r] *= sc; o[1][r] *= sc; } }
    m = mn;
    float sum = 0.f;
#pragma unroll
    for (int r = 0; r < 16; ++r) {
        if (live0<LV>(r)) { x0[r] = __builtin_amdgcn_exp2f(RAW ? __builtin_fmaf(x0[r], C2, -mn) : x0[r] - mn); sum += x0[r]; } else x0[r] = 0.f;
        if (live1<LV>(r)) { x1[r] = __builtin_amdgcn_exp2f(RAW ? __builtin_fmaf(x1[r], C2, -mn) : x1[r] - mn); sum += x1[r]; } else x1[r] = 0.f;
    }
    l += sum;
    bf16x8 pw[4];
    { unsigned w[16];
#pragma unroll
      for (int i = 0; i < 8; ++i) { w[i] = cvtpk(x0[2 * i], x0[2 * i + 1]); w[8 + i] = cvtpk(x1[2 * i], x1[2 * i + 1]); }
#pragma unroll
      for (int k = 0; k < 4; ++k) { typedef unsigned u32x4_ __attribute__((ext_vector_type(4))); u32x4_ t; t.x = w[4 * k]; t.y = w[4 * k + 1]; t.z = w[4 * k + 2]; t.w = w[4 * k + 3]; pw[k] = __builtin_bit_cast(bf16x8, t); } }
    const LAS unsigned char* vb = Vs + ((lane >> 4) & 1) * 32 + (lane & 3) * 8 + (4 * hi + ((lane & 15) >> 2)) * 64;
    s16x4 vlo[8], vhh[8];
    __builtin_amdgcn_sched_barrier(0);
#pragma unroll
    for (int d0 = 0; d0 < 2; ++d0)
#pragma unroll
        for (int ks = 0; ks < 4; ++ks) { if ((LV == 1 && ks == 3) || (LV == 2 && ks == 0)) continue;
            vlo[d0 * 4 + ks] = vtr(vb + d0 * 4096 + ks * 1024); vhh[d0 * 4 + ks] = vtr(vb + d0 * 4096 + ks * 1024 + 512); }
    __builtin_amdgcn_sched_barrier(0);
#pragma unroll
    for (int d0 = 0; d0 < 2; ++d0)
#pragma unroll
        for (int ks = 0; ks < 4; ++ks) {
            if ((LV == 1 && ks == 3) || (LV == 2 && ks == 0)) continue;
            const s16x4 lo = vlo[d0 * 4 + ks], hh = vhh[d0 * 4 + ks];
            const bf16x8 vf = (bf16x8){lo[0], lo[1], lo[2], lo[3], hh[0], hh[1], hh[2], hh[3]};
            o[d0] = __builtin_amdgcn_mfma_f32_32x32x16_bf16(vf, pw[ks], o[d0], 0, 0, 0);
        }
}
__device__ __forceinline__ void o_store(const f32x16 (&o)[2], float l, bf16* orow, int hi) {
    const float inv = __builtin_amdgcn_rcpf(hsum(l));
#pragma unroll
    for (int d0 = 0; d0 < 2; ++d0)
#pragma unroll
        for (int gp = 0; gp < 2; ++gp) {
            unsigned w[2][2];
#pragma unroll
            for (int k = 0; k < 2; ++k) { const int g = 2 * gp + k; w[k][0] = cvtpk(o[d0][4 * g] * inv, o[d0][4 * g + 1] * inv); w[k][1] = cvtpk(o[d0][4 * g + 2] * inv, o[d0][4 * g + 3] * inv); }
            unsigned rcv[2];
#pragma unroll
            for (int i = 0; i < 2; ++i) { const unsigned snd = hi ? w[0][i] : w[1][i];
                auto rr = __builtin_amdgcn_permlane32_swap(snd, snd, false, false); rcv[i] = hi ? rr[0] : rr[1]; }
            v4u st; if (hi) { st.x = rcv[0]; st.y = rcv[1]; st.z = w[1][0]; st.w = w[1][1]; } else { st.x = w[0][0]; st.y = w[0][1]; st.z = rcv[0]; st.w = rcv[1]; }
            *(v4u*)(orow + 32 * d0 + 16 * gp + 8 * hi) = st;
        }
}
#define AT_WAIT_BAR(N) asm volatile("s_waitcnt vmcnt(" #N ")\n\ts_barrier" ::: "memory")

struct UDesc { int kind, b, hh, blk, cq, nw, lo; };
__device__ __forceinline__ UDesc unit_desc(int i, int vcu, int UPW, bool ctx_out) {
    UDesc d; d.kind = -1; d.b = 0; d.hh = 0; d.blk = 0; d.cq = 0; d.nw = 0; d.lo = 0;
    if (i < 2 * UPW) { const int u = vcu * UPW + (i < UPW ? i : i - UPW); if (u >= 1024) return d; d.kind = i < UPW ? 0 : 1; d.b = u >> 8;
        if (d.kind == 0) { d.hh = (u >> 5) & 7; d.blk = u & 31; } else { d.hh = (u >> 7) & 1; d.blk = u & 127; } }
    else if (i == 2 * UPW) { if (!ctx_out || vcu >= 64) return d; d.cq = 1;
        if (vcu < 32) { d.kind = 1; d.b = vcu >> 3; d.hh = (vcu >> 2) & 1; d.blk = vcu & 3; } else { d.kind = 0; d.b = (vcu - 32) >> 3; d.hh = (vcu - 32) & 7; d.blk = 0; } }
    else return d;
    if (!d.cq) {
        if (d.kind == 1) { d.lo = max(0, 2 - d.blk); d.nw = min(4, 129 - d.blk) - d.lo + 1; }
        else { d.lo = min(max(4 * d.blk - 4, 0), 120); d.nw = min(max(4 * d.blk - 1, 0), 120) + 7 - d.lo + 1; }
    }
    return d;
}
__device__ __forceinline__ void tile_src(const UDesc& d, int t, int& row0, int& cols) {
    const int kcol = d.kind == 1 ? C_KA + d.hh * 64 : C_KN + d.hh * 64, vcol = d.kind == 1 ? C_VA + d.hh * 64 : C_VN + d.hh * 64;
    cols = kcol | (vcol << 16);
    if (t < d.nw) row0 = d.kind == 1 ? d.b * SEQ + 64 * d.blk - 128 + 64 * (d.lo + t) : d.b * SEQ + 64 * (d.lo + t);
    else row0 = TL + d.b * CTXL + 64 * (t - d.nw);
}
__device__ __forceinline__ size_t q_row(const UDesc& d, int wid, int r32) {
    if (d.kind == 1) { const int qrel = 32 * (wid >> 2) + r32; return d.cq ? (size_t)TL + (size_t)d.b * CTXL + 64 * d.blk + qrel : (size_t)d.b * SEQ + 64 * d.blk + qrel; }
    const int pair = wid >> 1, c = 32 * (wid & 1) + r32;
    return d.cq ? (size_t)TL + (size_t)d.b * CTXL + 64 * pair + c : (size_t)d.b * SEQ + (size_t)(4 * d.blk + pair) * 64 + c;
}
__device__ __forceinline__ void q_load(const UDesc& d, const bf16* ZMp, int wid, int r32, int hi, bf16x8 (&qr)[4]) {
    const int qcol = d.kind == 1 ? C_QA + (d.hh * 4 + (wid & 3)) * 64 : C_QN + d.hh * 64;
    const bf16* p = ZMp + q_row(d, wid, r32) * ZMC + qcol + 8 * hi;
#pragma unroll
    for (int d0 = 0; d0 < 4; ++d0) qr[d0] = *(const bf16x8*)(p + 16 * d0);
}

template <int VAR = 0>
__device__ __forceinline__ void attn_phase(LAS unsigned char* lds, const bf16* ZMp, bf16* OAp, bf16* OCp, const float* sinkp, const float* rpbl, int vcu, int G, bool ctx_out, int tid, int wid, int lane) {
    const int r32 = lane & 31, hi = lane >> 5;
    const int UPW = (1024 + G - 1) / G, NU = 2 * UPW + 1;
    LAS int* tt = (LAS int*)(lds + LDS_TT);
    int Ttot = 0;
    for (int i = 0; i < NU; ++i) { const UDesc d = unit_desc(i, vcu, UPW, ctx_out); if (d.kind < 0) continue; const int nt = d.nw + 4;
        for (int t = tid; t < nt; t += NWAVES * 64) { int row0, cols; tile_src(d, t, row0, cols); if (Ttot + t < MAXT) { tt[2 * (Ttot + t)] = row0; tt[2 * (Ttot + t) + 1] = cols; } }
        Ttot += nt; }
    if (Ttot > MAXT) Ttot = MAXT;
    if (tid < 8) ((LAS float*)(lds + LDS_TT + MAXT * 8))[tid] = sinkp[tid] * LOG2E;
    for (int u = tid; u < 8 * 480; u += NWAVES * 64) { const int h = u / 480, e = u - 480 * h, dr = e >> 5, dc = e & 31; ((LAS float*)(lds + LDS_TAB))[h * 512 + e] = dc < 31 ? rpbl[(h * 15 + dr) * 31 + dc] * LOG2E : 0.f; }
    asm volatile("s_waitcnt lgkmcnt(0)\n\ts_barrier" ::: "memory");
#define AT_ISSUE(T) do { const int row0_ = __builtin_amdgcn_readfirstlane(tt[2 * (T)]), cols_ = __builtin_amdgcn_readfirstlane(tt[2 * (T) + 1]); \
        tile_issue(lds + ((T) & (NS - 1)) * SLOT, ZMp, (size_t)row0_, cols_ & 0xffff, cols_ >> 16, wid, lane); } while (0)
    for (int T = 0; T < PF && T < Ttot; ++T) AT_ISSUE(T);
    int Tb = 0;
    bf16x8 qn[4];
    { int i0 = 0; UDesc d0 = unit_desc(0, vcu, UPW, ctx_out); while (d0.kind < 0 && i0 + 1 < NU) { ++i0; d0 = unit_desc(i0, vcu, UPW, ctx_out); } if (d0.kind >= 0) q_load(d0, ZMp, wid, r32, hi, qn); }
    for (int i = 0; i < NU; ++i) {
        const UDesc d = unit_desc(i, vcu, UPW, ctx_out); if (d.kind < 0) continue;
        bf16x8 qr[4];
#pragma unroll
        for (int k = 0; k < 4; ++k) qr[k] = qn[k];
        { int j = i + 1; UDesc dn = unit_desc(j, vcu, UPW, ctx_out); while (dn.kind < 0 && j + 1 < NU) { ++j; dn = unit_desc(j, vcu, UPW, ctx_out); } if (dn.kind < 0) dn = d; q_load(dn, ZMp, wid, r32, hi, qn); }
        const int NT = d.nw + 4;
        f32x16 o[2];
#pragma unroll
        for (int r = 0; r < 16; ++r) { o[0][r] = 0.f; o[1][r] = 0.f; }
        float m, l;
        if (d.kind == 1) {
            const int head = d.hh * 4 + (wid & 3), qrel = 32 * (wid >> 2) + r32;
            m = ((const LAS float*)(lds + LDS_TT + MAXT * 8))[head]; l = (hi == 0) ? 1.0f : 0.0f;
            int t = 0;
            do {
                const int T = Tb + t, outst = min(Ttot, T + PF) - (T + 1);
                if (outst >= 2) AT_WAIT_BAR(4); else if (outst == 1) AT_WAIT_BAR(2); else AT_WAIT_BAR(0);
                if (t == NT - 1) asm volatile("" : "+v"(qn[0]), "+v"(qn[1]), "+v"(qn[2]), "+v"(qn[3]));
                if (VAR != 5 && T + PF < Ttot) AT_ISSUE(T + PF);
                const LAS unsigned char* sl = lds + (T & (NS - 1)) * SLOT;
                f32x16 x0, x1; if (VAR == 4) { for (int r_ = 0; r_ < 16; ++r_) { x0[r_] = __builtin_bit_cast(float, (int)qr[r_ & 3][0] << 16) ; x1[r_] = x0[r_] * 0.5f; } } else qk_tile(x0, x1, sl, qr, r32, hi);
                const int j = d.lo + t;
                if (t < d.nw && (j == 0 || j == 4)) {
                    const int dq = qrel + 128 - 64 * j - 4 * hi;
#pragma unroll
                    for (int r = 0; r < 16; ++r) { const int dd = dq - ((r & 3) + 8 * (r >> 2));
                        x0[r] = (dd <= 128 && dd >= -128) ? x0[r] * C2 : -INFINITY; x1[r] = (dd - 32 <= 128 && dd - 32 >= -128) ? x1[r] * C2 : -INFINITY; }
                    sm_pv<false, 0, VAR>(x0, x1, m, l, o, sl + 8192, lane, hi);
                } else sm_pv<true, 0, VAR>(x0, x1, m, l, o, sl + 8192, lane, hi);
            } while (++t < NT);
            o_store(o, l, OAp + q_row(d, wid, r32) * BW + head * 64, hi);
        } else {
            const int half = wid & 1, c = 32 * half + r32, r = 4 * d.blk + (wid >> 1);
            const int r0w = min(max(r - 4, 0), 120), c0 = min(max(c - 8, 0), 48);
            const LAS float* tab = (const LAS float*)(lds + LDS_TAB + d.hh * 2048);
            unsigned vm = 0u;
#pragma unroll
            for (int r_ = 0; r_ < 16; ++r_) { const int kc = (r_ & 3) + 8 * (r_ >> 2) + 4 * hi; vm |= ((unsigned)(kc - c0) < 16u ? 1u : 0u) << r_; vm |= ((unsigned)(kc + 32 - c0) < 16u ? 1u : 0u) << (16 + r_); }
            m = -1e30f; l = 0.f;
            int t = 0;
            do {
                const int T = Tb + t, outst = min(Ttot, T + PF) - (T + 1);
                if (outst >= 2) AT_WAIT_BAR(4); else if (outst == 1) AT_WAIT_BAR(2); else AT_WAIT_BAR(0);
                if (t == NT - 1) asm volatile("" : "+v"(qn[0]), "+v"(qn[1]), "+v"(qn[2]), "+v"(qn[3]));
                if (VAR != 5 && T + PF < Ttot) AT_ISSUE(T + PF);
                const int kr = d.lo + t;
                if (t < d.nw && (kr < r0w || kr > r0w + 7)) continue;
                const LAS unsigned char* sl = lds + (T & (NS - 1)) * SLOT;
                f32x16 x0, x1; if (VAR == 4) { for (int r_ = 0; r_ < 16; ++r_) { x0[r_] = __builtin_bit_cast(float, (int)qr[r_ & 3][0] << 16) ; x1[r_] = x0[r_] * 0.5f; } } else qk_tile(x0, x1, sl, qr, r32, hi);
                if (t < d.nw) {
                    const LAS float* tb = tab + (kr - r + 7) * 32 + (4 * hi - c + 15);
                    if (half == 0) {
                        float b0[16], b1[4];
#pragma unroll
                        for (int r_ = 0; r_ < 16; ++r_) { const int rr = (r_ & 3) + 8 * (r_ >> 2); b0[r_] = tb[rr]; if (r_ < 4) b1[r_] = tb[rr + 32]; }
#pragma unroll
                        for (int r_ = 0; r_ < 16; ++r_) {
                            x0[r_] = ((vm >> r_) & 1u) ? __builtin_fmaf(x0[r_], C2, b0[r_]) : -INFINITY;
                            if (r_ < 4) x1[r_] = ((vm >> (16 + r_)) & 1u) ? __builtin_fmaf(x1[r_], C2, b1[r_]) : -INFINITY; }
                        sm_pv<false, 1, VAR>(x0, x1, m, l, o, sl + 8192, lane, hi);
                    } else {
                        float b0[4], b1[16];
#pragma unroll
                        for (int r_ = 0; r_ < 16; ++r_) { const int rr = (r_ & 3) + 8 * (r_ >> 2); if (r_ >= 12) b0[r_ - 12] = tb[rr]; b1[r_] = tb[rr + 32]; }
#pragma unroll
                        for (int r_ = 0; r_ < 16; ++r_) {
                            if (r_ >= 12) x0[r_] = ((vm >> r_) & 1u) ? __builtin_fmaf(x0[r_], C2, b0[r_ - 12]) : -INFINITY;
                            x1[r_] = ((vm >> (16 + r_)) & 1u) ? __builtin_fmaf(x1[r_], C2, b1[r_]) : -INFINITY; }
                        sm_pv<false, 2, VAR>(x0, x1, m, l, o, sl + 8192, lane, hi);
                    }
                } else sm_pv<true, 0, VAR>(x0, x1, m, l, o, sl + 8192, lane, hi);
            } while (++t < NT);
            o_store(o, l, OCp + q_row(d, wid, r32) * BW + d.hh * 64, hi);
        }
        Tb += NT;
    }
    AT_WAIT_BAR(0);
#undef AT_ISSUE
}
}

constexpr int PH_PER_LAYER = 17, NPHASES = 1 + DEPTH * PH_PER_LAYER;
struct Args { const float* in[23]; float* out; unsigned char* ws; int ph_lo, ph_hi; };
typedef __attribute__((address_space(4))) const Args CArgs;
__global__ void __launch_bounds__(NWAVES * 64, 2) mk_fwd(Args args) {
    extern __shared__ __attribute__((aligned(16))) unsigned char lds[];
    Frame F;
    F.lds = (LAS unsigned char*)lds;
    F.MISC = (volatile LAS unsigned*)(F.lds + MISC_OFF);
    F.G = gridDim.x; { const int bx = blockIdx.x; F.vcu = (F.G % 8 == 0) ? (bx % 8) * (F.G / 8) + bx / 8 : bx; }
    F.ctl = (unsigned*)(args.ws + WS_CTL);
    for (int u = threadIdx.x; u < (LDS_BYTES - LDSCTL_OFF) / 4; u += NWAVES * 64) ((LAS unsigned*)(F.lds + LDSCTL_OFF))[u] = 0u;
    { int wv_ = __builtin_amdgcn_readfirstlane((int)(threadIdx.x >> 6)); asm volatile("" : "+s"(wv_)); F.wv = wv_; }
    __syncthreads();
    const int lo = args.ph_lo, hi = args.ph_hi;
    const bool fused = (hi - lo) > 1;
    XcdBarrier bar; bar.bar = F.ctl + CW_BAR; bar.x = 0; bar.st = nullptr; bar.w = F.wv;
    if (fused) { bar = xcd_barrier_post(F.ctl + CW_BAR, F.MISC + 8); bar.w = F.wv; }
#ifndef MK_MASK
#define MK_MASK 0xFFFFFFFFu
#endif
#define SLOT(k) ((k) == 0 ? 0 : (((k) - 1) % PH_PER_LAYER) + 1)
#define IN(k) (((MK_MASK >> SLOT(k)) & 1u) && lo <= (k) && (k) < hi)
#define GRID_BAR() do { if (fused) xcd_barrier(bar); } while (0)
    const int NGW = F.G * NWAVES;
#define PHASE_ENTER() GAS unsigned char* wsg_ = (GAS unsigned char*)args.ws; asm volatile("" : "+s"(wsg_)); unsigned char* ws = (unsigned char*)wsg_; float* outp = (float*)(GAS float*)args.out; (void)outp; const CArgs* ka = (const CArgs*)__builtin_amdgcn_kernarg_segment_ptr(); asm volatile("" : "+s"(ka)); \
    int tid_ = (F.wv << 6) | (int)__builtin_amdgcn_mbcnt_hi(~0u, __builtin_amdgcn_mbcnt_lo(~0u, 0u)); asm volatile("" : "+v"(tid_)); const int lane = tid_ & 63; const int wave = __builtin_amdgcn_readfirstlane(tid_ >> 6); const int gw = F.vcu * NWAVES + wave; (void)gw; (void)lane; (void)ws; (void)ka;
#define INP(i) ((const float*)(const GAS float*)ka->in[i])
#define MOD ((float*)(GAS float*)(ws + WS_MOD))
#define ROPE ((float*)(GAS float*)(ws + WS_ROPE))
#define SLABCNT ((int*)(GAS int*)(ws + WS_SLABCNT))
#define PCUM ((int*)(GAS int*)(ws + WS_PCUM))
#define TOKER ((int*)(GAS int*)(ws + WS_TOKER))
#define TOKG ((float*)(GAS float*)(ws + WS_TOKG))
#define TOKPOS ((int*)(GAS int*)(ws + WS_TOKPOS))
#define HCTX ((float*)(GAS float*)(ws + WS_HCTX))
#define RS ((bf16*)(GAS bf16*)(ws + WS_RS))
#define W_IN ((bf16*)(GAS bf16*)(ws + WS_WIN))
#define W_BR ((bf16*)(GAS bf16*)(ws + WS_WBR))
#define W_OUT ((bf16*)(GAS bf16*)(ws + WS_WOUT))
#define W_GUD ((bf16*)(GAS bf16*)(ws + WS_WGUD))
#define W_DND ((bf16*)(GAS bf16*)(ws + WS_WDND))
#define W_GUM8 ((unsigned char*)(GAS unsigned char*)(ws + WS_WGUM))
#define W_DNM8 ((unsigned char*)(GAS unsigned char*)(ws + WS_WDNM))
#define HX ((bf16*)(GAS bf16*)(ws + WS_HX))
#define ZM ((bf16*)(GAS bf16*)(ws + WS_ZM))
#define ZG ((bf16*)(GAS bf16*)(ws + WS_ZG))
#define OA ((bf16*)(GAS bf16*)(ws + WS_O))
#define OB (OA + (size_t)TA * BW)
#define OC (OA + (size_t)2 * TA * BW)
#define SB ((float*)(GAS float*)(ws + WS_ZM))
#define Y16 ((bf16*)(GAS bf16*)(ws + WS_ZG))
#define HD ((bf16*)(GAS bf16*)(ws + WS_ZM))
#define XG ((bf16*)(GAS bf16*)(ws + WS_XG))
#define HM8 ((unsigned char*)(GAS unsigned char*)(ws + WS_HM))
#define XG8 ((unsigned char*)(GAS unsigned char*)(ws + WS_XG8))
#define HX8 ((unsigned char*)(GAS unsigned char*)(ws + WS_HX8))
#define W_ING8 ((unsigned char*)(GAS unsigned char*)(ws + WS_WING8))

    if (IN(0)) {
        PHASE_ENTER();
        {
            LAS float* scv = (LAS float*)(F.lds + RING_OFF);
            LAS float* red = scv + 5 * 1024;
            for (int u = tid_; u < 5 * 1024; u += NWAVES * 64) { const int bb = u >> 10, k = u & 1023; const float cv = bb < 4 ? INP(I_C)[bb * 1024 + k] : INP(I_CCTX)[k]; scv[u] = cv / (1.0f + __expf(-cv)); }
            __syncthreads();
            for (int it = blockIdx.x; it < 2 * 96; it += F.G) {
                const int l = it / 96, n = (it % 96) * 64 + lane;
                const float* wp = INP(I_WADA) + (size_t)l * D * 6144 + n;
                float a0 = 0.f, a1 = 0.f, a2 = 0.f, a3 = 0.f, a4 = 0.f;
                const int kb = wave * 128;
#pragma unroll 16
                for (int k = 0; k < 128; ++k) { const float w = wp[(size_t)(kb + k) * 6144];
                    a0 += scv[kb + k] * w; a1 += scv[1024 + kb + k] * w; a2 += scv[2048 + kb + k] * w; a3 += scv[3072 + kb + k] * w; a4 += scv[4096 + kb + k] * w; }
                red[(wave * 5 + 0) * 64 + lane] = a0; red[(wave * 5 + 1) * 64 + lane] = a1; red[(wave * 5 + 2) * 64 + lane] = a2; red[(wave * 5 + 3) * 64 + lane] = a3; red[(wave * 5 + 4) * 64 + lane] = a4;
                __syncthreads();
                if (tid_ < 320) { const int bb = tid_ >> 6, nn = tid_ & 63; float s = 0.f;
#pragma unroll
                    for (int w = 0; w < 8; ++w) s += red[(w * 5 + bb) * 64 + nn];
                    const int col = (it % 96) * 64 + nn;
                    MOD[((size_t)l * 5 + bb) * 6144 + col] = s + INP(I_BADA)[l * 6144 + col]; }
                __syncthreads();
            }
        }
        if (blockIdx.x == F.G - 1) {
            for (int u = tid_; u < 192 * 16; u += NWAVES * 64) { const int idx = u >> 4, i = u & 15; const float pos = (float)(idx < 128 ? idx : idx - 128);
                const float inv = 1.0f / powf(10000.0f, (float)(2 * i) / 32.0f); const float ang = pos * inv;
                ROPE[2 * u] = cosf(ang); ROPE[2 * u + 1] = sinf(ang); }
        }
        __syncthreads();
        {
            LAS float* scr = (LAS float*)(F.lds + RING_OFF + wave * 16384);
            constexpr int I_IN = (D / 64) * (INC / 32), I_BR = (BW / 64) * (D / 32), I_OUT = (D / 64) * (D / 32), I_GUD = (D / 64) * (2 * FFD / 32), I_DND = (FFD / 64) * (D / 32),
                          I_GUM = (D / 64) * (2 * FFE / 32), I_DNM = (FFE / 64) * (D / 32);
            constexpr int NITEMS = 2 * I_IN + 6 * I_BR + 2 * I_OUT + I_GUD + I_DND + NE * I_GUM + NE * I_DNM;
            for (int it = gw; it < NITEMS; it += NGW) {
                int r = it;
                if (r < 2 * I_IN) { const int l = r / I_IN, it2 = r % I_IN, n0 = 32 * (it2 % (INC / 32));
                    if (MK_GATE_F8 == 2) { tr_item8(INP(I_WIN) + (size_t)l * D * INC, INC, 64 * (it2 / (INC / 32)), n0, (unsigned char*)W_IN + (size_t)l * INC * D, D, n0, SC_WGU, scr, lane); continue; }
                    if (!MK_GATE_F8 || n0 < ZMC) tr_matrix_item(INP(I_WIN) + (size_t)l * D * INC, D, INC, 0, W_IN + (size_t)l * INC * D, it2, scr, lane);
                    if (MK_GATE_F8 && n0 >= ZMC) tr_item8(INP(I_WIN) + (size_t)l * D * INC, INC, 64 * (it2 / (INC / 32)), n0, W_ING8 + (size_t)l * ZGC * D, D, n0 - ZMC, SC_WGU, scr, lane);
                    continue; } r -= 2 * I_IN;
                if (r < 6 * I_BR) { const int q = r / I_BR; tr_matrix_item(INP(I_WBRANCH) + (size_t)q * BW * D, BW, D, 0, W_BR + (size_t)q * D * BW, r % I_BR, scr, lane); continue; } r -= 6 * I_BR;
                if (r < 2 * I_OUT) { const int l = r / I_OUT; tr_matrix_item(INP(I_WOUT) + (size_t)l * D * D, D, D, 0, W_OUT + (size_t)l * D * D, r % I_OUT, scr, lane); continue; } r -= 2 * I_OUT;
                if (r < I_GUD) { if (MK_DENSE_F8 >= 2) tr_matrix_item8(INP(I_WGUD), D, 2 * FFD, FFD, (unsigned char*)W_GUD, SC_WGU, r, scr, lane); else tr_matrix_item(INP(I_WGUD), D, 2 * FFD, FFD, W_GUD, r, scr, lane); continue; } r -= I_GUD;
                if (r < I_DND) { if (MK_DENSE_F8 >= 1) tr_matrix_item8(INP(I_WDND), FFD, D, 0, (unsigned char*)W_DND, SC_WDN, r, scr, lane); else tr_matrix_item(INP(I_WDND), FFD, D, 0, W_DND, r, scr, lane); continue; } r -= I_DND;
                if (r < NE * I_GUM) { const int e = r / I_GUM; tr_matrix_item8(INP(I_WGUM) + (size_t)e * D * 2 * FFE, D, 2 * FFE, FFE, W_GUM8 + (size_t)e * 2 * FFE * D, SC_WGU, r % I_GUM, scr, lane); continue; } r -= NE * I_GUM;
                { const int e = r / I_DNM; tr_matrix_item8(INP(I_WDNM) + (size_t)e * FFE * D, FFE, D, 0, W_DNM8 + (size_t)e * D * FFE, SC_WDN, r % I_DNM, scr, lane); }
            }
        }
        GRID_BAR();
    }

    for (int l = 0; l < DEPTH; ++l) {
        const int pb = 1 + l * PH_PER_LAYER;
        const bool ctx_out = (l < DEPTH - 1);
        const bool moe = (l & 1) != 0;
        const int rows_out = ctx_out ? TA : TL;
#define modl (MOD + (size_t)l * 5 * 6144)
#define xsrc_lat ((l == 0) ? INP(I_X) : (const float*)outp)
#define xsrc_ctx ((l == 0) ? INP(I_CTX) : (const float*)HCTX)

        if (IN(pb + 0) && l == 0) {
            PHASE_ENTER();
            const int chunk = (TL + NGW - 1) / NGW;
#define P1_ROW(t) do { const float* xr = (t) < TL ? xsrc_lat + (size_t)(t) * D : xsrc_ctx + (size_t)((t) - TL) * D; \
                f32x4 x[4], h[4]; row_load(xr, lane, x); const float rr = row_rrms(x); row_normmod(x, rr, gpre, sh, sc, h); if (MK_GATE_F8 < 2) row_store_bf16(HX + (size_t)(t) * D, lane, h); if (MK_GATE_F8) row_store_fp8(HX8 + (size_t)(t) * D, lane, h, SC_XG); } while (0)
            f32x4 gpre[4], sh[4], sc[4]; vec_load(INP(I_GPREMIX) + l * D, lane, gpre);
            for (int t0 = min(gw * chunk, TL), t1 = min(TL, t0 + chunk); t0 < t1; ) { const int bb = t0 >> 13, te = min(t1, (bb + 1) << 13); const float* md = modl + (size_t)bb * 6144;
                vec_load(md, lane, sh); vec_load(md + 1024, lane, sc);
                for (int t = t0; t < te; ++t) P1_ROW(t);
                t0 = te; }
            { const float* md = modl + (size_t)4 * 6144; vec_load(md, lane, sh); vec_load(md + 1024, lane, sc); for (int t = TL + gw; t < TA; t += NGW) P1_ROW(t); }
#undef P1_ROW
            GRID_BAR();
        }
        if (IN(pb + 1)) {
            PHASE_ENTER();
#if MK_GATE_F8 == 2
            {
                pg8::Gemm g{(const bf16*)HX8, (const bf16*)((unsigned char*)W_IN + (size_t)l * INC * D), TA, ZMC, D}; pg8::StaticOrder S; S.init(TA, ZMC, F.G, (int)blockIdx.x, MK_WGM);
                pg8::EpiZT<true> E{ZM, ZG, ROPE, TL / 256, INP(I_BGATE) + (size_t)l * 3 * D, 0, 1.0f / (SC_XG * SC_WGU)};
                pg8::gemm_phase<pg8::EpiZT<true>, pg8::StaticOrder, PG8_ALIGN, PG8_SP2>(F.lds + RING_OFF, g, S, E, F.wv);
            }
            {
                pg8::Gemm g{(const bf16*)HX8, (const bf16*)((unsigned char*)W_IN + (size_t)l * INC * D + (size_t)ZMC * D), rows_out, ZGC, D}; pg8::StaticOrder S; S.init(rows_out, ZGC, F.G, (int)blockIdx.x, MK_WGM);
                pg8::EpiZT<true> E{ZM, ZG, ROPE, TL / 256, INP(I_BGATE) + (size_t)l * 3 * D, ZMC / 256, 1.0f / (SC_XG * SC_WGU)};
                pg8::gemm_phase<pg8::EpiZT<true>, pg8::StaticOrder, PG8_ALIGN, PG8_SP2>(F.lds + RING_OFF, g, S, E, F.wv);
            }
#elif MK_GATE_F8
            {
                pg8::Gemm g{HX, W_IN + (size_t)l * INC * D, TA, ZMC, D}; pg8::StaticOrder S; S.init(TA, ZMC, F.G, (int)blockIdx.x, MK_WGM);
                pg8::EpiZ E{ZM, ZG, ROPE, TL / 256, INP(I_BGATE) + (size_t)l * 3 * D, 0, 1.0f};
                pg8::gemm_phase<pg8::EpiZ, pg8::StaticOrder, PG8_ALIGN, PG8_SP2>(F.lds + RING_OFF, g, S, E, F.wv);
            }
            {
                pg8::Gemm g{(const bf16*)HX8, (const bf16*)(W_ING8 + (size_t)l * ZGC * D), rows_out, ZGC, D}; pg8::StaticOrder S; S.init(rows_out, ZGC, F.G, (int)blockIdx.x, MK_WGM);
                pg8::EpiZT<true> E{ZM, ZG, ROPE, TL / 256, INP(I_BGATE) + (size_t)l * 3 * D, ZMC / 256, 1.0f / (SC_XG * SC_WGU)};
                pg8::gemm_phase<pg8::EpiZT<true>, pg8::StaticOrder, PG8_ALIGN, PG8_SP2>(F.lds + RING_OFF, g, S, E, F.wv);
            }
#else
            pg8::Gemm g{HX, W_IN + (size_t)l * INC * D, TA, INC, D}; pg8::StaticOrder S; S.init(TA, INC, F.G, (int)blockIdx.x, MK_WGM);
            pg8::EpiZ E{ZM, ZG, ROPE, TL / 256, INP(I_BGATE) + (size_t)l * 3 * D, 0, 1.0f};
            pg8::gemm_phase<pg8::EpiZ, pg8::StaticOrder, PG8_ALIGN, PG8_SP2>(F.lds + RING_OFF, g, S, E, F.wv);
#endif
            GRID_BAR();
        }
        if (IN(pb + 3)) {
            PHASE_ENTER();
            const float* sinkp = INP(I_SINK) + l * 8; const float* rpbp = INP(I_RPB) + (size_t)l * 8 * 15 * 31;
            const float* cw = INP(I_CONVW) + (size_t)l * 3 * BW;
            for (int t = gw; t < rows_out; t += NGW) {
                const bf16* zr = ZM + (size_t)t * ZMC;
                int s, len; size_t base;
                if (t < TL) { s = t & (SEQ - 1); len = SEQ; base = (size_t)(t - s); } else { s = (t - TL) & (CTXL - 1); len = CTXL; base = (size_t)(t - s); }
                const int ch = 8 * lane;
                float uu[3][8];
#pragma unroll
                for (int k = 0; k < 3; ++k) { const int sp = s + k - 1; const bool okk = (sp >= 0 && sp < len);
                    const bf16* zp = ZM + (base + (okk ? sp : s)) * ZMC; const v4u a = *(const v4u*)(zp + C_UX + ch), g = *(const v4u*)(zp + C_GC + ch); const float mk_ = okk ? 1.f : 0.f;
                    uu[k][0] = mk_ * bflo(a.x) * bflo(g.x); uu[k][1] = mk_ * bfhi(a.x) * bfhi(g.x); uu[k][2] = mk_ * bflo(a.y) * bflo(g.y); uu[k][3] = mk_ * bfhi(a.y) * bfhi(g.y);
                    uu[k][4] = mk_ * bflo(a.z) * bflo(g.z); uu[k][5] = mk_ * bfhi(a.z) * bfhi(g.z); uu[k][6] = mk_ * bflo(a.w) * bflo(g.w); uu[k][7] = mk_ * bfhi(a.w) * bfhi(g.w); }
                const v4u gbv = *(const v4u*)(zr + C_GB + ch);
                const float gb[8] = {bflo(gbv.x), bfhi(gbv.x), bflo(gbv.y), bfhi(gbv.y), bflo(gbv.z), bfhi(gbv.z), bflo(gbv.w), bfhi(gbv.w)};
                float o[8];
#pragma unroll
                for (int q = 0; q < 8; ++q) o[q] = gb[q] * (cw[ch + q] * uu[0][q] + cw[BW + ch + q] * uu[1][q] + cw[2 * BW + ch + q] * uu[2][q]);
                v4u w; w.x = pk2(o[0], o[1]); w.y = pk2(o[2], o[3]); w.z = pk2(o[4], o[5]); w.w = pk2(o[6], o[7]);
                *(v4u*)(OB + (size_t)t * BW + ch) = w;
            }
            at::attn_phase(F.lds + RING_OFF, ZM, OA, OC, sinkp, rpbp, F.vcu, F.G, ctx_out, tid_, wave, lane);
#ifdef MK_ATTN_PROBE
            at::attn_phase<MK_ATTN_PROBE>(F.lds + RING_OFF, ZM, (bf16*)(GAS bf16*)(ws + WS_HX), (bf16*)(GAS bf16*)(ws + WS_HX) + (size_t)TA * BW, sinkp, rpbp, F.vcu, F.G, ctx_out, tid_, wave, lane);
#endif
            GRID_BAR();
        }
        if (IN(pb + 4)) {
            PHASE_ENTER();
            pg8::Gemm g{OA, W_BR + (size_t)l * 3 * D * BW, rows_out, D, BW};
            pg8::BranchOrder3 S; S.so.init(rows_out, D, F.G, (int)blockIdx.x, MK_WGM);
            pg8::EpiBranchAcc E{HX, ZG};
            pg8::gemm_phase<pg8::EpiBranchAcc, pg8::BranchOrder3, PG8_ALIGN, PG8_SP2>(F.lds + RING_OFF, g, S, E, F.wv);
            GRID_BAR();
        }
        if (IN(pb + 5)) {
            PHASE_ENTER();
            pg8::Gemm g{HX, W_OUT + (size_t)l * D * D, rows_out, D, D}; pg8::StaticOrder S; S.init(rows_out, D, F.G, (int)blockIdx.x, MK_WGM);
            pg8::EpiBf16P E{Y16, D};
            pg8::gemm_phase<pg8::EpiBf16P, pg8::StaticOrder, PG8_ALIGN, PG8_SP2>(F.lds + RING_OFF, g, S, E, F.wv);
            GRID_BAR();
        }
        if (IN(pb + 6)) {
            PHASE_ENTER();
            if (!moe) {
                const int chunk = (TL + NGW - 1) / NGW;
#define P6_ROW(t) do { f32x4 x[4], y[4], h[4]; \
                    if (l == 0) row_load((t) < TL ? INP(I_X) + (size_t)(t) * D : INP(I_CTX) + (size_t)((t) - TL) * D, lane, x); else row_load_bf16(RS + (size_t)(t) * D, lane, x); \
                    row_load_bf16(Y16 + (size_t)(t) * D, lane, y); const float ry = row_rrms(y); \
                    _Pragma("unroll") for (int j = 0; j < 4; ++j) x[j] = x[j] + gt[j] * (y[j] * ry * gpo[j]); \
                    row_store_bf16(RS + (size_t)(t) * D, lane, x); const float rx = row_rrms(x); row_normmod(x, rx, gpre, sh, sc, h); \
                    if (MK_DENSE_F8 >= 2) row_store_fp8((unsigned char*)HX + (size_t)(t) * D, lane, h, SC_XG); else row_store_bf16(HX + (size_t)(t) * D, lane, h); } while (0)
                f32x4 gpo[4], gt[4], gpre[4], sh[4], sc[4]; vec_load(INP(I_GPOSTMIX) + l * D, lane, gpo); vec_load(INP(I_GPREFFN) + l * D, lane, gpre);
                for (int t0 = min(gw * chunk, TL), t1 = min(TL, t0 + chunk); t0 < t1; ) { const int bb = t0 >> 13, te = min(t1, (bb + 1) << 13); const float* md = modl + (size_t)bb * 6144;
                    vec_load(md + 2048, lane, gt); vec_load(md + 3072, lane, sh); vec_load(md + 4096, lane, sc);
                    for (int t = t0; t < te; ++t) P6_ROW(t);
                    t0 = te; }
                if (rows_out > TL) { const float* md = modl + (size_t)4 * 6144; vec_load(md + 2048, lane, gt); vec_load(md + 3072, lane, sh); vec_load(md + 4096, lane, sc); for (int t = TL + gw; t < rows_out; t += NGW) P6_ROW(t); }
#undef P6_ROW
            } else {
                LAS int* sel = (LAS int*)(F.lds + RING_OFF);
                LAS int* rnk = sel + 256;
                LAS f32x4* wrT = (LAS f32x4*)(F.lds + RING_OFF + 4096);
                const float* wr = INP(I_WROUTER) + (size_t)(l >> 1) * D * NE; const float* br = INP(I_BROUTER) + (l >> 1) * NE;
                for (int u = tid_; u < D * NE; u += NWAVES * 64) ((LAS float*)wrT)[(u & 7) * D + (u >> 3)] = wr[u];
                LDS_WAIT(); __syncthreads();
                f32x4 gpo[4], gt[4], gpre[4], sh[4], sc[4]; vec_load(INP(I_GPOSTMIX) + l * D, lane, gpo); vec_load(INP(I_GPREFFN) + l * D, lane, gpre);
                for (int slab = F.vcu; slab < TL / 128; slab += F.G) {
                    { const float* md = modl + (size_t)((slab * 128) >> 13) * 6144; vec_load(md + 2048, lane, gt); vec_load(md + 3072, lane, sh); vec_load(md + 4096, lane, sc); }
                    for (int i = 0; i < 16; ++i) {
                        const int tl_ = wave * 16 + i, t = slab * 128 + tl_;
                        f32x4 x[4], y[4], h[4]; if (l == 0) row_load(INP(I_X) + (size_t)t * D, lane, x); else row_load_bf16(RS + (size_t)t * D, lane, x);
                        row_load_bf16(Y16 + (size_t)t * D, lane, y);
                        const float ry = row_rrms(y);
#pragma unroll
                        for (int j = 0; j < 4; ++j) x[j] = x[j] + gt[j] * (y[j] * ry * gpo[j]);
                        row_store_bf16(RS + (size_t)t * D, lane, x);
                        const float rx = row_rrms(x);
                        row_normmod(x, rx, gpre, sh, sc, h);
                        row_store_bf16(HX + (size_t)t * D, lane, h);
                        float lg[8];
#pragma unroll
                        for (int e = 0; e < 8; ++e) lg[e] = 0.f;
#pragma unroll
                        for (int e = 0; e < 8; ++e)
#pragma unroll
                            for (int j = 0; j < 4; ++j) { const f32x4 w4 = wrT[e * (D / 4) + 2 * (64 * (j >> 1) + lane) + (j & 1)]; lg[e] += (h[j].x * w4.x + h[j].y * w4.y) + (h[j].z * w4.z + h[j].w * w4.w); }
#pragma unroll
                        for (int e = 0; e < 8; ++e) lg[e] = wave_sum(lg[e]) + br[e];
                        int e1 = 0; float v1 = lg[0];
#pragma unroll
                        for (int e = 1; e < 8; ++e) if (lg[e] > v1) { v1 = lg[e]; e1 = e; }
                        int e2 = -1; float v2 = -INFINITY;
#pragma unroll
                        for (int e = 0; e < 8; ++e) if (e != e1 && lg[e] > v2) { v2 = lg[e]; e2 = e; }
                        const float ex = __expf(v2 - v1), g1 = 1.0f / (1.0f + ex), g2 = ex / (1.0f + ex);
                        if (lane == 0) { sel[2 * tl_] = e1; sel[2 * tl_ + 1] = e2; TOKG[2 * (size_t)t] = g1; TOKG[2 * (size_t)t + 1] = g2; }
                    }
                    LDS_WAIT(); __syncthreads();
                    if (tid_ < 8) { int cnt = 0; for (int q = 0; q < 256; ++q) if (sel[q] == tid_) { rnk[q] = cnt; ++cnt; } SLABCNT[slab * 8 + tid_] = cnt; }
                    LDS_WAIT(); __syncthreads();
                    if (tid_ < 256) TOKER[(size_t)slab * 256 + tid_] = sel[tid_] | (rnk[tid_] << 8);
                    LDS_WAIT(); __syncthreads();
                }
            }
            GRID_BAR();
        }
        if (IN(pb + 7) && moe) {
            PHASE_ENTER();
            LAS int* scn = (LAS int*)(F.lds + RING_OFF);
            LAS int* pst = scn + 2048;
            for (int u = tid_; u < 2048; u += NWAVES * 64) scn[u] = SLABCNT[u];
            LDS_WAIT(); __syncthreads();
            if (tid_ < 8) { int run = 0; for (int q = 0; q < 256; ++q) { const int c = scn[q * 8 + tid_]; scn[q * 8 + tid_] = run; run += c; } pst[8 + tid_] = run; }
            LDS_WAIT(); __syncthreads();
            if (tid_ == 0) { int pan = 0; for (int e = 0; e < 8; ++e) { pst[e] = pan * 256; if (blockIdx.x == 0) PCUM[e] = pan; pan += (pst[8 + e] + 255) >> 8; } if (blockIdx.x == 0) PCUM[8] = pan; }
            LDS_WAIT(); __syncthreads();
            LAS int* posl = pst + 16;
            for (int slab = F.vcu; slab < TL / 128; slab += F.G) {
                if (tid_ < 256) { const int er = TOKER[(size_t)slab * 256 + tid_]; const int e = er & 255, rk = er >> 8; const int pos = pst[e] + scn[slab * 8 + e] + rk;
                    posl[tid_] = pos; TOKPOS[(size_t)slab * 256 + tid_] = pos; }
                LDS_WAIT(); __syncthreads();
                const v4u* srcb = (const v4u*)(HX + (size_t)slab * 128 * D);
#pragma unroll 4
                for (int i = 0; i < 16; ++i) { const int id = i * 512 + tid_, tk = id >> 6, chk = id & 63;
                    const v4u a = srcb[(size_t)tk * 128 + 2 * chk], b = srcb[(size_t)tk * 128 + 2 * chk + 1]; v4u o;
#define Q8(v) pg8::clamp_fp8((v) * SC_XG)
                    o.x = pg8::pk4_fp8(Q8(bflo(a.x)), Q8(bfhi(a.x)), Q8(bflo(a.y)), Q8(bfhi(a.y))); o.y = pg8::pk4_fp8(Q8(bflo(a.z)), Q8(bfhi(a.z)), Q8(bflo(a.w)), Q8(bfhi(a.w)));
                    o.z = pg8::pk4_fp8(Q8(bflo(b.x)), Q8(bfhi(b.x)), Q8(bflo(b.y)), Q8(bfhi(b.y))); o.w = pg8::pk4_fp8(Q8(bflo(b.z)), Q8(bfhi(b.z)), Q8(bflo(b.w)), Q8(bfhi(b.w)));
#undef Q8
                    ((v4u*)(XG8 + (size_t)posl[2 * tk] * D))[chk] = o; ((v4u*)(XG8 + (size_t)posl[2 * tk + 1] * D))[chk] = o; }
                LDS_WAIT(); __syncthreads();
            }
            GRID_BAR();
        }
        if (IN(pb + 8) && !moe) {
            PHASE_ENTER();
            pg8::Gemm g{HX, W_GUD, rows_out, 2 * FFD, D}; pg8::StaticOrder S; S.init(rows_out, 2 * FFD, F.G, (int)blockIdx.x, MK_WGM);
#if MK_DENSE_F8 >= 2
            pg8::EpiSwiglu8T<true> E{(unsigned char*)HD, FFD, 1.0f / (SC_XG * SC_WGU), SC_H};
            pg8::gemm_phase<pg8::EpiSwiglu8T<true>, pg8::StaticOrder, PG8_ALIGN, PG8_SP2>(F.lds + RING_OFF, g, S, E, F.wv);
#elif MK_DENSE_F8 == 1
            pg8::EpiSwiglu8T<false> E{(unsigned char*)HD, FFD, 1.0f, SC_H};
            pg8::gemm_phase<pg8::EpiSwiglu8T<false>, pg8::StaticOrder, PG8_ALIGN, PG8_SP2>(F.lds + RING_OFF, g, S, E, F.wv);
#else
            pg8::EpiSwiglu E{HD, FFD};
            pg8::gemm_phase<pg8::EpiSwiglu, pg8::StaticOrder, PG8_ALIGN, PG8_SP2>(F.lds + RING_OFF, g, S, E, F.wv);
#endif
            GRID_BAR();
        }
        if (IN(pb + 9) && !moe) {
            PHASE_ENTER();
            pg8::Gemm g{HD, W_DND, rows_out, D, FFD}; pg8::StaticOrder S; S.init(rows_out, D, F.G, (int)blockIdx.x, MK_WGM);
#if MK_DENSE_F8 >= 1
            pg8::EpiBf16PS8 E{Y16, D, 1.0f / (SC_H * SC_WDN)};
            pg8::gemm_phase<pg8::EpiBf16PS8, pg8::StaticOrder, PG8_ALIGN, PG8_SP2>(F.lds + RING_OFF, g, S, E, F.wv);
#else
            pg8::EpiBf16P E{Y16, D};
            pg8::gemm_phase<pg8::EpiBf16P, pg8::StaticOrder, PG8_ALIGN, PG8_SP2>(F.lds + RING_OFF, g, S, E, F.wv);
#endif
            GRID_BAR();
        }
        if (moe) {
            for (int ck = 0; ck < NCHUNK; ++ck) {
                if (IN(pb + 10 + 2 * ck)) {
                    PHASE_ENTER();
                    pg8::MoeOrder S; S.nN = 2 * FFE / 256; S.G = F.G; S.c = F.vcu; S.p_lo = ck * PCH;
#pragma unroll
                    for (int k = 0; k < 8; ++k) S.pc[k] = __builtin_amdgcn_readfirstlane(PCUM[k]);
                    const int ptot = __builtin_amdgcn_readfirstlane(PCUM[8]); S.np = min(max(ptot - ck * PCH, 0), PCH);
                    pg8::Gemm g{(const bf16*)XG8, (const bf16*)W_GUM8, 0, 2 * FFE, D};
                    pg8::EpiSwiglu8 E{HM8, FFE, 1.0f / (SC_XG * SC_WGU), SC_H};
                    pg8::gemm_phase<pg8::EpiSwiglu8, pg8::MoeOrder, PG8_ALIGN, PG8_SP2>(F.lds + RING_OFF, g, S, E, F.wv);
                    GRID_BAR();
                }
                if (IN(pb + 11 + 2 * ck)) {
                    PHASE_ENTER();
                    pg8::MoeOrder S; S.nN = D / 256; S.G = F.G; S.c = F.vcu; S.p_lo = ck * PCH;
#pragma unroll
                    for (int k = 0; k < 8; ++k) S.pc[k] = __builtin_amdgcn_readfirstlane(PCUM[k]);
                    const int ptot = __builtin_amdgcn_readfirstlane(PCUM[8]); S.np = min(max(ptot - ck * PCH, 0), PCH);
                    pg8::Gemm g{(const bf16*)HM8, (const bf16*)W_DNM8, 0, D, FFE};
                    pg8::EpiBf16PS8 E{XG, D, 1.0f / (SC_H * SC_WDN)};
                    pg8::gemm_phase<pg8::EpiBf16PS8, pg8::MoeOrder, PG8_ALIGN, PG8_SP2>(F.lds + RING_OFF, g, S, E, F.wv);
                    GRID_BAR();
                }
            }
        }
        if (IN(pb + 16)) {
            PHASE_ENTER();
            const int chunk = (TL + NGW - 1) / NGW; const bool nextl = (l + 1 < DEPTH);
#define P9_ROW(t) do { f32x4 x[4], y[4]; row_load_bf16(RS + (size_t)(t) * D, lane, x); \
                if (!moe) row_load_bf16(Y16 + (size_t)(t) * D, lane, y); \
                else { const int p0 = TOKPOS[2 * (size_t)(t)], p1 = TOKPOS[2 * (size_t)(t) + 1]; const float g0 = TOKG[2 * (size_t)(t)], g1 = TOKG[2 * (size_t)(t) + 1]; \
                    f32x4 ya[4], yb[4]; row_load_bf16(XG + (size_t)p0 * D, lane, ya); row_load_bf16(XG + (size_t)p1 * D, lane, yb); \
                    _Pragma("unroll") for (int j = 0; j < 4; ++j) y[j] = ya[j] * g0 + yb[j] * g1; } \
                const float ry = row_rrms(y); \
                _Pragma("unroll") for (int j = 0; j < 4; ++j) x[j] = x[j] + gt[j] * (y[j] * ry * gpo[j]); \
                if (nextl) row_store_bf16(RS + (size_t)(t) * D, lane, x); else if ((t) < TL) row_store(outp + (size_t)(t) * D, lane, x); \
                if (nextl) { f32x4 h[4]; const float rx = row_rrms(x); row_normmod(x, rx, gpre, sh, sc, h); if (MK_GATE_F8 < 2) row_store_bf16(HX + (size_t)(t) * D, lane, h); if (MK_GATE_F8) row_store_fp8(HX8 + (size_t)(t) * D, lane, h, SC_XG); } } while (0)
            f32x4 gpo[4], gt[4], gpre[4], sh[4], sc[4]; vec_load(INP(I_GPOSTFFN) + l * D, lane, gpo); vec_load(INP(I_GPREMIX) + (nextl ? l + 1 : l) * D, lane, gpre);
            for (int t0 = min(gw * chunk, TL), t1 = min(TL, t0 + chunk); t0 < t1; ) { const int bb = t0 >> 13, te = min(t1, (bb + 1) << 13); const float* md = modl + (size_t)bb * 6144;
                vec_load(md + 5120, lane, gt); vec_load(md + (nextl ? 5 * 6144 : 0), lane, sh); vec_load(md + (nextl ? 5 * 6144 : 0) + 1024, lane, sc);
                for (int t = t0; t < te; ++t) P9_ROW(t);
                t0 = te; }
            if (rows_out > TL) { const float* md = modl + (size_t)4 * 6144; vec_load(md + 5120, lane, gt); vec_load(md + (nextl ? 5 * 6144 : 0), lane, sh); vec_load(md + (nextl ? 5 * 6144 : 0) + 1024, lane, sc);
                for (int t = TL + gw; t < rows_out; t += NGW) P9_ROW(t); }
#undef P9_ROW
            if (l + 1 < DEPTH) GRID_BAR();
        }
    }
#undef IN
#undef GRID_BAR
}

extern "C" void kernel_launch(void* const* d_in, const int* in_sizes, int n_in, void* d_out, int out_size, void* d_ws, size_t ws_size, hipStream_t stream) {
    static int grid = 0;
    if (grid == 0) {
        if (n_in != 23 || in_sizes[0] != TL * D || out_size != TL * D || ws_size < WS_END) { fprintf(stderr, "kernel_launch: unexpected shapes: n_in %d in0 %d out %d ws %zu (need %zu); nothing launched\n", n_in, n_in > 0 ? in_sizes[0] : -1, out_size, ws_size, (size_t)WS_END); grid = -1; return; }
        int dev = 0, cus = 0, per_cu = 0;
        if (hipGetDevice(&dev) != hipSuccess || hipDeviceGetAttribute(&cus, hipDeviceAttributeMultiprocessorCount, dev) != hipSuccess) { fprintf(stderr, "kernel_launch: device query failed\n"); grid = -1; return; }
        if (hipFuncSetAttribute((const void*)mk_fwd, hipFuncAttributeMaxDynamicSharedMemorySize, LDS_BYTES) != hipSuccess) { fprintf(stderr, "kernel_launch: hipFuncSetAttribute failed\n"); grid = -1; return; }
        if (hipOccupancyMaxActiveBlocksPerMultiprocessor(&per_cu, (const void*)mk_fwd, NWAVES * 64, LDS_BYTES) != hipSuccess || per_cu < 1) fprintf(stderr, "kernel_launch: note: occupancy query reports %d\n", per_cu);
        (void)hipGetLastError();
        grid = cus;
    }
    if (grid < 0) return;
    if (hipMemsetAsync((char*)d_ws + WS_CTL, 0, CTL_ZERO_BYTES, stream) != hipSuccess) { fprintf(stderr, "kernel_launch: memset failed\n"); return; }
    Args a{};
    for (int i = 0; i < 23; ++i) a.in[i] = (const float*)d_in[i];
    a.out = (float*)d_out; a.ws = (unsigned char*)d_ws;
#if MK_PER_PHASE
    for (int ph = 0; ph < NPHASES; ++ph) { a.ph_lo = ph; a.ph_hi = ph + 1; hipLaunchKernelGGL(mk_fwd, dim3(grid), dim3(NWAVES * 64), LDS_BYTES, stream, a); }
#else
    a.ph_lo = 0; a.ph_hi = NPHASES;
    hipLaunchKernelGGL(mk_fwd, dim3(grid), dim3(NWAVES * 64), LDS_BYTES, stream, a);
#endif
    const hipError_t le = hipPeekAtLastError();
    if (le != hipSuccess) fprintf(stderr, "kernel_launch: launch failed: %s\n", hipGetErrorName(le));
}
```

```cpp
#include <hip/hip_runtime.h>
#include <cstdio>
#include <cstdint>
#ifndef MK_GATE_F8
#define MK_GATE_F8 1
#endif

namespace pg8 {
#define PG8_LAS __attribute__((address_space(3)))
typedef unsigned short bf16_t;
typedef short bf16x8 __attribute__((ext_vector_type(8)));
typedef float f32x4 __attribute__((ext_vector_type(4)));
typedef unsigned u32x4 __attribute__((ext_vector_type(4)));
typedef unsigned u32x2 __attribute__((ext_vector_type(2)));
typedef int v8i32 __attribute__((ext_vector_type(8)));
constexpr int BM = 256, BK = 64, HALF = 128, HTB = HALF * BK * 2  , STAGE_BYTES = 8 * HTB, NXCD = 8, WGM = 8;

__host__ __device__ __forceinline__ int lds_byte(int r, int c) { const int st = (r >> 4) * 2 + (c >> 5), rr = r & 15, cc = c & 31, ob = rr * 64 + cc * 2; return st * 1024 + (ob ^ (((ob >> 9) & 1) << 5)); }
__host__ __device__ __forceinline__ void stage_rc(int b, int& R, int& C) { const int st = b / 1024, sb = b % 1024, swz = sb ^ (((sb >> 9) & 1) << 5); R = (st >> 1) * 16 + swz / 64; C = (st & 1) * 32 + (swz % 64) / 2; }
__host__ __device__ __forceinline__ int perm32(int rho) { const int n = rho >> 4, i = rho & 15; return 8 * (i >> 2) + 4 * n + (i & 3); }

struct Unit { int pm, pn, pb; };
struct Gemm { const bf16_t* A; const bf16_t* Bt; int M, N, K; };

struct StaticOrder {
    int nM, nN, nwg, G, c, wgm;
    __host__ __device__ void init(int M, int N, int G_, int c_, int wgm_ = WGM) { nM = M / BM; nN = N / BM; nwg = nM * nN; G = G_; c = c_; wgm = wgm_; }
    __host__ __device__ bool next(int i, Unit& u) const {
        const long L = (long)i * G + c; if (L >= nwg) return false;
        int wgid = (int)L; { const int q = nwg / NXCD, r = nwg % NXCD, xcd = wgid % NXCD, off = wgid / NXCD; wgid = (xcd < r ? xcd * (q + 1) : r * (q + 1) + (xcd - r) * q) + off; }
        const int nig = wgm * nN, gid = wgid / nig, fm = gid * wgm, gsz = (nM - fm) < wgm ? (nM - fm) : wgm;
        u.pm = fm + ((wgid % nig) % gsz); u.pn = (wgid % nig) / gsz; u.pb = u.pn; return true;
    }
    __device__ __forceinline__ void a_ready(const Unit&) const {}
    __device__ __forceinline__ void done(const Unit&) const {}
};

__device__ __forceinline__ unsigned cvt_pk_bf16(float lo, float hi) { unsigned r; asm volatile("v_cvt_pk_bf16_f32 %0, %1, %2" : "=v"(r) : "v"(lo), "v"(hi)); return r; }
__device__ __forceinline__ float bf_lo(unsigned w) { return __uint_as_float(w << 16); }
__device__ __forceinline__ float bf_hi(unsigned w) { return __uint_as_float(w & 0xffff0000u); }
__device__ __forceinline__ float sigmoidf_(float x) { return __builtin_amdgcn_rcpf(1.0f + __builtin_amdgcn_exp2f(x * -1.4426950408889634f)); }

template <bool OPF8> struct EpiZT {
    static constexpr bool PERM = true, AFTER_DRAIN = false, HALFN = false, F8 = OPF8, RWACC = false;
    bf16_t* ZM; bf16_t* ZG; const float* rope; int n_lat_panels; const float* bgate; int pn_off; float gs;
    __device__ __forceinline__ void operator()(const f32x4 (&acc)[2][2][4][2], const Unit& u, int wr, int wc, int fr, int fq) const {
        const int row0 = u.pm * BM + wr * 64 + fr; int colt = (u.pn + pn_off) * BM; bf16_t* base = ZM; int ldc = 3840; bool isg = false;
        if (colt >= 3840) { base = ZG; colt -= 3840; ldc = 3072; isg = true; }
        const int col0 = colt + wc * 32 + 8 * fq;
        f32x4 gb[2][2];
        if (isg) {
#pragma unroll
            for (int bj = 0; bj < 2; ++bj) { gb[bj][0] = *(const f32x4*)(bgate + col0 + bj * HALF); gb[bj][1] = *(const f32x4*)(bgate + col0 + bj * HALF + 4); } }
        const int nrope = (u.pm < n_lat_panels) ? (u.pn + pn_off < 2 ? 2 : (u.pn + pn_off == 2 ? 1 : 0)) : 0;
#pragma unroll
        for (int ai = 0; ai < 2; ++ai)
#pragma unroll
            for (int m = 0; m < 4; ++m) { const int row = row0 + ai * HALF + m * 16; bf16_t* rowp = base + (size_t)row * ldc + col0;
                f32x4 cs[4];
                if (nrope) { const int s = row & 8191, pidx = (wc & 1) ? 128 + (s & 63) : (s >> 6); const f32x4* cp = (const f32x4*)(rope + (size_t)(pidx * 16 + 8 * (fq & 1)) * 2);
                    cs[0] = cp[0]; cs[1] = cp[1]; cs[2] = cp[2]; cs[3] = cp[3]; }
#pragma unroll
                for (int bj = 0; bj < 2; ++bj) { f32x4 v0 = acc[ai][bj][m][0], v1 = acc[ai][bj][m][1];
                    if (OPF8 && !isg) { v0 *= gs; v1 *= gs; }
                    if (isg) {
#pragma unroll
                        for (int j = 0; j < 4; ++j) { v0[j] = sigmoidf_(fminf(fmaxf(v0[j] * gs + gb[bj][0][j], -30.f), 30.f)); v1[j] = sigmoidf_(fminf(fmaxf(v1[j] * gs + gb[bj][1][j], -30.f), 30.f)); } }
                    if (bj < nrope) { const float sg = (fq >> 1) ? 1.f : -1.f;
                        float v[8] = {v0[0], v0[1], v0[2], v0[3], v1[0], v1[1], v1[2], v1[3]}, o[8];
#pragma unroll
                        for (int j = 0; j < 8; ++j) { const float pv = __shfl_xor(v[j], 32); const float c_ = cs[j >> 1][(j & 1) * 2], s_ = cs[j >> 1][(j & 1) * 2 + 1]; o[j] = v[j] * c_ + sg * pv * s_; }
                        v0 = (f32x4){o[0], o[1], o[2], o[3]}; v1 = (f32x4){o[4], o[5], o[6], o[7]}; }
                    u32x4 w; w.x = cvt_pk_bf16(v0[0], v0[1]); w.y = cvt_pk_bf16(v0[2], v0[3]); w.z = cvt_pk_bf16(v1[0], v1[1]); w.w = cvt_pk_bf16(v1[2], v1[3]);
                    *(u32x4*)(rowp + bj * HALF) = w; } }
    }
};
typedef EpiZT<false> EpiZ;
struct EpiBf16P {
    static constexpr bool PERM = true, AFTER_DRAIN = false, HALFN = false, F8 = false, RWACC = false;
    bf16_t* O; int ldc;
    __device__ __forceinline__ void operator()(const f32x4 (&acc)[2][2][4][2], const Unit& u, int wr, int wc, int fr, int fq) const {
        const int row0 = u.pm * BM + wr * 64 + fr; const int col0 = u.pn * BM + wc * 32 + 8 * fq;
#pragma unroll
        for (int ai = 0; ai < 2; ++ai)
#pragma unroll
            for (int m = 0; m < 4; ++m) { bf16_t* rowp = O + (size_t)(row0 + ai * HALF + m * 16) * ldc + col0;
#pragma unroll
                for (int bj = 0; bj < 2; ++bj) { const f32x4 v0 = acc[ai][bj][m][0], v1 = acc[ai][bj][m][1];
                    u32x4 w; w.x = cvt_pk_bf16(v0[0], v0[1]); w.y = cvt_pk_bf16(v0[2], v0[3]); w.z = cvt_pk_bf16(v1[0], v1[1]); w.w = cvt_pk_bf16(v1[2], v1[3]);
                    *(u32x4*)(rowp + bj * HALF) = w; } }
    }
};
struct EpiBranchAcc {
    static constexpr bool PERM = true, AFTER_DRAIN = false, HALFN = false, F8 = false, RWACC = true;
    bf16_t* MG; const bf16_t* ZG;
    __device__ __forceinline__ bool restart(const Unit& u) const { return u.pm >= 264; }
    __device__ __forceinline__ void rw(f32x4 (&acc)[2][2][4][2], const Unit& u, int wr, int wc, int fr, int fq) const {
        const int r = u.pm / 132, pmt = u.pm - 132 * r, rn = r < 2 ? r + 1 : r;
        const int row0 = pmt * BM + wr * 64 + fr, col0 = u.pn * BM + wc * 32 + 8 * fq;
        u32x4 gp[2][2], gn[2][2];
#define PG8_GLOAD(s, buf) do { const int bj_ = (s) >> 2, ai_ = ((s) >> 1) & 1, mb_ = ((s) & 1) * 2; _Pragma("unroll") for (int q_ = 0; q_ < 2; ++q_) { \
            const size_t row_ = (size_t)(row0 + ai_ * HALF + (mb_ + q_) * 16); const int col_ = col0 + bj_ * HALF; \
            gp[buf][q_] = *(const u32x4*)(ZG + row_ * 3072 + r * 1024 + col_); gn[buf][q_] = *(const u32x4*)(ZG + row_ * 3072 + rn * 1024 + col_); } } while (0)
        PG8_GLOAD(0, 0);
#pragma unroll
        for (int s = 0; s < 8; ++s) { const int bj = s >> 2, ai = (s >> 1) & 1, mb = (s & 1) * 2, col = col0 + bj * HALF;
            if (s + 1 < 8) PG8_GLOAD(s + 1, (s + 1) & 1);
            __builtin_amdgcn_sched_barrier(0);
#pragma unroll
            for (int q = 0; q < 2; ++q) { const int m = mb + q; const size_t row = (size_t)(row0 + ai * HALF + m * 16);
                const u32x4 g0 = gp[s & 1][q], g1 = gn[s & 1][q];
                const float x[8] = {bf_lo(g0.x), bf_hi(g0.x), bf_lo(g0.y), bf_hi(g0.y), bf_lo(g0.z), bf_hi(g0.z), bf_lo(g0.w), bf_hi(g0.w)};
                if (r < 2) {
                    const float y[8] = {bf_lo(g1.x), bf_hi(g1.x), bf_lo(g1.y), bf_hi(g1.y), bf_lo(g1.z), bf_hi(g1.z), bf_lo(g1.w), bf_hi(g1.w)};
#pragma unroll
                    for (int j = 0; j < 8; ++j) acc[ai][bj][m][j >> 2][j & 3] *= x[j] * __builtin_amdgcn_rcpf(y[j]);
                } else {
                    float v[8];
#pragma unroll
                    for (int j = 0; j < 8; ++j) v[j] = acc[ai][bj][m][j >> 2][j & 3] * x[j];
                    u32x4 w; w.x = cvt_pk_bf16(v[0], v[1]); w.y = cvt_pk_bf16(v[2], v[3]); w.z = cvt_pk_bf16(v[4], v[5]); w.w = cvt_pk_bf16(v[6], v[7]);
                    *(u32x4*)(MG + row * 1024 + col) = w;
                } }
        }
#undef PG8_GLOAD
    }
};
struct BranchOrder3 {
    StaticOrder so;
    __device__ __forceinline__ bool next(int i, Unit& u) const {
        const int ti = i / 3, r = i - 3 * ti; if (!so.next(ti, u)) return false;
        u.pb = 4 * r + u.pn; u.pm += 132 * r; return true;
    }
    __device__ __forceinline__ void a_ready(const Unit&) const {}
    __device__ __forceinline__ void done(const Unit&) const {}
};
struct EpiSwiglu {
    static constexpr bool PERM = true, AFTER_DRAIN = false, HALFN = false, F8 = false, RWACC = false;
    bf16_t* H; int ldh;
    __device__ __forceinline__ void operator()(const f32x4 (&acc)[2][2][4][2], const Unit& u, int wr, int wc, int fr, int fq) const {
        const int row0 = u.pm * BM + wr * 64 + fr; const int col0 = u.pn * HALF + wc * 32 + 8 * fq;
#pragma unroll
        for (int ai = 0; ai < 2; ++ai)
#pragma unroll
            for (int m = 0; m < 4; ++m) { bf16_t* rowp = H + (size_t)(row0 + ai * HALF + m * 16) * ldh + col0;
                float h[8];
#pragma unroll
                for (int n = 0; n < 2; ++n)
#pragma unroll
                    for (int j = 0; j < 4; ++j) { const float g = acc[ai][0][m][n][j], uu = acc[ai][1][m][n][j]; h[n * 4 + j] = g * sigmoidf_(g) * uu; }
                u32x4 w; w.x = cvt_pk_bf16(h[0], h[1]); w.y = cvt_pk_bf16(h[2], h[3]); w.z = cvt_pk_bf16(h[4], h[5]); w.w = cvt_pk_bf16(h[6], h[7]);
                *(u32x4*)rowp = w; }
    }
};
__device__ __forceinline__ unsigned pk4_fp8(float a, float b, float c, float d) { int w = __builtin_amdgcn_cvt_pk_fp8_f32(a, b, 0, false); w = __builtin_amdgcn_cvt_pk_fp8_f32(c, d, w, true); return (unsigned)w; }
__device__ __forceinline__ float clamp_fp8(float v) { return fminf(fmaxf(v, -448.0f), 448.0f); }
template <bool OPF8> struct EpiSwiglu8T {
    static constexpr bool PERM = true, AFTER_DRAIN = false, HALFN = false, F8 = OPF8, RWACC = false;
    unsigned char* H; int ldh; float sin, sout;
    __device__ __forceinline__ void operator()(const f32x4 (&acc)[2][2][4][2], const Unit& u, int wr, int wc, int fr, int fq) const {
        const int row0 = u.pm * BM + wr * 64 + fr; const int col0 = u.pn * HALF + wc * 32 + 8 * (fq & 2); const int odd = fq & 1;
#pragma unroll
        for (int ai = 0; ai < 2; ++ai)
#pragma unroll
            for (int mp = 0; mp < 2; ++mp) {
                unsigned w[2][2];
#pragma unroll
                for (int k = 0; k < 2; ++k) { const int m = 2 * mp + k; float h[8];
#pragma unroll
                    for (int n = 0; n < 2; ++n)
#pragma unroll
                        for (int j = 0; j < 4; ++j) { const float g = acc[ai][0][m][n][j] * sin, uu = acc[ai][1][m][n][j] * sin; h[n * 4 + j] = clamp_fp8(g * sigmoidf_(g) * uu * sout); }
                    w[k][0] = pk4_fp8(h[0], h[1], h[2], h[3]); w[k][1] = pk4_fp8(h[4], h[5], h[6], h[7]); }
                const unsigned s0 = odd ? w[0][0] : w[1][0], s1 = odd ? w[0][1] : w[1][1];
                const unsigned r0 = (unsigned)__shfl_xor((int)s0, 16), r1 = (unsigned)__shfl_xor((int)s1, 16);
                u32x4 st; if (odd) { st.x = r0; st.y = r1; st.z = w[1][0]; st.w = w[1][1]; } else { st.x = w[0][0]; st.y = w[0][1]; st.z = r0; st.w = r1; }
                *(u32x4*)(H + (size_t)(row0 + ai * HALF + (2 * mp + odd) * 16) * ldh + col0) = st; }
    }
};
typedef EpiSwiglu8T<true> EpiSwiglu8;
struct EpiBf16PS8 {
    static constexpr bool PERM = true, AFTER_DRAIN = false, HALFN = false, F8 = true, RWACC = false;
    bf16_t* O; int ldc; float s;
    __device__ __forceinline__ void operator()(const f32x4 (&acc)[2][2][4][2], const Unit& u, int wr, int wc, int fr, int fq) const {
        const int row0 = u.pm * BM + wr * 64 + fr; const int col0 = u.pn * BM + wc * 32 + 8 * fq;
#pragma unroll
        for (int ai = 0; ai < 2; ++ai)
#pragma unroll
            for (int m = 0; m < 4; ++m) { bf16_t* rowp = O + (size_t)(row0 + ai * HALF + m * 16) * ldc + col0;
#pragma unroll
                for (int bj = 0; bj < 2; ++bj) { const f32x4 v0 = acc[ai][bj][m][0] * s, v1 = acc[ai][bj][m][1] * s;
                    u32x4 w; w.x = cvt_pk_bf16(v0[0], v0[1]); w.y = cvt_pk_bf16(v0[2], v0[3]); w.z = cvt_pk_bf16(v1[0], v1[1]); w.w = cvt_pk_bf16(v1[2], v1[3]);
                    *(u32x4*)(rowp + bj * HALF) = w; } }
    }
};
struct MoeOrder {
    int nN, G, c, p_lo, np; int pc[8];
    __device__ __forceinline__ bool next(int i, Unit& u) const {
        const long L = (long)i * G + c; if (L >= (long)np * nN) return false;
        const int wgid = (int)L, nig = WGM * nN, gid = wgid / nig, fm = gid * WGM, gsz = (np - fm) < WGM ? (np - fm) : WGM;
        u.pm = p_lo + fm + ((wgid % nig) % gsz); u.pn = (wgid % nig) / gsz;
        int e = 0;
#pragma unroll
        for (int k = 1; k < 8; ++k) e += (u.pm >= pc[k]) ? 1 : 0;
        u.pb = e * nN + u.pn; return true;
    }
    __device__ __forceinline__ void a_ready(const Unit&) const {}
    __device__ __forceinline__ void done(const Unit&) const {}
};

template <class Epi, class Sched, bool ALIGN_EPI = false, bool SP2 = false>
__device__ __forceinline__ void gemm_phase(PG8_LAS unsigned char* lds, const Gemm g, const Sched& S, const Epi& E, int wv) {
    int tid_ = (wv << 6) | (int)__builtin_amdgcn_mbcnt_hi(~0u, __builtin_amdgcn_mbcnt_lo(~0u, 0u)); asm volatile("" : "+v"(tid_));
    const int tid = tid_, wid = __builtin_amdgcn_readfirstlane(tid >> 6), lane = tid & 63, wr = wid >> 2, wc = wid & 3, fr = lane & 15, fq = lane >> 4;
    constexpr bool HN = Epi::HALFN;
    constexpr bool F8 = Epi::F8;
    constexpr int ES = F8 ? 1 : 2;
    const int K = g.K, nt = K * ES / (BK * 2);
    unsigned voffA[2], voffB[2];
#pragma unroll
    for (int i = 0; i < 2; ++i) { int R, C; stage_rc(tid * 16 + i * 8192, R, C); const int Rb = Epi::PERM ? ((R & ~31) + perm32(R & 31)) : R;
        voffA[i] = (unsigned)(R * K * ES + C * 2); voffB[i] = (unsigned)(Rb * K * ES + C * 2); }
    const size_t kstep = (size_t)(BK * 2);
    const size_t hstep = (size_t)HALF * K * ES;
    const size_t tstep = 2 * hstep;
    const unsigned ldsw = (unsigned)wid * 1024u;
    const int aoff = lds_byte(wr * 64 + fr, fq * 8), boff = lds_byte(wc * 32 + fr, fq * 8);
#define PG8_SA(b, h) (((b) * 2 + (h)) * HTB)
#define PG8_SB(b, h) ((4 + (b) * 2 + (h)) * HTB)
#define PG8_STAGE(bufoff, gbase, voff) do { _Pragma("unroll") for (int _i = 0; _i < 2; ++_i) \
        __builtin_amdgcn_global_load_lds((const unsigned*)((const char*)(gbase) + (voff)[_i]), (PG8_LAS unsigned*)(lds + (bufoff) + ldsw + _i * 8192), 16, 0, 0); } while (0)
#define PG8_LDA(dst, b, h) do { if constexpr (F8) { _Pragma("unroll") for (int m = 0; m < 4; ++m) { const u32x4 lo_ = *(const PG8_LAS u32x4*)(lds + PG8_SA(b, h) + aoff + m * 2048), hi_ = *(const PG8_LAS u32x4*)(lds + PG8_SA(b, h) + aoff + m * 2048 + 1024); \
            dst##8[m] = __builtin_bit_cast(v8i32, __builtin_shufflevector(lo_, hi_, 0, 1, 2, 3, 4, 5, 6, 7)); } } \
        else { _Pragma("unroll") for (int m = 0; m < 4; ++m) _Pragma("unroll") for (int k = 0; k < 2; ++k) dst[m][k] = *(const PG8_LAS bf16x8*)(lds + PG8_SA(b, h) + aoff + m * 2048 + k * 1024); } } while (0)
#define PG8_LDB(dst, b, h) do { if constexpr (F8) { _Pragma("unroll") for (int n = 0; n < 2; ++n) { const u32x4 lo_ = *(const PG8_LAS u32x4*)(lds + PG8_SB(b, h) + boff + n * 2048), hi_ = *(const PG8_LAS u32x4*)(lds + PG8_SB(b, h) + boff + n * 2048 + 1024); \
            dst##8[n] = __builtin_bit_cast(v8i32, __builtin_shufflevector(lo_, hi_, 0, 1, 2, 3, 4, 5, 6, 7)); } } \
        else { _Pragma("unroll") for (int n = 0; n < 2; ++n) _Pragma("unroll") for (int k = 0; k < 2; ++k) dst[n][k] = *(const PG8_LAS bf16x8*)(lds + PG8_SB(b, h) + boff + n * 2048 + k * 1024); } } while (0)
#define PG8_MMA(ai, bj, At, Bt) do { __builtin_amdgcn_s_setprio(1); _Pragma("unroll") for (int m = 0; m < 4; ++m) _Pragma("unroll") for (int n = 0; n < 2; ++n) { \
        if constexpr (F8) { asm volatile("v_mfma_f32_16x16x128_f8f6f4 %0, %1, %2, %0" : "+v"(acc[ai][bj][m][n]) : "v"(Bt##8[n]), "v"(At##8[m])); } \
        else { _Pragma("unroll") for (int k = 0; k < 2; ++k) acc[ai][bj][m][n] = __builtin_amdgcn_mfma_f32_16x16x32_bf16(Bt[n][k], At[m][k], acc[ai][bj][m][n], 0, 0, 0); } } \
        __builtin_amdgcn_s_setprio(0); } while (0)
#define PG8_LDB1(dst, b, h) do { if constexpr (!HN) { PG8_LDB(dst, b, h); } } while (0)
#define PG8_MMA1(ai, bj, At, Bt) do { if constexpr (!HN) { PG8_MMA(ai, bj, At, Bt); } } while (0)
#define PG8_WAIT_V(n) asm volatile("s_waitcnt vmcnt(" #n ")" ::: "memory")
#define PG8_WAIT_L(n) asm volatile("s_waitcnt lgkmcnt(" #n ")" ::: "memory")
#define PG8_BAR __builtin_amdgcn_s_barrier()
#define PG8_SCHED __builtin_amdgcn_sched_barrier(0)
    Unit cur, nxt; int ui = 0;
    if (!S.next(0, cur)) return;
    f32x4 acc[2][2][4][2];
#pragma unroll
    for (int a = 0; a < 2; ++a)
#pragma unroll
        for (int b = 0; b < 2; ++b)
#pragma unroll
            for (int m = 0; m < 4; ++m)
#pragma unroll
                for (int n = 0; n < 2; ++n) acc[a][b][m][n] = (f32x4){0.f, 0.f, 0.f, 0.f};
    bf16x8 At[4][2], B0[2][2], B1[2][2];
    v8i32 At8[4], B08[2], B18[2];
    const char* cA = (const char*)g.A + (size_t)cur.pm * tstep; const char* cB = (const char*)g.Bt + (size_t)cur.pb * (HN ? hstep : tstep);
    S.a_ready(cur);
    if constexpr (SP2) {
        PG8_STAGE(PG8_SB(0, 0), cB, voffB); PG8_STAGE(PG8_SB(0, 1), cB + hstep, voffB); PG8_STAGE(PG8_SA(0, 0), cA, voffA); PG8_STAGE(PG8_SA(0, 1), cA + hstep, voffA);
        if (wr == 1) PG8_BAR;
        PG8_WAIT_V(2); PG8_BAR;
        PG8_STAGE(PG8_SB(1, 0), cB + kstep, voffB); PG8_STAGE(PG8_SA(1, 0), cA + kstep, voffA); PG8_STAGE(PG8_SB(1, 1), cB + hstep + kstep, voffB);
        PG8_WAIT_V(6); PG8_BAR;
    } else {
        PG8_STAGE(PG8_SB(0, 0), cB, voffB); PG8_STAGE(PG8_SA(0, 0), cA, voffA); PG8_STAGE(PG8_SB(0, 1), cB + hstep, voffB); PG8_STAGE(PG8_SA(0, 1), cA + hstep, voffA);
        if (wr == 1) PG8_BAR;
        PG8_WAIT_V(4); PG8_BAR;
        PG8_STAGE(PG8_SB(1, 0), cB + kstep, voffB); PG8_STAGE(PG8_SA(1, 0), cA + kstep, voffA); PG8_STAGE(PG8_SB(1, 1), cB + hstep + kstep, voffB);
        PG8_WAIT_V(6); PG8_BAR;
    }
    for (;;) {
        const bool has_next = S.next(ui + 1, nxt);
        const char* nA = has_next ? (const char*)g.A + (size_t)nxt.pm * tstep : cA; const char* nB = has_next ? (const char*)g.Bt + (size_t)nxt.pb * (HN ? hstep : tstep) : cB;
        for (int t = 0; t < nt; t += 2) {
            const bool last = (t == nt - 2);
            const char* a1 = cA + (size_t)(t + 1) * kstep;
            const char* a2 = last ? nA : cA + (size_t)(t + 2) * kstep; const char* b2 = last ? nB : cB + (size_t)(t + 2) * kstep;
            const char* a3 = a2 + kstep; const char* b3 = b2 + kstep;
            if (last && has_next) S.a_ready(nxt);
            if constexpr (SP2) {
            PG8_LDB(B0, 0, 0); PG8_LDB1(B1, 0, 1); PG8_SCHED; PG8_LDA(At, 0, 0); PG8_STAGE(PG8_SA(1, 1), a1 + hstep, voffA);
            PG8_WAIT_V(8); PG8_WAIT_L(0); PG8_BAR; PG8_MMA(0, 0, At, B0); PG8_MMA1(0, 1, At, B1); PG8_BAR; PG8_SCHED;
            PG8_LDA(At, 0, 1); PG8_STAGE(PG8_SB(0, 0), b2, voffB); PG8_STAGE(PG8_SB(0, 1), b2 + hstep, voffB); PG8_STAGE(PG8_SA(0, 0), a2, voffA);
            PG8_WAIT_V(8); PG8_WAIT_L(0); PG8_BAR; PG8_MMA(1, 0, At, B0); PG8_MMA1(1, 1, At, B1); PG8_BAR; PG8_SCHED;
            PG8_LDB(B0, 1, 0); PG8_LDB1(B1, 1, 1); PG8_SCHED; PG8_LDA(At, 1, 0); PG8_STAGE(PG8_SA(0, 1), a2 + hstep, voffA);
            PG8_WAIT_V(8); PG8_WAIT_L(0); PG8_BAR; PG8_MMA(0, 0, At, B0); PG8_MMA1(0, 1, At, B1); PG8_BAR; PG8_SCHED;
            PG8_LDA(At, 1, 1); PG8_STAGE(PG8_SB(1, 0), b3, voffB); PG8_STAGE(PG8_SB(1, 1), b3 + hstep, voffB); PG8_STAGE(PG8_SA(1, 0), a3, voffA);
            PG8_WAIT_V(8); PG8_WAIT_L(0); PG8_BAR; PG8_MMA(1, 0, At, B0); PG8_MMA1(1, 1, At, B1); PG8_BAR; PG8_SCHED;
            } else {
            PG8_LDB(B0, 0, 0); PG8_SCHED; PG8_LDA(At, 0, 0); PG8_STAGE(PG8_SA(1, 1), a1 + hstep, voffA);
            PG8_WAIT_L(8); PG8_BAR; PG8_WAIT_L(0); PG8_MMA(0, 0, At, B0); PG8_BAR; PG8_SCHED;
            PG8_LDB1(B1, 0, 1); PG8_STAGE(PG8_SB(0, 0), b2, voffB);
            PG8_BAR; PG8_WAIT_L(0); PG8_MMA1(0, 1, At, B1); PG8_BAR;
            PG8_LDA(At, 0, 1); PG8_STAGE(PG8_SA(0, 0), a2, voffA);
            PG8_BAR; PG8_WAIT_L(0); PG8_MMA(1, 0, At, B0); PG8_BAR; PG8_SCHED;
            PG8_STAGE(PG8_SB(0, 1), b2 + hstep, voffB);
            PG8_WAIT_V(6); PG8_BAR; PG8_MMA1(1, 1, At, B1); PG8_BAR;
            PG8_LDB(B0, 1, 0); PG8_SCHED; PG8_LDA(At, 1, 0); PG8_STAGE(PG8_SA(0, 1), a2 + hstep, voffA);
            PG8_WAIT_L(8); PG8_BAR; PG8_WAIT_L(0); PG8_MMA(0, 0, At, B0); PG8_BAR; PG8_SCHED;
            PG8_LDB1(B1, 1, 1); PG8_STAGE(PG8_SB(1, 0), b3, voffB);
            PG8_BAR; PG8_WAIT_L(0); PG8_MMA1(0, 1, At, B1); PG8_BAR;
            PG8_LDA(At, 1, 1); PG8_STAGE(PG8_SA(1, 0), a3, voffA);
            PG8_BAR; PG8_WAIT_L(0); PG8_MMA(1, 0, At, B0); PG8_BAR; PG8_SCHED;
            PG8_STAGE(PG8_SB(1, 1), b3 + hstep, voffB);
            PG8_WAIT_V(6); PG8_BAR; PG8_MMA1(1, 1, At, B1); PG8_BAR;
            }
        }
        if constexpr (F8) asm volatile("s_nop 15\n\ts_nop 15" ::: "memory");
        if constexpr (ALIGN_EPI) { if (wr == 0) PG8_BAR; }
        if constexpr (Epi::RWACC) { E.rw(acc, cur, wr, wc, fr, fq); S.done(cur); }
        else if constexpr (!Epi::AFTER_DRAIN) { E(acc, cur, wr, wc, fr, fq); S.done(cur); }
        if (!has_next) break;
        bool zero_acc = true; if constexpr (Epi::RWACC) zero_acc = E.restart(cur);
        if (zero_acc)
#pragma unroll
        for (int a = 0; a < 2; ++a)
#pragma unroll
            for (int b = 0; b < 2; ++b)
#pragma unroll
                for (int m = 0; m < 4; ++m)
#pragma unroll
                    for (int n = 0; n < 2; ++n) acc[a][b][m][n] = (f32x4){0.f, 0.f, 0.f, 0.f};
        cur = nxt; cA = nA; cB = nB; ++ui;
        if constexpr (ALIGN_EPI) { if (wr == 1) PG8_BAR; }
    }
    PG8_WAIT_V(0);
    if constexpr (!ALIGN_EPI) { if (wr == 0) PG8_BAR; }
    PG8_BAR;
    if constexpr (Epi::AFTER_DRAIN) { E.fused(acc, cur, wr, wc, fr, fq, lds, wid, lane); S.done(cur); }
#undef PG8_SA
#undef PG8_SB
#undef PG8_STAGE
#undef PG8_LDA
#undef PG8_LDB
#undef PG8_MMA
#undef PG8_LDB1
#undef PG8_MMA1
#undef PG8_WAIT_V
#undef PG8_WAIT_L
#undef PG8_BAR
#undef PG8_SCHED
}
}

#ifndef PG8_SP2
#define PG8_SP2 true
#endif
#ifndef PG8_ALIGN
#define PG8_ALIGN true
#endif
#ifndef MK_WGM
#define MK_WGM 4
#endif
#ifndef MK_DENSE_F8
#define MK_DENSE_F8 1
#endif
#ifndef MK_PER_PHASE
#define MK_PER_PHASE 0
#endif

constexpr int NWAVES = 8;
constexpr int D = 1024, BATCH = 4, SEQ = 8192, CTXL = 256, DEPTH = 2;
constexpr int TL = BATCH * SEQ, TC = BATCH * CTXL, TA = TL + TC;
constexpr int INC = 6912, ZMC = 3840, ZGC = 3072, BW = 512;
constexpr int FFD = 2816, FFE = 3584, NE = 8;
constexpr int MAXPAN = 264, PCH = 264, NCHUNK = 1;
constexpr float RMS_EPS = 1e-6f;
constexpr float SC_XG = 4.0f, SC_WGU = 32.0f, SC_H = 4.0f, SC_WDN = 64.0f;
constexpr int C_QA = 0, C_KA = 512, C_VA = 640, C_UX = 768, C_GB = 1280, C_GC = 1792, C_QN = 2304, C_KN = 2816, C_VN = 3328;

constexpr size_t MiB = 1u << 20;
constexpr size_t WS_CTL = 0, CTL_ZERO_BYTES = 1 * MiB;
constexpr size_t WS_MOD = 1 * MiB;
constexpr size_t WS_ROPE = WS_MOD + 256 * 1024;
constexpr size_t WS_SLABCNT = WS_MOD + 320 * 1024;
constexpr size_t WS_PCUM = WS_MOD + 384 * 1024;
constexpr size_t WS_TOKER = WS_MOD + 512 * 1024;
constexpr size_t WS_TOKG = WS_MOD + 768 * 1024;
constexpr size_t WS_TOKPOS = WS_MOD + 1024 * 1024;
constexpr size_t WS_HCTX = 4 * MiB;
constexpr size_t WS_WIN = 8 * MiB;
constexpr size_t WS_WBR = 35 * MiB;
constexpr size_t WS_WOUT = 41 * MiB;
constexpr size_t WS_WGUD = 45 * MiB;
constexpr size_t WS_WDND = 56 * MiB;
constexpr size_t WS_WGUM = 62 * MiB;
constexpr size_t WS_WDNM = 118 * MiB;
constexpr size_t WS_RS = 146 * MiB;
constexpr size_t WS_HX = 230 * MiB;
constexpr size_t WS_ZM = 296 * MiB;
constexpr size_t WS_ZG = 544 * MiB;
constexpr size_t WS_O = 742 * MiB;
constexpr size_t WS_XG = WS_ZM;
constexpr size_t WS_HM = WS_ZM + 132 * MiB;
constexpr size_t WS_XG8 = WS_O;
constexpr size_t WS_HX8 = 841 * MiB;
constexpr size_t WS_WING8 = 874 * MiB;
constexpr size_t WS_END = 880 * MiB;
static_assert(WS_WIN + (size_t)2 * INC * D * 2 <= WS_WBR && WS_WGUD + (size_t)2 * FFD * D * 2 <= WS_WDND && WS_WDND + (size_t)D * FFD * 2 <= WS_WGUM, "ws map (weights)");
static_assert(WS_WGUM + (size_t)NE * 2 * FFE * D <= WS_WDNM && WS_WDNM + (size_t)NE * D * FFE <= WS_RS && WS_RS + (size_t)TA * D * 2 <= WS_HX, "ws map (moe weights, residual stream)");
static_assert(WS_HX + (size_t)TA * D * 2 <= WS_ZM && WS_ZM + (size_t)TA * ZMC * 2 <= WS_ZG && WS_ZG + (size_t)TA * ZGC * 2 <= WS_O && WS_O + (size_t)3 * TA * BW * 2 <= WS_END, "ws map (activations)");
static_assert(WS_HM + (size_t)MAXPAN * 256 * FFE <= WS_O && WS_XG8 + (size_t)MAXPAN * 256 * D <= WS_END && (size_t)MAXPAN * 256 * D * 2 <= 132 * MiB && (size_t)TA * D * 4 <= 132 * MiB, "ws map (moe)");
constexpr int CW_BAR = 4096;

constexpr int RING_OFF = 0, RING_BYTES = 131072;
constexpr int LDSCTL_OFF = RING_BYTES, MISC_OFF = LDSCTL_OFF + 320;
constexpr int LDS_BYTES = 147456;

#define GAS __attribute__((address_space(1)))
#define LAS __attribute__((address_space(3)))
typedef unsigned short bf16;
typedef unsigned v4u __attribute__((ext_vector_type(4)));
typedef unsigned v2u __attribute__((ext_vector_type(2)));
typedef float f32x4 __attribute__((ext_vector_type(4)));
typedef float f32x2 __attribute__((ext_vector_type(2)));
#define LDS_WAIT() asm volatile("s_waitcnt lgkmcnt(0)" ::: "memory")
#define VM_WAIT() asm volatile("s_waitcnt vmcnt(0)" ::: "memory")
__device__ __forceinline__ unsigned f2bf(float f) { unsigned u = __builtin_bit_cast(unsigned, f); return (u + 0x7fffu + ((u >> 16) & 1u)) >> 16; }
__device__ __forceinline__ unsigned pk2(float lo, float hi) { return f2bf(lo) | (f2bf(hi) << 16); }
__device__ __forceinline__ float bflo(unsigned w) { return __uint_as_float(w << 16); }
__device__ __forceinline__ float bfhi(unsigned w) { return __uint_as_float(w & 0xffff0000u); }
__device__ __forceinline__ float bf2f(bf16 b) { return __uint_as_float(((unsigned)b) << 16); }

#define XB_TMO      128
#define XB_XCNT(j)  (256  + 64 * (j))
#define XB_XSUB(j)  (1280 + 64 * (j))
#define XB_XGEN(j)  (2304 + 64 * (j))
#define XB_TOP      3328
#define XB_TOPGEN   3392
#define XCD_BAR_WORDS 3456
#define XB_SPIN_CAP (1u << 21)

__device__ __forceinline__ unsigned xb_ld(unsigned* p)              { return __hip_atomic_load(p, __ATOMIC_RELAXED, __HIP_MEMORY_SCOPE_AGENT); }
__device__ __forceinline__ unsigned xb_add(unsigned* p, unsigned v) { return __hip_atomic_fetch_add(p, v, __ATOMIC_RELAXED, __HIP_MEMORY_SCOPE_AGENT); }
__device__ __forceinline__ unsigned xb_xcc_id() { return (unsigned)__builtin_amdgcn_s_getreg((3 << 11) | 20) & 0xFu; }
#define XB_SPIN(cond, bar) do { unsigned _sp = 0; while (cond) { __builtin_amdgcn_s_sleep(1); \
    if ((++_sp & 255u) == 0u) { if (xb_ld(&(bar)[XB_TMO])) break; if (_sp > XB_SPIN_CAP) { atomicAdd(&(bar)[XB_TMO], 1u); break; } } } } while (0)

struct XcdBarrier {
    unsigned* bar; unsigned x;
    volatile LAS unsigned* st;
    int w;
};

__device__ __forceinline__ XcdBarrier xcd_barrier_post(unsigned* bar, volatile LAS unsigned* st) {
    XcdBarrier b; b.bar = bar; b.x = xb_xcc_id(); b.st = st; b.w = 0;
    if (threadIdx.x == 0) (void)xb_add(&bar[XB_XCNT(b.x)], 1u);
    return b;
}
__device__ __forceinline__ void xcd_barrier_complete(unsigned* bar, unsigned x, unsigned& nloc, unsigned& nx) {
    const unsigned G = gridDim.x * gridDim.y * gridDim.z;
    unsigned sum, cnt, mine, sp = 0u;
    for (;;) {
        sum = 0u; cnt = 0u; mine = 0u;
#pragma unroll
        for (unsigned j = 0; j < 16; ++j) { const unsigned c = xb_ld(&bar[XB_XCNT(j)]); sum += c; cnt += (c > 0u) ? 1u : 0u; mine = (j == x) ? c : mine; }
        if (sum == G) break;
        __builtin_amdgcn_s_sleep(1);
        if ((++sp & 255u) == 0u) { if (xb_ld(&bar[XB_TMO])) break; if (sp > XB_SPIN_CAP) { atomicAdd(&bar[XB_TMO], 1u); break; } }
    }
    nloc = mine > 0u ? mine : 1u; nx = cnt > 0u ? cnt : 1u;
}

__device__ __forceinline__ void xcd_barrier(const XcdBarrier& b) {
    asm volatile("s_waitcnt vmcnt(0)" ::: "memory");
    __syncthreads();
    if (b.w == 0 && __builtin_amdgcn_mbcnt_hi(~0u, __builtin_amdgcn_mbcnt_lo(~0u, 0u)) == 0u) {
        unsigned* bar = b.bar; { GAS unsigned* bg_ = (GAS unsigned*)bar; asm volatile("" : "+s"(bg_)); bar = (unsigned*)bg_; }
        __builtin_amdgcn_s_waitcnt(0);
        unsigned nloc = b.st[0], nx = b.st[1];
        if (nloc == 0u) { xcd_barrier_complete(bar, b.x, nloc, nx); b.st[0] = nloc; b.st[1] = nx; }
        const unsigned old = xb_add(&bar[XB_XSUB(b.x)], 1u);
        const unsigned gen = old / nloc;
        if (old + 1u == (gen + 1u) * nloc) {
            __builtin_amdgcn_fence(__ATOMIC_RELEASE, "agent");
            asm volatile("s_waitcnt vmcnt(0)" ::: "memory");
            const unsigned og = xb_add(&bar[XB_TOP], 1u);
            const unsigned tg = og / nx;
            if (og + 1u == (tg + 1u) * nx) xb_add(&bar[XB_TOPGEN], 1u);
            else XB_SPIN(xb_ld(&bar[XB_TOPGEN]) == tg, bar);
            __builtin_amdgcn_fence(__ATOMIC_ACQUIRE, "agent");
            xb_add(&bar[XB_XGEN(b.x)], 1u);
            asm volatile("s_waitcnt vmcnt(0)" ::: "memory");
        } else {
            XB_SPIN(xb_ld(&bar[XB_XGEN(b.x)]) == gen, bar);
            __builtin_amdgcn_fence(__ATOMIC_ACQUIRE, "agent");
            asm volatile("s_waitcnt vmcnt(0)" ::: "memory");
        }
    }
    __syncthreads();
}

struct Frame {
    LAS unsigned char* lds;
    volatile LAS unsigned* MISC;
    unsigned* ctl;
    int vcu, G;
    int wv;
};
enum { I_X = 0, I_C, I_CTX, I_CCTX, I_WADA, I_BADA, I_GPREMIX, I_GPOSTMIX, I_GPREFFN, I_GPOSTFFN, I_WIN, I_BGATE, I_SINK, I_CONVW, I_RPB, I_WBRANCH, I_WOUT, I_WGUD, I_WDND, I_WROUTER, I_BROUTER, I_WGUM, I_WDNM };

__device__ __forceinline__ float wave_sum(float v) {
#pragma unroll
    for (int o = 1; o < 64; o <<= 1) v += __shfl_xor(v, o);
    return v;
}
__device__ __forceinline__ float wave_max(float v) {
#pragma unroll
    for (int o = 1; o < 64; o <<= 1) v = fmaxf(v, __shfl_xor(v, o));
    return v;
}

__device__ __forceinline__ void row_store_fp8(unsigned char* p, int lane, const f32x4 (&h)[4], float sc) {
#pragma unroll
    for (int c = 0; c < 2; ++c) { const f32x4 a = __builtin_elementwise_min(__builtin_elementwise_max(h[2 * c] * sc, (f32x4){-448.f, -448.f, -448.f, -448.f}), (f32x4){448.f, 448.f, 448.f, 448.f}), b = __builtin_elementwise_min(__builtin_elementwise_max(h[2 * c + 1] * sc, (f32x4){-448.f, -448.f, -448.f, -448.f}), (f32x4){448.f, 448.f, 448.f, 448.f});
        v2u w; w.x = pg8::pk4_fp8(a.x, a.y, a.z, a.w); w.y = pg8::pk4_fp8(b.x, b.y, b.z, b.w);
        *(v2u*)(p + 8 * (64 * c + lane)) = w; }
}

__device__ __forceinline__ void tr_item(const float* W, int N, int k0, int n0, bf16* WT, int Kd, int drow0, LAS float* scr, int lane) {
#pragma unroll
    for (int i = 0; i < 8; ++i) { const int kk = 8 * i + (lane >> 3), c4 = 4 * (lane & 7); const f32x4 v = *(const f32x4*)(W + (size_t)(k0 + kk) * N + n0 + c4);
        LAS float* d = scr + kk * 33 + c4; d[0] = v.x; d[1] = v.y; d[2] = v.z; d[3] = v.w; }
    LDS_WAIT(); asm volatile("" ::: "memory");
    const int c = lane & 7;
#pragma unroll
    for (int j = 0; j < 4; ++j) { const int n = (lane >> 3) + 8 * j; const LAS float* s = scr + (8 * c) * 33 + n;
        v4u o; o.x = pk2(s[0 * 33], s[1 * 33]); o.y = pk2(s[2 * 33], s[3 * 33]); o.z = pk2(s[4 * 33], s[5 * 33]); o.w = pk2(s[6 * 33], s[7 * 33]);
        *(v4u*)(WT + (size_t)(drow0 + n) * Kd + k0 + 8 * c) = o; }
    LDS_WAIT(); asm volatile("" ::: "memory");
}
__device__ __forceinline__ void tr_matrix_item(const float* W, int K, int N, int ff, bf16* WT, int item, LAS float* scr, int lane) {
    const int nblk = N / 32, kb = item / nblk, nb = item % nblk, n0 = 32 * nb;
    int drow0 = n0;
    if (ff > 0) { const int isu = n0 >= ff ? 1 : 0, nn = n0 - isu * ff; drow0 = 256 * (nn >> 7) + 128 * isu + (nn & 127); }
    tr_item(W, N, 64 * kb, n0, WT, K, drow0, scr, lane);
}

__device__ __forceinline__ void tr_item8(const float* W, int N, int k0, int n0, unsigned char* WT, int Kd, int drow0, float scale, LAS float* scr, int lane) {
#pragma unroll
    for (int i = 0; i < 8; ++i) { const int kk = 8 * i + (lane >> 3), c4 = 4 * (lane & 7); const f32x4 v = *(const f32x4*)(W + (size_t)(k0 + kk) * N + n0 + c4);
        LAS float* d = scr + kk * 33 + c4; d[0] = v.x; d[1] = v.y; d[2] = v.z; d[3] = v.w; }
    LDS_WAIT(); asm volatile("" ::: "memory");
    const int n = lane >> 1, kh = lane & 1; const LAS float* s = scr + (32 * kh) * 33 + n;
    unsigned w[8];
#pragma unroll
    for (int j = 0; j < 8; ++j) w[j] = pg8::pk4_fp8(s[(4 * j) * 33] * scale, s[(4 * j + 1) * 33] * scale, s[(4 * j + 2) * 33] * scale, s[(4 * j + 3) * 33] * scale);
    v4u* dst = (v4u*)(WT + (size_t)(drow0 + n) * Kd + k0 + 32 * kh);
    dst[0] = (v4u){w[0], w[1], w[2], w[3]}; dst[1] = (v4u){w[4], w[5], w[6], w[7]};
    LDS_WAIT(); asm volatile("" ::: "memory");
}
__device__ __forceinline__ void tr_matrix_item8(const float* W, int K, int N, int ff, unsigned char* WT, float scale, int item, LAS float* scr, int lane) {
    const int nblk = N / 32, kb = item / nblk, nb = item % nblk, n0 = 32 * nb;
    int drow0 = n0;
    if (ff > 0) { const int isu = n0 >= ff ? 1 : 0, nn = n0 - isu * ff; drow0 = 256 * (nn >> 7) + 128 * isu + (nn & 127); }
    tr_item8(W, N, 64 * kb, n0, WT, K, drow0, scale, scr, lane);
}

__device__ __forceinline__ void row_load(const float* p, int lane, f32x4 (&v)[4]) {
#pragma unroll
    for (int c = 0; c < 2; ++c) { const f32x4* r = (const f32x4*)(p + 8 * (64 * c + lane)); v[2 * c] = r[0]; v[2 * c + 1] = r[1]; }
}
__device__ __forceinline__ void row_load_bf16(const bf16* p, int lane, f32x4 (&v)[4]) {
#pragma unroll
    for (int c = 0; c < 2; ++c) { const v4u w = *(const v4u*)(p + 8 * (64 * c + lane));
        v[2 * c] = (f32x4){bflo(w.x), bfhi(w.x), bflo(w.y), bfhi(w.y)}; v[2 * c + 1] = (f32x4){bflo(w.z), bfhi(w.z), bflo(w.w), bfhi(w.w)}; }
}
__device__ __forceinline__ void row_store(float* p, int lane, const f32x4 (&v)[4]) {
#pragma unroll
    for (int c = 0; c < 2; ++c) { f32x4* r = (f32x4*)(p + 8 * (64 * c + lane)); r[0] = v[2 * c]; r[1] = v[2 * c + 1]; }
}
__device__ __forceinline__ float row_rrms(const f32x4 (&v)[4]) {
    float s = 0.f;
#pragma unroll
    for (int j = 0; j < 4; ++j) s += (v[j].x * v[j].x + v[j].y * v[j].y) + (v[j].z * v[j].z + v[j].w * v[j].w);
    return 1.0f / sqrtf(wave_sum(s) * (1.0f / D) + RMS_EPS);
}
__device__ __forceinline__ void vec_load(const float* p, int lane, f32x4 (&v)[4]) { row_load(p, lane, v); }
__device__ __forceinline__ void row_normmod(const f32x4 (&x)[4], float rr, const f32x4 (&g)[4], const f32x4 (&shift)[4], const f32x4 (&scale)[4], f32x4 (&h)[4]) {
#pragma unroll
    for (int j = 0; j < 4; ++j) h[j] = (x[j] * rr * g[j]) * (scale[j] + 1.0f) + shift[j];
}
__device__ __forceinline__ void row_store_bf16(bf16* p, int lane, const f32x4 (&h)[4]) {
#pragma unroll
    for (int c = 0; c < 2; ++c) { v4u w; w.x = pk2(h[2 * c].x, h[2 * c].y); w.y = pk2(h[2 * c].z, h[2 * c].w); w.z = pk2(h[2 * c + 1].x, h[2 * c + 1].y); w.w = pk2(h[2 * c + 1].z, h[2 * c + 1].w);
        *(v4u*)(p + 8 * (64 * c + lane)) = w; }
}

namespace at {
typedef short bf16x8 __attribute__((ext_vector_type(8)));
typedef short s16x4 __attribute__((ext_vector_type(4)));
typedef short v4i16_t __attribute__((ext_vector_type(4)));
typedef float f32x16 __attribute__((ext_vector_type(16)));
constexpr int NS = 4, PF = 3, SLOT = 16384;
constexpr int LDS_TAB = NS * SLOT + 1024;
constexpr int LDS_TT = LDS_TAB + 8 * 2048 + 1024;
constexpr int MAXT = 160;
constexpr float LOG2E = 1.4426950408889634f, C2 = 0.125f * LOG2E;
__device__ __forceinline__ unsigned cvtpk(float lo, float hi) { unsigned r; asm volatile("v_cvt_pk_bf16_f32 %0, %1, %2" : "=v"(r) : "v"(lo), "v"(hi)); return r; }
__device__ __forceinline__ float hmax(float v) { auto rr = __builtin_amdgcn_permlane32_swap(__float_as_uint(v), __float_as_uint(v), false, false); return fmaxf(__uint_as_float(rr[0]), __uint_as_float(rr[1])); }
__device__ __forceinline__ float hsum(float v) { auto rr = __builtin_amdgcn_permlane32_swap(__float_as_uint(v), __float_as_uint(v), false, false); return __uint_as_float(rr[0]) + __uint_as_float(rr[1]); }

__device__ __forceinline__ void glds16(const void* gsrc, unsigned lds_dst) { unsigned keep;
    asm volatile("s_mov_b32 %0, m0\n\ts_mov_b32 m0, %2\n\ts_nop 0\n\tglobal_load_lds_dwordx4 %1, off\n\ts_mov_b32 m0, %0" : "=&s"(keep) : "v"(gsrc), "s"(lds_dst) : "memory"); }
__device__ __forceinline__ void tile_issue(LAS unsigned char* slot, const bf16* ZMp, size_t row0, int kcol, int vcol, int wid, int lane) {
    const bf16* ksrc = ZMp + (row0 + lane) * ZMC + kcol + wid * 8;
    const bf16* vsrc = ZMp + (row0 + 16 * (wid & 3) + (lane >> 2)) * ZMC + vcol + (wid >> 2) * 32 + (lane & 3) * 8;
    const unsigned dst = (unsigned)__builtin_amdgcn_readfirstlane((int)(unsigned)(uintptr_t)slot + wid * 1024);
    glds16(ksrc, dst); glds16(vsrc, dst + 8192u);
}
__device__ __forceinline__ void qk_tile(f32x16& p0, f32x16& p1, const LAS unsigned char* Ks, const bf16x8 (&qr)[4], int r32, int hi) {
    const LAS unsigned char* kb = Ks + hi * 1024 + r32 * 16;
    bf16x8 kf[8];
#pragma unroll
    for (int d0 = 0; d0 < 4; ++d0) { kf[2 * d0] = *(const LAS bf16x8*)(kb + d0 * 2048); kf[2 * d0 + 1] = *(const LAS bf16x8*)(kb + d0 * 2048 + 512); }
    __builtin_amdgcn_sched_barrier(0);
#pragma unroll
    for (int r = 0; r < 16; ++r) { p0[r] = 0.f; p1[r] = 0.f; }
#pragma unroll
    for (int d0 = 0; d0 < 4; ++d0) {
        p0 = __builtin_amdgcn_mfma_f32_32x32x16_bf16(kf[2 * d0], qr[d0], p0, 0, 0, 0);
        p1 = __builtin_amdgcn_mfma_f32_32x32x16_bf16(kf[2 * d0 + 1], qr[d0], p1, 0, 0, 0);
    }
}
__device__ __forceinline__ s16x4 vtr(const LAS unsigned char* p) { return __builtin_bit_cast(s16x4, __builtin_amdgcn_ds_read_tr16_b64_v4i16((LAS v4i16_t*)p)); }
template <int LV> __device__ __forceinline__ constexpr bool live0(int r) { return LV == 2 ? r >= 12 : true; }
template <int LV> __device__ __forceinline__ constexpr bool live1(int r) { return LV == 1 ? r < 4 : true; }
template <bool RAW, int LV, int VAR = 0>
__device__ __forceinline__ void sm_pv(f32x16& x0, f32x16& x1, float& m, float& l, f32x16 (&o)[2], const LAS unsigned char* Vs, int lane, int hi) {
    if (VAR == 2) { l += x0[0] + x1[15];
        bf16x8 pw_[4]; unsigned w_[16];
#pragma unroll
        for (int i = 0; i < 8; ++i) { w_[i] = cvtpk(x0[2 * i], x0[2 * i + 1]); w_[8 + i] = cvtpk(x1[2 * i], x1[2 * i + 1]); }
#pragma unroll
        for (int k = 0; k < 4; ++k) { typedef unsigned u32x4_ __attribute__((ext_vector_type(4))); u32x4_ t; t.x = w_[4 * k]; t.y = w_[4 * k + 1]; t.z = w_[4 * k + 2]; t.w = w_[4 * k + 3]; pw_[k] = __builtin_bit_cast(bf16x8, t); }
        const LAS unsigned char* vb_ = Vs + ((lane >> 4) & 1) * 32 + (lane & 3) * 8 + (4 * hi + ((lane & 15) >> 2)) * 64;
#pragma unroll
        for (int d0 = 0; d0 < 2; ++d0)
#pragma unroll
            for (int ks = 0; ks < 4; ++ks) { if ((LV == 1 && ks == 3) || (LV == 2 && ks == 0)) continue;
                const s16x4 lo = vtr(vb_ + d0 * 4096 + ks * 1024), hh = vtr(vb_ + d0 * 4096 + ks * 1024 + 512);
                const bf16x8 vf = (bf16x8){lo[0], lo[1], lo[2], lo[3], hh[0], hh[1], hh[2], hh[3]};
                o[d0] = __builtin_amdgcn_mfma_f32_32x32x16_bf16(vf, pw_[ks], o[d0], 0, 0, 0); }
        return; }
    if (VAR == 3) { l += x0[0] + x1[15] + x0[7] + x1[3]; o[0][0] += x0[1]; o[1][0] += x1[1]; return; }
    float rm = -INFINITY;
#pragma unroll
    for (int r = 0; r < 16; ++r) { if (live0<LV>(r)) rm = fmaxf(rm, x0[r]); if (live1<LV>(r)) rm = fmaxf(rm, x1[r]); }
    rm = hmax(rm);
    const float mn = fmaxf(m, RAW ? rm * C2 : rm);
    { const float sc = __builtin_amdgcn_exp2f(m - mn); l *= sc;
#pragma unroll
      for (int r = 0; r < 16; ++r) { o[0][r] *= sc; o[1][r] *= sc; } }
    m = mn;
    float sum = 0.f;
#pragma unroll
    for (int r = 0; r < 16; ++r) {
        if (live0<LV>(r)) { x0[r] = __builtin_amdgcn_exp2f(RAW ? __builtin_fmaf(x0[r], C2, -mn) : x0[r] - mn); sum += x0[r]; } else x0[r] = 0.f;
        if (live1<LV>(r)) { x1[r] = __builtin_amdgcn_exp2f(RAW ? __builtin_fmaf(x1[r], C2, -mn) : x1[r] - mn); sum += x1[r]; } else x1[r] = 0.f;
    }
    l += sum;
    bf16x8 pw[4];
    { unsigned w[16];
#pragma unroll
      for (int i = 0; i < 8; ++i) { w[i] = cvtpk(x0[2 * i], x0[2 * i + 1]); w[8 + i] = cvtpk(x1[2 * i], x1[2 * i + 1]); }
#pragma unroll
      for (int k = 0; k < 4; ++k) { typedef unsigned u32x4_ __attribute__((ext_vector_type(4))); u32x4_ t; t.x = w[4 * k]; t.y = w[4 * k + 1]; t.z = w[4 * k + 2]; t.w = w[4 * k + 3]; pw[k] = __builtin_bit_cast(bf16x8, t); } }
    const LAS unsigned char* vb = Vs + ((lane >> 4) & 1) * 32 + (lane & 3) * 8 + (4 * hi + ((lane & 15) >> 2)) * 64;
    s16x4 vlo[8], vhh[8];
    __builtin_amdgcn_sched_barrier(0);
#pragma unroll
    for (int d0 = 0; d0 < 2; ++d0)
#pragma unroll
        for (int ks = 0; ks < 4; ++ks) { if ((LV == 1 && ks == 3) || (LV == 2 && ks == 0)) continue;
            vlo[d0 * 4 + ks] = vtr(vb + d0 * 4096 + ks * 1024); vhh[d0 * 4 + ks] = vtr(vb + d0 * 4096 + ks * 1024 + 512); }
    __builtin_amdgcn_sched_barrier(0);
#pragma unroll
    for (int d0 = 0; d0 < 2; ++d0)
#pragma unroll
        for (int ks = 0; ks < 4; ++ks) {
            if ((LV == 1 && ks == 3) || (LV == 2 && ks == 0)) continue;
            const s16x4 lo = vlo[d0 * 4 + ks], hh = vhh[d0 * 4 + ks];
            const bf16x8 vf = (bf16x8){lo[0], lo[1], lo[2], lo[3], hh[0], hh[1], hh[2], hh[3]};
            o[d0] = __builtin_amdgcn_mfma_f32_32x32x16_bf16(vf, pw[ks], o[d0], 0, 0, 0);
        }
}
__device__ __forceinline__ void o_store(const f32x16 (&o)[2], float l, bf16* orow, int hi) {
    const float inv = __builtin_amdgcn_rcpf(hsum(l));
#pragma unroll
    for (int d0 = 0; d0 < 2; ++d0)
#pragma unroll
        for (int gp = 0; gp < 2; ++gp) {
            unsigned w[2][2];
#pragma unroll
            for (int k = 0; k < 2; ++k) { const int g = 2 * gp + k; w[k][0] = cvtpk(o[d0][4 * g] * inv, o[d0][4 * g + 1] * inv); w[k][1] = cvtpk(o[d0][4 * g + 2] * inv, o[d0][4 * g + 3] * inv); }
            unsigned rcv[2];
#pragma unroll
            for (int i = 0; i < 2; ++i) { const unsigned snd = hi ? w[0][i] : w[1][i];
                auto rr = __builtin_amdgcn_permlane32_swap(snd, snd, false, false); rcv[i] = hi ? rr[0] : rr[1]; }
            v4u st; if (hi) { st.x = rcv[0]; st.y = rcv[1]; st.z = w[1][0]; st.w = w[1][1]; } else { st.x = w[0][0]; st.y = w[0][1]; st.z = rcv[0]; st.w = rcv[1]; }
            *(v4u*)(orow + 32 * d0 + 16 * gp + 8 * hi) = st;
        }
}
#define AT_WAIT_BAR(N) asm volatile("s_waitcnt vmcnt(" #N ")\n\ts_barrier" ::: "memory")

struct UDesc { int kind, b, hh, blk, cq, nw, lo; };
__device__ __forceinline__ UDesc unit_desc(int i, int vcu, int UPW, bool ctx_out) {
    UDesc d; d.kind = -1; d.b = 0; d.hh = 0; d.blk = 0; d.cq = 0; d.nw = 0; d.lo = 0;
    if (i < 2 * UPW) { const int u = vcu * UPW + (i < UPW ? i : i - UPW); if (u >= 1024) return d; d.kind = i < UPW ? 0 : 1; d.b = u >> 8;
        if (d.kind == 0) { d.hh = (u >> 5) & 7; d.blk = u & 31; } else { d.hh = (u >> 7) & 1; d.blk = u & 127; } }
    else if (i == 2 * UPW) { if (!ctx_out || vcu >= 64) return d; d.cq = 1;
        if (vcu < 32) { d.kind = 1; d.b = vcu >> 3; d.hh = (vcu >> 2) & 1; d.blk = vcu & 3; } else { d.kind = 0; d.b = (vcu - 32) >> 3; d.hh = (vcu - 32) & 7; d.blk = 0; } }
    else return d;
    if (!d.cq) {
        if (d.kind == 1) { d.lo = max(0, 2 - d.blk); d.nw = min(4, 129 - d.blk) - d.lo + 1; }
        else { d.lo = min(max(4 * d.blk - 4, 0), 120); d.nw = min(max(4 * d.blk - 1, 0), 120) + 7 - d.lo + 1; }
    }
    return d;
}
__device__ __forceinline__ void tile_src(const UDesc& d, int t, int& row0, int& cols) {
    const int kcol = d.kind == 1 ? C_KA + d.hh * 64 : C_KN + d.hh * 64, vcol = d.kind == 1 ? C_VA + d.hh * 64 : C_VN + d.hh * 64;
    cols = kcol | (vcol << 16);
    if (t < d.nw) row0 = d.kind == 1 ? d.b * SEQ + 64 * d.blk - 128 + 64 * (d.lo + t) : d.b * SEQ + 64 * (d.lo + t);
    else row0 = TL + d.b * CTXL + 64 * (t - d.nw);
}
__device__ __forceinline__ size_t q_row(const UDesc& d, int wid, int r32) {
    if (d.kind == 1) { const int qrel = 32 * (wid >> 2) + r32; return d.cq ? (size_t)TL + (size_t)d.b * CTXL + 64 * d.blk + qrel : (size_t)d.b * SEQ + 64 * d.blk + qrel; }
    const int pair = wid >> 1, c = 32 * (wid & 1) + r32;
    return d.cq ? (size_t)TL + (size_t)d.b * CTXL + 64 * pair + c : (size_t)d.b * SEQ + (size_t)(4 * d.blk + pair) * 64 + c;
}
__device__ __forceinline__ void q_load(const UDesc& d, const bf16* ZMp, int wid, int r32, int hi, bf16x8 (&qr)[4]) {
    const int qcol = d.kind == 1 ? C_QA + (d.hh * 4 + (wid & 3)) * 64 : C_QN + d.hh * 64;
    const bf16* p = ZMp + q_row(d, wid, r32) * ZMC + qcol + 8 * hi;
#pragma unroll
    for (int d0 = 0; d0 < 4; ++d0) qr[d0] = *(const bf16x8*)(p + 16 * d0);
}

template <int VAR = 0>
__device__ __forceinline__ void attn_phase(LAS unsigned char* lds, const bf16* ZMp, bf16* OAp, bf16* OCp, const float* sinkp, const float* rpbl, int vcu, int G, bool ctx_out, int tid, int wid, int lane) {
    const int r32 = lane & 31, hi = lane >> 5;
    const int UPW = (1024 + G - 1) / G, NU = 2 * UPW + 1;
    LAS int* tt = (LAS int*)(lds + LDS_TT);
    int Ttot = 0;
    for (int i = 0; i < NU; ++i) { const UDesc d = unit_desc(i, vcu, UPW, ctx_out); if (d.kind < 0) continue; const int nt = d.nw + 4;
        for (int t = tid; t < nt; t += NWAVES * 64) { int row0, cols; tile_src(d, t, row0, cols); if (Ttot + t < MAXT) { tt[2 * (Ttot + t)] = row0; tt[2 * (Ttot + t) + 1] = cols; } }
        Ttot += nt; }
    if (Ttot > MAXT) Ttot = MAXT;
    if (tid < 8) ((LAS float*)(lds + LDS_TT + MAXT * 8))[tid] = sinkp[tid] * LOG2E;
    for (int u = tid; u < 8 * 480; u += NWAVES * 64) { const int h = u / 480, e = u - 480 * h, dr = e >> 5, dc = e & 31; ((LAS float*)(lds + LDS_TAB))[h * 512 + e] = dc < 31 ? rpbl[(h * 15 + dr) * 31 + dc] * LOG2E : 0.f; }
    asm volatile("s_waitcnt lgkmcnt(0)\n\ts_barrier" ::: "memory");
#define AT_ISSUE(T) do { const int row0_ = __builtin_amdgcn_readfirstlane(tt[2 * (T)]), cols_ = __builtin_amdgcn_readfirstlane(tt[2 * (T) + 1]); \
        tile_issue(lds + ((T) & (NS - 1)) * SLOT, ZMp, (size_t)row0_, cols_ & 0xffff, cols_ >> 16, wid, lane); } while (0)
    for (int T = 0; T < PF && T < Ttot; ++T) AT_ISSUE(T);
    int Tb = 0;
    bf16x8 qn[4];
    { int i0 = 0; UDesc d0 = unit_desc(0, vcu, UPW, ctx_out); while (d0.kind < 0 && i0 + 1 < NU) { ++i0; d0 = unit_desc(i0, vcu, UPW, ctx_out); } if (d0.kind >= 0) q_load(d0, ZMp, wid, r32, hi, qn); }
    for (int i = 0; i < NU; ++i) {
        const UDesc d = unit_desc(i, vcu, UPW, ctx_out); if (d.kind < 0) continue;
        bf16x8 qr[4];
#pragma unroll
        for (int k = 0; k < 4; ++k) qr[k] = qn[k];
        { int j = i + 1; UDesc dn = unit_desc(j, vcu, UPW, ctx_out); while (dn.kind < 0 && j + 1 < NU) { ++j; dn = unit_desc(j, vcu, UPW, ctx_out); } if (dn.kind < 0) dn = d; q_load(dn, ZMp, wid, r32, hi, qn); }
        const int NT = d.nw + 4;
        f32x16 o[2];
#pragma unroll
        for (int r = 0; r < 16; ++r) { o[0][r] = 0.f; o[1][r] = 0.f; }
        float m, l;
        if (d.kind == 1) {
            const int head = d.hh * 4 + (wid & 3), qrel = 32 * (wid >> 2) + r32;
            m = ((const LAS float*)(lds + LDS_TT + MAXT * 8))[head]; l = (hi == 0) ? 1.0f : 0.0f;
            int t = 0;
            do {
                const int T = Tb + t, outst = min(Ttot, T + PF) - (T + 1);
                if (outst >= 2) AT_WAIT_BAR(4); else if (outst == 1) AT_WAIT_BAR(2); else AT_WAIT_BAR(0);
                if (t == NT - 1) asm volatile("" : "+v"(qn[0]), "+v"(qn[1]), "+v"(qn[2]), "+v"(qn[3]));
                if (VAR != 5 && T + PF < Ttot) AT_ISSUE(T + PF);
                const LAS unsigned char* sl = lds + (T & (NS - 1)) * SLOT;
                f32x16 x0, x1; if (VAR == 4) { for (int r_ = 0; r_ < 16; ++r_) { x0[r_] = __builtin_bit_cast(float, (int)qr[r_ & 3][0] << 16) ; x1[r_] = x0[r_] * 0.5f; } } else qk_tile(x0, x1, sl, qr, r32, hi);
                const int j = d.lo + t;
                if (t < d.nw && (j == 0 || j == 4)) {
                    const int dq = qrel + 128 - 64 * j - 4 * hi;
#pragma unroll
                    for (int r = 0; r < 16; ++r) { const int dd = dq - ((r & 3) + 8 * (r >> 2));
                        x0[r] = (dd <= 128 && dd >= -128) ? x0[r] * C2 : -INFINITY; x1[r] = (dd - 32 <= 128 && dd - 32 >= -128) ? x1[r] * C2 : -INFINITY; }
                    sm_pv<false, 0, VAR>(x0, x1, m, l, o, sl + 8192, lane, hi);
                } else sm_pv<true, 0, VAR>(x0, x1, m, l, o, sl + 8192, lane, hi);
            } while (++t < NT);
            o_store(o, l, OAp + q_row(d, wid, r32) * BW + head * 64, hi);
        } else {
            const int half = wid & 1, c = 32 * half + r32, r = 4 * d.blk + (wid >> 1);
            const int r0w = min(max(r - 4, 0), 120), c0 = min(max(c - 8, 0), 48);
            const LAS float* tab = (const LAS float*)(lds + LDS_TAB + d.hh * 2048);
            unsigned vm = 0u;
#pragma unroll
            for (int r_ = 0; r_ < 16; ++r_) { const int kc = (r_ & 3) + 8 * (r_ >> 2) + 4 * hi; vm |= ((unsigned)(kc - c0) < 16u ? 1u : 0u) << r_; vm |= ((unsigned)(kc + 32 - c0) < 16u ? 1u : 0u) << (16 + r_); }
            m = -1e30f; l = 0.f;
            int t = 0;
            do {
                const int T = Tb + t, outst = min(Ttot, T + PF) - (T + 1);
                if (outst >= 2) AT_WAIT_BAR(4); else if (outst == 1) AT_WAIT_BAR(2); else AT_WAIT_BAR(0);
                if (t == NT - 1) asm volatile("" : "+v"(qn[0]), "+v"(qn[1]), "+v"(qn[2]), "+v"(qn[3]));
                if (VAR != 5 && T + PF < Ttot) AT_ISSUE(T + PF);
                const int kr = d.lo + t;
                if (t < d.nw && (kr < r0w || kr > r0w + 7)) continue;
                const LAS unsigned char* sl = lds + (T & (NS - 1)) * SLOT;
                f32x16 x0, x1; if (VAR == 4) { for (int r_ = 0; r_ < 16; ++r_) { x0[r_] = __builtin_bit_cast(float, (int)qr[r_ & 3][0] << 16) ; x1[r_] = x0[r_] * 0.5f; } } else qk_tile(x0, x1, sl, qr, r32, hi);
                if (t < d.nw) {
                    const LAS float* tb = tab + (kr - r + 7) * 32 + (4 * hi - c + 15);
                    if (half == 0) {
                        float b0[16], b1[4];
#pragma unroll
                        for (int r_ = 0; r_ < 16; ++r_) { const int rr = (r_ & 3) + 8 * (r_ >> 2); b0[r_] = tb[rr]; if (r_ < 4) b1[r_] = tb[rr + 32]; }
#pragma unroll
                        for (int r_ = 0; r_ < 16; ++r_) {
                            x0[r_] = ((vm >> r_) & 1u) ? __builtin_fmaf(x0[r_], C2, b0[r_]) : -INFINITY;
                            if (r_ < 4) x1[r_] = ((vm >> (16 + r_)) & 1u) ? __builtin_fmaf(x1[r_], C2, b1[r_]) : -INFINITY; }
                        sm_pv<false, 1, VAR>(x0, x1, m, l, o, sl + 8192, lane, hi);
                    } else {
                        float b0[4], b1[16];
#pragma unroll
                        for (int r_ = 0; r_ < 16; ++r_) { const int rr = (r_ & 3) + 8 * (r_ >> 2); if (r_ >= 12) b0[r_ - 12] = tb[rr]; b1[r_] = tb[rr + 32]; }
#pragma unroll
                        for (int r_ = 0; r_ < 16; ++r_) {
                            if (r_ >= 12) x0[r_] = ((vm >> r_) & 1u) ? __builtin_fmaf(x0[r_], C2, b0[r_ - 12]) : -INFINITY;
                            x1[r_] = ((vm >> (16 + r_)) & 1u) ? __builtin_fmaf(x1[r_], C2, b1[r_]) : -INFINITY; }
                        sm_pv<false, 2, VAR>(x0, x1, m, l, o, sl + 8192, lane, hi);
                    }
                } else sm_pv<true, 0, VAR>(x0, x1, m, l, o, sl + 8192, lane, hi);
            } while (++t < NT);
            o_store(o, l, OCp + q_row(d, wid, r32) * BW + d.hh * 64, hi);
        }
        Tb += NT;
    }
    AT_WAIT_BAR(0);
#undef AT_ISSUE
}
}

constexpr int PH_PER_LAYER = 17, NPHASES = 1 + DEPTH * PH_PER_LAYER;
struct Args { const float* in[23]; float* out; unsigned char* ws; int ph_lo, ph_hi; };
typedef __attribute__((address_space(4))) const Args CArgs;
__global__ void __launch_bounds__(NWAVES * 64, 2) mk_fwd(Args args) {
    extern __shared__ __attribute__((aligned(16))) unsigned char lds[];
    Frame F;
    F.lds = (LAS unsigned char*)lds;
    F.MISC = (volatile LAS unsigned*)(F.lds + MISC_OFF);
    F.G = gridDim.x; { const int bx = blockIdx.x; F.vcu = (F.G % 8 == 0) ? (bx % 8) * (F.G / 8) + bx / 8 : bx; }
    F.ctl = (unsigned*)(args.ws + WS_CTL);
    for (int u = threadIdx.x; u < (LDS_BYTES - LDSCTL_OFF) / 4; u += NWAVES * 64) ((LAS unsigned*)(F.lds + LDSCTL_OFF))[u] = 0u;
    { int wv_ = __builtin_amdgcn_readfirstlane((int)(threadIdx.x >> 6)); asm volatile("" : "+s"(wv_)); F.wv = wv_; }
    __syncthreads();
    const int lo = args.ph_lo, hi = args.ph_hi;
    const bool fused = (hi - lo) > 1;
    XcdBarrier bar; bar.bar = F.ctl + CW_BAR; bar.x = 0; bar.st = nullptr; bar.w = F.wv;
    if (fused) { bar = xcd_barrier_post(F.ctl + CW_BAR, F.MISC + 8); bar.w = F.wv; }
#ifndef MK_MASK
#define MK_MASK 0xFFFFFFFFu
#endif
#define SLOT(k) ((k) == 0 ? 0 : (((k) - 1) % PH_PER_LAYER) + 1)
#define IN(k) (((MK_MASK >> SLOT(k)) & 1u) && lo <= (k) && (k) < hi)
#define GRID_BAR() do { if (fused) xcd_barrier(bar); } while (0)
    const int NGW = F.G * NWAVES;
#define PHASE_ENTER() GAS unsigned char* wsg_ = (GAS unsigned char*)args.ws; asm volatile("" : "+s"(wsg_)); unsigned char* ws = (unsigned char*)wsg_; float* outp = (float*)(GAS float*)args.out; (void)outp; const CArgs* ka = (const CArgs*)__builtin_amdgcn_kernarg_segment_ptr(); asm volatile("" : "+s"(ka)); \
    int tid_ = (F.wv << 6) | (int)__builtin_amdgcn_mbcnt_hi(~0u, __builtin_amdgcn_mbcnt_lo(~0u, 0u)); asm volatile("" : "+v"(tid_)); const int lane = tid_ & 63; const int wave = __builtin_amdgcn_readfirstlane(tid_ >> 6); const int gw = F.vcu * NWAVES + wave; (void)gw; (void)lane; (void)ws; (void)ka;
#define INP(i) ((const float*)(const GAS float*)ka->in[i])
#define MOD ((float*)(GAS float*)(ws + WS_MOD))
#define ROPE ((float*)(GAS float*)(ws + WS_ROPE))
#define SLABCNT ((int*)(GAS int*)(ws + WS_SLABCNT))
#define PCUM ((int*)(GAS int*)(ws + WS_PCUM))
#define TOKER ((int*)(GAS int*)(ws + WS_TOKER))
#define TOKG ((float*)(GAS float*)(ws + WS_TOKG))
#define TOKPOS ((int*)(GAS int*)(ws + WS_TOKPOS))
#define HCTX ((float*)(GAS float*)(ws + WS_HCTX))
#define RS ((bf16*)(GAS bf16*)(ws + WS_RS))
#define W_IN ((bf16*)(GAS bf16*)(ws + WS_WIN))
#define W_BR ((bf16*)(GAS bf16*)(ws + WS_WBR))
#define W_OUT ((bf16*)(GAS bf16*)(ws + WS_WOUT))
#define W_GUD ((bf16*)(GAS bf16*)(ws + WS_WGUD))
#define W_DND ((bf16*)(GAS bf16*)(ws + WS_WDND))
#define W_GUM8 ((unsigned char*)(GAS unsigned char*)(ws + WS_WGUM))
#define W_DNM8 ((unsigned char*)(GAS unsigned char*)(ws + WS_WDNM))
#define HX ((bf16*)(GAS bf16*)(ws + WS_HX))
#define ZM ((bf16*)(GAS bf16*)(ws + WS_ZM))
#define ZG ((bf16*)(GAS bf16*)(ws + WS_ZG))
#define OA ((bf16*)(GAS bf16*)(ws + WS_O))
#define OB (OA + (size_t)TA * BW)
#define OC (OA + (size_t)2 * TA * BW)
#define SB ((float*)(GAS float*)(ws + WS_ZM))
#define Y16 ((bf16*)(GAS bf16*)(ws + WS_ZG))
#define HD ((bf16*)(GAS bf16*)(ws + WS_ZM))
#define XG ((bf16*)(GAS bf16*)(ws + WS_XG))
#define HM8 ((unsigned char*)(GAS unsigned char*)(ws + WS_HM))
#define XG8 ((unsigned char*)(GAS unsigned char*)(ws + WS_XG8))
#define HX8 ((unsigned char*)(GAS unsigned char*)(ws + WS_HX8))
#define W_ING8 ((unsigned char*)(GAS unsigned char*)(ws + WS_WING8))

    if (IN(0)) {
        PHASE_ENTER();
        {
            LAS float* scv = (LAS float*)(F.lds + RING_OFF);
            LAS float* red = scv + 5 * 1024;
            for (int u = tid_; u < 5 * 1024; u += NWAVES * 64) { const int bb = u >> 10, k = u & 1023; const float cv = bb < 4 ? INP(I_C)[bb * 1024 + k] : INP(I_CCTX)[k]; scv[u] = cv / (1.0f + __expf(-cv)); }
            __syncthreads();
            for (int it = blockIdx.x; it < 2 * 96; it += F.G) {
                const int l = it / 96, n = (it % 96) * 64 + lane;
                const float* wp = INP(I_WADA) + (size_t)l * D * 6144 + n;
                float a0 = 0.f, a1 = 0.f, a2 = 0.f, a3 = 0.f, a4 = 0.f;
                const int kb = wave * 128;
#pragma unroll 16
                for (int k = 0; k < 128; ++k) { const float w = wp[(size_t)(kb + k) * 6144];
                    a0 += scv[kb + k] * w; a1 += scv[1024 + kb + k] * w; a2 += scv[2048 + kb + k] * w; a3 += scv[3072 + kb + k] * w; a4 += scv[4096 + kb + k] * w; }
                red[(wave * 5 + 0) * 64 + lane] = a0; red[(wave * 5 + 1) * 64 + lane] = a1; red[(wave * 5 + 2) * 64 + lane] = a2; red[(wave * 5 + 3) * 64 + lane] = a3; red[(wave * 5 + 4) * 64 + lane] = a4;
                __syncthreads();
                if (tid_ < 320) { const int bb = tid_ >> 6, nn = tid_ & 63; float s = 0.f;
#pragma unroll
                    for (int w = 0; w < 8; ++w) s += red[(w * 5 + bb) * 64 + nn];
                    const int col = (it % 96) * 64 + nn;
                    MOD[((size_t)l * 5 + bb) * 6144 + col] = s + INP(I_BADA)[l * 6144 + col]; }
                __syncthreads();
            }
        }
        if (blockIdx.x == F.G - 1) {
            for (int u = tid_; u < 192 * 16; u += NWAVES * 64) { const int idx = u >> 4, i = u & 15; const float pos = (float)(idx < 128 ? idx : idx - 128);
                const float inv = 1.0f / powf(10000.0f, (float)(2 * i) / 32.0f); const float ang = pos * inv;
                ROPE[2 * u] = cosf(ang); ROPE[2 * u + 1] = sinf(ang); }
        }
        __syncthreads();
        {
            LAS float* scr = (LAS float*)(F.lds + RING_OFF + wave * 16384);
            constexpr int I_IN = (D / 64) * (INC / 32), I_BR = (BW / 64) * (D / 32), I_OUT = (D / 64) * (D / 32), I_GUD = (D / 64) * (2 * FFD / 32), I_DND = (FFD / 64) * (D / 32),
                          I_GUM = (D / 64) * (2 * FFE / 32), I_DNM = (FFE / 64) * (D / 32);
            constexpr int NITEMS = 2 * I_IN + 6 * I_BR + 2 * I_OUT + I_GUD + I_DND + NE * I_GUM + NE * I_DNM;
            for (int it = gw; it < NITEMS; it += NGW) {
                int r = it;
                if (r < 2 * I_IN) { const int l = r / I_IN, it2 = r % I_IN, n0 = 32 * (it2 % (INC / 32));
                    if (MK_GATE_F8 == 2) { tr_item8(INP(I_WIN) + (size_t)l * D * INC, INC, 64 * (it2 / (INC / 32)), n0, (unsigned char*)W_IN + (size_t)l * INC * D, D, n0, SC_WGU, scr, lane); continue; }
                    if (!MK_GATE_F8 || n0 < ZMC) tr_matrix_item(INP(I_WIN) + (size_t)l * D * INC, D, INC, 0, W_IN + (size_t)l * INC * D, it2, scr, lane);
                    if (MK_GATE_F8 && n0 >= ZMC) tr_item8(INP(I_WIN) + (size_t)l * D * INC, INC, 64 * (it2 / (INC / 32)), n0, W_ING8 + (size_t)l * ZGC * D, D, n0 - ZMC, SC_WGU, scr, lane);
                    continue; } r -= 2 * I_IN;
                if (r < 6 * I_BR) { const int q = r / I_BR; tr_matrix_item(INP(I_WBRANCH) + (size_t)q * BW * D, BW, D, 0, W_BR + (size_t)q * D * BW, r % I_BR, scr, lane); continue; } r -= 6 * I_BR;
                if (r < 2 * I_OUT) { const int l = r / I_OUT; tr_matrix_item(INP(I_WOUT) + (size_t)l * D * D, D, D, 0, W_OUT + (size_t)l * D * D, r % I_OUT, scr, lane); continue; } r -= 2 * I_OUT;
                if (r < I_GUD) { if (MK_DENSE_F8 >= 2) tr_matrix_item8(INP(I_WGUD), D, 2 * FFD, FFD, (unsigned char*)W_GUD, SC_WGU, r, scr, lane); else tr_matrix_item(INP(I_WGUD), D, 2 * FFD, FFD, W_GUD, r, scr, lane); continue; } r -= I_GUD;
                if (r < I_DND) { if (MK_DENSE_F8 >= 1) tr_matrix_item8(INP(I_WDND), FFD, D, 0, (unsigned char*)W_DND, SC_WDN, r, scr, lane); else tr_matrix_item(INP(I_WDND), FFD, D, 0, W_DND, r, scr, lane); continue; } r -= I_DND;
                if (r < NE * I_GUM) { const int e = r / I_GUM; tr_matrix_item8(INP(I_WGUM) + (size_t)e * D * 2 * FFE, D, 2 * FFE, FFE, W_GUM8 + (size_t)e * 2 * FFE * D, SC_WGU, r % I_GUM, scr, lane); continue; } r -= NE * I_GUM;
                { const int e = r / I_DNM; tr_matrix_item8(INP(I_WDNM) + (size_t)e * FFE * D, FFE, D, 0, W_DNM8 + (size_t)e * D * FFE, SC_WDN, r % I_DNM, scr, lane); }
            }
        }
        GRID_BAR();
    }

    for (int l = 0; l < DEPTH; ++l) {
        const int pb = 1 + l * PH_PER_LAYER;
        const bool ctx_out = (l < DEPTH - 1);
        const bool moe = (l & 1) != 0;
        const int rows_out = ctx_out ? TA : TL;
#define modl (MOD + (size_t)l * 5 * 6144)
#define xsrc_lat ((l == 0) ? INP(I_X) : (const float*)outp)
#define xsrc_ctx ((l == 0) ? INP(I_CTX) : (const float*)HCTX)

        if (IN(pb + 0) && l == 0) {
            PHASE_ENTER();
            const int chunk = (TL + NGW - 1) / NGW;
#define P1_ROW(t) do { const float* xr = (t) < TL ? xsrc_lat + (size_t)(t) * D : xsrc_ctx + (size_t)((t) - TL) * D; \
                f32x4 x[4], h[4]; row_load(xr, lane, x); const float rr = row_rrms(x); row_normmod(x, rr, gpre, sh, sc, h); if (MK_GATE_F8 < 2) row_store_bf16(HX + (size_t)(t) * D, lane, h); if (MK_GATE_F8) row_store_fp8(HX8 + (size_t)(t) * D, lane, h, SC_XG); } while (0)
            f32x4 gpre[4], sh[4], sc[4]; vec_load(INP(I_GPREMIX) + l * D, lane, gpre);
            for (int t0 = min(gw * chunk, TL), t1 = min(TL, t0 + chunk); t0 < t1; ) { const int bb = t0 >> 13, te = min(t1, (bb + 1) << 13); const float* md = modl + (size_t)bb * 6144;
                vec_load(md, lane, sh); vec_load(md + 1024, lane, sc);
                for (int t = t0; t < te; ++t) P1_ROW(t);
                t0 = te; }
            { const float* md = modl + (size_t)4 * 6144; vec_load(md, lane, sh); vec_load(md + 1024, lane, sc); for (int t = TL + gw; t < TA; t += NGW) P1_ROW(t); }
#undef P1_ROW
            GRID_BAR();
        }
        if (IN(pb + 1)) {
            PHASE_ENTER();
#if MK_GATE_F8 == 2
            {
                pg8::Gemm g{(const bf16*)HX8, (const bf16*)((unsigned char*)W_IN + (size_t)l * INC * D), TA, ZMC, D}; pg8::StaticOrder S; S.init(TA, ZMC, F.G, (int)blockIdx.x, MK_WGM);
                pg8::EpiZT<true> E{ZM, ZG, ROPE, TL / 256, INP(I_BGATE) + (size_t)l * 3 * D, 0, 1.0f / (SC_XG * SC_WGU)};
                pg8::gemm_phase<pg8::EpiZT<true>, pg8::StaticOrder, PG8_ALIGN, PG8_SP2>(F.lds + RING_OFF, g, S, E, F.wv);
            }
            {
                pg8::Gemm g{(const bf16*)HX8, (const bf16*)((unsigned char*)W_IN + (size_t)l * INC * D + (size_t)ZMC * D), rows_out, ZGC, D}; pg8::StaticOrder S; S.init(rows_out, ZGC, F.G, (int)blockIdx.x, MK_WGM);
                pg8::EpiZT<true> E{ZM, ZG, ROPE, TL / 256, INP(I_BGATE) + (size_t)l * 3 * D, ZMC / 256, 1.0f / (SC_XG * SC_WGU)};
                pg8::gemm_phase<pg8::EpiZT<true>, pg8::StaticOrder, PG8_ALIGN, PG8_SP2>(F.lds + RING_OFF, g, S, E, F.wv);
            }
#elif MK_GATE_F8
            {
                pg8::Gemm g{HX, W_IN + (size_t)l * INC * D, TA, ZMC, D}; pg8::StaticOrder S; S.init(TA, ZMC, F.G, (int)blockIdx.x, MK_WGM);
                pg8::EpiZ E{ZM, ZG, ROPE, TL / 256, INP(I_BGATE) + (size_t)l * 3 * D, 0, 1.0f};
                pg8::gemm_phase<pg8::EpiZ, pg8::StaticOrder, PG8_ALIGN, PG8_SP2>(F.lds + RING_OFF, g, S, E, F.wv);
            }
            {
                pg8::Gemm g{(const bf16*)HX8, (const bf16*)(W_ING8 + (size_t)l * ZGC * D), rows_out, ZGC, D}; pg8::StaticOrder S; S.init(rows_out, ZGC, F.G, (int)blockIdx.x, MK_WGM);
                pg8::EpiZT<true> E{ZM, ZG, ROPE, TL / 256, INP(I_BGATE) + (size_t)l * 3 * D, ZMC / 256, 1.0f / (SC_XG * SC_WGU)};
                pg8::gemm_phase<pg8::EpiZT<true>, pg8::StaticOrder, PG8_ALIGN, PG8_SP2>(F.lds + RING_OFF, g, S, E, F.wv);
            }
#else
            pg8::Gemm g{HX, W_IN + (size_t)l * INC * D, TA, INC, D}; pg8::StaticOrder S; S.init(TA, INC, F.G, (int)blockIdx.x, MK_WGM);
            pg8::EpiZ E{ZM, ZG, ROPE, TL / 256, INP(I_BGATE) + (size_t)l * 3 * D, 0, 1.0f};
            pg8::gemm_phase<pg8::EpiZ, pg8::StaticOrder, PG8_ALIGN, PG8_SP2>(F.lds + RING_OFF, g, S, E, F.wv);
#endif
            GRID_BAR();
        }
        if (IN(pb + 3)) {
            PHASE_ENTER();
            const float* sinkp = INP(I_SINK) + l * 8; const float* rpbp = INP(I_RPB) + (size_t)l * 8 * 15 * 31;
            const float* cw = INP(I_CONVW) + (size_t)l * 3 * BW;
            {
                const int ch = 8 * lane;
                float cwr[3][8];
#pragma unroll
                for (int k = 0; k < 3; ++k) { const f32x4 a = *(const f32x4*)(cw + k * BW + ch), b = *(const f32x4*)(cw + k * BW + ch + 4); cwr[k][0] = a.x; cwr[k][1] = a.y; cwr[k][2] = a.z; cwr[k][3] = a.w; cwr[k][4] = b.x; cwr[k][5] = b.y; cwr[k][6] = b.z; cwr[k][7] = b.w; }
#define CONV_U(row, u) do { const bf16* zp_ = ZM + (size_t)(row) * ZMC; const v4u a_ = *(const v4u*)(zp_ + C_UX + ch), g_ = *(const v4u*)(zp_ + C_GC + ch); \
                    u[0] = bflo(a_.x) * bflo(g_.x); u[1] = bfhi(a_.x) * bfhi(g_.x); u[2] = bflo(a_.y) * bflo(g_.y); u[3] = bfhi(a_.y) * bfhi(g_.y); \
                    u[4] = bflo(a_.z) * bflo(g_.z); u[5] = bfhi(a_.z) * bfhi(g_.z); u[6] = bflo(a_.w) * bflo(g_.w); u[7] = bfhi(a_.w) * bfhi(g_.w); } while (0)
#define CONV_Z(u) do { _Pragma("unroll") for (int q_ = 0; q_ < 8; ++q_) u[q_] = 0.f; } while (0)
#define CONV_OUT(t) do { const v4u gbv = *(const v4u*)(ZM + (size_t)(t) * ZMC + C_GB + ch); \
                    const float gb[8] = {bflo(gbv.x), bfhi(gbv.x), bflo(gbv.y), bfhi(gbv.y), bflo(gbv.z), bfhi(gbv.z), bflo(gbv.w), bfhi(gbv.w)}; float o[8]; \
                    _Pragma("unroll") for (int q = 0; q < 8; ++q) o[q] = gb[q] * (cwr[0][q] * um[q] + cwr[1][q] * uc[q] + cwr[2][q] * up[q]); \
                    v4u w; w.x = pk2(o[0], o[1]); w.y = pk2(o[2], o[3]); w.z = pk2(o[4], o[5]); w.w = pk2(o[6], o[7]); \
                    *(v4u*)(OB + (size_t)(t) * BW + ch) = w; } while (0)
                const int cchunk = (TL + NGW - 1) / NGW;
                const int t0 = min(gw * cchunk, TL), t1 = min(TL, t0 + cchunk);
                if (t0 < t1) {
                    float um[8], uc[8], up[8];
                    if ((t0 & (SEQ - 1)) > 0) CONV_U(t0 - 1, um); else CONV_Z(um);
                    CONV_U(t0, uc);
                    for (int t = t0; t < t1; ++t) {
                        const int s = t & (SEQ - 1);
                        if (s == 0) CONV_Z(um);
                        if (s + 1 < SEQ) CONV_U(t + 1, up); else CONV_Z(up);
                        CONV_OUT(t);
#pragma unroll
                        for (int q = 0; q < 8; ++q) { um[q] = uc[q]; uc[q] = up[q]; }
                    }
                }
                for (int t = TL + gw; t < rows_out; t += NGW) {
                    const int s = (t - TL) & (CTXL - 1);
                    float um[8], uc[8], up[8];
                    if (s > 0) CONV_U(t - 1, um); else CONV_Z(um);
                    CONV_U(t, uc);
                    if (s + 1 < CTXL) CONV_U(t + 1, up); else CONV_Z(up);
                    CONV_OUT(t);
                }
#undef CONV_U
#undef CONV_Z
#undef CONV_OUT
            }
            at::attn_phase(F.lds + RING_OFF, ZM, OA, OC, sinkp, rpbp, F.vcu, F.G, ctx_out, tid_, wave, lane);
#ifdef MK_ATTN_PROBE
            at::attn_phase<MK_ATTN_PROBE>(F.lds + RING_OFF, ZM, (bf16*)(GAS bf16*)(ws + WS_HX), (bf16*)(GAS bf16*)(ws + WS_HX) + (size_t)TA * BW, sinkp, rpbp, F.vcu, F.G, ctx_out, tid_, wave, lane);
#endif
            GRID_BAR();
        }
        if (IN(pb + 4)) {
            PHASE_ENTER();
            pg8::Gemm g{OA, W_BR + (size_t)l * 3 * D * BW, rows_out, D, BW};
            pg8::BranchOrder3 S; S.so.init(rows_out, D, F.G, (int)blockIdx.x, MK_WGM);
            pg8::EpiBranchAcc E{HX, ZG};
            pg8::gemm_phase<pg8::EpiBranchAcc, pg8::BranchOrder3, PG8_ALIGN, PG8_SP2>(F.lds + RING_OFF, g, S, E, F.wv);
            GRID_BAR();
        }
        if (IN(pb + 5)) {
            PHASE_ENTER();
            pg8::Gemm g{HX, W_OUT + (size_t)l * D * D, rows_out, D, D}; pg8::StaticOrder S; S.init(rows_out, D, F.G, (int)blockIdx.x, MK_WGM);
            pg8::EpiBf16P E{Y16, D};
            pg8::gemm_phase<pg8::EpiBf16P, pg8::StaticOrder, PG8_ALIGN, PG8_SP2>(F.lds + RING_OFF, g, S, E, F.wv);
            GRID_BAR();
        }
        if (IN(pb + 6)) {
            PHASE_ENTER();
            if (!moe) {
                const int chunk = (TL + NGW - 1) / NGW;
#define P6_ROW(t) do { f32x4 x[4], y[4], h[4]; \
                    if (l == 0) row_load((t) < TL ? INP(I_X) + (size_t)(t) * D : INP(I_CTX) + (size_t)((t) - TL) * D, lane, x); else row_load_bf16(RS + (size_t)(t) * D, lane, x); \
                    row_load_bf16(Y16 + (size_t)(t) * D, lane, y); const float ry = row_rrms(y); \
                    _Pragma("unroll") for (int j = 0; j < 4; ++j) x[j] = x[j] + gt[j] * (y[j] * ry * gpo[j]); \
                    row_store_bf16(RS + (size_t)(t) * D, lane, x); const float rx = row_rrms(x); row_normmod(x, rx, gpre, sh, sc, h); \
                    if (MK_DENSE_F8 >= 2) row_store_fp8((unsigned char*)HX + (size_t)(t) * D, lane, h, SC_XG); else row_store_bf16(HX + (size_t)(t) * D, lane, h); } while (0)
                f32x4 gpo[4], gt[4], gpre[4], sh[4], sc[4]; vec_load(INP(I_GPOSTMIX) + l * D, lane, gpo); vec_load(INP(I_GPREFFN) + l * D, lane, gpre);
                for (int t0 = min(gw * chunk, TL), t1 = min(TL, t0 + chunk); t0 < t1; ) { const int bb = t0 >> 13, te = min(t1, (bb + 1) << 13); const float* md = modl + (size_t)bb * 6144;
                    vec_load(md + 2048, lane, gt); vec_load(md + 3072, lane, sh); vec_load(md + 4096, lane, sc);
                    for (int t = t0; t < te; ++t) P6_ROW(t);
                    t0 = te; }
                if (rows_out > TL) { const float* md = modl + (size_t)4 * 6144; vec_load(md + 2048, lane, gt); vec_load(md + 3072, lane, sh); vec_load(md + 4096, lane, sc); for (int t = TL + gw; t < rows_out; t += NGW) P6_ROW(t); }
#undef P6_ROW
            } else {
                LAS int* sel = (LAS int*)(F.lds + RING_OFF);
                LAS int* rnk = sel + 256;
                LAS f32x4* wrT = (LAS f32x4*)(F.lds + RING_OFF + 4096);
                const float* wr = INP(I_WROUTER) + (size_t)(l >> 1) * D * NE; const float* br = INP(I_BROUTER) + (l >> 1) * NE;
                for (int u = tid_; u < D * NE; u += NWAVES * 64) ((LAS float*)wrT)[(u & 7) * D + (u >> 3)] = wr[u];
                LDS_WAIT(); __syncthreads();
                f32x4 gpo[4], gt[4], gpre[4], sh[4], sc[4]; vec_load(INP(I_GPOSTMIX) + l * D, lane, gpo); vec_load(INP(I_GPREFFN) + l * D, lane, gpre);
                for (int slab = F.vcu; slab < TL / 128; slab += F.G) {
                    { const float* md = modl + (size_t)((slab * 128) >> 13) * 6144; vec_load(md + 2048, lane, gt); vec_load(md + 3072, lane, sh); vec_load(md + 4096, lane, sc); }
                    for (int i = 0; i < 16; ++i) {
                        const int tl_ = wave * 16 + i, t = slab * 128 + tl_;
                        f32x4 x[4], y[4], h[4]; if (l == 0) row_load(INP(I_X) + (size_t)t * D, lane, x); else row_load_bf16(RS + (size_t)t * D, lane, x);
                        row_load_bf16(Y16 + (size_t)t * D, lane, y);
                        const float ry = row_rrms(y);
#pragma unroll
                        for (int j = 0; j < 4; ++j) x[j] = x[j] + gt[j] * (y[j] * ry * gpo[j]);
                        row_store_bf16(RS + (size_t)t * D, lane, x);
                        const float rx = row_rrms(x);
                        row_normmod(x, rx, gpre, sh, sc, h);
                        row_store_bf16(HX + (size_t)t * D, lane, h);
                        float lg[8];
#pragma unroll
                        for (int e = 0; e < 8; ++e) lg[e] = 0.f;
#pragma unroll
                        for (int e = 0; e < 8; ++e)
#pragma unroll
                            for (int j = 0; j < 4; ++j) { const f32x4 w4 = wrT[e * (D / 4) + 2 * (64 * (j >> 1) + lane) + (j & 1)]; lg[e] += (h[j].x * w4.x + h[j].y * w4.y) + (h[j].z * w4.z + h[j].w * w4.w); }
#pragma unroll
                        for (int e = 0; e < 8; ++e) lg[e] = wave_sum(lg[e]) + br[e];
                        int e1 = 0; float v1 = lg[0];
#pragma unroll
                        for (int e = 1; e < 8; ++e) if (lg[e] > v1) { v1 = lg[e]; e1 = e; }
                        int e2 = -1; float v2 = -INFINITY;
#pragma unroll
                        for (int e = 0; e < 8; ++e) if (e != e1 && lg[e] > v2) { v2 = lg[e]; e2 = e; }
                        const float ex = __expf(v2 - v1), g1 = 1.0f / (1.0f + ex), g2 = ex / (1.0f + ex);
                        if (lane == 0) { sel[2 * tl_] = e1; sel[2 * tl_ + 1] = e2; TOKG[2 * (size_t)t] = g1; TOKG[2 * (size_t)t + 1] = g2; }
                    }
                    LDS_WAIT(); __syncthreads();
                    if (tid_ < 8) { int cnt = 0; for (int q = 0; q < 256; ++q) if (sel[q] == tid_) { rnk[q] = cnt; ++cnt; } SLABCNT[slab * 8 + tid_] = cnt; }
                    LDS_WAIT(); __syncthreads();
                    if (tid_ < 256) TOKER[(size_t)slab * 256 + tid_] = sel[tid_] | (rnk[tid_] << 8);
                    LDS_WAIT(); __syncthreads();
                }
            }
            GRID_BAR();
        }
        if (IN(pb + 7) && moe) {
            PHASE_ENTER();
            LAS int* scn = (LAS int*)(F.lds + RING_OFF);
            LAS int* pst = scn + 2048;
            for (int u = tid_; u < 2048; u += NWAVES * 64) scn[u] = SLABCNT[u];
            LDS_WAIT(); __syncthreads();
            if (tid_ < 8) { int run = 0; for (int q = 0; q < 256; ++q) { const int c = scn[q * 8 + tid_]; scn[q * 8 + tid_] = run; run += c; } pst[8 + tid_] = run; }
            LDS_WAIT(); __syncthreads();
            if (tid_ == 0) { int pan = 0; for (int e = 0; e < 8; ++e) { pst[e] = pan * 256; if (blockIdx.x == 0) PCUM[e] = pan; pan += (pst[8 + e] + 255) >> 8; } if (blockIdx.x == 0) PCUM[8] = pan; }
            LDS_WAIT(); __syncthreads();
            LAS int* posl = pst + 16;
            for (int slab = F.vcu; slab < TL / 128; slab += F.G) {
                if (tid_ < 256) { const int er = TOKER[(size_t)slab * 256 + tid_]; const int e = er & 255, rk = er >> 8; const int pos = pst[e] + scn[slab * 8 + e] + rk;
                    posl[tid_] = pos; TOKPOS[(size_t)slab * 256 + tid_] = pos; }
                LDS_WAIT(); __syncthreads();
                const v4u* srcb = (const v4u*)(HX + (size_t)slab * 128 * D);
#pragma unroll 4
                for (int i = 0; i < 16; ++i) { const int id = i * 512 + tid_, tk = id >> 6, chk = id & 63;
                    const v4u a = srcb[(size_t)tk * 128 + 2 * chk], b = srcb[(size_t)tk * 128 + 2 * chk + 1]; v4u o;
#define Q8(v) pg8::clamp_fp8((v) * SC_XG)
                    o.x = pg8::pk4_fp8(Q8(bflo(a.x)), Q8(bfhi(a.x)), Q8(bflo(a.y)), Q8(bfhi(a.y))); o.y = pg8::pk4_fp8(Q8(bflo(a.z)), Q8(bfhi(a.z)), Q8(bflo(a.w)), Q8(bfhi(a.w)));
                    o.z = pg8::pk4_fp8(Q8(bflo(b.x)), Q8(bfhi(b.x)), Q8(bflo(b.y)), Q8(bfhi(b.y))); o.w = pg8::pk4_fp8(Q8(bflo(b.z)), Q8(bfhi(b.z)), Q8(bflo(b.w)), Q8(bfhi(b.w)));
#undef Q8
                    ((v4u*)(XG8 + (size_t)posl[2 * tk] * D))[chk] = o; ((v4u*)(XG8 + (size_t)posl[2 * tk + 1] * D))[chk] = o; }
                LDS_WAIT(); __syncthreads();
            }
            GRID_BAR();
        }
        if (IN(pb + 8) && !moe) {
            PHASE_ENTER();
            pg8::Gemm g{HX, W_GUD, rows_out, 2 * FFD, D}; pg8::StaticOrder S; S.init(rows_out, 2 * FFD, F.G, (int)blockIdx.x, MK_WGM);
#if MK_DENSE_F8 >= 2
            pg8::EpiSwiglu8T<true> E{(unsigned char*)HD, FFD, 1.0f / (SC_XG * SC_WGU), SC_H};
            pg8::gemm_phase<pg8::EpiSwiglu8T<true>, pg8::StaticOrder, PG8_ALIGN, PG8_SP2>(F.lds + RING_OFF, g, S, E, F.wv);
#elif MK_DENSE_F8 == 1
            pg8::EpiSwiglu8T<false> E{(unsigned char*)HD, FFD, 1.0f, SC_H};
            pg8::gemm_phase<pg8::EpiSwiglu8T<false>, pg8::StaticOrder, PG8_ALIGN, PG8_SP2>(F.lds + RING_OFF, g, S, E, F.wv);
#else
            pg8::EpiSwiglu E{HD, FFD};
            pg8::gemm_phase<pg8::EpiSwiglu, pg8::StaticOrder, PG8_ALIGN, PG8_SP2>(F.lds + RING_OFF, g, S, E, F.wv);
#endif
            GRID_BAR();
        }
        if (IN(pb + 9) && !moe) {
            PHASE_ENTER();
            pg8::Gemm g{HD, W_DND, rows_out, D, FFD}; pg8::StaticOrder S; S.init(rows_out, D, F.G, (int)blockIdx.x, MK_WGM);
#if MK_DENSE_F8 >= 1
            pg8::EpiBf16PS8 E{Y16, D, 1.0f / (SC_H * SC_WDN)};
            pg8::gemm_phase<pg8::EpiBf16PS8, pg8::StaticOrder, PG8_ALIGN, PG8_SP2>(F.lds + RING_OFF, g, S, E, F.wv);
#else
            pg8::EpiBf16P E{Y16, D};
            pg8::gemm_phase<pg8::EpiBf16P, pg8::StaticOrder, PG8_ALIGN, PG8_SP2>(F.lds + RING_OFF, g, S, E, F.wv);
#endif
            GRID_BAR();
        }
        if (moe) {
            for (int ck = 0; ck < NCHUNK; ++ck) {
                if (IN(pb + 10 + 2 * ck)) {
                    PHASE_ENTER();
                    pg8::MoeOrder S; S.nN = 2 * FFE / 256; S.G = F.G; S.c = F.vcu; S.p_lo = ck * PCH;
#pragma unroll
                    for (int k = 0; k < 8; ++k) S.pc[k] = __builtin_amdgcn_readfirstlane(PCUM[k]);
                    const int ptot = __builtin_amdgcn_readfirstlane(PCUM[8]); S.np = min(max(ptot - ck * PCH, 0), PCH);
                    pg8::Gemm g{(const bf16*)XG8, (const bf16*)W_GUM8, 0, 2 * FFE, D};
                    pg8::EpiSwiglu8 E{HM8, FFE, 1.0f / (SC_XG * SC_WGU), SC_H};
                    pg8::gemm_phase<pg8::EpiSwiglu8, pg8::MoeOrder, PG8_ALIGN, PG8_SP2>(F.lds + RING_OFF, g, S, E, F.wv);
                    GRID_BAR();
                }
                if (IN(pb + 11 + 2 * ck)) {
                    PHASE_ENTER();
                    pg8::MoeOrder S; S.nN = D / 256; S.G = F.G; S.c = F.vcu; S.p_lo = ck * PCH;
#pragma unroll
                    for (int k = 0; k < 8; ++k) S.pc[k] = __builtin_amdgcn_readfirstlane(PCUM[k]);
                    const int ptot = __builtin_amdgcn_readfirstlane(PCUM[8]); S.np = min(max(ptot - ck * PCH, 0), PCH);
                    pg8::Gemm g{(const bf16*)HM8, (const bf16*)W_DNM8, 0, D, FFE};
                    pg8::EpiBf16PS8 E{XG, D, 1.0f / (SC_H * SC_WDN)};
                    pg8::gemm_phase<pg8::EpiBf16PS8, pg8::MoeOrder, PG8_ALIGN, PG8_SP2>(F.lds + RING_OFF, g, S, E, F.wv);
                    GRID_BAR();
                }
            }
        }
        if (IN(pb + 16)) {
            PHASE_ENTER();
            const int chunk = (TL + NGW - 1) / NGW; const bool nextl = (l + 1 < DEPTH);
#define P9_ROW(t) do { f32x4 x[4], y[4]; row_load_bf16(RS + (size_t)(t) * D, lane, x); \
                if (!moe) row_load_bf16(Y16 + (size_t)(t) * D, lane, y); \
                else { const int p0 = TOKPOS[2 * (size_t)(t)], p1 = TOKPOS[2 * (size_t)(t) + 1]; const float g0 = TOKG[2 * (size_t)(t)], g1 = TOKG[2 * (size_t)(t) + 1]; \
                    f32x4 ya[4], yb[4]; row_load_bf16(XG + (size_t)p0 * D, lane, ya); row_load_bf16(XG + (size_t)p1 * D, lane, yb); \
                    _Pragma("unroll") for (int j = 0; j < 4; ++j) y[j] = ya[j] * g0 + yb[j] * g1; } \
                const float ry = row_rrms(y); \
                _Pragma("unroll") for (int j = 0; j < 4; ++j) x[j] = x[j] + gt[j] * (y[j] * ry * gpo[j]); \
                if (nextl) row_store_bf16(RS + (size_t)(t) * D, lane, x); else if ((t) < TL) row_store(outp + (size_t)(t) * D, lane, x); \
                if (nextl) { f32x4 h[4]; const float rx = row_rrms(x); row_normmod(x, rx, gpre, sh, sc, h); if (MK_GATE_F8 < 2) row_store_bf16(HX + (size_t)(t) * D, lane, h); if (MK_GATE_F8) row_store_fp8(HX8 + (size_t)(t) * D, lane, h, SC_XG); } } while (0)
            f32x4 gpo[4], gt[4], gpre[4], sh[4], sc[4]; vec_load(INP(I_GPOSTFFN) + l * D, lane, gpo); vec_load(INP(I_GPREMIX) + (nextl ? l + 1 : l) * D, lane, gpre);
            for (int t0 = min(gw * chunk, TL), t1 = min(TL, t0 + chunk); t0 < t1; ) { const int bb = t0 >> 13, te = min(t1, (bb + 1) << 13); const float* md = modl + (size_t)bb * 6144;
                vec_load(md + 5120, lane, gt); vec_load(md + (nextl ? 5 * 6144 : 0), lane, sh); vec_load(md + (nextl ? 5 * 6144 : 0) + 1024, lane, sc);
                for (int t = t0; t < te; ++t) P9_ROW(t);
                t0 = te; }
            if (rows_out > TL) { const float* md = modl + (size_t)4 * 6144; vec_load(md + 5120, lane, gt); vec_load(md + (nextl ? 5 * 6144 : 0), lane, sh); vec_load(md + (nextl ? 5 * 6144 : 0) + 1024, lane, sc);
                for (int t = TL + gw; t < rows_out; t += NGW) P9_ROW(t); }
#undef P9_ROW
            if (l + 1 < DEPTH) GRID_BAR();
        }
    }
#undef IN
#undef GRID_BAR
}

extern "C" void kernel_launch(void* const* d_in, const int* in_sizes, int n_in, void* d_out, int out_size, void* d_ws, size_t ws_size, hipStream_t stream) {
    static int grid = 0;
    if (grid == 0) {
        if (n_in != 23 || in_sizes[0] != TL * D || out_size != TL * D || ws_size < WS_END) { fprintf(stderr, "kernel_launch: unexpected shapes: n_in %d in0 %d out %d ws %zu (need %zu); nothing launched\n", n_in, n_in > 0 ? in_sizes[0] : -1, out_size, ws_size, (size_t)WS_END); grid = -1; return; }
        int dev = 0, cus = 0, per_cu = 0;
        if (hipGetDevice(&dev) != hipSuccess || hipDeviceGetAttribute(&cus, hipDeviceAttributeMultiprocessorCount, dev) != hipSuccess) { fprintf(stderr, "kernel_launch: device query failed\n"); grid = -1; return; }
        if (hipFuncSetAttribute((const void*)mk_fwd, hipFuncAttributeMaxDynamicSharedMemorySize, LDS_BYTES) != hipSuccess) { fprintf(stderr, "kernel_launch: hipFuncSetAttribute failed\n"); grid = -1; return; }
        if (hipOccupancyMaxActiveBlocksPerMultiprocessor(&per_cu, (const void*)mk_fwd, NWAVES * 64, LDS_BYTES) != hipSuccess || per_cu < 1) fprintf(stderr, "kernel_launch: note: occupancy query reports %d\n", per_cu);
        (void)hipGetLastError();
        grid = cus;
    }
    if (grid < 0) return;
    if (hipMemsetAsync((char*)d_ws + WS_CTL, 0, CTL_ZERO_BYTES, stream) != hipSuccess) { fprintf(stderr, "kernel_launch: memset failed\n"); return; }
    Args a{};
    for (int i = 0; i < 23; ++i) a.in[i] = (const float*)d_in[i];
    a.out = (float*)d_out; a.ws = (unsigned char*)d_ws;
#if MK_PER_PHASE
    for (int ph = 0; ph < NPHASES; ++ph) { a.ph_lo = ph; a.ph_hi = ph + 1; hipLaunchKernelGGL(mk_fwd, dim3(grid), dim3(NWAVES * 64), LDS_BYTES, stream, a); }
#else
    a.ph_lo = 0; a.ph_hi = NPHASES;
    hipLaunchKernelGGL(mk_fwd, dim3(grid), dim3(NWAVES * 64), LDS_BYTES, stream, a);
#endif
    const hipError_t le = hipPeekAtLastError();
    if (le != hipSuccess) fprintf(stderr, "kernel_launch: launch failed: %s\n", hipGetErrorName(le));
}
```

```cpp
#include <hip/hip_runtime.h>
#include <cstdio>
#include <cstdint>
#ifndef MK_GATE_U8
#define MK_GATE_U8 1
#endif
#ifndef MK_GATE_F8
#define MK_GATE_F8 1
#endif

__device__ __forceinline__ int mk_lane() { unsigned z; asm volatile("s_mov_b32 %0, 0" : "=s"(z)); return (int)__builtin_amdgcn_mbcnt_hi(~0u, __builtin_amdgcn_mbcnt_lo(~0u, z)); }
template <int CTRL, int ROWMASK = 0xf> __device__ __forceinline__ float mk_dpp(float v) { return __builtin_bit_cast(float, __builtin_amdgcn_update_dpp(0, __builtin_bit_cast(int, v), CTRL, ROWMASK, 0xf, false)); }
__device__ __forceinline__ float mk_xor32(float v, bool upper) { const auto rr = __builtin_amdgcn_permlane32_swap(__builtin_bit_cast(unsigned, v), __builtin_bit_cast(unsigned, v), false, false); return __builtin_bit_cast(float, upper ? rr[0] : rr[1]); }
__device__ __forceinline__ int mk_xor16(int v) { return __builtin_amdgcn_ds_swizzle(v, 0x401F); }

namespace pg8 {
#define PG8_LAS __attribute__((address_space(3)))
typedef unsigned short bf16_t;
typedef short bf16x8 __attribute__((ext_vector_type(8)));
typedef float f32x4 __attribute__((ext_vector_type(4)));
typedef unsigned u32x4 __attribute__((ext_vector_type(4)));
typedef unsigned u32x2 __attribute__((ext_vector_type(2)));
typedef int v8i32 __attribute__((ext_vector_type(8)));
constexpr int BM = 256, BK = 64, HALF = 128, HTB = HALF * BK * 2  , STAGE_BYTES = 8 * HTB, NXCD = 8, WGM = 8;

__host__ __device__ __forceinline__ int lds_byte(int r, int c) { const int st = (r >> 4) * 2 + (c >> 5), rr = r & 15, cc = c & 31, ob = rr * 64 + cc * 2; return st * 1024 + (ob ^ (((ob >> 9) & 1) << 5)); }
__host__ __device__ __forceinline__ void stage_rc(int b, int& R, int& C) { const int st = b / 1024, sb = b % 1024, swz = sb ^ (((sb >> 9) & 1) << 5); R = (st >> 1) * 16 + swz / 64; C = (st & 1) * 32 + (swz % 64) / 2; }
__host__ __device__ __forceinline__ int perm32(int rho) { const int n = rho >> 4, i = rho & 15; return 8 * (i >> 2) + 4 * n + (i & 3); }

struct Unit { int pm, pn, pb; };
struct Gemm { const bf16_t* A; const bf16_t* Bt; int M, N, K; };

struct StaticOrder {
    int nM, nN, nwg, G, c, wgm;
    __host__ __device__ void init(int M, int N, int G_, int c_, int wgm_ = WGM) { nM = M / BM; nN = N / BM; nwg = nM * nN; G = G_; c = c_; wgm = wgm_; }
    __host__ __device__ bool next(int i, Unit& u) const {
        const long L = (long)i * G + c; if (L >= nwg) return false;
        int wgid = (int)L; { const int q = nwg / NXCD, r = nwg % NXCD, xcd = wgid % NXCD, off = wgid / NXCD; wgid = (xcd < r ? xcd * (q + 1) : r * (q + 1) + (xcd - r) * q) + off; }
        const int nig = wgm * nN, gid = wgid / nig, fm = gid * wgm, gsz = (nM - fm) < wgm ? (nM - fm) : wgm;
        u.pm = fm + ((wgid % nig) % gsz); u.pn = (wgid % nig) / gsz; u.pb = u.pn; return true;
    }
    __device__ __forceinline__ void a_ready(const Unit&) const {}
    __device__ __forceinline__ void done(const Unit&) const {}
};

__device__ __forceinline__ unsigned cvt_pk_bf16(float lo, float hi) { unsigned r; asm volatile("v_cvt_pk_bf16_f32 %0, %1, %2" : "=v"(r) : "v"(lo), "v"(hi)); return r; }
__device__ __forceinline__ float bf_lo(unsigned w) { return __uint_as_float(w << 16); }
__device__ __forceinline__ float bf_hi(unsigned w) { return __uint_as_float(w & 0xffff0000u); }
__device__ __forceinline__ float sigmoidf_(float x) { return __builtin_amdgcn_rcpf(1.0f + __builtin_amdgcn_exp2f(x * -1.4426950408889634f)); }

template <bool OPF8> struct EpiZT {
    static constexpr bool PERM = true, AFTER_DRAIN = false, HALFN = false, F8 = OPF8, RWACC = false;
    bf16_t* ZM; bf16_t* ZG; const float* rope; int n_lat_panels; const float* bgate; int pn_off; float gs;
    __device__ __forceinline__ void operator()(const f32x4 (&acc)[2][2][4][2], const Unit& u, int wr, int wc, int fr, int fq) const {
        const int row0 = u.pm * BM + wr * 64 + fr; int colt = (u.pn + pn_off) * BM; bf16_t* base = ZM; int ldc = 3840; bool isg = false;
        if (colt >= 3840) { base = ZG; colt -= 3840; ldc = 3072; isg = true; }
        const int col0 = colt + wc * 32 + 8 * fq;
        f32x4 gb[2][2];
        if (isg) {
#pragma unroll
            for (int bj = 0; bj < 2; ++bj) { gb[bj][0] = *(const f32x4*)(bgate + col0 + bj * HALF); gb[bj][1] = *(const f32x4*)(bgate + col0 + bj * HALF + 4); } }
        const int nrope = (u.pm < n_lat_panels) ? (u.pn + pn_off < 2 ? 2 : (u.pn + pn_off == 2 ? 1 : 0)) : 0;
#pragma unroll
        for (int ai = 0; ai < 2; ++ai)
#pragma unroll
            for (int m = 0; m < 4; ++m) { const int row = row0 + ai * HALF + m * 16; bf16_t* rowp = base + (size_t)row * ldc + col0;
                f32x4 cs[4];
                if (nrope) { const int s = row & 8191, pidx = (wc & 1) ? 128 + (s & 63) : (s >> 6); const f32x4* cp = (const f32x4*)(rope + (size_t)(pidx * 16 + 8 * (fq & 1)) * 2);
                    cs[0] = cp[0]; cs[1] = cp[1]; cs[2] = cp[2]; cs[3] = cp[3]; }
#pragma unroll
                for (int bj = 0; bj < 2; ++bj) { f32x4 v0 = acc[ai][bj][m][0], v1 = acc[ai][bj][m][1];
                    if (OPF8 && !isg) { v0 *= gs; v1 *= gs; }
                    if (isg) {
#pragma unroll
                        for (int j = 0; j < 4; ++j) { v0[j] = sigmoidf_(fminf(fmaxf(v0[j] * gs + gb[bj][0][j], -30.f), 30.f)); v1[j] = sigmoidf_(fminf(fmaxf(v1[j] * gs + gb[bj][1][j], -30.f), 30.f)); } }
                    if (bj < nrope) { const float sg = (fq >> 1) ? 1.f : -1.f;
                        float v[8] = {v0[0], v0[1], v0[2], v0[3], v1[0], v1[1], v1[2], v1[3]}, o[8];
#pragma unroll
                        for (int j = 0; j < 8; ++j) { const float pv = mk_xor32(v[j], (fq >> 1) != 0); const float c_ = cs[j >> 1][(j & 1) * 2], s_ = cs[j >> 1][(j & 1) * 2 + 1]; o[j] = v[j] * c_ + sg * pv * s_; }
                        v0 = (f32x4){o[0], o[1], o[2], o[3]}; v1 = (f32x4){o[4], o[5], o[6], o[7]}; }
                    if (MK_GATE_U8 && isg) {
                        unsigned b0 = 0u, b1 = 0u;
#pragma unroll
                        for (int j = 0; j < 4; ++j) { b0 = __builtin_amdgcn_cvt_pk_u8_f32(fmaxf(v0[j] * 255.f, 1.f), j, b0); b1 = __builtin_amdgcn_cvt_pk_u8_f32(fmaxf(v1[j] * 255.f, 1.f), j, b1); }
                        u32x2 w8; w8.x = b0; w8.y = b1;
                        *(u32x2*)((unsigned char*)ZG + (size_t)row * 3072 + col0 + bj * HALF) = w8;
                        continue; }
                    u32x4 w; w.x = cvt_pk_bf16(v0[0], v0[1]); w.y = cvt_pk_bf16(v0[2], v0[3]); w.z = cvt_pk_bf16(v1[0], v1[1]); w.w = cvt_pk_bf16(v1[2], v1[3]);
                    *(u32x4*)(rowp + bj * HALF) = w; } }
    }
};
typedef EpiZT<false> EpiZ;
struct EpiBf16P {
    static constexpr bool PERM = true, AFTER_DRAIN = false, HALFN = false, F8 = false, RWACC = false;
    bf16_t* O; int ldc;
    __device__ __forceinline__ void operator()(const f32x4 (&acc)[2][2][4][2], const Unit& u, int wr, int wc, int fr, int fq) const {
        const int row0 = u.pm * BM + wr * 64 + fr; const int col0 = u.pn * BM + wc * 32 + 8 * fq;
#pragma unroll
        for (int ai = 0; ai < 2; ++ai)
#pragma unroll
            for (int m = 0; m < 4; ++m) { bf16_t* rowp = O + (size_t)(row0 + ai * HALF + m * 16) * ldc + col0;
#pragma unroll
                for (int bj = 0; bj < 2; ++bj) { const f32x4 v0 = acc[ai][bj][m][0], v1 = acc[ai][bj][m][1];
                    u32x4 w; w.x = cvt_pk_bf16(v0[0], v0[1]); w.y = cvt_pk_bf16(v0[2], v0[3]); w.z = cvt_pk_bf16(v1[0], v1[1]); w.w = cvt_pk_bf16(v1[2], v1[3]);
                    *(u32x4*)(rowp + bj * HALF) = w; } }
    }
};
struct EpiBranchAcc {
    static constexpr bool PERM = true, AFTER_DRAIN = false, HALFN = false, F8 = false, RWACC = true;
    bf16_t* MG; const bf16_t* ZG;
    __device__ __forceinline__ bool restart(const Unit& u) const { return u.pm >= 264; }
    __device__ __forceinline__ void rw(f32x4 (&acc)[2][2][4][2], const Unit& u, int wr, int wc, int fr, int fq) const {
        const int r = u.pm / 132, pmt = u.pm - 132 * r, rn = r < 2 ? r + 1 : r;
        const int row0 = pmt * BM + wr * 64 + fr, col0 = u.pn * BM + wc * 32 + 8 * fq;
        constexpr int PG8_GD = 4;
        u32x4 gp[PG8_GD][2], gn[PG8_GD][2];
        constexpr unsigned GB = MK_GATE_U8 ? 1u : 2u;
        const unsigned o0 = (unsigned)row0 * (3072u * GB) + (unsigned)col0 * GB;
        const char* zp = (const char*)ZG + (size_t)r * 1024 * GB; const char* zn = (const char*)ZG + (size_t)rn * 1024 * GB;
#if MK_GATE_U8
#define PG8_GLOAD(s, buf) do { const int bj_ = (s) >> 2, ai_ = ((s) >> 1) & 1, mb_ = ((s) & 1) * 2; _Pragma("unroll") for (int q_ = 0; q_ < 2; ++q_) { \
            const unsigned off_ = o0 + (unsigned)(ai_ * HALF + (mb_ + q_) * 16) * 3072u + (unsigned)(bj_ * HALF); \
            const u32x2 a_ = *(const u32x2*)(zp + off_), b_ = *(const u32x2*)(zn + off_); gp[buf][q_].x = a_.x; gp[buf][q_].y = a_.y; gn[buf][q_].x = b_.x; gn[buf][q_].y = b_.y; } } while (0)
#else
#define PG8_GLOAD(s, buf) do { const int bj_ = (s) >> 2, ai_ = ((s) >> 1) & 1, mb_ = ((s) & 1) * 2; _Pragma("unroll") for (int q_ = 0; q_ < 2; ++q_) { \
            const unsigned off_ = o0 + (unsigned)(ai_ * HALF + (mb_ + q_) * 16) * 6144u + (unsigned)(bj_ * HALF * 2); \
            gp[buf][q_] = *(const u32x4*)(zp + off_); gn[buf][q_] = *(const u32x4*)(zn + off_); } } while (0)
#endif
#pragma unroll
        for (int s = 0; s < PG8_GD - 1; ++s) PG8_GLOAD(s, s);
#pragma unroll
        for (int s = 0; s < 8; ++s) { const int bj = s >> 2, ai = (s >> 1) & 1, mb = (s & 1) * 2, col = col0 + bj * HALF;
            if (s + PG8_GD - 1 < 8) PG8_GLOAD(s + PG8_GD - 1, (s + PG8_GD - 1) % PG8_GD);
            __builtin_amdgcn_sched_barrier(0);
#pragma unroll
            for (int q = 0; q < 2; ++q) { const int m = mb + q; const size_t row = (size_t)(row0 + ai * HALF + m * 16);
                const u32x4 g0 = gp[s % PG8_GD][q], g1 = gn[s % PG8_GD][q];
#if MK_GATE_U8
#define PG8_UB(w_, k_) ((float)(((w_) >> (8 * (k_))) & 255u))
                const float x[8] = {PG8_UB(g0.x, 0), PG8_UB(g0.x, 1), PG8_UB(g0.x, 2), PG8_UB(g0.x, 3), PG8_UB(g0.y, 0), PG8_UB(g0.y, 1), PG8_UB(g0.y, 2), PG8_UB(g0.y, 3)};
#else
                const float x[8] = {bf_lo(g0.x), bf_hi(g0.x), bf_lo(g0.y), bf_hi(g0.y), bf_lo(g0.z), bf_hi(g0.z), bf_lo(g0.w), bf_hi(g0.w)};
#endif
                if (r < 2) {
#if MK_GATE_U8
                    const float y[8] = {PG8_UB(g1.x, 0), PG8_UB(g1.x, 1), PG8_UB(g1.x, 2), PG8_UB(g1.x, 3), PG8_UB(g1.y, 0), PG8_UB(g1.y, 1), PG8_UB(g1.y, 2), PG8_UB(g1.y, 3)};
#else
                    const float y[8] = {bf_lo(g1.x), bf_hi(g1.x), bf_lo(g1.y), bf_hi(g1.y), bf_lo(g1.z), bf_hi(g1.z), bf_lo(g1.w), bf_hi(g1.w)};
#endif
#pragma unroll
                    for (int j = 0; j < 8; ++j) acc[ai][bj][m][j >> 2][j & 3] *= x[j] * __builtin_amdgcn_rcpf(y[j]);
                } else {
                    float v[8];
#pragma unroll
                    for (int j = 0; j < 8; ++j) v[j] = acc[ai][bj][m][j >> 2][j & 3] * (MK_GATE_U8 ? x[j] * (1.0f / 255.0f) : x[j]);
                    u32x4 w; w.x = cvt_pk_bf16(v[0], v[1]); w.y = cvt_pk_bf16(v[2], v[3]); w.z = cvt_pk_bf16(v[4], v[5]); w.w = cvt_pk_bf16(v[6], v[7]);
                    *(u32x4*)(MG + row * 1024 + col) = w;
                } }
        }
#undef PG8_GLOAD
    }
};
struct BranchOrder3 {
    StaticOrder so;
    __device__ __forceinline__ bool next(int i, Unit& u) const {
        const int ti = i / 3, r = i - 3 * ti; if (!so.next(ti, u)) return false;
        u.pb = 4 * r + u.pn; u.pm += 132 * r; return true;
    }
    __device__ __forceinline__ void a_ready(const Unit&) const {}
    __device__ __forceinline__ void done(const Unit&) const {}
};
struct EpiSwiglu {
    static constexpr bool PERM = true, AFTER_DRAIN = false, HALFN = false, F8 = false, RWACC = false;
    bf16_t* H; int ldh;
    __device__ __forceinline__ void operator()(const f32x4 (&acc)[2][2][4][2], const Unit& u, int wr, int wc, int fr, int fq) const {
        const int row0 = u.pm * BM + wr * 64 + fr; const int col0 = u.pn * HALF + wc * 32 + 8 * fq;
#pragma unroll
        for (int ai = 0; ai < 2; ++ai)
#pragma unroll
            for (int m = 0; m < 4; ++m) { bf16_t* rowp = H + (size_t)(row0 + ai * HALF + m * 16) * ldh + col0;
                float h[8];
#pragma unroll
                for (int n = 0; n < 2; ++n)
#pragma unroll
                    for (int j = 0; j < 4; ++j) { const float g = acc[ai][0][m][n][j], uu = acc[ai][1][m][n][j]; h[n * 4 + j] = g * sigmoidf_(g) * uu; }
                u32x4 w; w.x = cvt_pk_bf16(h[0], h[1]); w.y = cvt_pk_bf16(h[2], h[3]); w.z = cvt_pk_bf16(h[4], h[5]); w.w = cvt_pk_bf16(h[6], h[7]);
                *(u32x4*)rowp = w; }
    }
};
__device__ __forceinline__ unsigned pk4_fp8(float a, float b, float c, float d) { int w = __builtin_amdgcn_cvt_pk_fp8_f32(a, b, 0, false); w = __builtin_amdgcn_cvt_pk_fp8_f32(c, d, w, true); return (unsigned)w; }
__device__ __forceinline__ float clamp_fp8(float v) { return fminf(fmaxf(v, -448.0f), 448.0f); }
template <bool OPF8> struct EpiSwiglu8T {
    static constexpr bool PERM = true, AFTER_DRAIN = false, HALFN = false, F8 = OPF8, RWACC = false;
    unsigned char* H; int ldh; float sin, sout;
    __device__ __forceinline__ void operator()(const f32x4 (&acc)[2][2][4][2], const Unit& u, int wr, int wc, int fr, int fq) const {
        const int row0 = u.pm * BM + wr * 64 + fr; const int col0 = u.pn * HALF + wc * 32 + 8 * (fq & 2); const int odd = fq & 1;
#pragma unroll
        for (int ai = 0; ai < 2; ++ai)
#pragma unroll
            for (int mp = 0; mp < 2; ++mp) {
                unsigned w[2][2];
#pragma unroll
                for (int k = 0; k < 2; ++k) { const int m = 2 * mp + k; float h[8];
#pragma unroll
                    for (int n = 0; n < 2; ++n)
#pragma unroll
                        for (int j = 0; j < 4; ++j) { const float g = acc[ai][0][m][n][j] * sin, uu = acc[ai][1][m][n][j] * sin; h[n * 4 + j] = clamp_fp8(g * sigmoidf_(g) * uu * sout); }
                    w[k][0] = pk4_fp8(h[0], h[1], h[2], h[3]); w[k][1] = pk4_fp8(h[4], h[5], h[6], h[7]); }
                const unsigned s0 = odd ? w[0][0] : w[1][0], s1 = odd ? w[0][1] : w[1][1];
                const unsigned r0 = (unsigned)mk_xor16((int)s0), r1 = (unsigned)mk_xor16((int)s1);
                u32x4 st; if (odd) { st.x = r0; st.y = r1; st.z = w[1][0]; st.w = w[1][1]; } else { st.x = w[0][0]; st.y = w[0][1]; st.z = r0; st.w = r1; }
                *(u32x4*)(H + (size_t)(row0 + ai * HALF + (2 * mp + odd) * 16) * ldh + col0) = st; }
    }
};
typedef EpiSwiglu8T<true> EpiSwiglu8;
struct EpiBf16PS8 {
    static constexpr bool PERM = true, AFTER_DRAIN = false, HALFN = false, F8 = true, RWACC = false;
    bf16_t* O; int ldc; float s;
    __device__ __forceinline__ void operator()(const f32x4 (&acc)[2][2][4][2], const Unit& u, int wr, int wc, int fr, int fq) const {
        const int row0 = u.pm * BM + wr * 64 + fr; const int col0 = u.pn * BM + wc * 32 + 8 * fq;
#pragma unroll
        for (int ai = 0; ai < 2; ++ai)
#pragma unroll
            for (int m = 0; m < 4; ++m) { bf16_t* rowp = O + (size_t)(row0 + ai * HALF + m * 16) * ldc + col0;
#pragma unroll
                for (int bj = 0; bj < 2; ++bj) { const f32x4 v0 = acc[ai][bj][m][0] * s, v1 = acc[ai][bj][m][1] * s;
                    u32x4 w; w.x = cvt_pk_bf16(v0[0], v0[1]); w.y = cvt_pk_bf16(v0[2], v0[3]); w.z = cvt_pk_bf16(v1[0], v1[1]); w.w = cvt_pk_bf16(v1[2], v1[3]);
                    *(u32x4*)(rowp + bj * HALF) = w; } }
    }
};
struct MoeOrder {
    int nN, G, c, p_lo, np; int pc[8];
    __device__ __forceinline__ bool next(int i, Unit& u) const {
        const long L = (long)i * G + c; if (L >= (long)np * nN) return false;
        const int wgid = (int)L, nig = WGM * nN, gid = wgid / nig, fm = gid * WGM, gsz = (np - fm) < WGM ? (np - fm) : WGM;
        u.pm = p_lo + fm + ((wgid % nig) % gsz); u.pn = (wgid % nig) / gsz;
        int e = 0;
#pragma unroll
        for (int k = 1; k < 8; ++k) e += (u.pm >= pc[k]) ? 1 : 0;
        u.pb = e * nN + u.pn; return true;
    }
    __device__ __forceinline__ void a_ready(const Unit&) const {}
    __device__ __forceinline__ void done(const Unit&) const {}
};

template <class Epi, class Sched, bool ALIGN_EPI = false, bool SP2 = false>
__device__ __forceinline__ void gemm_phase(PG8_LAS unsigned char* lds, const Gemm g, const Sched& S, const Epi& E, int wv) {
    int tid_ = (wv << 6) | mk_lane(); asm volatile("" : "+v"(tid_));
    const int tid = tid_, wid = __builtin_amdgcn_readfirstlane(tid >> 6), lane = tid & 63, wr = wid >> 2, wc = wid & 3, fr = lane & 15, fq = lane >> 4;
    constexpr bool HN = Epi::HALFN;
    constexpr bool F8 = Epi::F8;
    constexpr int ES = F8 ? 1 : 2;
    const int K = g.K, nt = K * ES / (BK * 2);
    unsigned voffA[2], voffB[2];
#pragma unroll
    for (int i = 0; i < 2; ++i) { int R, C; stage_rc(tid * 16 + i * 8192, R, C); const int Rb = Epi::PERM ? ((R & ~31) + perm32(R & 31)) : R;
        voffA[i] = (unsigned)(R * K * ES + C * 2); voffB[i] = (unsigned)(Rb * K * ES + C * 2); }
    const size_t kstep = (size_t)(BK * 2);
    const size_t hstep = (size_t)HALF * K * ES;
    const size_t tstep = 2 * hstep;
    const unsigned ldsw = (unsigned)wid * 1024u;
    const int aoff = lds_byte(wr * 64 + fr, fq * 8), boff = lds_byte(wc * 32 + fr, fq * 8);
#define PG8_SA(b, h) (((b) * 2 + (h)) * HTB)
#define PG8_SB(b, h) ((4 + (b) * 2 + (h)) * HTB)
#define PG8_STAGE(bufoff, gbase, voff) do { _Pragma("unroll") for (int _i = 0; _i < 2; ++_i) \
        __builtin_amdgcn_global_load_lds((const unsigned*)((const char*)(gbase) + (voff)[_i]), (PG8_LAS unsigned*)(lds + (bufoff) + ldsw + _i * 8192), 16, 0, 0); } while (0)
#define PG8_LDA(dst, b, h) do { if constexpr (F8) { _Pragma("unroll") for (int m = 0; m < 4; ++m) { const u32x4 lo_ = *(const PG8_LAS u32x4*)(lds + PG8_SA(b, h) + aoff + m * 2048), hi_ = *(const PG8_LAS u32x4*)(lds + PG8_SA(b, h) + aoff + m * 2048 + 1024); \
            dst##8[m] = __builtin_bit_cast(v8i32, __builtin_shufflevector(lo_, hi_, 0, 1, 2, 3, 4, 5, 6, 7)); } } \
        else { _Pragma("unroll") for (int m = 0; m < 4; ++m) _Pragma("unroll") for (int k = 0; k < 2; ++k) dst[m][k] = *(const PG8_LAS bf16x8*)(lds + PG8_SA(b, h) + aoff + m * 2048 + k * 1024); } } while (0)
#define PG8_LDB(dst, b, h) do { if constexpr (F8) { _Pragma("unroll") for (int n = 0; n < 2; ++n) { const u32x4 lo_ = *(const PG8_LAS u32x4*)(lds + PG8_SB(b, h) + boff + n * 2048), hi_ = *(const PG8_LAS u32x4*)(lds + PG8_SB(b, h) + boff + n * 2048 + 1024); \
            dst##8[n] = __builtin_bit_cast(v8i32, __builtin_shufflevector(lo_, hi_, 0, 1, 2, 3, 4, 5, 6, 7)); } } \
        else { _Pragma("unroll") for (int n = 0; n < 2; ++n) _Pragma("unroll") for (int k = 0; k < 2; ++k) dst[n][k] = *(const PG8_LAS bf16x8*)(lds + PG8_SB(b, h) + boff + n * 2048 + k * 1024); } } while (0)
#define PG8_MMA(ai, bj, At, Bt) do { __builtin_amdgcn_s_setprio(1); _Pragma("unroll") for (int m = 0; m < 4; ++m) _Pragma("unroll") for (int n = 0; n < 2; ++n) { \
        if constexpr (F8) { asm volatile("v_mfma_f32_16x16x128_f8f6f4 %0, %1, %2, %0" : "+v"(acc[ai][bj][m][n]) : "v"(Bt##8[n]), "v"(At##8[m])); } \
        else { _Pragma("unroll") for (int k = 0; k < 2; ++k) acc[ai][bj][m][n] = __builtin_amdgcn_mfma_f32_16x16x32_bf16(Bt[n][k], At[m][k], acc[ai][bj][m][n], 0, 0, 0); } } \
        __builtin_amdgcn_s_setprio(0); } while (0)
#define PG8_LDB1(dst, b, h) do { if constexpr (!HN) { PG8_LDB(dst, b, h); } } while (0)
#define PG8_MMA1(ai, bj, At, Bt) do { if constexpr (!HN) { PG8_MMA(ai, bj, At, Bt); } } while (0)
#define PG8_WAIT_V(n) asm volatile("s_waitcnt vmcnt(" #n ")" ::: "memory")
#define PG8_WAIT_L(n) asm volatile("s_waitcnt lgkmcnt(" #n ")" ::: "memory")
#define PG8_BAR __builtin_amdgcn_s_barrier()
#define PG8_SCHED __builtin_amdgcn_sched_barrier(0)
    Unit cur, nxt; int ui = 0;
    if (!S.next(0, cur)) return;
    f32x4 acc[2][2][4][2];
#pragma unroll
    for (int a = 0; a < 2; ++a)
#pragma unroll
        for (int b = 0; b < 2; ++b)
#pragma unroll
            for (int m = 0; m < 4; ++m)
#pragma unroll
                for (int n = 0; n < 2; ++n) acc[a][b][m][n] = (f32x4){0.f, 0.f, 0.f, 0.f};
    bf16x8 At[4][2], B0[2][2], B1[2][2];
    v8i32 At8[4], B08[2], B18[2];
    const char* cA = (const char*)g.A + (size_t)cur.pm * tstep; const char* cB = (const char*)g.Bt + (size_t)cur.pb * (HN ? hstep : tstep);
    S.a_ready(cur);
    if constexpr (SP2) {
        PG8_STAGE(PG8_SB(0, 0), cB, voffB); PG8_STAGE(PG8_SB(0, 1), cB + hstep, voffB); PG8_STAGE(PG8_SA(0, 0), cA, voffA); PG8_STAGE(PG8_SA(0, 1), cA + hstep, voffA);
        if (wr == 1) PG8_BAR;
        PG8_WAIT_V(2); PG8_BAR;
        PG8_STAGE(PG8_SB(1, 0), cB + kstep, voffB); PG8_STAGE(PG8_SA(1, 0), cA + kstep, voffA); PG8_STAGE(PG8_SB(1, 1), cB + hstep + kstep, voffB);
        PG8_WAIT_V(6); PG8_BAR;
    } else {
        PG8_STAGE(PG8_SB(0, 0), cB, voffB); PG8_STAGE(PG8_SA(0, 0), cA, voffA); PG8_STAGE(PG8_SB(0, 1), cB + hstep, voffB); PG8_STAGE(PG8_SA(0, 1), cA + hstep, voffA);
        if (wr == 1) PG8_BAR;
        PG8_WAIT_V(4); PG8_BAR;
        PG8_STAGE(PG8_SB(1, 0), cB + kstep, voffB); PG8_STAGE(PG8_SA(1, 0), cA + kstep, voffA); PG8_STAGE(PG8_SB(1, 1), cB + hstep + kstep, voffB);
        PG8_WAIT_V(6); PG8_BAR;
    }
    for (;;) {
        const bool has_next = S.next(ui + 1, nxt);
        const char* nA = has_next ? (const char*)g.A + (size_t)nxt.pm * tstep : cA; const char* nB = has_next ? (const char*)g.Bt + (size_t)nxt.pb * (HN ? hstep : tstep) : cB;
        for (int t = 0; t < nt; t += 2) {
            const bool last = (t == nt - 2);
            const char* a1 = cA + (size_t)(t + 1) * kstep;
            const char* a2 = last ? nA : cA + (size_t)(t + 2) * kstep; const char* b2 = last ? nB : cB + (size_t)(t + 2) * kstep;
            const char* a3 = a2 + kstep; const char* b3 = b2 + kstep;
            if (last && has_next) S.a_ready(nxt);
            if constexpr (SP2) {
            PG8_LDB(B0, 0, 0); PG8_LDB1(B1, 0, 1); PG8_SCHED; PG8_LDA(At, 0, 0); PG8_STAGE(PG8_SA(1, 1), a1 + hstep, voffA);
            PG8_WAIT_V(8); PG8_WAIT_L(0); PG8_BAR; PG8_MMA(0, 0, At, B0); PG8_MMA1(0, 1, At, B1); PG8_BAR; PG8_SCHED;
            PG8_LDA(At, 0, 1); PG8_STAGE(PG8_SB(0, 0), b2, voffB); PG8_STAGE(PG8_SB(0, 1), b2 + hstep, voffB); PG8_STAGE(PG8_SA(0, 0), a2, voffA);
            PG8_WAIT_V(8); PG8_WAIT_L(0); PG8_BAR; PG8_MMA(1, 0, At, B0); PG8_MMA1(1, 1, At, B1); PG8_BAR; PG8_SCHED;
            PG8_LDB(B0, 1, 0); PG8_LDB1(B1, 1, 1); PG8_SCHED; PG8_LDA(At, 1, 0); PG8_STAGE(PG8_SA(0, 1), a2 + hstep, voffA);
            PG8_WAIT_V(8); PG8_WAIT_L(0); PG8_BAR; PG8_MMA(0, 0, At, B0); PG8_MMA1(0, 1, At, B1); PG8_BAR; PG8_SCHED;
            PG8_LDA(At, 1, 1); PG8_STAGE(PG8_SB(1, 0), b3, voffB); PG8_STAGE(PG8_SB(1, 1), b3 + hstep, voffB); PG8_STAGE(PG8_SA(1, 0), a3, voffA);
            PG8_WAIT_V(8); PG8_WAIT_L(0); PG8_BAR; PG8_MMA(1, 0, At, B0); PG8_MMA1(1, 1, At, B1); PG8_BAR; PG8_SCHED;
            } else {
            PG8_LDB(B0, 0, 0); PG8_SCHED; PG8_LDA(At, 0, 0); PG8_STAGE(PG8_SA(1, 1), a1 + hstep, voffA);
            PG8_WAIT_L(8); PG8_BAR; PG8_WAIT_L(0); PG8_MMA(0, 0, At, B0); PG8_BAR; PG8_SCHED;
            PG8_LDB1(B1, 0, 1); PG8_STAGE(PG8_SB(0, 0), b2, voffB);
            PG8_BAR; PG8_WAIT_L(0); PG8_MMA1(0, 1, At, B1); PG8_BAR;
            PG8_LDA(At, 0, 1); PG8_STAGE(PG8_SA(0, 0), a2, voffA);
            PG8_BAR; PG8_WAIT_L(0); PG8_MMA(1, 0, At, B0); PG8_BAR; PG8_SCHED;
            PG8_STAGE(PG8_SB(0, 1), b2 + hstep, voffB);
            PG8_WAIT_V(6); PG8_BAR; PG8_MMA1(1, 1, At, B1); PG8_BAR;
            PG8_LDB(B0, 1, 0); PG8_SCHED; PG8_LDA(At, 1, 0); PG8_STAGE(PG8_SA(0, 1), a2 + hstep, voffA);
            PG8_WAIT_L(8); PG8_BAR; PG8_WAIT_L(0); PG8_MMA(0, 0, At, B0); PG8_BAR; PG8_SCHED;
            PG8_LDB1(B1, 1, 1); PG8_STAGE(PG8_SB(1, 0), b3, voffB);
            PG8_BAR; PG8_WAIT_L(0); PG8_MMA1(0, 1, At, B1); PG8_BAR;
            PG8_LDA(At, 1, 1); PG8_STAGE(PG8_SA(1, 0), a3, voffA);
            PG8_BAR; PG8_WAIT_L(0); PG8_MMA(1, 0, At, B0); PG8_BAR; PG8_SCHED;
            PG8_STAGE(PG8_SB(1, 1), b3 + hstep, voffB);
            PG8_WAIT_V(6); PG8_BAR; PG8_MMA1(1, 1, At, B1); PG8_BAR;
            }
        }
        if constexpr (F8) asm volatile("s_nop 15\n\ts_nop 15" ::: "memory");
        if constexpr (ALIGN_EPI) { if (wr == 0) PG8_BAR; }
        if constexpr (Epi::RWACC) { E.rw(acc, cur, wr, wc, fr, fq); S.done(cur); }
        else if constexpr (!Epi::AFTER_DRAIN) { E(acc, cur, wr, wc, fr, fq); S.done(cur); }
        if (!has_next) break;
        bool zero_acc = true; if constexpr (Epi::RWACC) zero_acc = E.restart(cur);
        if (zero_acc)
#pragma unroll
        for (int a = 0; a < 2; ++a)
#pragma unroll
            for (int b = 0; b < 2; ++b)
#pragma unroll
                for (int m = 0; m < 4; ++m)
#pragma unroll
                    for (int n = 0; n < 2; ++n) acc[a][b][m][n] = (f32x4){0.f, 0.f, 0.f, 0.f};
        cur = nxt; cA = nA; cB = nB; ++ui;
        if constexpr (ALIGN_EPI) { if (wr == 1) PG8_BAR; }
    }
    PG8_WAIT_V(0);
    if constexpr (!ALIGN_EPI) { if (wr == 0) PG8_BAR; }
    PG8_BAR;
    if constexpr (Epi::AFTER_DRAIN) { E.fused(acc, cur, wr, wc, fr, fq, lds, wid, lane); S.done(cur); }
#undef PG8_SA
#undef PG8_SB
#undef PG8_STAGE
#undef PG8_LDA
#undef PG8_LDB
#undef PG8_MMA
#undef PG8_LDB1
#undef PG8_MMA1
#undef PG8_WAIT_V
#undef PG8_WAIT_L
#undef PG8_BAR
#undef PG8_SCHED
}
}

#ifndef PG8_SP2
#define PG8_SP2 true
#endif
#ifndef PG8_ALIGN
#define PG8_ALIGN true
#endif
#ifndef MK_WGM
#define MK_WGM 4
#endif
#ifndef MK_DENSE_F8
#define MK_DENSE_F8 1
#endif
#ifndef MK_PER_PHASE
#define MK_PER_PHASE 0
#endif

constexpr int NWAVES = 8;
constexpr int D = 1024, BATCH = 4, SEQ = 8192, CTXL = 256, DEPTH = 2;
constexpr int TL = BATCH * SEQ, TC = BATCH * CTXL, TA = TL + TC;
constexpr int INC = 6912, ZMC = 3840, ZGC = 3072, BW = 512;
constexpr int FFD = 2816, FFE = 3584, NE = 8;
constexpr int MAXPAN = 264, PCH = 264, NCHUNK = 1;
constexpr float RMS_EPS = 1e-6f;
constexpr float SC_XG = 4.0f, SC_WGU = 32.0f, SC_H = 4.0f, SC_WDN = 64.0f;
constexpr int C_QA = 0, C_KA = 512, C_VA = 640, C_UX = 768, C_GB = 1280, C_GC = 1792, C_QN = 2304, C_KN = 2816, C_VN = 3328;

constexpr size_t MiB = 1u << 20;
constexpr size_t WS_CTL = 0, CTL_ZERO_BYTES = 1 * MiB;
constexpr size_t WS_MOD = 1 * MiB;
constexpr size_t WS_ROPE = WS_MOD + 256 * 1024;
constexpr size_t WS_SLABCNT = WS_MOD + 320 * 1024;
constexpr size_t WS_PCUM = WS_MOD + 384 * 1024;
constexpr size_t WS_TOKER = WS_MOD + 512 * 1024;
constexpr size_t WS_TOKG = WS_MOD + 768 * 1024;
constexpr size_t WS_TOKPOS = WS_MOD + 1024 * 1024;
constexpr size_t WS_HCTX = 4 * MiB;
constexpr size_t WS_WIN = 8 * MiB;
constexpr size_t WS_WBR = 35 * MiB;
constexpr size_t WS_WOUT = 41 * MiB;
constexpr size_t WS_WGUD = 45 * MiB;
constexpr size_t WS_WDND = 56 * MiB;
constexpr size_t WS_WGUM = 62 * MiB;
constexpr size_t WS_WDNM = 118 * MiB;
constexpr size_t WS_RS = 146 * MiB;
constexpr size_t WS_HX = 230 * MiB;
constexpr size_t WS_ZM = 296 * MiB;
constexpr size_t WS_ZG = 544 * MiB;
constexpr size_t WS_O = 742 * MiB;
constexpr size_t WS_XG = WS_ZM;
constexpr size_t WS_HM = WS_ZM + 132 * MiB;
constexpr size_t WS_XG8 = WS_O;
constexpr size_t WS_HX8 = 841 * MiB;
constexpr size_t WS_WING8 = 874 * MiB;
constexpr size_t WS_END = 880 * MiB;
static_assert(WS_WIN + (size_t)2 * INC * D * 2 <= WS_WBR && WS_WGUD + (size_t)2 * FFD * D * 2 <= WS_WDND && WS_WDND + (size_t)D * FFD * 2 <= WS_WGUM, "ws map (weights)");
static_assert(WS_WGUM + (size_t)NE * 2 * FFE * D <= WS_WDNM && WS_WDNM + (size_t)NE * D * FFE <= WS_RS && WS_RS + (size_t)TA * D * 2 <= WS_HX, "ws map (moe weights, residual stream)");
static_assert(WS_HX + (size_t)TA * D * 2 <= WS_ZM && WS_ZM + (size_t)TA * ZMC * 2 <= WS_ZG && WS_ZG + (size_t)TA * ZGC * 2 <= WS_O && WS_O + (size_t)3 * TA * BW * 2 <= WS_END, "ws map (activations)");
static_assert(WS_HM + (size_t)MAXPAN * 256 * FFE <= WS_O && WS_XG8 + (size_t)MAXPAN * 256 * D <= WS_END && (size_t)MAXPAN * 256 * D * 2 <= 132 * MiB && (size_t)TA * D * 4 <= 132 * MiB, "ws map (moe)");
constexpr int CW_BAR = 4096;

constexpr int RING_OFF = 0, RING_BYTES = 131072;
constexpr int LDSCTL_OFF = RING_BYTES, MISC_OFF = LDSCTL_OFF + 320;
constexpr int LDS_BYTES = 147456;

#define GAS __attribute__((address_space(1)))
#define LAS __attribute__((address_space(3)))
typedef unsigned short bf16;
typedef unsigned v4u __attribute__((ext_vector_type(4)));
typedef unsigned v2u __attribute__((ext_vector_type(2)));
typedef float f32x4 __attribute__((ext_vector_type(4)));
typedef float f32x2 __attribute__((ext_vector_type(2)));
#define LDS_WAIT() asm volatile("s_waitcnt lgkmcnt(0)" ::: "memory")
#define VM_WAIT() asm volatile("s_waitcnt vmcnt(0)" ::: "memory")
__device__ __forceinline__ unsigned f2bf(float f) { unsigned u = __builtin_bit_cast(unsigned, f); return (u + 0x7fffu + ((u >> 16) & 1u)) >> 16; }
__device__ __forceinline__ unsigned pk2(float lo, float hi) { return f2bf(lo) | (f2bf(hi) << 16); }
__device__ __forceinline__ float bflo(unsigned w) { return __uint_as_float(w << 16); }
__device__ __forceinline__ float bfhi(unsigned w) { return __uint_as_float(w & 0xffff0000u); }
__device__ __forceinline__ float bf2f(bf16 b) { return __uint_as_float(((unsigned)b) << 16); }

#define XB_TMO      128
#define XB_XCNT(j)  (256  + 64 * (j))
#define XB_XSUB(j)  (1280 + 64 * (j))
#define XB_XGEN(j)  (2304 + 64 * (j))
#define XB_TOP      3328
#define XB_TOPGEN   3392
#define XCD_BAR_WORDS 3456
#define XB_SPIN_CAP (1u << 21)

__device__ __forceinline__ unsigned xb_ld(unsigned* p)              { return __hip_atomic_load(p, __ATOMIC_RELAXED, __HIP_MEMORY_SCOPE_AGENT); }
__device__ __forceinline__ unsigned xb_add(unsigned* p, unsigned v) { return __hip_atomic_fetch_add(p, v, __ATOMIC_RELAXED, __HIP_MEMORY_SCOPE_AGENT); }
__device__ __forceinline__ unsigned xb_xcc_id() { return (unsigned)__builtin_amdgcn_s_getreg((3 << 11) | 20) & 0xFu; }
#define XB_SPIN(cond, bar) do { unsigned _sp = 0; while (cond) { __builtin_amdgcn_s_sleep(1); \
    if ((++_sp & 255u) == 0u) { if (xb_ld(&(bar)[XB_TMO])) break; if (_sp > XB_SPIN_CAP) { atomicAdd(&(bar)[XB_TMO], 1u); break; } } } } while (0)

struct XcdBarrier {
    unsigned* bar; unsigned x;
    volatile LAS unsigned* st;
    int w;
};

__device__ __forceinline__ XcdBarrier xcd_barrier_post(unsigned* bar, volatile LAS unsigned* st) {
    XcdBarrier b; b.bar = bar; b.x = xb_xcc_id(); b.st = st; b.w = 0;
    if (threadIdx.x == 0) (void)xb_add(&bar[XB_XCNT(b.x)], 1u);
    return b;
}
__device__ __forceinline__ void xcd_barrier_complete(unsigned* bar, unsigned x, unsigned& nloc, unsigned& nx) {
    const unsigned G = gridDim.x * gridDim.y * gridDim.z;
    unsigned sum, cnt, mine, sp = 0u;
    for (;;) {
        sum = 0u; cnt = 0u; mine = 0u;
#pragma unroll
        for (unsigned j = 0; j < 16; ++j) { const unsigned c = xb_ld(&bar[XB_XCNT(j)]); sum += c; cnt += (c > 0u) ? 1u : 0u; mine = (j == x) ? c : mine; }
        if (sum == G) break;
        __builtin_amdgcn_s_sleep(1);
        if ((++sp & 255u) == 0u) { if (xb_ld(&bar[XB_TMO])) break; if (sp > XB_SPIN_CAP) { atomicAdd(&bar[XB_TMO], 1u); break; } }
    }
    nloc = mine > 0u ? mine : 1u; nx = cnt > 0u ? cnt : 1u;
}

__device__ __forceinline__ void xcd_barrier(const XcdBarrier& b) {
    asm volatile("s_waitcnt vmcnt(0)" ::: "memory");
    __syncthreads();
    if (b.w == 0 && mk_lane() == 0) {
        unsigned* bar = b.bar; { GAS unsigned* bg_ = (GAS unsigned*)bar; asm volatile("" : "+s"(bg_)); bar = (unsigned*)bg_; }
        __builtin_amdgcn_s_waitcnt(0);
        unsigned nloc = b.st[0], nx = b.st[1];
        if (nloc == 0u) { xcd_barrier_complete(bar, b.x, nloc, nx); b.st[0] = nloc; b.st[1] = nx; }
        const unsigned old = xb_add(&bar[XB_XSUB(b.x)], 1u);
        const unsigned gen = old / nloc;
        if (old + 1u == (gen + 1u) * nloc) {
            __builtin_amdgcn_fence(__ATOMIC_RELEASE, "agent");
            asm volatile("s_waitcnt vmcnt(0)" ::: "memory");
            const unsigned og = xb_add(&bar[XB_TOP], 1u);
            const unsigned tg = og / nx;
            if (og + 1u == (tg + 1u) * nx) xb_add(&bar[XB_TOPGEN], 1u);
            else XB_SPIN(xb_ld(&bar[XB_TOPGEN]) == tg, bar);
            __builtin_amdgcn_fence(__ATOMIC_ACQUIRE, "agent");
            xb_add(&bar[XB_XGEN(b.x)], 1u);
            asm volatile("s_waitcnt vmcnt(0)" ::: "memory");
        } else {
            XB_SPIN(xb_ld(&bar[XB_XGEN(b.x)]) == gen, bar);
            __builtin_amdgcn_fence(__ATOMIC_ACQUIRE, "agent");
            asm volatile("s_waitcnt vmcnt(0)" ::: "memory");
        }
    }
    __syncthreads();
}

struct Frame {
    LAS unsigned char* lds;
    volatile LAS unsigned* MISC;
    unsigned* ctl;
    int vcu, G;
    int wv;
};
enum { I_X = 0, I_C, I_CTX, I_CCTX, I_WADA, I_BADA, I_GPREMIX, I_GPOSTMIX, I_GPREFFN, I_GPOSTFFN, I_WIN, I_BGATE, I_SINK, I_CONVW, I_RPB, I_WBRANCH, I_WOUT, I_WGUD, I_WDND, I_WROUTER, I_BROUTER, I_WGUM, I_WDNM };

__device__ __forceinline__ float wave_sum(float v) {
    v += mk_dpp<0xB1>(v); v += mk_dpp<0x4E>(v); v += mk_dpp<0x141>(v); v += mk_dpp<0x140>(v);
    v += mk_dpp<0x142, 0xa>(v); v += mk_dpp<0x143, 0xc>(v);
    return __builtin_bit_cast(float, __builtin_amdgcn_readlane(__builtin_bit_cast(int, v), 63));
}
__device__ __forceinline__ float wave_max(float v) {
    v = fmaxf(v, mk_dpp<0xB1>(v)); v = fmaxf(v, mk_dpp<0x4E>(v)); v = fmaxf(v, mk_dpp<0x141>(v)); v = fmaxf(v, mk_dpp<0x140>(v));
    const float a = __builtin_bit_cast(float, __builtin_amdgcn_readlane(__builtin_bit_cast(int, v), 0)), b = __builtin_bit_cast(float, __builtin_amdgcn_readlane(__builtin_bit_cast(int, v), 16)),
                c = __builtin_bit_cast(float, __builtin_amdgcn_readlane(__builtin_bit_cast(int, v), 32)), d = __builtin_bit_cast(float, __builtin_amdgcn_readlane(__builtin_bit_cast(int, v), 48));
    return fmaxf(fmaxf(a, b), fmaxf(c, d));
}

__device__ __forceinline__ void row_store_fp8(unsigned char* p, int lane, const f32x4 (&h)[4], float sc) {
#pragma unroll
    for (int c = 0; c < 2; ++c) { const f32x4 a = __builtin_elementwise_min(__builtin_elementwise_max(h[2 * c] * sc, (f32x4){-448.f, -448.f, -448.f, -448.f}), (f32x4){448.f, 448.f, 448.f, 448.f}), b = __builtin_elementwise_min(__builtin_elementwise_max(h[2 * c + 1] * sc, (f32x4){-448.f, -448.f, -448.f, -448.f}), (f32x4){448.f, 448.f, 448.f, 448.f});
        v2u w; w.x = pg8::pk4_fp8(a.x, a.y, a.z, a.w); w.y = pg8::pk4_fp8(b.x, b.y, b.z, b.w);
        *(v2u*)(p + 8 * (64 * c + lane)) = w; }
}

__device__ __forceinline__ void tr_item(const float* W, int N, int k0, int n0, bf16* WT, int Kd, int drow0, LAS float* scr, int lane) {
#pragma unroll
    for (int i = 0; i < 8; ++i) { const int kk = 8 * i + (lane >> 3), c4 = 4 * (lane & 7); const f32x4 v = *(const f32x4*)(W + (size_t)(k0 + kk) * N + n0 + c4);
        LAS float* d = scr + kk * 33 + c4; d[0] = v.x; d[1] = v.y; d[2] = v.z; d[3] = v.w; }
    LDS_WAIT(); asm volatile("" ::: "memory");
    const int c = lane & 7;
#pragma unroll
    for (int j = 0; j < 4; ++j) { const int n = (lane >> 3) + 8 * j; const LAS float* s = scr + (8 * c) * 33 + n;
        v4u o; o.x = pk2(s[0 * 33], s[1 * 33]); o.y = pk2(s[2 * 33], s[3 * 33]); o.z = pk2(s[4 * 33], s[5 * 33]); o.w = pk2(s[6 * 33], s[7 * 33]);
        *(v4u*)(WT + (size_t)(drow0 + n) * Kd + k0 + 8 * c) = o; }
    LDS_WAIT(); asm volatile("" ::: "memory");
}
__device__ __forceinline__ void tr_matrix_item(const float* W, int K, int N, int ff, bf16* WT, int item, LAS float* scr, int lane) {
    const int nblk = N / 32, kb = item / nblk, nb = item % nblk, n0 = 32 * nb;
    int drow0 = n0;
    if (ff > 0) { const int isu = n0 >= ff ? 1 : 0, nn = n0 - isu * ff; drow0 = 256 * (nn >> 7) + 128 * isu + (nn & 127); }
    tr_item(W, N, 64 * kb, n0, WT, K, drow0, scr, lane);
}

__device__ __forceinline__ void tr_item8(const float* W, int N, int k0, int n0, unsigned char* WT, int Kd, int drow0, float scale, LAS float* scr, int lane) {
#pragma unroll
    for (int i = 0; i < 8; ++i) { const int kk = 8 * i + (lane >> 3), c4 = 4 * (lane & 7); const f32x4 v = *(const f32x4*)(W + (size_t)(k0 + kk) * N + n0 + c4);
        LAS float* d = scr + kk * 33 + c4; d[0] = v.x; d[1] = v.y; d[2] = v.z; d[3] = v.w; }
    LDS_WAIT(); asm volatile("" ::: "memory");
    const int n = lane >> 1, kh = lane & 1; const LAS float* s = scr + (32 * kh) * 33 + n;
    unsigned w[8];
#pragma unroll
    for (int j = 0; j < 8; ++j) w[j] = pg8::pk4_fp8(s[(4 * j) * 33] * scale, s[(4 * j + 1) * 33] * scale, s[(4 * j + 2) * 33] * scale, s[(4 * j + 3) * 33] * scale);
    v4u* dst = (v4u*)(WT + (size_t)(drow0 + n) * Kd + k0 + 32 * kh);
    dst[0] = (v4u){w[0], w[1], w[2], w[3]}; dst[1] = (v4u){w[4], w[5], w[6], w[7]};
    LDS_WAIT(); asm volatile("" ::: "memory");
}
__device__ __forceinline__ void tr_matrix_item8(const float* W, int K, int N, int ff, unsigned char* WT, float scale, int item, LAS float* scr, int lane) {
    const int nblk = N / 32, kb = item / nblk, nb = item % nblk, n0 = 32 * nb;
    int drow0 = n0;
    if (ff > 0) { const int isu = n0 >= ff ? 1 : 0, nn = n0 - isu * ff; drow0 = 256 * (nn >> 7) + 128 * isu + (nn & 127); }
    tr_item8(W, N, 64 * kb, n0, WT, K, drow0, scale, scr, lane);
}

__device__ __forceinline__ void row_load(const float* p, int lane, f32x4 (&v)[4]) {
#pragma unroll
    for (int c = 0; c < 2; ++c) { const f32x4* r = (const f32x4*)(p + 8 * (64 * c + lane)); v[2 * c] = r[0]; v[2 * c + 1] = r[1]; }
}
__device__ __forceinline__ void row_load_bf16(const bf16* p, int lane, f32x4 (&v)[4]) {
#pragma unroll
    for (int c = 0; c < 2; ++c) { const v4u w = *(const v4u*)(p + 8 * (64 * c + lane));
        v[2 * c] = (f32x4){bflo(w.x), bfhi(w.x), bflo(w.y), bfhi(w.y)}; v[2 * c + 1] = (f32x4){bflo(w.z), bfhi(w.z), bflo(w.w), bfhi(w.w)}; }
}
__device__ __forceinline__ void row_store(float* p, int lane, const f32x4 (&v)[4]) {
#pragma unroll
    for (int c = 0; c < 2; ++c) { f32x4* r = (f32x4*)(p + 8 * (64 * c + lane)); r[0] = v[2 * c]; r[1] = v[2 * c + 1]; }
}
__device__ __forceinline__ float row_rrms(const f32x4 (&v)[4]) {
    float s = 0.f;
#pragma unroll
    for (int j = 0; j < 4; ++j) s += (v[j].x * v[j].x + v[j].y * v[j].y) + (v[j].z * v[j].z + v[j].w * v[j].w);
    return 1.0f / sqrtf(wave_sum(s) * (1.0f / D) + RMS_EPS);
}
__device__ __forceinline__ void vec_load(const float* p, int lane, f32x4 (&v)[4]) { row_load(p, lane, v); }
__device__ __forceinline__ void row_normmod(const f32x4 (&x)[4], float rr, const f32x4 (&g)[4], const f32x4 (&shift)[4], const f32x4 (&scale)[4], f32x4 (&h)[4]) {
#pragma unroll
    for (int j = 0; j < 4; ++j) h[j] = (x[j] * rr * g[j]) * (scale[j] + 1.0f) + shift[j];
}
__device__ __forceinline__ void row_store_bf16(bf16* p, int lane, const f32x4 (&h)[4]) {
#pragma unroll
    for (int c = 0; c < 2; ++c) { v4u w; w.x = pk2(h[2 * c].x, h[2 * c].y); w.y = pk2(h[2 * c].z, h[2 * c].w); w.z = pk2(h[2 * c + 1].x, h[2 * c + 1].y); w.w = pk2(h[2 * c + 1].z, h[2 * c + 1].w);
        *(v4u*)(p + 8 * (64 * c + lane)) = w; }
}

namespace at {
typedef short bf16x8 __attribute__((ext_vector_type(8)));
typedef short s16x4 __attribute__((ext_vector_type(4)));
typedef short v4i16_t __attribute__((ext_vector_type(4)));
typedef float f32x16 __attribute__((ext_vector_type(16)));
constexpr int NS = 4, PF = 3, SLOT = 16384;
constexpr int LDS_TAB = NS * SLOT + 1024;
constexpr int LDS_TT = LDS_TAB + 8 * 2048 + 1024;
constexpr int MAXT = 160;
constexpr float LOG2E = 1.4426950408889634f, C2 = 0.125f * LOG2E;
__device__ __forceinline__ unsigned cvtpk(float lo, float hi) { unsigned r; asm volatile("v_cvt_pk_bf16_f32 %0, %1, %2" : "=v"(r) : "v"(lo), "v"(hi)); return r; }
__device__ __forceinline__ float hmax(float v) { auto rr = __builtin_amdgcn_permlane32_swap(__float_as_uint(v), __float_as_uint(v), false, false); return fmaxf(__uint_as_float(rr[0]), __uint_as_float(rr[1])); }
__device__ __forceinline__ float hsum(float v) { auto rr = __builtin_amdgcn_permlane32_swap(__float_as_uint(v), __float_as_uint(v), false, false); return __uint_as_float(rr[0]) + __uint_as_float(rr[1]); }

__device__ __forceinline__ void glds16(const void* gsrc, unsigned lds_dst) { unsigned keep;
    asm volatile("s_mov_b32 %0, m0\n\ts_mov_b32 m0, %2\n\ts_nop 0\n\tglobal_load_lds_dwordx4 %1, off\n\ts_mov_b32 m0, %0" : "=&s"(keep) : "v"(gsrc), "s"(lds_dst) : "memory"); }
__device__ __forceinline__ void tile_issue(LAS unsigned char* slot, const bf16* ZMp, size_t row0, int kcol, int vcol, int wid, int lane) {
    const bf16* ksrc = ZMp + (row0 + lane) * ZMC + kcol + wid * 8;
    const bf16* vsrc = ZMp + (row0 + 16 * (wid & 3) + (lane >> 2)) * ZMC + vcol + (wid >> 2) * 32 + (lane & 3) * 8;
    const unsigned dst = (unsigned)__builtin_amdgcn_readfirstlane((int)(unsigned)(uintptr_t)slot + wid * 1024);
    glds16(ksrc, dst); glds16(vsrc, dst + 8192u);
}
__device__ __forceinline__ void qk_tile(f32x16& p0, f32x16& p1, const LAS unsigned char* Ks, const bf16x8 (&qr)[4], int r32, int hi) {
    const LAS unsigned char* kb = Ks + hi * 1024 + r32 * 16;
    bf16x8 kf[8];
#pragma unroll
    for (int d0 = 0; d0 < 4; ++d0) { kf[2 * d0] = *(const LAS bf16x8*)(kb + d0 * 2048); kf[2 * d0 + 1] = *(const LAS bf16x8*)(kb + d0 * 2048 + 512); }
    __builtin_amdgcn_sched_barrier(0);
#pragma unroll
    for (int r = 0; r < 16; ++r) { p0[r] = 0.f; p1[r] = 0.f; }
#pragma unroll
    for (int d0 = 0; d0 < 4; ++d0) {
        p0 = __builtin_amdgcn_mfma_f32_32x32x16_bf16(kf[2 * d0], qr[d0], p0, 0, 0, 0);
        p1 = __builtin_amdgcn_mfma_f32_32x32x16_bf16(kf[2 * d0 + 1], qr[d0], p1, 0, 0, 0);
    }
}
__device__ __forceinline__ s16x4 vtr(const LAS unsigned char* p) { return __builtin_bit_cast(s16x4, __builtin_amdgcn_ds_read_tr16_b64_v4i16((LAS v4i16_t*)p)); }
template <int LV> __device__ __forceinline__ constexpr bool live0(int r) { return LV == 2 ? r >= 12 : true; }
template <int LV> __device__ __forceinline__ constexpr bool live1(int r) { return LV == 1 ? r < 4 : true; }
template <bool RAW, int LV, int VAR = 0>
__device__ __forceinline__ void sm_pv(f32x16& x0, f32x16& x1, float& m, float& l, f32x16 (&o)[2], const LAS unsigned char* Vs, int lane, int hi) {
    if (VAR == 2) { l += x0[0] + x1[15];
        bf16x8 pw_[4]; unsigned w_[16];
#pragma unroll
        for (int i = 0; i < 8; ++i) { w_[i] = cvtpk(x0[2 * i], x0[2 * i + 1]); w_[8 + i] = cvtpk(x1[2 * i], x1[2 * i + 1]); }
#pragma unroll
        for (int k = 0; k < 4; ++k) { typedef unsigned u32x4_ __attribute__((ext_vector_type(4))); u32x4_ t; t.x = w_[4 * k]; t.y = w_[4 * k + 1]; t.z = w_[4 * k + 2]; t.w = w_[4 * k + 3]; pw_[k] = __builtin_bit_cast(bf16x8, t); }
        const LAS unsigned char* vb_ = Vs + ((lane >> 4) & 1) * 32 + (lane & 3) * 8 + (4 * hi + ((lane & 15) >> 2)) * 64;
#pragma unroll
        for (int d0 = 0; d0 < 2; ++d0)
#pragma unroll
            for (int ks = 0; ks < 4; ++ks) { if ((LV == 1 && ks == 3) || (LV == 2 && ks == 0)) continue;
                const s16x4 lo = vtr(vb_ + d0 * 4096 + ks * 1024), hh = vtr(vb_ + d0 * 4096 + ks * 1024 + 512);
                const bf16x8 vf = (bf16x8){lo[0], lo[1], lo[2], lo[3], hh[0], hh[1], hh[2], hh[3]};
                o[d0] = __builtin_amdgcn_mfma_f32_32x32x16_bf16(vf, pw_[ks], o[d0], 0, 0, 0); }
        return; }
    if (VAR == 3) { l += x0[0] + x1[15] + x0[7] + x1[3]; o[0][0] += x0[1]; o[1][0] += x1[1]; return; }
    float rm = -INFINITY;
#pragma unroll
    for (int r = 0; r < 16; ++r) { if (live0<LV>(r)) rm = fmaxf(rm, x0[r]); if (live1<LV>(r)) rm = fmaxf(rm, x1[r]); }
    rm = hmax(rm);
    const float mn = fmaxf(m, RAW ? rm * C2 : rm);
    { const float sc = __builtin_amdgcn_exp2f(m - mn); l *= sc;
#pragma unroll
      for (int r = 0; r < 16; ++r) { o[0][r] *= sc; o[1][r] *= sc; } }
    m = mn;
    float sum = 0.f;
#pragma unroll
    for (int r = 0; r < 16; ++r) {
        if (live0<LV>(r)) { x0[r] = __builtin_amdgcn_exp2f(RAW ? __builtin_fmaf(x0[r], C2, -mn) : x0[r] - mn); sum += x0[r]; } else x0[r] = 0.f;
        if (live1<LV>(r)) { x1[r] = __builtin_amdgcn_exp2f(RAW ? __builtin_fmaf(x1[r], C2, -mn) : x1[r] - mn); sum += x1[r]; } else x1[r] = 0.f;
    }
    l += sum;
    bf16x8 pw[4];
    { unsigned w[16];
#pragma unroll
      for (int i = 0; i < 8; ++i) { w[i] = cvtpk(x0[2 * i], x0[2 * i + 1]); w[8 + i] = cvtpk(x1[2 * i], x1[2 * i + 1]); }
#pragma unroll
      for (int k = 0; k < 4; ++k) { typedef unsigned u32x4_ __attribute__((ext_vector_type(4))); u32x4_ t; t.x = w[4 * k]; t.y = w[4 * k + 1]; t.z = w[4 * k + 2]; t.w = w[4 * k + 3]; pw[k] = __builtin_bit_cast(bf16x8, t); } }
    const LAS unsigned char* vb = Vs + ((lane >> 4) & 1) * 32 + (lane & 3) * 8 + (4 * hi + ((lane & 15) >> 2)) * 64;
    s16x4 vlo[8], vhh[8];
    __builtin_amdgcn_sched_barrier(0);
#pragma unroll
    for (int d0 = 0; d0 < 2; ++d0)
#pragma unroll
        for (int ks = 0; ks < 4; ++ks) { if ((LV == 1 && ks == 3) || (LV == 2 && ks == 0)) continue;
            vlo[d0 * 4 + ks] = vtr(vb + d0 * 4096 + ks * 1024); vhh[d0 * 4 + ks] = vtr(vb + d0 * 4096 + ks * 1024 + 512); }
    __builtin_amdgcn_sched_barrier(0);
#pragma unroll
    for (int d0 = 0; d0 < 2; ++d0)
#pragma unroll
        for (int ks = 0; ks < 4; ++ks) {
            if ((LV == 1 && ks == 3) || (LV == 2 && ks == 0)) continue;
            const s16x4 lo = vlo[d0 * 4 + ks], hh = vhh[d0 * 4 + ks];
            const bf16x8 vf = (bf16x8){lo[0], lo[1], lo[2], lo[3], hh[0], hh[1], hh[2], hh[3]};
            o[d0] = __builtin_amdgcn_mfma_f32_32x32x16_bf16(vf, pw[ks], o[d0], 0, 0, 0);
        }
}
__device__ __forceinline__ void o_store(const f32x16 (&o)[2], float l, bf16* orow, int hi) {
    const float inv = __builtin_amdgcn_rcpf(hsum(l));
#pragma unroll
    for (int d0 = 0; d0 < 2; ++d0)
#pragma unroll
        for (int gp = 0; gp < 2; ++gp) {
            unsigned w[2][2];
#pragma unroll
            for (int k = 0; k < 2; ++k) { const int g = 2 * gp + k; w[k][0] = cvtpk(o[d0][4 * g] * inv, o[d0][4 * g + 1] * inv); w[k][1] = cvtpk(o[d0][4 * g + 2] * inv, o[d0][4 * g + 3] * inv); }
            unsigned rcv[2];
#pragma unroll
            for (int i = 0; i < 2; ++i) { const unsigned snd = hi ? w[0][i] : w[1][i];
                auto rr = __builtin_amdgcn_permlane32_swap(snd, snd, false, false); rcv[i] = hi ? rr[0] : rr[1]; }
            v4u st; if (hi) { st.x = rcv[0]; st.y = rcv[1]; st.z = w[1][0]; st.w = w[1][1]; } else { st.x = w[0][0]; st.y = w[0][1]; st.z = rcv[0]; st.w = rcv[1]; }
            *(v4u*)(orow + 32 * d0 + 16 * gp + 8 * hi) = st;
        }
}
#define AT_WAIT_BAR(N) asm volatile("s_waitcnt vmcnt(" #N ")\n\ts_barrier" ::: "memory")

struct UDesc { int kind, b, hh, blk, cq, nw, lo; };
__device__ __forceinline__ UDesc unit_desc(int i, int vcu, int UPW, bool ctx_out) {
    UDesc d; d.kind = -1; d.b = 0; d.hh = 0; d.blk = 0; d.cq = 0; d.nw = 0; d.lo = 0;
    if (i < 2 * UPW) { const int u = vcu * UPW + (i < UPW ? i : i - UPW); if (u >= 1024) return d; d.kind = i < UPW ? 0 : 1; d.b = u >> 8;
        if (d.kind == 0) { d.hh = (u >> 5) & 7; d.blk = u & 31; } else { d.hh = (u >> 7) & 1; d.blk = u & 127; } }
    else if (i == 2 * UPW) { if (!ctx_out || vcu >= 64) return d; d.cq = 1;
        if (vcu < 32) { d.kind = 1; d.b = vcu >> 3; d.hh = (vcu >> 2) & 1; d.blk = vcu & 3; } else { d.kind = 0; d.b = (vcu - 32) >> 3; d.hh = (vcu - 32) & 7; d.blk = 0; } }
    else return d;
    if (!d.cq) {
        if (d.kind == 1) { d.lo = max(0, 2 - d.blk); d.nw = min(4, 129 - d.blk) - d.lo + 1; }
        else { d.lo = min(max(4 * d.blk - 4, 0), 120); d.nw = min(max(4 * d.blk - 1, 0), 120) + 7 - d.lo + 1; }
    }
    return d;
}
__device__ __forceinline__ void tile_src(const UDesc& d, int t, int& row0, int& cols) {
    const int kcol = d.kind == 1 ? C_KA + d.hh * 64 : C_KN + d.hh * 64, vcol = d.kind == 1 ? C_VA + d.hh * 64 : C_VN + d.hh * 64;
    cols = kcol | (vcol << 16);
    if (t < d.nw) row0 = d.kind == 1 ? d.b * SEQ + 64 * d.blk - 128 + 64 * (d.lo + t) : d.b * SEQ + 64 * (d.lo + t);
    else row0 = TL + d.b * CTXL + 64 * (t - d.nw);
}
__device__ __forceinline__ size_t q_row(const UDesc& d, int wid, int r32) {
    if (d.kind == 1) { const int qrel = 32 * (wid >> 2) + r32; return d.cq ? (size_t)TL + (size_t)d.b * CTXL + 64 * d.blk + qrel : (size_t)d.b * SEQ + 64 * d.blk + qrel; }
    const int pair = wid >> 1, c = 32 * (wid & 1) + r32;
    return d.cq ? (size_t)TL + (size_t)d.b * CTXL + 64 * pair + c : (size_t)d.b * SEQ + (size_t)(4 * d.blk + pair) * 64 + c;
}
__device__ __forceinline__ void q_load(const UDesc& d, const bf16* ZMp, int wid, int r32, int hi, bf16x8 (&qr)[4]) {
    const int qcol = d.kind == 1 ? C_QA + (d.hh * 4 + (wid & 3)) * 64 : C_QN + d.hh * 64;
    const bf16* p = ZMp + q_row(d, wid, r32) * ZMC + qcol + 8 * hi;
#pragma unroll
    for (int d0 = 0; d0 < 4; ++d0) qr[d0] = *(const bf16x8*)(p + 16 * d0);
}

template <int VAR = 0>
__device__ __forceinline__ void attn_phase(LAS unsigned char* lds, const bf16* ZMp, bf16* OAp, bf16* OCp, const float* sinkp, const float* rpbl, int vcu, int G, bool ctx_out, int tid, int wid, int lane) {
    const int r32 = lane & 31, hi = lane >> 5;
    const int UPW = (1024 + G - 1) / G, NU = 2 * UPW + 1;
    LAS int* tt = (LAS int*)(lds + LDS_TT);
    int Ttot = 0;
    for (int i = 0; i < NU; ++i) { const UDesc d = unit_desc(i, vcu, UPW, ctx_out); if (d.kind < 0) continue; const int nt = d.nw + 4;
        for (int t = tid; t < nt; t += NWAVES * 64) { int row0, cols; tile_src(d, t, row0, cols); if (Ttot + t < MAXT) { tt[2 * (Ttot + t)] = row0; tt[2 * (Ttot + t) + 1] = cols; } }
        Ttot += nt; }
    if (Ttot > MAXT) Ttot = MAXT;
    if (tid < 8) ((LAS float*)(lds + LDS_TT + MAXT * 8))[tid] = sinkp[tid] * LOG2E;
    for (int u = tid; u < 8 * 480; u += NWAVES * 64) { const int h = u / 480, e = u - 480 * h, dr = e >> 5, dc = e & 31; ((LAS float*)(lds + LDS_TAB))[h * 512 + e] = dc < 31 ? rpbl[(h * 15 + dr) * 31 + dc] * LOG2E : 0.f; }
    asm volatile("s_waitcnt lgkmcnt(0)\n\ts_barrier" ::: "memory");
#define AT_ISSUE(T) do { const int row0_ = __builtin_amdgcn_readfirstlane(tt[2 * (T)]), cols_ = __builtin_amdgcn_readfirstlane(tt[2 * (T) + 1]); \
        tile_issue(lds + ((T) & (NS - 1)) * SLOT, ZMp, (size_t)row0_, cols_ & 0xffff, cols_ >> 16, wid, lane); } while (0)
    for (int T = 0; T < PF && T < Ttot; ++T) AT_ISSUE(T);
    int Tb = 0;
    bf16x8 qn[4];
    { int i0 = 0; UDesc d0 = unit_desc(0, vcu, UPW, ctx_out); while (d0.kind < 0 && i0 + 1 < NU) { ++i0; d0 = unit_desc(i0, vcu, UPW, ctx_out); } if (d0.kind >= 0) q_load(d0, ZMp, wid, r32, hi, qn); }
    for (int i = 0; i < NU; ++i) {
        const UDesc d = unit_desc(i, vcu, UPW, ctx_out); if (d.kind < 0) continue;
        bf16x8 qr[4];
#pragma unroll
        for (int k = 0; k < 4; ++k) qr[k] = qn[k];
        { int j = i + 1; UDesc dn = unit_desc(j, vcu, UPW, ctx_out); while (dn.kind < 0 && j + 1 < NU) { ++j; dn = unit_desc(j, vcu, UPW, ctx_out); } if (dn.kind < 0) dn = d; q_load(dn, ZMp, wid, r32, hi, qn); }
        const int NT = d.nw + 4;
        f32x16 o[2];
#pragma unroll
        for (int r = 0; r < 16; ++r) { o[0][r] = 0.f; o[1][r] = 0.f; }
        float m, l;
        if (d.kind == 1) {
            const int head = d.hh * 4 + (wid & 3), qrel = 32 * (wid >> 2) + r32;
            m = ((const LAS float*)(lds + LDS_TT + MAXT * 8))[head]; l = (hi == 0) ? 1.0f : 0.0f;
            int t = 0;
            do {
                const int T = Tb + t, outst = min(Ttot, T + PF) - (T + 1);
                if (outst >= 2) AT_WAIT_BAR(4); else if (outst == 1) AT_WAIT_BAR(2); else AT_WAIT_BAR(0);
                if (t == NT - 1) asm volatile("" : "+v"(qn[0]), "+v"(qn[1]), "+v"(qn[2]), "+v"(qn[3]));
                if (VAR != 5 && T + PF < Ttot) AT_ISSUE(T + PF);
                const LAS unsigned char* sl = lds + (T & (NS - 1)) * SLOT;
                f32x16 x0, x1; if (VAR == 4) { for (int r_ = 0; r_ < 16; ++r_) { x0[r_] = __builtin_bit_cast(float, (int)qr[r_ & 3][0] << 16) ; x1[r_] = x0[r_] * 0.5f; } } else qk_tile(x0, x1, sl, qr, r32, hi);
                const int j = d.lo + t;
                if (t < d.nw && (j == 0 || j == 4)) {
                    const int dq = qrel + 128 - 64 * j - 4 * hi;
#pragma unroll
                    for (int r = 0; r < 16; ++r) { const int dd = dq - ((r & 3) + 8 * (r >> 2));
                        x0[r] = (dd <= 128 && dd >= -128) ? x0[r] * C2 : -INFINITY; x1[r] = (dd - 32 <= 128 && dd - 32 >= -128) ? x1[r] * C2 : -INFINITY; }
                    sm_pv<false, 0, VAR>(x0, x1, m, l, o, sl + 8192, lane, hi);
                } else sm_pv<true, 0, VAR>(x0, x1, m, l, o, sl + 8192, lane, hi);
            } while (++t < NT);
            o_store(o, l, OAp + q_row(d, wid, r32) * BW + head * 64, hi);
        } else {
            const int half = wid & 1, c = 32 * half + r32, r = 4 * d.blk + (wid >> 1);
            const int r0w = min(max(r - 4, 0), 120), c0 = min(max(c - 8, 0), 48);
            const LAS float* tab = (const LAS float*)(lds + LDS_TAB + d.hh * 2048);
            unsigned vm = 0u;
#pragma unroll
            for (int r_ = 0; r_ < 16; ++r_) { const int kc = (r_ & 3) + 8 * (r_ >> 2) + 4 * hi; vm |= ((unsigned)(kc - c0) < 16u ? 1u : 0u) << r_; vm |= ((unsigned)(kc + 32 - c0) < 16u ? 1u : 0u) << (16 + r_); }
            m = -1e30f; l = 0.f;
            int t = 0;
            do {
                const int T = Tb + t, outst = min(Ttot, T + PF) - (T + 1);
                if (outst >= 2) AT_WAIT_BAR(4); else if (outst == 1) AT_WAIT_BAR(2); else AT_WAIT_BAR(0);
                if (t == NT - 1) asm volatile("" : "+v"(qn[0]), "+v"(qn[1]), "+v"(qn[2]), "+v"(qn[3]));
                if (VAR != 5 && T + PF < Ttot) AT_ISSUE(T + PF);
                const int kr = d.lo + t;
                if (t < d.nw && (kr < r0w || kr > r0w + 7)) continue;
                const LAS unsigned char* sl = lds + (T & (NS - 1)) * SLOT;
                f32x16 x0, x1; if (VAR == 4) { for (int r_ = 0; r_ < 16; ++r_) { x0[r_] = __builtin_bit_cast(float, (int)qr[r_ & 3][0] << 16) ; x1[r_] = x0[r_] * 0.5f; } } else qk_tile(x0, x1, sl, qr, r32, hi);
                if (t < d.nw) {
                    const LAS float* tb = tab + (kr - r + 7) * 32 + (4 * hi - c + 15);
                    if (half == 0) {
                        float b0[16], b1[4];
#pragma unroll
                        for (int r_ = 0; r_ < 16; ++r_) { const int rr = (r_ & 3) + 8 * (r_ >> 2); b0[r_] = tb[rr]; if (r_ < 4) b1[r_] = tb[rr + 32]; }
#pragma unroll
                        for (int r_ = 0; r_ < 16; ++r_) {
                            x0[r_] = ((vm >> r_) & 1u) ? __builtin_fmaf(x0[r_], C2, b0[r_]) : -INFINITY;
                            if (r_ < 4) x1[r_] = ((vm >> (16 + r_)) & 1u) ? __builtin_fmaf(x1[r_], C2, b1[r_]) : -INFINITY; }
                        sm_pv<false, 1, VAR>(x0, x1, m, l, o, sl + 8192, lane, hi);
                    } else {
                        float b0[4], b1[16];
#pragma unroll
                        for (int r_ = 0; r_ < 16; ++r_) { const int rr = (r_ & 3) + 8 * (r_ >> 2); if (r_ >= 12) b0[r_ - 12] = tb[rr]; b1[r_] = tb[rr + 32]; }
#pragma unroll
                        for (int r_ = 0; r_ < 16; ++r_) {
                            if (r_ >= 12) x0[r_] = ((vm >> r_) & 1u) ? __builtin_fmaf(x0[r_], C2, b0[r_ - 12]) : -INFINITY;
                            x1[r_] = ((vm >> (16 + r_)) & 1u) ? __builtin_fmaf(x1[r_], C2, b1[r_]) : -INFINITY; }
                        sm_pv<false, 2, VAR>(x0, x1, m, l, o, sl + 8192, lane, hi);
                    }
                } else sm_pv<true, 0, VAR>(x0, x1, m, l, o, sl + 8192, lane, hi);
            } while (++t < NT);
            o_store(o, l, OCp + q_row(d, wid, r32) * BW + d.hh * 64, hi);
        }
        Tb += NT;
    }
    AT_WAIT_BAR(0);
#undef AT_ISSUE
}
}

constexpr int PH_PER_LAYER = 17, NPHASES = 1 + DEPTH * PH_PER_LAYER;
struct Args { const float* in[23]; float* out; unsigned char* ws; int ph_lo, ph_hi; };
typedef __attribute__((address_space(4))) const Args CArgs;
__global__ void __launch_bounds__(NWAVES * 64, 2) mk_fwd(Args args) {
    extern __shared__ __attribute__((aligned(16))) unsigned char lds[];
    Frame F;
    F.lds = (LAS unsigned char*)lds;
    F.MISC = (volatile LAS unsigned*)(F.lds + MISC_OFF);
    F.G = gridDim.x; { const int bx = blockIdx.x; F.vcu = (F.G % 8 == 0) ? (bx % 8) * (F.G / 8) + bx / 8 : bx; }
    F.ctl = (unsigned*)(args.ws + WS_CTL);
    for (int u = threadIdx.x; u < (LDS_BYTES - LDSCTL_OFF) / 4; u += NWAVES * 64) ((LAS unsigned*)(F.lds + LDSCTL_OFF))[u] = 0u;
    { int wv_ = __builtin_amdgcn_readfirstlane((int)(threadIdx.x >> 6)); asm volatile("" : "+s"(wv_)); F.wv = wv_; }
    __syncthreads();
    const int lo = args.ph_lo, hi = args.ph_hi;
    const bool fused = (hi - lo) > 1;
    XcdBarrier bar; bar.bar = F.ctl + CW_BAR; bar.x = 0; bar.st = nullptr; bar.w = F.wv;
    if (fused) { bar = xcd_barrier_post(F.ctl + CW_BAR, F.MISC + 8); bar.w = F.wv; }
#ifndef MK_MASK
#define MK_MASK 0xFFFFFFFFu
#endif
#define SLOT(k) ((k) == 0 ? 0 : (((k) - 1) % PH_PER_LAYER) + 1)
#define IN(k) (((MK_MASK >> SLOT(k)) & 1u) && lo <= (k) && (k) < hi)
#define GRID_BAR() do { if (fused) xcd_barrier(bar); } while (0)
    const int NGW = F.G * NWAVES;
#define PHASE_ENTER() GAS unsigned char* wsg_ = (GAS unsigned char*)args.ws; asm volatile("" : "+s"(wsg_)); unsigned char* ws = (unsigned char*)wsg_; float* outp = (float*)(GAS float*)args.out; (void)outp; const CArgs* ka = (const CArgs*)__builtin_amdgcn_kernarg_segment_ptr(); asm volatile("" : "+s"(ka)); \
    int tid_ = (F.wv << 6) | mk_lane(); asm volatile("" : "+v"(tid_)); const int lane = tid_ & 63; const int wave = __builtin_amdgcn_readfirstlane(tid_ >> 6); const int gw = F.vcu * NWAVES + wave; (void)gw; (void)lane; (void)ws; (void)ka;
#define INP(i) ((const float*)(const GAS float*)ka->in[i])
#define MOD ((float*)(GAS float*)(ws + WS_MOD))
#define ROPE ((float*)(GAS float*)(ws + WS_ROPE))
#define SLABCNT ((int*)(GAS int*)(ws + WS_SLABCNT))
#define PCUM ((int*)(GAS int*)(ws + WS_PCUM))
#define TOKER ((int*)(GAS int*)(ws + WS_TOKER))
#define TOKG ((float*)(GAS float*)(ws + WS_TOKG))
#define TOKPOS ((int*)(GAS int*)(ws + WS_TOKPOS))
#define HCTX ((float*)(GAS float*)(ws + WS_HCTX))
#define RS ((bf16*)(GAS bf16*)(ws + WS_RS))
#define W_IN ((bf16*)(GAS bf16*)(ws + WS_WIN))
#define W_BR ((bf16*)(GAS bf16*)(ws + WS_WBR))
#define W_OUT ((bf16*)(GAS bf16*)(ws + WS_WOUT))
#define W_GUD ((bf16*)(GAS bf16*)(ws + WS_WGUD))
#define W_DND ((bf16*)(GAS bf16*)(ws + WS_WDND))
#define W_GUM8 ((unsigned char*)(GAS unsigned char*)(ws + WS_WGUM))
#define W_DNM8 ((unsigned char*)(GAS unsigned char*)(ws + WS_WDNM))
#define HX ((bf16*)(GAS bf16*)(ws + WS_HX))
#define ZM ((bf16*)(GAS bf16*)(ws + WS_ZM))
#define ZG ((bf16*)(GAS bf16*)(ws + WS_ZG))
#define OA ((bf16*)(GAS bf16*)(ws + WS_O))
#define OB (OA + (size_t)TA * BW)
#define OC (OA + (size_t)2 * TA * BW)
#define SB ((float*)(GAS float*)(ws + WS_ZM))
#define Y16 ((bf16*)(GAS bf16*)(ws + WS_ZG))
#define HD ((bf16*)(GAS bf16*)(ws + WS_ZM))
#define XG ((bf16*)(GAS bf16*)(ws + WS_XG))
#define HM8 ((unsigned char*)(GAS unsigned char*)(ws + WS_HM))
#define XG8 ((unsigned char*)(GAS unsigned char*)(ws + WS_XG8))
#define HX8 ((unsigned char*)(GAS unsigned char*)(ws + WS_HX8))
#define W_ING8 ((unsigned char*)(GAS unsigned char*)(ws + WS_WING8))

    if (IN(0)) {
        PHASE_ENTER();
        {
            LAS float* scv = (LAS float*)(F.lds + RING_OFF);
            LAS float* red = scv + 5 * 1024;
            for (int u = tid_; u < 5 * 1024; u += NWAVES * 64) { const int bb = u >> 10, k = u & 1023; const float cv = bb < 4 ? INP(I_C)[bb * 1024 + k] : INP(I_CCTX)[k]; scv[u] = cv / (1.0f + __expf(-cv)); }
            __syncthreads();
            for (int it = blockIdx.x; it < 2 * 96; it += F.G) {
                const int l = it / 96, n = (it % 96) * 64 + lane;
                const float* wp = INP(I_WADA) + (size_t)l * D * 6144 + n;
                float a0 = 0.f, a1 = 0.f, a2 = 0.f, a3 = 0.f, a4 = 0.f;
                const int kb = wave * 128;
#pragma unroll 16
                for (int k = 0; k < 128; ++k) { const float w = wp[(size_t)(kb + k) * 6144];
                    a0 += scv[kb + k] * w; a1 += scv[1024 + kb + k] * w; a2 += scv[2048 + kb + k] * w; a3 += scv[3072 + kb + k] * w; a4 += scv[4096 + kb + k] * w; }
                red[(wave * 5 + 0) * 64 + lane] = a0; red[(wave * 5 + 1) * 64 + lane] = a1; red[(wave * 5 + 2) * 64 + lane] = a2; red[(wave * 5 + 3) * 64 + lane] = a3; red[(wave * 5 + 4) * 64 + lane] = a4;
                __syncthreads();
                if (tid_ < 320) { const int bb = tid_ >> 6, nn = tid_ & 63; float s = 0.f;
#pragma unroll
                    for (int w = 0; w < 8; ++w) s += red[(w * 5 + bb) * 64 + nn];
                    const int col = (it % 96) * 64 + nn;
                    MOD[((size_t)l * 5 + bb) * 6144 + col] = s + INP(I_BADA)[l * 6144 + col]; }
                __syncthreads();
            }
        }
        if (blockIdx.x == F.G - 1) {
            for (int u = tid_; u < 192 * 16; u += NWAVES * 64) { const int idx = u >> 4, i = u & 15; const float pos = (float)(idx < 128 ? idx : idx - 128);
                const float inv = 1.0f / powf(10000.0f, (float)(2 * i) / 32.0f); const float ang = pos * inv;
                ROPE[2 * u] = cosf(ang); ROPE[2 * u + 1] = sinf(ang); }
        }
        __syncthreads();
        {
            LAS float* scr = (LAS float*)(F.lds + RING_OFF + wave * 16384);
            constexpr int I_IN = (D / 64) * (INC / 32), I_BR = (BW / 64) * (D / 32), I_OUT = (D / 64) * (D / 32), I_GUD = (D / 64) * (2 * FFD / 32), I_DND = (FFD / 64) * (D / 32),
                          I_GUM = (D / 64) * (2 * FFE / 32), I_DNM = (FFE / 64) * (D / 32);
            constexpr int NITEMS = 2 * I_IN + 6 * I_BR + 2 * I_OUT + I_GUD + I_DND + NE * I_GUM + NE * I_DNM;
            for (int it = gw; it < NITEMS; it += NGW) {
                int r = it;
                if (r < 2 * I_IN) { const int l = r / I_IN, it2 = r % I_IN, n0 = 32 * (it2 % (INC / 32));
                    if (MK_GATE_F8 == 2) { tr_item8(INP(I_WIN) + (size_t)l * D * INC, INC, 64 * (it2 / (INC / 32)), n0, (unsigned char*)W_IN + (size_t)l * INC * D, D, n0, SC_WGU, scr, lane); continue; }
                    if (!MK_GATE_F8 || n0 < ZMC) tr_matrix_item(INP(I_WIN) + (size_t)l * D * INC, D, INC, 0, W_IN + (size_t)l * INC * D, it2, scr, lane);
                    if (MK_GATE_F8 && n0 >= ZMC) tr_item8(INP(I_WIN) + (size_t)l * D * INC, INC, 64 * (it2 / (INC / 32)), n0, W_ING8 + (size_t)l * ZGC * D, D, n0 - ZMC, SC_WGU, scr, lane);
                    continue; } r -= 2 * I_IN;
                if (r < 6 * I_BR) { const int q = r / I_BR; tr_matrix_item(INP(I_WBRANCH) + (size_t)q * BW * D, BW, D, 0, W_BR + (size_t)q * D * BW, r % I_BR, scr, lane); continue; } r -= 6 * I_BR;
                if (r < 2 * I_OUT) { const int l = r / I_OUT; tr_matrix_item(INP(I_WOUT) + (size_t)l * D * D, D, D, 0, W_OUT + (size_t)l * D * D, r % I_OUT, scr, lane); continue; } r -= 2 * I_OUT;
                if (r < I_GUD) { if (MK_DENSE_F8 >= 2) tr_matrix_item8(INP(I_WGUD), D, 2 * FFD, FFD, (unsigned char*)W_GUD, SC_WGU, r, scr, lane); else tr_matrix_item(INP(I_WGUD), D, 2 * FFD, FFD, W_GUD, r, scr, lane); continue; } r -= I_GUD;
                if (r < I_DND) { if (MK_DENSE_F8 >= 1) tr_matrix_item8(INP(I_WDND), FFD, D, 0, (unsigned char*)W_DND, SC_WDN, r, scr, lane); else tr_matrix_item(INP(I_WDND), FFD, D, 0, W_DND, r, scr, lane); continue; } r -= I_DND;
                if (r < NE * I_GUM) { const int e = r / I_GUM; tr_matrix_item8(INP(I_WGUM) + (size_t)e * D * 2 * FFE, D, 2 * FFE, FFE, W_GUM8 + (size_t)e * 2 * FFE * D, SC_WGU, r % I_GUM, scr, lane); continue; } r -= NE * I_GUM;
                { const int e = r / I_DNM; tr_matrix_item8(INP(I_WDNM) + (size_t)e * FFE * D, FFE, D, 0, W_DNM8 + (size_t)e * D * FFE, SC_WDN, r % I_DNM, scr, lane); }
            }
        }
        GRID_BAR();
    }

    for (int l = 0; l < DEPTH; ++l) {
        const int pb = 1 + l * PH_PER_LAYER;
        const bool ctx_out = (l < DEPTH - 1);
        const bool moe = (l & 1) != 0;
        const int rows_out = ctx_out ? TA : TL;
#define modl (MOD + (size_t)l * 5 * 6144)
#define xsrc_lat ((l == 0) ? INP(I_X) : (const float*)outp)
#define xsrc_ctx ((l == 0) ? INP(I_CTX) : (const float*)HCTX)

        if (IN(pb + 0) && l == 0) {
            PHASE_ENTER();
            const int chunk = (TL + NGW - 1) / NGW;
#define P1_ROW(t) do { const float* xr = (t) < TL ? xsrc_lat + (size_t)(t) * D : xsrc_ctx + (size_t)((t) - TL) * D; \
                f32x4 x[4], h[4]; row_load(xr, lane, x); const float rr = row_rrms(x); row_normmod(x, rr, gpre, sh, sc, h); if (MK_GATE_F8 < 2) row_store_bf16(HX + (size_t)(t) * D, lane, h); if (MK_GATE_F8) row_store_fp8(HX8 + (size_t)(t) * D, lane, h, SC_XG); } while (0)
            f32x4 gpre[4], sh[4], sc[4]; vec_load(INP(I_GPREMIX) + l * D, lane, gpre);
            for (int t0 = min(gw * chunk, TL), t1 = min(TL, t0 + chunk); t0 < t1; ) { const int bb = t0 >> 13, te = min(t1, (bb + 1) << 13); const float* md = modl + (size_t)bb * 6144;
                vec_load(md, lane, sh); vec_load(md + 1024, lane, sc);
                for (int t = t0; t < te; ++t) P1_ROW(t);
                t0 = te; }
            { const float* md = modl + (size_t)4 * 6144; vec_load(md, lane, sh); vec_load(md + 1024, lane, sc); for (int t = TL + gw; t < TA; t += NGW) P1_ROW(t); }
#undef P1_ROW
            GRID_BAR();
        }
        if (IN(pb + 1)) {
            PHASE_ENTER();
#if MK_GATE_F8 == 2
            {
                pg8::Gemm g{(const bf16*)HX8, (const bf16*)((unsigned char*)W_IN + (size_t)l * INC * D), TA, ZMC, D}; pg8::StaticOrder S; S.init(TA, ZMC, F.G, (int)blockIdx.x, MK_WGM);
                pg8::EpiZT<true> E{ZM, ZG, ROPE, TL / 256, INP(I_BGATE) + (size_t)l * 3 * D, 0, 1.0f / (SC_XG * SC_WGU)};
                pg8::gemm_phase<pg8::EpiZT<true>, pg8::StaticOrder, PG8_ALIGN, PG8_SP2>(F.lds + RING_OFF, g, S, E, F.wv);
            }
            {
                pg8::Gemm g{(const bf16*)HX8, (const bf16*)((unsigned char*)W_IN + (size_t)l * INC * D + (size_t)ZMC * D), rows_out, ZGC, D}; pg8::StaticOrder S; S.init(rows_out, ZGC, F.G, (int)blockIdx.x, MK_WGM);
                pg8::EpiZT<true> E{ZM, ZG, ROPE, TL / 256, INP(I_BGATE) + (size_t)l * 3 * D, ZMC / 256, 1.0f / (SC_XG * SC_WGU)};
                pg8::gemm_phase<pg8::EpiZT<true>, pg8::StaticOrder, PG8_ALIGN, PG8_SP2>(F.lds + RING_OFF, g, S, E, F.wv);
            }
#elif MK_GATE_F8
            {
                pg8::Gemm g{HX, W_IN + (size_t)l * INC * D, TA, ZMC, D}; pg8::StaticOrder S; S.init(TA, ZMC, F.G, (int)blockIdx.x, MK_WGM);
                pg8::EpiZ E{ZM, ZG, ROPE, TL / 256, INP(I_BGATE) + (size_t)l * 3 * D, 0, 1.0f};
                pg8::gemm_phase<pg8::EpiZ, pg8::StaticOrder, PG8_ALIGN, PG8_SP2>(F.lds + RING_OFF, g, S, E, F.wv);
            }
            {
                pg8::Gemm g{(const bf16*)HX8, (const bf16*)(W_ING8 + (size_t)l * ZGC * D), rows_out, ZGC, D}; pg8::StaticOrder S; S.init(rows_out, ZGC, F.G, (int)blockIdx.x, MK_WGM);
                pg8::EpiZT<true> E{ZM, ZG, ROPE, TL / 256, INP(I_BGATE) + (size_t)l * 3 * D, ZMC / 256, 1.0f / (SC_XG * SC_WGU)};
                pg8::gemm_phase<pg8::EpiZT<true>, pg8::StaticOrder, PG8_ALIGN, PG8_SP2>(F.lds + RING_OFF, g, S, E, F.wv);
            }
#else
            pg8::Gemm g{HX, W_IN + (size_t)l * INC * D, TA, INC, D}; pg8::StaticOrder S; S.init(TA, INC, F.G, (int)blockIdx.x, MK_WGM);
            pg8::EpiZ E{ZM, ZG, ROPE, TL / 256, INP(I_BGATE) + (size_t)l * 3 * D, 0, 1.0f};
            pg8::gemm_phase<pg8::EpiZ, pg8::StaticOrder, PG8_ALIGN, PG8_SP2>(F.lds + RING_OFF, g, S, E, F.wv);
#endif
            GRID_BAR();
        }
        if (IN(pb + 3)) {
            PHASE_ENTER();
            const float* sinkp = INP(I_SINK) + l * 8; const float* rpbp = INP(I_RPB) + (size_t)l * 8 * 15 * 31;
            const float* cw = INP(I_CONVW) + (size_t)l * 3 * BW;
            {
                const int ch = 8 * lane;
                float cwr[3][8];
#pragma unroll
                for (int k = 0; k < 3; ++k) { const f32x4 a = *(const f32x4*)(cw + k * BW + ch), b = *(const f32x4*)(cw + k * BW + ch + 4); cwr[k][0] = a.x; cwr[k][1] = a.y; cwr[k][2] = a.z; cwr[k][3] = a.w; cwr[k][4] = b.x; cwr[k][5] = b.y; cwr[k][6] = b.z; cwr[k][7] = b.w; }
#define CONV_U(row, u) do { const bf16* zp_ = ZM + (size_t)(row) * ZMC; const v4u a_ = *(const v4u*)(zp_ + C_UX + ch), g_ = *(const v4u*)(zp_ + C_GC + ch); \
                    u[0] = bflo(a_.x) * bflo(g_.x); u[1] = bfhi(a_.x) * bfhi(g_.x); u[2] = bflo(a_.y) * bflo(g_.y); u[3] = bfhi(a_.y) * bfhi(g_.y); \
                    u[4] = bflo(a_.z) * bflo(g_.z); u[5] = bfhi(a_.z) * bfhi(g_.z); u[6] = bflo(a_.w) * bflo(g_.w); u[7] = bfhi(a_.w) * bfhi(g_.w); } while (0)
#define CONV_Z(u) do { _Pragma("unroll") for (int q_ = 0; q_ < 8; ++q_) u[q_] = 0.f; } while (0)
#define CONV_OUT(t) do { const v4u gbv = *(const v4u*)(ZM + (size_t)(t) * ZMC + C_GB + ch); \
                    const float gb[8] = {bflo(gbv.x), bfhi(gbv.x), bflo(gbv.y), bfhi(gbv.y), bflo(gbv.z), bfhi(gbv.z), bflo(gbv.w), bfhi(gbv.w)}; float o[8]; \
                    _Pragma("unroll") for (int q = 0; q < 8; ++q) o[q] = gb[q] * (cwr[0][q] * um[q] + cwr[1][q] * uc[q] + cwr[2][q] * up[q]); \
                    v4u w; w.x = pk2(o[0], o[1]); w.y = pk2(o[2], o[3]); w.z = pk2(o[4], o[5]); w.w = pk2(o[6], o[7]); \
                    *(v4u*)(OB + (size_t)(t) * BW + ch) = w; } while (0)
                const int cchunk = (TL + NGW - 1) / NGW;
                const int t0 = min(gw * cchunk, TL), t1 = min(TL, t0 + cchunk);
                if (t0 < t1) {
                    float um[8], uc[8], up[8];
                    if ((t0 & (SEQ - 1)) > 0) CONV_U(t0 - 1, um); else CONV_Z(um);
                    CONV_U(t0, uc);
                    for (int t = t0; t < t1; ++t) {
                        const int s = t & (SEQ - 1);
                        if (s == 0) CONV_Z(um);
                        if (s + 1 < SEQ) CONV_U(t + 1, up); else CONV_Z(up);
                        CONV_OUT(t);
#pragma unroll
                        for (int q = 0; q < 8; ++q) { um[q] = uc[q]; uc[q] = up[q]; }
                    }
                }
                for (int t = TL + gw; t < rows_out; t += NGW) {
                    const int s = (t - TL) & (CTXL - 1);
                    float um[8], uc[8], up[8];
                    if (s > 0) CONV_U(t - 1, um); else CONV_Z(um);
                    CONV_U(t, uc);
                    if (s + 1 < CTXL) CONV_U(t + 1, up); else CONV_Z(up);
                    CONV_OUT(t);
                }
#undef CONV_U
#undef CONV_Z
#undef CONV_OUT
            }
            at::attn_phase(F.lds + RING_OFF, ZM, OA, OC, sinkp, rpbp, F.vcu, F.G, ctx_out, tid_, wave, lane);
#ifdef MK_ATTN_PROBE
            at::attn_phase<MK_ATTN_PROBE>(F.lds + RING_OFF, ZM, (bf16*)(GAS bf16*)(ws + WS_HX), (bf16*)(GAS bf16*)(ws + WS_HX) + (size_t)TA * BW, sinkp, rpbp, F.vcu, F.G, ctx_out, tid_, wave, lane);
#endif
            GRID_BAR();
        }
        if (IN(pb + 4)) {
            PHASE_ENTER();
            pg8::Gemm g{OA, W_BR + (size_t)l * 3 * D * BW, rows_out, D, BW};
            pg8::BranchOrder3 S; S.so.init(rows_out, D, F.G, (int)blockIdx.x, MK_WGM);
            pg8::EpiBranchAcc E{HX, ZG};
            pg8::gemm_phase<pg8::EpiBranchAcc, pg8::BranchOrder3, PG8_ALIGN, PG8_SP2>(F.lds + RING_OFF, g, S, E, F.wv);
            GRID_BAR();
        }
        if (IN(pb + 5)) {
            PHASE_ENTER();
            pg8::Gemm g{HX, W_OUT + (size_t)l * D * D, rows_out, D, D}; pg8::StaticOrder S; S.init(rows_out, D, F.G, (int)blockIdx.x, MK_WGM);
            pg8::EpiBf16P E{Y16, D};
            pg8::gemm_phase<pg8::EpiBf16P, pg8::StaticOrder, PG8_ALIGN, PG8_SP2>(F.lds + RING_OFF, g, S, E, F.wv);
            GRID_BAR();
        }
        if (IN(pb + 6)) {
            PHASE_ENTER();
            if (!moe) {
                const int chunk = (TL + NGW - 1) / NGW;
#define P6_ROW(t) do { f32x4 x[4], y[4], h[4]; \
                    if (l == 0) row_load((t) < TL ? INP(I_X) + (size_t)(t) * D : INP(I_CTX) + (size_t)((t) - TL) * D, lane, x); else row_load_bf16(RS + (size_t)(t) * D, lane, x); \
                    row_load_bf16(Y16 + (size_t)(t) * D, lane, y); const float ry = row_rrms(y); \
                    _Pragma("unroll") for (int j = 0; j < 4; ++j) x[j] = x[j] + gt[j] * (y[j] * ry * gpo[j]); \
                    row_store_bf16(RS + (size_t)(t) * D, lane, x); const float rx = row_rrms(x); row_normmod(x, rx, gpre, sh, sc, h); \
                    if (MK_DENSE_F8 >= 2) row_store_fp8((unsigned char*)HX + (size_t)(t) * D, lane, h, SC_XG); else row_store_bf16(HX + (size_t)(t) * D, lane, h); } while (0)
                f32x4 gpo[4], gt[4], gpre[4], sh[4], sc[4]; vec_load(INP(I_GPOSTMIX) + l * D, lane, gpo); vec_load(INP(I_GPREFFN) + l * D, lane, gpre);
                for (int t0 = min(gw * chunk, TL), t1 = min(TL, t0 + chunk); t0 < t1; ) { const int bb = t0 >> 13, te = min(t1, (bb + 1) << 13); const float* md = modl + (size_t)bb * 6144;
                    vec_load(md + 2048, lane, gt); vec_load(md + 3072, lane, sh); vec_load(md + 4096, lane, sc);
                    for (int t = t0; t < te; ++t) P6_ROW(t);
                    t0 = te; }
                if (rows_out > TL) { const float* md = modl + (size_t)4 * 6144; vec_load(md + 2048, lane, gt); vec_load(md + 3072, lane, sh); vec_load(md + 4096, lane, sc); for (int t = TL + gw; t < rows_out; t += NGW) P6_ROW(t); }
#undef P6_ROW
            } else {
                LAS int* sel = (LAS int*)(F.lds + RING_OFF);
                LAS int* rnk = sel + 256;
                LAS f32x4* wrT = (LAS f32x4*)(F.lds + RING_OFF + 4096);
                const float* wr = INP(I_WROUTER) + (size_t)(l >> 1) * D * NE; const float* br = INP(I_BROUTER) + (l >> 1) * NE;
                for (int u = tid_; u < D * NE; u += NWAVES * 64) ((LAS float*)wrT)[(u & 7) * D + (u >> 3)] = wr[u];
                LDS_WAIT(); __syncthreads();
                f32x4 gpo[4], gt[4], gpre[4], sh[4], sc[4]; vec_load(INP(I_GPOSTMIX) + l * D, lane, gpo); vec_load(INP(I_GPREFFN) + l * D, lane, gpre);
                for (int slab = F.vcu; slab < TL / 128; slab += F.G) {
                    { const float* md = modl + (size_t)((slab * 128) >> 13) * 6144; vec_load(md + 2048, lane, gt); vec_load(md + 3072, lane, sh); vec_load(md + 4096, lane, sc); }
                    for (int i = 0; i < 16; ++i) {
                        const int tl_ = wave * 16 + i, t = slab * 128 + tl_;
                        f32x4 x[4], y[4], h[4]; if (l == 0) row_load(INP(I_X) + (size_t)t * D, lane, x); else row_load_bf16(RS + (size_t)t * D, lane, x);
                        row_load_bf16(Y16 + (size_t)t * D, lane, y);
                        const float ry = row_rrms(y);
#pragma unroll
                        for (int j = 0; j < 4; ++j) x[j] = x[j] + gt[j] * (y[j] * ry * gpo[j]);
                        row_store_bf16(RS + (size_t)t * D, lane, x);
                        const float rx = row_rrms(x);
                        row_normmod(x, rx, gpre, sh, sc, h);
                        row_store_bf16(HX + (size_t)t * D, lane, h);
                        float lg[8];
#pragma unroll
                        for (int e = 0; e < 8; ++e) lg[e] = 0.f;
#pragma unroll
                        for (int e = 0; e < 8; ++e)
#pragma unroll
                            for (int j = 0; j < 4; ++j) { const f32x4 w4 = wrT[e * (D / 4) + 2 * (64 * (j >> 1) + lane) + (j & 1)]; lg[e] += (h[j].x * w4.x + h[j].y * w4.y) + (h[j].z * w4.z + h[j].w * w4.w); }
#pragma unroll
                        for (int e = 0; e < 8; ++e) lg[e] = wave_sum(lg[e]) + br[e];
                        int e1 = 0; float v1 = lg[0];
#pragma unroll
                        for (int e = 1; e < 8; ++e) if (lg[e] > v1) { v1 = lg[e]; e1 = e; }
                        int e2 = -1; float v2 = -INFINITY;
#pragma unroll
                        for (int e = 0; e < 8; ++e) if (e != e1 && lg[e] > v2) { v2 = lg[e]; e2 = e; }
                        const float ex = __expf(v2 - v1), g1 = 1.0f / (1.0f + ex), g2 = ex / (1.0f + ex);
                        if (lane == 0) { sel[2 * tl_] = e1; sel[2 * tl_ + 1] = e2; TOKG[2 * (size_t)t] = g1; TOKG[2 * (size_t)t + 1] = g2; }
                    }
                    LDS_WAIT(); __syncthreads();
                    if (tid_ < 8) { int cnt = 0; for (int q = 0; q < 256; ++q) if (sel[q] == tid_) { rnk[q] = cnt; ++cnt; } SLABCNT[slab * 8 + tid_] = cnt; }
                    LDS_WAIT(); __syncthreads();
                    if (tid_ < 256) TOKER[(size_t)slab * 256 + tid_] = sel[tid_] | (rnk[tid_] << 8);
                    LDS_WAIT(); __syncthreads();
                }
            }
            GRID_BAR();
        }
        if (IN(pb + 7) && moe) {
            PHASE_ENTER();
            LAS int* scn = (LAS int*)(F.lds + RING_OFF);
            LAS int* pst = scn + 2048;
            for (int u = tid_; u < 2048; u += NWAVES * 64) scn[u] = SLABCNT[u];
            LDS_WAIT(); __syncthreads();
            if (tid_ < 8) { int run = 0; for (int q = 0; q < 256; ++q) { const int c = scn[q * 8 + tid_]; scn[q * 8 + tid_] = run; run += c; } pst[8 + tid_] = run; }
            LDS_WAIT(); __syncthreads();
            if (tid_ == 0) { int pan = 0; for (int e = 0; e < 8; ++e) { pst[e] = pan * 256; if (blockIdx.x == 0) PCUM[e] = pan; pan += (pst[8 + e] + 255) >> 8; } if (blockIdx.x == 0) PCUM[8] = pan; }
            LDS_WAIT(); __syncthreads();
            LAS int* posl = pst + 16;
            for (int slab = F.vcu; slab < TL / 128; slab += F.G) {
                if (tid_ < 256) { const int er = TOKER[(size_t)slab * 256 + tid_]; const int e = er & 255, rk = er >> 8; const int pos = pst[e] + scn[slab * 8 + e] + rk;
                    posl[tid_] = pos; TOKPOS[(size_t)slab * 256 + tid_] = pos; }
                LDS_WAIT(); __syncthreads();
                const v4u* srcb = (const v4u*)(HX + (size_t)slab * 128 * D);
#pragma unroll 4
                for (int i = 0; i < 16; ++i) { const int id = i * 512 + tid_, tk = id >> 6, chk = id & 63;
                    const v4u a = srcb[(size_t)tk * 128 + 2 * chk], b = srcb[(size_t)tk * 128 + 2 * chk + 1]; v4u o;
#define Q8(v) pg8::clamp_fp8((v) * SC_XG)
                    o.x = pg8::pk4_fp8(Q8(bflo(a.x)), Q8(bfhi(a.x)), Q8(bflo(a.y)), Q8(bfhi(a.y))); o.y = pg8::pk4_fp8(Q8(bflo(a.z)), Q8(bfhi(a.z)), Q8(bflo(a.w)), Q8(bfhi(a.w)));
                    o.z = pg8::pk4_fp8(Q8(bflo(b.x)), Q8(bfhi(b.x)), Q8(bflo(b.y)), Q8(bfhi(b.y))); o.w = pg8::pk4_fp8(Q8(bflo(b.z)), Q8(bfhi(b.z)), Q8(bflo(b.w)), Q8(bfhi(b.w)));
#undef Q8
                    ((v4u*)(XG8 + (size_t)posl[2 * tk] * D))[chk] = o; ((v4u*)(XG8 + (size_t)posl[2 * tk + 1] * D))[chk] = o; }
                LDS_WAIT(); __syncthreads();
            }
            GRID_BAR();
        }
        if (IN(pb + 8) && !moe) {
            PHASE_ENTER();
            pg8::Gemm g{HX, W_GUD, rows_out, 2 * FFD, D}; pg8::StaticOrder S; S.init(rows_out, 2 * FFD, F.G, (int)blockIdx.x, MK_WGM);
#if MK_DENSE_F8 >= 2
            pg8::EpiSwiglu8T<true> E{(unsigned char*)HD, FFD, 1.0f / (SC_XG * SC_WGU), SC_H};
            pg8::gemm_phase<pg8::EpiSwiglu8T<true>, pg8::StaticOrder, PG8_ALIGN, PG8_SP2>(F.lds + RING_OFF, g, S, E, F.wv);
#elif MK_DENSE_F8 == 1
            pg8::EpiSwiglu8T<false> E{(unsigned char*)HD, FFD, 1.0f, SC_H};
            pg8::gemm_phase<pg8::EpiSwiglu8T<false>, pg8::StaticOrder, PG8_ALIGN, PG8_SP2>(F.lds + RING_OFF, g, S, E, F.wv);
#else
            pg8::EpiSwiglu E{HD, FFD};
            pg8::gemm_phase<pg8::EpiSwiglu, pg8::StaticOrder, PG8_ALIGN, PG8_SP2>(F.lds + RING_OFF, g, S, E, F.wv);
#endif
            GRID_BAR();
        }
        if (IN(pb + 9) && !moe) {
            PHASE_ENTER();
            pg8::Gemm g{HD, W_DND, rows_out, D, FFD}; pg8::StaticOrder S; S.init(rows_out, D, F.G, (int)blockIdx.x, MK_WGM);
#if MK_DENSE_F8 >= 1
            pg8::EpiBf16PS8 E{Y16, D, 1.0f / (SC_H * SC_WDN)};
            pg8::gemm_phase<pg8::EpiBf16PS8, pg8::StaticOrder, PG8_ALIGN, PG8_SP2>(F.lds + RING_OFF, g, S, E, F.wv);
#else
            pg8::EpiBf16P E{Y16, D};
            pg8::gemm_phase<pg8::EpiBf16P, pg8::StaticOrder, PG8_ALIGN, PG8_SP2>(F.lds + RING_OFF, g, S, E, F.wv);
#endif
            GRID_BAR();
        }
        if (moe) {
            for (int ck = 0; ck < NCHUNK; ++ck) {
                if (IN(pb + 10 + 2 * ck)) {
                    PHASE_ENTER();
                    pg8::MoeOrder S; S.nN = 2 * FFE / 256; S.G = F.G; S.c = F.vcu; S.p_lo = ck * PCH;
#pragma unroll
                    for (int k = 0; k < 8; ++k) S.pc[k] = __builtin_amdgcn_readfirstlane(PCUM[k]);
                    const int ptot = __builtin_amdgcn_readfirstlane(PCUM[8]); S.np = min(max(ptot - ck * PCH, 0), PCH);
                    pg8::Gemm g{(const bf16*)XG8, (const bf16*)W_GUM8, 0, 2 * FFE, D};
                    pg8::EpiSwiglu8 E{HM8, FFE, 1.0f / (SC_XG * SC_WGU), SC_H};
                    pg8::gemm_phase<pg8::EpiSwiglu8, pg8::MoeOrder, PG8_ALIGN, PG8_SP2>(F.lds + RING_OFF, g, S, E, F.wv);
                    GRID_BAR();
                }
                if (IN(pb + 11 + 2 * ck)) {
                    PHASE_ENTER();
                    pg8::MoeOrder S; S.nN = D / 256; S.G = F.G; S.c = F.vcu; S.p_lo = ck * PCH;
#pragma unroll
                    for (int k = 0; k < 8; ++k) S.pc[k] = __builtin_amdgcn_readfirstlane(PCUM[k]);
                    const int ptot = __builtin_amdgcn_readfirstlane(PCUM[8]); S.np = min(max(ptot - ck * PCH, 0), PCH);
                    pg8::Gemm g{(const bf16*)HM8, (const bf16*)W_DNM8, 0, D, FFE};
                    pg8::EpiBf16PS8 E{XG, D, 1.0f / (SC_H * SC_WDN)};
                    pg8::gemm_phase<pg8::EpiBf16PS8, pg8::MoeOrder, PG8_ALIGN, PG8_SP2>(F.lds + RING_OFF, g, S, E, F.wv);
                    GRID_BAR();
                }
            }
        }
        if (IN(pb + 16)) {
            PHASE_ENTER();
            const int chunk = (TL + NGW - 1) / NGW; const bool nextl = (l + 1 < DEPTH);
#define P9_ROW(t) do { f32x4 x[4], y[4]; row_load_bf16(RS + (size_t)(t) * D, lane, x); \
                if (!moe) row_load_bf16(Y16 + (size_t)(t) * D, lane, y); \
                else { const int p0 = TOKPOS[2 * (size_t)(t)], p1 = TOKPOS[2 * (size_t)(t) + 1]; const float g0 = TOKG[2 * (size_t)(t)], g1 = TOKG[2 * (size_t)(t) + 1]; \
                    f32x4 ya[4], yb[4]; row_load_bf16(XG + (size_t)p0 * D, lane, ya); row_load_bf16(XG + (size_t)p1 * D, lane, yb); \
                    _Pragma("unroll") for (int j = 0; j < 4; ++j) y[j] = ya[j] * g0 + yb[j] * g1; } \
                const float ry = row_rrms(y); \
                _Pragma("unroll") for (int j = 0; j < 4; ++j) x[j] = x[j] + gt[j] * (y[j] * ry * gpo[j]); \
                if (nextl) row_store_bf16(RS + (size_t)(t) * D, lane, x); else if ((t) < TL) row_store(outp + (size_t)(t) * D, lane, x); \
                if (nextl) { f32x4 h[4]; const float rx = row_rrms(x); row_normmod(x, rx, gpre, sh, sc, h); if (MK_GATE_F8 < 2) row_store_bf16(HX + (size_t)(t) * D, lane, h); if (MK_GATE_F8) row_store_fp8(HX8 + (size_t)(t) * D, lane, h, SC_XG); } } while (0)
            f32x4 gpo[4], gt[4], gpre[4], sh[4], sc[4]; vec_load(INP(I_GPOSTFFN) + l * D, lane, gpo); vec_load(INP(I_GPREMIX) + (nextl ? l + 1 : l) * D, lane, gpre);
            for (int t0 = min(gw * chunk, TL), t1 = min(TL, t0 + chunk); t0 < t1; ) { const int bb = t0 >> 13, te = min(t1, (bb + 1) << 13); const float* md = modl + (size_t)bb * 6144;
                vec_load(md + 5120, lane, gt); vec_load(md + (nextl ? 5 * 6144 : 0), lane, sh); vec_load(md + (nextl ? 5 * 6144 : 0) + 1024, lane, sc);
                for (int t = t0; t < te; ++t) P9_ROW(t);
                t0 = te; }
            if (rows_out > TL) { const float* md = modl + (size_t)4 * 6144; vec_load(md + 5120, lane, gt); vec_load(md + (nextl ? 5 * 6144 : 0), lane, sh); vec_load(md + (nextl ? 5 * 6144 : 0) + 1024, lane, sc);
                for (int t = TL + gw; t < rows_out; t += NGW) P9_ROW(t); }
#undef P9_ROW
            if (l + 1 < DEPTH) GRID_BAR();
        }
    }
#undef IN
#undef GRID_BAR
}

extern "C" void kernel_launch(void* const* d_in, const int* in_sizes, int n_in, void* d_out, int out_size, void* d_ws, size_t ws_size, hipStream_t stream) {
    static int grid = 0;
    if (grid == 0) {
        if (n_in != 23 || in_sizes[0] != TL * D || out_size != TL * D || ws_size < WS_END) { fprintf(stderr, "kernel_launch: unexpected shapes: n_in %d in0 %d out %d ws %zu (need %zu); nothing launched\n", n_in, n_in > 0 ? in_sizes[0] : -1, out_size, ws_size, (size_t)WS_END); grid = -1; return; }
        int dev = 0, cus = 0, per_cu = 0;
        if (hipGetDevice(&dev) != hipSuccess || hipDeviceGetAttribute(&cus, hipDeviceAttributeMultiprocessorCount, dev) != hipSuccess) { fprintf(stderr, "kernel_launch: device query failed\n"); grid = -1; return; }
        if (hipFuncSetAttribute((const void*)mk_fwd, hipFuncAttributeMaxDynamicSharedMemorySize, LDS_BYTES) != hipSuccess) { fprintf(stderr, "kernel_launch: hipFuncSetAttribute failed\n"); grid = -1; return; }
        if (hipOccupancyMaxActiveBlocksPerMultiprocessor(&per_cu, (const void*)mk_fwd, NWAVES * 64, LDS_BYTES) != hipSuccess || per_cu < 1) fprintf(stderr, "kernel_launch: note: occupancy query reports %d\n", per_cu);
        (void)hipGetLastError();
        grid = cus;
    }
    if (grid < 0) return;
    if (hipMemsetAsync((char*)d_ws + WS_CTL, 0, CTL_ZERO_BYTES, stream) != hipSuccess) { fprintf(stderr, "kernel_launch: memset failed\n"); return; }
    Args a{};
    for (int i = 0; i < 23; ++i) a.in[i] = (const float*)d_in[i];
    a.out = (float*)d_out; a.ws = (unsigned char*)d_ws;
#if MK_PER_PHASE
    for (int ph = 0; ph < NPHASES; ++ph) { a.ph_lo = ph; a.ph_hi = ph + 1; hipLaunchKernelGGL(mk_fwd, dim3(grid), dim3(NWAVES * 64), LDS_BYTES, stream, a); }
#else
    a.ph_lo = 0; a.ph_hi = NPHASES;
    hipLaunchKernelGGL(mk_fwd, dim3(grid), dim3(NWAVES * 64), LDS_BYTES, stream, a);
#endif
    const hipError_t le = hipPeekAtLastError();
    if (le != hipSuccess) fprintf(stderr, "kernel_launch: launch failed: %s\n", hipGetErrorName(le));
}
```

```cpp
#include <hip/hip_runtime.h>
#include <cstdio>
#include <cstdint>
#ifndef MK_GATE_U8
#define MK_GATE_U8 1
#endif
#ifndef MK_GATE_F8
#define MK_GATE_F8 1
#endif

__device__ __forceinline__ int mk_lane() { unsigned z; asm volatile("s_mov_b32 %0, 0" : "=s"(z)); return (int)__builtin_amdgcn_mbcnt_hi(~0u, __builtin_amdgcn_mbcnt_lo(~0u, z)); }
template <int CTRL, int ROWMASK = 0xf> __device__ __forceinline__ float mk_dpp(float v) { return __builtin_bit_cast(float, __builtin_amdgcn_update_dpp(0, __builtin_bit_cast(int, v), CTRL, ROWMASK, 0xf, false)); }
__device__ __forceinline__ float mk_xor32(float v, bool upper) { const auto rr = __builtin_amdgcn_permlane32_swap(__builtin_bit_cast(unsigned, v), __builtin_bit_cast(unsigned, v), false, false); return __builtin_bit_cast(float, upper ? rr[0] : rr[1]); }
__device__ __forceinline__ int mk_xor16(int v) { return __builtin_amdgcn_ds_swizzle(v, 0x401F); }

namespace pg8 {
#define PG8_LAS __attribute__((address_space(3)))
typedef unsigned short bf16_t;
typedef short bf16x8 __attribute__((ext_vector_type(8)));
typedef float f32x4 __attribute__((ext_vector_type(4)));
typedef unsigned u32x4 __attribute__((ext_vector_type(4)));
typedef unsigned u32x2 __attribute__((ext_vector_type(2)));
typedef int v8i32 __attribute__((ext_vector_type(8)));
constexpr int BM = 256, BK = 64, HALF = 128, HTB = HALF * BK * 2  , STAGE_BYTES = 8 * HTB, NXCD = 8, WGM = 8;

__host__ __device__ __forceinline__ int lds_byte(int r, int c) { const int st = (r >> 4) * 2 + (c >> 5), rr = r & 15, cc = c & 31, ob = rr * 64 + cc * 2; return st * 1024 + (ob ^ (((ob >> 9) & 1) << 5)); }
__host__ __device__ __forceinline__ void stage_rc(int b, int& R, int& C) { const int st = b / 1024, sb = b % 1024, swz = sb ^ (((sb >> 9) & 1) << 5); R = (st >> 1) * 16 + swz / 64; C = (st & 1) * 32 + (swz % 64) / 2; }
__host__ __device__ __forceinline__ int perm32(int rho) { const int n = rho >> 4, i = rho & 15; return 8 * (i >> 2) + 4 * n + (i & 3); }

struct Unit { int pm, pn, pb; };
struct Gemm { const bf16_t* A; const bf16_t* Bt; int M, N, K; };

struct StaticOrder {
    int nM, nN, nwg, G, c, wgm;
    __host__ __device__ void init(int M, int N, int G_, int c_, int wgm_ = WGM) { nM = M / BM; nN = N / BM; nwg = nM * nN; G = G_; c = c_; wgm = wgm_; }
    __host__ __device__ bool next(int i, Unit& u) const {
        const long L = (long)i * G + c; if (L >= nwg) return false;
        int wgid = (int)L; { const int q = nwg / NXCD, r = nwg % NXCD, xcd = wgid % NXCD, off = wgid / NXCD; wgid = (xcd < r ? xcd * (q + 1) : r * (q + 1) + (xcd - r) * q) + off; }
        const int nig = wgm * nN, gid = wgid / nig, fm = gid * wgm, gsz = (nM - fm) < wgm ? (nM - fm) : wgm;
        u.pm = fm + ((wgid % nig) % gsz); u.pn = (wgid % nig) / gsz; u.pb = u.pn; return true;
    }
    __device__ __forceinline__ void a_ready(const Unit&) const {}
    __device__ __forceinline__ void done(const Unit&) const {}
};

__device__ __forceinline__ unsigned cvt_pk_bf16(float lo, float hi) { unsigned r; asm volatile("v_cvt_pk_bf16_f32 %0, %1, %2" : "=v"(r) : "v"(lo), "v"(hi)); return r; }
__device__ __forceinline__ float bf_lo(unsigned w) { return __uint_as_float(w << 16); }
__device__ __forceinline__ float bf_hi(unsigned w) { return __uint_as_float(w & 0xffff0000u); }
__device__ __forceinline__ float sigmoidf_(float x) { return __builtin_amdgcn_rcpf(1.0f + __builtin_amdgcn_exp2f(x * -1.4426950408889634f)); }

template <bool OPF8> struct EpiZT {
    static constexpr bool PERM = true, AFTER_DRAIN = false, HALFN = false, F8 = OPF8, RWACC = false;
    bf16_t* ZM; bf16_t* ZG; const float* rope; int n_lat_panels; const float* bgate; int pn_off; float gs;
    __device__ __forceinline__ void operator()(const f32x4 (&acc)[2][2][4][2], const Unit& u, int wr, int wc, int fr, int fq) const {
        const int row0 = u.pm * BM + wr * 64 + fr; int colt = (u.pn + pn_off) * BM; bf16_t* base = ZM; int ldc = 3840; bool isg = false;
        if (colt >= 3840) { base = ZG; colt -= 3840; ldc = 3072; isg = true; }
        const int col0 = colt + wc * 32 + 8 * fq;
        f32x4 gb[2][2];
        if (isg) {
#pragma unroll
            for (int bj = 0; bj < 2; ++bj) { gb[bj][0] = *(const f32x4*)(bgate + col0 + bj * HALF); gb[bj][1] = *(const f32x4*)(bgate + col0 + bj * HALF + 4); } }
        const int nrope = (u.pm < n_lat_panels) ? (u.pn + pn_off < 2 ? 2 : (u.pn + pn_off == 2 ? 1 : 0)) : 0;
#pragma unroll
        for (int ai = 0; ai < 2; ++ai)
#pragma unroll
            for (int m = 0; m < 4; ++m) { const int row = row0 + ai * HALF + m * 16; bf16_t* rowp = base + (size_t)row * ldc + col0;
                f32x4 cs[4];
                if (nrope) { const int s = row & 8191, pidx = (wc & 1) ? 128 + (s & 63) : (s >> 6); const f32x4* cp = (const f32x4*)(rope + (size_t)(pidx * 16 + 8 * (fq & 1)) * 2);
                    cs[0] = cp[0]; cs[1] = cp[1]; cs[2] = cp[2]; cs[3] = cp[3]; }
#pragma unroll
                for (int bj = 0; bj < 2; ++bj) { f32x4 v0 = acc[ai][bj][m][0], v1 = acc[ai][bj][m][1];
                    if (OPF8 && !isg) { v0 *= gs; v1 *= gs; }
                    if (isg) {
#pragma unroll
                        for (int j = 0; j < 4; ++j) { v0[j] = sigmoidf_(fminf(fmaxf(v0[j] * gs + gb[bj][0][j], -30.f), 30.f)); v1[j] = sigmoidf_(fminf(fmaxf(v1[j] * gs + gb[bj][1][j], -30.f), 30.f)); } }
                    if (bj < nrope) { const float sg = (fq >> 1) ? 1.f : -1.f;
                        float v[8] = {v0[0], v0[1], v0[2], v0[3], v1[0], v1[1], v1[2], v1[3]}, o[8];
#pragma unroll
                        for (int j = 0; j < 8; ++j) { const float pv = mk_xor32(v[j], (fq >> 1) != 0); const float c_ = cs[j >> 1][(j & 1) * 2], s_ = cs[j >> 1][(j & 1) * 2 + 1]; o[j] = v[j] * c_ + sg * pv * s_; }
                        v0 = (f32x4){o[0], o[1], o[2], o[3]}; v1 = (f32x4){o[4], o[5], o[6], o[7]}; }
                    if (MK_GATE_U8 && isg) {
                        unsigned b0 = 0u, b1 = 0u;
#pragma unroll
                        for (int j = 0; j < 4; ++j) { b0 = __builtin_amdgcn_cvt_pk_u8_f32(fmaxf(v0[j] * 255.f, 1.f), j, b0); b1 = __builtin_amdgcn_cvt_pk_u8_f32(fmaxf(v1[j] * 255.f, 1.f), j, b1); }
                        u32x2 w8; w8.x = b0; w8.y = b1;
                        *(u32x2*)((unsigned char*)ZG + (size_t)row * 3072 + col0 + bj * HALF) = w8;
                        continue; }
                    u32x4 w; w.x = cvt_pk_bf16(v0[0], v0[1]); w.y = cvt_pk_bf16(v0[2], v0[3]); w.z = cvt_pk_bf16(v1[0], v1[1]); w.w = cvt_pk_bf16(v1[2], v1[3]);
                    *(u32x4*)(rowp + bj * HALF) = w; } }
    }
};
typedef EpiZT<false> EpiZ;
struct EpiBf16P {
    static constexpr bool PERM = true, AFTER_DRAIN = false, HALFN = false, F8 = false, RWACC = false;
    bf16_t* O; int ldc;
    __device__ __forceinline__ void operator()(const f32x4 (&acc)[2][2][4][2], const Unit& u, int wr, int wc, int fr, int fq) const {
        const int row0 = u.pm * BM + wr * 64 + fr; const int col0 = u.pn * BM + wc * 32 + 8 * fq;
#pragma unroll
        for (int ai = 0; ai < 2; ++ai)
#pragma unroll
            for (int m = 0; m < 4; ++m) { bf16_t* rowp = O + (size_t)(row0 + ai * HALF + m * 16) * ldc + col0;
#pragma unroll
                for (int bj = 0; bj < 2; ++bj) { const f32x4 v0 = acc[ai][bj][m][0], v1 = acc[ai][bj][m][1];
                    u32x4 w; w.x = cvt_pk_bf16(v0[0], v0[1]); w.y = cvt_pk_bf16(v0[2], v0[3]); w.z = cvt_pk_bf16(v1[0], v1[1]); w.w = cvt_pk_bf16(v1[2], v1[3]);
                    *(u32x4*)(rowp + bj * HALF) = w; } }
    }
};
struct EpiBranchAcc {
    static constexpr bool PERM = true, AFTER_DRAIN = false, HALFN = false, F8 = false, RWACC = true;
    bf16_t* MG; const bf16_t* ZG;
    __device__ __forceinline__ bool restart(const Unit& u) const { return u.pm >= 264; }
    __device__ __forceinline__ void rw(f32x4 (&acc)[2][2][4][2], const Unit& u, int wr, int wc, int fr, int fq) const {
        const int r = u.pm / 132, pmt = u.pm - 132 * r, rn = r < 2 ? r + 1 : r;
        const int row0 = pmt * BM + wr * 64 + fr, col0 = u.pn * BM + wc * 32 + 8 * fq;
        constexpr int PG8_GD = 4;
        u32x4 gp[PG8_GD][2], gn[PG8_GD][2];
        constexpr unsigned GB = MK_GATE_U8 ? 1u : 2u;
        const unsigned o0 = (unsigned)row0 * (3072u * GB) + (unsigned)col0 * GB;
        const char* zp = (const char*)ZG + (size_t)r * 1024 * GB; const char* zn = (const char*)ZG + (size_t)rn * 1024 * GB;
#if MK_GATE_U8
#define PG8_GLOAD(s, buf) do { const int bj_ = (s) >> 2, ai_ = ((s) >> 1) & 1, mb_ = ((s) & 1) * 2; _Pragma("unroll") for (int q_ = 0; q_ < 2; ++q_) { \
            const unsigned off_ = o0 + (unsigned)(ai_ * HALF + (mb_ + q_) * 16) * 3072u + (unsigned)(bj_ * HALF); \
            const u32x2 a_ = *(const u32x2*)(zp + off_), b_ = *(const u32x2*)(zn + off_); gp[buf][q_].x = a_.x; gp[buf][q_].y = a_.y; gn[buf][q_].x = b_.x; gn[buf][q_].y = b_.y; } } while (0)
#else
#define PG8_GLOAD(s, buf) do { const int bj_ = (s) >> 2, ai_ = ((s) >> 1) & 1, mb_ = ((s) & 1) * 2; _Pragma("unroll") for (int q_ = 0; q_ < 2; ++q_) { \
            const unsigned off_ = o0 + (unsigned)(ai_ * HALF + (mb_ + q_) * 16) * 6144u + (unsigned)(bj_ * HALF * 2); \
            gp[buf][q_] = *(const u32x4*)(zp + off_); gn[buf][q_] = *(const u32x4*)(zn + off_); } } while (0)
#endif
#pragma unroll
        for (int s = 0; s < PG8_GD - 1; ++s) PG8_GLOAD(s, s);
#pragma unroll
        for (int s = 0; s < 8; ++s) { const int bj = s >> 2, ai = (s >> 1) & 1, mb = (s & 1) * 2, col = col0 + bj * HALF;
            if (s + PG8_GD - 1 < 8) PG8_GLOAD(s + PG8_GD - 1, (s + PG8_GD - 1) % PG8_GD);
            __builtin_amdgcn_sched_barrier(0);
#pragma unroll
            for (int q = 0; q < 2; ++q) { const int m = mb + q; const size_t row = (size_t)(row0 + ai * HALF + m * 16);
                const u32x4 g0 = gp[s % PG8_GD][q], g1 = gn[s % PG8_GD][q];
#if MK_GATE_U8
#define PG8_UB(w_, k_) ((float)(((w_) >> (8 * (k_))) & 255u))
                const float x[8] = {PG8_UB(g0.x, 0), PG8_UB(g0.x, 1), PG8_UB(g0.x, 2), PG8_UB(g0.x, 3), PG8_UB(g0.y, 0), PG8_UB(g0.y, 1), PG8_UB(g0.y, 2), PG8_UB(g0.y, 3)};
#else
                const float x[8] = {bf_lo(g0.x), bf_hi(g0.x), bf_lo(g0.y), bf_hi(g0.y), bf_lo(g0.z), bf_hi(g0.z), bf_lo(g0.w), bf_hi(g0.w)};
#endif
                if (r < 2) {
#if MK_GATE_U8
                    const float y[8] = {PG8_UB(g1.x, 0), PG8_UB(g1.x, 1), PG8_UB(g1.x, 2), PG8_UB(g1.x, 3), PG8_UB(g1.y, 0), PG8_UB(g1.y, 1), PG8_UB(g1.y, 2), PG8_UB(g1.y, 3)};
#else
                    const float y[8] = {bf_lo(g1.x), bf_hi(g1.x), bf_lo(g1.y), bf_hi(g1.y), bf_lo(g1.z), bf_hi(g1.z), bf_lo(g1.w), bf_hi(g1.w)};
#endif
#pragma unroll
                    for (int j = 0; j < 8; ++j) acc[ai][bj][m][j >> 2][j & 3] *= x[j] * __builtin_amdgcn_rcpf(y[j]);
                } else {
                    float v[8];
#pragma unroll
                    for (int j = 0; j < 8; ++j) v[j] = acc[ai][bj][m][j >> 2][j & 3] * (MK_GATE_U8 ? x[j] * (1.0f / 255.0f) : x[j]);
                    u32x4 w; w.x = cvt_pk_bf16(v[0], v[1]); w.y = cvt_pk_bf16(v[2], v[3]); w.z = cvt_pk_bf16(v[4], v[5]); w.w = cvt_pk_bf16(v[6], v[7]);
                    *(u32x4*)(MG + row * 1024 + col) = w;
                } }
        }
#undef PG8_GLOAD
    }
};
struct BranchOrder3 {
    StaticOrder so;
    __device__ __forceinline__ bool next(int i, Unit& u) const {
        const int ti = i / 3, r = i - 3 * ti; if (!so.next(ti, u)) return false;
        u.pb = 4 * r + u.pn; u.pm += 132 * r; return true;
    }
    __device__ __forceinline__ void a_ready(const Unit&) const {}
    __device__ __forceinline__ void done(const Unit&) const {}
};
struct EpiSwiglu {
    static constexpr bool PERM = true, AFTER_DRAIN = false, HALFN = false, F8 = false, RWACC = false;
    bf16_t* H; int ldh;
    __device__ __forceinline__ void operator()(const f32x4 (&acc)[2][2][4][2], const Unit& u, int wr, int wc, int fr, int fq) const {
        const int row0 = u.pm * BM + wr * 64 + fr; const int col0 = u.pn * HALF + wc * 32 + 8 * fq;
#pragma unroll
        for (int ai = 0; ai < 2; ++ai)
#pragma unroll
            for (int m = 0; m < 4; ++m) { bf16_t* rowp = H + (size_t)(row0 + ai * HALF + m * 16) * ldh + col0;
                float h[8];
#pragma unroll
                for (int n = 0; n < 2; ++n)
#pragma unroll
                    for (int j = 0; j < 4; ++j) { const float g = acc[ai][0][m][n][j], uu = acc[ai][1][m][n][j]; h[n * 4 + j] = g * sigmoidf_(g) * uu; }
                u32x4 w; w.x = cvt_pk_bf16(h[0], h[1]); w.y = cvt_pk_bf16(h[2], h[3]); w.z = cvt_pk_bf16(h[4], h[5]); w.w = cvt_pk_bf16(h[6], h[7]);
                *(u32x4*)rowp = w; }
    }
};
__device__ __forceinline__ unsigned pk4_fp8(float a, float b, float c, float d) { int w = __builtin_amdgcn_cvt_pk_fp8_f32(a, b, 0, false); w = __builtin_amdgcn_cvt_pk_fp8_f32(c, d, w, true); return (unsigned)w; }
__device__ __forceinline__ float clamp_fp8(float v) { return fminf(fmaxf(v, -448.0f), 448.0f); }
template <bool OPF8> struct EpiSwiglu8T {
    static constexpr bool PERM = true, AFTER_DRAIN = false, HALFN = false, F8 = OPF8, RWACC = false;
    unsigned char* H; int ldh; float sin, sout;
    __device__ __forceinline__ void operator()(const f32x4 (&acc)[2][2][4][2], const Unit& u, int wr, int wc, int fr, int fq) const {
        const int row0 = u.pm * BM + wr * 64 + fr; const int col0 = u.pn * HALF + wc * 32 + 8 * (fq & 2); const int odd = fq & 1;
#pragma unroll
        for (int ai = 0; ai < 2; ++ai)
#pragma unroll
            for (int mp = 0; mp < 2; ++mp) {
                unsigned w[2][2];
#pragma unroll
                for (int k = 0; k < 2; ++k) { const int m = 2 * mp + k; float h[8];
#pragma unroll
                    for (int n = 0; n < 2; ++n)
#pragma unroll
                        for (int j = 0; j < 4; ++j) { const float g = acc[ai][0][m][n][j] * sin, uu = acc[ai][1][m][n][j] * sin; h[n * 4 + j] = clamp_fp8(g * sigmoidf_(g) * uu * sout); }
                    w[k][0] = pk4_fp8(h[0], h[1], h[2], h[3]); w[k][1] = pk4_fp8(h[4], h[5], h[6], h[7]); }
                const unsigned s0 = odd ? w[0][0] : w[1][0], s1 = odd ? w[0][1] : w[1][1];
                const unsigned r0 = (unsigned)mk_xor16((int)s0), r1 = (unsigned)mk_xor16((int)s1);
                u32x4 st; if (odd) { st.x = r0; st.y = r1; st.z = w[1][0]; st.w = w[1][1]; } else { st.x = w[0][0]; st.y = w[0][1]; st.z = r0; st.w = r1; }
                *(u32x4*)(H + (size_t)(row0 + ai * HALF + (2 * mp + odd) * 16) * ldh + col0) = st; }
    }
};
typedef EpiSwiglu8T<true> EpiSwiglu8;
struct EpiBf16PS8 {
    static constexpr bool PERM = true, AFTER_DRAIN = false, HALFN = false, F8 = true, RWACC = false;
    bf16_t* O; int ldc; float s;
    __device__ __forceinline__ void operator()(const f32x4 (&acc)[2][2][4][2], const Unit& u, int wr, int wc, int fr, int fq) const {
        const int row0 = u.pm * BM + wr * 64 + fr; const int col0 = u.pn * BM + wc * 32 + 8 * fq;
#pragma unroll
        for (int ai = 0; ai < 2; ++ai)
#pragma unroll
            for (int m = 0; m < 4; ++m) { bf16_t* rowp = O + (size_t)(row0 + ai * HALF + m * 16) * ldc + col0;
#pragma unroll
                for (int bj = 0; bj < 2; ++bj) { const f32x4 v0 = acc[ai][bj][m][0] * s, v1 = acc[ai][bj][m][1] * s;
                    u32x4 w; w.x = cvt_pk_bf16(v0[0], v0[1]); w.y = cvt_pk_bf16(v0[2], v0[3]); w.z = cvt_pk_bf16(v1[0], v1[1]); w.w = cvt_pk_bf16(v1[2], v1[3]);
                    *(u32x4*)(rowp + bj * HALF) = w; } }
    }
};
struct MoeOrder {
    int nN, G, c, p_lo, np; int pc[8];
    __device__ __forceinline__ bool next(int i, Unit& u) const {
        const long L = (long)i * G + c; if (L >= (long)np * nN) return false;
        const int wgid = (int)L, nig = WGM * nN, gid = wgid / nig, fm = gid * WGM, gsz = (np - fm) < WGM ? (np - fm) : WGM;
        u.pm = p_lo + fm + ((wgid % nig) % gsz); u.pn = (wgid % nig) / gsz;
        int e = 0;
#pragma unroll
        for (int k = 1; k < 8; ++k) e += (u.pm >= pc[k]) ? 1 : 0;
        u.pb = e * nN + u.pn; return true;
    }
    __device__ __forceinline__ void a_ready(const Unit&) const {}
    __device__ __forceinline__ void done(const Unit&) const {}
};

template <class Epi, class Sched, bool ALIGN_EPI = false, bool SP2 = false>
__device__ __forceinline__ void gemm_phase(PG8_LAS unsigned char* lds, const Gemm g, const Sched& S, const Epi& E, int wv) {
    int tid_ = (wv << 6) | mk_lane(); asm volatile("" : "+v"(tid_));
    const int tid = tid_, wid = __builtin_amdgcn_readfirstlane(tid >> 6), lane = tid & 63, wr = wid >> 2, wc = wid & 3, fr = lane & 15, fq = lane >> 4;
    constexpr bool HN = Epi::HALFN;
    constexpr bool F8 = Epi::F8;
    constexpr int ES = F8 ? 1 : 2;
    const int K = g.K, nt = K * ES / (BK * 2);
    unsigned voffA[2], voffB[2];
#pragma unroll
    for (int i = 0; i < 2; ++i) { int R, C; stage_rc(tid * 16 + i * 8192, R, C); const int Rb = Epi::PERM ? ((R & ~31) + perm32(R & 31)) : R;
        voffA[i] = (unsigned)(R * K * ES + C * 2); voffB[i] = (unsigned)(Rb * K * ES + C * 2); }
    const size_t kstep = (size_t)(BK * 2);
    const size_t hstep = (size_t)HALF * K * ES;
    const size_t tstep = 2 * hstep;
    const unsigned ldsw = (unsigned)wid * 1024u;
    const int aoff = lds_byte(wr * 64 + fr, fq * 8), boff = lds_byte(wc * 32 + fr, fq * 8);
#define PG8_SA(b, h) (((b) * 2 + (h)) * HTB)
#define PG8_SB(b, h) ((4 + (b) * 2 + (h)) * HTB)
#define PG8_STAGE(bufoff, gbase, voff) do { _Pragma("unroll") for (int _i = 0; _i < 2; ++_i) \
        __builtin_amdgcn_global_load_lds((const unsigned*)((const char*)(gbase) + (voff)[_i]), (PG8_LAS unsigned*)(lds + (bufoff) + ldsw + _i * 8192), 16, 0, 0); } while (0)
#define PG8_LDA(dst, b, h) do { if constexpr (F8) { _Pragma("unroll") for (int m = 0; m < 4; ++m) { const u32x4 lo_ = *(const PG8_LAS u32x4*)(lds + PG8_SA(b, h) + aoff + m * 2048), hi_ = *(const PG8_LAS u32x4*)(lds + PG8_SA(b, h) + aoff + m * 2048 + 1024); \
            dst##8[m] = __builtin_bit_cast(v8i32, __builtin_shufflevector(lo_, hi_, 0, 1, 2, 3, 4, 5, 6, 7)); } } \
        else { _Pragma("unroll") for (int m = 0; m < 4; ++m) _Pragma("unroll") for (int k = 0; k < 2; ++k) dst[m][k] = *(const PG8_LAS bf16x8*)(lds + PG8_SA(b, h) + aoff + m * 2048 + k * 1024); } } while (0)
#define PG8_LDB(dst, b, h) do { if constexpr (F8) { _Pragma("unroll") for (int n = 0; n < 2; ++n) { const u32x4 lo_ = *(const PG8_LAS u32x4*)(lds + PG8_SB(b, h) + boff + n * 2048), hi_ = *(const PG8_LAS u32x4*)(lds + PG8_SB(b, h) + boff + n * 2048 + 1024); \
            dst##8[n] = __builtin_bit_cast(v8i32, __builtin_shufflevector(lo_, hi_, 0, 1, 2, 3, 4, 5, 6, 7)); } } \
        else { _Pragma("unroll") for (int n = 0; n < 2; ++n) _Pragma("unroll") for (int k = 0; k < 2; ++k) dst[n][k] = *(const PG8_LAS bf16x8*)(lds + PG8_SB(b, h) + boff + n * 2048 + k * 1024); } } while (0)
#define PG8_MMA(ai, bj, At, Bt) do { __builtin_amdgcn_s_setprio(1); _Pragma("unroll") for (int m = 0; m < 4; ++m) _Pragma("unroll") for (int n = 0; n < 2; ++n) { \
        if constexpr (F8) { asm volatile("v_mfma_f32_16x16x128_f8f6f4 %0, %1, %2, %0" : "+v"(acc[ai][bj][m][n]) : "v"(Bt##8[n]), "v"(At##8[m])); } \
        else { _Pragma("unroll") for (int k = 0; k < 2; ++k) acc[ai][bj][m][n] = __builtin_amdgcn_mfma_f32_16x16x32_bf16(Bt[n][k], At[m][k], acc[ai][bj][m][n], 0, 0, 0); } } \
        __builtin_amdgcn_s_setprio(0); } while (0)
#define PG8_LDB1(dst, b, h) do { if constexpr (!HN) { PG8_LDB(dst, b, h); } } while (0)
#define PG8_MMA1(ai, bj, At, Bt) do { if constexpr (!HN) { PG8_MMA(ai, bj, At, Bt); } } while (0)
#define PG8_WAIT_V(n) asm volatile("s_waitcnt vmcnt(" #n ")" ::: "memory")
#define PG8_WAIT_L(n) asm volatile("s_waitcnt lgkmcnt(" #n ")" ::: "memory")
#define PG8_BAR __builtin_amdgcn_s_barrier()
#define PG8_SCHED __builtin_amdgcn_sched_barrier(0)
    Unit cur, nxt; int ui = 0;
    if (!S.next(0, cur)) return;
    f32x4 acc[2][2][4][2];
#pragma unroll
    for (int a = 0; a < 2; ++a)
#pragma unroll
        for (int b = 0; b < 2; ++b)
#pragma unroll
            for (int m = 0; m < 4; ++m)
#pragma unroll
                for (int n = 0; n < 2; ++n) acc[a][b][m][n] = (f32x4){0.f, 0.f, 0.f, 0.f};
    bf16x8 At[4][2], B0[2][2], B1[2][2];
    v8i32 At8[4], B08[2], B18[2];
    const char* cA = (const char*)g.A + (size_t)cur.pm * tstep; const char* cB = (const char*)g.Bt + (size_t)cur.pb * (HN ? hstep : tstep);
    S.a_ready(cur);
    if constexpr (SP2) {
        PG8_STAGE(PG8_SB(0, 0), cB, voffB); PG8_STAGE(PG8_SB(0, 1), cB + hstep, voffB); PG8_STAGE(PG8_SA(0, 0), cA, voffA); PG8_STAGE(PG8_SA(0, 1), cA + hstep, voffA);
        if (wr == 1) PG8_BAR;
        PG8_WAIT_V(2); PG8_BAR;
        PG8_STAGE(PG8_SB(1, 0), cB + kstep, voffB); PG8_STAGE(PG8_SA(1, 0), cA + kstep, voffA); PG8_STAGE(PG8_SB(1, 1), cB + hstep + kstep, voffB);
        PG8_WAIT_V(6); PG8_BAR;
    } else {
        PG8_STAGE(PG8_SB(0, 0), cB, voffB); PG8_STAGE(PG8_SA(0, 0), cA, voffA); PG8_STAGE(PG8_SB(0, 1), cB + hstep, voffB); PG8_STAGE(PG8_SA(0, 1), cA + hstep, voffA);
        if (wr == 1) PG8_BAR;
        PG8_WAIT_V(4); PG8_BAR;
        PG8_STAGE(PG8_SB(1, 0), cB + kstep, voffB); PG8_STAGE(PG8_SA(1, 0), cA + kstep, voffA); PG8_STAGE(PG8_SB(1, 1), cB + hstep + kstep, voffB);
        PG8_WAIT_V(6); PG8_BAR;
    }
    for (;;) {
        const bool has_next = S.next(ui + 1, nxt);
        const char* nA = has_next ? (const char*)g.A + (size_t)nxt.pm * tstep : cA; const char* nB = has_next ? (const char*)g.Bt + (size_t)nxt.pb * (HN ? hstep : tstep) : cB;
        for (int t = 0; t < nt; t += 2) {
            const bool last = (t == nt - 2);
            const char* a1 = cA + (size_t)(t + 1) * kstep;
            const char* a2 = last ? nA : cA + (size_t)(t + 2) * kstep; const char* b2 = last ? nB : cB + (size_t)(t + 2) * kstep;
            const char* a3 = a2 + kstep; const char* b3 = b2 + kstep;
            if (last && has_next) S.a_ready(nxt);
            if constexpr (SP2) {
            PG8_LDB(B0, 0, 0); PG8_LDB1(B1, 0, 1); PG8_SCHED; PG8_LDA(At, 0, 0); PG8_STAGE(PG8_SA(1, 1), a1 + hstep, voffA);
            PG8_WAIT_V(8); PG8_WAIT_L(0); PG8_BAR; PG8_MMA(0, 0, At, B0); PG8_MMA1(0, 1, At, B1); PG8_BAR; PG8_SCHED;
            PG8_LDA(At, 0, 1); PG8_STAGE(PG8_SB(0, 0), b2, voffB); PG8_STAGE(PG8_SB(0, 1), b2 + hstep, voffB); PG8_STAGE(PG8_SA(0, 0), a2, voffA);
            PG8_WAIT_V(8); PG8_WAIT_L(0); PG8_BAR; PG8_MMA(1, 0, At, B0); PG8_MMA1(1, 1, At, B1); PG8_BAR; PG8_SCHED;
            PG8_LDB(B0, 1, 0); PG8_LDB1(B1, 1, 1); PG8_SCHED; PG8_LDA(At, 1, 0); PG8_STAGE(PG8_SA(0, 1), a2 + hstep, voffA);
            PG8_WAIT_V(8); PG8_WAIT_L(0); PG8_BAR; PG8_MMA(0, 0, At, B0); PG8_MMA1(0, 1, At, B1); PG8_BAR; PG8_SCHED;
            PG8_LDA(At, 1, 1); PG8_STAGE(PG8_SB(1, 0), b3, voffB); PG8_STAGE(PG8_SB(1, 1), b3 + hstep, voffB); PG8_STAGE(PG8_SA(1, 0), a3, voffA);
            PG8_WAIT_V(8); PG8_WAIT_L(0); PG8_BAR; PG8_MMA(1, 0, At, B0); PG8_MMA1(1, 1, At, B1); PG8_BAR; PG8_SCHED;
            } else {
            PG8_LDB(B0, 0, 0); PG8_SCHED; PG8_LDA(At, 0, 0); PG8_STAGE(PG8_SA(1, 1), a1 + hstep, voffA);
            PG8_WAIT_L(8); PG8_BAR; PG8_WAIT_L(0); PG8_MMA(0, 0, At, B0); PG8_BAR; PG8_SCHED;
            PG8_LDB1(B1, 0, 1); PG8_STAGE(PG8_SB(0, 0), b2, voffB);
            PG8_BAR; PG8_WAIT_L(0); PG8_MMA1(0, 1, At, B1); PG8_BAR;
            PG8_LDA(At, 0, 1); PG8_STAGE(PG8_SA(0, 0), a2, voffA);
            PG8_BAR; PG8_WAIT_L(0); PG8_MMA(1, 0, At, B0); PG8_BAR; PG8_SCHED;
            PG8_STAGE(PG8_SB(0, 1), b2 + hstep, voffB);
            PG8_WAIT_V(6); PG8_BAR; PG8_MMA1(1, 1, At, B1); PG8_BAR;
            PG8_LDB(B0, 1, 0); PG8_SCHED; PG8_LDA(At, 1, 0); PG8_STAGE(PG8_SA(0, 1), a2 + hstep, voffA);
            PG8_WAIT_L(8); PG8_BAR; PG8_WAIT_L(0); PG8_MMA(0, 0, At, B0); PG8_BAR; PG8_SCHED;
            PG8_LDB1(B1, 1, 1); PG8_STAGE(PG8_SB(1, 0), b3, voffB);
            PG8_BAR; PG8_WAIT_L(0); PG8_MMA1(0, 1, At, B1); PG8_BAR;
            PG8_LDA(At, 1, 1); PG8_STAGE(PG8_SA(1, 0), a3, voffA);
            PG8_BAR; PG8_WAIT_L(0); PG8_MMA(1, 0, At, B0); PG8_BAR; PG8_SCHED;
            PG8_STAGE(PG8_SB(1, 1), b3 + hstep, voffB);
            PG8_WAIT_V(6); PG8_BAR; PG8_MMA1(1, 1, At, B1); PG8_BAR;
            }
        }
        if constexpr (F8) asm volatile("s_nop 15\n\ts_nop 15" ::: "memory");
        if constexpr (ALIGN_EPI) { if (wr == 0) PG8_BAR; }
        if constexpr (Epi::RWACC) { E.rw(acc, cur, wr, wc, fr, fq); S.done(cur); }
        else if constexpr (!Epi::AFTER_DRAIN) { E(acc, cur, wr, wc, fr, fq); S.done(cur); }
        if (!has_next) break;
        bool zero_acc = true; if constexpr (Epi::RWACC) zero_acc = E.restart(cur);
        if (zero_acc)
#pragma unroll
        for (int a = 0; a < 2; ++a)
#pragma unroll
            for (int b = 0; b < 2; ++b)
#pragma unroll
                for (int m = 0; m < 4; ++m)
#pragma unroll
                    for (int n = 0; n < 2; ++n) acc[a][b][m][n] = (f32x4){0.f, 0.f, 0.f, 0.f};
        cur = nxt; cA = nA; cB = nB; ++ui;
        if constexpr (ALIGN_EPI) { if (wr == 1) PG8_BAR; }
    }
    PG8_WAIT_V(0);
    if constexpr (!ALIGN_EPI) { if (wr == 0) PG8_BAR; }
    PG8_BAR;
    if constexpr (Epi::AFTER_DRAIN) { E.fused(acc, cur, wr, wc, fr, fq, lds, wid, lane); S.done(cur); }
#undef PG8_SA
#undef PG8_SB
#undef PG8_STAGE
#undef PG8_LDA
#undef PG8_LDB
#undef PG8_MMA
#undef PG8_LDB1
#undef PG8_MMA1
#undef PG8_WAIT_V
#undef PG8_WAIT_L
#undef PG8_BAR
#undef PG8_SCHED
}
}

#ifndef PG8_SP2
#define PG8_SP2 true
#endif
#ifndef PG8_ALIGN
#define PG8_ALIGN true
#endif
#ifndef MK_WGM
#define MK_WGM 4
#endif
#ifndef MK_DENSE_F8
#define MK_DENSE_F8 1
#endif
#ifndef MK_PER_PHASE
#define MK_PER_PHASE 0
#endif

constexpr int NWAVES = 8;
constexpr int D = 1024, BATCH = 4, SEQ = 8192, CTXL = 256, DEPTH = 2;
constexpr int TL = BATCH * SEQ, TC = BATCH * CTXL, TA = TL + TC;
constexpr int INC = 6912, ZMC = 3840, ZGC = 3072, BW = 512;
constexpr int FFD = 2816, FFE = 3584, NE = 8;
constexpr int MAXPAN = 264, PCH = 264, NCHUNK = 1;
constexpr float RMS_EPS = 1e-6f;
constexpr float SC_XG = 4.0f, SC_WGU = 32.0f, SC_H = 4.0f, SC_WDN = 64.0f;
constexpr int C_QA = 0, C_KA = 512, C_VA = 640, C_UX = 768, C_GB = 1280, C_GC = 1792, C_QN = 2304, C_KN = 2816, C_VN = 3328;

constexpr size_t MiB = 1u << 20;
constexpr size_t WS_CTL = 0, CTL_ZERO_BYTES = 1 * MiB;
constexpr size_t WS_MOD = 1 * MiB;
constexpr size_t WS_ROPE = WS_MOD + 256 * 1024;
constexpr size_t WS_SLABCNT = WS_MOD + 320 * 1024;
constexpr size_t WS_PCUM = WS_MOD + 384 * 1024;
constexpr size_t WS_TOKER = WS_MOD + 512 * 1024;
constexpr size_t WS_TOKG = WS_MOD + 768 * 1024;
constexpr size_t WS_TOKPOS = WS_MOD + 1024 * 1024;
constexpr size_t WS_HCTX = 4 * MiB;
constexpr size_t WS_WIN = 8 * MiB;
constexpr size_t WS_WBR = 35 * MiB;
constexpr size_t WS_WOUT = 41 * MiB;
constexpr size_t WS_WGUD = 45 * MiB;
constexpr size_t WS_WDND = 56 * MiB;
constexpr size_t WS_WGUM = 62 * MiB;
constexpr size_t WS_WDNM = 118 * MiB;
constexpr size_t WS_RS = 146 * MiB;
constexpr size_t WS_HX = 230 * MiB;
constexpr size_t WS_ZM = 296 * MiB;
constexpr size_t WS_ZG = 544 * MiB;
constexpr size_t WS_O = 742 * MiB;
constexpr size_t WS_XG = WS_ZM;
constexpr size_t WS_HM = WS_ZM + 132 * MiB;
constexpr size_t WS_XG8 = WS_O;
constexpr size_t WS_HX8 = 841 * MiB;
constexpr size_t WS_WING8 = 874 * MiB;
constexpr size_t WS_END = 880 * MiB;
static_assert(WS_WIN + (size_t)2 * INC * D * 2 <= WS_WBR && WS_WGUD + (size_t)2 * FFD * D * 2 <= WS_WDND && WS_WDND + (size_t)D * FFD * 2 <= WS_WGUM, "ws map (weights)");
static_assert(WS_WGUM + (size_t)NE * 2 * FFE * D <= WS_WDNM && WS_WDNM + (size_t)NE * D * FFE <= WS_RS && WS_RS + (size_t)TA * D * 2 <= WS_HX, "ws map (moe weights, residual stream)");
static_assert(WS_HX + (size_t)TA * D * 2 <= WS_ZM && WS_ZM + (size_t)TA * ZMC * 2 <= WS_ZG && WS_ZG + (size_t)TA * ZGC * 2 <= WS_O && WS_O + (size_t)3 * TA * BW * 2 <= WS_END, "ws map (activations)");
static_assert(WS_HM + (size_t)MAXPAN * 256 * FFE <= WS_O && WS_XG8 + (size_t)MAXPAN * 256 * D <= WS_END && (size_t)MAXPAN * 256 * D * 2 <= 132 * MiB && (size_t)TA * D * 4 <= 132 * MiB, "ws map (moe)");
constexpr int CW_BAR = 4096;

constexpr int RING_OFF = 0, RING_BYTES = 131072;
constexpr int LDSCTL_OFF = RING_BYTES, MISC_OFF = LDSCTL_OFF + 320;
constexpr int LDS_BYTES = 147456;

#define GAS __attribute__((address_space(1)))
#define LAS __attribute__((address_space(3)))
typedef unsigned short bf16;
typedef unsigned v4u __attribute__((ext_vector_type(4)));
typedef unsigned v2u __attribute__((ext_vector_type(2)));
typedef float f32x4 __attribute__((ext_vector_type(4)));
typedef float f32x2 __attribute__((ext_vector_type(2)));
#define LDS_WAIT() asm volatile("s_waitcnt lgkmcnt(0)" ::: "memory")
#define VM_WAIT() asm volatile("s_waitcnt vmcnt(0)" ::: "memory")
__device__ __forceinline__ unsigned f2bf(float f) { unsigned u = __builtin_bit_cast(unsigned, f); return (u + 0x7fffu + ((u >> 16) & 1u)) >> 16; }
__device__ __forceinline__ unsigned pk2(float lo, float hi) { return f2bf(lo) | (f2bf(hi) << 16); }
__device__ __forceinline__ float bflo(unsigned w) { return __uint_as_float(w << 16); }
__device__ __forceinline__ float bfhi(unsigned w) { return __uint_as_float(w & 0xffff0000u); }
__device__ __forceinline__ float bf2f(bf16 b) { return __uint_as_float(((unsigned)b) << 16); }

#define XB_TMO      128
#define XB_XCNT(j)  (256  + 64 * (j))
#define XB_XSUB(j)  (1280 + 64 * (j))
#define XB_XGEN(j)  (2304 + 64 * (j))
#define XB_TOP      3328
#define XB_TOPGEN   3392
#define XCD_BAR_WORDS 3456
#define XB_SPIN_CAP (1u << 21)

__device__ __forceinline__ unsigned xb_ld(unsigned* p)              { return __hip_atomic_load(p, __ATOMIC_RELAXED, __HIP_MEMORY_SCOPE_AGENT); }
__device__ __forceinline__ unsigned xb_add(unsigned* p, unsigned v) { return __hip_atomic_fetch_add(p, v, __ATOMIC_RELAXED, __HIP_MEMORY_SCOPE_AGENT); }
__device__ __forceinline__ unsigned xb_xcc_id() { return (unsigned)__builtin_amdgcn_s_getreg((3 << 11) | 20) & 0xFu; }
#define XB_SPIN(cond, bar) do { unsigned _sp = 0; while (cond) { __builtin_amdgcn_s_sleep(1); \
    if ((++_sp & 255u) == 0u) { if (xb_ld(&(bar)[XB_TMO])) break; if (_sp > XB_SPIN_CAP) { atomicAdd(&(bar)[XB_TMO], 1u); break; } } } } while (0)

struct XcdBarrier {
    unsigned* bar; unsigned x;
    volatile LAS unsigned* st;
    int w;
};

__device__ __forceinline__ XcdBarrier xcd_barrier_post(unsigned* bar, volatile LAS unsigned* st) {
    XcdBarrier b; b.bar = bar; b.x = xb_xcc_id(); b.st = st; b.w = 0;
    if (threadIdx.x == 0) (void)xb_add(&bar[XB_XCNT(b.x)], 1u);
    return b;
}
__device__ __forceinline__ void xcd_barrier_complete(unsigned* bar, unsigned x, unsigned& nloc, unsigned& nx) {
    const unsigned G = gridDim.x * gridDim.y * gridDim.z;
    unsigned sum, cnt, mine, sp = 0u;
    for (;;) {
        sum = 0u; cnt = 0u; mine = 0u;
#pragma unroll
        for (unsigned j = 0; j < 16; ++j) { const unsigned c = xb_ld(&bar[XB_XCNT(j)]); sum += c; cnt += (c > 0u) ? 1u : 0u; mine = (j == x) ? c : mine; }
        if (sum == G) break;
        __builtin_amdgcn_s_sleep(1);
        if ((++sp & 255u) == 0u) { if (xb_ld(&bar[XB_TMO])) break; if (sp > XB_SPIN_CAP) { atomicAdd(&bar[XB_TMO], 1u); break; } }
    }
    nloc = mine > 0u ? mine : 1u; nx = cnt > 0u ? cnt : 1u;
}

__device__ __forceinline__ void xcd_barrier(const XcdBarrier& b) {
    asm volatile("s_waitcnt vmcnt(0)" ::: "memory");
    __syncthreads();
    if (b.w == 0 && mk_lane() == 0) {
        unsigned* bar = b.bar; { GAS unsigned* bg_ = (GAS unsigned*)bar; asm volatile("" : "+s"(bg_)); bar = (unsigned*)bg_; }
        __builtin_amdgcn_s_waitcnt(0);
        unsigned nloc = b.st[0], nx = b.st[1];
        if (nloc == 0u) { xcd_barrier_complete(bar, b.x, nloc, nx); b.st[0] = nloc; b.st[1] = nx; }
        const unsigned old = xb_add(&bar[XB_XSUB(b.x)], 1u);
        const unsigned gen = old / nloc;
        if (old + 1u == (gen + 1u) * nloc) {
            __builtin_amdgcn_fence(__ATOMIC_RELEASE, "agent");
            asm volatile("s_waitcnt vmcnt(0)" ::: "memory");
            const unsigned og = xb_add(&bar[XB_TOP], 1u);
            const unsigned tg = og / nx;
            if (og + 1u == (tg + 1u) * nx) xb_add(&bar[XB_TOPGEN], 1u);
            else XB_SPIN(xb_ld(&bar[XB_TOPGEN]) == tg, bar);
            __builtin_amdgcn_fence(__ATOMIC_ACQUIRE, "agent");
            xb_add(&bar[XB_XGEN(b.x)], 1u);
            asm volatile("s_waitcnt vmcnt(0)" ::: "memory");
        } else {
            XB_SPIN(xb_ld(&bar[XB_XGEN(b.x)]) == gen, bar);
            __builtin_amdgcn_fence(__ATOMIC_ACQUIRE, "agent");
            asm volatile("s_waitcnt vmcnt(0)" ::: "memory");
        }
    }
    __syncthreads();
}

struct Frame {
    LAS unsigned char* lds;
    volatile LAS unsigned* MISC;
    unsigned* ctl;
    int vcu, G;
    int wv;
};
enum { I_X = 0, I_C, I_CTX, I_CCTX, I_WADA, I_BADA, I_GPREMIX, I_GPOSTMIX, I_GPREFFN, I_GPOSTFFN, I_WIN, I_BGATE, I_SINK, I_CONVW, I_RPB, I_WBRANCH, I_WOUT, I_WGUD, I_WDND, I_WROUTER, I_BROUTER, I_WGUM, I_WDNM };

__device__ __forceinline__ float wave_sum(float v) {
    v += mk_dpp<0xB1>(v); v += mk_dpp<0x4E>(v); v += mk_dpp<0x141>(v); v += mk_dpp<0x140>(v);
    v += mk_dpp<0x142, 0xa>(v); v += mk_dpp<0x143, 0xc>(v);
    return __builtin_bit_cast(float, __builtin_amdgcn_readlane(__builtin_bit_cast(int, v), 63));
}
__device__ __forceinline__ float wave_max(float v) {
    v = fmaxf(v, mk_dpp<0xB1>(v)); v = fmaxf(v, mk_dpp<0x4E>(v)); v = fmaxf(v, mk_dpp<0x141>(v)); v = fmaxf(v, mk_dpp<0x140>(v));
    const float a = __builtin_bit_cast(float, __builtin_amdgcn_readlane(__builtin_bit_cast(int, v), 0)), b = __builtin_bit_cast(float, __builtin_amdgcn_readlane(__builtin_bit_cast(int, v), 16)),
                c = __builtin_bit_cast(float, __builtin_amdgcn_readlane(__builtin_bit_cast(int, v), 32)), d = __builtin_bit_cast(float, __builtin_amdgcn_readlane(__builtin_bit_cast(int, v), 48));
    return fmaxf(fmaxf(a, b), fmaxf(c, d));
}

__device__ __forceinline__ void row_store_fp8(unsigned char* p, int lane, const f32x4 (&h)[4], float sc) {
#pragma unroll
    for (int c = 0; c < 2; ++c) { const f32x4 a = __builtin_elementwise_min(__builtin_elementwise_max(h[2 * c] * sc, (f32x4){-448.f, -448.f, -448.f, -448.f}), (f32x4){448.f, 448.f, 448.f, 448.f}), b = __builtin_elementwise_min(__builtin_elementwise_max(h[2 * c + 1] * sc, (f32x4){-448.f, -448.f, -448.f, -448.f}), (f32x4){448.f, 448.f, 448.f, 448.f});
        v2u w; w.x = pg8::pk4_fp8(a.x, a.y, a.z, a.w); w.y = pg8::pk4_fp8(b.x, b.y, b.z, b.w);
        *(v2u*)(p + 8 * (64 * c + lane)) = w; }
}

__device__ __forceinline__ void tr_item(const float* W, int N, int k0, int n0, bf16* WT, int Kd, int drow0, LAS float* scr, int lane) {
#pragma unroll
    for (int i = 0; i < 8; ++i) { const int kk = 8 * i + (lane >> 3), c4 = 4 * (lane & 7); const f32x4 v = *(const f32x4*)(W + (size_t)(k0 + kk) * N + n0 + c4);
        LAS float* d = scr + kk * 33 + c4; d[0] = v.x; d[1] = v.y; d[2] = v.z; d[3] = v.w; }
    LDS_WAIT(); asm volatile("" ::: "memory");
    const int c = lane & 7;
#pragma unroll
    for (int j = 0; j < 4; ++j) { const int n = (lane >> 3) + 8 * j; const LAS float* s = scr + (8 * c) * 33 + n;
        v4u o; o.x = pk2(s[0 * 33], s[1 * 33]); o.y = pk2(s[2 * 33], s[3 * 33]); o.z = pk2(s[4 * 33], s[5 * 33]); o.w = pk2(s[6 * 33], s[7 * 33]);
        *(v4u*)(WT + (size_t)(drow0 + n) * Kd + k0 + 8 * c) = o; }
    LDS_WAIT(); asm volatile("" ::: "memory");
}
__device__ __forceinline__ void tr_matrix_item(const float* W, int K, int N, int ff, bf16* WT, int item, LAS float* scr, int lane) {
    const int nblk = N / 32, kb = item / nblk, nb = item % nblk, n0 = 32 * nb;
    int drow0 = n0;
    if (ff > 0) { const int isu = n0 >= ff ? 1 : 0, nn = n0 - isu * ff; drow0 = 256 * (nn >> 7) + 128 * isu + (nn & 127); }
    tr_item(W, N, 64 * kb, n0, WT, K, drow0, scr, lane);
}

__device__ __forceinline__ void tr_item8(const float* W, int N, int k0, int n0, unsigned char* WT, int Kd, int drow0, float scale, LAS float* scr, int lane) {
#pragma unroll
    for (int i = 0; i < 8; ++i) { const int kk = 8 * i + (lane >> 3), c4 = 4 * (lane & 7); const f32x4 v = *(const f32x4*)(W + (size_t)(k0 + kk) * N + n0 + c4);
        LAS float* d = scr + kk * 33 + c4; d[0] = v.x; d[1] = v.y; d[2] = v.z; d[3] = v.w; }
    LDS_WAIT(); asm volatile("" ::: "memory");
    const int n = lane >> 1, kh = lane & 1; const LAS float* s = scr + (32 * kh) * 33 + n;
    unsigned w[8];
#pragma unroll
    for (int j = 0; j < 8; ++j) w[j] = pg8::pk4_fp8(s[(4 * j) * 33] * scale, s[(4 * j + 1) * 33] * scale, s[(4 * j + 2) * 33] * scale, s[(4 * j + 3) * 33] * scale);
    v4u* dst = (v4u*)(WT + (size_t)(drow0 + n) * Kd + k0 + 32 * kh);
    dst[0] = (v4u){w[0], w[1], w[2], w[3]}; dst[1] = (v4u){w[4], w[5], w[6], w[7]};
    LDS_WAIT(); asm volatile("" ::: "memory");
}
__device__ __forceinline__ void tr_matrix_item8(const float* W, int K, int N, int ff, unsigned char* WT, float scale, int item, LAS float* scr, int lane) {
    const int nblk = N / 32, kb = item / nblk, nb = item % nblk, n0 = 32 * nb;
    int drow0 = n0;
    if (ff > 0) { const int isu = n0 >= ff ? 1 : 0, nn = n0 - isu * ff; drow0 = 256 * (nn >> 7) + 128 * isu + (nn & 127); }
    tr_item8(W, N, 64 * kb, n0, WT, K, drow0, scale, scr, lane);
}

__device__ __forceinline__ void row_load(const float* p, int lane, f32x4 (&v)[4]) {
#pragma unroll
    for (int c = 0; c < 2; ++c) { const f32x4* r = (const f32x4*)(p + 8 * (64 * c + lane)); v[2 * c] = r[0]; v[2 * c + 1] = r[1]; }
}
__device__ __forceinline__ void row_load_bf16(const bf16* p, int lane, f32x4 (&v)[4]) {
#pragma unroll
    for (int c = 0; c < 2; ++c) { const v4u w = *(const v4u*)(p + 8 * (64 * c + lane));
        v[2 * c] = (f32x4){bflo(w.x), bfhi(w.x), bflo(w.y), bfhi(w.y)}; v[2 * c + 1] = (f32x4){bflo(w.z), bfhi(w.z), bflo(w.w), bfhi(w.w)}; }
}
__device__ __forceinline__ void row_store(float* p, int lane, const f32x4 (&v)[4]) {
#pragma unroll
    for (int c = 0; c < 2; ++c) { f32x4* r = (f32x4*)(p + 8 * (64 * c + lane)); r[0] = v[2 * c]; r[1] = v[2 * c + 1]; }
}
__device__ __forceinline__ float row_rrms(const f32x4 (&v)[4]) {
    float s = 0.f;
#pragma unroll
    for (int j = 0; j < 4; ++j) s += (v[j].x * v[j].x + v[j].y * v[j].y) + (v[j].z * v[j].z + v[j].w * v[j].w);
    return 1.0f / sqrtf(wave_sum(s) * (1.0f / D) + RMS_EPS);
}
__device__ __forceinline__ void vec_load(const float* p, int lane, f32x4 (&v)[4]) { row_load(p, lane, v); }
__device__ __forceinline__ void row_normmod(const f32x4 (&x)[4], float rr, const f32x4 (&g)[4], const f32x4 (&shift)[4], const f32x4 (&scale)[4], f32x4 (&h)[4]) {
#pragma unroll
    for (int j = 0; j < 4; ++j) h[j] = (x[j] * rr * g[j]) * (scale[j] + 1.0f) + shift[j];
}
__device__ __forceinline__ void row_store_bf16(bf16* p, int lane, const f32x4 (&h)[4]) {
#pragma unroll
    for (int c = 0; c < 2; ++c) { v4u w; w.x = pk2(h[2 * c].x, h[2 * c].y); w.y = pk2(h[2 * c].z, h[2 * c].w); w.z = pk2(h[2 * c + 1].x, h[2 * c + 1].y); w.w = pk2(h[2 * c + 1].z, h[2 * c + 1].w);
        *(v4u*)(p + 8 * (64 * c + lane)) = w; }
}

namespace at {
typedef short bf16x8 __attribute__((ext_vector_type(8)));
typedef short s16x4 __attribute__((ext_vector_type(4)));
typedef short v4i16_t __attribute__((ext_vector_type(4)));
typedef float f32x16 __attribute__((ext_vector_type(16)));
constexpr int NS = 4, PF = 3, SLOT = 16384;
constexpr int LDS_TAB = NS * SLOT + 1024;
constexpr int LDS_TT = LDS_TAB + 8 * 2048 + 1024;
constexpr int MAXT = 160;
constexpr float LOG2E = 1.4426950408889634f, C2 = 0.125f * LOG2E;
__device__ __forceinline__ unsigned cvtpk(float lo, float hi) { unsigned r; asm volatile("v_cvt_pk_bf16_f32 %0, %1, %2" : "=v"(r) : "v"(lo), "v"(hi)); return r; }
__device__ __forceinline__ float hmax(float v) { auto rr = __builtin_amdgcn_permlane32_swap(__float_as_uint(v), __float_as_uint(v), false, false); return fmaxf(__uint_as_float(rr[0]), __uint_as_float(rr[1])); }
__device__ __forceinline__ float hsum(float v) { auto rr = __builtin_amdgcn_permlane32_swap(__float_as_uint(v), __float_as_uint(v), false, false); return __uint_as_float(rr[0]) + __uint_as_float(rr[1]); }

__device__ __forceinline__ void glds16(const void* gsrc, unsigned lds_dst) { unsigned keep;
    asm volatile("s_mov_b32 %0, m0\n\ts_mov_b32 m0, %2\n\ts_nop 0\n\tglobal_load_lds_dwordx4 %1, off\n\ts_mov_b32 m0, %0" : "=&s"(keep) : "v"(gsrc), "s"(lds_dst) : "memory"); }
__device__ __forceinline__ void tile_issue(LAS unsigned char* slot, const bf16* ZMp, size_t row0, int kcol, int vcol, int wid, int lane) {
    const bf16* ksrc = ZMp + (row0 + lane) * ZMC + kcol + wid * 8;
    const bf16* vsrc = ZMp + (row0 + 16 * (wid & 3) + (lane >> 2)) * ZMC + vcol + (wid >> 2) * 32 + (lane & 3) * 8;
    const unsigned dst = (unsigned)__builtin_amdgcn_readfirstlane((int)(unsigned)(uintptr_t)slot + wid * 1024);
    glds16(ksrc, dst); glds16(vsrc, dst + 8192u);
}
__device__ __forceinline__ void qk_tile(f32x16& p0, f32x16& p1, const LAS unsigned char* Ks, const bf16x8 (&qr)[4], int r32, int hi) {
    const LAS unsigned char* kb = Ks + hi * 1024 + r32 * 16;
    bf16x8 kf[8];
#pragma unroll
    for (int d0 = 0; d0 < 4; ++d0) { kf[2 * d0] = *(const LAS bf16x8*)(kb + d0 * 2048); kf[2 * d0 + 1] = *(const LAS bf16x8*)(kb + d0 * 2048 + 512); }
    __builtin_amdgcn_sched_barrier(0);
#pragma unroll
    for (int r = 0; r < 16; ++r) { p0[r] = 0.f; p1[r] = 0.f; }
#pragma unroll
    for (int d0 = 0; d0 < 4; ++d0) {
        p0 = __builtin_amdgcn_mfma_f32_32x32x16_bf16(kf[2 * d0], qr[d0], p0, 0, 0, 0);
        p1 = __builtin_amdgcn_mfma_f32_32x32x16_bf16(kf[2 * d0 + 1], qr[d0], p1, 0, 0, 0);
    }
}
__device__ __forceinline__ s16x4 vtr(const LAS unsigned char* p) { return __builtin_bit_cast(s16x4, __builtin_amdgcn_ds_read_tr16_b64_v4i16((LAS v4i16_t*)p)); }
template <int LV> __device__ __forceinline__ constexpr bool live0(int r) { return LV == 2 ? r >= 12 : true; }
template <int LV> __device__ __forceinline__ constexpr bool live1(int r) { return LV == 1 ? r < 4 : true; }
template <bool RAW, int LV, int VAR = 0>
__device__ __forceinline__ void sm_pv(f32x16& x0, f32x16& x1, float& m, float& l, f32x16 (&o)[2], const LAS unsigned char* Vs, int lane, int hi) {
    if (VAR == 2) { l += x0[0] + x1[15];
        bf16x8 pw_[4]; unsigned w_[16];
#pragma unroll
        for (int i = 0; i < 8; ++i) { w_[i] = cvtpk(x0[2 * i], x0[2 * i + 1]); w_[8 + i] = cvtpk(x1[2 * i], x1[2 * i + 1]); }
#pragma unroll
        for (int k = 0; k < 4; ++k) { typedef unsigned u32x4_ __attribute__((ext_vector_type(4))); u32x4_ t; t.x = w_[4 * k]; t.y = w_[4 * k + 1]; t.z = w_[4 * k + 2]; t.w = w_[4 * k + 3]; pw_[k] = __builtin_bit_cast(bf16x8, t); }
        const LAS unsigned char* vb_ = Vs + ((lane >> 4) & 1) * 32 + (lane & 3) * 8 + (4 * hi + ((lane & 15) >> 2)) * 64;
#pragma unroll
        for (int d0 = 0; d0 < 2; ++d0)
#pragma unroll
            for (int ks = 0; ks < 4; ++ks) { if ((LV == 1 && ks == 3) || (LV == 2 && ks == 0)) continue;
                const s16x4 lo = vtr(vb_ + d0 * 4096 + ks * 1024), hh = vtr(vb_ + d0 * 4096 + ks * 1024 + 512);
                const bf16x8 vf = (bf16x8){lo[0], lo[1], lo[2], lo[3], hh[0], hh[1], hh[2], hh[3]};
                o[d0] = __builtin_amdgcn_mfma_f32_32x32x16_bf16(vf, pw_[ks], o[d0], 0, 0, 0); }
        return; }
    if (VAR == 3) { l += x0[0] + x1[15] + x0[7] + x1[3]; o[0][0] += x0[1]; o[1][0] += x1[1]; return; }
    float rm = -INFINITY;
#pragma unroll
    for (int r = 0; r < 16; ++r) { if (live0<LV>(r)) rm = fmaxf(rm, x0[r]); if (live1<LV>(r)) rm = fmaxf(rm, x1[r]); }
    rm = hmax(rm);
    const float mn = fmaxf(m, RAW ? rm * C2 : rm);
    { const float sc = __builtin_amdgcn_exp2f(m - mn); l *= sc;
#pragma unroll
      for (int r = 0; r < 16; ++r) { o[0][r] *= sc; o[1][r] *= sc; } }
    m = mn;
    float sum = 0.f;
#pragma unroll
    for (int r = 0; r < 16; ++r) {
        if (live0<LV>(r)) { x0[r] = __builtin_amdgcn_exp2f(RAW ? __builtin_fmaf(x0[r], C2, -mn) : x0[r] - mn); sum += x0[r]; } else x0[r] = 0.f;
        if (live1<LV>(r)) { x1[r] = __builtin_amdgcn_exp2f(RAW ? __builtin_fmaf(x1[r], C2, -mn) : x1[r] - mn); sum += x1[r]; } else x1[r] = 0.f;
    }
    l += sum;
    bf16x8 pw[4];
    { unsigned w[16];
#pragma unroll
      for (int i = 0; i < 8; ++i) { w[i] = cvtpk(x0[2 * i], x0[2 * i + 1]); w[8 + i] = cvtpk(x1[2 * i], x1[2 * i + 1]); }
#pragma unroll
      for (int k = 0; k < 4; ++k) { typedef unsigned u32x4_ __attribute__((ext_vector_type(4))); u32x4_ t; t.x = w[4 * k]; t.y = w[4 * k + 1]; t.z = w[4 * k + 2]; t.w = w[4 * k + 3]; pw[k] = __builtin_bit_cast(bf16x8, t); } }
    const LAS unsigned char* vb = Vs + ((lane >> 4) & 1) * 32 + (lane & 3) * 8 + (4 * hi + ((lane & 15) >> 2)) * 64;
    s16x4 vlo[8], vhh[8];
    __builtin_amdgcn_sched_barrier(0);
#pragma unroll
    for (int d0 = 0; d0 < 2; ++d0)
#pragma unroll
        for (int ks = 0; ks < 4; ++ks) { if ((LV == 1 && ks == 3) || (LV == 2 && ks == 0)) continue;
            vlo[d0 * 4 + ks] = vtr(vb + d0 * 4096 + ks * 1024); vhh[d0 * 4 + ks] = vtr(vb + d0 * 4096 + ks * 1024 + 512); }
    __builtin_amdgcn_sched_barrier(0);
#pragma unroll
    for (int d0 = 0; d0 < 2; ++d0)
#pragma unroll
        for (int ks = 0; ks < 4; ++ks) {
            if ((LV == 1 && ks == 3) || (LV == 2 && ks == 0)) continue;
            const s16x4 lo = vlo[d0 * 4 + ks], hh = vhh[d0 * 4 + ks];
            const bf16x8 vf = (bf16x8){lo[0], lo[1], lo[2], lo[3], hh[0], hh[1], hh[2], hh[3]};
            o[d0] = __builtin_amdgcn_mfma_f32_32x32x16_bf16(vf, pw[ks], o[d0], 0, 0, 0);
        }
}
__device__ __forceinline__ void o_store(const f32x16 (&o)[2], float l, bf16* orow, int hi) {
    const float inv = __builtin_amdgcn_rcpf(hsum(l));
#pragma unroll
    for (int d0 = 0; d0 < 2; ++d0)
#pragma unroll
        for (int gp = 0; gp < 2; ++gp) {
            unsigned w[2][2];
#pragma unroll
            for (int k = 0; k < 2; ++k) { const int g = 2 * gp + k; w[k][0] = cvtpk(o[d0][4 * g] * inv, o[d0][4 * g + 1] * inv); w[k][1] = cvtpk(o[d0][4 * g + 2] * inv, o[d0][4 * g + 3] * inv); }
            unsigned rcv[2];
#pragma unroll
            for (int i = 0; i < 2; ++i) { const unsigned snd = hi ? w[0][i] : w[1][i];
                auto rr = __builtin_amdgcn_permlane32_swap(snd, snd, false, false); rcv[i] = hi ? rr[0] : rr[1]; }
            v4u st; if (hi) { st.x = rcv[0]; st.y = rcv[1]; st.z = w[1][0]; st.w = w[1][1]; } else { st.x = w[0][0]; st.y = w[0][1]; st.z = rcv[0]; st.w = rcv[1]; }
            *(v4u*)(orow + 32 * d0 + 16 * gp + 8 * hi) = st;
        }
}
#define AT_WAIT_BAR(N) asm volatile("s_waitcnt vmcnt(" #N ")\n\ts_barrier" ::: "memory")

struct UDesc { int kind, b, hh, blk, cq, nw, lo; };
__device__ __forceinline__ UDesc unit_desc(int i, int vcu, int UPW, bool ctx_out) {
    UDesc d; d.kind = -1; d.b = 0; d.hh = 0; d.blk = 0; d.cq = 0; d.nw = 0; d.lo = 0;
    if (i < 2 * UPW) { const int u = vcu * UPW + (i < UPW ? i : i - UPW); if (u >= 1024) return d; d.kind = i < UPW ? 0 : 1; d.b = u >> 8;
        if (d.kind == 0) { d.hh = (u >> 5) & 7; d.blk = u & 31; } else { d.hh = (u >> 7) & 1; d.blk = u & 127; } }
    else if (i == 2 * UPW) { if (!ctx_out || vcu >= 64) return d; d.cq = 1;
        if (vcu < 32) { d.kind = 1; d.b = vcu >> 3; d.hh = (vcu >> 2) & 1; d.blk = vcu & 3; } else { d.kind = 0; d.b = (vcu - 32) >> 3; d.hh = (vcu - 32) & 7; d.blk = 0; } }
    else return d;
    if (!d.cq) {
        if (d.kind == 1) { d.lo = max(0, 2 - d.blk); d.nw = min(4, 129 - d.blk) - d.lo + 1; }
        else { d.lo = min(max(4 * d.blk - 4, 0), 120); d.nw = min(max(4 * d.blk - 1, 0), 120) + 7 - d.lo + 1; }
    }
    return d;
}
__device__ __forceinline__ void tile_src(const UDesc& d, int t, int& row0, int& cols) {
    const int kcol = d.kind == 1 ? C_KA + d.hh * 64 : C_KN + d.hh * 64, vcol = d.kind == 1 ? C_VA + d.hh * 64 : C_VN + d.hh * 64;
    cols = kcol | (vcol << 16);
    if (t < d.nw) row0 = d.kind == 1 ? d.b * SEQ + 64 * d.blk - 128 + 64 * (d.lo + t) : d.b * SEQ + 64 * (d.lo + t);
    else row0 = TL + d.b * CTXL + 64 * (t - d.nw);
}
__device__ __forceinline__ size_t q_row(const UDesc& d, int wid, int r32) {
    if (d.kind == 1) { const int qrel = 32 * (wid >> 2) + r32; return d.cq ? (size_t)TL + (size_t)d.b * CTXL + 64 * d.blk + qrel : (size_t)d.b * SEQ + 64 * d.blk + qrel; }
    const int pair = wid >> 1, c = 32 * (wid & 1) + r32;
    return d.cq ? (size_t)TL + (size_t)d.b * CTXL + 64 * pair + c : (size_t)d.b * SEQ + (size_t)(4 * d.blk + pair) * 64 + c;
}
__device__ __forceinline__ void q_load(const UDesc& d, const bf16* ZMp, int wid, int r32, int hi, bf16x8 (&qr)[4]) {
    const int qcol = d.kind == 1 ? C_QA + (d.hh * 4 + (wid & 3)) * 64 : C_QN + d.hh * 64;
    const bf16* p = ZMp + q_row(d, wid, r32) * ZMC + qcol + 8 * hi;
#pragma unroll
    for (int d0 = 0; d0 < 4; ++d0) qr[d0] = *(const bf16x8*)(p + 16 * d0);
}

template <int VAR = 0>
__device__ __forceinline__ void attn_phase(LAS unsigned char* lds, const bf16* ZMp, bf16* OAp, bf16* OCp, const float* sinkp, const float* rpbl, int vcu, int G, bool ctx_out, int tid, int wid, int lane) {
    const int r32 = lane & 31, hi = lane >> 5;
    const int UPW = (1024 + G - 1) / G, NU = 2 * UPW + 1;
    LAS int* tt = (LAS int*)(lds + LDS_TT);
    int Ttot = 0;
    for (int i = 0; i < NU; ++i) { const UDesc d = unit_desc(i, vcu, UPW, ctx_out); if (d.kind < 0) continue; const int nt = d.nw + 4;
        for (int t = tid; t < nt; t += NWAVES * 64) { int row0, cols; tile_src(d, t, row0, cols); if (Ttot + t < MAXT) { tt[2 * (Ttot + t)] = row0; tt[2 * (Ttot + t) + 1] = cols; } }
        Ttot += nt; }
    if (Ttot > MAXT) Ttot = MAXT;
    if (tid < 8) ((LAS float*)(lds + LDS_TT + MAXT * 8))[tid] = sinkp[tid] * LOG2E;
    for (int u = tid; u < 8 * 480; u += NWAVES * 64) { const int h = u / 480, e = u - 480 * h, dr = e >> 5, dc = e & 31; ((LAS float*)(lds + LDS_TAB))[h * 512 + e] = dc < 31 ? rpbl[(h * 15 + dr) * 31 + dc] * LOG2E : 0.f; }
    asm volatile("s_waitcnt lgkmcnt(0)\n\ts_barrier" ::: "memory");
#define AT_ISSUE(T) do { const int row0_ = __builtin_amdgcn_readfirstlane(tt[2 * (T)]), cols_ = __builtin_amdgcn_readfirstlane(tt[2 * (T) + 1]); \
        tile_issue(lds + ((T) & (NS - 1)) * SLOT, ZMp, (size_t)row0_, cols_ & 0xffff, cols_ >> 16, wid, lane); } while (0)
    for (int T = 0; T < PF && T < Ttot; ++T) AT_ISSUE(T);
    int Tb = 0;
    bf16x8 qn[4];
    { int i0 = 0; UDesc d0 = unit_desc(0, vcu, UPW, ctx_out); while (d0.kind < 0 && i0 + 1 < NU) { ++i0; d0 = unit_desc(i0, vcu, UPW, ctx_out); } if (d0.kind >= 0) q_load(d0, ZMp, wid, r32, hi, qn); }
    for (int i = 0; i < NU; ++i) {
        const UDesc d = unit_desc(i, vcu, UPW, ctx_out); if (d.kind < 0) continue;
        bf16x8 qr[4];
#pragma unroll
        for (int k = 0; k < 4; ++k) qr[k] = qn[k];
        { int j = i + 1; UDesc dn = unit_desc(j, vcu, UPW, ctx_out); while (dn.kind < 0 && j + 1 < NU) { ++j; dn = unit_desc(j, vcu, UPW, ctx_out); } if (dn.kind < 0) dn = d; q_load(dn, ZMp, wid, r32, hi, qn); }
        const int NT = d.nw + 4;
        f32x16 o[2];
#pragma unroll
        for (int r = 0; r < 16; ++r) { o[0][r] = 0.f; o[1][r] = 0.f; }
        float m, l;
        if (d.kind == 1) {
            const int head = d.hh * 4 + (wid & 3), qrel = 32 * (wid >> 2) + r32;
            m = ((const LAS float*)(lds + LDS_TT + MAXT * 8))[head]; l = (hi == 0) ? 1.0f : 0.0f;
            int t = 0;
            do {
                const int T = Tb + t, outst = min(Ttot, T + PF) - (T + 1);
                if (outst >= 2) AT_WAIT_BAR(4); else if (outst == 1) AT_WAIT_BAR(2); else AT_WAIT_BAR(0);
                if (t == NT - 1) asm volatile("" : "+v"(qn[0]), "+v"(qn[1]), "+v"(qn[2]), "+v"(qn[3]));
                if (VAR != 5 && T + PF < Ttot) AT_ISSUE(T + PF);
                const LAS unsigned char* sl = lds + (T & (NS - 1)) * SLOT;
                f32x16 x0, x1; if (VAR == 4) { for (int r_ = 0; r_ < 16; ++r_) { x0[r_] = __builtin_bit_cast(float, (int)qr[r_ & 3][0] << 16) ; x1[r_] = x0[r_] * 0.5f; } } else qk_tile(x0, x1, sl, qr, r32, hi);
                const int j = d.lo + t;
                if (t < d.nw && (j == 0 || j == 4)) {
                    const int dq = qrel + 128 - 64 * j - 4 * hi;
#pragma unroll
                    for (int r = 0; r < 16; ++r) { const int dd = dq - ((r & 3) + 8 * (r >> 2));
                        x0[r] = (dd <= 128 && dd >= -128) ? x0[r] * C2 : -INFINITY; x1[r] = (dd - 32 <= 128 && dd - 32 >= -128) ? x1[r] * C2 : -INFINITY; }
                    sm_pv<false, 0, VAR>(x0, x1, m, l, o, sl + 8192, lane, hi);
                } else sm_pv<true, 0, VAR>(x0, x1, m, l, o, sl + 8192, lane, hi);
            } while (++t < NT);
            o_store(o, l, OAp + q_row(d, wid, r32) * BW + head * 64, hi);
        } else {
            const int half = wid & 1, c = 32 * half + r32, r = 4 * d.blk + (wid >> 1);
            const int r0w = min(max(r - 4, 0), 120), c0 = min(max(c - 8, 0), 48);
            const LAS float* tab = (const LAS float*)(lds + LDS_TAB + d.hh * 2048);
            unsigned vm = 0u;
#pragma unroll
            for (int r_ = 0; r_ < 16; ++r_) { const int kc = (r_ & 3) + 8 * (r_ >> 2) + 4 * hi; vm |= ((unsigned)(kc - c0) < 16u ? 1u : 0u) << r_; vm |= ((unsigned)(kc + 32 - c0) < 16u ? 1u : 0u) << (16 + r_); }
            m = -1e30f; l = 0.f;
            int t = 0;
            do {
                const int T = Tb + t, outst = min(Ttot, T + PF) - (T + 1);
                if (outst >= 2) AT_WAIT_BAR(4); else if (outst == 1) AT_WAIT_BAR(2); else AT_WAIT_BAR(0);
                if (t == NT - 1) asm volatile("" : "+v"(qn[0]), "+v"(qn[1]), "+v"(qn[2]), "+v"(qn[3]));
                if (VAR != 5 && T + PF < Ttot) AT_ISSUE(T + PF);
                const int kr = d.lo + t;
                if (t < d.nw && (kr < r0w || kr > r0w + 7)) continue;
                const LAS unsigned char* sl = lds + (T & (NS - 1)) * SLOT;
                f32x16 x0, x1; if (VAR == 4) { for (int r_ = 0; r_ < 16; ++r_) { x0[r_] = __builtin_bit_cast(float, (int)qr[r_ & 3][0] << 16) ; x1[r_] = x0[r_] * 0.5f; } } else qk_tile(x0, x1, sl, qr, r32, hi);
                if (t < d.nw) {
                    const LAS float* tb = tab + (kr - r + 7) * 32 + (4 * hi - c + 15);
                    if (half == 0) {
                        float b0[16], b1[4];
#pragma unroll
                        for (int r_ = 0; r_ < 16; ++r_) { const int rr = (r_ & 3) + 8 * (r_ >> 2); b0[r_] = tb[rr]; if (r_ < 4) b1[r_] = tb[rr + 32]; }
#pragma unroll
                        for (int r_ = 0; r_ < 16; ++r_) {
                            x0[r_] = ((vm >> r_) & 1u) ? __builtin_fmaf(x0[r_], C2, b0[r_]) : -INFINITY;
                            if (r_ < 4) x1[r_] = ((vm >> (16 + r_)) & 1u) ? __builtin_fmaf(x1[r_], C2, b1[r_]) : -INFINITY; }
                        sm_pv<false, 1, VAR>(x0, x1, m, l, o, sl + 8192, lane, hi);
                    } else {
                        float b0[4], b1[16];
#pragma unroll
                        for (int r_ = 0; r_ < 16; ++r_) { const int rr = (r_ & 3) + 8 * (r_ >> 2); if (r_ >= 12) b0[r_ - 12] = tb[rr]; b1[r_] = tb[rr + 32]; }
#pragma unroll
                        for (int r_ = 0; r_ < 16; ++r_) {
                            if (r_ >= 12) x0[r_] = ((vm >> r_) & 1u) ? __builtin_fmaf(x0[r_], C2, b0[r_ - 12]) : -INFINITY;
                            x1[r_] = ((vm >> (16 + r_)) & 1u) ? __builtin_fmaf(x1[r_], C2, b1[r_]) : -INFINITY; }
                        sm_pv<false, 2, VAR>(x0, x1, m, l, o, sl + 8192, lane, hi);
                    }
                } else sm_pv<true, 0, VAR>(x0, x1, m, l, o, sl + 8192, lane, hi);
            } while (++t < NT);
            o_store(o, l, OCp + q_row(d, wid, r32) * BW + d.hh * 64, hi);
        }
        Tb += NT;
    }
    AT_WAIT_BAR(0);
#undef AT_ISSUE
}
}

constexpr int PH_PER_LAYER = 17, NPHASES = 1 + DEPTH * PH_PER_LAYER;
struct Args { const float* in[23]; float* out; unsigned char* ws; int ph_lo, ph_hi; };
typedef __attribute__((address_space(4))) const Args CArgs;
__global__ void __launch_bounds__(NWAVES * 64, 2) mk_fwd(Args args) {
    extern __shared__ __attribute__((aligned(16))) unsigned char lds[];
    Frame F;
    F.lds = (LAS unsigned char*)lds;
    F.MISC = (volatile LAS unsigned*)(F.lds + MISC_OFF);
    F.G = gridDim.x; { const int bx = blockIdx.x; F.vcu = (F.G % 8 == 0) ? (bx % 8) * (F.G / 8) + bx / 8 : bx; }
    F.ctl = (unsigned*)(args.ws + WS_CTL);
    for (int u = threadIdx.x; u < (LDS_BYTES - LDSCTL_OFF) / 4; u += NWAVES * 64) ((LAS unsigned*)(F.lds + LDSCTL_OFF))[u] = 0u;
    { int wv_ = __builtin_amdgcn_readfirstlane((int)(threadIdx.x >> 6)); asm volatile("" : "+s"(wv_)); F.wv = wv_; }
    __syncthreads();
    const int lo = args.ph_lo, hi = args.ph_hi;
    const bool fused = (hi - lo) > 1;
    XcdBarrier bar; bar.bar = F.ctl + CW_BAR; bar.x = 0; bar.st = nullptr; bar.w = F.wv;
    if (fused) { bar = xcd_barrier_post(F.ctl + CW_BAR, F.MISC + 8); bar.w = F.wv; }
#ifndef MK_MASK
#define MK_MASK 0xFFFFFFFFu
#endif
#define SLOT(k) ((k) == 0 ? 0 : (((k) - 1) % PH_PER_LAYER) + 1)
#define IN(k) (((MK_MASK >> SLOT(k)) & 1u) && lo <= (k) && (k) < hi)
#define GRID_BAR() do { if (fused) xcd_barrier(bar); } while (0)
    const int NGW = F.G * NWAVES;
#define PHASE_ENTER() GAS unsigned char* wsg_ = (GAS unsigned char*)args.ws; asm volatile("" : "+s"(wsg_)); unsigned char* ws = (unsigned char*)wsg_; float* outp = (float*)(GAS float*)args.out; (void)outp; const CArgs* ka = (const CArgs*)__builtin_amdgcn_kernarg_segment_ptr(); asm volatile("" : "+s"(ka)); \
    int tid_ = (F.wv << 6) | mk_lane(); asm volatile("" : "+v"(tid_)); const int lane = tid_ & 63; const int wave = __builtin_amdgcn_readfirstlane(tid_ >> 6); const int gw = F.vcu * NWAVES + wave; (void)gw; (void)lane; (void)ws; (void)ka;
#define INP(i) ((const float*)(const GAS float*)ka->in[i])
#define MOD ((float*)(GAS float*)(ws + WS_MOD))
#define ROPE ((float*)(GAS float*)(ws + WS_ROPE))
#define SLABCNT ((int*)(GAS int*)(ws + WS_SLABCNT))
#define PCUM ((int*)(GAS int*)(ws + WS_PCUM))
#define TOKER ((int*)(GAS int*)(ws + WS_TOKER))
#define TOKG ((float*)(GAS float*)(ws + WS_TOKG))
#define TOKPOS ((int*)(GAS int*)(ws + WS_TOKPOS))
#define HCTX ((float*)(GAS float*)(ws + WS_HCTX))
#define RS ((bf16*)(GAS bf16*)(ws + WS_RS))
#define W_IN ((bf16*)(GAS bf16*)(ws + WS_WIN))
#define W_BR ((bf16*)(GAS bf16*)(ws + WS_WBR))
#define W_OUT ((bf16*)(GAS bf16*)(ws + WS_WOUT))
#define W_GUD ((bf16*)(GAS bf16*)(ws + WS_WGUD))
#define W_DND ((bf16*)(GAS bf16*)(ws + WS_WDND))
#define W_GUM8 ((unsigned char*)(GAS unsigned char*)(ws + WS_WGUM))
#define W_DNM8 ((unsigned char*)(GAS unsigned char*)(ws + WS_WDNM))
#define HX ((bf16*)(GAS bf16*)(ws + WS_HX))
#define ZM ((bf16*)(GAS bf16*)(ws + WS_ZM))
#define ZG ((bf16*)(GAS bf16*)(ws + WS_ZG))
#define OA ((bf16*)(GAS bf16*)(ws + WS_O))
#define OB (OA + (size_t)TA * BW)
#define OC (OA + (size_t)2 * TA * BW)
#define SB ((float*)(GAS float*)(ws + WS_ZM))
#define Y16 ((bf16*)(GAS bf16*)(ws + WS_ZG))
#define HD ((bf16*)(GAS bf16*)(ws + WS_ZM))
#define XG ((bf16*)(GAS bf16*)(ws + WS_XG))
#define HM8 ((unsigned char*)(GAS unsigned char*)(ws + WS_HM))
#define XG8 ((unsigned char*)(GAS unsigned char*)(ws + WS_XG8))
#define HX8 ((unsigned char*)(GAS unsigned char*)(ws + WS_HX8))
#define W_ING8 ((unsigned char*)(GAS unsigned char*)(ws + WS_WING8))

    if (IN(0)) {
        PHASE_ENTER();
        {
            LAS float* scv = (LAS float*)(F.lds + RING_OFF);
            LAS float* red = scv + 5 * 1024;
            for (int u = tid_; u < 5 * 1024; u += NWAVES * 64) { const int bb = u >> 10, k = u & 1023; const float cv = bb < 4 ? INP(I_C)[bb * 1024 + k] : INP(I_CCTX)[k]; scv[u] = cv / (1.0f + __expf(-cv)); }
            __syncthreads();
            for (int it = blockIdx.x; it < 2 * 96; it += F.G) {
                const int l = it / 96, n = (it % 96) * 64 + lane;
                const float* wp = INP(I_WADA) + (size_t)l * D * 6144 + n;
                float a0 = 0.f, a1 = 0.f, a2 = 0.f, a3 = 0.f, a4 = 0.f;
                const int kb = wave * 128;
#pragma unroll 16
                for (int k = 0; k < 128; ++k) { const float w = wp[(size_t)(kb + k) * 6144];
                    a0 += scv[kb + k] * w; a1 += scv[1024 + kb + k] * w; a2 += scv[2048 + kb + k] * w; a3 += scv[3072 + kb + k] * w; a4 += scv[4096 + kb + k] * w; }
                red[(wave * 5 + 0) * 64 + lane] = a0; red[(wave * 5 + 1) * 64 + lane] = a1; red[(wave * 5 + 2) * 64 + lane] = a2; red[(wave * 5 + 3) * 64 + lane] = a3; red[(wave * 5 + 4) * 64 + lane] = a4;
                __syncthreads();
                if (tid_ < 320) { const int bb = tid_ >> 6, nn = tid_ & 63; float s = 0.f;
#pragma unroll
                    for (int w = 0; w < 8; ++w) s += red[(w * 5 + bb) * 64 + nn];
                    const int col = (it % 96) * 64 + nn;
                    MOD[((size_t)l * 5 + bb) * 6144 + col] = s + INP(I_BADA)[l * 6144 + col]; }
                __syncthreads();
            }
        }
        if (blockIdx.x == F.G - 1) {
            for (int u = tid_; u < 192 * 16; u += NWAVES * 64) { const int idx = u >> 4, i = u & 15; const float pos = (float)(idx < 128 ? idx : idx - 128);
                const float inv = 1.0f / powf(10000.0f, (float)(2 * i) / 32.0f); const float ang = pos * inv;
                ROPE[2 * u] = cosf(ang); ROPE[2 * u + 1] = sinf(ang); }
        }
        __syncthreads();
        {
            LAS float* scr = (LAS float*)(F.lds + RING_OFF + wave * 16384);
            constexpr int I_IN = (D / 64) * (INC / 32), I_BR = (BW / 64) * (D / 32), I_OUT = (D / 64) * (D / 32), I_GUD = (D / 64) * (2 * FFD / 32), I_DND = (FFD / 64) * (D / 32),
                          I_GUM = (D / 64) * (2 * FFE / 32), I_DNM = (FFE / 64) * (D / 32);
            constexpr int NITEMS = 2 * I_IN + 6 * I_BR + 2 * I_OUT + I_GUD + I_DND + NE * I_GUM + NE * I_DNM;
            for (int it = gw; it < NITEMS; it += NGW) {
                int r = it;
                if (r < 2 * I_IN) { const int l = r / I_IN, it2 = r % I_IN, n0 = 32 * (it2 % (INC / 32));
                    if (MK_GATE_F8 == 2) { tr_item8(INP(I_WIN) + (size_t)l * D * INC, INC, 64 * (it2 / (INC / 32)), n0, (unsigned char*)W_IN + (size_t)l * INC * D, D, n0, SC_WGU, scr, lane); continue; }
                    if (!MK_GATE_F8 || n0 < ZMC) tr_matrix_item(INP(I_WIN) + (size_t)l * D * INC, D, INC, 0, W_IN + (size_t)l * INC * D, it2, scr, lane);
                    if (MK_GATE_F8 && n0 >= ZMC) tr_item8(INP(I_WIN) + (size_t)l * D * INC, INC, 64 * (it2 / (INC / 32)), n0, W_ING8 + (size_t)l * ZGC * D, D, n0 - ZMC, SC_WGU, scr, lane);
                    continue; } r -= 2 * I_IN;
                if (r < 6 * I_BR) { const int q = r / I_BR; tr_matrix_item(INP(I_WBRANCH) + (size_t)q * BW * D, BW, D, 0, W_BR + (size_t)q * D * BW, r % I_BR, scr, lane); continue; } r -= 6 * I_BR;
                if (r < 2 * I_OUT) { const int l = r / I_OUT; tr_matrix_item(INP(I_WOUT) + (size_t)l * D * D, D, D, 0, W_OUT + (size_t)l * D * D, r % I_OUT, scr, lane); continue; } r -= 2 * I_OUT;
                if (r < I_GUD) { if (MK_DENSE_F8 >= 2) tr_matrix_item8(INP(I_WGUD), D, 2 * FFD, FFD, (unsigned char*)W_GUD, SC_WGU, r, scr, lane); else tr_matrix_item(INP(I_WGUD), D, 2 * FFD, FFD, W_GUD, r, scr, lane); continue; } r -= I_GUD;
                if (r < I_DND) { if (MK_DENSE_F8 >= 1) tr_matrix_item8(INP(I_WDND), FFD, D, 0, (unsigned char*)W_DND, SC_WDN, r, scr, lane); else tr_matrix_item(INP(I_WDND), FFD, D, 0, W_DND, r, scr, lane); continue; } r -= I_DND;
                if (r < NE * I_GUM) { const int e = r / I_GUM; tr_matrix_item8(INP(I_WGUM) + (size_t)e * D * 2 * FFE, D, 2 * FFE, FFE, W_GUM8 + (size_t)e * 2 * FFE * D, SC_WGU, r % I_GUM, scr, lane); continue; } r -= NE * I_GUM;
                { const int e = r / I_DNM; tr_matrix_item8(INP(I_WDNM) + (size_t)e * FFE * D, FFE, D, 0, W_DNM8 + (size_t)e * D * FFE, SC_WDN, r % I_DNM, scr, lane); }
            }
        }
        GRID_BAR();
    }

    for (int l = 0; l < DEPTH; ++l) {
        const int pb = 1 + l * PH_PER_LAYER;
        const bool ctx_out = (l < DEPTH - 1);
        const bool moe = (l & 1) != 0;
        const int rows_out = ctx_out ? TA : TL;
#define modl (MOD + (size_t)l * 5 * 6144)
#define xsrc_lat ((l == 0) ? INP(I_X) : (const float*)outp)
#define xsrc_ctx ((l == 0) ? INP(I_CTX) : (const float*)HCTX)

        if (IN(pb + 0) && l == 0) {
            PHASE_ENTER();
            const int chunk = (TL + NGW - 1) / NGW;
#define P1_ROW(t) do { const float* xr = (t) < TL ? xsrc_lat + (size_t)(t) * D : xsrc_ctx + (size_t)((t) - TL) * D; \
                f32x4 x[4], h[4]; row_load(xr, lane, x); const float rr = row_rrms(x); row_normmod(x, rr, gpre, sh, sc, h); if (MK_GATE_F8 < 2) row_store_bf16(HX + (size_t)(t) * D, lane, h); if (MK_GATE_F8) row_store_fp8(HX8 + (size_t)(t) * D, lane, h, SC_XG); } while (0)
            f32x4 gpre[4], sh[4], sc[4]; vec_load(INP(I_GPREMIX) + l * D, lane, gpre);
            for (int t0 = min(gw * chunk, TL), t1 = min(TL, t0 + chunk); t0 < t1; ) { const int bb = t0 >> 13, te = min(t1, (bb + 1) << 13); const float* md = modl + (size_t)bb * 6144;
                vec_load(md, lane, sh); vec_load(md + 1024, lane, sc);
                for (int t = t0; t < te; ++t) P1_ROW(t);
                t0 = te; }
            { const float* md = modl + (size_t)4 * 6144; vec_load(md, lane, sh); vec_load(md + 1024, lane, sc); for (int t = TL + gw; t < TA; t += NGW) P1_ROW(t); }
#undef P1_ROW
            GRID_BAR();
        }
        if (IN(pb + 1)) {
            PHASE_ENTER();
#if MK_GATE_F8 == 2
            {
                pg8::Gemm g{(const bf16*)HX8, (const bf16*)((unsigned char*)W_IN + (size_t)l * INC * D), TA, ZMC, D}; pg8::StaticOrder S; S.init(TA, ZMC, F.G, (int)blockIdx.x, MK_WGM);
                pg8::EpiZT<true> E{ZM, ZG, ROPE, TL / 256, INP(I_BGATE) + (size_t)l * 3 * D, 0, 1.0f / (SC_XG * SC_WGU)};
                pg8::gemm_phase<pg8::EpiZT<true>, pg8::StaticOrder, PG8_ALIGN, PG8_SP2>(F.lds + RING_OFF, g, S, E, F.wv);
            }
            {
                pg8::Gemm g{(const bf16*)HX8, (const bf16*)((unsigned char*)W_IN + (size_t)l * INC * D + (size_t)ZMC * D), rows_out, ZGC, D}; pg8::StaticOrder S; S.init(rows_out, ZGC, F.G, (int)blockIdx.x, MK_WGM);
                pg8::EpiZT<true> E{ZM, ZG, ROPE, TL / 256, INP(I_BGATE) + (size_t)l * 3 * D, ZMC / 256, 1.0f / (SC_XG * SC_WGU)};
                pg8::gemm_phase<pg8::EpiZT<true>, pg8::StaticOrder, PG8_ALIGN, PG8_SP2>(F.lds + RING_OFF, g, S, E, F.wv);
            }
#elif MK_GATE_F8
            {
                pg8::Gemm g{HX, W_IN + (size_t)l * INC * D, TA, ZMC, D}; pg8::StaticOrder S; S.init(TA, ZMC, F.G, (int)blockIdx.x, MK_WGM);
                pg8::EpiZ E{ZM, ZG, ROPE, TL / 256, INP(I_BGATE) + (size_t)l * 3 * D, 0, 1.0f};
                pg8::gemm_phase<pg8::EpiZ, pg8::StaticOrder, PG8_ALIGN, PG8_SP2>(F.lds + RING_OFF, g, S, E, F.wv);
            }
            {
                pg8::Gemm g{(const bf16*)HX8, (const bf16*)(W_ING8 + (size_t)l * ZGC * D), rows_out, ZGC, D}; pg8::StaticOrder S; S.init(rows_out, ZGC, F.G, (int)blockIdx.x, MK_WGM);
                pg8::EpiZT<true> E{ZM, ZG, ROPE, TL / 256, INP(I_BGATE) + (size_t)l * 3 * D, ZMC / 256, 1.0f / (SC_XG * SC_WGU)};
                pg8::gemm_phase<pg8::EpiZT<true>, pg8::StaticOrder, PG8_ALIGN, PG8_SP2>(F.lds + RING_OFF, g, S, E, F.wv);
            }
#else
            pg8::Gemm g{HX, W_IN + (size_t)l * INC * D, TA, INC, D}; pg8::StaticOrder S; S.init(TA, INC, F.G, (int)blockIdx.x, MK_WGM);
            pg8::EpiZ E{ZM, ZG, ROPE, TL / 256, INP(I_BGATE) + (size_t)l * 3 * D, 0, 1.0f};
            pg8::gemm_phase<pg8::EpiZ, pg8::StaticOrder, PG8_ALIGN, PG8_SP2>(F.lds + RING_OFF, g, S, E, F.wv);
#endif
            GRID_BAR();
        }
        if (IN(pb + 3)) {
            PHASE_ENTER();
            const float* sinkp = INP(I_SINK) + l * 8; const float* rpbp = INP(I_RPB) + (size_t)l * 8 * 15 * 31;
            const float* cw = INP(I_CONVW) + (size_t)l * 3 * BW;
            {
                const int ch = 8 * lane;
                float cwr[3][8];
#pragma unroll
                for (int k = 0; k < 3; ++k) { const f32x4 a = *(const f32x4*)(cw + k * BW + ch), b = *(const f32x4*)(cw + k * BW + ch + 4); cwr[k][0] = a.x; cwr[k][1] = a.y; cwr[k][2] = a.z; cwr[k][3] = a.w; cwr[k][4] = b.x; cwr[k][5] = b.y; cwr[k][6] = b.z; cwr[k][7] = b.w; }
#define CONV_U(row, u) do { const bf16* zp_ = ZM + (size_t)(row) * ZMC; const v4u a_ = *(const v4u*)(zp_ + C_UX + ch), g_ = *(const v4u*)(zp_ + C_GC + ch); \
                    u[0] = bflo(a_.x) * bflo(g_.x); u[1] = bfhi(a_.x) * bfhi(g_.x); u[2] = bflo(a_.y) * bflo(g_.y); u[3] = bfhi(a_.y) * bfhi(g_.y); \
                    u[4] = bflo(a_.z) * bflo(g_.z); u[5] = bfhi(a_.z) * bfhi(g_.z); u[6] = bflo(a_.w) * bflo(g_.w); u[7] = bfhi(a_.w) * bfhi(g_.w); } while (0)
#define CONV_Z(u) do { _Pragma("unroll") for (int q_ = 0; q_ < 8; ++q_) u[q_] = 0.f; } while (0)
#define CONV_OUT(t) do { const v4u gbv = *(const v4u*)(ZM + (size_t)(t) * ZMC + C_GB + ch); \
                    const float gb[8] = {bflo(gbv.x), bfhi(gbv.x), bflo(gbv.y), bfhi(gbv.y), bflo(gbv.z), bfhi(gbv.z), bflo(gbv.w), bfhi(gbv.w)}; float o[8]; \
                    _Pragma("unroll") for (int q = 0; q < 8; ++q) o[q] = gb[q] * (cwr[0][q] * um[q] + cwr[1][q] * uc[q] + cwr[2][q] * up[q]); \
                    v4u w; w.x = pk2(o[0], o[1]); w.y = pk2(o[2], o[3]); w.z = pk2(o[4], o[5]); w.w = pk2(o[6], o[7]); \
                    *(v4u*)(OB + (size_t)(t) * BW + ch) = w; } while (0)
                const int cchunk = (TL + NGW - 1) / NGW;
                const int t0 = min(gw * cchunk, TL), t1 = min(TL, t0 + cchunk);
                if (t0 < t1) {
                    float um[8], uc[8], up[8];
                    if ((t0 & (SEQ - 1)) > 0) CONV_U(t0 - 1, um); else CONV_Z(um);
                    CONV_U(t0, uc);
                    for (int t = t0; t < t1; ++t) {
                        const int s = t & (SEQ - 1);
                        if (s == 0) CONV_Z(um);
                        if (s + 1 < SEQ) CONV_U(t + 1, up); else CONV_Z(up);
                        CONV_OUT(t);
#pragma unroll
                        for (int q = 0; q < 8; ++q) { um[q] = uc[q]; uc[q] = up[q]; }
                    }
                }
                for (int t = TL + gw; t < rows_out; t += NGW) {
                    const int s = (t - TL) & (CTXL - 1);
                    float um[8], uc[8], up[8];
                    if (s > 0) CONV_U(t - 1, um); else CONV_Z(um);
                    CONV_U(t, uc);
                    if (s + 1 < CTXL) CONV_U(t + 1, up); else CONV_Z(up);
                    CONV_OUT(t);
                }
#undef CONV_U
#undef CONV_Z
#undef CONV_OUT
            }
            at::attn_phase(F.lds + RING_OFF, ZM, OA, OC, sinkp, rpbp, F.vcu, F.G, ctx_out, tid_, wave, lane);
#ifdef MK_ATTN_PROBE
            at::attn_phase<MK_ATTN_PROBE>(F.lds + RING_OFF, ZM, (bf16*)(GAS bf16*)(ws + WS_HX), (bf16*)(GAS bf16*)(ws + WS_HX) + (size_t)TA * BW, sinkp, rpbp, F.vcu, F.G, ctx_out, tid_, wave, lane);
#endif
            GRID_BAR();
        }
        if (IN(pb + 4)) {
            PHASE_ENTER();
            pg8::Gemm g{OA, W_BR + (size_t)l * 3 * D * BW, rows_out, D, BW};
            pg8::BranchOrder3 S; S.so.init(rows_out, D, F.G, (int)blockIdx.x, MK_WGM);
            pg8::EpiBranchAcc E{HX, ZG};
            pg8::gemm_phase<pg8::EpiBranchAcc, pg8::BranchOrder3, PG8_ALIGN, PG8_SP2>(F.lds + RING_OFF, g, S, E, F.wv);
            GRID_BAR();
        }
        if (IN(pb + 5)) {
            PHASE_ENTER();
            pg8::Gemm g{HX, W_OUT + (size_t)l * D * D, rows_out, D, D}; pg8::StaticOrder S; S.init(rows_out, D, F.G, (int)blockIdx.x, MK_WGM);
            pg8::EpiBf16P E{Y16, D};
            pg8::gemm_phase<pg8::EpiBf16P, pg8::StaticOrder, PG8_ALIGN, PG8_SP2>(F.lds + RING_OFF, g, S, E, F.wv);
            GRID_BAR();
        }
        if (IN(pb + 6)) {
            PHASE_ENTER();
            if (!moe) {
                const int chunk = (TL + NGW - 1) / NGW;
#define P6_ROW(t) do { f32x4 x[4], y[4], h[4]; \
                    if (l == 0) row_load((t) < TL ? INP(I_X) + (size_t)(t) * D : INP(I_CTX) + (size_t)((t) - TL) * D, lane, x); else row_load_bf16(RS + (size_t)(t) * D, lane, x); \
                    row_load_bf16(Y16 + (size_t)(t) * D, lane, y); const float ry = row_rrms(y); \
                    _Pragma("unroll") for (int j = 0; j < 4; ++j) x[j] = x[j] + gt[j] * (y[j] * ry * gpo[j]); \
                    row_store_bf16(RS + (size_t)(t) * D, lane, x); const float rx = row_rrms(x); row_normmod(x, rx, gpre, sh, sc, h); \
                    if (MK_DENSE_F8 >= 2) row_store_fp8((unsigned char*)HX + (size_t)(t) * D, lane, h, SC_XG); else row_store_bf16(HX + (size_t)(t) * D, lane, h); } while (0)
                f32x4 gpo[4], gt[4], gpre[4], sh[4], sc[4]; vec_load(INP(I_GPOSTMIX) + l * D, lane, gpo); vec_load(INP(I_GPREFFN) + l * D, lane, gpre);
                for (int t0 = min(gw * chunk, TL), t1 = min(TL, t0 + chunk); t0 < t1; ) { const int bb = t0 >> 13, te = min(t1, (bb + 1) << 13); const float* md = modl + (size_t)bb * 6144;
                    vec_load(md + 2048, lane, gt); vec_load(md + 3072, lane, sh); vec_load(md + 4096, lane, sc);
                    for (int t = t0; t < te; ++t) P6_ROW(t);
                    t0 = te; }
                if (rows_out > TL) { const float* md = modl + (size_t)4 * 6144; vec_load(md + 2048, lane, gt); vec_load(md + 3072, lane, sh); vec_load(md + 4096, lane, sc); for (int t = TL + gw; t < rows_out; t += NGW) P6_ROW(t); }
#undef P6_ROW
            } else {
                LAS int* sel = (LAS int*)(F.lds + RING_OFF);
                LAS int* rnk = sel + 256;
                LAS f32x4* wrT = (LAS f32x4*)(F.lds + RING_OFF + 4096);
                const float* wr = INP(I_WROUTER) + (size_t)(l >> 1) * D * NE; const float* br = INP(I_BROUTER) + (l >> 1) * NE;
                for (int u = tid_; u < D * NE; u += NWAVES * 64) ((LAS float*)wrT)[(u & 7) * D + (u >> 3)] = wr[u];
                LDS_WAIT(); __syncthreads();
                f32x4 gpo[4], gt[4], gpre[4], sh[4], sc[4]; vec_load(INP(I_GPOSTMIX) + l * D, lane, gpo); vec_load(INP(I_GPREFFN) + l * D, lane, gpre);
                for (int slab = F.vcu; slab < TL / 128; slab += F.G) {
                    { const float* md = modl + (size_t)((slab * 128) >> 13) * 6144; vec_load(md + 2048, lane, gt); vec_load(md + 3072, lane, sh); vec_load(md + 4096, lane, sc); }
                    for (int i = 0; i < 16; ++i) {
                        const int tl_ = wave * 16 + i, t = slab * 128 + tl_;
                        f32x4 x[4], y[4], h[4]; if (l == 0) row_load(INP(I_X) + (size_t)t * D, lane, x); else row_load_bf16(RS + (size_t)t * D, lane, x);
                        row_load_bf16(Y16 + (size_t)t * D, lane, y);
                        const float ry = row_rrms(y);
#pragma unroll
                        for (int j = 0; j < 4; ++j) x[j] = x[j] + gt[j] * (y[j] * ry * gpo[j]);
                        row_store_bf16(RS + (size_t)t * D, lane, x);
                        const float rx = row_rrms(x);
                        row_normmod(x, rx, gpre, sh, sc, h);
                        row_store_fp8((unsigned char*)HX + (size_t)t * D, lane, h, SC_XG);
                        float lg[8];
#pragma unroll
                        for (int e = 0; e < 8; ++e) lg[e] = 0.f;
#pragma unroll
                        for (int e = 0; e < 8; ++e)
#pragma unroll
                            for (int j = 0; j < 4; ++j) { const f32x4 w4 = wrT[e * (D / 4) + 2 * (64 * (j >> 1) + lane) + (j & 1)]; lg[e] += (h[j].x * w4.x + h[j].y * w4.y) + (h[j].z * w4.z + h[j].w * w4.w); }
#pragma unroll
                        for (int e = 0; e < 8; ++e) lg[e] = wave_sum(lg[e]) + br[e];
                        int e1 = 0; float v1 = lg[0];
#pragma unroll
                        for (int e = 1; e < 8; ++e) if (lg[e] > v1) { v1 = lg[e]; e1 = e; }
                        int e2 = -1; float v2 = -INFINITY;
#pragma unroll
                        for (int e = 0; e < 8; ++e) if (e != e1 && lg[e] > v2) { v2 = lg[e]; e2 = e; }
                        const float ex = __expf(v2 - v1), g1 = 1.0f / (1.0f + ex), g2 = ex / (1.0f + ex);
                        if (lane == 0) { sel[2 * tl_] = e1; sel[2 * tl_ + 1] = e2; TOKG[2 * (size_t)t] = g1; TOKG[2 * (size_t)t + 1] = g2; }
                    }
                    LDS_WAIT(); __syncthreads();
                    if (tid_ < 8) { int cnt = 0; for (int q = 0; q < 256; ++q) if (sel[q] == tid_) { rnk[q] = cnt; ++cnt; } SLABCNT[slab * 8 + tid_] = cnt; }
                    LDS_WAIT(); __syncthreads();
                    if (tid_ < 256) TOKER[(size_t)slab * 256 + tid_] = sel[tid_] | (rnk[tid_] << 8);
                    LDS_WAIT(); __syncthreads();
                }
            }
            GRID_BAR();
        }
        if (IN(pb + 7) && moe) {
            PHASE_ENTER();
            LAS int* scn = (LAS int*)(F.lds + RING_OFF);
            LAS int* pst = scn + 2048;
            for (int u = tid_; u < 2048; u += NWAVES * 64) scn[u] = SLABCNT[u];
            LDS_WAIT(); __syncthreads();
            if (tid_ < 8) { int run = 0; for (int q = 0; q < 256; ++q) { const int c = scn[q * 8 + tid_]; scn[q * 8 + tid_] = run; run += c; } pst[8 + tid_] = run; }
            LDS_WAIT(); __syncthreads();
            if (tid_ == 0) { int pan = 0; for (int e = 0; e < 8; ++e) { pst[e] = pan * 256; if (blockIdx.x == 0) PCUM[e] = pan; pan += (pst[8 + e] + 255) >> 8; } if (blockIdx.x == 0) PCUM[8] = pan; }
            LDS_WAIT(); __syncthreads();
            LAS int* posl = pst + 16;
            for (int slab = F.vcu; slab < TL / 128; slab += F.G) {
                if (tid_ < 256) { const int er = TOKER[(size_t)slab * 256 + tid_]; const int e = er & 255, rk = er >> 8; const int pos = pst[e] + scn[slab * 8 + e] + rk;
                    posl[tid_] = pos; TOKPOS[(size_t)slab * 256 + tid_] = pos; }
                LDS_WAIT(); __syncthreads();
                const v4u* srcb = (const v4u*)((const unsigned char*)HX + (size_t)slab * 128 * D);
#pragma unroll 4
                for (int i = 0; i < 16; ++i) { const int id = i * 512 + tid_, tk = id >> 6, chk = id & 63;
                    const v4u o = srcb[(size_t)tk * 64 + chk];
                    ((v4u*)(XG8 + (size_t)posl[2 * tk] * D))[chk] = o; ((v4u*)(XG8 + (size_t)posl[2 * tk + 1] * D))[chk] = o; }
                LDS_WAIT(); __syncthreads();
            }
            GRID_BAR();
        }
        if (IN(pb + 8) && !moe) {
            PHASE_ENTER();
            pg8::Gemm g{HX, W_GUD, rows_out, 2 * FFD, D}; pg8::StaticOrder S; S.init(rows_out, 2 * FFD, F.G, (int)blockIdx.x, MK_WGM);
#if MK_DENSE_F8 >= 2
            pg8::EpiSwiglu8T<true> E{(unsigned char*)HD, FFD, 1.0f / (SC_XG * SC_WGU), SC_H};
            pg8::gemm_phase<pg8::EpiSwiglu8T<true>, pg8::StaticOrder, PG8_ALIGN, PG8_SP2>(F.lds + RING_OFF, g, S, E, F.wv);
#elif MK_DENSE_F8 == 1
            pg8::EpiSwiglu8T<false> E{(unsigned char*)HD, FFD, 1.0f, SC_H};
            pg8::gemm_phase<pg8::EpiSwiglu8T<false>, pg8::StaticOrder, PG8_ALIGN, PG8_SP2>(F.lds + RING_OFF, g, S, E, F.wv);
#else
            pg8::EpiSwiglu E{HD, FFD};
            pg8::gemm_phase<pg8::EpiSwiglu, pg8::StaticOrder, PG8_ALIGN, PG8_SP2>(F.lds + RING_OFF, g, S, E, F.wv);
#endif
            GRID_BAR();
        }
        if (IN(pb + 9) && !moe) {
            PHASE_ENTER();
            pg8::Gemm g{HD, W_DND, rows_out, D, FFD}; pg8::StaticOrder S; S.init(rows_out, D, F.G, (int)blockIdx.x, MK_WGM);
#if MK_DENSE_F8 >= 1
            pg8::EpiBf16PS8 E{Y16, D, 1.0f / (SC_H * SC_WDN)};
            pg8::gemm_phase<pg8::EpiBf16PS8, pg8::StaticOrder, PG8_ALIGN, PG8_SP2>(F.lds + RING_OFF, g, S, E, F.wv);
#else
            pg8::EpiBf16P E{Y16, D};
            pg8::gemm_phase<pg8::EpiBf16P, pg8::StaticOrder, PG8_ALIGN, PG8_SP2>(F.lds + RING_OFF, g, S, E, F.wv);
#endif
            GRID_BAR();
        }
        if (moe) {
            for (int ck = 0; ck < NCHUNK; ++ck) {
                if (IN(pb + 10 + 2 * ck)) {
                    PHASE_ENTER();
                    pg8::MoeOrder S; S.nN = 2 * FFE / 256; S.G = F.G; S.c = F.vcu; S.p_lo = ck * PCH;
#pragma unroll
                    for (int k = 0; k < 8; ++k) S.pc[k] = __builtin_amdgcn_readfirstlane(PCUM[k]);
                    const int ptot = __builtin_amdgcn_readfirstlane(PCUM[8]); S.np = min(max(ptot - ck * PCH, 0), PCH);
                    pg8::Gemm g{(const bf16*)XG8, (const bf16*)W_GUM8, 0, 2 * FFE, D};
                    pg8::EpiSwiglu8 E{HM8, FFE, 1.0f / (SC_XG * SC_WGU), SC_H};
                    pg8::gemm_phase<pg8::EpiSwiglu8, pg8::MoeOrder, PG8_ALIGN, PG8_SP2>(F.lds + RING_OFF, g, S, E, F.wv);
                    GRID_BAR();
                }
                if (IN(pb + 11 + 2 * ck)) {
                    PHASE_ENTER();
                    pg8::MoeOrder S; S.nN = D / 256; S.G = F.G; S.c = F.vcu; S.p_lo = ck * PCH;
#pragma unroll
                    for (int k = 0; k < 8; ++k) S.pc[k] = __builtin_amdgcn_readfirstlane(PCUM[k]);
                    const int ptot = __builtin_amdgcn_readfirstlane(PCUM[8]); S.np = min(max(ptot - ck * PCH, 0), PCH);
                    pg8::Gemm g{(const bf16*)HM8, (const bf16*)W_DNM8, 0, D, FFE};
                    pg8::EpiBf16PS8 E{XG, D, 1.0f / (SC_H * SC_WDN)};
                    pg8::gemm_phase<pg8::EpiBf16PS8, pg8::MoeOrder, PG8_ALIGN, PG8_SP2>(F.lds + RING_OFF, g, S, E, F.wv);
                    GRID_BAR();
                }
            }
        }
        if (IN(pb + 16)) {
            PHASE_ENTER();
            const int chunk = (TL + NGW - 1) / NGW; const bool nextl = (l + 1 < DEPTH);
#define P9_ROW(t) do { f32x4 x[4], y[4]; row_load_bf16(RS + (size_t)(t) * D, lane, x); \
                if (!moe) row_load_bf16(Y16 + (size_t)(t) * D, lane, y); \
                else { const int p0 = TOKPOS[2 * (size_t)(t)], p1 = TOKPOS[2 * (size_t)(t) + 1]; const float g0 = TOKG[2 * (size_t)(t)], g1 = TOKG[2 * (size_t)(t) + 1]; \
                    f32x4 ya[4], yb[4]; row_load_bf16(XG + (size_t)p0 * D, lane, ya); row_load_bf16(XG + (size_t)p1 * D, lane, yb); \
                    _Pragma("unroll") for (int j = 0; j < 4; ++j) y[j] = ya[j] * g0 + yb[j] * g1; } \
                const float ry = row_rrms(y); \
                _Pragma("unroll") for (int j = 0; j < 4; ++j) x[j] = x[j] + gt[j] * (y[j] * ry * gpo[j]); \
                if (nextl) row_store_bf16(RS + (size_t)(t) * D, lane, x); else if ((t) < TL) row_store(outp + (size_t)(t) * D, lane, x); \
                if (nextl) { f32x4 h[4]; const float rx = row_rrms(x); row_normmod(x, rx, gpre, sh, sc, h); if (MK_GATE_F8 < 2) row_store_bf16(HX + (size_t)(t) * D, lane, h); if (MK_GATE_F8) row_store_fp8(HX8 + (size_t)(t) * D, lane, h, SC_XG); } } while (0)
            f32x4 gpo[4], gt[4], gpre[4], sh[4], sc[4]; vec_load(INP(I_GPOSTFFN) + l * D, lane, gpo); vec_load(INP(I_GPREMIX) + (nextl ? l + 1 : l) * D, lane, gpre);
            for (int t0 = min(gw * chunk, TL), t1 = min(TL, t0 + chunk); t0 < t1; ) { const int bb = t0 >> 13, te = min(t1, (bb + 1) << 13); const float* md = modl + (size_t)bb * 6144;
                vec_load(md + 5120, lane, gt); vec_load(md + (nextl ? 5 * 6144 : 0), lane, sh); vec_load(md + (nextl ? 5 * 6144 : 0) + 1024, lane, sc);
                for (int t = t0; t < te; ++t) P9_ROW(t);
                t0 = te; }
            if (rows_out > TL) { const float* md = modl + (size_t)4 * 6144; vec_load(md + 5120, lane, gt); vec_load(md + (nextl ? 5 * 6144 : 0), lane, sh); vec_load(md + (nextl ? 5 * 6144 : 0) + 1024, lane, sc);
                for (int t = TL + gw; t < rows_out; t += NGW) P9_ROW(t); }
#undef P9_ROW
            if (l + 1 < DEPTH) GRID_BAR();
        }
    }
#undef IN
#undef GRID_BAR
}

extern "C" void kernel_launch(void* const* d_in, const int* in_sizes, int n_in, void* d_out, int out_size, void* d_ws, size_t ws_size, hipStream_t stream) {
    static int grid = 0;
    if (grid == 0) {
        if (n_in != 23 || in_sizes[0] != TL * D || out_size != TL * D || ws_size < WS_END) { fprintf(stderr, "kernel_launch: unexpected shapes: n_in %d in0 %d out %d ws %zu (need %zu); nothing launched\n", n_in, n_in > 0 ? in_sizes[0] : -1, out_size, ws_size, (size_t)WS_END); grid = -1; return; }
        int dev = 0, cus = 0, per_cu = 0;
        if (hipGetDevice(&dev) != hipSuccess || hipDeviceGetAttribute(&cus, hipDeviceAttributeMultiprocessorCount, dev) != hipSuccess) { fprintf(stderr, "kernel_launch: device query failed\n"); grid = -1; return; }
        if (hipFuncSetAttribute((const void*)mk_fwd, hipFuncAttributeMaxDynamicSharedMemorySize, LDS_BYTES) != hipSuccess) { fprintf(stderr, "kernel_launch: hipFuncSetAttribute failed\n"); grid = -1; return; }
        if (hipOccupancyMaxActiveBlocksPerMultiprocessor(&per_cu, (const void*)mk_fwd, NWAVES * 64, LDS_BYTES) != hipSuccess || per_cu < 1) fprintf(stderr, "kernel_launch: note: occupancy query reports %d\n", per_cu);
        (void)hipGetLastError();
        grid = cus;
    }
    if (grid < 0) return;
    if (hipMemsetAsync((char*)d_ws + WS_CTL, 0, CTL_ZERO_BYTES, stream) != hipSuccess) { fprintf(stderr, "kernel_launch: memset failed\n"); return; }
    Args a{};
    for (int i = 0; i < 23; ++i) a.in[i] = (const float*)d_in[i];
    a.out = (float*)d_out; a.ws = (unsigned char*)d_ws;
#if MK_PER_PHASE
    for (int ph = 0; ph < NPHASES; ++ph) { a.ph_lo = ph; a.ph_hi = ph + 1; hipLaunchKernelGGL(mk_fwd, dim3(grid), dim3(NWAVES * 64), LDS_BYTES, stream, a); }
#else
    a.ph_lo = 0; a.ph_hi = NPHASES;
    hipLaunchKernelGGL(mk_fwd, dim3(grid), dim3(NWAVES * 64), LDS_BYTES, stream, a);
#endif
    const hipError_t le = hipPeekAtLastError();
    if (le != hipSuccess) fprintf(stderr, "kernel_launch: launch failed: %s\n", hipGetErrorName(le));
}
```

```cpp
#include <hip/hip_runtime.h>
#include <cstdio>
#include <cstdint>
#ifndef MK_GATE_U8
#define MK_GATE_U8 1
#endif
#ifndef MK_GATE_F8
#define MK_GATE_F8 1
#endif

__device__ __forceinline__ int mk_lane() { unsigned z; asm volatile("s_mov_b32 %0, 0" : "=s"(z)); return (int)__builtin_amdgcn_mbcnt_hi(~0u, __builtin_amdgcn_mbcnt_lo(~0u, z)); }
template <int CTRL, int ROWMASK = 0xf> __device__ __forceinline__ float mk_dpp(float v) { return __builtin_bit_cast(float, __builtin_amdgcn_update_dpp(0, __builtin_bit_cast(int, v), CTRL, ROWMASK, 0xf, false)); }
__device__ __forceinline__ float mk_xor32(float v, bool upper) { const auto rr = __builtin_amdgcn_permlane32_swap(__builtin_bit_cast(unsigned, v), __builtin_bit_cast(unsigned, v), false, false); return __builtin_bit_cast(float, upper ? rr[0] : rr[1]); }
__device__ __forceinline__ int mk_xor16(int v) { return __builtin_amdgcn_ds_swizzle(v, 0x401F); }

namespace pg8 {
#define PG8_LAS __attribute__((address_space(3)))
typedef unsigned short bf16_t;
typedef short bf16x8 __attribute__((ext_vector_type(8)));
typedef float f32x4 __attribute__((ext_vector_type(4)));
typedef unsigned u32x4 __attribute__((ext_vector_type(4)));
typedef unsigned u32x2 __attribute__((ext_vector_type(2)));
typedef int v8i32 __attribute__((ext_vector_type(8)));
constexpr int BM = 256, BK = 64, HALF = 128, HTB = HALF * BK * 2  , STAGE_BYTES = 8 * HTB, NXCD = 8, WGM = 8;

__host__ __device__ __forceinline__ int lds_byte(int r, int c) { const int st = (r >> 4) * 2 + (c >> 5), rr = r & 15, cc = c & 31, ob = rr * 64 + cc * 2; return st * 1024 + (ob ^ (((ob >> 9) & 1) << 5)); }
__host__ __device__ __forceinline__ void stage_rc(int b, int& R, int& C) { const int st = b / 1024, sb = b % 1024, swz = sb ^ (((sb >> 9) & 1) << 5); R = (st >> 1) * 16 + swz / 64; C = (st & 1) * 32 + (swz % 64) / 2; }
__host__ __device__ __forceinline__ int perm32(int rho) { const int n = rho >> 4, i = rho & 15; return 8 * (i >> 2) + 4 * n + (i & 3); }

struct Unit { int pm, pn, pb; };
struct Gemm { const bf16_t* A; const bf16_t* Bt; int M, N, K; };

struct StaticOrder {
    int nM, nN, nwg, G, c, wgm;
    __host__ __device__ void init(int M, int N, int G_, int c_, int wgm_ = WGM) { nM = M / BM; nN = N / BM; nwg = nM * nN; G = G_; c = c_; wgm = wgm_; }
    __host__ __device__ bool next(int i, Unit& u) const {
        const long L = (long)i * G + c; if (L >= nwg) return false;
        int wgid = (int)L; { const int q = nwg / NXCD, r = nwg % NXCD, xcd = wgid % NXCD, off = wgid / NXCD; wgid = (xcd < r ? xcd * (q + 1) : r * (q + 1) + (xcd - r) * q) + off; }
        const int nig = wgm * nN, gid = wgid / nig, fm = gid * wgm, gsz = (nM - fm) < wgm ? (nM - fm) : wgm;
        u.pm = fm + ((wgid % nig) % gsz); u.pn = (wgid % nig) / gsz; u.pb = u.pn; return true;
    }
    __device__ __forceinline__ void a_ready(const Unit&) const {}
    __device__ __forceinline__ void done(const Unit&) const {}
};

__device__ __forceinline__ unsigned cvt_pk_bf16(float lo, float hi) { unsigned r; asm volatile("v_cvt_pk_bf16_f32 %0, %1, %2" : "=v"(r) : "v"(lo), "v"(hi)); return r; }
__device__ __forceinline__ float bf_lo(unsigned w) { return __uint_as_float(w << 16); }
__device__ __forceinline__ float bf_hi(unsigned w) { return __uint_as_float(w & 0xffff0000u); }
__device__ __forceinline__ float sigmoidf_(float x) { return __builtin_amdgcn_rcpf(1.0f + __builtin_amdgcn_exp2f(x * -1.4426950408889634f)); }

template <bool OPF8> struct EpiZT {
    static constexpr bool PERM = true, AFTER_DRAIN = false, HALFN = false, F8 = OPF8, RWACC = false;
    bf16_t* ZM; bf16_t* ZG; const float* rope; int n_lat_panels; const float* bgate; int pn_off; float gs;
    __device__ __forceinline__ void operator()(const f32x4 (&acc)[2][2][4][2], const Unit& u, int wr, int wc, int fr, int fq) const {
        const int row0 = u.pm * BM + wr * 64 + fr; int colt = (u.pn + pn_off) * BM; bf16_t* base = ZM; int ldc = 3840; bool isg = false;
        if (colt >= 3840) { base = ZG; colt -= 3840; ldc = 3072; isg = true; }
        const int col0 = colt + wc * 32 + 8 * fq;
        f32x4 gb[2][2];
        if (isg) {
#pragma unroll
            for (int bj = 0; bj < 2; ++bj) { gb[bj][0] = *(const f32x4*)(bgate + col0 + bj * HALF); gb[bj][1] = *(const f32x4*)(bgate + col0 + bj * HALF + 4); } }
        const int nrope = (u.pm < n_lat_panels) ? (u.pn + pn_off < 2 ? 2 : (u.pn + pn_off == 2 ? 1 : 0)) : 0;
#pragma unroll
        for (int ai = 0; ai < 2; ++ai)
#pragma unroll
            for (int m = 0; m < 4; ++m) { const int row = row0 + ai * HALF + m * 16; bf16_t* rowp = base + (size_t)row * ldc + col0;
                f32x4 cs[4];
                if (nrope) { const int s = row & 8191, pidx = (wc & 1) ? 128 + (s & 63) : (s >> 6); const f32x4* cp = (const f32x4*)(rope + (size_t)(pidx * 16 + 8 * (fq & 1)) * 2);
                    cs[0] = cp[0]; cs[1] = cp[1]; cs[2] = cp[2]; cs[3] = cp[3]; }
#pragma unroll
                for (int bj = 0; bj < 2; ++bj) { f32x4 v0 = acc[ai][bj][m][0], v1 = acc[ai][bj][m][1];
                    if (OPF8 && !isg) { v0 *= gs; v1 *= gs; }
                    if (isg) {
#pragma unroll
                        for (int j = 0; j < 4; ++j) { v0[j] = sigmoidf_(fminf(fmaxf(v0[j] * gs + gb[bj][0][j], -30.f), 30.f)); v1[j] = sigmoidf_(fminf(fmaxf(v1[j] * gs + gb[bj][1][j], -30.f), 30.f)); } }
                    if (bj < nrope) { const float sg = (fq >> 1) ? 1.f : -1.f;
                        float v[8] = {v0[0], v0[1], v0[2], v0[3], v1[0], v1[1], v1[2], v1[3]}, o[8];
#pragma unroll
                        for (int j = 0; j < 8; ++j) { const float pv = mk_xor32(v[j], (fq >> 1) != 0); const float c_ = cs[j >> 1][(j & 1) * 2], s_ = cs[j >> 1][(j & 1) * 2 + 1]; o[j] = v[j] * c_ + sg * pv * s_; }
                        v0 = (f32x4){o[0], o[1], o[2], o[3]}; v1 = (f32x4){o[4], o[5], o[6], o[7]}; }
                    if (MK_GATE_U8 && isg) {
                        unsigned b0 = 0u, b1 = 0u;
#pragma unroll
                        for (int j = 0; j < 4; ++j) { b0 = __builtin_amdgcn_cvt_pk_u8_f32(fmaxf(v0[j] * 255.f, 1.f), j, b0); b1 = __builtin_amdgcn_cvt_pk_u8_f32(fmaxf(v1[j] * 255.f, 1.f), j, b1); }
                        u32x2 w8; w8.x = b0; w8.y = b1;
                        *(u32x2*)((unsigned char*)ZG + (size_t)row * 3072 + col0 + bj * HALF) = w8;
                        continue; }
                    u32x4 w; w.x = cvt_pk_bf16(v0[0], v0[1]); w.y = cvt_pk_bf16(v0[2], v0[3]); w.z = cvt_pk_bf16(v1[0], v1[1]); w.w = cvt_pk_bf16(v1[2], v1[3]);
                    *(u32x4*)(rowp + bj * HALF) = w; } }
    }
};
typedef EpiZT<false> EpiZ;
struct EpiBf16P {
    static constexpr bool PERM = true, AFTER_DRAIN = false, HALFN = false, F8 = false, RWACC = false;
    bf16_t* O; int ldc;
    __device__ __forceinline__ void operator()(const f32x4 (&acc)[2][2][4][2], const Unit& u, int wr, int wc, int fr, int fq) const {
        const int row0 = u.pm * BM + wr * 64 + fr; const int col0 = u.pn * BM + wc * 32 + 8 * fq;
#pragma unroll
        for (int ai = 0; ai < 2; ++ai)
#pragma unroll
            for (int m = 0; m < 4; ++m) { bf16_t* rowp = O + (size_t)(row0 + ai * HALF + m * 16) * ldc + col0;
#pragma unroll
                for (int bj = 0; bj < 2; ++bj) { const f32x4 v0 = acc[ai][bj][m][0], v1 = acc[ai][bj][m][1];
                    u32x4 w; w.x = cvt_pk_bf16(v0[0], v0[1]); w.y = cvt_pk_bf16(v0[2], v0[3]); w.z = cvt_pk_bf16(v1[0], v1[1]); w.w = cvt_pk_bf16(v1[2], v1[3]);
                    *(u32x4*)(rowp + bj * HALF) = w; } }
    }
};
struct EpiBranchAcc {
    static constexpr bool PERM = true, AFTER_DRAIN = false, HALFN = false, F8 = false, RWACC = true;
    bf16_t* MG; const bf16_t* ZG;
    __device__ __forceinline__ bool restart(const Unit& u) const { return u.pm >= 264; }
    __device__ __forceinline__ void rw(f32x4 (&acc)[2][2][4][2], const Unit& u, int wr, int wc, int fr, int fq) const {
        const int r = u.pm / 132, pmt = u.pm - 132 * r, rn = r < 2 ? r + 1 : r;
        const int row0 = pmt * BM + wr * 64 + fr, col0 = u.pn * BM + wc * 32 + 8 * fq;
        constexpr int PG8_GD = 4;
        u32x4 gp[PG8_GD][2], gn[PG8_GD][2];
        constexpr unsigned GB = MK_GATE_U8 ? 1u : 2u;
        const unsigned o0 = (unsigned)row0 * (3072u * GB) + (unsigned)col0 * GB;
        const char* zp = (const char*)ZG + (size_t)r * 1024 * GB; const char* zn = (const char*)ZG + (size_t)rn * 1024 * GB;
#if MK_GATE_U8
#define PG8_GLOAD(s, buf) do { const int bj_ = (s) >> 2, ai_ = ((s) >> 1) & 1, mb_ = ((s) & 1) * 2; _Pragma("unroll") for (int q_ = 0; q_ < 2; ++q_) { \
            const unsigned off_ = o0 + (unsigned)(ai_ * HALF + (mb_ + q_) * 16) * 3072u + (unsigned)(bj_ * HALF); \
            const u32x2 a_ = *(const u32x2*)(zp + off_), b_ = *(const u32x2*)(zn + off_); gp[buf][q_].x = a_.x; gp[buf][q_].y = a_.y; gn[buf][q_].x = b_.x; gn[buf][q_].y = b_.y; } } while (0)
#else
#define PG8_GLOAD(s, buf) do { const int bj_ = (s) >> 2, ai_ = ((s) >> 1) & 1, mb_ = ((s) & 1) * 2; _Pragma("unroll") for (int q_ = 0; q_ < 2; ++q_) { \
            const unsigned off_ = o0 + (unsigned)(ai_ * HALF + (mb_ + q_) * 16) * 6144u + (unsigned)(bj_ * HALF * 2); \
            gp[buf][q_] = *(const u32x4*)(zp + off_); gn[buf][q_] = *(const u32x4*)(zn + off_); } } while (0)
#endif
#pragma unroll
        for (int s = 0; s < PG8_GD - 1; ++s) PG8_GLOAD(s, s);
#pragma unroll
        for (int s = 0; s < 8; ++s) { const int bj = s >> 2, ai = (s >> 1) & 1, mb = (s & 1) * 2, col = col0 + bj * HALF;
            if (s + PG8_GD - 1 < 8) PG8_GLOAD(s + PG8_GD - 1, (s + PG8_GD - 1) % PG8_GD);
            __builtin_amdgcn_sched_barrier(0);
#pragma unroll
            for (int q = 0; q < 2; ++q) { const int m = mb + q; const size_t row = (size_t)(row0 + ai * HALF + m * 16);
                const u32x4 g0 = gp[s % PG8_GD][q], g1 = gn[s % PG8_GD][q];
#if MK_GATE_U8
#define PG8_UB(w_, k_) ((float)(((w_) >> (8 * (k_))) & 255u))
                const float x[8] = {PG8_UB(g0.x, 0), PG8_UB(g0.x, 1), PG8_UB(g0.x, 2), PG8_UB(g0.x, 3), PG8_UB(g0.y, 0), PG8_UB(g0.y, 1), PG8_UB(g0.y, 2), PG8_UB(g0.y, 3)};
#else
                const float x[8] = {bf_lo(g0.x), bf_hi(g0.x), bf_lo(g0.y), bf_hi(g0.y), bf_lo(g0.z), bf_hi(g0.z), bf_lo(g0.w), bf_hi(g0.w)};
#endif
                if (r < 2) {
#if MK_GATE_U8
                    const float y[8] = {PG8_UB(g1.x, 0), PG8_UB(g1.x, 1), PG8_UB(g1.x, 2), PG8_UB(g1.x, 3), PG8_UB(g1.y, 0), PG8_UB(g1.y, 1), PG8_UB(g1.y, 2), PG8_UB(g1.y, 3)};
#else
                    const float y[8] = {bf_lo(g1.x), bf_hi(g1.x), bf_lo(g1.y), bf_hi(g1.y), bf_lo(g1.z), bf_hi(g1.z), bf_lo(g1.w), bf_hi(g1.w)};
#endif
#pragma unroll
                    for (int j = 0; j < 8; ++j) acc[ai][bj][m][j >> 2][j & 3] *= x[j] * __builtin_amdgcn_rcpf(y[j]);
                } else {
                    float v[8];
#pragma unroll
                    for (int j = 0; j < 8; ++j) v[j] = acc[ai][bj][m][j >> 2][j & 3] * (MK_GATE_U8 ? x[j] * (1.0f / 255.0f) : x[j]);
                    u32x4 w; w.x = cvt_pk_bf16(v[0], v[1]); w.y = cvt_pk_bf16(v[2], v[3]); w.z = cvt_pk_bf16(v[4], v[5]); w.w = cvt_pk_bf16(v[6], v[7]);
                    *(u32x4*)(MG + row * 1024 + col) = w;
                } }
        }
#undef PG8_GLOAD
    }
};
struct BranchOrder3 {
    StaticOrder so;
    __device__ __forceinline__ bool next(int i, Unit& u) const {
        const int ti = i / 3, r = i - 3 * ti; if (!so.next(ti, u)) return false;
        u.pb = 4 * r + u.pn; u.pm += 132 * r; return true;
    }
    __device__ __forceinline__ void a_ready(const Unit&) const {}
    __device__ __forceinline__ void done(const Unit&) const {}
};
struct EpiSwiglu {
    static constexpr bool PERM = true, AFTER_DRAIN = false, HALFN = false, F8 = false, RWACC = false;
    bf16_t* H; int ldh;
    __device__ __forceinline__ void operator()(const f32x4 (&acc)[2][2][4][2], const Unit& u, int wr, int wc, int fr, int fq) const {
        const int row0 = u.pm * BM + wr * 64 + fr; const int col0 = u.pn * HALF + wc * 32 + 8 * fq;
#pragma unroll
        for (int ai = 0; ai < 2; ++ai)
#pragma unroll
            for (int m = 0; m < 4; ++m) { bf16_t* rowp = H + (size_t)(row0 + ai * HALF + m * 16) * ldh + col0;
                float h[8];
#pragma unroll
                for (int n = 0; n < 2; ++n)
#pragma unroll
                    for (int j = 0; j < 4; ++j) { const float g = acc[ai][0][m][n][j], uu = acc[ai][1][m][n][j]; h[n * 4 + j] = g * sigmoidf_(g) * uu; }
                u32x4 w; w.x = cvt_pk_bf16(h[0], h[1]); w.y = cvt_pk_bf16(h[2], h[3]); w.z = cvt_pk_bf16(h[4], h[5]); w.w = cvt_pk_bf16(h[6], h[7]);
                *(u32x4*)rowp = w; }
    }
};
__device__ __forceinline__ unsigned pk4_fp8(float a, float b, float c, float d) { int w = __builtin_amdgcn_cvt_pk_fp8_f32(a, b, 0, false); w = __builtin_amdgcn_cvt_pk_fp8_f32(c, d, w, true); return (unsigned)w; }
__device__ __forceinline__ float clamp_fp8(float v) { return fminf(fmaxf(v, -448.0f), 448.0f); }
template <bool OPF8> struct EpiSwiglu8T {
    static constexpr bool PERM = true, AFTER_DRAIN = false, HALFN = false, F8 = OPF8, RWACC = false;
    unsigned char* H; int ldh; float sin, sout;
    __device__ __forceinline__ void operator()(const f32x4 (&acc)[2][2][4][2], const Unit& u, int wr, int wc, int fr, int fq) const {
        const int row0 = u.pm * BM + wr * 64 + fr; const int col0 = u.pn * HALF + wc * 32 + 8 * (fq & 2); const int odd = fq & 1;
#pragma unroll
        for (int ai = 0; ai < 2; ++ai)
#pragma unroll
            for (int mp = 0; mp < 2; ++mp) {
                unsigned w[2][2];
#pragma unroll
                for (int k = 0; k < 2; ++k) { const int m = 2 * mp + k; float h[8];
#pragma unroll
                    for (int n = 0; n < 2; ++n)
#pragma unroll
                        for (int j = 0; j < 4; ++j) { const float g = acc[ai][0][m][n][j] * sin, uu = acc[ai][1][m][n][j] * sin; h[n * 4 + j] = clamp_fp8(g * sigmoidf_(g) * uu * sout); }
                    w[k][0] = pk4_fp8(h[0], h[1], h[2], h[3]); w[k][1] = pk4_fp8(h[4], h[5], h[6], h[7]); }
                const unsigned s0 = odd ? w[0][0] : w[1][0], s1 = odd ? w[0][1] : w[1][1];
                const unsigned r0 = (unsigned)mk_xor16((int)s0), r1 = (unsigned)mk_xor16((int)s1);
                u32x4 st; if (odd) { st.x = r0; st.y = r1; st.z = w[1][0]; st.w = w[1][1]; } else { st.x = w[0][0]; st.y = w[0][1]; st.z = r0; st.w = r1; }
                *(u32x4*)(H + (size_t)(row0 + ai * HALF + (2 * mp + odd) * 16) * ldh + col0) = st; }
    }
};
typedef EpiSwiglu8T<true> EpiSwiglu8;
struct EpiBf16PS8 {
    static constexpr bool PERM = true, AFTER_DRAIN = false, HALFN = false, F8 = true, RWACC = false;
    bf16_t* O; int ldc; float s;
    __device__ __forceinline__ void operator()(const f32x4 (&acc)[2][2][4][2], const Unit& u, int wr, int wc, int fr, int fq) const {
        const int row0 = u.pm * BM + wr * 64 + fr; const int col0 = u.pn * BM + wc * 32 + 8 * fq;
#pragma unroll
        for (int ai = 0; ai < 2; ++ai)
#pragma unroll
            for (int m = 0; m < 4; ++m) { bf16_t* rowp = O + (size_t)(row0 + ai * HALF + m * 16) * ldc + col0;
#pragma unroll
                for (int bj = 0; bj < 2; ++bj) { const f32x4 v0 = acc[ai][bj][m][0] * s, v1 = acc[ai][bj][m][1] * s;
                    u32x4 w; w.x = cvt_pk_bf16(v0[0], v0[1]); w.y = cvt_pk_bf16(v0[2], v0[3]); w.z = cvt_pk_bf16(v1[0], v1[1]); w.w = cvt_pk_bf16(v1[2], v1[3]);
                    *(u32x4*)(rowp + bj * HALF) = w; } }
    }
};
struct MoeOrder {
    int nN, G, c, p_lo, np; int pc[8];
    __device__ __forceinline__ bool next(int i, Unit& u) const {
        const long L = (long)i * G + c; if (L >= (long)np * nN) return false;
        const int wgid = (int)L, nig = WGM * nN, gid = wgid / nig, fm = gid * WGM, gsz = (np - fm) < WGM ? (np - fm) : WGM;
        u.pm = p_lo + fm + ((wgid % nig) % gsz); u.pn = (wgid % nig) / gsz;
        int e = 0;
#pragma unroll
        for (int k = 1; k < 8; ++k) e += (u.pm >= pc[k]) ? 1 : 0;
        u.pb = e * nN + u.pn; return true;
    }
    __device__ __forceinline__ void a_ready(const Unit&) const {}
    __device__ __forceinline__ void done(const Unit&) const {}
};

template <class Epi, class Sched, bool ALIGN_EPI = false, bool SP2 = false>
__device__ __forceinline__ void gemm_phase(PG8_LAS unsigned char* lds, const Gemm g, const Sched& S, const Epi& E, int wv) {
    int tid_ = (wv << 6) | mk_lane(); asm volatile("" : "+v"(tid_));
    const int tid = tid_, wid = __builtin_amdgcn_readfirstlane(tid >> 6), lane = tid & 63, wr = wid >> 2, wc = wid & 3, fr = lane & 15, fq = lane >> 4;
    constexpr bool HN = Epi::HALFN;
    constexpr bool F8 = Epi::F8;
    constexpr int ES = F8 ? 1 : 2;
    const int K = g.K, nt = K * ES / (BK * 2);
    unsigned voffA[2], voffB[2];
#pragma unroll
    for (int i = 0; i < 2; ++i) { int R, C; stage_rc(tid * 16 + i * 8192, R, C); const int Rb = Epi::PERM ? ((R & ~31) + perm32(R & 31)) : R;
        voffA[i] = (unsigned)(R * K * ES + C * 2); voffB[i] = (unsigned)(Rb * K * ES + C * 2); }
    const size_t kstep = (size_t)(BK * 2);
    const size_t hstep = (size_t)HALF * K * ES;
    const size_t tstep = 2 * hstep;
    const unsigned ldsw = (unsigned)wid * 1024u;
    const int aoff = lds_byte(wr * 64 + fr, fq * 8), boff = lds_byte(wc * 32 + fr, fq * 8);
#define PG8_SA(b, h) (((b) * 2 + (h)) * HTB)
#define PG8_SB(b, h) ((4 + (b) * 2 + (h)) * HTB)
#define PG8_STAGE(bufoff, gbase, voff) do { _Pragma("unroll") for (int _i = 0; _i < 2; ++_i) \
        __builtin_amdgcn_global_load_lds((const unsigned*)((const char*)(gbase) + (voff)[_i]), (PG8_LAS unsigned*)(lds + (bufoff) + ldsw + _i * 8192), 16, 0, 0); } while (0)
#define PG8_LDA(dst, b, h) do { if constexpr (F8) { _Pragma("unroll") for (int m = 0; m < 4; ++m) { const u32x4 lo_ = *(const PG8_LAS u32x4*)(lds + PG8_SA(b, h) + aoff + m * 2048), hi_ = *(const PG8_LAS u32x4*)(lds + PG8_SA(b, h) + aoff + m * 2048 + 1024); \
            dst##8[m] = __builtin_bit_cast(v8i32, __builtin_shufflevector(lo_, hi_, 0, 1, 2, 3, 4, 5, 6, 7)); } } \
        else { _Pragma("unroll") for (int m = 0; m < 4; ++m) _Pragma("unroll") for (int k = 0; k < 2; ++k) dst[m][k] = *(const PG8_LAS bf16x8*)(lds + PG8_SA(b, h) + aoff + m * 2048 + k * 1024); } } while (0)
#define PG8_LDB(dst, b, h) do { if constexpr (F8) { _Pragma("unroll") for (int n = 0; n < 2; ++n) { const u32x4 lo_ = *(const PG8_LAS u32x4*)(lds + PG8_SB(b, h) + boff + n * 2048), hi_ = *(const PG8_LAS u32x4*)(lds + PG8_SB(b, h) + boff + n * 2048 + 1024); \
            dst##8[n] = __builtin_bit_cast(v8i32, __builtin_shufflevector(lo_, hi_, 0, 1, 2, 3, 4, 5, 6, 7)); } } \
        else { _Pragma("unroll") for (int n = 0; n < 2; ++n) _Pragma("unroll") for (int k = 0; k < 2; ++k) dst[n][k] = *(const PG8_LAS bf16x8*)(lds + PG8_SB(b, h) + boff + n * 2048 + k * 1024); } } while (0)
#define PG8_MMA(ai, bj, At, Bt) do { __builtin_amdgcn_s_setprio(1); _Pragma("unroll") for (int m = 0; m < 4; ++m) _Pragma("unroll") for (int n = 0; n < 2; ++n) { \
        if constexpr (F8) { asm volatile("v_mfma_f32_16x16x128_f8f6f4 %0, %1, %2, %0" : "+v"(acc[ai][bj][m][n]) : "v"(Bt##8[n]), "v"(At##8[m])); } \
        else { _Pragma("unroll") for (int k = 0; k < 2; ++k) acc[ai][bj][m][n] = __builtin_amdgcn_mfma_f32_16x16x32_bf16(Bt[n][k], At[m][k], acc[ai][bj][m][n], 0, 0, 0); } } \
        __builtin_amdgcn_s_setprio(0); } while (0)
#define PG8_LDB1(dst, b, h) do { if constexpr (!HN) { PG8_LDB(dst, b, h); } } while (0)
#define PG8_MMA1(ai, bj, At, Bt) do { if constexpr (!HN) { PG8_MMA(ai, bj, At, Bt); } } while (0)
#define PG8_WAIT_V(n) asm volatile("s_waitcnt vmcnt(" #n ")" ::: "memory")
#define PG8_WAIT_L(n) asm volatile("s_waitcnt lgkmcnt(" #n ")" ::: "memory")
#define PG8_BAR __builtin_amdgcn_s_barrier()
#define PG8_SCHED __builtin_amdgcn_sched_barrier(0)
    Unit cur, nxt; int ui = 0;
    if (!S.next(0, cur)) return;
    f32x4 acc[2][2][4][2];
#pragma unroll
    for (int a = 0; a < 2; ++a)
#pragma unroll
        for (int b = 0; b < 2; ++b)
#pragma unroll
            for (int m = 0; m < 4; ++m)
#pragma unroll
                for (int n = 0; n < 2; ++n) acc[a][b][m][n] = (f32x4){0.f, 0.f, 0.f, 0.f};
    bf16x8 At[4][2], B0[2][2], B1[2][2];
    v8i32 At8[4], B08[2], B18[2];
    const char* cA = (const char*)g.A + (size_t)cur.pm * tstep; const char* cB = (const char*)g.Bt + (size_t)cur.pb * (HN ? hstep : tstep);
    S.a_ready(cur);
    if constexpr (SP2) {
        PG8_STAGE(PG8_SB(0, 0), cB, voffB); PG8_STAGE(PG8_SB(0, 1), cB + hstep, voffB); PG8_STAGE(PG8_SA(0, 0), cA, voffA); PG8_STAGE(PG8_SA(0, 1), cA + hstep, voffA);
        if (wr == 1) PG8_BAR;
        PG8_WAIT_V(2); PG8_BAR;
        PG8_STAGE(PG8_SB(1, 0), cB + kstep, voffB); PG8_STAGE(PG8_SA(1, 0), cA + kstep, voffA); PG8_STAGE(PG8_SB(1, 1), cB + hstep + kstep, voffB);
        PG8_WAIT_V(6); PG8_BAR;
    } else {
        PG8_STAGE(PG8_SB(0, 0), cB, voffB); PG8_STAGE(PG8_SA(0, 0), cA, voffA); PG8_STAGE(PG8_SB(0, 1), cB + hstep, voffB); PG8_STAGE(PG8_SA(0, 1), cA + hstep, voffA);
        if (wr == 1) PG8_BAR;
        PG8_WAIT_V(4); PG8_BAR;
        PG8_STAGE(PG8_SB(1, 0), cB + kstep, voffB); PG8_STAGE(PG8_SA(1, 0), cA + kstep, voffA); PG8_STAGE(PG8_SB(1, 1), cB + hstep + kstep, voffB);
        PG8_WAIT_V(6); PG8_BAR;
    }
    for (;;) {
        const bool has_next = S.next(ui + 1, nxt);
        const char* nA = has_next ? (const char*)g.A + (size_t)nxt.pm * tstep : cA; const char* nB = has_next ? (const char*)g.Bt + (size_t)nxt.pb * (HN ? hstep : tstep) : cB;
        for (int t = 0; t < nt; t += 2) {
            const bool last = (t == nt - 2);
            const char* a1 = cA + (size_t)(t + 1) * kstep;
            const char* a2 = last ? nA : cA + (size_t)(t + 2) * kstep; const char* b2 = last ? nB : cB + (size_t)(t + 2) * kstep;
            const char* a3 = a2 + kstep; const char* b3 = b2 + kstep;
            if (last && has_next) S.a_ready(nxt);
            if constexpr (SP2) {
            PG8_LDB(B0, 0, 0); PG8_LDB1(B1, 0, 1); PG8_SCHED; PG8_LDA(At, 0, 0); PG8_STAGE(PG8_SA(1, 1), a1 + hstep, voffA);
            PG8_WAIT_V(8); PG8_WAIT_L(0); PG8_BAR; PG8_MMA(0, 0, At, B0); PG8_MMA1(0, 1, At, B1); PG8_BAR; PG8_SCHED;
            PG8_LDA(At, 0, 1); PG8_STAGE(PG8_SB(0, 0), b2, voffB); PG8_STAGE(PG8_SB(0, 1), b2 + hstep, voffB); PG8_STAGE(PG8_SA(0, 0), a2, voffA);
            PG8_WAIT_V(8); PG8_WAIT_L(0); PG8_BAR; PG8_MMA(1, 0, At, B0); PG8_MMA1(1, 1, At, B1); PG8_BAR; PG8_SCHED;
            PG8_LDB(B0, 1, 0); PG8_LDB1(B1, 1, 1); PG8_SCHED; PG8_LDA(At, 1, 0); PG8_STAGE(PG8_SA(0, 1), a2 + hstep, voffA);
            PG8_WAIT_V(8); PG8_WAIT_L(0); PG8_BAR; PG8_MMA(0, 0, At, B0); PG8_MMA1(0, 1, At, B1); PG8_BAR; PG8_SCHED;
            PG8_LDA(At, 1, 1); PG8_STAGE(PG8_SB(1, 0), b3, voffB); PG8_STAGE(PG8_SB(1, 1), b3 + hstep, voffB); PG8_STAGE(PG8_SA(1, 0), a3, voffA);
            PG8_WAIT_V(8); PG8_WAIT_L(0); PG8_BAR; PG8_MMA(1, 0, At, B0); PG8_MMA1(1, 1, At, B1); PG8_BAR; PG8_SCHED;
            } else {
            PG8_LDB(B0, 0, 0); PG8_SCHED; PG8_LDA(At, 0, 0); PG8_STAGE(PG8_SA(1, 1), a1 + hstep, voffA);
            PG8_WAIT_L(8); PG8_BAR; PG8_WAIT_L(0); PG8_MMA(0, 0, At, B0); PG8_BAR; PG8_SCHED;
            PG8_LDB1(B1, 0, 1); PG8_STAGE(PG8_SB(0, 0), b2, voffB);
            PG8_BAR; PG8_WAIT_L(0); PG8_MMA1(0, 1, At, B1); PG8_BAR;
            PG8_LDA(At, 0, 1); PG8_STAGE(PG8_SA(0, 0), a2, voffA);
            PG8_BAR; PG8_WAIT_L(0); PG8_MMA(1, 0, At, B0); PG8_BAR; PG8_SCHED;
            PG8_STAGE(PG8_SB(0, 1), b2 + hstep, voffB);
            PG8_WAIT_V(6); PG8_BAR; PG8_MMA1(1, 1, At, B1); PG8_BAR;
            PG8_LDB(B0, 1, 0); PG8_SCHED; PG8_LDA(At, 1, 0); PG8_STAGE(PG8_SA(0, 1), a2 + hstep, voffA);
            PG8_WAIT_L(8); PG8_BAR; PG8_WAIT_L(0); PG8_MMA(0, 0, At, B0); PG8_BAR; PG8_SCHED;
            PG8_LDB1(B1, 1, 1); PG8_STAGE(PG8_SB(1, 0), b3, voffB);
            PG8_BAR; PG8_WAIT_L(0); PG8_MMA1(0, 1, At, B1); PG8_BAR;
            PG8_LDA(At, 1, 1); PG8_STAGE(PG8_SA(1, 0), a3, voffA);
            PG8_BAR; PG8_WAIT_L(0); PG8_MMA(1, 0, At, B0); PG8_BAR; PG8_SCHED;
            PG8_STAGE(PG8_SB(1, 1), b3 + hstep, voffB);
            PG8_WAIT_V(6); PG8_BAR; PG8_MMA1(1, 1, At, B1); PG8_BAR;
            }
        }
        if constexpr (F8) asm volatile("s_nop 15\n\ts_nop 15" ::: "memory");
        if constexpr (ALIGN_EPI) { if (wr == 0) PG8_BAR; }
        if constexpr (Epi::RWACC) { E.rw(acc, cur, wr, wc, fr, fq); S.done(cur); }
        else if constexpr (!Epi::AFTER_DRAIN) { E(acc, cur, wr, wc, fr, fq); S.done(cur); }
        if (!has_next) break;
        bool zero_acc = true; if constexpr (Epi::RWACC) zero_acc = E.restart(cur);
        if (zero_acc)
#pragma unroll
        for (int a = 0; a < 2; ++a)
#pragma unroll
            for (int b = 0; b < 2; ++b)
#pragma unroll
                for (int m = 0; m < 4; ++m)
#pragma unroll
                    for (int n = 0; n < 2; ++n) acc[a][b][m][n] = (f32x4){0.f, 0.f, 0.f, 0.f};
        cur = nxt; cA = nA; cB = nB; ++ui;
        if constexpr (ALIGN_EPI) { if (wr == 1) PG8_BAR; }
    }
    PG8_WAIT_V(0);
    if constexpr (!ALIGN_EPI) { if (wr == 0) PG8_BAR; }
    PG8_BAR;
    if constexpr (Epi::AFTER_DRAIN) { E.fused(acc, cur, wr, wc, fr, fq, lds, wid, lane); S.done(cur); }
#undef PG8_SA
#undef PG8_SB
#undef PG8_STAGE
#undef PG8_LDA
#undef PG8_LDB
#undef PG8_MMA
#undef PG8_LDB1
#undef PG8_MMA1
#undef PG8_WAIT_V
#undef PG8_WAIT_L
#undef PG8_BAR
#undef PG8_SCHED
}
}

#ifndef PG8_SP2
#define PG8_SP2 true
#endif
#ifndef PG8_ALIGN
#define PG8_ALIGN true
#endif
#ifndef MK_WGM
#define MK_WGM 4
#endif
#ifndef MK_DENSE_F8
#define MK_DENSE_F8 1
#endif
#ifndef MK_PER_PHASE
#define MK_PER_PHASE 0
#endif

constexpr int NWAVES = 8;
constexpr int D = 1024, BATCH = 4, SEQ = 8192, CTXL = 256, DEPTH = 2;
constexpr int TL = BATCH * SEQ, TC = BATCH * CTXL, TA = TL + TC;
constexpr int INC = 6912, ZMC = 3840, ZGC = 3072, BW = 512;
constexpr int FFD = 2816, FFE = 3584, NE = 8;
constexpr int MAXPAN = 264, PCH = 264, NCHUNK = 1;
constexpr float RMS_EPS = 1e-6f;
constexpr float SC_XG = 4.0f, SC_WGU = 32.0f, SC_H = 4.0f, SC_WDN = 64.0f;
constexpr int C_QA = 0, C_KA = 512, C_VA = 640, C_UX = 768, C_GB = 1280, C_GC = 1792, C_QN = 2304, C_KN = 2816, C_VN = 3328;

constexpr size_t MiB = 1u << 20;
constexpr size_t WS_CTL = 0, CTL_ZERO_BYTES = 1 * MiB;
constexpr size_t WS_MOD = 1 * MiB;
constexpr size_t WS_ROPE = WS_MOD + 256 * 1024;
constexpr size_t WS_SLABCNT = WS_MOD + 320 * 1024;
constexpr size_t WS_PCUM = WS_MOD + 384 * 1024;
constexpr size_t WS_TOKER = WS_MOD + 512 * 1024;
constexpr size_t WS_TOKG = WS_MOD + 768 * 1024;
constexpr size_t WS_TOKPOS = WS_MOD + 1024 * 1024;
constexpr size_t WS_HCTX = 4 * MiB;
constexpr size_t WS_WIN = 8 * MiB;
constexpr size_t WS_WBR = 35 * MiB;
constexpr size_t WS_WOUT = 41 * MiB;
constexpr size_t WS_WGUD = 45 * MiB;
constexpr size_t WS_WDND = 56 * MiB;
constexpr size_t WS_WGUM = 62 * MiB;
constexpr size_t WS_WDNM = 118 * MiB;
constexpr size_t WS_RS = 146 * MiB;
constexpr size_t WS_HX = 230 * MiB;
constexpr size_t WS_ZM = 296 * MiB;
constexpr size_t WS_ZG = 544 * MiB;
constexpr size_t WS_O = 742 * MiB;
constexpr size_t WS_XG = WS_ZM;
constexpr size_t WS_HM = WS_ZM + 132 * MiB;
constexpr size_t WS_XG8 = WS_O;
constexpr size_t WS_HX8 = 841 * MiB;
constexpr size_t WS_WING8 = 874 * MiB;
constexpr size_t WS_END = 880 * MiB;
static_assert(WS_WIN + (size_t)2 * INC * D * 2 <= WS_WBR && WS_WGUD + (size_t)2 * FFD * D * 2 <= WS_WDND && WS_WDND + (size_t)D * FFD * 2 <= WS_WGUM, "ws map (weights)");
static_assert(WS_WGUM + (size_t)NE * 2 * FFE * D <= WS_WDNM && WS_WDNM + (size_t)NE * D * FFE <= WS_RS && WS_RS + (size_t)TA * D * 2 <= WS_HX, "ws map (moe weights, residual stream)");
static_assert(WS_HX + (size_t)TA * D * 2 <= WS_ZM && WS_ZM + (size_t)TA * ZMC * 2 <= WS_ZG && WS_ZG + (size_t)TA * ZGC * 2 <= WS_O && WS_O + (size_t)3 * TA * BW * 2 <= WS_END, "ws map (activations)");
static_assert(WS_HM + (size_t)MAXPAN * 256 * FFE <= WS_O && WS_XG8 + (size_t)MAXPAN * 256 * D <= WS_END && (size_t)MAXPAN * 256 * D * 2 <= 132 * MiB && (size_t)TA * D * 4 <= 132 * MiB, "ws map (moe)");
constexpr int CW_BAR = 4096;

constexpr int RING_OFF = 0, RING_BYTES = 131072;
constexpr int LDSCTL_OFF = RING_BYTES, MISC_OFF = LDSCTL_OFF + 320;
constexpr int LDS_BYTES = 147456;

#define GAS __attribute__((address_space(1)))
#define LAS __attribute__((address_space(3)))
typedef unsigned short bf16;
typedef unsigned v4u __attribute__((ext_vector_type(4)));
typedef unsigned v2u __attribute__((ext_vector_type(2)));
typedef float f32x4 __attribute__((ext_vector_type(4)));
typedef float f32x2 __attribute__((ext_vector_type(2)));
#define LDS_WAIT() asm volatile("s_waitcnt lgkmcnt(0)" ::: "memory")
#define VM_WAIT() asm volatile("s_waitcnt vmcnt(0)" ::: "memory")
__device__ __forceinline__ unsigned f2bf(float f) { unsigned u = __builtin_bit_cast(unsigned, f); return (u + 0x7fffu + ((u >> 16) & 1u)) >> 16; }
__device__ __forceinline__ unsigned pk2(float lo, float hi) { return f2bf(lo) | (f2bf(hi) << 16); }
__device__ __forceinline__ float bflo(unsigned w) { return __uint_as_float(w << 16); }
__device__ __forceinline__ float bfhi(unsigned w) { return __uint_as_float(w & 0xffff0000u); }
__device__ __forceinline__ float bf2f(bf16 b) { return __uint_as_float(((unsigned)b) << 16); }

#define XB_TMO      128
#define XB_XCNT(j)  (256  + 64 * (j))
#define XB_XSUB(j)  (1280 + 64 * (j))
#define XB_XGEN(j)  (2304 + 64 * (j))
#define XB_TOP      3328
#define XB_TOPGEN   3392
#define XCD_BAR_WORDS 3456
#define XB_SPIN_CAP (1u << 21)

__device__ __forceinline__ unsigned xb_ld(unsigned* p)              { return __hip_atomic_load(p, __ATOMIC_RELAXED, __HIP_MEMORY_SCOPE_AGENT); }
__device__ __forceinline__ unsigned xb_add(unsigned* p, unsigned v) { return __hip_atomic_fetch_add(p, v, __ATOMIC_RELAXED, __HIP_MEMORY_SCOPE_AGENT); }
__device__ __forceinline__ unsigned xb_xcc_id() { return (unsigned)__builtin_amdgcn_s_getreg((3 << 11) | 20) & 0xFu; }
#define XB_SPIN(cond, bar) do { unsigned _sp = 0; while (cond) { __builtin_amdgcn_s_sleep(1); \
    if ((++_sp & 255u) == 0u) { if (xb_ld(&(bar)[XB_TMO])) break; if (_sp > XB_SPIN_CAP) { atomicAdd(&(bar)[XB_TMO], 1u); break; } } } } while (0)

struct XcdBarrier {
    unsigned* bar; unsigned x;
    volatile LAS unsigned* st;
    int w;
};

__device__ __forceinline__ XcdBarrier xcd_barrier_post(unsigned* bar, volatile LAS unsigned* st) {
    XcdBarrier b; b.bar = bar; b.x = xb_xcc_id(); b.st = st; b.w = 0;
    if (threadIdx.x == 0) (void)xb_add(&bar[XB_XCNT(b.x)], 1u);
    return b;
}
__device__ __forceinline__ void xcd_barrier_complete(unsigned* bar, unsigned x, unsigned& nloc, unsigned& nx) {
    const unsigned G = gridDim.x * gridDim.y * gridDim.z;
    unsigned sum, cnt, mine, sp = 0u;
    for (;;) {
        sum = 0u; cnt = 0u; mine = 0u;
#pragma unroll
        for (unsigned j = 0; j < 16; ++j) { const unsigned c = xb_ld(&bar[XB_XCNT(j)]); sum += c; cnt += (c > 0u) ? 1u : 0u; mine = (j == x) ? c : mine; }
        if (sum == G) break;
        __builtin_amdgcn_s_sleep(1);
        if ((++sp & 255u) == 0u) { if (xb_ld(&bar[XB_TMO])) break; if (sp > XB_SPIN_CAP) { atomicAdd(&bar[XB_TMO], 1u); break; } }
    }
    nloc = mine > 0u ? mine : 1u; nx = cnt > 0u ? cnt : 1u;
}

__device__ __forceinline__ void xcd_barrier(const XcdBarrier& b) {
    asm volatile("s_waitcnt vmcnt(0)" ::: "memory");
    __syncthreads();
    if (b.w == 0 && mk_lane() == 0) {
        unsigned* bar = b.bar; { GAS unsigned* bg_ = (GAS unsigned*)bar; asm volatile("" : "+s"(bg_)); bar = (unsigned*)bg_; }
        __builtin_amdgcn_s_waitcnt(0);
        unsigned nloc = b.st[0], nx = b.st[1];
        if (nloc == 0u) { xcd_barrier_complete(bar, b.x, nloc, nx); b.st[0] = nloc; b.st[1] = nx; }
        const unsigned old = xb_add(&bar[XB_XSUB(b.x)], 1u);
        const unsigned gen = old / nloc;
        if (old + 1u == (gen + 1u) * nloc) {
            __builtin_amdgcn_fence(__ATOMIC_RELEASE, "agent");
            asm volatile("s_waitcnt vmcnt(0)" ::: "memory");
            const unsigned og = xb_add(&bar[XB_TOP], 1u);
            const unsigned tg = og / nx;
            if (og + 1u == (tg + 1u) * nx) xb_add(&bar[XB_TOPGEN], 1u);
            else XB_SPIN(xb_ld(&bar[XB_TOPGEN]) == tg, bar);
            __builtin_amdgcn_fence(__ATOMIC_ACQUIRE, "agent");
            xb_add(&bar[XB_XGEN(b.x)], 1u);
            asm volatile("s_waitcnt vmcnt(0)" ::: "memory");
        } else {
            XB_SPIN(xb_ld(&bar[XB_XGEN(b.x)]) == gen, bar);
            __builtin_amdgcn_fence(__ATOMIC_ACQUIRE, "agent");
            asm volatile("s_waitcnt vmcnt(0)" ::: "memory");
        }
    }
    __syncthreads();
}

struct Frame {
    LAS unsigned char* lds;
    volatile LAS unsigned* MISC;
    unsigned* ctl;
    int vcu, G;
    int wv;
};
enum { I_X = 0, I_C, I_CTX, I_CCTX, I_WADA, I_BADA, I_GPREMIX, I_GPOSTMIX, I_GPREFFN, I_GPOSTFFN, I_WIN, I_BGATE, I_SINK, I_CONVW, I_RPB, I_WBRANCH, I_WOUT, I_WGUD, I_WDND, I_WROUTER, I_BROUTER, I_WGUM, I_WDNM };

__device__ __forceinline__ float wave_sum(float v) {
    v += mk_dpp<0xB1>(v); v += mk_dpp<0x4E>(v); v += mk_dpp<0x141>(v); v += mk_dpp<0x140>(v);
    v += mk_dpp<0x142, 0xa>(v); v += mk_dpp<0x143, 0xc>(v);
    return __builtin_bit_cast(float, __builtin_amdgcn_readlane(__builtin_bit_cast(int, v), 63));
}
__device__ __forceinline__ float wave_max(float v) {
    v = fmaxf(v, mk_dpp<0xB1>(v)); v = fmaxf(v, mk_dpp<0x4E>(v)); v = fmaxf(v, mk_dpp<0x141>(v)); v = fmaxf(v, mk_dpp<0x140>(v));
    const float a = __builtin_bit_cast(float, __builtin_amdgcn_readlane(__builtin_bit_cast(int, v), 0)), b = __builtin_bit_cast(float, __builtin_amdgcn_readlane(__builtin_bit_cast(int, v), 16)),
                c = __builtin_bit_cast(float, __builtin_amdgcn_readlane(__builtin_bit_cast(int, v), 32)), d = __builtin_bit_cast(float, __builtin_amdgcn_readlane(__builtin_bit_cast(int, v), 48));
    return fmaxf(fmaxf(a, b), fmaxf(c, d));
}

__device__ __forceinline__ void row_store_fp8(unsigned char* p, int lane, const f32x4 (&h)[4], float sc) {
#pragma unroll
    for (int c = 0; c < 2; ++c) { const f32x4 a = __builtin_elementwise_min(__builtin_elementwise_max(h[2 * c] * sc, (f32x4){-448.f, -448.f, -448.f, -448.f}), (f32x4){448.f, 448.f, 448.f, 448.f}), b = __builtin_elementwise_min(__builtin_elementwise_max(h[2 * c + 1] * sc, (f32x4){-448.f, -448.f, -448.f, -448.f}), (f32x4){448.f, 448.f, 448.f, 448.f});
        v2u w; w.x = pg8::pk4_fp8(a.x, a.y, a.z, a.w); w.y = pg8::pk4_fp8(b.x, b.y, b.z, b.w);
        *(v2u*)(p + 8 * (64 * c + lane)) = w; }
}

__device__ __forceinline__ void tr_item(const float* W, int N, int k0, int n0, bf16* WT, int Kd, int drow0, LAS float* scr, int lane) {
#pragma unroll
    for (int i = 0; i < 8; ++i) { const int kk = 8 * i + (lane >> 3), c4 = 4 * (lane & 7); const f32x4 v = *(const f32x4*)(W + (size_t)(k0 + kk) * N + n0 + c4);
        LAS float* d = scr + kk * 33 + c4; d[0] = v.x; d[1] = v.y; d[2] = v.z; d[3] = v.w; }
    LDS_WAIT(); asm volatile("" ::: "memory");
    const int c = lane & 7;
#pragma unroll
    for (int j = 0; j < 4; ++j) { const int n = (lane >> 3) + 8 * j; const LAS float* s = scr + (8 * c) * 33 + n;
        v4u o; o.x = pk2(s[0 * 33], s[1 * 33]); o.y = pk2(s[2 * 33], s[3 * 33]); o.z = pk2(s[4 * 33], s[5 * 33]); o.w = pk2(s[6 * 33], s[7 * 33]);
        *(v4u*)(WT + (size_t)(drow0 + n) * Kd + k0 + 8 * c) = o; }
    LDS_WAIT(); asm volatile("" ::: "memory");
}
__device__ __forceinline__ void tr_matrix_item(const float* W, int K, int N, int ff, bf16* WT, int item, LAS float* scr, int lane) {
    const int nblk = N / 32, kb = item / nblk, nb = item % nblk, n0 = 32 * nb;
    int drow0 = n0;
    if (ff > 0) { const int isu = n0 >= ff ? 1 : 0, nn = n0 - isu * ff; drow0 = 256 * (nn >> 7) + 128 * isu + (nn & 127); }
    tr_item(W, N, 64 * kb, n0, WT, K, drow0, scr, lane);
}

__device__ __forceinline__ void tr_item8(const float* W, int N, int k0, int n0, unsigned char* WT, int Kd, int drow0, float scale, LAS float* scr, int lane) {
#pragma unroll
    for (int i = 0; i < 8; ++i) { const int kk = 8 * i + (lane >> 3), c4 = 4 * (lane & 7); const f32x4 v = *(const f32x4*)(W + (size_t)(k0 + kk) * N + n0 + c4);
        LAS float* d = scr + kk * 33 + c4; d[0] = v.x; d[1] = v.y; d[2] = v.z; d[3] = v.w; }
    LDS_WAIT(); asm volatile("" ::: "memory");
    const int n = lane >> 1, kh = lane & 1; const LAS float* s = scr + (32 * kh) * 33 + n;
    unsigned w[8];
#pragma unroll
    for (int j = 0; j < 8; ++j) w[j] = pg8::pk4_fp8(s[(4 * j) * 33] * scale, s[(4 * j + 1) * 33] * scale, s[(4 * j + 2) * 33] * scale, s[(4 * j + 3) * 33] * scale);
    v4u* dst = (v4u*)(WT + (size_t)(drow0 + n) * Kd + k0 + 32 * kh);
    dst[0] = (v4u){w[0], w[1], w[2], w[3]}; dst[1] = (v4u){w[4], w[5], w[6], w[7]};
    LDS_WAIT(); asm volatile("" ::: "memory");
}
__device__ __forceinline__ void tr_matrix_item8(const float* W, int K, int N, int ff, unsigned char* WT, float scale, int item, LAS float* scr, int lane) {
    const int nblk = N / 32, kb = item / nblk, nb = item % nblk, n0 = 32 * nb;
    int drow0 = n0;
    if (ff > 0) { const int isu = n0 >= ff ? 1 : 0, nn = n0 - isu * ff; drow0 = 256 * (nn >> 7) + 128 * isu + (nn & 127); }
    tr_item8(W, N, 64 * kb, n0, WT, K, drow0, scale, scr, lane);
}

__device__ __forceinline__ void row_load(const float* p, int lane, f32x4 (&v)[4]) {
#pragma unroll
    for (int c = 0; c < 2; ++c) { const f32x4* r = (const f32x4*)(p + 8 * (64 * c + lane)); v[2 * c] = r[0]; v[2 * c + 1] = r[1]; }
}
__device__ __forceinline__ void row_load_bf16(const bf16* p, int lane, f32x4 (&v)[4]) {
#pragma unroll
    for (int c = 0; c < 2; ++c) { const v4u w = *(const v4u*)(p + 8 * (64 * c + lane));
        v[2 * c] = (f32x4){bflo(w.x), bfhi(w.x), bflo(w.y), bfhi(w.y)}; v[2 * c + 1] = (f32x4){bflo(w.z), bfhi(w.z), bflo(w.w), bfhi(w.w)}; }
}
__device__ __forceinline__ void row_store(float* p, int lane, const f32x4 (&v)[4]) {
#pragma unroll
    for (int c = 0; c < 2; ++c) { f32x4* r = (f32x4*)(p + 8 * (64 * c + lane)); r[0] = v[2 * c]; r[1] = v[2 * c + 1]; }
}
__device__ __forceinline__ float row_rrms(const f32x4 (&v)[4]) {
    float s = 0.f;
#pragma unroll
    for (int j = 0; j < 4; ++j) s += (v[j].x * v[j].x + v[j].y * v[j].y) + (v[j].z * v[j].z + v[j].w * v[j].w);
    return 1.0f / sqrtf(wave_sum(s) * (1.0f / D) + RMS_EPS);
}
__device__ __forceinline__ void vec_load(const float* p, int lane, f32x4 (&v)[4]) { row_load(p, lane, v); }
__device__ __forceinline__ void row_normmod(const f32x4 (&x)[4], float rr, const f32x4 (&g)[4], const f32x4 (&shift)[4], const f32x4 (&scale)[4], f32x4 (&h)[4]) {
#pragma unroll
    for (int j = 0; j < 4; ++j) h[j] = (x[j] * rr * g[j]) * (scale[j] + 1.0f) + shift[j];
}
__device__ __forceinline__ void row_store_bf16(bf16* p, int lane, const f32x4 (&h)[4]) {
#pragma unroll
    for (int c = 0; c < 2; ++c) { v4u w; w.x = pk2(h[2 * c].x, h[2 * c].y); w.y = pk2(h[2 * c].z, h[2 * c].w); w.z = pk2(h[2 * c + 1].x, h[2 * c + 1].y); w.w = pk2(h[2 * c + 1].z, h[2 * c + 1].w);
        *(v4u*)(p + 8 * (64 * c + lane)) = w; }
}

namespace at {
typedef short bf16x8 __attribute__((ext_vector_type(8)));
typedef short s16x4 __attribute__((ext_vector_type(4)));
typedef short v4i16_t __attribute__((ext_vector_type(4)));
typedef float f32x16 __attribute__((ext_vector_type(16)));
constexpr int NS = 4, PF = 3, SLOT = 16384;
constexpr int LDS_TAB = NS * SLOT + 1024;
constexpr int LDS_TT = LDS_TAB + 8 * 2048 + 1024;
constexpr int MAXT = 160;
constexpr float LOG2E = 1.4426950408889634f, C2 = 0.125f * LOG2E;
__device__ __forceinline__ unsigned cvtpk(float lo, float hi) { unsigned r; asm volatile("v_cvt_pk_bf16_f32 %0, %1, %2" : "=v"(r) : "v"(lo), "v"(hi)); return r; }
__device__ __forceinline__ float hmax(float v) { auto rr = __builtin_amdgcn_permlane32_swap(__float_as_uint(v), __float_as_uint(v), false, false); return fmaxf(__uint_as_float(rr[0]), __uint_as_float(rr[1])); }
__device__ __forceinline__ float hsum(float v) { auto rr = __builtin_amdgcn_permlane32_swap(__float_as_uint(v), __float_as_uint(v), false, false); return __uint_as_float(rr[0]) + __uint_as_float(rr[1]); }

__device__ __forceinline__ void glds16(const void* gsrc, unsigned lds_dst) { unsigned keep;
    asm volatile("s_mov_b32 %0, m0\n\ts_mov_b32 m0, %2\n\ts_nop 0\n\tglobal_load_lds_dwordx4 %1, off\n\ts_mov_b32 m0, %0" : "=&s"(keep) : "v"(gsrc), "s"(lds_dst) : "memory"); }
__device__ __forceinline__ void tile_issue(LAS unsigned char* slot, const bf16* ZMp, size_t row0, int kcol, int vcol, int wid, int lane) {
    const bf16* ksrc = ZMp + (row0 + lane) * ZMC + kcol + wid * 8;
    const bf16* vsrc = ZMp + (row0 + 16 * (wid & 3) + (lane >> 2)) * ZMC + vcol + (wid >> 2) * 32 + (lane & 3) * 8;
    const unsigned dst = (unsigned)__builtin_amdgcn_readfirstlane((int)(unsigned)(uintptr_t)slot + wid * 1024);
    glds16(ksrc, dst); glds16(vsrc, dst + 8192u);
}
__device__ __forceinline__ void k_load_half(bf16x8 (&kf)[4], const LAS unsigned char* Ks, int h, int r32, int hi) {
    const LAS unsigned char* kb = Ks + hi * 1024 + r32 * 16 + h * 4096;
#pragma unroll
    for (int d0 = 0; d0 < 2; ++d0) { kf[2 * d0] = *(const LAS bf16x8*)(kb + d0 * 2048); kf[2 * d0 + 1] = *(const LAS bf16x8*)(kb + d0 * 2048 + 512); }
}
__device__ __forceinline__ void qk_tile(f32x16& p0, f32x16& p1, const LAS unsigned char* Ks, const bf16x8 (&kfa)[4], const bf16x8 (&qr)[4], int r32, int hi) {
    bf16x8 kfb[4]; k_load_half(kfb, Ks, 1, r32, hi);
    __builtin_amdgcn_sched_barrier(0);
#pragma unroll
    for (int r = 0; r < 16; ++r) { p0[r] = 0.f; p1[r] = 0.f; }
#pragma unroll
    for (int d0 = 0; d0 < 2; ++d0) {
        p0 = __builtin_amdgcn_mfma_f32_32x32x16_bf16(kfa[2 * d0], qr[d0], p0, 0, 0, 0);
        p1 = __builtin_amdgcn_mfma_f32_32x32x16_bf16(kfa[2 * d0 + 1], qr[d0], p1, 0, 0, 0);
    }
#pragma unroll
    for (int d0 = 0; d0 < 2; ++d0) {
        p0 = __builtin_amdgcn_mfma_f32_32x32x16_bf16(kfb[2 * d0], qr[2 + d0], p0, 0, 0, 0);
        p1 = __builtin_amdgcn_mfma_f32_32x32x16_bf16(kfb[2 * d0 + 1], qr[2 + d0], p1, 0, 0, 0);
    }
}
__device__ __forceinline__ s16x4 vtr(const LAS unsigned char* p) { return __builtin_bit_cast(s16x4, __builtin_amdgcn_ds_read_tr16_b64_v4i16((LAS v4i16_t*)p)); }
template <int LV> __device__ __forceinline__ constexpr bool live0(int r) { return LV == 2 ? r >= 12 : true; }
template <int LV> __device__ __forceinline__ constexpr bool live1(int r) { return LV == 1 ? r < 4 : true; }
template <bool RAW, int LV, int VAR = 0>
__device__ __forceinline__ void sm_pv(f32x16& x0, f32x16& x1, float& m, float& l, f32x16 (&o)[2], const LAS unsigned char* Vs, int lane, int hi, bf16x8 (&kfa)[4], const LAS unsigned char* Ksn, bool pre) {
    if (VAR == 2) { l += x0[0] + x1[15];
        bf16x8 pw_[4]; unsigned w_[16];
#pragma unroll
        for (int i = 0; i < 8; ++i) { w_[i] = cvtpk(x0[2 * i], x0[2 * i + 1]); w_[8 + i] = cvtpk(x1[2 * i], x1[2 * i + 1]); }
#pragma unroll
        for (int k = 0; k < 4; ++k) { typedef unsigned u32x4_ __attribute__((ext_vector_type(4))); u32x4_ t; t.x = w_[4 * k]; t.y = w_[4 * k + 1]; t.z = w_[4 * k + 2]; t.w = w_[4 * k + 3]; pw_[k] = __builtin_bit_cast(bf16x8, t); }
        const LAS unsigned char* vb_ = Vs + ((lane >> 4) & 1) * 32 + (lane & 3) * 8 + (4 * hi + ((lane & 15) >> 2)) * 64;
#pragma unroll
        for (int d0 = 0; d0 < 2; ++d0)
#pragma unroll
            for (int ks = 0; ks < 4; ++ks) { if ((LV == 1 && ks == 3) || (LV == 2 && ks == 0)) continue;
                const s16x4 lo = vtr(vb_ + d0 * 4096 + ks * 1024), hh = vtr(vb_ + d0 * 4096 + ks * 1024 + 512);
                const bf16x8 vf = (bf16x8){lo[0], lo[1], lo[2], lo[3], hh[0], hh[1], hh[2], hh[3]};
                o[d0] = __builtin_amdgcn_mfma_f32_32x32x16_bf16(vf, pw_[ks], o[d0], 0, 0, 0); }
        if (pre) k_load_half(kfa, Ksn, 0, lane & 31, hi);
        return; }
    if (VAR == 3) { if (pre) k_load_half(kfa, Ksn, 0, lane & 31, hi); l += x0[0] + x1[15] + x0[7] + x1[3]; o[0][0] += x0[1]; o[1][0] += x1[1]; return; }
    float rm = -INFINITY;
#pragma unroll
    for (int r = 0; r < 16; ++r) { if (live0<LV>(r)) rm = fmaxf(rm, x0[r]); if (live1<LV>(r)) rm = fmaxf(rm, x1[r]); }
    rm = hmax(rm);
    const float mn = fmaxf(m, RAW ? rm * C2 : rm);
    { const float sc = __builtin_amdgcn_exp2f(m - mn); l *= sc;
#pragma unroll
      for (int r = 0; r < 16; ++r) { o[0][r] *= sc; o[1][r] *= sc; } }
    m = mn;
    float sum = 0.f;
#pragma unroll
    for (int r = 0; r < 16; ++r) {
        if (live0<LV>(r)) { x0[r] = __builtin_amdgcn_exp2f(RAW ? __builtin_fmaf(x0[r], C2, -mn) : x0[r] - mn); sum += x0[r]; } else x0[r] = 0.f;
        if (live1<LV>(r)) { x1[r] = __builtin_amdgcn_exp2f(RAW ? __builtin_fmaf(x1[r], C2, -mn) : x1[r] - mn); sum += x1[r]; } else x1[r] = 0.f;
    }
    l += sum;
    bf16x8 pw[4];
    { unsigned w[16];
#pragma unroll
      for (int i = 0; i < 8; ++i) { w[i] = cvtpk(x0[2 * i], x0[2 * i + 1]); w[8 + i] = cvtpk(x1[2 * i], x1[2 * i + 1]); }
#pragma unroll
      for (int k = 0; k < 4; ++k) { typedef unsigned u32x4_ __attribute__((ext_vector_type(4))); u32x4_ t; t.x = w[4 * k]; t.y = w[4 * k + 1]; t.z = w[4 * k + 2]; t.w = w[4 * k + 3]; pw[k] = __builtin_bit_cast(bf16x8, t); } }
    if (pre) k_load_half(kfa, Ksn, 0, lane & 31, hi);
    const LAS unsigned char* vb = Vs + ((lane >> 4) & 1) * 32 + (lane & 3) * 8 + (4 * hi + ((lane & 15) >> 2)) * 64;
#pragma unroll
    for (int d0 = 0; d0 < 2; ++d0)
#pragma unroll
        for (int ks = 0; ks < 4; ++ks) {
            if ((LV == 1 && ks == 3) || (LV == 2 && ks == 0)) continue;
            const s16x4 lo = vtr(vb + d0 * 4096 + ks * 1024), hh = vtr(vb + d0 * 4096 + ks * 1024 + 512);
            const bf16x8 vf = (bf16x8){lo[0], lo[1], lo[2], lo[3], hh[0], hh[1], hh[2], hh[3]};
            o[d0] = __builtin_amdgcn_mfma_f32_32x32x16_bf16(vf, pw[ks], o[d0], 0, 0, 0);
        }
}
__device__ __forceinline__ void o_store(const f32x16 (&o)[2], float l, bf16* orow, int hi) {
    const float inv = __builtin_amdgcn_rcpf(hsum(l));
#pragma unroll
    for (int d0 = 0; d0 < 2; ++d0)
#pragma unroll
        for (int gp = 0; gp < 2; ++gp) {
            unsigned w[2][2];
#pragma unroll
            for (int k = 0; k < 2; ++k) { const int g = 2 * gp + k; w[k][0] = cvtpk(o[d0][4 * g] * inv, o[d0][4 * g + 1] * inv); w[k][1] = cvtpk(o[d0][4 * g + 2] * inv, o[d0][4 * g + 3] * inv); }
            unsigned rcv[2];
#pragma unroll
            for (int i = 0; i < 2; ++i) { const unsigned snd = hi ? w[0][i] : w[1][i];
                auto rr = __builtin_amdgcn_permlane32_swap(snd, snd, false, false); rcv[i] = hi ? rr[0] : rr[1]; }
            v4u st; if (hi) { st.x = rcv[0]; st.y = rcv[1]; st.z = w[1][0]; st.w = w[1][1]; } else { st.x = w[0][0]; st.y = w[0][1]; st.z = rcv[0]; st.w = rcv[1]; }
            *(v4u*)(orow + 32 * d0 + 16 * gp + 8 * hi) = st;
        }
}
#define AT_WAIT_BAR(N) asm volatile("s_waitcnt vmcnt(" #N ")\n\ts_barrier" ::: "memory")

struct UDesc { int kind, b, hh, blk, cq, nw, lo; };
__device__ __forceinline__ UDesc unit_desc(int i, int vcu, int UPW, bool ctx_out) {
    UDesc d; d.kind = -1; d.b = 0; d.hh = 0; d.blk = 0; d.cq = 0; d.nw = 0; d.lo = 0;
    if (i < 2 * UPW) { const int u = vcu * UPW + (i < UPW ? i : i - UPW); if (u >= 1024) return d; d.kind = i < UPW ? 0 : 1; d.b = u >> 8;
        if (d.kind == 0) { d.hh = (u >> 5) & 7; d.blk = u & 31; } else { d.hh = (u >> 7) & 1; d.blk = u & 127; } }
    else if (i == 2 * UPW) { if (!ctx_out || vcu >= 64) return d; d.cq = 1;
        if (vcu < 32) { d.kind = 1; d.b = vcu >> 3; d.hh = (vcu >> 2) & 1; d.blk = vcu & 3; } else { d.kind = 0; d.b = (vcu - 32) >> 3; d.hh = (vcu - 32) & 7; d.blk = 0; } }
    else return d;
    if (!d.cq) {
        if (d.kind == 1) { d.lo = max(0, 2 - d.blk); d.nw = min(4, 129 - d.blk) - d.lo + 1; }
        else { d.lo = min(max(4 * d.blk - 4, 0), 120); d.nw = min(max(4 * d.blk - 1, 0), 120) + 7 - d.lo + 1; }
    }
    return d;
}
__device__ __forceinline__ void tile_src(const UDesc& d, int t, int& row0, int& cols) {
    const int kcol = d.kind == 1 ? C_KA + d.hh * 64 : C_KN + d.hh * 64, vcol = d.kind == 1 ? C_VA + d.hh * 64 : C_VN + d.hh * 64;
    cols = kcol | (vcol << 16);
    if (t < d.nw) row0 = d.kind == 1 ? d.b * SEQ + 64 * d.blk - 128 + 64 * (d.lo + t) : d.b * SEQ + 64 * (d.lo + t);
    else row0 = TL + d.b * CTXL + 64 * (t - d.nw);
}
__device__ __forceinline__ size_t q_row(const UDesc& d, int wid, int r32) {
    if (d.kind == 1) { const int qrel = 32 * (wid >> 2) + r32; return d.cq ? (size_t)TL + (size_t)d.b * CTXL + 64 * d.blk + qrel : (size_t)d.b * SEQ + 64 * d.blk + qrel; }
    const int pair = wid >> 1, c = 32 * (wid & 1) + r32;
    return d.cq ? (size_t)TL + (size_t)d.b * CTXL + 64 * pair + c : (size_t)d.b * SEQ + (size_t)(4 * d.blk + pair) * 64 + c;
}
__device__ __forceinline__ void q_load(const UDesc& d, const bf16* ZMp, int wid, int r32, int hi, bf16x8 (&qr)[4]) {
    const int qcol = d.kind == 1 ? C_QA + (d.hh * 4 + (wid & 3)) * 64 : C_QN + d.hh * 64;
    const bf16* p = ZMp + q_row(d, wid, r32) * ZMC + qcol + 8 * hi;
#pragma unroll
    for (int d0 = 0; d0 < 4; ++d0) qr[d0] = *(const bf16x8*)(p + 16 * d0);
}

template <int VAR = 0>
__device__ __forceinline__ void attn_phase(LAS unsigned char* lds, const bf16* ZMp, bf16* OAp, bf16* OCp, const float* sinkp, const float* rpbl, int vcu, int G, bool ctx_out, int tid, int wid, int lane) {
    const int r32 = lane & 31, hi = lane >> 5;
    const int UPW = (1024 + G - 1) / G, NU = 2 * UPW + 1;
    LAS int* tt = (LAS int*)(lds + LDS_TT);
    int Ttot = 0;
    for (int i = 0; i < NU; ++i) { const UDesc d = unit_desc(i, vcu, UPW, ctx_out); if (d.kind < 0) continue; const int nt = d.nw + 4;
        for (int t = tid; t < nt; t += NWAVES * 64) { int row0, cols; tile_src(d, t, row0, cols); if (Ttot + t < MAXT) { tt[2 * (Ttot + t)] = row0; tt[2 * (Ttot + t) + 1] = cols; } }
        Ttot += nt; }
    if (Ttot > MAXT) Ttot = MAXT;
    if (tid < 8) ((LAS float*)(lds + LDS_TT + MAXT * 8))[tid] = sinkp[tid] * LOG2E;
    for (int u = tid; u < 8 * 480; u += NWAVES * 64) { const int h = u / 480, e = u - 480 * h, dr = e >> 5, dc = e & 31; ((LAS float*)(lds + LDS_TAB))[h * 512 + e] = dc < 31 ? rpbl[(h * 15 + dr) * 31 + dc] * LOG2E : 0.f; }
    asm volatile("s_waitcnt lgkmcnt(0)\n\ts_barrier" ::: "memory");
#define AT_ISSUE(T) do { const int row0_ = __builtin_amdgcn_readfirstlane(tt[2 * (T)]), cols_ = __builtin_amdgcn_readfirstlane(tt[2 * (T) + 1]); \
        tile_issue(lds + ((T) & (NS - 1)) * SLOT, ZMp, (size_t)row0_, cols_ & 0xffff, cols_ >> 16, wid, lane); } while (0)
    for (int T = 0; T < PF && T < Ttot; ++T) AT_ISSUE(T);
    int Tb = 0;
    bf16x8 qn[4];
    { int i0 = 0; UDesc d0 = unit_desc(0, vcu, UPW, ctx_out); while (d0.kind < 0 && i0 + 1 < NU) { ++i0; d0 = unit_desc(i0, vcu, UPW, ctx_out); } if (d0.kind >= 0) q_load(d0, ZMp, wid, r32, hi, qn); }
    for (int i = 0; i < NU; ++i) {
        const UDesc d = unit_desc(i, vcu, UPW, ctx_out); if (d.kind < 0) continue;
        bf16x8 qr[4];
#pragma unroll
        for (int k = 0; k < 4; ++k) qr[k] = qn[k];
        { int j = i + 1; UDesc dn = unit_desc(j, vcu, UPW, ctx_out); while (dn.kind < 0 && j + 1 < NU) { ++j; dn = unit_desc(j, vcu, UPW, ctx_out); } if (dn.kind < 0) dn = d; q_load(dn, ZMp, wid, r32, hi, qn); }
        const int NT = d.nw + 4;
        f32x16 o[2];
#pragma unroll
        for (int r = 0; r < 16; ++r) { o[0][r] = 0.f; o[1][r] = 0.f; }
        float m, l;
        if (d.kind == 1) {
            const int head = d.hh * 4 + (wid & 3), qrel = 32 * (wid >> 2) + r32;
            m = ((const LAS float*)(lds + LDS_TT + MAXT * 8))[head]; l = (hi == 0) ? 1.0f : 0.0f;
            bf16x8 kfa[4];
#pragma unroll
            for (int k = 0; k < 4; ++k) kfa[k] = (bf16x8){0, 0, 0, 0, 0, 0, 0, 0};
            int t = 0;
            do {
                const int T = Tb + t;
                if (T + 2 < Ttot) AT_WAIT_BAR(2); else AT_WAIT_BAR(0);
                if (t == NT - 1) asm volatile("" : "+v"(qn[0]), "+v"(qn[1]), "+v"(qn[2]), "+v"(qn[3]));
                if (VAR != 5 && T + PF < Ttot) AT_ISSUE(T + PF);
                const LAS unsigned char* sl = lds + (T & (NS - 1)) * SLOT;
                const LAS unsigned char* sln = lds + ((T + 1) & (NS - 1)) * SLOT; const bool pre = t + 1 < NT;
                if (t == 0) k_load_half(kfa, sl, 0, r32, hi);
                f32x16 x0, x1; qk_tile(x0, x1, sl, kfa, qr, r32, hi);
                const int j = d.lo + t;
                if (t < d.nw && (j == 0 || j == 4)) {
                    const int dq = qrel + 128 - 64 * j - 4 * hi;
#pragma unroll
                    for (int r = 0; r < 16; ++r) { const int dd = dq - ((r & 3) + 8 * (r >> 2));
                        x0[r] = (dd <= 128 && dd >= -128) ? x0[r] * C2 : -INFINITY; x1[r] = (dd - 32 <= 128 && dd - 32 >= -128) ? x1[r] * C2 : -INFINITY; }
                    sm_pv<false, 0, VAR>(x0, x1, m, l, o, sl + 8192, lane, hi, kfa, sln, pre);
                } else sm_pv<true, 0, VAR>(x0, x1, m, l, o, sl + 8192, lane, hi, kfa, sln, pre);
            } while (++t < NT);
            o_store(o, l, OAp + q_row(d, wid, r32) * BW + head * 64, hi);
        } else {
            const int half = wid & 1, c = 32 * half + r32, r = 4 * d.blk + (wid >> 1);
            const int r0w = min(max(r - 4, 0), 120), c0 = min(max(c - 8, 0), 48);
            const LAS float* tab = (const LAS float*)(lds + LDS_TAB + d.hh * 2048);
            unsigned vm = 0u;
#pragma unroll
            for (int r_ = 0; r_ < 16; ++r_) { const int kc = (r_ & 3) + 8 * (r_ >> 2) + 4 * hi; vm |= ((unsigned)(kc - c0) < 16u ? 1u : 0u) << r_; vm |= ((unsigned)(kc + 32 - c0) < 16u ? 1u : 0u) << (16 + r_); }
            m = -1e30f; l = 0.f;
            bf16x8 kfa[4];
#pragma unroll
            for (int k = 0; k < 4; ++k) kfa[k] = (bf16x8){0, 0, 0, 0, 0, 0, 0, 0};
            int t = 0;
            do {
                const int T = Tb + t;
                if (T + 2 < Ttot) AT_WAIT_BAR(2); else AT_WAIT_BAR(0);
                if (t == NT - 1) asm volatile("" : "+v"(qn[0]), "+v"(qn[1]), "+v"(qn[2]), "+v"(qn[3]));
                if (VAR != 5 && T + PF < Ttot) AT_ISSUE(T + PF);
                const int kr = d.lo + t;
                const bool use = !(t < d.nw && (kr < r0w || kr > r0w + 7));
                const bool usen = !(t + 1 < d.nw && (kr + 1 < r0w || kr + 1 > r0w + 7));
                const LAS unsigned char* sl = lds + (T & (NS - 1)) * SLOT; const LAS unsigned char* sln = lds + ((T + 1) & (NS - 1)) * SLOT; const bool pre = usen && t + 1 < NT;
                if (!use) { if (pre) k_load_half(kfa, sln, 0, r32, hi); continue; }
                if (t == 0) k_load_half(kfa, sl, 0, r32, hi);
                f32x16 x0, x1; qk_tile(x0, x1, sl, kfa, qr, r32, hi);
                if (t < d.nw) {
                    const LAS float* tb = tab + (kr - r + 7) * 32 + (4 * hi - c + 15);
                    if (half == 0) {
                        float b0[16], b1[4];
#pragma unroll
                        for (int r_ = 0; r_ < 16; ++r_) { const int rr = (r_ & 3) + 8 * (r_ >> 2); b0[r_] = tb[rr]; if (r_ < 4) b1[r_] = tb[rr + 32]; }
#pragma unroll
                        for (int r_ = 0; r_ < 16; ++r_) {
                            x0[r_] = ((vm >> r_) & 1u) ? __builtin_fmaf(x0[r_], C2, b0[r_]) : -INFINITY;
                            if (r_ < 4) x1[r_] = ((vm >> (16 + r_)) & 1u) ? __builtin_fmaf(x1[r_], C2, b1[r_]) : -INFINITY; }
                        sm_pv<false, 1, VAR>(x0, x1, m, l, o, sl + 8192, lane, hi, kfa, sln, pre);
                    } else {
                        float b0[4], b1[16];
#pragma unroll
                        for (int r_ = 0; r_ < 16; ++r_) { const int rr = (r_ & 3) + 8 * (r_ >> 2); if (r_ >= 12) b0[r_ - 12] = tb[rr]; b1[r_] = tb[rr + 32]; }
#pragma unroll
                        for (int r_ = 0; r_ < 16; ++r_) {
                            if (r_ >= 12) x0[r_] = ((vm >> r_) & 1u) ? __builtin_fmaf(x0[r_], C2, b0[r_ - 12]) : -INFINITY;
                            x1[r_] = ((vm >> (16 + r_)) & 1u) ? __builtin_fmaf(x1[r_], C2, b1[r_]) : -INFINITY; }
                        sm_pv<false, 2, VAR>(x0, x1, m, l, o, sl + 8192, lane, hi, kfa, sln, pre);
                    }
                } else sm_pv<true, 0, VAR>(x0, x1, m, l, o, sl + 8192, lane, hi, kfa, sln, pre);
            } while (++t < NT);
            o_store(o, l, OCp + q_row(d, wid, r32) * BW + d.hh * 64, hi);
        }
        Tb += NT;
    }
    AT_WAIT_BAR(0);
#undef AT_ISSUE
}
}

constexpr int PH_PER_LAYER = 17, NPHASES = 1 + DEPTH * PH_PER_LAYER;
struct Args { const float* in[23]; float* out; unsigned char* ws; int ph_lo, ph_hi; };
typedef __attribute__((address_space(4))) const Args CArgs;
__global__ void __launch_bounds__(NWAVES * 64, 2) mk_fwd(Args args) {
    extern __shared__ __attribute__((aligned(16))) unsigned char lds[];
    Frame F;
    F.lds = (LAS unsigned char*)lds;
    F.MISC = (volatile LAS unsigned*)(F.lds + MISC_OFF);
    F.G = gridDim.x; { const int bx = blockIdx.x; F.vcu = (F.G % 8 == 0) ? (bx % 8) * (F.G / 8) + bx / 8 : bx; }
    F.ctl = (unsigned*)(args.ws + WS_CTL);
    for (int u = threadIdx.x; u < (LDS_BYTES - LDSCTL_OFF) / 4; u += NWAVES * 64) ((LAS unsigned*)(F.lds + LDSCTL_OFF))[u] = 0u;
    { int wv_ = __builtin_amdgcn_readfirstlane((int)(threadIdx.x >> 6)); asm volatile("" : "+s"(wv_)); F.wv = wv_; }
    __syncthreads();
    const int lo = args.ph_lo, hi = args.ph_hi;
    const bool fused = (hi - lo) > 1;
    XcdBarrier bar; bar.bar = F.ctl + CW_BAR; bar.x = 0; bar.st = nullptr; bar.w = F.wv;
    if (fused) { bar = xcd_barrier_post(F.ctl + CW_BAR, F.MISC + 8); bar.w = F.wv; }
#ifndef MK_MASK
#define MK_MASK 0xFFFFFFFFu
#endif
#define SLOT(k) ((k) == 0 ? 0 : (((k) - 1) % PH_PER_LAYER) + 1)
#define IN(k) (((MK_MASK >> SLOT(k)) & 1u) && lo <= (k) && (k) < hi)
#define GRID_BAR() do { if (fused) xcd_barrier(bar); } while (0)
    const int NGW = F.G * NWAVES;
#define PHASE_ENTER() GAS unsigned char* wsg_ = (GAS unsigned char*)args.ws; asm volatile("" : "+s"(wsg_)); unsigned char* ws = (unsigned char*)wsg_; float* outp = (float*)(GAS float*)args.out; (void)outp; const CArgs* ka = (const CArgs*)__builtin_amdgcn_kernarg_segment_ptr(); asm volatile("" : "+s"(ka)); \
    int tid_ = (F.wv << 6) | mk_lane(); asm volatile("" : "+v"(tid_)); const int lane = tid_ & 63; const int wave = __builtin_amdgcn_readfirstlane(tid_ >> 6); const int gw = F.vcu * NWAVES + wave; (void)gw; (void)lane; (void)ws; (void)ka;
#define INP(i) ((const float*)(const GAS float*)ka->in[i])
#define MOD ((float*)(GAS float*)(ws + WS_MOD))
#define ROPE ((float*)(GAS float*)(ws + WS_ROPE))
#define SLABCNT ((int*)(GAS int*)(ws + WS_SLABCNT))
#define PCUM ((int*)(GAS int*)(ws + WS_PCUM))
#define TOKER ((int*)(GAS int*)(ws + WS_TOKER))
#define TOKG ((float*)(GAS float*)(ws + WS_TOKG))
#define TOKPOS ((int*)(GAS int*)(ws + WS_TOKPOS))
#define HCTX ((float*)(GAS float*)(ws + WS_HCTX))
#define RS ((bf16*)(GAS bf16*)(ws + WS_RS))
#define W_IN ((bf16*)(GAS bf16*)(ws + WS_WIN))
#define W_BR ((bf16*)(GAS bf16*)(ws + WS_WBR))
#define W_OUT ((bf16*)(GAS bf16*)(ws + WS_WOUT))
#define W_GUD ((bf16*)(GAS bf16*)(ws + WS_WGUD))
#define W_DND ((bf16*)(GAS bf16*)(ws + WS_WDND))
#define W_GUM8 ((unsigned char*)(GAS unsigned char*)(ws + WS_WGUM))
#define W_DNM8 ((unsigned char*)(GAS unsigned char*)(ws + WS_WDNM))
#define HX ((bf16*)(GAS bf16*)(ws + WS_HX))
#define ZM ((bf16*)(GAS bf16*)(ws + WS_ZM))
#define ZG ((bf16*)(GAS bf16*)(ws + WS_ZG))
#define OA ((bf16*)(GAS bf16*)(ws + WS_O))
#define OB (OA + (size_t)TA * BW)
#define OC (OA + (size_t)2 * TA * BW)
#define SB ((float*)(GAS float*)(ws + WS_ZM))
#define Y16 ((bf16*)(GAS bf16*)(ws + WS_ZG))
#define HD ((bf16*)(GAS bf16*)(ws + WS_ZM))
#define XG ((bf16*)(GAS bf16*)(ws + WS_XG))
#define HM8 ((unsigned char*)(GAS unsigned char*)(ws + WS_HM))
#define XG8 ((unsigned char*)(GAS unsigned char*)(ws + WS_XG8))
#define HX8 ((unsigned char*)(GAS unsigned char*)(ws + WS_HX8))
#define W_ING8 ((unsigned char*)(GAS unsigned char*)(ws + WS_WING8))

    if (IN(0)) {
        PHASE_ENTER();
        {
            LAS float* scv = (LAS float*)(F.lds + RING_OFF);
            LAS float* red = scv + 5 * 1024;
            for (int u = tid_; u < 5 * 1024; u += NWAVES * 64) { const int bb = u >> 10, k = u & 1023; const float cv = bb < 4 ? INP(I_C)[bb * 1024 + k] : INP(I_CCTX)[k]; scv[u] = cv / (1.0f + __expf(-cv)); }
            __syncthreads();
            for (int it = blockIdx.x; it < 2 * 96; it += F.G) {
                const int l = it / 96, n = (it % 96) * 64 + lane;
                const float* wp = INP(I_WADA) + (size_t)l * D * 6144 + n;
                float a0 = 0.f, a1 = 0.f, a2 = 0.f, a3 = 0.f, a4 = 0.f;
                const int kb = wave * 128;
#pragma unroll 16
                for (int k = 0; k < 128; ++k) { const float w = wp[(size_t)(kb + k) * 6144];
                    a0 += scv[kb + k] * w; a1 += scv[1024 + kb + k] * w; a2 += scv[2048 + kb + k] * w; a3 += scv[3072 + kb + k] * w; a4 += scv[4096 + kb + k] * w; }
                red[(wave * 5 + 0) * 64 + lane] = a0; red[(wave * 5 + 1) * 64 + lane] = a1; red[(wave * 5 + 2) * 64 + lane] = a2; red[(wave * 5 + 3) * 64 + lane] = a3; red[(wave * 5 + 4) * 64 + lane] = a4;
                __syncthreads();
                if (tid_ < 320) { const int bb = tid_ >> 6, nn = tid_ & 63; float s = 0.f;
#pragma unroll
                    for (int w = 0; w < 8; ++w) s += red[(w * 5 + bb) * 64 + nn];
                    const int col = (it % 96) * 64 + nn;
                    MOD[((size_t)l * 5 + bb) * 6144 + col] = s + INP(I_BADA)[l * 6144 + col]; }
                __syncthreads();
            }
        }
        if (blockIdx.x == F.G - 1) {
            for (int u = tid_; u < 192 * 16; u += NWAVES * 64) { const int idx = u >> 4, i = u & 15; const float pos = (float)(idx < 128 ? idx : idx - 128);
                const float inv = 1.0f / powf(10000.0f, (float)(2 * i) / 32.0f); const float ang = pos * inv;
                ROPE[2 * u] = cosf(ang); ROPE[2 * u + 1] = sinf(ang); }
        }
        __syncthreads();
        {
            LAS float* scr = (LAS float*)(F.lds + RING_OFF + wave * 16384);
            constexpr int I_IN = (D / 64) * (INC / 32), I_BR = (BW / 64) * (D / 32), I_OUT = (D / 64) * (D / 32), I_GUD = (D / 64) * (2 * FFD / 32), I_DND = (FFD / 64) * (D / 32),
                          I_GUM = (D / 64) * (2 * FFE / 32), I_DNM = (FFE / 64) * (D / 32);
            constexpr int NITEMS = 2 * I_IN + 6 * I_BR + 2 * I_OUT + I_GUD + I_DND + NE * I_GUM + NE * I_DNM;
            for (int it = gw; it < NITEMS; it += NGW) {
                int r = it;
                if (r < 2 * I_IN) { const int l = r / I_IN, it2 = r % I_IN, n0 = 32 * (it2 % (INC / 32));
                    if (MK_GATE_F8 == 2) { tr_item8(INP(I_WIN) + (size_t)l * D * INC, INC, 64 * (it2 / (INC / 32)), n0, (unsigned char*)W_IN + (size_t)l * INC * D, D, n0, SC_WGU, scr, lane); continue; }
                    if (!MK_GATE_F8 || n0 < ZMC) tr_matrix_item(INP(I_WIN) + (size_t)l * D * INC, D, INC, 0, W_IN + (size_t)l * INC * D, it2, scr, lane);
                    if (MK_GATE_F8 && n0 >= ZMC) tr_item8(INP(I_WIN) + (size_t)l * D * INC, INC, 64 * (it2 / (INC / 32)), n0, W_ING8 + (size_t)l * ZGC * D, D, n0 - ZMC, SC_WGU, scr, lane);
                    continue; } r -= 2 * I_IN;
                if (r < 6 * I_BR) { const int q = r / I_BR; tr_matrix_item(INP(I_WBRANCH) + (size_t)q * BW * D, BW, D, 0, W_BR + (size_t)q * D * BW, r % I_BR, scr, lane); continue; } r -= 6 * I_BR;
                if (r < 2 * I_OUT) { const int l = r / I_OUT; tr_matrix_item(INP(I_WOUT) + (size_t)l * D * D, D, D, 0, W_OUT + (size_t)l * D * D, r % I_OUT, scr, lane); continue; } r -= 2 * I_OUT;
                if (r < I_GUD) { if (MK_DENSE_F8 >= 2) tr_matrix_item8(INP(I_WGUD), D, 2 * FFD, FFD, (unsigned char*)W_GUD, SC_WGU, r, scr, lane); else tr_matrix_item(INP(I_WGUD), D, 2 * FFD, FFD, W_GUD, r, scr, lane); continue; } r -= I_GUD;
                if (r < I_DND) { if (MK_DENSE_F8 >= 1) tr_matrix_item8(INP(I_WDND), FFD, D, 0, (unsigned char*)W_DND, SC_WDN, r, scr, lane); else tr_matrix_item(INP(I_WDND), FFD, D, 0, W_DND, r, scr, lane); continue; } r -= I_DND;
                if (r < NE * I_GUM) { const int e = r / I_GUM; tr_matrix_item8(INP(I_WGUM) + (size_t)e * D * 2 * FFE, D, 2 * FFE, FFE, W_GUM8 + (size_t)e * 2 * FFE * D, SC_WGU, r % I_GUM, scr, lane); continue; } r -= NE * I_GUM;
                { const int e = r / I_DNM; tr_matrix_item8(INP(I_WDNM) + (size_t)e * FFE * D, FFE, D, 0, W_DNM8 + (size_t)e * D * FFE, SC_WDN, r % I_DNM, scr, lane); }
            }
        }
        GRID_BAR();
    }

    for (int l = 0; l < DEPTH; ++l) {
        const int pb = 1 + l * PH_PER_LAYER;
        const bool ctx_out = (l < DEPTH - 1);
        const bool moe = (l & 1) != 0;
        const int rows_out = ctx_out ? TA : TL;
#define modl (MOD + (size_t)l * 5 * 6144)
#define xsrc_lat ((l == 0) ? INP(I_X) : (const float*)outp)
#define xsrc_ctx ((l == 0) ? INP(I_CTX) : (const float*)HCTX)

        if (IN(pb + 0) && l == 0) {
            PHASE_ENTER();
            const int chunk = (TL + NGW - 1) / NGW;
#define P1_ROW(t) do { const float* xr = (t) < TL ? xsrc_lat + (size_t)(t) * D : xsrc_ctx + (size_t)((t) - TL) * D; \
                f32x4 x[4], h[4]; row_load(xr, lane, x); const float rr = row_rrms(x); row_normmod(x, rr, gpre, sh, sc, h); if (MK_GATE_F8 < 2) row_store_bf16(HX + (size_t)(t) * D, lane, h); if (MK_GATE_F8) row_store_fp8(HX8 + (size_t)(t) * D, lane, h, SC_XG); } while (0)
            f32x4 gpre[4], sh[4], sc[4]; vec_load(INP(I_GPREMIX) + l * D, lane, gpre);
            for (int t0 = min(gw * chunk, TL), t1 = min(TL, t0 + chunk); t0 < t1; ) { const int bb = t0 >> 13, te = min(t1, (bb + 1) << 13); const float* md = modl + (size_t)bb * 6144;
                vec_load(md, lane, sh); vec_load(md + 1024, lane, sc);
                for (int t = t0; t < te; ++t) P1_ROW(t);
                t0 = te; }
            { const float* md = modl + (size_t)4 * 6144; vec_load(md, lane, sh); vec_load(md + 1024, lane, sc); for (int t = TL + gw; t < TA; t += NGW) P1_ROW(t); }
#undef P1_ROW
            GRID_BAR();
        }
        if (IN(pb + 1)) {
            PHASE_ENTER();
#if MK_GATE_F8 == 2
            {
                pg8::Gemm g{(const bf16*)HX8, (const bf16*)((unsigned char*)W_IN + (size_t)l * INC * D), TA, ZMC, D}; pg8::StaticOrder S; S.init(TA, ZMC, F.G, (int)blockIdx.x, MK_WGM);
                pg8::EpiZT<true> E{ZM, ZG, ROPE, TL / 256, INP(I_BGATE) + (size_t)l * 3 * D, 0, 1.0f / (SC_XG * SC_WGU)};
                pg8::gemm_phase<pg8::EpiZT<true>, pg8::StaticOrder, PG8_ALIGN, PG8_SP2>(F.lds + RING_OFF, g, S, E, F.wv);
            }
            {
                pg8::Gemm g{(const bf16*)HX8, (const bf16*)((unsigned char*)W_IN + (size_t)l * INC * D + (size_t)ZMC * D), rows_out, ZGC, D}; pg8::StaticOrder S; S.init(rows_out, ZGC, F.G, (int)blockIdx.x, MK_WGM);
                pg8::EpiZT<true> E{ZM, ZG, ROPE, TL / 256, INP(I_BGATE) + (size_t)l * 3 * D, ZMC / 256, 1.0f / (SC_XG * SC_WGU)};
                pg8::gemm_phase<pg8::EpiZT<true>, pg8::StaticOrder, PG8_ALIGN, PG8_SP2>(F.lds + RING_OFF, g, S, E, F.wv);
            }
#elif MK_GATE_F8
            {
                pg8::Gemm g{HX, W_IN + (size_t)l * INC * D, TA, ZMC, D}; pg8::StaticOrder S; S.init(TA, ZMC, F.G, (int)blockIdx.x, MK_WGM);
                pg8::EpiZ E{ZM, ZG, ROPE, TL / 256, INP(I_BGATE) + (size_t)l * 3 * D, 0, 1.0f};
                pg8::gemm_phase<pg8::EpiZ, pg8::StaticOrder, PG8_ALIGN, PG8_SP2>(F.lds + RING_OFF, g, S, E, F.wv);
            }
            {
                pg8::Gemm g{(const bf16*)HX8, (const bf16*)(W_ING8 + (size_t)l * ZGC * D), rows_out, ZGC, D}; pg8::StaticOrder S; S.init(rows_out, ZGC, F.G, (int)blockIdx.x, MK_WGM);
                pg8::EpiZT<true> E{ZM, ZG, ROPE, TL / 256, INP(I_BGATE) + (size_t)l * 3 * D, ZMC / 256, 1.0f / (SC_XG * SC_WGU)};
                pg8::gemm_phase<pg8::EpiZT<true>, pg8::StaticOrder, PG8_ALIGN, PG8_SP2>(F.lds + RING_OFF, g, S, E, F.wv);
            }
#else
            pg8::Gemm g{HX, W_IN + (size_t)l * INC * D, TA, INC, D}; pg8::StaticOrder S; S.init(TA, INC, F.G, (int)blockIdx.x, MK_WGM);
            pg8::EpiZ E{ZM, ZG, ROPE, TL / 256, INP(I_BGATE) + (size_t)l * 3 * D, 0, 1.0f};
            pg8::gemm_phase<pg8::EpiZ, pg8::StaticOrder, PG8_ALIGN, PG8_SP2>(F.lds + RING_OFF, g, S, E, F.wv);
#endif
            GRID_BAR();
        }
        if (IN(pb + 3)) {
            PHASE_ENTER();
            const float* sinkp = INP(I_SINK) + l * 8; const float* rpbp = INP(I_RPB) + (size_t)l * 8 * 15 * 31;
            const float* cw = INP(I_CONVW) + (size_t)l * 3 * BW;
            {
                const int ch = 8 * lane;
                float cwr[3][8];
#pragma unroll
                for (int k = 0; k < 3; ++k) { const f32x4 a = *(const f32x4*)(cw + k * BW + ch), b = *(const f32x4*)(cw + k * BW + ch + 4); cwr[k][0] = a.x; cwr[k][1] = a.y; cwr[k][2] = a.z; cwr[k][3] = a.w; cwr[k][4] = b.x; cwr[k][5] = b.y; cwr[k][6] = b.z; cwr[k][7] = b.w; }
#define CONV_U(row, u) do { const bf16* zp_ = ZM + (size_t)(row) * ZMC; const v4u a_ = *(const v4u*)(zp_ + C_UX + ch), g_ = *(const v4u*)(zp_ + C_GC + ch); \
                    u[0] = bflo(a_.x) * bflo(g_.x); u[1] = bfhi(a_.x) * bfhi(g_.x); u[2] = bflo(a_.y) * bflo(g_.y); u[3] = bfhi(a_.y) * bfhi(g_.y); \
                    u[4] = bflo(a_.z) * bflo(g_.z); u[5] = bfhi(a_.z) * bfhi(g_.z); u[6] = bflo(a_.w) * bflo(g_.w); u[7] = bfhi(a_.w) * bfhi(g_.w); } while (0)
#define CONV_Z(u) do { _Pragma("unroll") for (int q_ = 0; q_ < 8; ++q_) u[q_] = 0.f; } while (0)
#define CONV_OUT(t) do { const v4u gbv = *(const v4u*)(ZM + (size_t)(t) * ZMC + C_GB + ch); \
                    const float gb[8] = {bflo(gbv.x), bfhi(gbv.x), bflo(gbv.y), bfhi(gbv.y), bflo(gbv.z), bfhi(gbv.z), bflo(gbv.w), bfhi(gbv.w)}; float o[8]; \
                    _Pragma("unroll") for (int q = 0; q < 8; ++q) o[q] = gb[q] * (cwr[0][q] * um[q] + cwr[1][q] * uc[q] + cwr[2][q] * up[q]); \
                    v4u w; w.x = pk2(o[0], o[1]); w.y = pk2(o[2], o[3]); w.z = pk2(o[4], o[5]); w.w = pk2(o[6], o[7]); \
                    *(v4u*)(OB + (size_t)(t) * BW + ch) = w; } while (0)
                const int cchunk = (TL + NGW - 1) / NGW;
                const int t0 = min(gw * cchunk, TL), t1 = min(TL, t0 + cchunk);
                if (t0 < t1) {
                    float um[8], uc[8], up[8];
                    if ((t0 & (SEQ - 1)) > 0) CONV_U(t0 - 1, um); else CONV_Z(um);
                    CONV_U(t0, uc);
                    for (int t = t0; t < t1; ++t) {
                        const int s = t & (SEQ - 1);
                        if (s == 0) CONV_Z(um);
                        if (s + 1 < SEQ) CONV_U(t + 1, up); else CONV_Z(up);
                        CONV_OUT(t);
#pragma unroll
                        for (int q = 0; q < 8; ++q) { um[q] = uc[q]; uc[q] = up[q]; }
                    }
                }
                for (int t = TL + gw; t < rows_out; t += NGW) {
                    const int s = (t - TL) & (CTXL - 1);
                    float um[8], uc[8], up[8];
                    if (s > 0) CONV_U(t - 1, um); else CONV_Z(um);
                    CONV_U(t, uc);
                    if (s + 1 < CTXL) CONV_U(t + 1, up); else CONV_Z(up);
                    CONV_OUT(t);
                }
#undef CONV_U
#undef CONV_Z
#undef CONV_OUT
            }
            at::attn_phase(F.lds + RING_OFF, ZM, OA, OC, sinkp, rpbp, F.vcu, F.G, ctx_out, tid_, wave, lane);
#ifdef MK_ATTN_PROBE
            at::attn_phase<MK_ATTN_PROBE>(F.lds + RING_OFF, ZM, (bf16*)(GAS bf16*)(ws + WS_HX), (bf16*)(GAS bf16*)(ws + WS_HX) + (size_t)TA * BW, sinkp, rpbp, F.vcu, F.G, ctx_out, tid_, wave, lane);
#endif
            GRID_BAR();
        }
        if (IN(pb + 4)) {
            PHASE_ENTER();
            pg8::Gemm g{OA, W_BR + (size_t)l * 3 * D * BW, rows_out, D, BW};
            pg8::BranchOrder3 S; S.so.init(rows_out, D, F.G, (int)blockIdx.x, MK_WGM);
            pg8::EpiBranchAcc E{HX, ZG};
            pg8::gemm_phase<pg8::EpiBranchAcc, pg8::BranchOrder3, PG8_ALIGN, PG8_SP2>(F.lds + RING_OFF, g, S, E, F.wv);
            GRID_BAR();
        }
        if (IN(pb + 5)) {
            PHASE_ENTER();
            pg8::Gemm g{HX, W_OUT + (size_t)l * D * D, rows_out, D, D}; pg8::StaticOrder S; S.init(rows_out, D, F.G, (int)blockIdx.x, MK_WGM);
            pg8::EpiBf16P E{Y16, D};
            pg8::gemm_phase<pg8::EpiBf16P, pg8::StaticOrder, PG8_ALIGN, PG8_SP2>(F.lds + RING_OFF, g, S, E, F.wv);
            GRID_BAR();
        }
        if (IN(pb + 6)) {
            PHASE_ENTER();
            if (!moe) {
                const int chunk = (TL + NGW - 1) / NGW;
#define P6_ROW(t) do { f32x4 x[4], y[4], h[4]; \
                    if (l == 0) row_load((t) < TL ? INP(I_X) + (size_t)(t) * D : INP(I_CTX) + (size_t)((t) - TL) * D, lane, x); else row_load_bf16(RS + (size_t)(t) * D, lane, x); \
                    row_load_bf16(Y16 + (size_t)(t) * D, lane, y); const float ry = row_rrms(y); \
                    _Pragma("unroll") for (int j = 0; j < 4; ++j) x[j] = x[j] + gt[j] * (y[j] * ry * gpo[j]); \
                    row_store_bf16(RS + (size_t)(t) * D, lane, x); const float rx = row_rrms(x); row_normmod(x, rx, gpre, sh, sc, h); \
                    if (MK_DENSE_F8 >= 2) row_store_fp8((unsigned char*)HX + (size_t)(t) * D, lane, h, SC_XG); else row_store_bf16(HX + (size_t)(t) * D, lane, h); } while (0)
                f32x4 gpo[4], gt[4], gpre[4], sh[4], sc[4]; vec_load(INP(I_GPOSTMIX) + l * D, lane, gpo); vec_load(INP(I_GPREFFN) + l * D, lane, gpre);
                for (int t0 = min(gw * chunk, TL), t1 = min(TL, t0 + chunk); t0 < t1; ) { const int bb = t0 >> 13, te = min(t1, (bb + 1) << 13); const float* md = modl + (size_t)bb * 6144;
                    vec_load(md + 2048, lane, gt); vec_load(md + 3072, lane, sh); vec_load(md + 4096, lane, sc);
                    for (int t = t0; t < te; ++t) P6_ROW(t);
                    t0 = te; }
                if (rows_out > TL) { const float* md = modl + (size_t)4 * 6144; vec_load(md + 2048, lane, gt); vec_load(md + 3072, lane, sh); vec_load(md + 4096, lane, sc); for (int t = TL + gw; t < rows_out; t += NGW) P6_ROW(t); }
#undef P6_ROW
            } else {
                LAS int* sel = (LAS int*)(F.lds + RING_OFF);
                LAS int* rnk = sel + 256;
                LAS f32x4* wrT = (LAS f32x4*)(F.lds + RING_OFF + 4096);
                const float* wr = INP(I_WROUTER) + (size_t)(l >> 1) * D * NE; const float* br = INP(I_BROUTER) + (l >> 1) * NE;
                for (int u = tid_; u < D * NE; u += NWAVES * 64) ((LAS float*)wrT)[(u & 7) * D + (u >> 3)] = wr[u];
                LDS_WAIT(); __syncthreads();
                f32x4 gpo[4], gt[4], gpre[4], sh[4], sc[4]; vec_load(INP(I_GPOSTMIX) + l * D, lane, gpo); vec_load(INP(I_GPREFFN) + l * D, lane, gpre);
                for (int slab = F.vcu; slab < TL / 128; slab += F.G) {
                    { const float* md = modl + (size_t)((slab * 128) >> 13) * 6144; vec_load(md + 2048, lane, gt); vec_load(md + 3072, lane, sh); vec_load(md + 4096, lane, sc); }
                    for (int i = 0; i < 16; ++i) {
                        const int tl_ = wave * 16 + i, t = slab * 128 + tl_;
                        f32x4 x[4], y[4], h[4]; if (l == 0) row_load(INP(I_X) + (size_t)t * D, lane, x); else row_load_bf16(RS + (size_t)t * D, lane, x);
                        row_load_bf16(Y16 + (size_t)t * D, lane, y);
                        const float ry = row_rrms(y);
#pragma unroll
                        for (int j = 0; j < 4; ++j) x[j] = x[j] + gt[j] * (y[j] * ry * gpo[j]);
                        row_store_bf16(RS + (size_t)t * D, lane, x);
                        const float rx = row_rrms(x);
                        row_normmod(x, rx, gpre, sh, sc, h);
                        row_store_fp8((unsigned char*)HX + (size_t)t * D, lane, h, SC_XG);
                        float lg[8];
#pragma unroll
                        for (int e = 0; e < 8; ++e) lg[e] = 0.f;
#pragma unroll
                        for (int e = 0; e < 8; ++e)
#pragma unroll
                            for (int j = 0; j < 4; ++j) { const f32x4 w4 = wrT[e * (D / 4) + 2 * (64 * (j >> 1) + lane) + (j & 1)]; lg[e] += (h[j].x * w4.x + h[j].y * w4.y) + (h[j].z * w4.z + h[j].w * w4.w); }
#pragma unroll
                        for (int e = 0; e < 8; ++e) lg[e] = wave_sum(lg[e]) + br[e];
                        int e1 = 0; float v1 = lg[0];
#pragma unroll
                        for (int e = 1; e < 8; ++e) if (lg[e] > v1) { v1 = lg[e]; e1 = e; }
                        int e2 = -1; float v2 = -INFINITY;
#pragma unroll
                        for (int e = 0; e < 8; ++e) if (e != e1 && lg[e] > v2) { v2 = lg[e]; e2 = e; }
                        const float ex = __expf(v2 - v1), g1 = 1.0f / (1.0f + ex), g2 = ex / (1.0f + ex);
                        if (lane == 0) { sel[2 * tl_] = e1; sel[2 * tl_ + 1] = e2; TOKG[2 * (size_t)t] = g1; TOKG[2 * (size_t)t + 1] = g2; }
                    }
                    LDS_WAIT(); __syncthreads();
                    if (tid_ < 8) { int cnt = 0; for (int q = 0; q < 256; ++q) if (sel[q] == tid_) { rnk[q] = cnt; ++cnt; } SLABCNT[slab * 8 + tid_] = cnt; }
                    LDS_WAIT(); __syncthreads();
                    if (tid_ < 256) TOKER[(size_t)slab * 256 + tid_] = sel[tid_] | (rnk[tid_] << 8);
                    LDS_WAIT(); __syncthreads();
                }
            }
            GRID_BAR();
        }
        if (IN(pb + 7) && moe) {
            PHASE_ENTER();
            LAS int* scn = (LAS int*)(F.lds + RING_OFF);
            LAS int* pst = scn + 2048;
            for (int u = tid_; u < 2048; u += NWAVES * 64) scn[u] = SLABCNT[u];
            LDS_WAIT(); __syncthreads();
            if (tid_ < 8) { int run = 0; for (int q = 0; q < 256; ++q) { const int c = scn[q * 8 + tid_]; scn[q * 8 + tid_] = run; run += c; } pst[8 + tid_] = run; }
            LDS_WAIT(); __syncthreads();
            if (tid_ == 0) { int pan = 0; for (int e = 0; e < 8; ++e) { pst[e] = pan * 256; if (blockIdx.x == 0) PCUM[e] = pan; pan += (pst[8 + e] + 255) >> 8; } if (blockIdx.x == 0) PCUM[8] = pan; }
            LDS_WAIT(); __syncthreads();
            LAS int* posl = pst + 16;
            for (int slab = F.vcu; slab < TL / 128; slab += F.G) {
                if (tid_ < 256) { const int er = TOKER[(size_t)slab * 256 + tid_]; const int e = er & 255, rk = er >> 8; const int pos = pst[e] + scn[slab * 8 + e] + rk;
                    posl[tid_] = pos; TOKPOS[(size_t)slab * 256 + tid_] = pos; }
                LDS_WAIT(); __syncthreads();
                const v4u* srcb = (const v4u*)((const unsigned char*)HX + (size_t)slab * 128 * D);
#pragma unroll 4
                for (int i = 0; i < 16; ++i) { const int id = i * 512 + tid_, tk = id >> 6, chk = id & 63;
                    const v4u o = srcb[(size_t)tk * 64 + chk];
                    ((v4u*)(XG8 + (size_t)posl[2 * tk] * D))[chk] = o; ((v4u*)(XG8 + (size_t)posl[2 * tk + 1] * D))[chk] = o; }
                LDS_WAIT(); __syncthreads();
            }
            GRID_BAR();
        }
        if (IN(pb + 8) && !moe) {
            PHASE_ENTER();
            pg8::Gemm g{HX, W_GUD, rows_out, 2 * FFD, D}; pg8::StaticOrder S; S.init(rows_out, 2 * FFD, F.G, (int)blockIdx.x, MK_WGM);
#if MK_DENSE_F8 >= 2
            pg8::EpiSwiglu8T<true> E{(unsigned char*)HD, FFD, 1.0f / (SC_XG * SC_WGU), SC_H};
            pg8::gemm_phase<pg8::EpiSwiglu8T<true>, pg8::StaticOrder, PG8_ALIGN, PG8_SP2>(F.lds + RING_OFF, g, S, E, F.wv);
#elif MK_DENSE_F8 == 1
            pg8::EpiSwiglu8T<false> E{(unsigned char*)HD, FFD, 1.0f, SC_H};
            pg8::gemm_phase<pg8::EpiSwiglu8T<false>, pg8::StaticOrder, PG8_ALIGN, PG8_SP2>(F.lds + RING_OFF, g, S, E, F.wv);
#else
            pg8::EpiSwiglu E{HD, FFD};
            pg8::gemm_phase<pg8::EpiSwiglu, pg8::StaticOrder, PG8_ALIGN, PG8_SP2>(F.lds + RING_OFF, g, S, E, F.wv);
#endif
            GRID_BAR();
        }
        if (IN(pb + 9) && !moe) {
            PHASE_ENTER();
            pg8::Gemm g{HD, W_DND, rows_out, D, FFD}; pg8::StaticOrder S; S.init(rows_out, D, F.G, (int)blockIdx.x, MK_WGM);
#if MK_DENSE_F8 >= 1
            pg8::EpiBf16PS8 E{Y16, D, 1.0f / (SC_H * SC_WDN)};
            pg8::gemm_phase<pg8::EpiBf16PS8, pg8::StaticOrder, PG8_ALIGN, PG8_SP2>(F.lds + RING_OFF, g, S, E, F.wv);
#else
            pg8::EpiBf16P E{Y16, D};
            pg8::gemm_phase<pg8::EpiBf16P, pg8::StaticOrder, PG8_ALIGN, PG8_SP2>(F.lds + RING_OFF, g, S, E, F.wv);
#endif
            GRID_BAR();
        }
        if (moe) {
            for (int ck = 0; ck < NCHUNK; ++ck) {
                if (IN(pb + 10 + 2 * ck)) {
                    PHASE_ENTER();
                    pg8::MoeOrder S; S.nN = 2 * FFE / 256; S.G = F.G; S.c = F.vcu; S.p_lo = ck * PCH;
#pragma unroll
                    for (int k = 0; k < 8; ++k) S.pc[k] = __builtin_amdgcn_readfirstlane(PCUM[k]);
                    const int ptot = __builtin_amdgcn_readfirstlane(PCUM[8]); S.np = min(max(ptot - ck * PCH, 0), PCH);
                    pg8::Gemm g{(const bf16*)XG8, (const bf16*)W_GUM8, 0, 2 * FFE, D};
                    pg8::EpiSwiglu8 E{HM8, FFE, 1.0f / (SC_XG * SC_WGU), SC_H};
                    pg8::gemm_phase<pg8::EpiSwiglu8, pg8::MoeOrder, PG8_ALIGN, PG8_SP2>(F.lds + RING_OFF, g, S, E, F.wv);
                    GRID_BAR();
                }
                if (IN(pb + 11 + 2 * ck)) {
                    PHASE_ENTER();
                    pg8::MoeOrder S; S.nN = D / 256; S.G = F.G; S.c = F.vcu; S.p_lo = ck * PCH;
#pragma unroll
                    for (int k = 0; k < 8; ++k) S.pc[k] = __builtin_amdgcn_readfirstlane(PCUM[k]);
                    const int ptot = __builtin_amdgcn_readfirstlane(PCUM[8]); S.np = min(max(ptot - ck * PCH, 0), PCH);
                    pg8::Gemm g{(const bf16*)HM8, (const bf16*)W_DNM8, 0, D, FFE};
                    pg8::EpiBf16PS8 E{XG, D, 1.0f / (SC_H * SC_WDN)};
                    pg8::gemm_phase<pg8::EpiBf16PS8, pg8::MoeOrder, PG8_ALIGN, PG8_SP2>(F.lds + RING_OFF, g, S, E, F.wv);
                    GRID_BAR();
                }
            }
        }
        if (IN(pb + 16)) {
            PHASE_ENTER();
            const int chunk = (TL + NGW - 1) / NGW; const bool nextl = (l + 1 < DEPTH);
#define P9_ROW(t) do { f32x4 x[4], y[4]; row_load_bf16(RS + (size_t)(t) * D, lane, x); \
                if (!moe) row_load_bf16(Y16 + (size_t)(t) * D, lane, y); \
                else { const int p0 = TOKPOS[2 * (size_t)(t)], p1 = TOKPOS[2 * (size_t)(t) + 1]; const float g0 = TOKG[2 * (size_t)(t)], g1 = TOKG[2 * (size_t)(t) + 1]; \
                    f32x4 ya[4], yb[4]; row_load_bf16(XG + (size_t)p0 * D, lane, ya); row_load_bf16(XG + (size_t)p1 * D, lane, yb); \
                    _Pragma("unroll") for (int j = 0; j < 4; ++j) y[j] = ya[j] * g0 + yb[j] * g1; } \
                const float ry = row_rrms(y); \
                _Pragma("unroll") for (int j = 0; j < 4; ++j) x[j] = x[j] + gt[j] * (y[j] * ry * gpo[j]); \
                if (nextl) row_store_bf16(RS + (size_t)(t) * D, lane, x); else if ((t) < TL) row_store(outp + (size_t)(t) * D, lane, x); \
                if (nextl) { f32x4 h[4]; const float rx = row_rrms(x); row_normmod(x, rx, gpre, sh, sc, h); if (MK_GATE_F8 < 2) row_store_bf16(HX + (size_t)(t) * D, lane, h); if (MK_GATE_F8) row_store_fp8(HX8 + (size_t)(t) * D, lane, h, SC_XG); } } while (0)
            f32x4 gpo[4], gt[4], gpre[4], sh[4], sc[4]; vec_load(INP(I_GPOSTFFN) + l * D, lane, gpo); vec_load(INP(I_GPREMIX) + (nextl ? l + 1 : l) * D, lane, gpre);
            for (int t0 = min(gw * chunk, TL), t1 = min(TL, t0 + chunk); t0 < t1; ) { const int bb = t0 >> 13, te = min(t1, (bb + 1) << 13); const float* md = modl + (size_t)bb * 6144;
                vec_load(md + 5120, lane, gt); vec_load(md + (nextl ? 5 * 6144 : 0), lane, sh); vec_load(md + (nextl ? 5 * 6144 : 0) + 1024, lane, sc);
                for (int t = t0; t < te; ++t) P9_ROW(t);
                t0 = te; }
            if (rows_out > TL) { const float* md = modl + (size_t)4 * 6144; vec_load(md + 5120, lane, gt); vec_load(md + (nextl ? 5 * 6144 : 0), lane, sh); vec_load(md + (nextl ? 5 * 6144 : 0) + 1024, lane, sc);
                for (int t = TL + gw; t < rows_out; t += NGW) P9_ROW(t); }
#undef P9_ROW
            if (l + 1 < DEPTH) GRID_BAR();
        }
    }
#undef IN
#undef GRID_BAR
}

extern "C" void kernel_launch(void* const* d_in, const int* in_sizes, int n_in, void* d_out, int out_size, void* d_ws, size_t ws_size, hipStream_t stream) {
    static int grid = 0;
    if (grid == 0) {
        if (n_in != 23 || in_sizes[0] != TL * D || out_size != TL * D || ws_size < WS_END) { fprintf(stderr, "kernel_launch: unexpected shapes: n_in %d in0 %d out %d ws %zu (need %zu); nothing launched\n", n_in, n_in > 0 ? in_sizes[0] : -1, out_size, ws_size, (size_t)WS_END); grid = -1; return; }
        int dev = 0, cus = 0, per_cu = 0;
        if (hipGetDevice(&dev) != hipSuccess || hipDeviceGetAttribute(&cus, hipDeviceAttributeMultiprocessorCount, dev) != hipSuccess) { fprintf(stderr, "kernel_launch: device query failed\n"); grid = -1; return; }
        if (hipFuncSetAttribute((const void*)mk_fwd, hipFuncAttributeMaxDynamicSharedMemorySize, LDS_BYTES) != hipSuccess) { fprintf(stderr, "kernel_launch: hipFuncSetAttribute failed\n"); grid = -1; return; }
        if (hipOccupancyMaxActiveBlocksPerMultiprocessor(&per_cu, (const void*)mk_fwd, NWAVES * 64, LDS_BYTES) != hipSuccess || per_cu < 1) fprintf(stderr, "kernel_launch: note: occupancy query reports %d\n", per_cu);
        (void)hipGetLastError();
        grid = cus;
    }
    if (grid < 0) return;
    if (hipMemsetAsync((char*)d_ws + WS_CTL, 0, CTL_ZERO_BYTES, stream) != hipSuccess) { fprintf(stderr, "kernel_launch: memset failed\n"); return; }
    Args a{};
    for (int i = 0; i < 23; ++i) a.in[i] = (const float*)d_in[i];
    a.out = (float*)d_out; a.ws = (unsigned char*)d_ws;
#if MK_PER_PHASE
    for (int ph = 0; ph < NPHASES; ++ph) { a.ph_lo = ph; a.ph_hi = ph + 1; hipLaunchKernelGGL(mk_fwd, dim3(grid), dim3(NWAVES * 64), LDS_BYTES, stream, a); }
#else
    a.ph_lo = 0; a.ph_hi = NPHASES;
    hipLaunchKernelGGL(mk_fwd, dim3(grid), dim3(NWAVES * 64), LDS_BYTES, stream, a);
#endif
    const hipError_t le = hipPeekAtLastError();
    if (le != hipSuccess) fprintf(stderr, "kernel_launch: launch failed: %s\n", hipGetErrorName(le));
}
```

```cpp
#include <hip/hip_runtime.h>
#include <cstdio>
#include <cstdint>
#ifndef MK_GATE_U8
#define MK_GATE_U8 1
#endif
#ifndef MK_GATE_F8
#define MK_GATE_F8 1
#endif

__device__ __forceinline__ int mk_lane() { unsigned z; asm volatile("s_mov_b32 %0, 0" : "=s"(z)); return (int)__builtin_amdgcn_mbcnt_hi(~0u, __builtin_amdgcn_mbcnt_lo(~0u, z)); }
template <int CTRL, int ROWMASK = 0xf> __device__ __forceinline__ float mk_dpp(float v) { return __builtin_bit_cast(float, __builtin_amdgcn_update_dpp(0, __builtin_bit_cast(int, v), CTRL, ROWMASK, 0xf, false)); }
__device__ __forceinline__ float mk_xor32(float v, bool upper) { const auto rr = __builtin_amdgcn_permlane32_swap(__builtin_bit_cast(unsigned, v), __builtin_bit_cast(unsigned, v), false, false); return __builtin_bit_cast(float, upper ? rr[0] : rr[1]); }
__device__ __forceinline__ int mk_xor16(int v) { return __builtin_amdgcn_ds_swizzle(v, 0x401F); }

namespace pg8 {
#define PG8_LAS __attribute__((address_space(3)))
typedef unsigned short bf16_t;
typedef short bf16x8 __attribute__((ext_vector_type(8)));
typedef float f32x4 __attribute__((ext_vector_type(4)));
typedef unsigned u32x4 __attribute__((ext_vector_type(4)));
typedef unsigned u32x2 __attribute__((ext_vector_type(2)));
typedef int v8i32 __attribute__((ext_vector_type(8)));
constexpr int BM = 256, BK = 64, HALF = 128, HTB = HALF * BK * 2  , STAGE_BYTES = 8 * HTB, NXCD = 8, WGM = 8;

__host__ __device__ __forceinline__ int lds_byte(int r, int c) { const int st = (r >> 4) * 2 + (c >> 5), rr = r & 15, cc = c & 31, ob = rr * 64 + cc * 2; return st * 1024 + (ob ^ (((ob >> 9) & 1) << 5)); }
__host__ __device__ __forceinline__ void stage_rc(int b, int& R, int& C) { const int st = b / 1024, sb = b % 1024, swz = sb ^ (((sb >> 9) & 1) << 5); R = (st >> 1) * 16 + swz / 64; C = (st & 1) * 32 + (swz % 64) / 2; }
__host__ __device__ __forceinline__ int perm32(int rho) { const int n = rho >> 4, i = rho & 15; return 8 * (i >> 2) + 4 * n + (i & 3); }

struct Unit { int pm, pn, pb; };
struct Gemm { const bf16_t* A; const bf16_t* Bt; int M, N, K; };

struct StaticOrder {
    int nM, nN, nwg, G, c, wgm;
    __host__ __device__ void init(int M, int N, int G_, int c_, int wgm_ = WGM) { nM = M / BM; nN = N / BM; nwg = nM * nN; G = G_; c = c_; wgm = wgm_; }
    __host__ __device__ bool next(int i, Unit& u) const {
        const long L = (long)i * G + c; if (L >= nwg) return false;
        int wgid = (int)L; { const int q = nwg / NXCD, r = nwg % NXCD, xcd = wgid % NXCD, off = wgid / NXCD; wgid = (xcd < r ? xcd * (q + 1) : r * (q + 1) + (xcd - r) * q) + off; }
        const int nig = wgm * nN, gid = wgid / nig, fm = gid * wgm, gsz = (nM - fm) < wgm ? (nM - fm) : wgm;
        u.pm = fm + ((wgid % nig) % gsz); u.pn = (wgid % nig) / gsz; u.pb = u.pn; return true;
    }
    __device__ __forceinline__ void a_ready(const Unit&) const {}
    __device__ __forceinline__ void done(const Unit&) const {}
};

__device__ __forceinline__ unsigned cvt_pk_bf16(float lo, float hi) { unsigned r; asm volatile("v_cvt_pk_bf16_f32 %0, %1, %2" : "=v"(r) : "v"(lo), "v"(hi)); return r; }
__device__ __forceinline__ float bf_lo(unsigned w) { return __uint_as_float(w << 16); }
__device__ __forceinline__ float bf_hi(unsigned w) { return __uint_as_float(w & 0xffff0000u); }
__device__ __forceinline__ float sigmoidf_(float x) { return __builtin_amdgcn_rcpf(1.0f + __builtin_amdgcn_exp2f(x * -1.4426950408889634f)); }

template <bool OPF8> struct EpiZT {
    static constexpr bool PERM = true, AFTER_DRAIN = false, HALFN = false, F8 = OPF8, RWACC = false;
    bf16_t* ZM; bf16_t* ZG; const float* rope; int n_lat_panels; const float* bgate; int pn_off; float gs;
    __device__ __forceinline__ void operator()(const f32x4 (&acc)[2][2][4][2], const Unit& u, int wr, int wc, int fr, int fq) const {
        const int row0 = u.pm * BM + wr * 64 + fr; int colt = (u.pn + pn_off) * BM; bf16_t* base = ZM; int ldc = 3840; bool isg = false;
        if (colt >= 3840) { base = ZG; colt -= 3840; ldc = 3072; isg = true; }
        const int col0 = colt + wc * 32 + 8 * fq;
        f32x4 gb[2][2];
        if (isg) {
#pragma unroll
            for (int bj = 0; bj < 2; ++bj) { gb[bj][0] = *(const f32x4*)(bgate + col0 + bj * HALF); gb[bj][1] = *(const f32x4*)(bgate + col0 + bj * HALF + 4); } }
        const int nrope = (u.pm < n_lat_panels) ? (u.pn + pn_off < 2 ? 2 : (u.pn + pn_off == 2 ? 1 : 0)) : 0;
#pragma unroll
        for (int ai = 0; ai < 2; ++ai)
#pragma unroll
            for (int m = 0; m < 4; ++m) { const int row = row0 + ai * HALF + m * 16; bf16_t* rowp = base + (size_t)row * ldc + col0;
                f32x4 cs[4];
                if (nrope) { const int s = row & 8191, pidx = (wc & 1) ? 128 + (s & 63) : (s >> 6); const f32x4* cp = (const f32x4*)(rope + (size_t)(pidx * 16 + 8 * (fq & 1)) * 2);
                    cs[0] = cp[0]; cs[1] = cp[1]; cs[2] = cp[2]; cs[3] = cp[3]; }
#pragma unroll
                for (int bj = 0; bj < 2; ++bj) { f32x4 v0 = acc[ai][bj][m][0], v1 = acc[ai][bj][m][1];
                    if (OPF8 && !isg) { v0 *= gs; v1 *= gs; }
                    if (isg) {
#pragma unroll
                        for (int j = 0; j < 4; ++j) { v0[j] = sigmoidf_(fminf(fmaxf(v0[j] * gs + gb[bj][0][j], -30.f), 30.f)); v1[j] = sigmoidf_(fminf(fmaxf(v1[j] * gs + gb[bj][1][j], -30.f), 30.f)); } }
                    if (bj < nrope) { const float sg = (fq >> 1) ? 1.f : -1.f;
                        float v[8] = {v0[0], v0[1], v0[2], v0[3], v1[0], v1[1], v1[2], v1[3]}, o[8];
#pragma unroll
                        for (int j = 0; j < 8; ++j) { const float pv = mk_xor32(v[j], (fq >> 1) != 0); const float c_ = cs[j >> 1][(j & 1) * 2], s_ = cs[j >> 1][(j & 1) * 2 + 1]; o[j] = v[j] * c_ + sg * pv * s_; }
                        v0 = (f32x4){o[0], o[1], o[2], o[3]}; v1 = (f32x4){o[4], o[5], o[6], o[7]}; }
                    if (MK_GATE_U8 && isg) {
                        unsigned b0 = 0u, b1 = 0u;
#pragma unroll
                        for (int j = 0; j < 4; ++j) { b0 = __builtin_amdgcn_cvt_pk_u8_f32(fmaxf(v0[j] * 255.f, 1.f), j, b0); b1 = __builtin_amdgcn_cvt_pk_u8_f32(fmaxf(v1[j] * 255.f, 1.f), j, b1); }
                        u32x2 w8; w8.x = b0; w8.y = b1;
                        *(u32x2*)((unsigned char*)ZG + (size_t)row * 3072 + col0 + bj * HALF) = w8;
                        continue; }
                    u32x4 w; w.x = cvt_pk_bf16(v0[0], v0[1]); w.y = cvt_pk_bf16(v0[2], v0[3]); w.z = cvt_pk_bf16(v1[0], v1[1]); w.w = cvt_pk_bf16(v1[2], v1[3]);
                    *(u32x4*)(rowp + bj * HALF) = w; } }
    }
};
typedef EpiZT<false> EpiZ;

struct EpiZM {
    static constexpr bool PERM = true, AFTER_DRAIN = false, HALFN = false, F8 = false, RWACC = false;
    bf16_t* ZM; const PG8_LAS float* rope; int n_lat_panels;
    __device__ __forceinline__ void operator()(const f32x4 (&acc)[2][2][4][2], const Unit& u, int wr, int wc, int fr, int fq) const {
        const int row0 = u.pm * BM + wr * 64 + fr; const int col0 = u.pn * BM + wc * 32 + 8 * fq;
        const int nrope = (u.pm < n_lat_panels) ? (u.pn < 2 ? 2 : (u.pn == 2 ? 1 : 0)) : 0;
#pragma unroll
        for (int ai = 0; ai < 2; ++ai)
#pragma unroll
            for (int m = 0; m < 4; ++m) { const int row = row0 + ai * HALF + m * 16; bf16_t* rowp = ZM + (size_t)row * 3840 + col0;
                f32x4 cs[4];
                if (nrope) { const int s = row & 8191, pidx = (wc & 1) ? 128 + (s & 63) : (s >> 6); const PG8_LAS f32x4* cp = (const PG8_LAS f32x4*)(rope + (pidx * 16 + 8 * (fq & 1)) * 2);
                    cs[0] = cp[0]; cs[1] = cp[1]; cs[2] = cp[2]; cs[3] = cp[3]; }
#pragma unroll
                for (int bj = 0; bj < 2; ++bj) { f32x4 v0 = acc[ai][bj][m][0], v1 = acc[ai][bj][m][1];
                    if (bj < nrope) { const float sg = (fq >> 1) ? 1.f : -1.f;
                        float v[8] = {v0[0], v0[1], v0[2], v0[3], v1[0], v1[1], v1[2], v1[3]}, o[8];
#pragma unroll
                        for (int j = 0; j < 8; ++j) { const float pv = mk_xor32(v[j], (fq >> 1) != 0); const float c_ = cs[j >> 1][(j & 1) * 2], s_ = cs[j >> 1][(j & 1) * 2 + 1]; o[j] = v[j] * c_ + sg * pv * s_; }
                        v0 = (f32x4){o[0], o[1], o[2], o[3]}; v1 = (f32x4){o[4], o[5], o[6], o[7]}; }
                    u32x4 w; w.x = cvt_pk_bf16(v0[0], v0[1]); w.y = cvt_pk_bf16(v0[2], v0[3]); w.z = cvt_pk_bf16(v1[0], v1[1]); w.w = cvt_pk_bf16(v1[2], v1[3]);
                    *(u32x4*)(rowp + bj * HALF) = w; } }
    }
};
struct EpiZGate {
    static constexpr bool PERM = true, AFTER_DRAIN = false, HALFN = false, F8 = true, RWACC = false;
    unsigned char* ZG; const float* bgate; float gs;
    __device__ __forceinline__ void operator()(const f32x4 (&acc)[2][2][4][2], const Unit& u, int wr, int wc, int fr, int fq) const {
        const int row0 = u.pm * BM + wr * 64 + fr; const int colb = u.pn * BM + wc * 32; const int odd = fq & 1;
        f32x4 gb[2][2];
#pragma unroll
        for (int bj = 0; bj < 2; ++bj) { gb[bj][0] = *(const f32x4*)(bgate + colb + 8 * fq + bj * HALF); gb[bj][1] = *(const f32x4*)(bgate + colb + 8 * fq + bj * HALF + 4); }
#pragma unroll
        for (int ai = 0; ai < 2; ++ai)
#pragma unroll
            for (int mp = 0; mp < 2; ++mp)
#pragma unroll
                for (int bj = 0; bj < 2; ++bj) {
                    unsigned w[2][2];
#pragma unroll
                    for (int k = 0; k < 2; ++k) { const int m = 2 * mp + k; const f32x4 v0 = acc[ai][bj][m][0], v1 = acc[ai][bj][m][1]; unsigned b0 = 0u, b1 = 0u;
#pragma unroll
                        for (int j = 0; j < 4; ++j) { const float g0 = sigmoidf_(fminf(fmaxf(v0[j] * gs + gb[bj][0][j], -30.f), 30.f)), g1 = sigmoidf_(fminf(fmaxf(v1[j] * gs + gb[bj][1][j], -30.f), 30.f));
                            b0 = __builtin_amdgcn_cvt_pk_u8_f32(fmaxf(g0 * 255.f, 1.f), j, b0); b1 = __builtin_amdgcn_cvt_pk_u8_f32(fmaxf(g1 * 255.f, 1.f), j, b1); }
                        w[k][0] = b0; w[k][1] = b1; }
                    const unsigned s0 = odd ? w[0][0] : w[1][0], s1 = odd ? w[0][1] : w[1][1];
                    const unsigned r0 = (unsigned)mk_xor16((int)s0), r1 = (unsigned)mk_xor16((int)s1);
                    u32x4 st; if (odd) { st.x = r0; st.y = r1; st.z = w[1][0]; st.w = w[1][1]; } else { st.x = w[0][0]; st.y = w[0][1]; st.z = r0; st.w = r1; }
                    *(u32x4*)(ZG + (size_t)(row0 + ai * HALF + (2 * mp + odd) * 16) * 3072 + colb + 8 * (fq & 2) + bj * HALF) = st; }
    }
};
struct EpiBf16P {
    static constexpr bool PERM = true, AFTER_DRAIN = false, HALFN = false, F8 = false, RWACC = false;
    bf16_t* O; int ldc;
    __device__ __forceinline__ void operator()(const f32x4 (&acc)[2][2][4][2], const Unit& u, int wr, int wc, int fr, int fq) const {
        const int row0 = u.pm * BM + wr * 64 + fr; const int col0 = u.pn * BM + wc * 32 + 8 * fq;
#pragma unroll
        for (int ai = 0; ai < 2; ++ai)
#pragma unroll
            for (int m = 0; m < 4; ++m) { bf16_t* rowp = O + (size_t)(row0 + ai * HALF + m * 16) * ldc + col0;
#pragma unroll
                for (int bj = 0; bj < 2; ++bj) { const f32x4 v0 = acc[ai][bj][m][0], v1 = acc[ai][bj][m][1];
                    u32x4 w; w.x = cvt_pk_bf16(v0[0], v0[1]); w.y = cvt_pk_bf16(v0[2], v0[3]); w.z = cvt_pk_bf16(v1[0], v1[1]); w.w = cvt_pk_bf16(v1[2], v1[3]);
                    *(u32x4*)(rowp + bj * HALF) = w; } }
    }
};
struct EpiBranchAcc {
    static constexpr bool PERM = true, AFTER_DRAIN = false, HALFN = false, F8 = false, RWACC = true;
    bf16_t* MG; const bf16_t* ZG;
    __device__ __forceinline__ bool restart(const Unit& u) const { return u.pm >= 264; }
    __device__ __forceinline__ void rw(f32x4 (&acc)[2][2][4][2], const Unit& u, int wr, int wc, int fr, int fq) const {
        const int r = u.pm / 132, pmt = u.pm - 132 * r, rn = r < 2 ? r + 1 : r;
        const int row0 = pmt * BM + wr * 64 + fr, col0 = u.pn * BM + wc * 32 + 8 * fq;
        constexpr int PG8_GD = 4;
        u32x4 gp[PG8_GD][2], gn[PG8_GD][2];
        constexpr unsigned GB = MK_GATE_U8 ? 1u : 2u;
        const unsigned o0 = (unsigned)row0 * (3072u * GB) + (unsigned)col0 * GB;
        const char* zp = (const char*)ZG + (size_t)r * 1024 * GB; const char* zn = (const char*)ZG + (size_t)rn * 1024 * GB;
#if MK_GATE_U8
#define PG8_GLOAD(s, buf) do { const int bj_ = (s) >> 2, ai_ = ((s) >> 1) & 1, mb_ = ((s) & 1) * 2; _Pragma("unroll") for (int q_ = 0; q_ < 2; ++q_) { \
            const unsigned off_ = o0 + (unsigned)(ai_ * HALF + (mb_ + q_) * 16) * 3072u + (unsigned)(bj_ * HALF); \
            const u32x2 a_ = *(const u32x2*)(zp + off_), b_ = *(const u32x2*)(zn + off_); gp[buf][q_].x = a_.x; gp[buf][q_].y = a_.y; gn[buf][q_].x = b_.x; gn[buf][q_].y = b_.y; } } while (0)
#else
#define PG8_GLOAD(s, buf) do { const int bj_ = (s) >> 2, ai_ = ((s) >> 1) & 1, mb_ = ((s) & 1) * 2; _Pragma("unroll") for (int q_ = 0; q_ < 2; ++q_) { \
            const unsigned off_ = o0 + (unsigned)(ai_ * HALF + (mb_ + q_) * 16) * 6144u + (unsigned)(bj_ * HALF * 2); \
            gp[buf][q_] = *(const u32x4*)(zp + off_); gn[buf][q_] = *(const u32x4*)(zn + off_); } } while (0)
#endif
#pragma unroll
        for (int s = 0; s < PG8_GD - 1; ++s) PG8_GLOAD(s, s);
#pragma unroll
        for (int s = 0; s < 8; ++s) { const int bj = s >> 2, ai = (s >> 1) & 1, mb = (s & 1) * 2, col = col0 + bj * HALF;
            if (s + PG8_GD - 1 < 8) PG8_GLOAD(s + PG8_GD - 1, (s + PG8_GD - 1) % PG8_GD);
            __builtin_amdgcn_sched_barrier(0);
#pragma unroll
            for (int q = 0; q < 2; ++q) { const int m = mb + q; const size_t row = (size_t)(row0 + ai * HALF + m * 16);
                const u32x4 g0 = gp[s % PG8_GD][q], g1 = gn[s % PG8_GD][q];
#if MK_GATE_U8
#define PG8_UB(w_, k_) ((float)(((w_) >> (8 * (k_))) & 255u))
                const float x[8] = {PG8_UB(g0.x, 0), PG8_UB(g0.x, 1), PG8_UB(g0.x, 2), PG8_UB(g0.x, 3), PG8_UB(g0.y, 0), PG8_UB(g0.y, 1), PG8_UB(g0.y, 2), PG8_UB(g0.y, 3)};
#else
                const float x[8] = {bf_lo(g0.x), bf_hi(g0.x), bf_lo(g0.y), bf_hi(g0.y), bf_lo(g0.z), bf_hi(g0.z), bf_lo(g0.w), bf_hi(g0.w)};
#endif
                if (r < 2) {
#if MK_GATE_U8
                    const float y[8] = {PG8_UB(g1.x, 0), PG8_UB(g1.x, 1), PG8_UB(g1.x, 2), PG8_UB(g1.x, 3), PG8_UB(g1.y, 0), PG8_UB(g1.y, 1), PG8_UB(g1.y, 2), PG8_UB(g1.y, 3)};
#else
                    const float y[8] = {bf_lo(g1.x), bf_hi(g1.x), bf_lo(g1.y), bf_hi(g1.y), bf_lo(g1.z), bf_hi(g1.z), bf_lo(g1.w), bf_hi(g1.w)};
#endif
#pragma unroll
                    for (int j = 0; j < 8; ++j) acc[ai][bj][m][j >> 2][j & 3] *= x[j] * __builtin_amdgcn_rcpf(y[j]);
                } else {
                    float v[8];
#pragma unroll
                    for (int j = 0; j < 8; ++j) v[j] = acc[ai][bj][m][j >> 2][j & 3] * (MK_GATE_U8 ? x[j] * (1.0f / 255.0f) : x[j]);
                    u32x4 w; w.x = cvt_pk_bf16(v[0], v[1]); w.y = cvt_pk_bf16(v[2], v[3]); w.z = cvt_pk_bf16(v[4], v[5]); w.w = cvt_pk_bf16(v[6], v[7]);
                    *(u32x4*)(MG + row * 1024 + col) = w;
                } }
        }
#undef PG8_GLOAD
    }
};
struct BranchOrder3 {
    StaticOrder so;
    __device__ __forceinline__ bool next(int i, Unit& u) const {
        const int ti = i / 3, r = i - 3 * ti; if (!so.next(ti, u)) return false;
        u.pb = 4 * r + u.pn; u.pm += 132 * r; return true;
    }
    __device__ __forceinline__ void a_ready(const Unit&) const {}
    __device__ __forceinline__ void done(const Unit&) const {}
};
struct EpiSwiglu {
    static constexpr bool PERM = true, AFTER_DRAIN = false, HALFN = false, F8 = false, RWACC = false;
    bf16_t* H; int ldh;
    __device__ __forceinline__ void operator()(const f32x4 (&acc)[2][2][4][2], const Unit& u, int wr, int wc, int fr, int fq) const {
        const int row0 = u.pm * BM + wr * 64 + fr; const int col0 = u.pn * HALF + wc * 32 + 8 * fq;
#pragma unroll
        for (int ai = 0; ai < 2; ++ai)
#pragma unroll
            for (int m = 0; m < 4; ++m) { bf16_t* rowp = H + (size_t)(row0 + ai * HALF + m * 16) * ldh + col0;
                float h[8];
#pragma unroll
                for (int n = 0; n < 2; ++n)
#pragma unroll
                    for (int j = 0; j < 4; ++j) { const float g = acc[ai][0][m][n][j], uu = acc[ai][1][m][n][j]; h[n * 4 + j] = g * sigmoidf_(g) * uu; }
                u32x4 w; w.x = cvt_pk_bf16(h[0], h[1]); w.y = cvt_pk_bf16(h[2], h[3]); w.z = cvt_pk_bf16(h[4], h[5]); w.w = cvt_pk_bf16(h[6], h[7]);
                *(u32x4*)rowp = w; }
    }
};
__device__ __forceinline__ unsigned pk4_fp8(float a, float b, float c, float d) { int w = __builtin_amdgcn_cvt_pk_fp8_f32(a, b, 0, false); w = __builtin_amdgcn_cvt_pk_fp8_f32(c, d, w, true); return (unsigned)w; }
__device__ __forceinline__ float clamp_fp8(float v) { return fminf(fmaxf(v, -448.0f), 448.0f); }
template <bool OPF8> struct EpiSwiglu8T {
    static constexpr bool PERM = true, AFTER_DRAIN = false, HALFN = false, F8 = OPF8, RWACC = false;
    unsigned char* H; int ldh; float sin, sout;
    __device__ __forceinline__ void operator()(const f32x4 (&acc)[2][2][4][2], const Unit& u, int wr, int wc, int fr, int fq) const {
        const int row0 = u.pm * BM + wr * 64 + fr; const int col0 = u.pn * HALF + wc * 32 + 8 * (fq & 2); const int odd = fq & 1;
#pragma unroll
        for (int ai = 0; ai < 2; ++ai)
#pragma unroll
            for (int mp = 0; mp < 2; ++mp) {
                unsigned w[2][2];
#pragma unroll
                for (int k = 0; k < 2; ++k) { const int m = 2 * mp + k; float h[8];
#pragma unroll
                    for (int n = 0; n < 2; ++n)
#pragma unroll
                        for (int j = 0; j < 4; ++j) { const float g = acc[ai][0][m][n][j] * sin, uu = acc[ai][1][m][n][j] * sin; h[n * 4 + j] = clamp_fp8(g * sigmoidf_(g) * uu * sout); }
                    w[k][0] = pk4_fp8(h[0], h[1], h[2], h[3]); w[k][1] = pk4_fp8(h[4], h[5], h[6], h[7]); }
                const unsigned s0 = odd ? w[0][0] : w[1][0], s1 = odd ? w[0][1] : w[1][1];
                const unsigned r0 = (unsigned)mk_xor16((int)s0), r1 = (unsigned)mk_xor16((int)s1);
                u32x4 st; if (odd) { st.x = r0; st.y = r1; st.z = w[1][0]; st.w = w[1][1]; } else { st.x = w[0][0]; st.y = w[0][1]; st.z = r0; st.w = r1; }
                *(u32x4*)(H + (size_t)(row0 + ai * HALF + (2 * mp + odd) * 16) * ldh + col0) = st; }
    }
};
typedef EpiSwiglu8T<true> EpiSwiglu8;
struct EpiBf16PS8 {
    static constexpr bool PERM = true, AFTER_DRAIN = false, HALFN = false, F8 = true, RWACC = false;
    bf16_t* O; int ldc; float s;
    __device__ __forceinline__ void operator()(const f32x4 (&acc)[2][2][4][2], const Unit& u, int wr, int wc, int fr, int fq) const {
        const int row0 = u.pm * BM + wr * 64 + fr; const int col0 = u.pn * BM + wc * 32 + 8 * fq;
#pragma unroll
        for (int ai = 0; ai < 2; ++ai)
#pragma unroll
            for (int m = 0; m < 4; ++m) { bf16_t* rowp = O + (size_t)(row0 + ai * HALF + m * 16) * ldc + col0;
#pragma unroll
                for (int bj = 0; bj < 2; ++bj) { const f32x4 v0 = acc[ai][bj][m][0] * s, v1 = acc[ai][bj][m][1] * s;
                    u32x4 w; w.x = cvt_pk_bf16(v0[0], v0[1]); w.y = cvt_pk_bf16(v0[2], v0[3]); w.z = cvt_pk_bf16(v1[0], v1[1]); w.w = cvt_pk_bf16(v1[2], v1[3]);
                    *(u32x4*)(rowp + bj * HALF) = w; } }
    }
};
struct MoeOrder {
    int nN, G, c, p_lo, np; int pc[8];
    __device__ __forceinline__ bool next(int i, Unit& u) const {
        const long L = (long)i * G + c; if (L >= (long)np * nN) return false;
        const int wgid = (int)L, nig = WGM * nN, gid = wgid / nig, fm = gid * WGM, gsz = (np - fm) < WGM ? (np - fm) : WGM;
        u.pm = p_lo + fm + ((wgid % nig) % gsz); u.pn = (wgid % nig) / gsz;
        int e = 0;
#pragma unroll
        for (int k = 1; k < 8; ++k) e += (u.pm >= pc[k]) ? 1 : 0;
        u.pb = e * nN + u.pn; return true;
    }
    __device__ __forceinline__ void a_ready(const Unit&) const {}
    __device__ __forceinline__ void done(const Unit&) const {}
};

template <class Epi, class Sched, bool ALIGN_EPI = false, bool SP2 = false>
__device__ __forceinline__ void gemm_phase(PG8_LAS unsigned char* lds, const Gemm g, const Sched& S, const Epi& E, int wv) {
    int tid_ = (wv << 6) | mk_lane(); asm volatile("" : "+v"(tid_));
    const int tid = tid_, wid = __builtin_amdgcn_readfirstlane(tid >> 6), lane = tid & 63, wr = wid >> 2, wc = wid & 3, fr = lane & 15, fq = lane >> 4;
    constexpr bool HN = Epi::HALFN;
    constexpr bool F8 = Epi::F8;
    constexpr int ES = F8 ? 1 : 2;
    const int K = g.K, nt = K * ES / (BK * 2);
    unsigned voffA[2], voffB[2];
#pragma unroll
    for (int i = 0; i < 2; ++i) { int R, C; stage_rc(tid * 16 + i * 8192, R, C); const int Rb = Epi::PERM ? ((R & ~31) + perm32(R & 31)) : R;
        voffA[i] = (unsigned)(R * K * ES + C * 2); voffB[i] = (unsigned)(Rb * K * ES + C * 2); }
    const size_t kstep = (size_t)(BK * 2);
    const size_t hstep = (size_t)HALF * K * ES;
    const size_t tstep = 2 * hstep;
    const unsigned ldsw = (unsigned)wid * 1024u;
    const int aoff = lds_byte(wr * 64 + fr, fq * 8), boff = lds_byte(wc * 32 + fr, fq * 8);
#define PG8_SA(b, h) (((b) * 2 + (h)) * HTB)
#define PG8_SB(b, h) ((4 + (b) * 2 + (h)) * HTB)
#define PG8_STAGE(bufoff, gbase, voff) do { _Pragma("unroll") for (int _i = 0; _i < 2; ++_i) \
        __builtin_amdgcn_global_load_lds((const unsigned*)((const char*)(gbase) + (voff)[_i]), (PG8_LAS unsigned*)(lds + (bufoff) + ldsw + _i * 8192), 16, 0, 0); } while (0)
#define PG8_LDA(dst, b, h) do { if constexpr (F8) { _Pragma("unroll") for (int m = 0; m < 4; ++m) { const u32x4 lo_ = *(const PG8_LAS u32x4*)(lds + PG8_SA(b, h) + aoff + m * 2048), hi_ = *(const PG8_LAS u32x4*)(lds + PG8_SA(b, h) + aoff + m * 2048 + 1024); \
            dst##8[m] = __builtin_bit_cast(v8i32, __builtin_shufflevector(lo_, hi_, 0, 1, 2, 3, 4, 5, 6, 7)); } } \
        else { _Pragma("unroll") for (int m = 0; m < 4; ++m) _Pragma("unroll") for (int k = 0; k < 2; ++k) dst[m][k] = *(const PG8_LAS bf16x8*)(lds + PG8_SA(b, h) + aoff + m * 2048 + k * 1024); } } while (0)
#define PG8_LDB(dst, b, h) do { if constexpr (F8) { _Pragma("unroll") for (int n = 0; n < 2; ++n) { const u32x4 lo_ = *(const PG8_LAS u32x4*)(lds + PG8_SB(b, h) + boff + n * 2048), hi_ = *(const PG8_LAS u32x4*)(lds + PG8_SB(b, h) + boff + n * 2048 + 1024); \
            dst##8[n] = __builtin_bit_cast(v8i32, __builtin_shufflevector(lo_, hi_, 0, 1, 2, 3, 4, 5, 6, 7)); } } \
        else { _Pragma("unroll") for (int n = 0; n < 2; ++n) _Pragma("unroll") for (int k = 0; k < 2; ++k) dst[n][k] = *(const PG8_LAS bf16x8*)(lds + PG8_SB(b, h) + boff + n * 2048 + k * 1024); } } while (0)
#define PG8_MMA(ai, bj, At, Bt) do { __builtin_amdgcn_s_setprio(1); _Pragma("unroll") for (int m = 0; m < 4; ++m) _Pragma("unroll") for (int n = 0; n < 2; ++n) { \
        if constexpr (F8) { asm volatile("v_mfma_f32_16x16x128_f8f6f4 %0, %1, %2, %0" : "+v"(acc[ai][bj][m][n]) : "v"(Bt##8[n]), "v"(At##8[m])); } \
        else { _Pragma("unroll") for (int k = 0; k < 2; ++k) acc[ai][bj][m][n] = __builtin_amdgcn_mfma_f32_16x16x32_bf16(Bt[n][k], At[m][k], acc[ai][bj][m][n], 0, 0, 0); } } \
        __builtin_amdgcn_s_setprio(0); } while (0)
#define PG8_LDB1(dst, b, h) do { if constexpr (!HN) { PG8_LDB(dst, b, h); } } while (0)
#define PG8_MMA1(ai, bj, At, Bt) do { if constexpr (!HN) { PG8_MMA(ai, bj, At, Bt); } } while (0)
#define PG8_WAIT_V(n) asm volatile("s_waitcnt vmcnt(" #n ")" ::: "memory")
#define PG8_WAIT_L(n) asm volatile("s_waitcnt lgkmcnt(" #n ")" ::: "memory")
#define PG8_BAR __builtin_amdgcn_s_barrier()
#define PG8_SCHED __builtin_amdgcn_sched_barrier(0)
    Unit cur, nxt; int ui = 0;
    if (!S.next(0, cur)) return;
    f32x4 acc[2][2][4][2];
#pragma unroll
    for (int a = 0; a < 2; ++a)
#pragma unroll
        for (int b = 0; b < 2; ++b)
#pragma unroll
            for (int m = 0; m < 4; ++m)
#pragma unroll
                for (int n = 0; n < 2; ++n) acc[a][b][m][n] = (f32x4){0.f, 0.f, 0.f, 0.f};
    bf16x8 At[4][2], B0[2][2], B1[2][2];
    v8i32 At8[4], B08[2], B18[2];
    const char* cA = (const char*)g.A + (size_t)cur.pm * tstep; const char* cB = (const char*)g.Bt + (size_t)cur.pb * (HN ? hstep : tstep);
    S.a_ready(cur);
    if constexpr (SP2) {
        PG8_STAGE(PG8_SB(0, 0), cB, voffB); PG8_STAGE(PG8_SB(0, 1), cB + hstep, voffB); PG8_STAGE(PG8_SA(0, 0), cA, voffA); PG8_STAGE(PG8_SA(0, 1), cA + hstep, voffA);
        if (wr == 1) PG8_BAR;
        PG8_WAIT_V(2); PG8_BAR;
        PG8_STAGE(PG8_SB(1, 0), cB + kstep, voffB); PG8_STAGE(PG8_SA(1, 0), cA + kstep, voffA); PG8_STAGE(PG8_SB(1, 1), cB + hstep + kstep, voffB);
        PG8_WAIT_V(6); PG8_BAR;
    } else {
        PG8_STAGE(PG8_SB(0, 0), cB, voffB); PG8_STAGE(PG8_SA(0, 0), cA, voffA); PG8_STAGE(PG8_SB(0, 1), cB + hstep, voffB); PG8_STAGE(PG8_SA(0, 1), cA + hstep, voffA);
        if (wr == 1) PG8_BAR;
        PG8_WAIT_V(4); PG8_BAR;
        PG8_STAGE(PG8_SB(1, 0), cB + kstep, voffB); PG8_STAGE(PG8_SA(1, 0), cA + kstep, voffA); PG8_STAGE(PG8_SB(1, 1), cB + hstep + kstep, voffB);
        PG8_WAIT_V(6); PG8_BAR;
    }
    for (;;) {
        const bool has_next = S.next(ui + 1, nxt);
        const char* nA = has_next ? (const char*)g.A + (size_t)nxt.pm * tstep : cA; const char* nB = has_next ? (const char*)g.Bt + (size_t)nxt.pb * (HN ? hstep : tstep) : cB;
        for (int t = 0; t < nt; t += 2) {
            const bool last = (t == nt - 2);
            const char* a1 = cA + (size_t)(t + 1) * kstep;
            const char* a2 = last ? nA : cA + (size_t)(t + 2) * kstep; const char* b2 = last ? nB : cB + (size_t)(t + 2) * kstep;
            const char* a3 = a2 + kstep; const char* b3 = b2 + kstep;
            if (last && has_next) S.a_ready(nxt);
            if constexpr (SP2) {
            PG8_LDB(B0, 0, 0); PG8_LDB1(B1, 0, 1); PG8_SCHED; PG8_LDA(At, 0, 0); PG8_STAGE(PG8_SA(1, 1), a1 + hstep, voffA);
            PG8_WAIT_V(8); PG8_WAIT_L(0); PG8_BAR; PG8_MMA(0, 0, At, B0); PG8_MMA1(0, 1, At, B1); PG8_BAR; PG8_SCHED;
            PG8_LDA(At, 0, 1); PG8_STAGE(PG8_SB(0, 0), b2, voffB); PG8_STAGE(PG8_SB(0, 1), b2 + hstep, voffB); PG8_STAGE(PG8_SA(0, 0), a2, voffA);
            PG8_WAIT_V(8); PG8_WAIT_L(0); PG8_BAR; PG8_MMA(1, 0, At, B0); PG8_MMA1(1, 1, At, B1); PG8_BAR; PG8_SCHED;
            PG8_LDB(B0, 1, 0); PG8_LDB1(B1, 1, 1); PG8_SCHED; PG8_LDA(At, 1, 0); PG8_STAGE(PG8_SA(0, 1), a2 + hstep, voffA);
            PG8_WAIT_V(8); PG8_WAIT_L(0); PG8_BAR; PG8_MMA(0, 0, At, B0); PG8_MMA1(0, 1, At, B1); PG8_BAR; PG8_SCHED;
            PG8_LDA(At, 1, 1); PG8_STAGE(PG8_SB(1, 0), b3, voffB); PG8_STAGE(PG8_SB(1, 1), b3 + hstep, voffB); PG8_STAGE(PG8_SA(1, 0), a3, voffA);
            PG8_WAIT_V(8); PG8_WAIT_L(0); PG8_BAR; PG8_MMA(1, 0, At, B0); PG8_MMA1(1, 1, At, B1); PG8_BAR; PG8_SCHED;
            } else {
            PG8_LDB(B0, 0, 0); PG8_SCHED; PG8_LDA(At, 0, 0); PG8_STAGE(PG8_SA(1, 1), a1 + hstep, voffA);
            PG8_WAIT_L(8); PG8_BAR; PG8_WAIT_L(0); PG8_MMA(0, 0, At, B0); PG8_BAR; PG8_SCHED;
            PG8_LDB1(B1, 0, 1); PG8_STAGE(PG8_SB(0, 0), b2, voffB);
            PG8_BAR; PG8_WAIT_L(0); PG8_MMA1(0, 1, At, B1); PG8_BAR;
            PG8_LDA(At, 0, 1); PG8_STAGE(PG8_SA(0, 0), a2, voffA);
            PG8_BAR; PG8_WAIT_L(0); PG8_MMA(1, 0, At, B0); PG8_BAR; PG8_SCHED;
            PG8_STAGE(PG8_SB(0, 1), b2 + hstep, voffB);
            PG8_WAIT_V(6); PG8_BAR; PG8_MMA1(1, 1, At, B1); PG8_BAR;
            PG8_LDB(B0, 1, 0); PG8_SCHED; PG8_LDA(At, 1, 0); PG8_STAGE(PG8_SA(0, 1), a2 + hstep, voffA);
            PG8_WAIT_L(8); PG8_BAR; PG8_WAIT_L(0); PG8_MMA(0, 0, At, B0); PG8_BAR; PG8_SCHED;
            PG8_LDB1(B1, 1, 1); PG8_STAGE(PG8_SB(1, 0), b3, voffB);
            PG8_BAR; PG8_WAIT_L(0); PG8_MMA1(0, 1, At, B1); PG8_BAR;
            PG8_LDA(At, 1, 1); PG8_STAGE(PG8_SA(1, 0), a3, voffA);
            PG8_BAR; PG8_WAIT_L(0); PG8_MMA(1, 0, At, B0); PG8_BAR; PG8_SCHED;
            PG8_STAGE(PG8_SB(1, 1), b3 + hstep, voffB);
            PG8_WAIT_V(6); PG8_BAR; PG8_MMA1(1, 1, At, B1); PG8_BAR;
            }
        }
        if constexpr (F8) asm volatile("s_nop 15\n\ts_nop 15" ::: "memory");
        if constexpr (ALIGN_EPI) { if (wr == 0) PG8_BAR; }
        if constexpr (Epi::RWACC) { E.rw(acc, cur, wr, wc, fr, fq); S.done(cur); }
        else if constexpr (!Epi::AFTER_DRAIN) { E(acc, cur, wr, wc, fr, fq); S.done(cur); }
        if (!has_next) break;
        bool zero_acc = true; if constexpr (Epi::RWACC) zero_acc = E.restart(cur);
        if (zero_acc)
#pragma unroll
        for (int a = 0; a < 2; ++a)
#pragma unroll
            for (int b = 0; b < 2; ++b)
#pragma unroll
                for (int m = 0; m < 4; ++m)
#pragma unroll
                    for (int n = 0; n < 2; ++n) acc[a][b][m][n] = (f32x4){0.f, 0.f, 0.f, 0.f};
        cur = nxt; cA = nA; cB = nB; ++ui;
        if constexpr (ALIGN_EPI) { if (wr == 1) PG8_BAR; }
    }
    PG8_WAIT_V(0);
    if constexpr (!ALIGN_EPI) { if (wr == 0) PG8_BAR; }
    PG8_BAR;
    if constexpr (Epi::AFTER_DRAIN) { E.fused(acc, cur, wr, wc, fr, fq, lds, wid, lane); S.done(cur); }
#undef PG8_SA
#undef PG8_SB
#undef PG8_STAGE
#undef PG8_LDA
#undef PG8_LDB
#undef PG8_MMA
#undef PG8_LDB1
#undef PG8_MMA1
#undef PG8_WAIT_V
#undef PG8_WAIT_L
#undef PG8_BAR
#undef PG8_SCHED
}
}

#ifndef PG8_SP2
#define PG8_SP2 true
#endif
#ifndef PG8_ALIGN
#define PG8_ALIGN true
#endif
#ifndef MK_WGM
#define MK_WGM 4
#endif
#ifndef MK_DENSE_F8
#define MK_DENSE_F8 1
#endif
#ifndef MK_PER_PHASE
#define MK_PER_PHASE 0
#endif

constexpr int NWAVES = 8;
constexpr int D = 1024, BATCH = 4, SEQ = 8192, CTXL = 256, DEPTH = 2;
constexpr int TL = BATCH * SEQ, TC = BATCH * CTXL, TA = TL + TC;
constexpr int INC = 6912, ZMC = 3840, ZGC = 3072, BW = 512;
constexpr int FFD = 2816, FFE = 3584, NE = 8;
constexpr int MAXPAN = 264, PCH = 264, NCHUNK = 1;
constexpr float RMS_EPS = 1e-6f;
constexpr float SC_XG = 4.0f, SC_WGU = 32.0f, SC_H = 4.0f, SC_WDN = 64.0f;
constexpr int C_QA = 0, C_KA = 512, C_VA = 640, C_UX = 768, C_GB = 1280, C_GC = 1792, C_QN = 2304, C_KN = 2816, C_VN = 3328;

constexpr size_t MiB = 1u << 20;
constexpr size_t WS_CTL = 0, CTL_ZERO_BYTES = 1 * MiB;
constexpr size_t WS_MOD = 1 * MiB;
constexpr size_t WS_ROPE = WS_MOD + 256 * 1024;
constexpr size_t WS_SLABCNT = WS_MOD + 320 * 1024;
constexpr size_t WS_PCUM = WS_MOD + 384 * 1024;
constexpr size_t WS_TOKER = WS_MOD + 512 * 1024;
constexpr size_t WS_TOKG = WS_MOD + 768 * 1024;
constexpr size_t WS_TOKPOS = WS_MOD + 1024 * 1024;
constexpr size_t WS_HCTX = 4 * MiB;
constexpr size_t WS_WIN = 8 * MiB;
constexpr size_t WS_WBR = 35 * MiB;
constexpr size_t WS_WOUT = 41 * MiB;
constexpr size_t WS_WGUD = 45 * MiB;
constexpr size_t WS_WDND = 56 * MiB;
constexpr size_t WS_WGUM = 62 * MiB;
constexpr size_t WS_WDNM = 118 * MiB;
constexpr size_t WS_RS = 146 * MiB;
constexpr size_t WS_HX = 230 * MiB;
constexpr size_t WS_ZM = 296 * MiB;
constexpr size_t WS_ZG = 544 * MiB;
constexpr size_t WS_O = 742 * MiB;
constexpr size_t WS_XG = WS_ZM;
constexpr size_t WS_HM = WS_ZM + 132 * MiB;
constexpr size_t WS_XG8 = WS_O;
constexpr size_t WS_HX8 = 841 * MiB;
constexpr size_t WS_WING8 = 874 * MiB;
constexpr size_t WS_END = 880 * MiB;
static_assert(WS_WIN + (size_t)2 * INC * D * 2 <= WS_WBR && WS_WGUD + (size_t)2 * FFD * D * 2 <= WS_WDND && WS_WDND + (size_t)D * FFD * 2 <= WS_WGUM, "ws map (weights)");
static_assert(WS_WGUM + (size_t)NE * 2 * FFE * D <= WS_WDNM && WS_WDNM + (size_t)NE * D * FFE <= WS_RS && WS_RS + (size_t)TA * D * 2 <= WS_HX, "ws map (moe weights, residual stream)");
static_assert(WS_HX + (size_t)TA * D * 2 <= WS_ZM && WS_ZM + (size_t)TA * ZMC * 2 <= WS_ZG && WS_ZG + (size_t)TA * ZGC * 2 <= WS_O && WS_O + (size_t)3 * TA * BW * 2 <= WS_END, "ws map (activations)");
static_assert(WS_HM + (size_t)MAXPAN * 256 * FFE <= WS_O && WS_XG8 + (size_t)MAXPAN * 256 * D <= WS_END && (size_t)MAXPAN * 256 * D * 2 <= 132 * MiB && (size_t)TA * D * 4 <= 132 * MiB, "ws map (moe)");
constexpr int CW_BAR = 4096;

constexpr int RING_OFF = 0, RING_BYTES = 131072;
constexpr int LDSCTL_OFF = RING_BYTES, MISC_OFF = LDSCTL_OFF + 320;
constexpr int ROPEL_OFF = RING_BYTES + 1024, ROPEL_BYTES = 192 * 16 * 2 * 4;
constexpr int LDS_BYTES = 163840;
static_assert(ROPEL_OFF + ROPEL_BYTES <= LDS_BYTES, "lds map");

#define GAS __attribute__((address_space(1)))
#define LAS __attribute__((address_space(3)))
typedef unsigned short bf16;
typedef unsigned v4u __attribute__((ext_vector_type(4)));
typedef unsigned v2u __attribute__((ext_vector_type(2)));
typedef float f32x4 __attribute__((ext_vector_type(4)));
typedef float f32x2 __attribute__((ext_vector_type(2)));
#define LDS_WAIT() asm volatile("s_waitcnt lgkmcnt(0)" ::: "memory")
#define VM_WAIT() asm volatile("s_waitcnt vmcnt(0)" ::: "memory")
__device__ __forceinline__ unsigned f2bf(float f) { unsigned u = __builtin_bit_cast(unsigned, f); return (u + 0x7fffu + ((u >> 16) & 1u)) >> 16; }
__device__ __forceinline__ unsigned pk2(float lo, float hi) { return f2bf(lo) | (f2bf(hi) << 16); }
__device__ __forceinline__ float bflo(unsigned w) { return __uint_as_float(w << 16); }
__device__ __forceinline__ float bfhi(unsigned w) { return __uint_as_float(w & 0xffff0000u); }
__device__ __forceinline__ float bf2f(bf16 b) { return __uint_as_float(((unsigned)b) << 16); }

#define XB_TMO      128
#define XB_XCNT(j)  (256  + 64 * (j))
#define XB_XSUB(j)  (1280 + 64 * (j))
#define XB_XGEN(j)  (2304 + 64 * (j))
#define XB_TOP      3328
#define XB_TOPGEN   3392
#define XCD_BAR_WORDS 3456
#define XB_SPIN_CAP (1u << 21)

__device__ __forceinline__ unsigned xb_ld(unsigned* p)              { return __hip_atomic_load(p, __ATOMIC_RELAXED, __HIP_MEMORY_SCOPE_AGENT); }
__device__ __forceinline__ unsigned xb_add(unsigned* p, unsigned v) { return __hip_atomic_fetch_add(p, v, __ATOMIC_RELAXED, __HIP_MEMORY_SCOPE_AGENT); }
__device__ __forceinline__ unsigned xb_xcc_id() { return (unsigned)__builtin_amdgcn_s_getreg((3 << 11) | 20) & 0xFu; }
#define XB_SPIN(cond, bar) do { unsigned _sp = 0; while (cond) { __builtin_amdgcn_s_sleep(1); \
    if ((++_sp & 255u) == 0u) { if (xb_ld(&(bar)[XB_TMO])) break; if (_sp > XB_SPIN_CAP) { atomicAdd(&(bar)[XB_TMO], 1u); break; } } } } while (0)

struct XcdBarrier {
    unsigned* bar; unsigned x;
    volatile LAS unsigned* st;
    int w;
};

__device__ __forceinline__ XcdBarrier xcd_barrier_post(unsigned* bar, volatile LAS unsigned* st) {
    XcdBarrier b; b.bar = bar; b.x = xb_xcc_id(); b.st = st; b.w = 0;
    if (threadIdx.x == 0) (void)xb_add(&bar[XB_XCNT(b.x)], 1u);
    return b;
}
__device__ __forceinline__ void xcd_barrier_complete(unsigned* bar, unsigned x, unsigned& nloc, unsigned& nx) {
    const unsigned G = gridDim.x * gridDim.y * gridDim.z;
    unsigned sum, cnt, mine, sp = 0u;
    for (;;) {
        sum = 0u; cnt = 0u; mine = 0u;
#pragma unroll
        for (unsigned j = 0; j < 16; ++j) { const unsigned c = xb_ld(&bar[XB_XCNT(j)]); sum += c; cnt += (c > 0u) ? 1u : 0u; mine = (j == x) ? c : mine; }
        if (sum == G) break;
        __builtin_amdgcn_s_sleep(1);
        if ((++sp & 255u) == 0u) { if (xb_ld(&bar[XB_TMO])) break; if (sp > XB_SPIN_CAP) { atomicAdd(&bar[XB_TMO], 1u); break; } }
    }
    nloc = mine > 0u ? mine : 1u; nx = cnt > 0u ? cnt : 1u;
}

__device__ __forceinline__ void xcd_barrier(const XcdBarrier& b) {
    asm volatile("s_waitcnt vmcnt(0)" ::: "memory");
    __syncthreads();
    if (b.w == 0 && mk_lane() == 0) {
        unsigned* bar = b.bar; { GAS unsigned* bg_ = (GAS unsigned*)bar; asm volatile("" : "+s"(bg_)); bar = (unsigned*)bg_; }
        __builtin_amdgcn_s_waitcnt(0);
        unsigned nloc = b.st[0], nx = b.st[1];
        if (nloc == 0u) { xcd_barrier_complete(bar, b.x, nloc, nx); b.st[0] = nloc; b.st[1] = nx; }
        const unsigned old = xb_add(&bar[XB_XSUB(b.x)], 1u);
        const unsigned gen = old / nloc;
        if (old + 1u == (gen + 1u) * nloc) {
            __builtin_amdgcn_fence(__ATOMIC_RELEASE, "agent");
            asm volatile("s_waitcnt vmcnt(0)" ::: "memory");
            const unsigned og = xb_add(&bar[XB_TOP], 1u);
            const unsigned tg = og / nx;
            if (og + 1u == (tg + 1u) * nx) xb_add(&bar[XB_TOPGEN], 1u);
            else XB_SPIN(xb_ld(&bar[XB_TOPGEN]) == tg, bar);
            __builtin_amdgcn_fence(__ATOMIC_ACQUIRE, "agent");
            xb_add(&bar[XB_XGEN(b.x)], 1u);
            asm volatile("s_waitcnt vmcnt(0)" ::: "memory");
        } else {
            XB_SPIN(xb_ld(&bar[XB_XGEN(b.x)]) == gen, bar);
            __builtin_amdgcn_fence(__ATOMIC_ACQUIRE, "agent");
            asm volatile("s_waitcnt vmcnt(0)" ::: "memory");
        }
    }
    __syncthreads();
}

struct Frame {
    LAS unsigned char* lds;
    volatile LAS unsigned* MISC;
    unsigned* ctl;
    int vcu, G;
    int wv;
};
enum { I_X = 0, I_C, I_CTX, I_CCTX, I_WADA, I_BADA, I_GPREMIX, I_GPOSTMIX, I_GPREFFN, I_GPOSTFFN, I_WIN, I_BGATE, I_SINK, I_CONVW, I_RPB, I_WBRANCH, I_WOUT, I_WGUD, I_WDND, I_WROUTER, I_BROUTER, I_WGUM, I_WDNM };

__device__ __forceinline__ float wave_sum(float v) {
    v += mk_dpp<0xB1>(v); v += mk_dpp<0x4E>(v); v += mk_dpp<0x141>(v); v += mk_dpp<0x140>(v);
    v += mk_dpp<0x142, 0xa>(v); v += mk_dpp<0x143, 0xc>(v);
    return __builtin_bit_cast(float, __builtin_amdgcn_readlane(__builtin_bit_cast(int, v), 63));
}
__device__ __forceinline__ float wave_max(float v) {
    v = fmaxf(v, mk_dpp<0xB1>(v)); v = fmaxf(v, mk_dpp<0x4E>(v)); v = fmaxf(v, mk_dpp<0x141>(v)); v = fmaxf(v, mk_dpp<0x140>(v));
    const float a = __builtin_bit_cast(float, __builtin_amdgcn_readlane(__builtin_bit_cast(int, v), 0)), b = __builtin_bit_cast(float, __builtin_amdgcn_readlane(__builtin_bit_cast(int, v), 16)),
                c = __builtin_bit_cast(float, __builtin_amdgcn_readlane(__builtin_bit_cast(int, v), 32)), d = __builtin_bit_cast(float, __builtin_amdgcn_readlane(__builtin_bit_cast(int, v), 48));
    return fmaxf(fmaxf(a, b), fmaxf(c, d));
}

__device__ __forceinline__ void row_store_fp8(unsigned char* p, int lane, const f32x4 (&h)[4], float sc) {
#pragma unroll
    for (int c = 0; c < 2; ++c) { const f32x4 a = __builtin_elementwise_min(__builtin_elementwise_max(h[2 * c] * sc, (f32x4){-448.f, -448.f, -448.f, -448.f}), (f32x4){448.f, 448.f, 448.f, 448.f}), b = __builtin_elementwise_min(__builtin_elementwise_max(h[2 * c + 1] * sc, (f32x4){-448.f, -448.f, -448.f, -448.f}), (f32x4){448.f, 448.f, 448.f, 448.f});
        v2u w; w.x = pg8::pk4_fp8(a.x, a.y, a.z, a.w); w.y = pg8::pk4_fp8(b.x, b.y, b.z, b.w);
        *(v2u*)(p + 8 * (64 * c + lane)) = w; }
}

__device__ __forceinline__ void tr_item(const float* W, int N, int k0, int n0, bf16* WT, int Kd, int drow0, LAS float* scr, int lane) {
#pragma unroll
    for (int i = 0; i < 8; ++i) { const int kk = 8 * i + (lane >> 3), c4 = 4 * (lane & 7); const f32x4 v = *(const f32x4*)(W + (size_t)(k0 + kk) * N + n0 + c4);
        LAS float* d = scr + kk * 33 + c4; d[0] = v.x; d[1] = v.y; d[2] = v.z; d[3] = v.w; }
    LDS_WAIT(); asm volatile("" ::: "memory");
    const int c = lane & 7;
#pragma unroll
    for (int j = 0; j < 4; ++j) { const int n = (lane >> 3) + 8 * j; const LAS float* s = scr + (8 * c) * 33 + n;
        v4u o; o.x = pk2(s[0 * 33], s[1 * 33]); o.y = pk2(s[2 * 33], s[3 * 33]); o.z = pk2(s[4 * 33], s[5 * 33]); o.w = pk2(s[6 * 33], s[7 * 33]);
        *(v4u*)(WT + (size_t)(drow0 + n) * Kd + k0 + 8 * c) = o; }
    LDS_WAIT(); asm volatile("" ::: "memory");
}
__device__ __forceinline__ void tr_matrix_item(const float* W, int K, int N, int ff, bf16* WT, int item, LAS float* scr, int lane) {
    const int nblk = N / 32, kb = item / nblk, nb = item % nblk, n0 = 32 * nb;
    int drow0 = n0;
    if (ff > 0) { const int isu = n0 >= ff ? 1 : 0, nn = n0 - isu * ff; drow0 = 256 * (nn >> 7) + 128 * isu + (nn & 127); }
    tr_item(W, N, 64 * kb, n0, WT, K, drow0, scr, lane);
}

__device__ __forceinline__ void tr_item8(const float* W, int N, int k0, int n0, unsigned char* WT, int Kd, int drow0, float scale, LAS float* scr, int lane) {
#pragma unroll
    for (int i = 0; i < 8; ++i) { const int kk = 8 * i + (lane >> 3), c4 = 4 * (lane & 7); const f32x4 v = *(const f32x4*)(W + (size_t)(k0 + kk) * N + n0 + c4);
        LAS float* d = scr + kk * 33 + c4; d[0] = v.x; d[1] = v.y; d[2] = v.z; d[3] = v.w; }
    LDS_WAIT(); asm volatile("" ::: "memory");
    const int n = lane >> 1, kh = lane & 1; const LAS float* s = scr + (32 * kh) * 33 + n;
    unsigned w[8];
#pragma unroll
    for (int j = 0; j < 8; ++j) w[j] = pg8::pk4_fp8(s[(4 * j) * 33] * scale, s[(4 * j + 1) * 33] * scale, s[(4 * j + 2) * 33] * scale, s[(4 * j + 3) * 33] * scale);
    v4u* dst = (v4u*)(WT + (size_t)(drow0 + n) * Kd + k0 + 32 * kh);
    dst[0] = (v4u){w[0], w[1], w[2], w[3]}; dst[1] = (v4u){w[4], w[5], w[6], w[7]};
    LDS_WAIT(); asm volatile("" ::: "memory");
}
__device__ __forceinline__ void tr_matrix_item8(const float* W, int K, int N, int ff, unsigned char* WT, float scale, int item, LAS float* scr, int lane) {
    const int nblk = N / 32, kb = item / nblk, nb = item % nblk, n0 = 32 * nb;
    int drow0 = n0;
    if (ff > 0) { const int isu = n0 >= ff ? 1 : 0, nn = n0 - isu * ff; drow0 = 256 * (nn >> 7) + 128 * isu + (nn & 127); }
    tr_item8(W, N, 64 * kb, n0, WT, K, drow0, scale, scr, lane);
}

__device__ __forceinline__ void row_load(const float* p, int lane, f32x4 (&v)[4]) {
#pragma unroll
    for (int c = 0; c < 2; ++c) { const f32x4* r = (const f32x4*)(p + 8 * (64 * c + lane)); v[2 * c] = r[0]; v[2 * c + 1] = r[1]; }
}
__device__ __forceinline__ void row_load_bf16(const bf16* p, int lane, f32x4 (&v)[4]) {
#pragma unroll
    for (int c = 0; c < 2; ++c) { const v4u w = *(const v4u*)(p + 8 * (64 * c + lane));
        v[2 * c] = (f32x4){bflo(w.x), bfhi(w.x), bflo(w.y), bfhi(w.y)}; v[2 * c + 1] = (f32x4){bflo(w.z), bfhi(w.z), bflo(w.w), bfhi(w.w)}; }
}
__device__ __forceinline__ void row_store(float* p, int lane, const f32x4 (&v)[4]) {
#pragma unroll
    for (int c = 0; c < 2; ++c) { f32x4* r = (f32x4*)(p + 8 * (64 * c + lane)); r[0] = v[2 * c]; r[1] = v[2 * c + 1]; }
}
__device__ __forceinline__ float row_rrms(const f32x4 (&v)[4]) {
    float s = 0.f;
#pragma unroll
    for (int j = 0; j < 4; ++j) s += (v[j].x * v[j].x + v[j].y * v[j].y) + (v[j].z * v[j].z + v[j].w * v[j].w);
    return 1.0f / sqrtf(wave_sum(s) * (1.0f / D) + RMS_EPS);
}
__device__ __forceinline__ void vec_load(const float* p, int lane, f32x4 (&v)[4]) { row_load(p, lane, v); }
__device__ __forceinline__ void row_normmod(const f32x4 (&x)[4], float rr, const f32x4 (&g)[4], const f32x4 (&shift)[4], const f32x4 (&scale)[4], f32x4 (&h)[4]) {
#pragma unroll
    for (int j = 0; j < 4; ++j) h[j] = (x[j] * rr * g[j]) * (scale[j] + 1.0f) + shift[j];
}
__device__ __forceinline__ void row_store_bf16(bf16* p, int lane, const f32x4 (&h)[4]) {
#pragma unroll
    for (int c = 0; c < 2; ++c) { v4u w; w.x = pk2(h[2 * c].x, h[2 * c].y); w.y = pk2(h[2 * c].z, h[2 * c].w); w.z = pk2(h[2 * c + 1].x, h[2 * c + 1].y); w.w = pk2(h[2 * c + 1].z, h[2 * c + 1].w);
        *(v4u*)(p + 8 * (64 * c + lane)) = w; }
}

namespace at {
typedef short bf16x8 __attribute__((ext_vector_type(8)));
typedef short s16x4 __attribute__((ext_vector_type(4)));
typedef short v4i16_t __attribute__((ext_vector_type(4)));
typedef float f32x16 __attribute__((ext_vector_type(16)));
constexpr int NS = 4, PF = 3, SLOT = 16384;
constexpr int LDS_TAB = NS * SLOT + 1024;
constexpr int LDS_TT = LDS_TAB + 8 * 2048 + 1024;
constexpr int MAXT = 160;
constexpr float LOG2E = 1.4426950408889634f, C2 = 0.125f * LOG2E;
__device__ __forceinline__ unsigned cvtpk(float lo, float hi) { unsigned r; asm volatile("v_cvt_pk_bf16_f32 %0, %1, %2" : "=v"(r) : "v"(lo), "v"(hi)); return r; }
__device__ __forceinline__ float hmax(float v) { auto rr = __builtin_amdgcn_permlane32_swap(__float_as_uint(v), __float_as_uint(v), false, false); return fmaxf(__uint_as_float(rr[0]), __uint_as_float(rr[1])); }
__device__ __forceinline__ float hsum(float v) { auto rr = __builtin_amdgcn_permlane32_swap(__float_as_uint(v), __float_as_uint(v), false, false); return __uint_as_float(rr[0]) + __uint_as_float(rr[1]); }

__device__ __forceinline__ void glds16(const void* gsrc, unsigned lds_dst) { unsigned keep;
    asm volatile("s_mov_b32 %0, m0\n\ts_mov_b32 m0, %2\n\ts_nop 0\n\tglobal_load_lds_dwordx4 %1, off\n\ts_mov_b32 m0, %0" : "=&s"(keep) : "v"(gsrc), "s"(lds_dst) : "memory"); }
__device__ __forceinline__ void tile_issue(LAS unsigned char* slot, const bf16* ZMp, size_t row0, int kcol, int vcol, int wid, int lane) {
    const bf16* ksrc = ZMp + (row0 + lane) * ZMC + kcol + wid * 8;
    const bf16* vsrc = ZMp + (row0 + 16 * (wid & 3) + (lane >> 2)) * ZMC + vcol + (wid >> 2) * 32 + (lane & 3) * 8;
    const unsigned dst = (unsigned)__builtin_amdgcn_readfirstlane((int)(unsigned)(uintptr_t)slot + wid * 1024);
    glds16(ksrc, dst); glds16(vsrc, dst + 8192u);
}
__device__ __forceinline__ void k_load_half(bf16x8 (&kf)[4], const LAS unsigned char* Ks, int h, int r32, int hi) {
    const LAS unsigned char* kb = Ks + hi * 1024 + r32 * 16 + h * 4096;
#pragma unroll
    for (int d0 = 0; d0 < 2; ++d0) { kf[2 * d0] = *(const LAS bf16x8*)(kb + d0 * 2048); kf[2 * d0 + 1] = *(const LAS bf16x8*)(kb + d0 * 2048 + 512); }
}
__device__ __forceinline__ void qk_tile(f32x16& p0, f32x16& p1, const LAS unsigned char* Ks, const bf16x8 (&kfa)[4], const bf16x8 (&qr)[4], int r32, int hi) {
    bf16x8 kfb[4]; k_load_half(kfb, Ks, 1, r32, hi);
    __builtin_amdgcn_sched_barrier(0);
#pragma unroll
    for (int r = 0; r < 16; ++r) { p0[r] = 0.f; p1[r] = 0.f; }
#pragma unroll
    for (int d0 = 0; d0 < 2; ++d0) {
        p0 = __builtin_amdgcn_mfma_f32_32x32x16_bf16(kfa[2 * d0], qr[d0], p0, 0, 0, 0);
        p1 = __builtin_amdgcn_mfma_f32_32x32x16_bf16(kfa[2 * d0 + 1], qr[d0], p1, 0, 0, 0);
    }
#pragma unroll
    for (int d0 = 0; d0 < 2; ++d0) {
        p0 = __builtin_amdgcn_mfma_f32_32x32x16_bf16(kfb[2 * d0], qr[2 + d0], p0, 0, 0, 0);
        p1 = __builtin_amdgcn_mfma_f32_32x32x16_bf16(kfb[2 * d0 + 1], qr[2 + d0], p1, 0, 0, 0);
    }
}
__device__ __forceinline__ s16x4 vtr(const LAS unsigned char* p) { return __builtin_bit_cast(s16x4, __builtin_amdgcn_ds_read_tr16_b64_v4i16((LAS v4i16_t*)p)); }
template <int LV> __device__ __forceinline__ constexpr bool live0(int r) { return LV == 2 ? r >= 12 : true; }
template <int LV> __device__ __forceinline__ constexpr bool live1(int r) { return LV == 1 ? r < 4 : true; }
template <bool RAW, int LV, int VAR = 0>
__device__ __forceinline__ void sm_pv(f32x16& x0, f32x16& x1, float& m, float& l, f32x16 (&o)[2], const LAS unsigned char* Vs, int lane, int hi, bf16x8 (&kfa)[4], const LAS unsigned char* Ksn, bool pre) {
    if (VAR == 2) { l += x0[0] + x1[15];
        bf16x8 pw_[4]; unsigned w_[16];
#pragma unroll
        for (int i = 0; i < 8; ++i) { w_[i] = cvtpk(x0[2 * i], x0[2 * i + 1]); w_[8 + i] = cvtpk(x1[2 * i], x1[2 * i + 1]); }
#pragma unroll
        for (int k = 0; k < 4; ++k) { typedef unsigned u32x4_ __attribute__((ext_vector_type(4))); u32x4_ t; t.x = w_[4 * k]; t.y = w_[4 * k + 1]; t.z = w_[4 * k + 2]; t.w = w_[4 * k + 3]; pw_[k] = __builtin_bit_cast(bf16x8, t); }
        const LAS unsigned char* vb_ = Vs + ((lane >> 4) & 1) * 32 + (lane & 3) * 8 + (4 * hi + ((lane & 15) >> 2)) * 64;
#pragma unroll
        for (int d0 = 0; d0 < 2; ++d0)
#pragma unroll
            for (int ks = 0; ks < 4; ++ks) { if ((LV == 1 && ks == 3) || (LV == 2 && ks == 0)) continue;
                const s16x4 lo = vtr(vb_ + d0 * 4096 + ks * 1024), hh = vtr(vb_ + d0 * 4096 + ks * 1024 + 512);
                const bf16x8 vf = (bf16x8){lo[0], lo[1], lo[2], lo[3], hh[0], hh[1], hh[2], hh[3]};
                o[d0] = __builtin_amdgcn_mfma_f32_32x32x16_bf16(vf, pw_[ks], o[d0], 0, 0, 0); }
        if (pre) k_load_half(kfa, Ksn, 0, lane & 31, hi);
        return; }
    if (VAR == 3) { if (pre) k_load_half(kfa, Ksn, 0, lane & 31, hi); l += x0[0] + x1[15] + x0[7] + x1[3]; o[0][0] += x0[1]; o[1][0] += x1[1]; return; }
    float rm = -INFINITY;
#pragma unroll
    for (int r = 0; r < 16; ++r) { if (live0<LV>(r)) rm = fmaxf(rm, x0[r]); if (live1<LV>(r)) rm = fmaxf(rm, x1[r]); }
    rm = hmax(rm);
    const float mn = fmaxf(m, RAW ? rm * C2 : rm);
    { const float sc = __builtin_amdgcn_exp2f(m - mn); l *= sc;
#pragma unroll
      for (int r = 0; r < 16; ++r) { o[0][r] *= sc; o[1][r] *= sc; } }
    m = mn;
    float sum = 0.f;
#pragma unroll
    for (int r = 0; r < 16; ++r) {
        if (live0<LV>(r)) { x0[r] = __builtin_amdgcn_exp2f(RAW ? __builtin_fmaf(x0[r], C2, -mn) : x0[r] - mn); sum += x0[r]; } else x0[r] = 0.f;
        if (live1<LV>(r)) { x1[r] = __builtin_amdgcn_exp2f(RAW ? __builtin_fmaf(x1[r], C2, -mn) : x1[r] - mn); sum += x1[r]; } else x1[r] = 0.f;
    }
    l += sum;
    bf16x8 pw[4];
    { unsigned w[16];
#pragma unroll
      for (int i = 0; i < 8; ++i) { w[i] = cvtpk(x0[2 * i], x0[2 * i + 1]); w[8 + i] = cvtpk(x1[2 * i], x1[2 * i + 1]); }
#pragma unroll
      for (int k = 0; k < 4; ++k) { typedef unsigned u32x4_ __attribute__((ext_vector_type(4))); u32x4_ t; t.x = w[4 * k]; t.y = w[4 * k + 1]; t.z = w[4 * k + 2]; t.w = w[4 * k + 3]; pw[k] = __builtin_bit_cast(bf16x8, t); } }
    if (pre) k_load_half(kfa, Ksn, 0, lane & 31, hi);
    const LAS unsigned char* vb = Vs + ((lane >> 4) & 1) * 32 + (lane & 3) * 8 + (4 * hi + ((lane & 15) >> 2)) * 64;
#pragma unroll
    for (int d0 = 0; d0 < 2; ++d0)
#pragma unroll
        for (int ks = 0; ks < 4; ++ks) {
            if ((LV == 1 && ks == 3) || (LV == 2 && ks == 0)) continue;
            const s16x4 lo = vtr(vb + d0 * 4096 + ks * 1024), hh = vtr(vb + d0 * 4096 + ks * 1024 + 512);
            const bf16x8 vf = (bf16x8){lo[0], lo[1], lo[2], lo[3], hh[0], hh[1], hh[2], hh[3]};
            o[d0] = __builtin_amdgcn_mfma_f32_32x32x16_bf16(vf, pw[ks], o[d0], 0, 0, 0);
        }
}
__device__ __forceinline__ void o_store(const f32x16 (&o)[2], float l, bf16* orow, int hi) {
    const float inv = __builtin_amdgcn_rcpf(hsum(l));
#pragma unroll
    for (int d0 = 0; d0 < 2; ++d0)
#pragma unroll
        for (int gp = 0; gp < 2; ++gp) {
            unsigned w[2][2];
#pragma unroll
            for (int k = 0; k < 2; ++k) { const int g = 2 * gp + k; w[k][0] = cvtpk(o[d0][4 * g] * inv, o[d0][4 * g + 1] * inv); w[k][1] = cvtpk(o[d0][4 * g + 2] * inv, o[d0][4 * g + 3] * inv); }
            unsigned rcv[2];
#pragma unroll
            for (int i = 0; i < 2; ++i) { const unsigned snd = hi ? w[0][i] : w[1][i];
                auto rr = __builtin_amdgcn_permlane32_swap(snd, snd, false, false); rcv[i] = hi ? rr[0] : rr[1]; }
            v4u st; if (hi) { st.x = rcv[0]; st.y = rcv[1]; st.z = w[1][0]; st.w = w[1][1]; } else { st.x = w[0][0]; st.y = w[0][1]; st.z = rcv[0]; st.w = rcv[1]; }
            *(v4u*)(orow + 32 * d0 + 16 * gp + 8 * hi) = st;
        }
}
#define AT_WAIT_BAR(N) asm volatile("s_waitcnt vmcnt(" #N ")\n\ts_barrier" ::: "memory")

struct UDesc { int kind, b, hh, blk, cq, nw, lo; };
__device__ __forceinline__ UDesc unit_desc(int i, int vcu, int UPW, bool ctx_out) {
    UDesc d; d.kind = -1; d.b = 0; d.hh = 0; d.blk = 0; d.cq = 0; d.nw = 0; d.lo = 0;
    if (i < 2 * UPW) { const int u = vcu * UPW + (i < UPW ? i : i - UPW); if (u >= 1024) return d; d.kind = i < UPW ? 0 : 1; d.b = u >> 8;
        if (d.kind == 0) { d.hh = (u >> 5) & 7; d.blk = u & 31; } else { d.hh = (u >> 7) & 1; d.blk = u & 127; } }
    else if (i == 2 * UPW) { if (!ctx_out || vcu >= 64) return d; d.cq = 1;
        if (vcu < 32) { d.kind = 1; d.b = vcu >> 3; d.hh = (vcu >> 2) & 1; d.blk = vcu & 3; } else { d.kind = 0; d.b = (vcu - 32) >> 3; d.hh = (vcu - 32) & 7; d.blk = 0; } }
    else return d;
    if (!d.cq) {
        if (d.kind == 1) { d.lo = max(0, 2 - d.blk); d.nw = min(4, 129 - d.blk) - d.lo + 1; }
        else { d.lo = min(max(4 * d.blk - 4, 0), 120); d.nw = min(max(4 * d.blk - 1, 0), 120) + 7 - d.lo + 1; }
    }
    return d;
}
__device__ __forceinline__ void tile_src(const UDesc& d, int t, int& row0, int& cols) {
    const int kcol = d.kind == 1 ? C_KA + d.hh * 64 : C_KN + d.hh * 64, vcol = d.kind == 1 ? C_VA + d.hh * 64 : C_VN + d.hh * 64;
    cols = kcol | (vcol << 16);
    if (t < d.nw) row0 = d.kind == 1 ? d.b * SEQ + 64 * d.blk - 128 + 64 * (d.lo + t) : d.b * SEQ + 64 * (d.lo + t);
    else row0 = TL + d.b * CTXL + 64 * (t - d.nw);
}
__device__ __forceinline__ size_t q_row(const UDesc& d, int wid, int r32) {
    if (d.kind == 1) { const int qrel = 32 * (wid >> 2) + r32; return d.cq ? (size_t)TL + (size_t)d.b * CTXL + 64 * d.blk + qrel : (size_t)d.b * SEQ + 64 * d.blk + qrel; }
    const int pair = wid >> 1, c = 32 * (wid & 1) + r32;
    return d.cq ? (size_t)TL + (size_t)d.b * CTXL + 64 * pair + c : (size_t)d.b * SEQ + (size_t)(4 * d.blk + pair) * 64 + c;
}
__device__ __forceinline__ void q_load(const UDesc& d, const bf16* ZMp, int wid, int r32, int hi, bf16x8 (&qr)[4]) {
    const int qcol = d.kind == 1 ? C_QA + (d.hh * 4 + (wid & 3)) * 64 : C_QN + d.hh * 64;
    const bf16* p = ZMp + q_row(d, wid, r32) * ZMC + qcol + 8 * hi;
#pragma unroll
    for (int d0 = 0; d0 < 4; ++d0) qr[d0] = *(const bf16x8*)(p + 16 * d0);
}

template <int VAR = 0>
__device__ __forceinline__ void attn_phase(LAS unsigned char* lds, const bf16* ZMp, bf16* OAp, bf16* OCp, const float* sinkp, const float* rpbl, int vcu, int G, bool ctx_out, int tid, int wid, int lane) {
    const int r32 = lane & 31, hi = lane >> 5;
    const int UPW = (1024 + G - 1) / G, NU = 2 * UPW + 1;
    LAS int* tt = (LAS int*)(lds + LDS_TT);
    int Ttot = 0;
    for (int i = 0; i < NU; ++i) { const UDesc d = unit_desc(i, vcu, UPW, ctx_out); if (d.kind < 0) continue; const int nt = d.nw + 4;
        for (int t = tid; t < nt; t += NWAVES * 64) { int row0, cols; tile_src(d, t, row0, cols); if (Ttot + t < MAXT) { tt[2 * (Ttot + t)] = row0; tt[2 * (Ttot + t) + 1] = cols; } }
        Ttot += nt; }
    if (Ttot > MAXT) Ttot = MAXT;
    if (tid < 8) ((LAS float*)(lds + LDS_TT + MAXT * 8))[tid] = sinkp[tid] * LOG2E;
    for (int u = tid; u < 8 * 480; u += NWAVES * 64) { const int h = u / 480, e = u - 480 * h, dr = e >> 5, dc = e & 31; ((LAS float*)(lds + LDS_TAB))[h * 512 + e] = dc < 31 ? rpbl[(h * 15 + dr) * 31 + dc] * LOG2E : 0.f; }
    asm volatile("s_waitcnt lgkmcnt(0)\n\ts_barrier" ::: "memory");
#define AT_ISSUE(T) do { const int row0_ = __builtin_amdgcn_readfirstlane(tt[2 * (T)]), cols_ = __builtin_amdgcn_readfirstlane(tt[2 * (T) + 1]); \
        tile_issue(lds + ((T) & (NS - 1)) * SLOT, ZMp, (size_t)row0_, cols_ & 0xffff, cols_ >> 16, wid, lane); } while (0)
    for (int T = 0; T < PF && T < Ttot; ++T) AT_ISSUE(T);
    int Tb = 0;
    bf16x8 qn[4];
    { int i0 = 0; UDesc d0 = unit_desc(0, vcu, UPW, ctx_out); while (d0.kind < 0 && i0 + 1 < NU) { ++i0; d0 = unit_desc(i0, vcu, UPW, ctx_out); } if (d0.kind >= 0) q_load(d0, ZMp, wid, r32, hi, qn); }
    for (int i = 0; i < NU; ++i) {
        const UDesc d = unit_desc(i, vcu, UPW, ctx_out); if (d.kind < 0) continue;
        bf16x8 qr[4];
#pragma unroll
        for (int k = 0; k < 4; ++k) qr[k] = qn[k];
        { int j = i + 1; UDesc dn = unit_desc(j, vcu, UPW, ctx_out); while (dn.kind < 0 && j + 1 < NU) { ++j; dn = unit_desc(j, vcu, UPW, ctx_out); } if (dn.kind < 0) dn = d; q_load(dn, ZMp, wid, r32, hi, qn); }
        const int NT = d.nw + 4;
        f32x16 o[2];
#pragma unroll
        for (int r = 0; r < 16; ++r) { o[0][r] = 0.f; o[1][r] = 0.f; }
        float m, l;
        if (d.kind == 1) {
            const int head = d.hh * 4 + (wid & 3), qrel = 32 * (wid >> 2) + r32;
            m = ((const LAS float*)(lds + LDS_TT + MAXT * 8))[head]; l = (hi == 0) ? 1.0f : 0.0f;
            bf16x8 kfa[4];
#pragma unroll
            for (int k = 0; k < 4; ++k) kfa[k] = (bf16x8){0, 0, 0, 0, 0, 0, 0, 0};
            int t = 0;
            do {
                const int T = Tb + t;
                if (T + 2 < Ttot) AT_WAIT_BAR(2); else AT_WAIT_BAR(0);
                if (t == NT - 1) asm volatile("" : "+v"(qn[0]), "+v"(qn[1]), "+v"(qn[2]), "+v"(qn[3]));
                if (VAR != 5 && T + PF < Ttot) AT_ISSUE(T + PF);
                const LAS unsigned char* sl = lds + (T & (NS - 1)) * SLOT;
                const LAS unsigned char* sln = lds + ((T + 1) & (NS - 1)) * SLOT; const bool pre = t + 1 < NT;
                if (t == 0) k_load_half(kfa, sl, 0, r32, hi);
                f32x16 x0, x1; qk_tile(x0, x1, sl, kfa, qr, r32, hi);
                const int j = d.lo + t;
                if (t < d.nw && (j == 0 || j == 4)) {
                    const int dq = qrel + 128 - 64 * j - 4 * hi;
#pragma unroll
                    for (int r = 0; r < 16; ++r) { const int dd = dq - ((r & 3) + 8 * (r >> 2));
                        x0[r] = (dd <= 128 && dd >= -128) ? x0[r] * C2 : -INFINITY; x1[r] = (dd - 32 <= 128 && dd - 32 >= -128) ? x1[r] * C2 : -INFINITY; }
                    sm_pv<false, 0, VAR>(x0, x1, m, l, o, sl + 8192, lane, hi, kfa, sln, pre);
                } else sm_pv<true, 0, VAR>(x0, x1, m, l, o, sl + 8192, lane, hi, kfa, sln, pre);
            } while (++t < NT);
            o_store(o, l, OAp + q_row(d, wid, r32) * BW + head * 64, hi);
        } else {
            const int half = wid & 1, c = 32 * half + r32, r = 4 * d.blk + (wid >> 1);
            const int r0w = min(max(r - 4, 0), 120), c0 = min(max(c - 8, 0), 48);
            const LAS float* tab = (const LAS float*)(lds + LDS_TAB + d.hh * 2048);
            unsigned vm = 0u;
#pragma unroll
            for (int r_ = 0; r_ < 16; ++r_) { const int kc = (r_ & 3) + 8 * (r_ >> 2) + 4 * hi; vm |= ((unsigned)(kc - c0) < 16u ? 1u : 0u) << r_; vm |= ((unsigned)(kc + 32 - c0) < 16u ? 1u : 0u) << (16 + r_); }
            m = -1e30f; l = 0.f;
            bf16x8 kfa[4];
#pragma unroll
            for (int k = 0; k < 4; ++k) kfa[k] = (bf16x8){0, 0, 0, 0, 0, 0, 0, 0};
            int t = 0;
            do {
                const int T = Tb + t;
                if (T + 2 < Ttot) AT_WAIT_BAR(2); else AT_WAIT_BAR(0);
                if (t == NT - 1) asm volatile("" : "+v"(qn[0]), "+v"(qn[1]), "+v"(qn[2]), "+v"(qn[3]));
                if (VAR != 5 && T + PF < Ttot) AT_ISSUE(T + PF);
                const int kr = d.lo + t;
                const bool use = !(t < d.nw && (kr < r0w || kr > r0w + 7));
                const bool usen = !(t + 1 < d.nw && (kr + 1 < r0w || kr + 1 > r0w + 7));
                const LAS unsigned char* sl = lds + (T & (NS - 1)) * SLOT; const LAS unsigned char* sln = lds + ((T + 1) & (NS - 1)) * SLOT; const bool pre = usen && t + 1 < NT;
                if (!use) { if (pre) k_load_half(kfa, sln, 0, r32, hi); continue; }
                if (t == 0) k_load_half(kfa, sl, 0, r32, hi);
                f32x16 x0, x1; qk_tile(x0, x1, sl, kfa, qr, r32, hi);
                if (t < d.nw) {
                    const LAS float* tb = tab + (kr - r + 7) * 32 + (4 * hi - c + 15);
                    if (half == 0) {
                        float b0[16], b1[4];
#pragma unroll
                        for (int r_ = 0; r_ < 16; ++r_) { const int rr = (r_ & 3) + 8 * (r_ >> 2); b0[r_] = tb[rr]; if (r_ < 4) b1[r_] = tb[rr + 32]; }
#pragma unroll
                        for (int r_ = 0; r_ < 16; ++r_) {
                            x0[r_] = ((vm >> r_) & 1u) ? __builtin_fmaf(x0[r_], C2, b0[r_]) : -INFINITY;
                            if (r_ < 4) x1[r_] = ((vm >> (16 + r_)) & 1u) ? __builtin_fmaf(x1[r_], C2, b1[r_]) : -INFINITY; }
                        sm_pv<false, 1, VAR>(x0, x1, m, l, o, sl + 8192, lane, hi, kfa, sln, pre);
                    } else {
                        float b0[4], b1[16];
#pragma unroll
                        for (int r_ = 0; r_ < 16; ++r_) { const int rr = (r_ & 3) + 8 * (r_ >> 2); if (r_ >= 12) b0[r_ - 12] = tb[rr]; b1[r_] = tb[rr + 32]; }
#pragma unroll
                        for (int r_ = 0; r_ < 16; ++r_) {
                            if (r_ >= 12) x0[r_] = ((vm >> r_) & 1u) ? __builtin_fmaf(x0[r_], C2, b0[r_ - 12]) : -INFINITY;
                            x1[r_] = ((vm >> (16 + r_)) & 1u) ? __builtin_fmaf(x1[r_], C2, b1[r_]) : -INFINITY; }
                        sm_pv<false, 2, VAR>(x0, x1, m, l, o, sl + 8192, lane, hi, kfa, sln, pre);
                    }
                } else sm_pv<true, 0, VAR>(x0, x1, m, l, o, sl + 8192, lane, hi, kfa, sln, pre);
            } while (++t < NT);
            o_store(o, l, OCp + q_row(d, wid, r32) * BW + d.hh * 64, hi);
        }
        Tb += NT;
    }
    AT_WAIT_BAR(0);
#undef AT_ISSUE
}
}

constexpr int PH_PER_LAYER = 17, NPHASES = 1 + DEPTH * PH_PER_LAYER;
struct Args { const float* in[23]; float* out; unsigned char* ws; int ph_lo, ph_hi; };
typedef __attribute__((address_space(4))) const Args CArgs;
__global__ void __launch_bounds__(NWAVES * 64, 2) mk_fwd(Args args) {
    extern __shared__ __attribute__((aligned(16))) unsigned char lds[];
    Frame F;
    F.lds = (LAS unsigned char*)lds;
    F.MISC = (volatile LAS unsigned*)(F.lds + MISC_OFF);
    F.G = gridDim.x; { const int bx = blockIdx.x; F.vcu = (F.G % 8 == 0) ? (bx % 8) * (F.G / 8) + bx / 8 : bx; }
    F.ctl = (unsigned*)(args.ws + WS_CTL);
    for (int u = threadIdx.x; u < (ROPEL_OFF - LDSCTL_OFF) / 4; u += NWAVES * 64) ((LAS unsigned*)(F.lds + LDSCTL_OFF))[u] = 0u;
    for (int u = threadIdx.x; u < 192 * 16; u += NWAVES * 64) { const int idx = u >> 4, i = u & 15; const float pos = (float)(idx < 128 ? idx : idx - 128);
        const float inv = 1.0f / powf(10000.0f, (float)(2 * i) / 32.0f); const float ang = pos * inv;
        ((LAS float*)(F.lds + ROPEL_OFF))[2 * u] = cosf(ang); ((LAS float*)(F.lds + ROPEL_OFF))[2 * u + 1] = sinf(ang); }
    { int wv_ = __builtin_amdgcn_readfirstlane((int)(threadIdx.x >> 6)); asm volatile("" : "+s"(wv_)); F.wv = wv_; }
    __syncthreads();
    const int lo = args.ph_lo, hi = args.ph_hi;
    const bool fused = (hi - lo) > 1;
    XcdBarrier bar; bar.bar = F.ctl + CW_BAR; bar.x = 0; bar.st = nullptr; bar.w = F.wv;
    if (fused) { bar = xcd_barrier_post(F.ctl + CW_BAR, F.MISC + 8); bar.w = F.wv; }
#ifndef MK_MASK
#define MK_MASK 0xFFFFFFFFu
#endif
#define SLOT(k) ((k) == 0 ? 0 : (((k) - 1) % PH_PER_LAYER) + 1)
#define IN(k) (((MK_MASK >> SLOT(k)) & 1u) && lo <= (k) && (k) < hi)
#define GRID_BAR() do { if (fused) xcd_barrier(bar); } while (0)
    const int NGW = F.G * NWAVES;
#define PHASE_ENTER() GAS unsigned char* wsg_ = (GAS unsigned char*)args.ws; asm volatile("" : "+s"(wsg_)); unsigned char* ws = (unsigned char*)wsg_; float* outp = (float*)(GAS float*)args.out; (void)outp; const CArgs* ka = (const CArgs*)__builtin_amdgcn_kernarg_segment_ptr(); asm volatile("" : "+s"(ka)); \
    int tid_ = (F.wv << 6) | mk_lane(); asm volatile("" : "+v"(tid_)); const int lane = tid_ & 63; const int wave = __builtin_amdgcn_readfirstlane(tid_ >> 6); const int gw = F.vcu * NWAVES + wave; (void)gw; (void)lane; (void)ws; (void)ka;
#define INP(i) ((const float*)(const GAS float*)ka->in[i])
#define MOD ((float*)(GAS float*)(ws + WS_MOD))
#define ROPE ((float*)(GAS float*)(ws + WS_ROPE))
#define SLABCNT ((int*)(GAS int*)(ws + WS_SLABCNT))
#define PCUM ((int*)(GAS int*)(ws + WS_PCUM))
#define TOKER ((int*)(GAS int*)(ws + WS_TOKER))
#define TOKG ((float*)(GAS float*)(ws + WS_TOKG))
#define TOKPOS ((int*)(GAS int*)(ws + WS_TOKPOS))
#define HCTX ((float*)(GAS float*)(ws + WS_HCTX))
#define RS ((bf16*)(GAS bf16*)(ws + WS_RS))
#define W_IN ((bf16*)(GAS bf16*)(ws + WS_WIN))
#define W_BR ((bf16*)(GAS bf16*)(ws + WS_WBR))
#define W_OUT ((bf16*)(GAS bf16*)(ws + WS_WOUT))
#define W_GUD ((bf16*)(GAS bf16*)(ws + WS_WGUD))
#define W_DND ((bf16*)(GAS bf16*)(ws + WS_WDND))
#define W_GUM8 ((unsigned char*)(GAS unsigned char*)(ws + WS_WGUM))
#define W_DNM8 ((unsigned char*)(GAS unsigned char*)(ws + WS_WDNM))
#define HX ((bf16*)(GAS bf16*)(ws + WS_HX))
#define ZM ((bf16*)(GAS bf16*)(ws + WS_ZM))
#define ZG ((bf16*)(GAS bf16*)(ws + WS_ZG))
#define OA ((bf16*)(GAS bf16*)(ws + WS_O))
#define OB (OA + (size_t)TA * BW)
#define OC (OA + (size_t)2 * TA * BW)
#define SB ((float*)(GAS float*)(ws + WS_ZM))
#define Y16 ((bf16*)(GAS bf16*)(ws + WS_ZG))
#define HD ((bf16*)(GAS bf16*)(ws + WS_ZM))
#define XG ((bf16*)(GAS bf16*)(ws + WS_XG))
#define HM8 ((unsigned char*)(GAS unsigned char*)(ws + WS_HM))
#define XG8 ((unsigned char*)(GAS unsigned char*)(ws + WS_XG8))
#define HX8 ((unsigned char*)(GAS unsigned char*)(ws + WS_HX8))
#define W_ING8 ((unsigned char*)(GAS unsigned char*)(ws + WS_WING8))

    if (IN(0)) {
        PHASE_ENTER();
        {
            LAS float* scv = (LAS float*)(F.lds + RING_OFF);
            LAS float* red = scv + 5 * 1024;
            for (int u = tid_; u < 5 * 1024; u += NWAVES * 64) { const int bb = u >> 10, k = u & 1023; const float cv = bb < 4 ? INP(I_C)[bb * 1024 + k] : INP(I_CCTX)[k]; scv[u] = cv / (1.0f + __expf(-cv)); }
            __syncthreads();
            for (int it = blockIdx.x; it < 2 * 96; it += F.G) {
                const int l = it / 96, n = (it % 96) * 64 + lane;
                const float* wp = INP(I_WADA) + (size_t)l * D * 6144 + n;
                float a0 = 0.f, a1 = 0.f, a2 = 0.f, a3 = 0.f, a4 = 0.f;
                const int kb = wave * 128;
#pragma unroll 16
                for (int k = 0; k < 128; ++k) { const float w = wp[(size_t)(kb + k) * 6144];
                    a0 += scv[kb + k] * w; a1 += scv[1024 + kb + k] * w; a2 += scv[2048 + kb + k] * w; a3 += scv[3072 + kb + k] * w; a4 += scv[4096 + kb + k] * w; }
                red[(wave * 5 + 0) * 64 + lane] = a0; red[(wave * 5 + 1) * 64 + lane] = a1; red[(wave * 5 + 2) * 64 + lane] = a2; red[(wave * 5 + 3) * 64 + lane] = a3; red[(wave * 5 + 4) * 64 + lane] = a4;
                __syncthreads();
                if (tid_ < 320) { const int bb = tid_ >> 6, nn = tid_ & 63; float s = 0.f;
#pragma unroll
                    for (int w = 0; w < 8; ++w) s += red[(w * 5 + bb) * 64 + nn];
                    const int col = (it % 96) * 64 + nn;
                    MOD[((size_t)l * 5 + bb) * 6144 + col] = s + INP(I_BADA)[l * 6144 + col]; }
                __syncthreads();
            }
        }
        __syncthreads();
        {
            LAS float* scr = (LAS float*)(F.lds + RING_OFF + wave * 16384);
            constexpr int I_IN = (D / 64) * (INC / 32), I_BR = (BW / 64) * (D / 32), I_OUT = (D / 64) * (D / 32), I_GUD = (D / 64) * (2 * FFD / 32), I_DND = (FFD / 64) * (D / 32),
                          I_GUM = (D / 64) * (2 * FFE / 32), I_DNM = (FFE / 64) * (D / 32);
            constexpr int NITEMS = 2 * I_IN + 6 * I_BR + 2 * I_OUT + I_GUD + I_DND + NE * I_GUM + NE * I_DNM;
            for (int it = gw; it < NITEMS; it += NGW) {
                int r = it;
                if (r < 2 * I_IN) { const int l = r / I_IN, it2 = r % I_IN, n0 = 32 * (it2 % (INC / 32));
                    if (MK_GATE_F8 == 2) { tr_item8(INP(I_WIN) + (size_t)l * D * INC, INC, 64 * (it2 / (INC / 32)), n0, (unsigned char*)W_IN + (size_t)l * INC * D, D, n0, SC_WGU, scr, lane); continue; }
                    if (!MK_GATE_F8 || n0 < ZMC) tr_matrix_item(INP(I_WIN) + (size_t)l * D * INC, D, INC, 0, W_IN + (size_t)l * INC * D, it2, scr, lane);
                    if (MK_GATE_F8 && n0 >= ZMC) tr_item8(INP(I_WIN) + (size_t)l * D * INC, INC, 64 * (it2 / (INC / 32)), n0, W_ING8 + (size_t)l * ZGC * D, D, n0 - ZMC, SC_WGU, scr, lane);
                    continue; } r -= 2 * I_IN;
                if (r < 6 * I_BR) { const int q = r / I_BR; tr_matrix_item(INP(I_WBRANCH) + (size_t)q * BW * D, BW, D, 0, W_BR + (size_t)q * D * BW, r % I_BR, scr, lane); continue; } r -= 6 * I_BR;
                if (r < 2 * I_OUT) { const int l = r / I_OUT; tr_matrix_item(INP(I_WOUT) + (size_t)l * D * D, D, D, 0, W_OUT + (size_t)l * D * D, r % I_OUT, scr, lane); continue; } r -= 2 * I_OUT;
                if (r < I_GUD) { if (MK_DENSE_F8 >= 2) tr_matrix_item8(INP(I_WGUD), D, 2 * FFD, FFD, (unsigned char*)W_GUD, SC_WGU, r, scr, lane); else tr_matrix_item(INP(I_WGUD), D, 2 * FFD, FFD, W_GUD, r, scr, lane); continue; } r -= I_GUD;
                if (r < I_DND) { if (MK_DENSE_F8 >= 1) tr_matrix_item8(INP(I_WDND), FFD, D, 0, (unsigned char*)W_DND, SC_WDN, r, scr, lane); else tr_matrix_item(INP(I_WDND), FFD, D, 0, W_DND, r, scr, lane); continue; } r -= I_DND;
                if (r < NE * I_GUM) { const int e = r / I_GUM; tr_matrix_item8(INP(I_WGUM) + (size_t)e * D * 2 * FFE, D, 2 * FFE, FFE, W_GUM8 + (size_t)e * 2 * FFE * D, SC_WGU, r % I_GUM, scr, lane); continue; } r -= NE * I_GUM;
                { const int e = r / I_DNM; tr_matrix_item8(INP(I_WDNM) + (size_t)e * FFE * D, FFE, D, 0, W_DNM8 + (size_t)e * D * FFE, SC_WDN, r % I_DNM, scr, lane); }
            }
        }
        GRID_BAR();
    }

    for (int l = 0; l < DEPTH; ++l) {
        const int pb = 1 + l * PH_PER_LAYER;
        const bool ctx_out = (l < DEPTH - 1);
        const bool moe = (l & 1) != 0;
        const int rows_out = ctx_out ? TA : TL;
#define modl (MOD + (size_t)l * 5 * 6144)
#define xsrc_lat ((l == 0) ? INP(I_X) : (const float*)outp)
#define xsrc_ctx ((l == 0) ? INP(I_CTX) : (const float*)HCTX)

        if (IN(pb + 0) && l == 0) {
            PHASE_ENTER();
            const int chunk = (TL + NGW - 1) / NGW;
#define P1_ROW(t) do { const float* xr = (t) < TL ? xsrc_lat + (size_t)(t) * D : xsrc_ctx + (size_t)((t) - TL) * D; \
                f32x4 x[4], h[4]; row_load(xr, lane, x); const float rr = row_rrms(x); row_normmod(x, rr, gpre, sh, sc, h); if (MK_GATE_F8 < 2) row_store_bf16(HX + (size_t)(t) * D, lane, h); if (MK_GATE_F8) row_store_fp8(HX8 + (size_t)(t) * D, lane, h, SC_XG); } while (0)
            f32x4 gpre[4], sh[4], sc[4]; vec_load(INP(I_GPREMIX) + l * D, lane, gpre);
            for (int t0 = min(gw * chunk, TL), t1 = min(TL, t0 + chunk); t0 < t1; ) { const int bb = t0 >> 13, te = min(t1, (bb + 1) << 13); const float* md = modl + (size_t)bb * 6144;
                vec_load(md, lane, sh); vec_load(md + 1024, lane, sc);
                for (int t = t0; t < te; ++t) P1_ROW(t);
                t0 = te; }
            { const float* md = modl + (size_t)4 * 6144; vec_load(md, lane, sh); vec_load(md + 1024, lane, sc); for (int t = TL + gw; t < TA; t += NGW) P1_ROW(t); }
#undef P1_ROW
            GRID_BAR();
        }
        if (IN(pb + 1)) {
            PHASE_ENTER();
#if MK_GATE_F8 == 2
            {
                pg8::Gemm g{(const bf16*)HX8, (const bf16*)((unsigned char*)W_IN + (size_t)l * INC * D), TA, ZMC, D}; pg8::StaticOrder S; S.init(TA, ZMC, F.G, (int)blockIdx.x, MK_WGM);
                pg8::EpiZT<true> E{ZM, ZG, ROPE, TL / 256, INP(I_BGATE) + (size_t)l * 3 * D, 0, 1.0f / (SC_XG * SC_WGU)};
                pg8::gemm_phase<pg8::EpiZT<true>, pg8::StaticOrder, PG8_ALIGN, PG8_SP2>(F.lds + RING_OFF, g, S, E, F.wv);
            }
            {
                pg8::Gemm g{(const bf16*)HX8, (const bf16*)((unsigned char*)W_IN + (size_t)l * INC * D + (size_t)ZMC * D), rows_out, ZGC, D}; pg8::StaticOrder S; S.init(rows_out, ZGC, F.G, (int)blockIdx.x, MK_WGM);
                pg8::EpiZT<true> E{ZM, ZG, ROPE, TL / 256, INP(I_BGATE) + (size_t)l * 3 * D, ZMC / 256, 1.0f / (SC_XG * SC_WGU)};
                pg8::gemm_phase<pg8::EpiZT<true>, pg8::StaticOrder, PG8_ALIGN, PG8_SP2>(F.lds + RING_OFF, g, S, E, F.wv);
            }
#elif MK_GATE_F8
            {
                pg8::Gemm g{HX, W_IN + (size_t)l * INC * D, TA, ZMC, D}; pg8::StaticOrder S; S.init(TA, ZMC, F.G, (int)blockIdx.x, MK_WGM);
                pg8::EpiZM E{ZM, (const LAS float*)(F.lds + ROPEL_OFF), TL / 256};
                pg8::gemm_phase<pg8::EpiZM, pg8::StaticOrder, PG8_ALIGN, PG8_SP2>(F.lds + RING_OFF, g, S, E, F.wv);
            }
            {
                pg8::Gemm g{(const bf16*)HX8, (const bf16*)(W_ING8 + (size_t)l * ZGC * D), rows_out, ZGC, D}; pg8::StaticOrder S; S.init(rows_out, ZGC, F.G, ((int)blockIdx.x + 68) % F.G, MK_WGM);
                pg8::EpiZGate E{(unsigned char*)ZG, INP(I_BGATE) + (size_t)l * 3 * D, 1.0f / (SC_XG * SC_WGU)};
                pg8::gemm_phase<pg8::EpiZGate, pg8::StaticOrder, PG8_ALIGN, PG8_SP2>(F.lds + RING_OFF, g, S, E, F.wv);
            }
#else
            pg8::Gemm g{HX, W_IN + (size_t)l * INC * D, TA, INC, D}; pg8::StaticOrder S; S.init(TA, INC, F.G, (int)blockIdx.x, MK_WGM);
            pg8::EpiZ E{ZM, ZG, ROPE, TL / 256, INP(I_BGATE) + (size_t)l * 3 * D, 0, 1.0f};
            pg8::gemm_phase<pg8::EpiZ, pg8::StaticOrder, PG8_ALIGN, PG8_SP2>(F.lds + RING_OFF, g, S, E, F.wv);
#endif
            GRID_BAR();
        }
        if (IN(pb + 3)) {
            PHASE_ENTER();
            const float* sinkp = INP(I_SINK) + l * 8; const float* rpbp = INP(I_RPB) + (size_t)l * 8 * 15 * 31;
            const float* cw = INP(I_CONVW) + (size_t)l * 3 * BW;
            {
                const int ch = 8 * lane;
                float cwr[3][8];
#pragma unroll
                for (int k = 0; k < 3; ++k) { const f32x4 a = *(const f32x4*)(cw + k * BW + ch), b = *(const f32x4*)(cw + k * BW + ch + 4); cwr[k][0] = a.x; cwr[k][1] = a.y; cwr[k][2] = a.z; cwr[k][3] = a.w; cwr[k][4] = b.x; cwr[k][5] = b.y; cwr[k][6] = b.z; cwr[k][7] = b.w; }
#define CONV_U(row, u) do { const bf16* zp_ = ZM + (size_t)(row) * ZMC; const v4u a_ = *(const v4u*)(zp_ + C_UX + ch), g_ = *(const v4u*)(zp_ + C_GC + ch); \
                    u[0] = bflo(a_.x) * bflo(g_.x); u[1] = bfhi(a_.x) * bfhi(g_.x); u[2] = bflo(a_.y) * bflo(g_.y); u[3] = bfhi(a_.y) * bfhi(g_.y); \
                    u[4] = bflo(a_.z) * bflo(g_.z); u[5] = bfhi(a_.z) * bfhi(g_.z); u[6] = bflo(a_.w) * bflo(g_.w); u[7] = bfhi(a_.w) * bfhi(g_.w); } while (0)
#define CONV_Z(u) do { _Pragma("unroll") for (int q_ = 0; q_ < 8; ++q_) u[q_] = 0.f; } while (0)
#define CONV_OUT(t) do { const v4u gbv = *(const v4u*)(ZM + (size_t)(t) * ZMC + C_GB + ch); \
                    const float gb[8] = {bflo(gbv.x), bfhi(gbv.x), bflo(gbv.y), bfhi(gbv.y), bflo(gbv.z), bfhi(gbv.z), bflo(gbv.w), bfhi(gbv.w)}; float o[8]; \
                    _Pragma("unroll") for (int q = 0; q < 8; ++q) o[q] = gb[q] * (cwr[0][q] * um[q] + cwr[1][q] * uc[q] + cwr[2][q] * up[q]); \
                    v4u w; w.x = pk2(o[0], o[1]); w.y = pk2(o[2], o[3]); w.z = pk2(o[4], o[5]); w.w = pk2(o[6], o[7]); \
                    *(v4u*)(OB + (size_t)(t) * BW + ch) = w; } while (0)
                const int cchunk = (TL + NGW - 1) / NGW;
                const int t0 = min(gw * cchunk, TL), t1 = min(TL, t0 + cchunk);
                if (t0 < t1) {
                    float um[8], uc[8], up[8];
                    if ((t0 & (SEQ - 1)) > 0) CONV_U(t0 - 1, um); else CONV_Z(um);
                    CONV_U(t0, uc);
                    for (int t = t0; t < t1; ++t) {
                        const int s = t & (SEQ - 1);
                        if (s == 0) CONV_Z(um);
                        if (s + 1 < SEQ) CONV_U(t + 1, up); else CONV_Z(up);
                        CONV_OUT(t);
#pragma unroll
                        for (int q = 0; q < 8; ++q) { um[q] = uc[q]; uc[q] = up[q]; }
                    }
                }
                for (int t = TL + gw; t < rows_out; t += NGW) {
                    const int s = (t - TL) & (CTXL - 1);
                    float um[8], uc[8], up[8];
                    if (s > 0) CONV_U(t - 1, um); else CONV_Z(um);
                    CONV_U(t, uc);
                    if (s + 1 < CTXL) CONV_U(t + 1, up); else CONV_Z(up);
                    CONV_OUT(t);
                }
#undef CONV_U
#undef CONV_Z
#undef CONV_OUT
            }
            at::attn_phase(F.lds + RING_OFF, ZM, OA, OC, sinkp, rpbp, F.vcu, F.G, ctx_out, tid_, wave, lane);
#ifdef MK_ATTN_PROBE
            at::attn_phase<MK_ATTN_PROBE>(F.lds + RING_OFF, ZM, (bf16*)(GAS bf16*)(ws + WS_HX), (bf16*)(GAS bf16*)(ws + WS_HX) + (size_t)TA * BW, sinkp, rpbp, F.vcu, F.G, ctx_out, tid_, wave, lane);
#endif
            GRID_BAR();
        }
        if (IN(pb + 4)) {
            PHASE_ENTER();
            pg8::Gemm g{OA, W_BR + (size_t)l * 3 * D * BW, rows_out, D, BW};
            pg8::BranchOrder3 S; S.so.init(rows_out, D, F.G, (int)blockIdx.x, MK_WGM);
            pg8::EpiBranchAcc E{HX, ZG};
            pg8::gemm_phase<pg8::EpiBranchAcc, pg8::BranchOrder3, PG8_ALIGN, PG8_SP2>(F.lds + RING_OFF, g, S, E, F.wv);
            GRID_BAR();
        }
        if (IN(pb + 5)) {
            PHASE_ENTER();
            pg8::Gemm g{HX, W_OUT + (size_t)l * D * D, rows_out, D, D}; pg8::StaticOrder S; S.init(rows_out, D, F.G, (int)blockIdx.x, MK_WGM);
            pg8::EpiBf16P E{Y16, D};
            pg8::gemm_phase<pg8::EpiBf16P, pg8::StaticOrder, PG8_ALIGN, PG8_SP2>(F.lds + RING_OFF, g, S, E, F.wv);
            GRID_BAR();
        }
        if (IN(pb + 6)) {
            PHASE_ENTER();
            if (!moe) {
                const int chunk = (TL + NGW - 1) / NGW;
#define P6_ROW(t) do { f32x4 x[4], y[4], h[4]; \
                    if (l == 0) row_load((t) < TL ? INP(I_X) + (size_t)(t) * D : INP(I_CTX) + (size_t)((t) - TL) * D, lane, x); else row_load_bf16(RS + (size_t)(t) * D, lane, x); \
                    row_load_bf16(Y16 + (size_t)(t) * D, lane, y); const float ry = row_rrms(y); \
                    _Pragma("unroll") for (int j = 0; j < 4; ++j) x[j] = x[j] + gt[j] * (y[j] * ry * gpo[j]); \
                    row_store_bf16(RS + (size_t)(t) * D, lane, x); const float rx = row_rrms(x); row_normmod(x, rx, gpre, sh, sc, h); \
                    if (MK_DENSE_F8 >= 2) row_store_fp8((unsigned char*)HX + (size_t)(t) * D, lane, h, SC_XG); else row_store_bf16(HX + (size_t)(t) * D, lane, h); } while (0)
                f32x4 gpo[4], gt[4], gpre[4], sh[4], sc[4]; vec_load(INP(I_GPOSTMIX) + l * D, lane, gpo); vec_load(INP(I_GPREFFN) + l * D, lane, gpre);
                for (int t0 = min(gw * chunk, TL), t1 = min(TL, t0 + chunk); t0 < t1; ) { const int bb = t0 >> 13, te = min(t1, (bb + 1) << 13); const float* md = modl + (size_t)bb * 6144;
                    vec_load(md + 2048, lane, gt); vec_load(md + 3072, lane, sh); vec_load(md + 4096, lane, sc);
                    for (int t = t0; t < te; ++t) P6_ROW(t);
                    t0 = te; }
                if (rows_out > TL) { const float* md = modl + (size_t)4 * 6144; vec_load(md + 2048, lane, gt); vec_load(md + 3072, lane, sh); vec_load(md + 4096, lane, sc); for (int t = TL + gw; t < rows_out; t += NGW) P6_ROW(t); }
#undef P6_ROW
            } else {
                LAS int* sel = (LAS int*)(F.lds + RING_OFF);
                LAS int* rnk = sel + 256;
                LAS f32x4* wrT = (LAS f32x4*)(F.lds + RING_OFF + 4096);
                const float* wr = INP(I_WROUTER) + (size_t)(l >> 1) * D * NE; const float* br = INP(I_BROUTER) + (l >> 1) * NE;
                for (int u = tid_; u < D * NE; u += NWAVES * 64) ((LAS float*)wrT)[(u & 7) * D + (u >> 3)] = wr[u];
                LDS_WAIT(); __syncthreads();
                f32x4 gpo[4], gt[4], gpre[4], sh[4], sc[4]; vec_load(INP(I_GPOSTMIX) + l * D, lane, gpo); vec_load(INP(I_GPREFFN) + l * D, lane, gpre);
                for (int slab = F.vcu; slab < TL / 128; slab += F.G) {
                    { const float* md = modl + (size_t)((slab * 128) >> 13) * 6144; vec_load(md + 2048, lane, gt); vec_load(md + 3072, lane, sh); vec_load(md + 4096, lane, sc); }
                    for (int i = 0; i < 16; ++i) {
                        const int tl_ = wave * 16 + i, t = slab * 128 + tl_;
                        f32x4 x[4], y[4], h[4]; if (l == 0) row_load(INP(I_X) + (size_t)t * D, lane, x); else row_load_bf16(RS + (size_t)t * D, lane, x);
                        row_load_bf16(Y16 + (size_t)t * D, lane, y);
                        const float ry = row_rrms(y);
#pragma unroll
                        for (int j = 0; j < 4; ++j) x[j] = x[j] + gt[j] * (y[j] * ry * gpo[j]);
                        row_store_bf16(RS + (size_t)t * D, lane, x);
                        const float rx = row_rrms(x);
                        row_normmod(x, rx, gpre, sh, sc, h);
                        row_store_fp8((unsigned char*)HX + (size_t)t * D, lane, h, SC_XG);
                        float lg[8];
#pragma unroll
                        for (int e = 0; e < 8; ++e) lg[e] = 0.f;
#pragma unroll
                        for (int e = 0; e < 8; ++e)
#pragma unroll
                            for (int j = 0; j < 4; ++j) { const f32x4 w4 = wrT[e * (D / 4) + 2 * (64 * (j >> 1) + lane) + (j & 1)]; lg[e] += (h[j].x * w4.x + h[j].y * w4.y) + (h[j].z * w4.z + h[j].w * w4.w); }
#pragma unroll
                        for (int e = 0; e < 8; ++e) lg[e] = wave_sum(lg[e]) + br[e];
                        int e1 = 0; float v1 = lg[0];
#pragma unroll
                        for (int e = 1; e < 8; ++e) if (lg[e] > v1) { v1 = lg[e]; e1 = e; }
                        int e2 = -1; float v2 = -INFINITY;
#pragma unroll
                        for (int e = 0; e < 8; ++e) if (e != e1 && lg[e] > v2) { v2 = lg[e]; e2 = e; }
                        const float ex = __expf(v2 - v1), g1 = 1.0f / (1.0f + ex), g2 = ex / (1.0f + ex);
                        if (lane == 0) { sel[2 * tl_] = e1; sel[2 * tl_ + 1] = e2; TOKG[2 * (size_t)t] = g1; TOKG[2 * (size_t)t + 1] = g2; }
                    }
                    LDS_WAIT(); __syncthreads();
                    if (tid_ < 8) { int cnt = 0; for (int q = 0; q < 256; ++q) if (sel[q] == tid_) { rnk[q] = cnt; ++cnt; } SLABCNT[slab * 8 + tid_] = cnt; }
                    LDS_WAIT(); __syncthreads();
                    if (tid_ < 256) TOKER[(size_t)slab * 256 + tid_] = sel[tid_] | (rnk[tid_] << 8);
                    LDS_WAIT(); __syncthreads();
                }
            }
            GRID_BAR();
        }
        if (IN(pb + 7) && moe) {
            PHASE_ENTER();
            LAS int* scn = (LAS int*)(F.lds + RING_OFF);
            LAS int* pst = scn + 2048;
            for (int u = tid_; u < 2048; u += NWAVES * 64) scn[u] = SLABCNT[u];
            LDS_WAIT(); __syncthreads();
            if (tid_ < 8) { int run = 0; for (int q = 0; q < 256; ++q) { const int c = scn[q * 8 + tid_]; scn[q * 8 + tid_] = run; run += c; } pst[8 + tid_] = run; }
            LDS_WAIT(); __syncthreads();
            if (tid_ == 0) { int pan = 0; for (int e = 0; e < 8; ++e) { pst[e] = pan * 256; if (blockIdx.x == 0) PCUM[e] = pan; pan += (pst[8 + e] + 255) >> 8; } if (blockIdx.x == 0) PCUM[8] = pan; }
            LDS_WAIT(); __syncthreads();
            LAS int* posl = pst + 16;
            for (int slab = F.vcu; slab < TL / 128; slab += F.G) {
                if (tid_ < 256) { const int er = TOKER[(size_t)slab * 256 + tid_]; const int e = er & 255, rk = er >> 8; const int pos = pst[e] + scn[slab * 8 + e] + rk;
                    posl[tid_] = pos; TOKPOS[(size_t)slab * 256 + tid_] = pos; }
                LDS_WAIT(); __syncthreads();
                const v4u* srcb = (const v4u*)((const unsigned char*)HX + (size_t)slab * 128 * D);
#pragma unroll 4
                for (int i = 0; i < 16; ++i) { const int id = i * 512 + tid_, tk = id >> 6, chk = id & 63;
                    const v4u o = srcb[(size_t)tk * 64 + chk];
                    ((v4u*)(XG8 + (size_t)posl[2 * tk] * D))[chk] = o; ((v4u*)(XG8 + (size_t)posl[2 * tk + 1] * D))[chk] = o; }
                LDS_WAIT(); __syncthreads();
            }
            GRID_BAR();
        }
        if (IN(pb + 8) && !moe) {
            PHASE_ENTER();
            pg8::Gemm g{HX, W_GUD, rows_out, 2 * FFD, D}; pg8::StaticOrder S; S.init(rows_out, 2 * FFD, F.G, (int)blockIdx.x, MK_WGM);
#if MK_DENSE_F8 >= 2
            pg8::EpiSwiglu8T<true> E{(unsigned char*)HD, FFD, 1.0f / (SC_XG * SC_WGU), SC_H};
            pg8::gemm_phase<pg8::EpiSwiglu8T<true>, pg8::StaticOrder, PG8_ALIGN, PG8_SP2>(F.lds + RING_OFF, g, S, E, F.wv);
#elif MK_DENSE_F8 == 1
            pg8::EpiSwiglu8T<false> E{(unsigned char*)HD, FFD, 1.0f, SC_H};
            pg8::gemm_phase<pg8::EpiSwiglu8T<false>, pg8::StaticOrder, PG8_ALIGN, PG8_SP2>(F.lds + RING_OFF, g, S, E, F.wv);
#else
            pg8::EpiSwiglu E{HD, FFD};
            pg8::gemm_phase<pg8::EpiSwiglu, pg8::StaticOrder, PG8_ALIGN, PG8_SP2>(F.lds + RING_OFF, g, S, E, F.wv);
#endif
            GRID_BAR();
        }
        if (IN(pb + 9) && !moe) {
            PHASE_ENTER();
            pg8::Gemm g{HD, W_DND, rows_out, D, FFD}; pg8::StaticOrder S; S.init(rows_out, D, F.G, (int)blockIdx.x, MK_WGM);
#if MK_DENSE_F8 >= 1
            pg8::EpiBf16PS8 E{Y16, D, 1.0f / (SC_H * SC_WDN)};
            pg8::gemm_phase<pg8::EpiBf16PS8, pg8::StaticOrder, PG8_ALIGN, PG8_SP2>(F.lds + RING_OFF, g, S, E, F.wv);
#else
            pg8::EpiBf16P E{Y16, D};
            pg8::gemm_phase<pg8::EpiBf16P, pg8::StaticOrder, PG8_ALIGN, PG8_SP2>(F.lds + RING_OFF, g, S, E, F.wv);
#endif
            GRID_BAR();
        }
        if (moe) {
            for (int ck = 0; ck < NCHUNK; ++ck) {
                if (IN(pb + 10 + 2 * ck)) {
                    PHASE_ENTER();
                    pg8::MoeOrder S; S.nN = 2 * FFE / 256; S.G = F.G; S.c = F.vcu; S.p_lo = ck * PCH;
#pragma unroll
                    for (int k = 0; k < 8; ++k) S.pc[k] = __builtin_amdgcn_readfirstlane(PCUM[k]);
                    const int ptot = __builtin_amdgcn_readfirstlane(PCUM[8]); S.np = min(max(ptot - ck * PCH, 0), PCH);
                    pg8::Gemm g{(const bf16*)XG8, (const bf16*)W_GUM8, 0, 2 * FFE, D};
                    pg8::EpiSwiglu8 E{HM8, FFE, 1.0f / (SC_XG * SC_WGU), SC_H};
                    pg8::gemm_phase<pg8::EpiSwiglu8, pg8::MoeOrder, PG8_ALIGN, PG8_SP2>(F.lds + RING_OFF, g, S, E, F.wv);
                    GRID_BAR();
                }
                if (IN(pb + 11 + 2 * ck)) {
                    PHASE_ENTER();
                    pg8::MoeOrder S; S.nN = D / 256; S.G = F.G; S.c = F.vcu; S.p_lo = ck * PCH;
#pragma unroll
                    for (int k = 0; k < 8; ++k) S.pc[k] = __builtin_amdgcn_readfirstlane(PCUM[k]);
                    const int ptot = __builtin_amdgcn_readfirstlane(PCUM[8]); S.np = min(max(ptot - ck * PCH, 0), PCH);
                    pg8::Gemm g{(const bf16*)HM8, (const bf16*)W_DNM8, 0, D, FFE};
                    pg8::EpiBf16PS8 E{XG, D, 1.0f / (SC_H * SC_WDN)};
                    pg8::gemm_phase<pg8::EpiBf16PS8, pg8::MoeOrder, PG8_ALIGN, PG8_SP2>(F.lds + RING_OFF, g, S, E, F.wv);
                    GRID_BAR();
                }
            }
        }
        if (IN(pb + 16)) {
            PHASE_ENTER();
            const int chunk = (TL + NGW - 1) / NGW; const bool nextl = (l + 1 < DEPTH);
#define P9_ROW(t) do { f32x4 x[4], y[4]; row_load_bf16(RS + (size_t)(t) * D, lane, x); \
                if (!moe) row_load_bf16(Y16 + (size_t)(t) * D, lane, y); \
                else { const int p0 = TOKPOS[2 * (size_t)(t)], p1 = TOKPOS[2 * (size_t)(t) + 1]; const float g0 = TOKG[2 * (size_t)(t)], g1 = TOKG[2 * (size_t)(t) + 1]; \
                    f32x4 ya[4], yb[4]; row_load_bf16(XG + (size_t)p0 * D, lane, ya); row_load_bf16(XG + (size_t)p1 * D, lane, yb); \
                    _Pragma("unroll") for (int j = 0; j < 4; ++j) y[j] = ya[j] * g0 + yb[j] * g1; } \
                const float ry = row_rrms(y); \
                _Pragma("unroll") for (int j = 0; j < 4; ++j) x[j] = x[j] + gt[j] * (y[j] * ry * gpo[j]); \
                if (nextl) row_store_bf16(RS + (size_t)(t) * D, lane, x); else if ((t) < TL) row_store(outp + (size_t)(t) * D, lane, x); \
                if (nextl) { f32x4 h[4]; const float rx = row_rrms(x); row_normmod(x, rx, gpre, sh, sc, h); if (MK_GATE_F8 < 2) row_store_bf16(HX + (size_t)(t) * D, lane, h); if (MK_GATE_F8) row_store_fp8(HX8 + (size_t)(t) * D, lane, h, SC_XG); } } while (0)
            f32x4 gpo[4], gt[4], gpre[4], sh[4], sc[4]; vec_load(INP(I_GPOSTFFN) + l * D, lane, gpo); vec_load(INP(I_GPREMIX) + (nextl ? l + 1 : l) * D, lane, gpre);
            for (int t0 = min(gw * chunk, TL), t1 = min(TL, t0 + chunk); t0 < t1; ) { const int bb = t0 >> 13, te = min(t1, (bb + 1) << 13); const float* md = modl + (size_t)bb * 6144;
                vec_load(md + 5120, lane, gt); vec_load(md + (nextl ? 5 * 6144 : 0), lane, sh); vec_load(md + (nextl ? 5 * 6144 : 0) + 1024, lane, sc);
                for (int t = t0; t < te; ++t) P9_ROW(t);
                t0 = te; }
            if (rows_out > TL) { const float* md = modl + (size_t)4 * 6144; vec_load(md + 5120, lane, gt); vec_load(md + (nextl ? 5 * 6144 : 0), lane, sh); vec_load(md + (nextl ? 5 * 6144 : 0) + 1024, lane, sc);
                for (int t = TL + gw; t < rows_out; t += NGW) P9_ROW(t); }
#undef P9_ROW
            if (l + 1 < DEPTH) GRID_BAR();
        }
    }
#undef IN
#undef GRID_BAR
}

extern "C" void kernel_launch(void* const* d_in, const int* in_sizes, int n_in, void* d_out, int out_size, void* d_ws, size_t ws_size, hipStream_t stream) {
    static int grid = 0;
    if (grid == 0) {
        if (n_in != 23 || in_sizes[0] != TL * D || out_size != TL * D || ws_size < WS_END) { fprintf(stderr, "kernel_launch: unexpected shapes: n_in %d in0 %d out %d ws %zu (need %zu); nothing launched\n", n_in, n_in > 0 ? in_sizes[0] : -1, out_size, ws_size, (size_t)WS_END); grid = -1; return; }
        int dev = 0, cus = 0, per_cu = 0;
        if (hipGetDevice(&dev) != hipSuccess || hipDeviceGetAttribute(&cus, hipDeviceAttributeMultiprocessorCount, dev) != hipSuccess) { fprintf(stderr, "kernel_launch: device query failed\n"); grid = -1; return; }
        if (hipFuncSetAttribute((const void*)mk_fwd, hipFuncAttributeMaxDynamicSharedMemorySize, LDS_BYTES) != hipSuccess) { fprintf(stderr, "kernel_launch: hipFuncSetAttribute failed\n"); grid = -1; return; }
        if (hipOccupancyMaxActiveBlocksPerMultiprocessor(&per_cu, (const void*)mk_fwd, NWAVES * 64, LDS_BYTES) != hipSuccess || per_cu < 1) fprintf(stderr, "kernel_launch: note: occupancy query reports %d\n", per_cu);
        (void)hipGetLastError();
        grid = cus;
    }
    if (grid < 0) return;
    if (hipMemsetAsync((char*)d_ws + WS_CTL, 0, CTL_ZERO_BYTES, stream) != hipSuccess) { fprintf(stderr, "kernel_launch: memset failed\n"); return; }
    Args a{};
    for (int i = 0; i < 23; ++i) a.in[i] = (const float*)d_in[i];
    a.out = (float*)d_out; a.ws = (unsigned char*)d_ws;
#if MK_PER_PHASE
    for (int ph = 0; ph < NPHASES; ++ph) { a.ph_lo = ph; a.ph_hi = ph + 1; hipLaunchKernelGGL(mk_fwd, dim3(grid), dim3(NWAVES * 64), LDS_BYTES, stream, a); }
#else
    a.ph_lo = 0; a.ph_hi = NPHASES;
    hipLaunchKernelGGL(mk_fwd, dim3(grid), dim3(NWAVES * 64), LDS_BYTES, stream, a);
#endif
    const hipError_t le = hipPeekAtLastError();
    if (le != hipSuccess) fprintf(stderr, "kernel_launch: launch failed: %s\n", hipGetErrorName(le));
}
```

```cpp
#include <hip/hip_runtime.h>
#include <cstdio>
#include <cstdint>
#ifndef MK_GATE_U8
#define MK_GATE_U8 1
#endif
#ifndef MK_GATE_F8
#define MK_GATE_F8 1
#endif

__device__ __forceinline__ int mk_lane() { unsigned z; asm volatile("s_mov_b32 %0, 0" : "=s"(z)); return (int)__builtin_amdgcn_mbcnt_hi(~0u, __builtin_amdgcn_mbcnt_lo(~0u, z)); }
template <int CTRL, int ROWMASK = 0xf> __device__ __forceinline__ float mk_dpp(float v) { return __builtin_bit_cast(float, __builtin_amdgcn_update_dpp(0, __builtin_bit_cast(int, v), CTRL, ROWMASK, 0xf, false)); }
__device__ __forceinline__ float mk_xor32(float v, bool upper) { const auto rr = __builtin_amdgcn_permlane32_swap(__builtin_bit_cast(unsigned, v), __builtin_bit_cast(unsigned, v), false, false); return __builtin_bit_cast(float, upper ? rr[0] : rr[1]); }
__device__ __forceinline__ int mk_xor16(int v) { return __builtin_amdgcn_ds_swizzle(v, 0x401F); }

namespace pg8 {
#define PG8_LAS __attribute__((address_space(3)))
typedef unsigned short bf16_t;
typedef short bf16x8 __attribute__((ext_vector_type(8)));
typedef float f32x4 __attribute__((ext_vector_type(4)));
typedef unsigned u32x4 __attribute__((ext_vector_type(4)));
typedef unsigned u32x2 __attribute__((ext_vector_type(2)));
typedef int v8i32 __attribute__((ext_vector_type(8)));
constexpr int BM = 256, BK = 64, HALF = 128, HTB = HALF * BK * 2  , STAGE_BYTES = 8 * HTB, NXCD = 8, WGM = 8;

__host__ __device__ __forceinline__ int lds_byte(int r, int c) { const int st = (r >> 4) * 2 + (c >> 5), rr = r & 15, cc = c & 31, ob = rr * 64 + cc * 2; return st * 1024 + (ob ^ (((ob >> 9) & 1) << 5)); }
__host__ __device__ __forceinline__ void stage_rc(int b, int& R, int& C) { const int st = b / 1024, sb = b % 1024, swz = sb ^ (((sb >> 9) & 1) << 5); R = (st >> 1) * 16 + swz / 64; C = (st & 1) * 32 + (swz % 64) / 2; }
__host__ __device__ __forceinline__ int perm32(int rho) { const int n = rho >> 4, i = rho & 15; return 8 * (i >> 2) + 4 * n + (i & 3); }

struct Unit { int pm, pn, pb; };
struct Gemm { const bf16_t* A; const bf16_t* Bt; int M, N, K; };

struct StaticOrder {
    int nM, nN, nwg, G, c, wgm;
    __host__ __device__ void init(int M, int N, int G_, int c_, int wgm_ = WGM) { nM = M / BM; nN = N / BM; nwg = nM * nN; G = G_; c = c_; wgm = wgm_; }
    __host__ __device__ bool next(int i, Unit& u) const {
        const long L = (long)i * G + c; if (L >= nwg) return false;
        int wgid = (int)L; { const int q = nwg / NXCD, r = nwg % NXCD, xcd = wgid % NXCD, off = wgid / NXCD; wgid = (xcd < r ? xcd * (q + 1) : r * (q + 1) + (xcd - r) * q) + off; }
        const int nig = wgm * nN, gid = wgid / nig, fm = gid * wgm, gsz = (nM - fm) < wgm ? (nM - fm) : wgm;
        u.pm = fm + ((wgid % nig) % gsz); u.pn = (wgid % nig) / gsz; u.pb = u.pn; return true;
    }
    __device__ __forceinline__ void a_ready(const Unit&) const {}
    __device__ __forceinline__ void done(const Unit&) const {}
};

__device__ __forceinline__ unsigned cvt_pk_bf16(float lo, float hi) { unsigned r; asm volatile("v_cvt_pk_bf16_f32 %0, %1, %2" : "=v"(r) : "v"(lo), "v"(hi)); return r; }
__device__ __forceinline__ float bf_lo(unsigned w) { return __uint_as_float(w << 16); }
__device__ __forceinline__ float bf_hi(unsigned w) { return __uint_as_float(w & 0xffff0000u); }
__device__ __forceinline__ float sigmoidf_(float x) { return __builtin_amdgcn_rcpf(1.0f + __builtin_amdgcn_exp2f(x * -1.4426950408889634f)); }

template <bool OPF8> struct EpiZT {
    static constexpr bool PERM = true, AFTER_DRAIN = false, HALFN = false, F8 = OPF8, RWACC = false;
    bf16_t* ZM; bf16_t* ZG; const float* rope; int n_lat_panels; const float* bgate; int pn_off; float gs;
    __device__ __forceinline__ void operator()(const f32x4 (&acc)[2][2][4][2], const Unit& u, int wr, int wc, int fr, int fq) const {
        const int row0 = u.pm * BM + wr * 64 + fr; int colt = (u.pn + pn_off) * BM; bf16_t* base = ZM; int ldc = 3840; bool isg = false;
        if (colt >= 3840) { base = ZG; colt -= 3840; ldc = 3072; isg = true; }
        const int col0 = colt + wc * 32 + 8 * fq;
        f32x4 gb[2][2];
        if (isg) {
#pragma unroll
            for (int bj = 0; bj < 2; ++bj) { gb[bj][0] = *(const f32x4*)(bgate + col0 + bj * HALF); gb[bj][1] = *(const f32x4*)(bgate + col0 + bj * HALF + 4); } }
        const int nrope = (u.pm < n_lat_panels) ? (u.pn + pn_off < 2 ? 2 : (u.pn + pn_off == 2 ? 1 : 0)) : 0;
#pragma unroll
        for (int ai = 0; ai < 2; ++ai)
#pragma unroll
            for (int m = 0; m < 4; ++m) { const int row = row0 + ai * HALF + m * 16; bf16_t* rowp = base + (size_t)row * ldc + col0;
                f32x4 cs[4];
                if (nrope) { const int s = row & 8191, pidx = (wc & 1) ? 128 + (s & 63) : (s >> 6); const f32x4* cp = (const f32x4*)(rope + (size_t)(pidx * 16 + 8 * (fq & 1)) * 2);
                    cs[0] = cp[0]; cs[1] = cp[1]; cs[2] = cp[2]; cs[3] = cp[3]; }
#pragma unroll
                for (int bj = 0; bj < 2; ++bj) { f32x4 v0 = acc[ai][bj][m][0], v1 = acc[ai][bj][m][1];
                    if (OPF8 && !isg) { v0 *= gs; v1 *= gs; }
                    if (isg) {
#pragma unroll
                        for (int j = 0; j < 4; ++j) { v0[j] = sigmoidf_(fminf(fmaxf(v0[j] * gs + gb[bj][0][j], -30.f), 30.f)); v1[j] = sigmoidf_(fminf(fmaxf(v1[j] * gs + gb[bj][1][j], -30.f), 30.f)); } }
                    if (bj < nrope) { const float sg = (fq >> 1) ? 1.f : -1.f;
                        float v[8] = {v0[0], v0[1], v0[2], v0[3], v1[0], v1[1], v1[2], v1[3]}, o[8];
#pragma unroll
                        for (int j = 0; j < 8; ++j) { const float pv = mk_xor32(v[j], (fq >> 1) != 0); const float c_ = cs[j >> 1][(j & 1) * 2], s_ = cs[j >> 1][(j & 1) * 2 + 1]; o[j] = v[j] * c_ + sg * pv * s_; }
                        v0 = (f32x4){o[0], o[1], o[2], o[3]}; v1 = (f32x4){o[4], o[5], o[6], o[7]}; }
                    if (MK_GATE_U8 && isg) {
                        unsigned b0 = 0u, b1 = 0u;
#pragma unroll
                        for (int j = 0; j < 4; ++j) { b0 = __builtin_amdgcn_cvt_pk_u8_f32(fmaxf(v0[j] * 255.f, 1.f), j, b0); b1 = __builtin_amdgcn_cvt_pk_u8_f32(fmaxf(v1[j] * 255.f, 1.f), j, b1); }
                        u32x2 w8; w8.x = b0; w8.y = b1;
                        *(u32x2*)((unsigned char*)ZG + (size_t)row * 3072 + col0 + bj * HALF) = w8;
                        continue; }
                    u32x4 w; w.x = cvt_pk_bf16(v0[0], v0[1]); w.y = cvt_pk_bf16(v0[2], v0[3]); w.z = cvt_pk_bf16(v1[0], v1[1]); w.w = cvt_pk_bf16(v1[2], v1[3]);
                    *(u32x4*)(rowp + bj * HALF) = w; } }
    }
};
typedef EpiZT<false> EpiZ;

struct EpiZM {
    static constexpr bool PERM = true, AFTER_DRAIN = false, HALFN = false, F8 = false, RWACC = false;
    bf16_t* ZM; const PG8_LAS float* rope; int n_lat_panels;
    __device__ __forceinline__ void operator()(const f32x4 (&acc)[2][2][4][2], const Unit& u, int wr, int wc, int fr, int fq) const {
        const int row0 = u.pm * BM + wr * 64 + fr; const int col0 = u.pn * BM + wc * 32 + 8 * fq;
        const int nrope = (u.pm < n_lat_panels) ? (u.pn < 2 ? 2 : (u.pn == 2 ? 1 : 0)) : 0;
#pragma unroll
        for (int ai = 0; ai < 2; ++ai)
#pragma unroll
            for (int m = 0; m < 4; ++m) { const int row = row0 + ai * HALF + m * 16; bf16_t* rowp = ZM + (size_t)row * 3840 + col0;
                f32x4 cs[4];
                if (nrope) { const int s = row & 8191, pidx = (wc & 1) ? 128 + (s & 63) : (s >> 6); const PG8_LAS f32x4* cp = (const PG8_LAS f32x4*)(rope + (pidx * 16 + 8 * (fq & 1)) * 2);
                    cs[0] = cp[0]; cs[1] = cp[1]; cs[2] = cp[2]; cs[3] = cp[3]; }
#pragma unroll
                for (int bj = 0; bj < 2; ++bj) { f32x4 v0 = acc[ai][bj][m][0], v1 = acc[ai][bj][m][1];
                    if (bj < nrope) { const float sg = (fq >> 1) ? 1.f : -1.f;
                        float v[8] = {v0[0], v0[1], v0[2], v0[3], v1[0], v1[1], v1[2], v1[3]}, o[8];
#pragma unroll
                        for (int j = 0; j < 8; ++j) { const float pv = mk_xor32(v[j], (fq >> 1) != 0); const float c_ = cs[j >> 1][(j & 1) * 2], s_ = cs[j >> 1][(j & 1) * 2 + 1]; o[j] = v[j] * c_ + sg * pv * s_; }
                        v0 = (f32x4){o[0], o[1], o[2], o[3]}; v1 = (f32x4){o[4], o[5], o[6], o[7]}; }
                    u32x4 w; w.x = cvt_pk_bf16(v0[0], v0[1]); w.y = cvt_pk_bf16(v0[2], v0[3]); w.z = cvt_pk_bf16(v1[0], v1[1]); w.w = cvt_pk_bf16(v1[2], v1[3]);
                    *(u32x4*)(rowp + bj * HALF) = w; } }
    }
};
struct EpiZGate {
    static constexpr bool PERM = true, AFTER_DRAIN = false, HALFN = false, F8 = true, RWACC = false;
    unsigned char* ZG; const float* bgate; float gs;
    __device__ __forceinline__ void operator()(const f32x4 (&acc)[2][2][4][2], const Unit& u, int wr, int wc, int fr, int fq) const {
        const int row0 = u.pm * BM + wr * 64 + fr; const int colb = u.pn * BM + wc * 32; const int odd = fq & 1;
        f32x4 gb[2][2];
#pragma unroll
        for (int bj = 0; bj < 2; ++bj) { gb[bj][0] = *(const f32x4*)(bgate + colb + 8 * fq + bj * HALF); gb[bj][1] = *(const f32x4*)(bgate + colb + 8 * fq + bj * HALF + 4); }
#pragma unroll
        for (int ai = 0; ai < 2; ++ai)
#pragma unroll
            for (int mp = 0; mp < 2; ++mp)
#pragma unroll
                for (int bj = 0; bj < 2; ++bj) {
                    unsigned w[2][2];
#pragma unroll
                    for (int k = 0; k < 2; ++k) { const int m = 2 * mp + k; const f32x4 v0 = acc[ai][bj][m][0], v1 = acc[ai][bj][m][1]; unsigned b0 = 0u, b1 = 0u;
#pragma unroll
                        for (int j = 0; j < 4; ++j) { const float g0 = sigmoidf_(fminf(fmaxf(v0[j] * gs + gb[bj][0][j], -30.f), 30.f)), g1 = sigmoidf_(fminf(fmaxf(v1[j] * gs + gb[bj][1][j], -30.f), 30.f));
                            b0 = __builtin_amdgcn_cvt_pk_u8_f32(fmaxf(g0 * 255.f, 1.f), j, b0); b1 = __builtin_amdgcn_cvt_pk_u8_f32(fmaxf(g1 * 255.f, 1.f), j, b1); }
                        w[k][0] = b0; w[k][1] = b1; }
                    const unsigned s0 = odd ? w[0][0] : w[1][0], s1 = odd ? w[0][1] : w[1][1];
                    const unsigned r0 = (unsigned)mk_xor16((int)s0), r1 = (unsigned)mk_xor16((int)s1);
                    u32x4 st; if (odd) { st.x = r0; st.y = r1; st.z = w[1][0]; st.w = w[1][1]; } else { st.x = w[0][0]; st.y = w[0][1]; st.z = r0; st.w = r1; }
                    *(u32x4*)(ZG + (size_t)(row0 + ai * HALF + (2 * mp + odd) * 16) * 3072 + colb + 8 * (fq & 2) + bj * HALF) = st; }
    }
};
struct EpiBf16P {
    static constexpr bool PERM = true, AFTER_DRAIN = false, HALFN = false, F8 = false, RWACC = false;
    bf16_t* O; int ldc;
    __device__ __forceinline__ void operator()(const f32x4 (&acc)[2][2][4][2], const Unit& u, int wr, int wc, int fr, int fq) const {
        const int row0 = u.pm * BM + wr * 64 + fr; const int col0 = u.pn * BM + wc * 32 + 8 * fq;
#pragma unroll
        for (int ai = 0; ai < 2; ++ai)
#pragma unroll
            for (int m = 0; m < 4; ++m) { bf16_t* rowp = O + (size_t)(row0 + ai * HALF + m * 16) * ldc + col0;
#pragma unroll
                for (int bj = 0; bj < 2; ++bj) { const f32x4 v0 = acc[ai][bj][m][0], v1 = acc[ai][bj][m][1];
                    u32x4 w; w.x = cvt_pk_bf16(v0[0], v0[1]); w.y = cvt_pk_bf16(v0[2], v0[3]); w.z = cvt_pk_bf16(v1[0], v1[1]); w.w = cvt_pk_bf16(v1[2], v1[3]);
                    *(u32x4*)(rowp + bj * HALF) = w; } }
    }
};
struct EpiBranchAcc {
    static constexpr bool PERM = true, AFTER_DRAIN = false, HALFN = false, F8 = false, RWACC = true;
    bf16_t* MG; const bf16_t* ZG;
    __device__ __forceinline__ bool restart(const Unit& u) const { return u.pm >= 264; }
    __device__ __forceinline__ void rw(f32x4 (&acc)[2][2][4][2], const Unit& u, int wr, int wc, int fr, int fq) const {
        const int r = u.pm / 132, pmt = u.pm - 132 * r, rn = r < 2 ? r + 1 : r;
        const int row0 = pmt * BM + wr * 64 + fr, col0 = u.pn * BM + wc * 32 + 8 * fq;
        constexpr int PG8_GD = 4;
        u32x4 gp[PG8_GD][2], gn[PG8_GD][2];
        constexpr unsigned GB = MK_GATE_U8 ? 1u : 2u;
        const unsigned o0 = (unsigned)row0 * (3072u * GB) + (unsigned)col0 * GB;
        const char* zp = (const char*)ZG + (size_t)r * 1024 * GB; const char* zn = (const char*)ZG + (size_t)rn * 1024 * GB;
#if MK_GATE_U8
#define PG8_GLOAD(s, buf) do { const int bj_ = (s) >> 2, ai_ = ((s) >> 1) & 1, mb_ = ((s) & 1) * 2; _Pragma("unroll") for (int q_ = 0; q_ < 2; ++q_) { \
            const unsigned off_ = o0 + (unsigned)(ai_ * HALF + (mb_ + q_) * 16) * 3072u + (unsigned)(bj_ * HALF); \
            const u32x2 a_ = *(const u32x2*)(zp + off_), b_ = *(const u32x2*)(zn + off_); gp[buf][q_].x = a_.x; gp[buf][q_].y = a_.y; gn[buf][q_].x = b_.x; gn[buf][q_].y = b_.y; } } while (0)
#else
#define PG8_GLOAD(s, buf) do { const int bj_ = (s) >> 2, ai_ = ((s) >> 1) & 1, mb_ = ((s) & 1) * 2; _Pragma("unroll") for (int q_ = 0; q_ < 2; ++q_) { \
            const unsigned off_ = o0 + (unsigned)(ai_ * HALF + (mb_ + q_) * 16) * 6144u + (unsigned)(bj_ * HALF * 2); \
            gp[buf][q_] = *(const u32x4*)(zp + off_); gn[buf][q_] = *(const u32x4*)(zn + off_); } } while (0)
#endif
#pragma unroll
        for (int s = 0; s < PG8_GD - 1; ++s) PG8_GLOAD(s, s);
#pragma unroll
        for (int s = 0; s < 8; ++s) { const int bj = s >> 2, ai = (s >> 1) & 1, mb = (s & 1) * 2, col = col0 + bj * HALF;
            if (s + PG8_GD - 1 < 8) PG8_GLOAD(s + PG8_GD - 1, (s + PG8_GD - 1) % PG8_GD);
            __builtin_amdgcn_sched_barrier(0);
#pragma unroll
            for (int q = 0; q < 2; ++q) { const int m = mb + q; const size_t row = (size_t)(row0 + ai * HALF + m * 16);
                const u32x4 g0 = gp[s % PG8_GD][q], g1 = gn[s % PG8_GD][q];
#if MK_GATE_U8
#define PG8_UB(w_, k_) ((float)(((w_) >> (8 * (k_))) & 255u))
                const float x[8] = {PG8_UB(g0.x, 0), PG8_UB(g0.x, 1), PG8_UB(g0.x, 2), PG8_UB(g0.x, 3), PG8_UB(g0.y, 0), PG8_UB(g0.y, 1), PG8_UB(g0.y, 2), PG8_UB(g0.y, 3)};
#else
                const float x[8] = {bf_lo(g0.x), bf_hi(g0.x), bf_lo(g0.y), bf_hi(g0.y), bf_lo(g0.z), bf_hi(g0.z), bf_lo(g0.w), bf_hi(g0.w)};
#endif
                if (r < 2) {
#if MK_GATE_U8
                    const float y[8] = {PG8_UB(g1.x, 0), PG8_UB(g1.x, 1), PG8_UB(g1.x, 2), PG8_UB(g1.x, 3), PG8_UB(g1.y, 0), PG8_UB(g1.y, 1), PG8_UB(g1.y, 2), PG8_UB(g1.y, 3)};
#else
                    const float y[8] = {bf_lo(g1.x), bf_hi(g1.x), bf_lo(g1.y), bf_hi(g1.y), bf_lo(g1.z), bf_hi(g1.z), bf_lo(g1.w), bf_hi(g1.w)};
#endif
#pragma unroll
                    for (int j = 0; j < 8; ++j) acc[ai][bj][m][j >> 2][j & 3] *= x[j] * __builtin_amdgcn_rcpf(y[j]);
                } else {
                    float v[8];
#pragma unroll
                    for (int j = 0; j < 8; ++j) v[j] = acc[ai][bj][m][j >> 2][j & 3] * (MK_GATE_U8 ? x[j] * (1.0f / 255.0f) : x[j]);
                    u32x4 w; w.x = cvt_pk_bf16(v[0], v[1]); w.y = cvt_pk_bf16(v[2], v[3]); w.z = cvt_pk_bf16(v[4], v[5]); w.w = cvt_pk_bf16(v[6], v[7]);
                    *(u32x4*)(MG + row * 1024 + col) = w;
                } }
        }
#undef PG8_GLOAD
    }
};
struct BranchOrder3 {
    StaticOrder so;
    __device__ __forceinline__ bool next(int i, Unit& u) const {
        const int ti = i / 3, r = i - 3 * ti; if (!so.next(ti, u)) return false;
        u.pb = 4 * r + u.pn; u.pm += 132 * r; return true;
    }
    __device__ __forceinline__ void a_ready(const Unit&) const {}
    __device__ __forceinline__ void done(const Unit&) const {}
};
struct EpiSwiglu {
    static constexpr bool PERM = true, AFTER_DRAIN = false, HALFN = false, F8 = false, RWACC = false;
    bf16_t* H; int ldh;
    __device__ __forceinline__ void operator()(const f32x4 (&acc)[2][2][4][2], const Unit& u, int wr, int wc, int fr, int fq) const {
        const int row0 = u.pm * BM + wr * 64 + fr; const int col0 = u.pn * HALF + wc * 32 + 8 * fq;
#pragma unroll
        for (int ai = 0; ai < 2; ++ai)
#pragma unroll
            for (int m = 0; m < 4; ++m) { bf16_t* rowp = H + (size_t)(row0 + ai * HALF + m * 16) * ldh + col0;
                float h[8];
#pragma unroll
                for (int n = 0; n < 2; ++n)
#pragma unroll
                    for (int j = 0; j < 4; ++j) { const float g = acc[ai][0][m][n][j], uu = acc[ai][1][m][n][j]; h[n * 4 + j] = g * sigmoidf_(g) * uu; }
                u32x4 w; w.x = cvt_pk_bf16(h[0], h[1]); w.y = cvt_pk_bf16(h[2], h[3]); w.z = cvt_pk_bf16(h[4], h[5]); w.w = cvt_pk_bf16(h[6], h[7]);
                *(u32x4*)rowp = w; }
    }
};
__device__ __forceinline__ unsigned pk4_fp8(float a, float b, float c, float d) { int w = __builtin_amdgcn_cvt_pk_fp8_f32(a, b, 0, false); w = __builtin_amdgcn_cvt_pk_fp8_f32(c, d, w, true); return (unsigned)w; }
__device__ __forceinline__ float clamp_fp8(float v) { return fminf(fmaxf(v, -448.0f), 448.0f); }
template <bool OPF8> struct EpiSwiglu8T {
    static constexpr bool PERM = true, AFTER_DRAIN = false, HALFN = false, F8 = OPF8, RWACC = false;
    unsigned char* H; int ldh; float sin, sout;
    __device__ __forceinline__ void operator()(const f32x4 (&acc)[2][2][4][2], const Unit& u, int wr, int wc, int fr, int fq) const {
        const int row0 = u.pm * BM + wr * 64 + fr; const int col0 = u.pn * HALF + wc * 32 + 8 * (fq & 2); const int odd = fq & 1;
#pragma unroll
        for (int ai = 0; ai < 2; ++ai)
#pragma unroll
            for (int mp = 0; mp < 2; ++mp) {
                unsigned w[2][2];
#pragma unroll
                for (int k = 0; k < 2; ++k) { const int m = 2 * mp + k; float h[8];
#pragma unroll
                    for (int n = 0; n < 2; ++n)
#pragma unroll
                        for (int j = 0; j < 4; ++j) { const float g = acc[ai][0][m][n][j] * sin, uu = acc[ai][1][m][n][j] * sin; h[n * 4 + j] = clamp_fp8(g * sigmoidf_(g) * uu * sout); }
                    w[k][0] = pk4_fp8(h[0], h[1], h[2], h[3]); w[k][1] = pk4_fp8(h[4], h[5], h[6], h[7]); }
                const unsigned s0 = odd ? w[0][0] : w[1][0], s1 = odd ? w[0][1] : w[1][1];
                const unsigned r0 = (unsigned)mk_xor16((int)s0), r1 = (unsigned)mk_xor16((int)s1);
                u32x4 st; if (odd) { st.x = r0; st.y = r1; st.z = w[1][0]; st.w = w[1][1]; } else { st.x = w[0][0]; st.y = w[0][1]; st.z = r0; st.w = r1; }
                *(u32x4*)(H + (size_t)(row0 + ai * HALF + (2 * mp + odd) * 16) * ldh + col0) = st; }
    }
};
typedef EpiSwiglu8T<true> EpiSwiglu8;
struct EpiBf16PS8 {
    static constexpr bool PERM = true, AFTER_DRAIN = false, HALFN = false, F8 = true, RWACC = false;
    bf16_t* O; int ldc; float s;
    __device__ __forceinline__ void operator()(const f32x4 (&acc)[2][2][4][2], const Unit& u, int wr, int wc, int fr, int fq) const {
        const int row0 = u.pm * BM + wr * 64 + fr; const int col0 = u.pn * BM + wc * 32 + 8 * fq;
#pragma unroll
        for (int ai = 0; ai < 2; ++ai)
#pragma unroll
            for (int m = 0; m < 4; ++m) { bf16_t* rowp = O + (size_t)(row0 + ai * HALF + m * 16) * ldc + col0;
#pragma unroll
                for (int bj = 0; bj < 2; ++bj) { const f32x4 v0 = acc[ai][bj][m][0] * s, v1 = acc[ai][bj][m][1] * s;
                    u32x4 w; w.x = cvt_pk_bf16(v0[0], v0[1]); w.y = cvt_pk_bf16(v0[2], v0[3]); w.z = cvt_pk_bf16(v1[0], v1[1]); w.w = cvt_pk_bf16(v1[2], v1[3]);
                    *(u32x4*)(rowp + bj * HALF) = w; } }
    }
};
struct MoeOrder {
    int nN, G, c, p_lo, np; int pc[8];
    __device__ __forceinline__ bool next(int i, Unit& u) const {
        const long L = (long)i * G + c; if (L >= (long)np * nN) return false;
        const int wgid = (int)L, nig = WGM * nN, gid = wgid / nig, fm = gid * WGM, gsz = (np - fm) < WGM ? (np - fm) : WGM;
        u.pm = p_lo + fm + ((wgid % nig) % gsz); u.pn = (wgid % nig) / gsz;
        int e = 0;
#pragma unroll
        for (int k = 1; k < 8; ++k) e += (u.pm >= pc[k]) ? 1 : 0;
        u.pb = e * nN + u.pn; return true;
    }
    __device__ __forceinline__ void a_ready(const Unit&) const {}
    __device__ __forceinline__ void done(const Unit&) const {}
};

__device__ __forceinline__ void glds_s(const char* sbase, unsigned voff, unsigned lds_dst) { unsigned keep;
    asm volatile("s_mov_b32 %0, m0\n\ts_mov_b32 m0, %3\n\ts_nop 0\n\tglobal_load_lds_dwordx4 %1, %2\n\ts_mov_b32 m0, %0" : "=&s"(keep) : "v"(voff), "s"(sbase), "s"(lds_dst) : "memory"); }
__device__ __forceinline__ const char* uni_ptr(const char* p) { const unsigned long long b = (unsigned long long)(uintptr_t)p; const unsigned lo = (unsigned)__builtin_amdgcn_readfirstlane((int)(unsigned)b), hi = (unsigned)__builtin_amdgcn_readfirstlane((int)(unsigned)(b >> 32));
    return (const char*)(uintptr_t)(((unsigned long long)hi << 32) | lo); }
template <class Epi, class Sched, bool ALIGN_EPI = false, bool SP2 = false>
__device__ __forceinline__ void gemm_phase(PG8_LAS unsigned char* lds, const Gemm g, const Sched& S, const Epi& E, int wv) {
    int tid_ = (wv << 6) | mk_lane(); asm volatile("" : "+v"(tid_));
    const int tid = tid_, wid = __builtin_amdgcn_readfirstlane(tid >> 6), lane = tid & 63, wr = wid >> 2, wc = wid & 3, fr = lane & 15, fq = lane >> 4;
    constexpr bool HN = Epi::HALFN;
    constexpr bool F8 = Epi::F8;
    constexpr int ES = F8 ? 1 : 2;
    const int K = g.K, nt = K * ES / (BK * 2);
    unsigned voffA[2], voffB[2];
#pragma unroll
    for (int i = 0; i < 2; ++i) { int R, C; stage_rc(tid * 16 + i * 8192, R, C); const int Rb = Epi::PERM ? ((R & ~31) + perm32(R & 31)) : R;
        voffA[i] = (unsigned)(R * K * ES + C * 2); voffB[i] = (unsigned)(Rb * K * ES + C * 2); }
    const size_t kstep = (size_t)(BK * 2);
    const size_t hstep = (size_t)HALF * K * ES;
    const size_t tstep = 2 * hstep;
    const unsigned ldsw = (unsigned)wid * 1024u;
    const unsigned ldsb = (unsigned)__builtin_amdgcn_readfirstlane((int)((unsigned)(uintptr_t)lds + ldsw));
    const int aoff = lds_byte(wr * 64 + fr, fq * 8), boff = lds_byte(wc * 32 + fr, fq * 8);
#define PG8_SA(b, h) (((b) * 2 + (h)) * HTB)
#define PG8_SB(b, h) ((4 + (b) * 2 + (h)) * HTB)
#define PG8_STAGE(bufoff, gbase, voff) do { _Pragma("unroll") for (int _i = 0; _i < 2; ++_i) \
        glds_s((const char*)(gbase), (voff)[_i], ldsb + (unsigned)((bufoff) + _i * 8192)); } while (0)
#define PG8_LDA(dst, b, h) do { if constexpr (F8) { _Pragma("unroll") for (int m = 0; m < 4; ++m) { const u32x4 lo_ = *(const PG8_LAS u32x4*)(lds + PG8_SA(b, h) + aoff + m * 2048), hi_ = *(const PG8_LAS u32x4*)(lds + PG8_SA(b, h) + aoff + m * 2048 + 1024); \
            dst##8[m] = __builtin_bit_cast(v8i32, __builtin_shufflevector(lo_, hi_, 0, 1, 2, 3, 4, 5, 6, 7)); } } \
        else { _Pragma("unroll") for (int m = 0; m < 4; ++m) _Pragma("unroll") for (int k = 0; k < 2; ++k) dst[m][k] = *(const PG8_LAS bf16x8*)(lds + PG8_SA(b, h) + aoff + m * 2048 + k * 1024); } } while (0)
#define PG8_LDB(dst, b, h) do { if constexpr (F8) { _Pragma("unroll") for (int n = 0; n < 2; ++n) { const u32x4 lo_ = *(const PG8_LAS u32x4*)(lds + PG8_SB(b, h) + boff + n * 2048), hi_ = *(const PG8_LAS u32x4*)(lds + PG8_SB(b, h) + boff + n * 2048 + 1024); \
            dst##8[n] = __builtin_bit_cast(v8i32, __builtin_shufflevector(lo_, hi_, 0, 1, 2, 3, 4, 5, 6, 7)); } } \
        else { _Pragma("unroll") for (int n = 0; n < 2; ++n) _Pragma("unroll") for (int k = 0; k < 2; ++k) dst[n][k] = *(const PG8_LAS bf16x8*)(lds + PG8_SB(b, h) + boff + n * 2048 + k * 1024); } } while (0)
#define PG8_MMA(ai, bj, At, Bt) do { __builtin_amdgcn_s_setprio(1); _Pragma("unroll") for (int m = 0; m < 4; ++m) _Pragma("unroll") for (int n = 0; n < 2; ++n) { \
        if constexpr (F8) { asm volatile("v_mfma_f32_16x16x128_f8f6f4 %0, %1, %2, %0" : "+v"(acc[ai][bj][m][n]) : "v"(Bt##8[n]), "v"(At##8[m])); } \
        else { _Pragma("unroll") for (int k = 0; k < 2; ++k) acc[ai][bj][m][n] = __builtin_amdgcn_mfma_f32_16x16x32_bf16(Bt[n][k], At[m][k], acc[ai][bj][m][n], 0, 0, 0); } } \
        __builtin_amdgcn_s_setprio(0); } while (0)
#define PG8_LDB1(dst, b, h) do { if constexpr (!HN) { PG8_LDB(dst, b, h); } } while (0)
#define PG8_MMA1(ai, bj, At, Bt) do { if constexpr (!HN) { PG8_MMA(ai, bj, At, Bt); } } while (0)
#define PG8_WAIT_V(n) asm volatile("s_waitcnt vmcnt(" #n ")" ::: "memory")
#define PG8_WAIT_L(n) asm volatile("s_waitcnt lgkmcnt(" #n ")" ::: "memory")
#define PG8_BAR __builtin_amdgcn_s_barrier()
#define PG8_SCHED __builtin_amdgcn_sched_barrier(0)
    Unit cur, nxt; int ui = 0;
    if (!S.next(0, cur)) return;
    f32x4 acc[2][2][4][2];
#pragma unroll
    for (int a = 0; a < 2; ++a)
#pragma unroll
        for (int b = 0; b < 2; ++b)
#pragma unroll
            for (int m = 0; m < 4; ++m)
#pragma unroll
                for (int n = 0; n < 2; ++n) acc[a][b][m][n] = (f32x4){0.f, 0.f, 0.f, 0.f};
    bf16x8 At[4][2], B0[2][2], B1[2][2];
    v8i32 At8[4], B08[2], B18[2];
    const char* cA = uni_ptr((const char*)g.A + (size_t)cur.pm * tstep); const char* cB = uni_ptr((const char*)g.Bt + (size_t)cur.pb * (HN ? hstep : tstep));
    S.a_ready(cur);
    if constexpr (SP2) {
        PG8_STAGE(PG8_SB(0, 0), cB, voffB); PG8_STAGE(PG8_SB(0, 1), cB + hstep, voffB); PG8_STAGE(PG8_SA(0, 0), cA, voffA); PG8_STAGE(PG8_SA(0, 1), cA + hstep, voffA);
        if (wr == 1) PG8_BAR;
        PG8_WAIT_V(2); PG8_BAR;
        PG8_STAGE(PG8_SB(1, 0), cB + kstep, voffB); PG8_STAGE(PG8_SA(1, 0), cA + kstep, voffA); PG8_STAGE(PG8_SB(1, 1), cB + hstep + kstep, voffB);
        PG8_WAIT_V(6); PG8_BAR;
    } else {
        PG8_STAGE(PG8_SB(0, 0), cB, voffB); PG8_STAGE(PG8_SA(0, 0), cA, voffA); PG8_STAGE(PG8_SB(0, 1), cB + hstep, voffB); PG8_STAGE(PG8_SA(0, 1), cA + hstep, voffA);
        if (wr == 1) PG8_BAR;
        PG8_WAIT_V(4); PG8_BAR;
        PG8_STAGE(PG8_SB(1, 0), cB + kstep, voffB); PG8_STAGE(PG8_SA(1, 0), cA + kstep, voffA); PG8_STAGE(PG8_SB(1, 1), cB + hstep + kstep, voffB);
        PG8_WAIT_V(6); PG8_BAR;
    }
    for (;;) {
        const bool has_next = S.next(ui + 1, nxt);
        const char* nA = uni_ptr(has_next ? (const char*)g.A + (size_t)nxt.pm * tstep : cA); const char* nB = uni_ptr(has_next ? (const char*)g.Bt + (size_t)nxt.pb * (HN ? hstep : tstep) : cB);
        for (int t = 0; t < nt; t += 2) {
            const bool last = (t == nt - 2);
            const char* a1 = cA + (size_t)(t + 1) * kstep;
            const char* a2 = last ? nA : cA + (size_t)(t + 2) * kstep; const char* b2 = last ? nB : cB + (size_t)(t + 2) * kstep;
            const char* a3 = a2 + kstep; const char* b3 = b2 + kstep;
            if (last && has_next) S.a_ready(nxt);
            if constexpr (SP2) {
            PG8_LDB(B0, 0, 0); PG8_LDB1(B1, 0, 1); PG8_SCHED; PG8_LDA(At, 0, 0); PG8_STAGE(PG8_SA(1, 1), a1 + hstep, voffA);
            PG8_WAIT_V(8); PG8_WAIT_L(0); PG8_BAR; PG8_MMA(0, 0, At, B0); PG8_MMA1(0, 1, At, B1); PG8_BAR; PG8_SCHED;
            PG8_LDA(At, 0, 1); PG8_STAGE(PG8_SB(0, 0), b2, voffB); PG8_STAGE(PG8_SB(0, 1), b2 + hstep, voffB); PG8_STAGE(PG8_SA(0, 0), a2, voffA);
            PG8_WAIT_V(8); PG8_WAIT_L(0); PG8_BAR; PG8_MMA(1, 0, At, B0); PG8_MMA1(1, 1, At, B1); PG8_BAR; PG8_SCHED;
            PG8_LDB(B0, 1, 0); PG8_LDB1(B1, 1, 1); PG8_SCHED; PG8_LDA(At, 1, 0); PG8_STAGE(PG8_SA(0, 1), a2 + hstep, voffA);
            PG8_WAIT_V(8); PG8_WAIT_L(0); PG8_BAR; PG8_MMA(0, 0, At, B0); PG8_MMA1(0, 1, At, B1); PG8_BAR; PG8_SCHED;
            PG8_LDA(At, 1, 1); PG8_STAGE(PG8_SB(1, 0), b3, voffB); PG8_STAGE(PG8_SB(1, 1), b3 + hstep, voffB); PG8_STAGE(PG8_SA(1, 0), a3, voffA);
            PG8_WAIT_V(8); PG8_WAIT_L(0); PG8_BAR; PG8_MMA(1, 0, At, B0); PG8_MMA1(1, 1, At, B1); PG8_BAR; PG8_SCHED;
            } else {
            PG8_LDB(B0, 0, 0); PG8_SCHED; PG8_LDA(At, 0, 0); PG8_STAGE(PG8_SA(1, 1), a1 + hstep, voffA);
            PG8_WAIT_L(8); PG8_BAR; PG8_WAIT_L(0); PG8_MMA(0, 0, At, B0); PG8_BAR; PG8_SCHED;
            PG8_LDB1(B1, 0, 1); PG8_STAGE(PG8_SB(0, 0), b2, voffB);
            PG8_BAR; PG8_WAIT_L(0); PG8_MMA1(0, 1, At, B1); PG8_BAR;
            PG8_LDA(At, 0, 1); PG8_STAGE(PG8_SA(0, 0), a2, voffA);
            PG8_BAR; PG8_WAIT_L(0); PG8_MMA(1, 0, At, B0); PG8_BAR; PG8_SCHED;
            PG8_STAGE(PG8_SB(0, 1), b2 + hstep, voffB);
            PG8_WAIT_V(6); PG8_BAR; PG8_MMA1(1, 1, At, B1); PG8_BAR;
            PG8_LDB(B0, 1, 0); PG8_SCHED; PG8_LDA(At, 1, 0); PG8_STAGE(PG8_SA(0, 1), a2 + hstep, voffA);
            PG8_WAIT_L(8); PG8_BAR; PG8_WAIT_L(0); PG8_MMA(0, 0, At, B0); PG8_BAR; PG8_SCHED;
            PG8_LDB1(B1, 1, 1); PG8_STAGE(PG8_SB(1, 0), b3, voffB);
            PG8_BAR; PG8_WAIT_L(0); PG8_MMA1(0, 1, At, B1); PG8_BAR;
            PG8_LDA(At, 1, 1); PG8_STAGE(PG8_SA(1, 0), a3, voffA);
            PG8_BAR; PG8_WAIT_L(0); PG8_MMA(1, 0, At, B0); PG8_BAR; PG8_SCHED;
            PG8_STAGE(PG8_SB(1, 1), b3 + hstep, voffB);
            PG8_WAIT_V(6); PG8_BAR; PG8_MMA1(1, 1, At, B1); PG8_BAR;
            }
        }
        if constexpr (F8) asm volatile("s_nop 15\n\ts_nop 15" ::: "memory");
        if constexpr (ALIGN_EPI) { if (wr == 0) PG8_BAR; }
        if constexpr (Epi::RWACC) { E.rw(acc, cur, wr, wc, fr, fq); S.done(cur); }
        else if constexpr (!Epi::AFTER_DRAIN) { E(acc, cur, wr, wc, fr, fq); S.done(cur); }
        if (!has_next) break;
        bool zero_acc = true; if constexpr (Epi::RWACC) zero_acc = E.restart(cur);
        if (zero_acc)
#pragma unroll
        for (int a = 0; a < 2; ++a)
#pragma unroll
            for (int b = 0; b < 2; ++b)
#pragma unroll
                for (int m = 0; m < 4; ++m)
#pragma unroll
                    for (int n = 0; n < 2; ++n) acc[a][b][m][n] = (f32x4){0.f, 0.f, 0.f, 0.f};
        cur = nxt; cA = nA; cB = nB; ++ui;
        if constexpr (ALIGN_EPI) { if (wr == 1) PG8_BAR; }
    }
    PG8_WAIT_V(0);
    if constexpr (!ALIGN_EPI) { if (wr == 0) PG8_BAR; }
    PG8_BAR;
    if constexpr (Epi::AFTER_DRAIN) { E.fused(acc, cur, wr, wc, fr, fq, lds, wid, lane); S.done(cur); }
#undef PG8_SA
#undef PG8_SB
#undef PG8_STAGE
#undef PG8_LDA
#undef PG8_LDB
#undef PG8_MMA
#undef PG8_LDB1
#undef PG8_MMA1
#undef PG8_WAIT_V
#undef PG8_WAIT_L
#undef PG8_BAR
#undef PG8_SCHED
}
}

#ifndef PG8_SP2
#define PG8_SP2 true
#endif
#ifndef PG8_ALIGN
#define PG8_ALIGN true
#endif
#ifndef MK_WGM
#define MK_WGM 4
#endif
#ifndef MK_DENSE_F8
#define MK_DENSE_F8 1
#endif
#ifndef MK_PER_PHASE
#define MK_PER_PHASE 0
#endif

constexpr int NWAVES = 8;
constexpr int D = 1024, BATCH = 4, SEQ = 8192, CTXL = 256, DEPTH = 2;
constexpr int TL = BATCH * SEQ, TC = BATCH * CTXL, TA = TL + TC;
constexpr int INC = 6912, ZMC = 3840, ZGC = 3072, BW = 512;
constexpr int FFD = 2816, FFE = 3584, NE = 8;
constexpr int MAXPAN = 264, PCH = 264, NCHUNK = 1;
constexpr float RMS_EPS = 1e-6f;
constexpr float SC_XG = 4.0f, SC_WGU = 32.0f, SC_H = 4.0f, SC_WDN = 64.0f;
constexpr int C_QA = 0, C_KA = 512, C_VA = 640, C_UX = 768, C_GB = 1280, C_GC = 1792, C_QN = 2304, C_KN = 2816, C_VN = 3328;

constexpr size_t MiB = 1u << 20;
constexpr size_t WS_CTL = 0, CTL_ZERO_BYTES = 1 * MiB;
constexpr size_t WS_MOD = 1 * MiB;
constexpr size_t WS_ROPE = WS_MOD + 256 * 1024;
constexpr size_t WS_SLABCNT = WS_MOD + 320 * 1024;
constexpr size_t WS_PCUM = WS_MOD + 384 * 1024;
constexpr size_t WS_TOKER = WS_MOD + 512 * 1024;
constexpr size_t WS_TOKG = WS_MOD + 768 * 1024;
constexpr size_t WS_TOKPOS = WS_MOD + 1024 * 1024;
constexpr size_t WS_HCTX = 4 * MiB;
constexpr size_t WS_WIN = 8 * MiB;
constexpr size_t WS_WBR = 35 * MiB;
constexpr size_t WS_WOUT = 41 * MiB;
constexpr size_t WS_WGUD = 45 * MiB;
constexpr size_t WS_WDND = 56 * MiB;
constexpr size_t WS_WGUM = 62 * MiB;
constexpr size_t WS_WDNM = 118 * MiB;
constexpr size_t WS_RS = 146 * MiB;
constexpr size_t WS_HX = 230 * MiB;
constexpr size_t WS_ZM = 296 * MiB;
constexpr size_t WS_ZG = 544 * MiB;
constexpr size_t WS_O = 742 * MiB;
constexpr size_t WS_XG = WS_ZM;
constexpr size_t WS_HM = WS_ZM + 132 * MiB;
constexpr size_t WS_XG8 = WS_O;
constexpr size_t WS_HX8 = 841 * MiB;
constexpr size_t WS_WING8 = 874 * MiB;
constexpr size_t WS_END = 880 * MiB;
static_assert(WS_WIN + (size_t)2 * INC * D * 2 <= WS_WBR && WS_WGUD + (size_t)2 * FFD * D * 2 <= WS_WDND && WS_WDND + (size_t)D * FFD * 2 <= WS_WGUM, "ws map (weights)");
static_assert(WS_WGUM + (size_t)NE * 2 * FFE * D <= WS_WDNM && WS_WDNM + (size_t)NE * D * FFE <= WS_RS && WS_RS + (size_t)TA * D * 2 <= WS_HX, "ws map (moe weights, residual stream)");
static_assert(WS_HX + (size_t)TA * D * 2 <= WS_ZM && WS_ZM + (size_t)TA * ZMC * 2 <= WS_ZG && WS_ZG + (size_t)TA * ZGC * 2 <= WS_O && WS_O + (size_t)3 * TA * BW * 2 <= WS_END, "ws map (activations)");
static_assert(WS_HM + (size_t)MAXPAN * 256 * FFE <= WS_O && WS_XG8 + (size_t)MAXPAN * 256 * D <= WS_END && (size_t)MAXPAN * 256 * D * 2 <= 132 * MiB && (size_t)TA * D * 4 <= 132 * MiB, "ws map (moe)");
constexpr int CW_BAR = 4096;

constexpr int RING_OFF = 0, RING_BYTES = 131072;
constexpr int LDSCTL_OFF = RING_BYTES, MISC_OFF = LDSCTL_OFF + 320;
constexpr int ROPEL_OFF = RING_BYTES + 1024, ROPEL_BYTES = 192 * 16 * 2 * 4;
constexpr int LDS_BYTES = 163840;
static_assert(ROPEL_OFF + ROPEL_BYTES <= LDS_BYTES, "lds map");

#define GAS __attribute__((address_space(1)))
#define LAS __attribute__((address_space(3)))
typedef unsigned short bf16;
typedef unsigned v4u __attribute__((ext_vector_type(4)));
typedef unsigned v2u __attribute__((ext_vector_type(2)));
typedef float f32x4 __attribute__((ext_vector_type(4)));
typedef float f32x2 __attribute__((ext_vector_type(2)));
#define LDS_WAIT() asm volatile("s_waitcnt lgkmcnt(0)" ::: "memory")
#define VM_WAIT() asm volatile("s_waitcnt vmcnt(0)" ::: "memory")
__device__ __forceinline__ unsigned f2bf(float f) { unsigned u = __builtin_bit_cast(unsigned, f); return (u + 0x7fffu + ((u >> 16) & 1u)) >> 16; }
__device__ __forceinline__ unsigned pk2(float lo, float hi) { return f2bf(lo) | (f2bf(hi) << 16); }
__device__ __forceinline__ float bflo(unsigned w) { return __uint_as_float(w << 16); }
__device__ __forceinline__ float bfhi(unsigned w) { return __uint_as_float(w & 0xffff0000u); }
__device__ __forceinline__ float bf2f(bf16 b) { return __uint_as_float(((unsigned)b) << 16); }

#define XB_TMO      128
#define XB_XCNT(j)  (256  + 64 * (j))
#define XB_XSUB(j)  (1280 + 64 * (j))
#define XB_XGEN(j)  (2304 + 64 * (j))
#define XB_TOP      3328
#define XB_TOPGEN   3392
#define XCD_BAR_WORDS 3456
#define XB_SPIN_CAP (1u << 21)

__device__ __forceinline__ unsigned xb_ld(unsigned* p)              { return __hip_atomic_load(p, __ATOMIC_RELAXED, __HIP_MEMORY_SCOPE_AGENT); }
__device__ __forceinline__ unsigned xb_add(unsigned* p, unsigned v) { return __hip_atomic_fetch_add(p, v, __ATOMIC_RELAXED, __HIP_MEMORY_SCOPE_AGENT); }
__device__ __forceinline__ unsigned xb_xcc_id() { return (unsigned)__builtin_amdgcn_s_getreg((3 << 11) | 20) & 0xFu; }
#define XB_SPIN(cond, bar) do { unsigned _sp = 0; while (cond) { __builtin_amdgcn_s_sleep(1); \
    if ((++_sp & 255u) == 0u) { if (xb_ld(&(bar)[XB_TMO])) break; if (_sp > XB_SPIN_CAP) { atomicAdd(&(bar)[XB_TMO], 1u); break; } } } } while (0)

struct XcdBarrier {
    unsigned* bar; unsigned x;
    volatile LAS unsigned* st;
    int w;
};

__device__ __forceinline__ XcdBarrier xcd_barrier_post(unsigned* bar, volatile LAS unsigned* st) {
    XcdBarrier b; b.bar = bar; b.x = xb_xcc_id(); b.st = st; b.w = 0;
    if (threadIdx.x == 0) (void)xb_add(&bar[XB_XCNT(b.x)], 1u);
    return b;
}
__device__ __forceinline__ void xcd_barrier_complete(unsigned* bar, unsigned x, unsigned& nloc, unsigned& nx) {
    const unsigned G = gridDim.x * gridDim.y * gridDim.z;
    unsigned sum, cnt, mine, sp = 0u;
    for (;;) {
        sum = 0u; cnt = 0u; mine = 0u;
#pragma unroll
        for (unsigned j = 0; j < 16; ++j) { const unsigned c = xb_ld(&bar[XB_XCNT(j)]); sum += c; cnt += (c > 0u) ? 1u : 0u; mine = (j == x) ? c : mine; }
        if (sum == G) break;
        __builtin_amdgcn_s_sleep(1);
        if ((++sp & 255u) == 0u) { if (xb_ld(&bar[XB_TMO])) break; if (sp > XB_SPIN_CAP) { atomicAdd(&bar[XB_TMO], 1u); break; } }
    }
    nloc = mine > 0u ? mine : 1u; nx = cnt > 0u ? cnt : 1u;
}

__device__ __forceinline__ void xcd_barrier(const XcdBarrier& b) {
    asm volatile("s_waitcnt vmcnt(0)" ::: "memory");
    __syncthreads();
    if (b.w == 0 && mk_lane() == 0) {
        unsigned* bar = b.bar; { GAS unsigned* bg_ = (GAS unsigned*)bar; asm volatile("" : "+s"(bg_)); bar = (unsigned*)bg_; }
        __builtin_amdgcn_s_waitcnt(0);
        unsigned nloc = b.st[0], nx = b.st[1];
        if (nloc == 0u) { xcd_barrier_complete(bar, b.x, nloc, nx); b.st[0] = nloc; b.st[1] = nx; }
        const unsigned old = xb_add(&bar[XB_XSUB(b.x)], 1u);
        const unsigned gen = old / nloc;
        if (old + 1u == (gen + 1u) * nloc) {
            __builtin_amdgcn_fence(__ATOMIC_RELEASE, "agent");
            asm volatile("s_waitcnt vmcnt(0)" ::: "memory");
            const unsigned og = xb_add(&bar[XB_TOP], 1u);
            const unsigned tg = og / nx;
            if (og + 1u == (tg + 1u) * nx) xb_add(&bar[XB_TOPGEN], 1u);
            else XB_SPIN(xb_ld(&bar[XB_TOPGEN]) == tg, bar);
            __builtin_amdgcn_fence(__ATOMIC_ACQUIRE, "agent");
            xb_add(&bar[XB_XGEN(b.x)], 1u);
            asm volatile("s_waitcnt vmcnt(0)" ::: "memory");
        } else {
            XB_SPIN(xb_ld(&bar[XB_XGEN(b.x)]) == gen, bar);
            __builtin_amdgcn_fence(__ATOMIC_ACQUIRE, "agent");
            asm volatile("s_waitcnt vmcnt(0)" ::: "memory");
        }
    }
    __syncthreads();
}

struct Frame {
    LAS unsigned char* lds;
    volatile LAS unsigned* MISC;
    unsigned* ctl;
    int vcu, G;
    int wv;
};
enum { I_X = 0, I_C, I_CTX, I_CCTX, I_WADA, I_BADA, I_GPREMIX, I_GPOSTMIX, I_GPREFFN, I_GPOSTFFN, I_WIN, I_BGATE, I_SINK, I_CONVW, I_RPB, I_WBRANCH, I_WOUT, I_WGUD, I_WDND, I_WROUTER, I_BROUTER, I_WGUM, I_WDNM };

__device__ __forceinline__ float wave_sum(float v) {
    v += mk_dpp<0xB1>(v); v += mk_dpp<0x4E>(v); v += mk_dpp<0x141>(v); v += mk_dpp<0x140>(v);
    v += mk_dpp<0x142, 0xa>(v); v += mk_dpp<0x143, 0xc>(v);
    return __builtin_bit_cast(float, __builtin_amdgcn_readlane(__builtin_bit_cast(int, v), 63));
}
__device__ __forceinline__ float wave_max(float v) {
    v = fmaxf(v, mk_dpp<0xB1>(v)); v = fmaxf(v, mk_dpp<0x4E>(v)); v = fmaxf(v, mk_dpp<0x141>(v)); v = fmaxf(v, mk_dpp<0x140>(v));
    const float a = __builtin_bit_cast(float, __builtin_amdgcn_readlane(__builtin_bit_cast(int, v), 0)), b = __builtin_bit_cast(float, __builtin_amdgcn_readlane(__builtin_bit_cast(int, v), 16)),
                c = __builtin_bit_cast(float, __builtin_amdgcn_readlane(__builtin_bit_cast(int, v), 32)), d = __builtin_bit_cast(float, __builtin_amdgcn_readlane(__builtin_bit_cast(int, v), 48));
    return fmaxf(fmaxf(a, b), fmaxf(c, d));
}

__device__ __forceinline__ void row_store_fp8(unsigned char* p, int lane, const f32x4 (&h)[4], float sc) {
#pragma unroll
    for (int c = 0; c < 2; ++c) { const f32x4 a = __builtin_elementwise_min(__builtin_elementwise_max(h[2 * c] * sc, (f32x4){-448.f, -448.f, -448.f, -448.f}), (f32x4){448.f, 448.f, 448.f, 448.f}), b = __builtin_elementwise_min(__builtin_elementwise_max(h[2 * c + 1] * sc, (f32x4){-448.f, -448.f, -448.f, -448.f}), (f32x4){448.f, 448.f, 448.f, 448.f});
        v2u w; w.x = pg8::pk4_fp8(a.x, a.y, a.z, a.w); w.y = pg8::pk4_fp8(b.x, b.y, b.z, b.w);
        *(v2u*)(p + 8 * (64 * c + lane)) = w; }
}

__device__ __forceinline__ void tr_item(const float* W, int N, int k0, int n0, bf16* WT, int Kd, int drow0, LAS float* scr, int lane) {
#pragma unroll
    for (int i = 0; i < 8; ++i) { const int kk = 8 * i + (lane >> 3), c4 = 4 * (lane & 7); const f32x4 v = *(const f32x4*)(W + (size_t)(k0 + kk) * N + n0 + c4);
        LAS float* d = scr + kk * 33 + c4; d[0] = v.x; d[1] = v.y; d[2] = v.z; d[3] = v.w; }
    LDS_WAIT(); asm volatile("" ::: "memory");
    const int c = lane & 7;
#pragma unroll
    for (int j = 0; j < 4; ++j) { const int n = (lane >> 3) + 8 * j; const LAS float* s = scr + (8 * c) * 33 + n;
        v4u o; o.x = pk2(s[0 * 33], s[1 * 33]); o.y = pk2(s[2 * 33], s[3 * 33]); o.z = pk2(s[4 * 33], s[5 * 33]); o.w = pk2(s[6 * 33], s[7 * 33]);
        *(v4u*)(WT + (size_t)(drow0 + n) * Kd + k0 + 8 * c) = o; }
    LDS_WAIT(); asm volatile("" ::: "memory");
}
__device__ __forceinline__ void tr_matrix_item(const float* W, int K, int N, int ff, bf16* WT, int item, LAS float* scr, int lane) {
    const int nblk = N / 32, kb = item / nblk, nb = item % nblk, n0 = 32 * nb;
    int drow0 = n0;
    if (ff > 0) { const int isu = n0 >= ff ? 1 : 0, nn = n0 - isu * ff; drow0 = 256 * (nn >> 7) + 128 * isu + (nn & 127); }
    tr_item(W, N, 64 * kb, n0, WT, K, drow0, scr, lane);
}

__device__ __forceinline__ void tr_item8(const float* W, int N, int k0, int n0, unsigned char* WT, int Kd, int drow0, float scale, LAS float* scr, int lane) {
#pragma unroll
    for (int i = 0; i < 8; ++i) { const int kk = 8 * i + (lane >> 3), c4 = 4 * (lane & 7); const f32x4 v = *(const f32x4*)(W + (size_t)(k0 + kk) * N + n0 + c4);
        LAS float* d = scr + kk * 33 + c4; d[0] = v.x; d[1] = v.y; d[2] = v.z; d[3] = v.w; }
    LDS_WAIT(); asm volatile("" ::: "memory");
    const int n = lane >> 1, kh = lane & 1; const LAS float* s = scr + (32 * kh) * 33 + n;
    unsigned w[8];
#pragma unroll
    for (int j = 0; j < 8; ++j) w[j] = pg8::pk4_fp8(s[(4 * j) * 33] * scale, s[(4 * j + 1) * 33] * scale, s[(4 * j + 2) * 33] * scale, s[(4 * j + 3) * 33] * scale);
    v4u* dst = (v4u*)(WT + (size_t)(drow0 + n) * Kd + k0 + 32 * kh);
    dst[0] = (v4u){w[0], w[1], w[2], w[3]}; dst[1] = (v4u){w[4], w[5], w[6], w[7]};
    LDS_WAIT(); asm volatile("" ::: "memory");
}
__device__ __forceinline__ void tr_matrix_item8(const float* W, int K, int N, int ff, unsigned char* WT, float scale, int item, LAS float* scr, int lane) {
    const int nblk = N / 32, kb = item / nblk, nb = item % nblk, n0 = 32 * nb;
    int drow0 = n0;
    if (ff > 0) { const int isu = n0 >= ff ? 1 : 0, nn = n0 - isu * ff; drow0 = 256 * (nn >> 7) + 128 * isu + (nn & 127); }
    tr_item8(W, N, 64 * kb, n0, WT, K, drow0, scale, scr, lane);
}

__device__ __forceinline__ void row_load(const float* p, int lane, f32x4 (&v)[4]) {
#pragma unroll
    for (int c = 0; c < 2; ++c) { const f32x4* r = (const f32x4*)(p + 8 * (64 * c + lane)); v[2 * c] = r[0]; v[2 * c + 1] = r[1]; }
}
__device__ __forceinline__ void row_load_bf16(const bf16* p, int lane, f32x4 (&v)[4]) {
#pragma unroll
    for (int c = 0; c < 2; ++c) { const v4u w = *(const v4u*)(p + 8 * (64 * c + lane));
        v[2 * c] = (f32x4){bflo(w.x), bfhi(w.x), bflo(w.y), bfhi(w.y)}; v[2 * c + 1] = (f32x4){bflo(w.z), bfhi(w.z), bflo(w.w), bfhi(w.w)}; }
}
__device__ __forceinline__ void row_store(float* p, int lane, const f32x4 (&v)[4]) {
#pragma unroll
    for (int c = 0; c < 2; ++c) { f32x4* r = (f32x4*)(p + 8 * (64 * c + lane)); r[0] = v[2 * c]; r[1] = v[2 * c + 1]; }
}
__device__ __forceinline__ float row_rrms(const f32x4 (&v)[4]) {
    float s = 0.f;
#pragma unroll
    for (int j = 0; j < 4; ++j) s += (v[j].x * v[j].x + v[j].y * v[j].y) + (v[j].z * v[j].z + v[j].w * v[j].w);
    return 1.0f / sqrtf(wave_sum(s) * (1.0f / D) + RMS_EPS);
}
__device__ __forceinline__ void vec_load(const float* p, int lane, f32x4 (&v)[4]) { row_load(p, lane, v); }
__device__ __forceinline__ void row_normmod(const f32x4 (&x)[4], float rr, const f32x4 (&g)[4], const f32x4 (&shift)[4], const f32x4 (&scale)[4], f32x4 (&h)[4]) {
#pragma unroll
    for (int j = 0; j < 4; ++j) h[j] = (x[j] * rr * g[j]) * (scale[j] + 1.0f) + shift[j];
}
__device__ __forceinline__ void row_store_bf16(bf16* p, int lane, const f32x4 (&h)[4]) {
#pragma unroll
    for (int c = 0; c < 2; ++c) { v4u w; w.x = pk2(h[2 * c].x, h[2 * c].y); w.y = pk2(h[2 * c].z, h[2 * c].w); w.z = pk2(h[2 * c + 1].x, h[2 * c + 1].y); w.w = pk2(h[2 * c + 1].z, h[2 * c + 1].w);
        *(v4u*)(p + 8 * (64 * c + lane)) = w; }
}

namespace at {
typedef short bf16x8 __attribute__((ext_vector_type(8)));
typedef short s16x4 __attribute__((ext_vector_type(4)));
typedef short v4i16_t __attribute__((ext_vector_type(4)));
typedef float f32x16 __attribute__((ext_vector_type(16)));
constexpr int NS = 4, PF = 3, SLOT = 16384;
constexpr int LDS_TAB = NS * SLOT + 1024;
constexpr int LDS_TT = LDS_TAB + 8 * 2048 + 1024;
constexpr int MAXT = 160;
constexpr float LOG2E = 1.4426950408889634f, C2 = 0.125f * LOG2E;
__device__ __forceinline__ unsigned cvtpk(float lo, float hi) { unsigned r; asm volatile("v_cvt_pk_bf16_f32 %0, %1, %2" : "=v"(r) : "v"(lo), "v"(hi)); return r; }
__device__ __forceinline__ float hmax(float v) { auto rr = __builtin_amdgcn_permlane32_swap(__float_as_uint(v), __float_as_uint(v), false, false); return fmaxf(__uint_as_float(rr[0]), __uint_as_float(rr[1])); }
__device__ __forceinline__ float hsum(float v) { auto rr = __builtin_amdgcn_permlane32_swap(__float_as_uint(v), __float_as_uint(v), false, false); return __uint_as_float(rr[0]) + __uint_as_float(rr[1]); }

__device__ __forceinline__ void glds16(const void* gsrc, unsigned lds_dst) { unsigned keep;
    asm volatile("s_mov_b32 %0, m0\n\ts_mov_b32 m0, %2\n\ts_nop 0\n\tglobal_load_lds_dwordx4 %1, off\n\ts_mov_b32 m0, %0" : "=&s"(keep) : "v"(gsrc), "s"(lds_dst) : "memory"); }
__device__ __forceinline__ void tile_issue(LAS unsigned char* slot, const bf16* ZMp, size_t row0, int kcol, int vcol, int wid, int lane) {
    const bf16* ksrc = ZMp + (row0 + lane) * ZMC + kcol + wid * 8;
    const bf16* vsrc = ZMp + (row0 + 16 * (wid & 3) + (lane >> 2)) * ZMC + vcol + (wid >> 2) * 32 + (lane & 3) * 8;
    const unsigned dst = (unsigned)__builtin_amdgcn_readfirstlane((int)(unsigned)(uintptr_t)slot + wid * 1024);
    glds16(ksrc, dst); glds16(vsrc, dst + 8192u);
}
__device__ __forceinline__ void k_load_half(bf16x8 (&kf)[4], const LAS unsigned char* Ks, int h, int r32, int hi) {
    const LAS unsigned char* kb = Ks + hi * 1024 + r32 * 16 + h * 4096;
#pragma unroll
    for (int d0 = 0; d0 < 2; ++d0) { kf[2 * d0] = *(const LAS bf16x8*)(kb + d0 * 2048); kf[2 * d0 + 1] = *(const LAS bf16x8*)(kb + d0 * 2048 + 512); }
}
__device__ __forceinline__ void qk_tile(f32x16& p0, f32x16& p1, const LAS unsigned char* Ks, const bf16x8 (&kfa)[4], const bf16x8 (&qr)[4], int r32, int hi) {
    bf16x8 kfb[4]; k_load_half(kfb, Ks, 1, r32, hi);
    __builtin_amdgcn_sched_barrier(0);
#pragma unroll
    for (int r = 0; r < 16; ++r) { p0[r] = 0.f; p1[r] = 0.f; }
#pragma unroll
    for (int d0 = 0; d0 < 2; ++d0) {
        p0 = __builtin_amdgcn_mfma_f32_32x32x16_bf16(kfa[2 * d0], qr[d0], p0, 0, 0, 0);
        p1 = __builtin_amdgcn_mfma_f32_32x32x16_bf16(kfa[2 * d0 + 1], qr[d0], p1, 0, 0, 0);
    }
#pragma unroll
    for (int d0 = 0; d0 < 2; ++d0) {
        p0 = __builtin_amdgcn_mfma_f32_32x32x16_bf16(kfb[2 * d0], qr[2 + d0], p0, 0, 0, 0);
        p1 = __builtin_amdgcn_mfma_f32_32x32x16_bf16(kfb[2 * d0 + 1], qr[2 + d0], p1, 0, 0, 0);
    }
}
__device__ __forceinline__ s16x4 vtr(const LAS unsigned char* p) { return __builtin_bit_cast(s16x4, __builtin_amdgcn_ds_read_tr16_b64_v4i16((LAS v4i16_t*)p)); }
template <int LV> __device__ __forceinline__ constexpr bool live0(int r) { return LV == 2 ? r >= 12 : true; }
template <int LV> __device__ __forceinline__ constexpr bool live1(int r) { return LV == 1 ? r < 4 : true; }
template <bool RAW, int LV, int VAR = 0>
__device__ __forceinline__ void sm_pv(f32x16& x0, f32x16& x1, float& m, float& l, f32x16 (&o)[2], const LAS unsigned char* Vs, int lane, int hi, bf16x8 (&kfa)[4], const LAS unsigned char* Ksn, bool pre) {
    if (VAR == 2) { l += x0[0] + x1[15];
        bf16x8 pw_[4]; unsigned w_[16];
#pragma unroll
        for (int i = 0; i < 8; ++i) { w_[i] = cvtpk(x0[2 * i], x0[2 * i + 1]); w_[8 + i] = cvtpk(x1[2 * i], x1[2 * i + 1]); }
#pragma unroll
        for (int k = 0; k < 4; ++k) { typedef unsigned u32x4_ __attribute__((ext_vector_type(4))); u32x4_ t; t.x = w_[4 * k]; t.y = w_[4 * k + 1]; t.z = w_[4 * k + 2]; t.w = w_[4 * k + 3]; pw_[k] = __builtin_bit_cast(bf16x8, t); }
        const LAS unsigned char* vb_ = Vs + ((lane >> 4) & 1) * 32 + (lane & 3) * 8 + (4 * hi + ((lane & 15) >> 2)) * 64;
#pragma unroll
        for (int d0 = 0; d0 < 2; ++d0)
#pragma unroll
            for (int ks = 0; ks < 4; ++ks) { if ((LV == 1 && ks == 3) || (LV == 2 && ks == 0)) continue;
                const s16x4 lo = vtr(vb_ + d0 * 4096 + ks * 1024), hh = vtr(vb_ + d0 * 4096 + ks * 1024 + 512);
                const bf16x8 vf = (bf16x8){lo[0], lo[1], lo[2], lo[3], hh[0], hh[1], hh[2], hh[3]};
                o[d0] = __builtin_amdgcn_mfma_f32_32x32x16_bf16(vf, pw_[ks], o[d0], 0, 0, 0); }
        if (pre) k_load_half(kfa, Ksn, 0, lane & 31, hi);
        return; }
    if (VAR == 3) { if (pre) k_load_half(kfa, Ksn, 0, lane & 31, hi); l += x0[0] + x1[15] + x0[7] + x1[3]; o[0][0] += x0[1]; o[1][0] += x1[1]; return; }
    float rm = -INFINITY;
#pragma unroll
    for (int r = 0; r < 16; ++r) { if (live0<LV>(r)) rm = fmaxf(rm, x0[r]); if (live1<LV>(r)) rm = fmaxf(rm, x1[r]); }
    rm = hmax(rm);
    const float mn = fmaxf(m, RAW ? rm * C2 : rm);
    { const float sc = __builtin_amdgcn_exp2f(m - mn); l *= sc;
#pragma unroll
      for (int r = 0; r < 16; ++r) { o[0][r] *= sc; o[1][r] *= sc; } }
    m = mn;
    float sum = 0.f;
#pragma unroll
    for (int r = 0; r < 16; ++r) {
        if (live0<LV>(r)) { x0[r] = __builtin_amdgcn_exp2f(RAW ? __builtin_fmaf(x0[r], C2, -mn) : x0[r] - mn); sum += x0[r]; } else x0[r] = 0.f;
        if (live1<LV>(r)) { x1[r] = __builtin_amdgcn_exp2f(RAW ? __builtin_fmaf(x1[r], C2, -mn) : x1[r] - mn); sum += x1[r]; } else x1[r] = 0.f;
    }
    l += sum;
    bf16x8 pw[4];
    { unsigned w[16];
#pragma unroll
      for (int i = 0; i < 8; ++i) { w[i] = cvtpk(x0[2 * i], x0[2 * i + 1]); w[8 + i] = cvtpk(x1[2 * i], x1[2 * i + 1]); }
#pragma unroll
      for (int k = 0; k < 4; ++k) { typedef unsigned u32x4_ __attribute__((ext_vector_type(4))); u32x4_ t; t.x = w[4 * k]; t.y = w[4 * k + 1]; t.z = w[4 * k + 2]; t.w = w[4 * k + 3]; pw[k] = __builtin_bit_cast(bf16x8, t); } }
    if (pre) k_load_half(kfa, Ksn, 0, lane & 31, hi);
    const LAS unsigned char* vb = Vs + ((lane >> 4) & 1) * 32 + (lane & 3) * 8 + (4 * hi + ((lane & 15) >> 2)) * 64;
#pragma unroll
    for (int d0 = 0; d0 < 2; ++d0)
#pragma unroll
        for (int ks = 0; ks < 4; ++ks) {
            if ((LV == 1 && ks == 3) || (LV == 2 && ks == 0)) continue;
            const s16x4 lo = vtr(vb + d0 * 4096 + ks * 1024), hh = vtr(vb + d0 * 4096 + ks * 1024 + 512);
            const bf16x8 vf = (bf16x8){lo[0], lo[1], lo[2], lo[3], hh[0], hh[1], hh[2], hh[3]};
            o[d0] = __builtin_amdgcn_mfma_f32_32x32x16_bf16(vf, pw[ks], o[d0], 0, 0, 0);
        }
}
__device__ __forceinline__ void o_store(const f32x16 (&o)[2], float l, bf16* orow, int hi) {
    const float inv = __builtin_amdgcn_rcpf(hsum(l));
#pragma unroll
    for (int d0 = 0; d0 < 2; ++d0)
#pragma unroll
        for (int gp = 0; gp < 2; ++gp) {
            unsigned w[2][2];
#pragma unroll
            for (int k = 0; k < 2; ++k) { const int g = 2 * gp + k; w[k][0] = cvtpk(o[d0][4 * g] * inv, o[d0][4 * g + 1] * inv); w[k][1] = cvtpk(o[d0][4 * g + 2] * inv, o[d0][4 * g + 3] * inv); }
            unsigned rcv[2];
#pragma unroll
            for (int i = 0; i < 2; ++i) { const unsigned snd = hi ? w[0][i] : w[1][i];
                auto rr = __builtin_amdgcn_permlane32_swap(snd, snd, false, false); rcv[i] = hi ? rr[0] : rr[1]; }
            v4u st; if (hi) { st.x = rcv[0]; st.y = rcv[1]; st.z = w[1][0]; st.w = w[1][1]; } else { st.x = w[0][0]; st.y = w[0][1]; st.z = rcv[0]; st.w = rcv[1]; }
            *(v4u*)(orow + 32 * d0 + 16 * gp + 8 * hi) = st;
        }
}
#define AT_WAIT_BAR(N) asm volatile("s_waitcnt vmcnt(" #N ")\n\ts_barrier" ::: "memory")

struct UDesc { int kind, b, hh, blk, cq, nw, lo; };
__device__ __forceinline__ UDesc unit_desc(int i, int vcu, int UPW, bool ctx_out) {
    UDesc d; d.kind = -1; d.b = 0; d.hh = 0; d.blk = 0; d.cq = 0; d.nw = 0; d.lo = 0;
    if (i < 2 * UPW) { const int u = vcu * UPW + (i < UPW ? i : i - UPW); if (u >= 1024) return d; d.kind = i < UPW ? 0 : 1; d.b = u >> 8;
        if (d.kind == 0) { d.hh = (u >> 5) & 7; d.blk = u & 31; } else { d.hh = (u >> 7) & 1; d.blk = u & 127; } }
    else if (i == 2 * UPW) { if (!ctx_out || vcu >= 64) return d; d.cq = 1;
        if (vcu < 32) { d.kind = 1; d.b = vcu >> 3; d.hh = (vcu >> 2) & 1; d.blk = vcu & 3; } else { d.kind = 0; d.b = (vcu - 32) >> 3; d.hh = (vcu - 32) & 7; d.blk = 0; } }
    else return d;
    if (!d.cq) {
        if (d.kind == 1) { d.lo = max(0, 2 - d.blk); d.nw = min(4, 129 - d.blk) - d.lo + 1; }
        else { d.lo = min(max(4 * d.blk - 4, 0), 120); d.nw = min(max(4 * d.blk - 1, 0), 120) + 7 - d.lo + 1; }
    }
    return d;
}
__device__ __forceinline__ void tile_src(const UDesc& d, int t, int& row0, int& cols) {
    const int kcol = d.kind == 1 ? C_KA + d.hh * 64 : C_KN + d.hh * 64, vcol = d.kind == 1 ? C_VA + d.hh * 64 : C_VN + d.hh * 64;
    cols = kcol | (vcol << 16);
    if (t < d.nw) row0 = d.kind == 1 ? d.b * SEQ + 64 * d.blk - 128 + 64 * (d.lo + t) : d.b * SEQ + 64 * (d.lo + t);
    else row0 = TL + d.b * CTXL + 64 * (t - d.nw);
}
__device__ __forceinline__ size_t q_row(const UDesc& d, int wid, int r32) {
    if (d.kind == 1) { const int qrel = 32 * (wid >> 2) + r32; return d.cq ? (size_t)TL + (size_t)d.b * CTXL + 64 * d.blk + qrel : (size_t)d.b * SEQ + 64 * d.blk + qrel; }
    const int pair = wid >> 1, c = 32 * (wid & 1) + r32;
    return d.cq ? (size_t)TL + (size_t)d.b * CTXL + 64 * pair + c : (size_t)d.b * SEQ + (size_t)(4 * d.blk + pair) * 64 + c;
}
__device__ __forceinline__ void q_load(const UDesc& d, const bf16* ZMp, int wid, int r32, int hi, bf16x8 (&qr)[4]) {
    const int qcol = d.kind == 1 ? C_QA + (d.hh * 4 + (wid & 3)) * 64 : C_QN + d.hh * 64;
    const bf16* p = ZMp + q_row(d, wid, r32) * ZMC + qcol + 8 * hi;
#pragma unroll
    for (int d0 = 0; d0 < 4; ++d0) qr[d0] = *(const bf16x8*)(p + 16 * d0);
}

template <int VAR = 0>
__device__ __forceinline__ void attn_phase(LAS unsigned char* lds, const bf16* ZMp, bf16* OAp, bf16* OCp, const float* sinkp, const float* rpbl, int vcu, int G, bool ctx_out, int tid, int wid, int lane) {
    const int r32 = lane & 31, hi = lane >> 5;
    const int UPW = (1024 + G - 1) / G, NU = 2 * UPW + 1;
    LAS int* tt = (LAS int*)(lds + LDS_TT);
    int Ttot = 0;
    for (int i = 0; i < NU; ++i) { const UDesc d = unit_desc(i, vcu, UPW, ctx_out); if (d.kind < 0) continue; const int nt = d.nw + 4;
        for (int t = tid; t < nt; t += NWAVES * 64) { int row0, cols; tile_src(d, t, row0, cols); if (Ttot + t < MAXT) { tt[2 * (Ttot + t)] = row0; tt[2 * (Ttot + t) + 1] = cols; } }
        Ttot += nt; }
    if (Ttot > MAXT) Ttot = MAXT;
    if (tid < 8) ((LAS float*)(lds + LDS_TT + MAXT * 8))[tid] = sinkp[tid] * LOG2E;
    for (int u = tid; u < 8 * 480; u += NWAVES * 64) { const int h = u / 480, e = u - 480 * h, dr = e >> 5, dc = e & 31; ((LAS float*)(lds + LDS_TAB))[h * 512 + e] = dc < 31 ? rpbl[(h * 15 + dr) * 31 + dc] * LOG2E : 0.f; }
    asm volatile("s_waitcnt lgkmcnt(0)\n\ts_barrier" ::: "memory");
#define AT_ISSUE(T) do { const int row0_ = __builtin_amdgcn_readfirstlane(tt[2 * (T)]), cols_ = __builtin_amdgcn_readfirstlane(tt[2 * (T) + 1]); \
        tile_issue(lds + ((T) & (NS - 1)) * SLOT, ZMp, (size_t)row0_, cols_ & 0xffff, cols_ >> 16, wid, lane); } while (0)
    for (int T = 0; T < PF && T < Ttot; ++T) AT_ISSUE(T);
    int Tb = 0;
    bf16x8 qn[4];
    { int i0 = 0; UDesc d0 = unit_desc(0, vcu, UPW, ctx_out); while (d0.kind < 0 && i0 + 1 < NU) { ++i0; d0 = unit_desc(i0, vcu, UPW, ctx_out); } if (d0.kind >= 0) q_load(d0, ZMp, wid, r32, hi, qn); }
    for (int i = 0; i < NU; ++i) {
        const UDesc d = unit_desc(i, vcu, UPW, ctx_out); if (d.kind < 0) continue;
        bf16x8 qr[4];
#pragma unroll
        for (int k = 0; k < 4; ++k) qr[k] = qn[k];
        { int j = i + 1; UDesc dn = unit_desc(j, vcu, UPW, ctx_out); while (dn.kind < 0 && j + 1 < NU) { ++j; dn = unit_desc(j, vcu, UPW, ctx_out); } if (dn.kind < 0) dn = d; q_load(dn, ZMp, wid, r32, hi, qn); }
        const int NT = d.nw + 4;
        f32x16 o[2];
#pragma unroll
        for (int r = 0; r < 16; ++r) { o[0][r] = 0.f; o[1][r] = 0.f; }
        float m, l;
        if (d.kind == 1) {
            const int head = d.hh * 4 + (wid & 3), qrel = 32 * (wid >> 2) + r32;
            m = ((const LAS float*)(lds + LDS_TT + MAXT * 8))[head]; l = (hi == 0) ? 1.0f : 0.0f;
            bf16x8 kfa[4];
#pragma unroll
            for (int k = 0; k < 4; ++k) kfa[k] = (bf16x8){0, 0, 0, 0, 0, 0, 0, 0};
            int t = 0;
            do {
                const int T = Tb + t;
                if (T + 2 < Ttot) AT_WAIT_BAR(2); else AT_WAIT_BAR(0);
                if (t == NT - 1) asm volatile("" : "+v"(qn[0]), "+v"(qn[1]), "+v"(qn[2]), "+v"(qn[3]));
                if (VAR != 5 && T + PF < Ttot) AT_ISSUE(T + PF);
                const LAS unsigned char* sl = lds + (T & (NS - 1)) * SLOT;
                const LAS unsigned char* sln = lds + ((T + 1) & (NS - 1)) * SLOT; const bool pre = t + 1 < NT;
                if (t == 0) k_load_half(kfa, sl, 0, r32, hi);
                f32x16 x0, x1; qk_tile(x0, x1, sl, kfa, qr, r32, hi);
                const int j = d.lo + t;
                if (t < d.nw && (j == 0 || j == 4)) {
                    const int dq = qrel + 128 - 64 * j - 4 * hi;
#pragma unroll
                    for (int r = 0; r < 16; ++r) { const int dd = dq - ((r & 3) + 8 * (r >> 2));
                        x0[r] = (dd <= 128 && dd >= -128) ? x0[r] * C2 : -INFINITY; x1[r] = (dd - 32 <= 128 && dd - 32 >= -128) ? x1[r] * C2 : -INFINITY; }
                    sm_pv<false, 0, VAR>(x0, x1, m, l, o, sl + 8192, lane, hi, kfa, sln, pre);
                } else sm_pv<true, 0, VAR>(x0, x1, m, l, o, sl + 8192, lane, hi, kfa, sln, pre);
            } while (++t < NT);
            o_store(o, l, OAp + q_row(d, wid, r32) * BW + head * 64, hi);
        } else {
            const int half = wid & 1, c = 32 * half + r32, r = 4 * d.blk + (wid >> 1);
            const int r0w = min(max(r - 4, 0), 120), c0 = min(max(c - 8, 0), 48);
            const LAS float* tab = (const LAS float*)(lds + LDS_TAB + d.hh * 2048);
            unsigned vm = 0u;
#pragma unroll
            for (int r_ = 0; r_ < 16; ++r_) { const int kc = (r_ & 3) + 8 * (r_ >> 2) + 4 * hi; vm |= ((unsigned)(kc - c0) < 16u ? 1u : 0u) << r_; vm |= ((unsigned)(kc + 32 - c0) < 16u ? 1u : 0u) << (16 + r_); }
            m = -1e30f; l = 0.f;
            bf16x8 kfa[4];
#pragma unroll
            for (int k = 0; k < 4; ++k) kfa[k] = (bf16x8){0, 0, 0, 0, 0, 0, 0, 0};
            int t = 0;
            do {
                const int T = Tb + t;
                if (T + 2 < Ttot) AT_WAIT_BAR(2); else AT_WAIT_BAR(0);
                if (t == NT - 1) asm volatile("" : "+v"(qn[0]), "+v"(qn[1]), "+v"(qn[2]), "+v"(qn[3]));
                if (VAR != 5 && T + PF < Ttot) AT_ISSUE(T + PF);
                const int kr = d.lo + t;
                const bool use = !(t < d.nw && (kr < r0w || kr > r0w + 7));
                const bool usen = !(t + 1 < d.nw && (kr + 1 < r0w || kr + 1 > r0w + 7));
                const LAS unsigned char* sl = lds + (T & (NS - 1)) * SLOT; const LAS unsigned char* sln = lds + ((T + 1) & (NS - 1)) * SLOT; const bool pre = usen && t + 1 < NT;
                if (!use) { if (pre) k_load_half(kfa, sln, 0, r32, hi); continue; }
                if (t == 0) k_load_half(kfa, sl, 0, r32, hi);
                f32x16 x0, x1; qk_tile(x0, x1, sl, kfa, qr, r32, hi);
                if (t < d.nw) {
                    const LAS float* tb = tab + (kr - r + 7) * 32 + (4 * hi - c + 15);
                    if (half == 0) {
                        float b0[16], b1[4];
#pragma unroll
                        for (int r_ = 0; r_ < 16; ++r_) { const int rr = (r_ & 3) + 8 * (r_ >> 2); b0[r_] = tb[rr]; if (r_ < 4) b1[r_] = tb[rr + 32]; }
#pragma unroll
                        for (int r_ = 0; r_ < 16; ++r_) {
                            x0[r_] = ((vm >> r_) & 1u) ? __builtin_fmaf(x0[r_], C2, b0[r_]) : -INFINITY;
                            if (r_ < 4) x1[r_] = ((vm >> (16 + r_)) & 1u) ? __builtin_fmaf(x1[r_], C2, b1[r_]) : -INFINITY; }
                        sm_pv<false, 1, VAR>(x0, x1, m, l, o, sl + 8192, lane, hi, kfa, sln, pre);
                    } else {
                        float b0[4], b1[16];
#pragma unroll
                        for (int r_ = 0; r_ < 16; ++r_) { const int rr = (r_ & 3) + 8 * (r_ >> 2); if (r_ >= 12) b0[r_ - 12] = tb[rr]; b1[r_] = tb[rr + 32]; }
#pragma unroll
                        for (int r_ = 0; r_ < 16; ++r_) {
                            if (r_ >= 12) x0[r_] = ((vm >> r_) & 1u) ? __builtin_fmaf(x0[r_], C2, b0[r_ - 12]) : -INFINITY;
                            x1[r_] = ((vm >> (16 + r_)) & 1u) ? __builtin_fmaf(x1[r_], C2, b1[r_]) : -INFINITY; }
                        sm_pv<false, 2, VAR>(x0, x1, m, l, o, sl + 8192, lane, hi, kfa, sln, pre);
                    }
                } else sm_pv<true, 0, VAR>(x0, x1, m, l, o, sl + 8192, lane, hi, kfa, sln, pre);
            } while (++t < NT);
            o_store(o, l, OCp + q_row(d, wid, r32) * BW + d.hh * 64, hi);
        }
        Tb += NT;
    }
    AT_WAIT_BAR(0);
#undef AT_ISSUE
}
}

constexpr int PH_PER_LAYER = 17, NPHASES = 1 + DEPTH * PH_PER_LAYER;
struct Args { const float* in[23]; float* out; unsigned char* ws; int ph_lo, ph_hi; };
typedef __attribute__((address_space(4))) const Args CArgs;
__global__ void __launch_bounds__(NWAVES * 64, 2) mk_fwd(Args args) {
    extern __shared__ __attribute__((aligned(16))) unsigned char lds[];
    Frame F;
    F.lds = (LAS unsigned char*)lds;
    F.MISC = (volatile LAS unsigned*)(F.lds + MISC_OFF);
    F.G = gridDim.x; { const int bx = blockIdx.x; F.vcu = (F.G % 8 == 0) ? (bx % 8) * (F.G / 8) + bx / 8 : bx; }
    F.ctl = (unsigned*)(args.ws + WS_CTL);
    for (int u = threadIdx.x; u < (ROPEL_OFF - LDSCTL_OFF) / 4; u += NWAVES * 64) ((LAS unsigned*)(F.lds + LDSCTL_OFF))[u] = 0u;
    for (int u = threadIdx.x; u < 192 * 16; u += NWAVES * 64) { const int idx = u >> 4, i = u & 15; const float pos = (float)(idx < 128 ? idx : idx - 128);
        const float inv = 1.0f / powf(10000.0f, (float)(2 * i) / 32.0f); const float ang = pos * inv;
        ((LAS float*)(F.lds + ROPEL_OFF))[2 * u] = cosf(ang); ((LAS float*)(F.lds + ROPEL_OFF))[2 * u + 1] = sinf(ang); }
    { int wv_ = __builtin_amdgcn_readfirstlane((int)(threadIdx.x >> 6)); asm volatile("" : "+s"(wv_)); F.wv = wv_; }
    __syncthreads();
    const int lo = args.ph_lo, hi = args.ph_hi;
    const bool fused = (hi - lo) > 1;
    XcdBarrier bar; bar.bar = F.ctl + CW_BAR; bar.x = 0; bar.st = nullptr; bar.w = F.wv;
    if (fused) { bar = xcd_barrier_post(F.ctl + CW_BAR, F.MISC + 8); bar.w = F.wv; }
#ifndef MK_MASK
#define MK_MASK 0xFFFFFFFFu
#endif
#define SLOT(k) ((k) == 0 ? 0 : (((k) - 1) % PH_PER_LAYER) + 1)
#define IN(k) (((MK_MASK >> SLOT(k)) & 1u) && lo <= (k) && (k) < hi)
#define GRID_BAR() do { if (fused) xcd_barrier(bar); } while (0)
    const int NGW = F.G * NWAVES;
#define PHASE_ENTER() GAS unsigned char* wsg_ = (GAS unsigned char*)args.ws; asm volatile("" : "+s"(wsg_)); unsigned char* ws = (unsigned char*)wsg_; float* outp = (float*)(GAS float*)args.out; (void)outp; const CArgs* ka = (const CArgs*)__builtin_amdgcn_kernarg_segment_ptr(); asm volatile("" : "+s"(ka)); \
    int tid_ = (F.wv << 6) | mk_lane(); asm volatile("" : "+v"(tid_)); const int lane = tid_ & 63; const int wave = __builtin_amdgcn_readfirstlane(tid_ >> 6); const int gw = F.vcu * NWAVES + wave; (void)gw; (void)lane; (void)ws; (void)ka;
#define INP(i) ((const float*)(const GAS float*)ka->in[i])
#define MOD ((float*)(GAS float*)(ws + WS_MOD))
#define ROPE ((float*)(GAS float*)(ws + WS_ROPE))
#define SLABCNT ((int*)(GAS int*)(ws + WS_SLABCNT))
#define PCUM ((int*)(GAS int*)(ws + WS_PCUM))
#define TOKER ((int*)(GAS int*)(ws + WS_TOKER))
#define TOKG ((float*)(GAS float*)(ws + WS_TOKG))
#define TOKPOS ((int*)(GAS int*)(ws + WS_TOKPOS))
#define HCTX ((float*)(GAS float*)(ws + WS_HCTX))
#define RS ((bf16*)(GAS bf16*)(ws + WS_RS))
#define W_IN ((bf16*)(GAS bf16*)(ws + WS_WIN))
#define W_BR ((bf16*)(GAS bf16*)(ws + WS_WBR))
#define W_OUT ((bf16*)(GAS bf16*)(ws + WS_WOUT))
#define W_GUD ((bf16*)(GAS bf16*)(ws + WS_WGUD))
#define W_DND ((bf16*)(GAS bf16*)(ws + WS_WDND))
#define W_GUM8 ((unsigned char*)(GAS unsigned char*)(ws + WS_WGUM))
#define W_DNM8 ((unsigned char*)(GAS unsigned char*)(ws + WS_WDNM))
#define HX ((bf16*)(GAS bf16*)(ws + WS_HX))
#define ZM ((bf16*)(GAS bf16*)(ws + WS_ZM))
#define ZG ((bf16*)(GAS bf16*)(ws + WS_ZG))
#define OA ((bf16*)(GAS bf16*)(ws + WS_O))
#define OB (OA + (size_t)TA * BW)
#define OC (OA + (size_t)2 * TA * BW)
#define SB ((float*)(GAS float*)(ws + WS_ZM))
#define Y16 ((bf16*)(GAS bf16*)(ws + WS_ZG))
#define HD ((bf16*)(GAS bf16*)(ws + WS_ZM))
#define XG ((bf16*)(GAS bf16*)(ws + WS_XG))
#define HM8 ((unsigned char*)(GAS unsigned char*)(ws + WS_HM))
#define XG8 ((unsigned char*)(GAS unsigned char*)(ws + WS_XG8))
#define HX8 ((unsigned char*)(GAS unsigned char*)(ws + WS_HX8))
#define W_ING8 ((unsigned char*)(GAS unsigned char*)(ws + WS_WING8))

    if (IN(0)) {
        PHASE_ENTER();
        {
            LAS float* scv = (LAS float*)(F.lds + RING_OFF);
            LAS float* red = scv + 5 * 1024;
            for (int u = tid_; u < 5 * 1024; u += NWAVES * 64) { const int bb = u >> 10, k = u & 1023; const float cv = bb < 4 ? INP(I_C)[bb * 1024 + k] : INP(I_CCTX)[k]; scv[u] = cv / (1.0f + __expf(-cv)); }
            __syncthreads();
            for (int it = blockIdx.x; it < 2 * 96; it += F.G) {
                const int l = it / 96, n = (it % 96) * 64 + lane;
                const float* wp = INP(I_WADA) + (size_t)l * D * 6144 + n;
                float a0 = 0.f, a1 = 0.f, a2 = 0.f, a3 = 0.f, a4 = 0.f;
                const int kb = wave * 128;
#pragma unroll 16
                for (int k = 0; k < 128; ++k) { const float w = wp[(size_t)(kb + k) * 6144];
                    a0 += scv[kb + k] * w; a1 += scv[1024 + kb + k] * w; a2 += scv[2048 + kb + k] * w; a3 += scv[3072 + kb + k] * w; a4 += scv[4096 + kb + k] * w; }
                red[(wave * 5 + 0) * 64 + lane] = a0; red[(wave * 5 + 1) * 64 + lane] = a1; red[(wave * 5 + 2) * 64 + lane] = a2; red[(wave * 5 + 3) * 64 + lane] = a3; red[(wave * 5 + 4) * 64 + lane] = a4;
                __syncthreads();
                if (tid_ < 320) { const int bb = tid_ >> 6, nn = tid_ & 63; float s = 0.f;
#pragma unroll
                    for (int w = 0; w < 8; ++w) s += red[(w * 5 + bb) * 64 + nn];
                    const int col = (it % 96) * 64 + nn;
                    MOD[((size_t)l * 5 + bb) * 6144 + col] = s + INP(I_BADA)[l * 6144 + col]; }
                __syncthreads();
            }
        }
        __syncthreads();
        {
            LAS float* scr = (LAS float*)(F.lds + RING_OFF + wave * 16384);
            constexpr int I_IN = (D / 64) * (INC / 32), I_BR = (BW / 64) * (D / 32), I_OUT = (D / 64) * (D / 32), I_GUD = (D / 64) * (2 * FFD / 32), I_DND = (FFD / 64) * (D / 32),
                          I_GUM = (D / 64) * (2 * FFE / 32), I_DNM = (FFE / 64) * (D / 32);
            constexpr int NITEMS = 2 * I_IN + 6 * I_BR + 2 * I_OUT + I_GUD + I_DND + NE * I_GUM + NE * I_DNM;
            for (int it = gw; it < NITEMS; it += NGW) {
                int r = it;
                if (r < 2 * I_IN) { const int l = r / I_IN, it2 = r % I_IN, n0 = 32 * (it2 % (INC / 32));
                    if (MK_GATE_F8 == 2) { tr_item8(INP(I_WIN) + (size_t)l * D * INC, INC, 64 * (it2 / (INC / 32)), n0, (unsigned char*)W_IN + (size_t)l * INC * D, D, n0, SC_WGU, scr, lane); continue; }
                    if (!MK_GATE_F8 || n0 < ZMC) tr_matrix_item(INP(I_WIN) + (size_t)l * D * INC, D, INC, 0, W_IN + (size_t)l * INC * D, it2, scr, lane);
                    if (MK_GATE_F8 && n0 >= ZMC) tr_item8(INP(I_WIN) + (size_t)l * D * INC, INC, 64 * (it2 / (INC / 32)), n0, W_ING8 + (size_t)l * ZGC * D, D, n0 - ZMC, SC_WGU, scr, lane);
                    continue; } r -= 2 * I_IN;
                if (r < 6 * I_BR) { const int q = r / I_BR; tr_matrix_item(INP(I_WBRANCH) + (size_t)q * BW * D, BW, D, 0, W_BR + (size_t)q * D * BW, r % I_BR, scr, lane); continue; } r -= 6 * I_BR;
                if (r < 2 * I_OUT) { const int l = r / I_OUT; tr_matrix_item(INP(I_WOUT) + (size_t)l * D * D, D, D, 0, W_OUT + (size_t)l * D * D, r % I_OUT, scr, lane); continue; } r -= 2 * I_OUT;
                if (r < I_GUD) { if (MK_DENSE_F8 >= 2) tr_matrix_item8(INP(I_WGUD), D, 2 * FFD, FFD, (unsigned char*)W_GUD, SC_WGU, r, scr, lane); else tr_matrix_item(INP(I_WGUD), D, 2 * FFD, FFD, W_GUD, r, scr, lane); continue; } r -= I_GUD;
                if (r < I_DND) { if (MK_DENSE_F8 >= 1) tr_matrix_item8(INP(I_WDND), FFD, D, 0, (unsigned char*)W_DND, SC_WDN, r, scr, lane); else tr_matrix_item(INP(I_WDND), FFD, D, 0, W_DND, r, scr, lane); continue; } r -= I_DND;
                if (r < NE * I_GUM) { const int e = r / I_GUM; tr_matrix_item8(INP(I_WGUM) + (size_t)e * D * 2 * FFE, D, 2 * FFE, FFE, W_GUM8 + (size_t)e * 2 * FFE * D, SC_WGU, r % I_GUM, scr, lane); continue; } r -= NE * I_GUM;
                { const int e = r / I_DNM; tr_matrix_item8(INP(I_WDNM) + (size_t)e * FFE * D, FFE, D, 0, W_DNM8 + (size_t)e * D * FFE, SC_WDN, r % I_DNM, scr, lane); }
            }
        }
        GRID_BAR();
    }

    for (int l = 0; l < DEPTH; ++l) {
        const int pb = 1 + l * PH_PER_LAYER;
        const bool ctx_out = (l < DEPTH - 1);
        const bool moe = (l & 1) != 0;
        const int rows_out = ctx_out ? TA : TL;
#define modl (MOD + (size_t)l * 5 * 6144)
#define xsrc_lat ((l == 0) ? INP(I_X) : (const float*)outp)
#define xsrc_ctx ((l == 0) ? INP(I_CTX) : (const float*)HCTX)

        if (IN(pb + 0) && l == 0) {
            PHASE_ENTER();
            const int chunk = (TL + NGW - 1) / NGW;
#define P1_ROW(t) do { const float* xr = (t) < TL ? xsrc_lat + (size_t)(t) * D : xsrc_ctx + (size_t)((t) - TL) * D; \
                f32x4 x[4], h[4]; row_load(xr, lane, x); const float rr = row_rrms(x); row_normmod(x, rr, gpre, sh, sc, h); if (MK_GATE_F8 < 2) row_store_bf16(HX + (size_t)(t) * D, lane, h); if (MK_GATE_F8) row_store_fp8(HX8 + (size_t)(t) * D, lane, h, SC_XG); } while (0)
            f32x4 gpre[4], sh[4], sc[4]; vec_load(INP(I_GPREMIX) + l * D, lane, gpre);
            for (int t0 = min(gw * chunk, TL), t1 = min(TL, t0 + chunk); t0 < t1; ) { const int bb = t0 >> 13, te = min(t1, (bb + 1) << 13); const float* md = modl + (size_t)bb * 6144;
                vec_load(md, lane, sh); vec_load(md + 1024, lane, sc);
                for (int t = t0; t < te; ++t) P1_ROW(t);
                t0 = te; }
            { const float* md = modl + (size_t)4 * 6144; vec_load(md, lane, sh); vec_load(md + 1024, lane, sc); for (int t = TL + gw; t < TA; t += NGW) P1_ROW(t); }
#undef P1_ROW
            GRID_BAR();
        }
        if (IN(pb + 1)) {
            PHASE_ENTER();
#if MK_GATE_F8 == 2
            {
                pg8::Gemm g{(const bf16*)HX8, (const bf16*)((unsigned char*)W_IN + (size_t)l * INC * D), TA, ZMC, D}; pg8::StaticOrder S; S.init(TA, ZMC, F.G, (int)blockIdx.x, MK_WGM);
                pg8::EpiZT<true> E{ZM, ZG, ROPE, TL / 256, INP(I_BGATE) + (size_t)l * 3 * D, 0, 1.0f / (SC_XG * SC_WGU)};
                pg8::gemm_phase<pg8::EpiZT<true>, pg8::StaticOrder, PG8_ALIGN, PG8_SP2>(F.lds + RING_OFF, g, S, E, F.wv);
            }
            {
                pg8::Gemm g{(const bf16*)HX8, (const bf16*)((unsigned char*)W_IN + (size_t)l * INC * D + (size_t)ZMC * D), rows_out, ZGC, D}; pg8::StaticOrder S; S.init(rows_out, ZGC, F.G, (int)blockIdx.x, MK_WGM);
                pg8::EpiZT<true> E{ZM, ZG, ROPE, TL / 256, INP(I_BGATE) + (size_t)l * 3 * D, ZMC / 256, 1.0f / (SC_XG * SC_WGU)};
                pg8::gemm_phase<pg8::EpiZT<true>, pg8::StaticOrder, PG8_ALIGN, PG8_SP2>(F.lds + RING_OFF, g, S, E, F.wv);
            }
#elif MK_GATE_F8
            {
                pg8::Gemm g{HX, W_IN + (size_t)l * INC * D, TA, ZMC, D}; pg8::StaticOrder S; S.init(TA, ZMC, F.G, (int)blockIdx.x, MK_WGM);
                pg8::EpiZM E{ZM, (const LAS float*)(F.lds + ROPEL_OFF), TL / 256};
                pg8::gemm_phase<pg8::EpiZM, pg8::StaticOrder, PG8_ALIGN, PG8_SP2>(F.lds + RING_OFF, g, S, E, F.wv);
            }
            {
                pg8::Gemm g{(const bf16*)HX8, (const bf16*)(W_ING8 + (size_t)l * ZGC * D), rows_out, ZGC, D}; pg8::StaticOrder S; S.init(rows_out, ZGC, F.G, ((int)blockIdx.x + 68) % F.G, MK_WGM);
                pg8::EpiZGate E{(unsigned char*)ZG, INP(I_BGATE) + (size_t)l * 3 * D, 1.0f / (SC_XG * SC_WGU)};
                pg8::gemm_phase<pg8::EpiZGate, pg8::StaticOrder, PG8_ALIGN, PG8_SP2>(F.lds + RING_OFF, g, S, E, F.wv);
            }
#else
            pg8::Gemm g{HX, W_IN + (size_t)l * INC * D, TA, INC, D}; pg8::StaticOrder S; S.init(TA, INC, F.G, (int)blockIdx.x, MK_WGM);
            pg8::EpiZ E{ZM, ZG, ROPE, TL / 256, INP(I_BGATE) + (size_t)l * 3 * D, 0, 1.0f};
            pg8::gemm_phase<pg8::EpiZ, pg8::StaticOrder, PG8_ALIGN, PG8_SP2>(F.lds + RING_OFF, g, S, E, F.wv);
#endif
            GRID_BAR();
        }
        if (IN(pb + 3)) {
            PHASE_ENTER();
            const float* sinkp = INP(I_SINK) + l * 8; const float* rpbp = INP(I_RPB) + (size_t)l * 8 * 15 * 31;
            const float* cw = INP(I_CONVW) + (size_t)l * 3 * BW;
            {
                const int ch = 8 * lane;
                float cwr[3][8];
#pragma unroll
                for (int k = 0; k < 3; ++k) { const f32x4 a = *(const f32x4*)(cw + k * BW + ch), b = *(const f32x4*)(cw + k * BW + ch + 4); cwr[k][0] = a.x; cwr[k][1] = a.y; cwr[k][2] = a.z; cwr[k][3] = a.w; cwr[k][4] = b.x; cwr[k][5] = b.y; cwr[k][6] = b.z; cwr[k][7] = b.w; }
#define CONV_U(row, u) do { const bf16* zp_ = ZM + (size_t)(row) * ZMC; const v4u a_ = *(const v4u*)(zp_ + C_UX + ch), g_ = *(const v4u*)(zp_ + C_GC + ch); \
                    u[0] = bflo(a_.x) * bflo(g_.x); u[1] = bfhi(a_.x) * bfhi(g_.x); u[2] = bflo(a_.y) * bflo(g_.y); u[3] = bfhi(a_.y) * bfhi(g_.y); \
                    u[4] = bflo(a_.z) * bflo(g_.z); u[5] = bfhi(a_.z) * bfhi(g_.z); u[6] = bflo(a_.w) * bflo(g_.w); u[7] = bfhi(a_.w) * bfhi(g_.w); } while (0)
#define CONV_Z(u) do { _Pragma("unroll") for (int q_ = 0; q_ < 8; ++q_) u[q_] = 0.f; } while (0)
#define CONV_OUT(t) do { const v4u gbv = *(const v4u*)(ZM + (size_t)(t) * ZMC + C_GB + ch); \
                    const float gb[8] = {bflo(gbv.x), bfhi(gbv.x), bflo(gbv.y), bfhi(gbv.y), bflo(gbv.z), bfhi(gbv.z), bflo(gbv.w), bfhi(gbv.w)}; float o[8]; \
                    _Pragma("unroll") for (int q = 0; q < 8; ++q) o[q] = gb[q] * (cwr[0][q] * um[q] + cwr[1][q] * uc[q] + cwr[2][q] * up[q]); \
                    v4u w; w.x = pk2(o[0], o[1]); w.y = pk2(o[2], o[3]); w.z = pk2(o[4], o[5]); w.w = pk2(o[6], o[7]); \
                    *(v4u*)(OB + (size_t)(t) * BW + ch) = w; } while (0)
                const int cchunk = (TL + NGW - 1) / NGW;
                const int t0 = min(gw * cchunk, TL), t1 = min(TL, t0 + cchunk);
                if (t0 < t1) {
                    float um[8], uc[8], up[8];
                    if ((t0 & (SEQ - 1)) > 0) CONV_U(t0 - 1, um); else CONV_Z(um);
                    CONV_U(t0, uc);
                    for (int t = t0; t < t1; ++t) {
                        const int s = t & (SEQ - 1);
                        if (s == 0) CONV_Z(um);
                        if (s + 1 < SEQ) CONV_U(t + 1, up); else CONV_Z(up);
                        CONV_OUT(t);
#pragma unroll
                        for (int q = 0; q < 8; ++q) { um[q] = uc[q]; uc[q] = up[q]; }
                    }
                }
                for (int t = TL + gw; t < rows_out; t += NGW) {
                    const int s = (t - TL) & (CTXL - 1);
                    float um[8], uc[8], up[8];
                    if (s > 0) CONV_U(t - 1, um); else CONV_Z(um);
                    CONV_U(t, uc);
                    if (s + 1 < CTXL) CONV_U(t + 1, up); else CONV_Z(up);
                    CONV_OUT(t);
                }
#undef CONV_U
#undef CONV_Z
#undef CONV_OUT
            }
            at::attn_phase(F.lds + RING_OFF, ZM, OA, OC, sinkp, rpbp, F.vcu, F.G, ctx_out, tid_, wave, lane);
#ifdef MK_ATTN_PROBE
            at::attn_phase<MK_ATTN_PROBE>(F.lds + RING_OFF, ZM, (bf16*)(GAS bf16*)(ws + WS_HX), (bf16*)(GAS bf16*)(ws + WS_HX) + (size_t)TA * BW, sinkp, rpbp, F.vcu, F.G, ctx_out, tid_, wave, lane);
#endif
            GRID_BAR();
        }
        if (IN(pb + 4)) {
            PHASE_ENTER();
            pg8::Gemm g{OA, W_BR + (size_t)l * 3 * D * BW, rows_out, D, BW};
            pg8::BranchOrder3 S; S.so.init(rows_out, D, F.G, (int)blockIdx.x, MK_WGM);
            pg8::EpiBranchAcc E{HX, ZG};
            pg8::gemm_phase<pg8::EpiBranchAcc, pg8::BranchOrder3, PG8_ALIGN, PG8_SP2>(F.lds + RING_OFF, g, S, E, F.wv);
            GRID_BAR();
        }
        if (IN(pb + 5)) {
            PHASE_ENTER();
            pg8::Gemm g{HX, W_OUT + (size_t)l * D * D, rows_out, D, D}; pg8::StaticOrder S; S.init(rows_out, D, F.G, (int)blockIdx.x, MK_WGM);
            pg8::EpiBf16P E{Y16, D};
            pg8::gemm_phase<pg8::EpiBf16P, pg8::StaticOrder, PG8_ALIGN, PG8_SP2>(F.lds + RING_OFF, g, S, E, F.wv);
            GRID_BAR();
        }
        if (IN(pb + 6)) {
            PHASE_ENTER();
            if (!moe) {
                const int chunk = (TL + NGW - 1) / NGW;
#define P6_ROW(t) do { f32x4 x[4], y[4], h[4]; \
                    if (l == 0) row_load((t) < TL ? INP(I_X) + (size_t)(t) * D : INP(I_CTX) + (size_t)((t) - TL) * D, lane, x); else row_load_bf16(RS + (size_t)(t) * D, lane, x); \
                    row_load_bf16(Y16 + (size_t)(t) * D, lane, y); const float ry = row_rrms(y); \
                    _Pragma("unroll") for (int j = 0; j < 4; ++j) x[j] = x[j] + gt[j] * (y[j] * ry * gpo[j]); \
                    row_store_bf16(RS + (size_t)(t) * D, lane, x); const float rx = row_rrms(x); row_normmod(x, rx, gpre, sh, sc, h); \
                    if (MK_DENSE_F8 >= 2) row_store_fp8((unsigned char*)HX + (size_t)(t) * D, lane, h, SC_XG); else row_store_bf16(HX + (size_t)(t) * D, lane, h); } while (0)
                f32x4 gpo[4], gt[4], gpre[4], sh[4], sc[4]; vec_load(INP(I_GPOSTMIX) + l * D, lane, gpo); vec_load(INP(I_GPREFFN) + l * D, lane, gpre);
                for (int t0 = min(gw * chunk, TL), t1 = min(TL, t0 + chunk); t0 < t1; ) { const int bb = t0 >> 13, te = min(t1, (bb + 1) << 13); const float* md = modl + (size_t)bb * 6144;
                    vec_load(md + 2048, lane, gt); vec_load(md + 3072, lane, sh); vec_load(md + 4096, lane, sc);
                    for (int t = t0; t < te; ++t) P6_ROW(t);
                    t0 = te; }
                if (rows_out > TL) { const float* md = modl + (size_t)4 * 6144; vec_load(md + 2048, lane, gt); vec_load(md + 3072, lane, sh); vec_load(md + 4096, lane, sc); for (int t = TL + gw; t < rows_out; t += NGW) P6_ROW(t); }
#undef P6_ROW
            } else {
                LAS int* sel = (LAS int*)(F.lds + RING_OFF);
                LAS int* rnk = sel + 256;
                LAS f32x4* wrT = (LAS f32x4*)(F.lds + RING_OFF + 4096);
                const float* wr = INP(I_WROUTER) + (size_t)(l >> 1) * D * NE; const float* br = INP(I_BROUTER) + (l >> 1) * NE;
                for (int u = tid_; u < D * NE; u += NWAVES * 64) ((LAS float*)wrT)[(u & 7) * D + (u >> 3)] = wr[u];
                LDS_WAIT(); __syncthreads();
                f32x4 gpo[4], gt[4], gpre[4], sh[4], sc[4]; vec_load(INP(I_GPOSTMIX) + l * D, lane, gpo); vec_load(INP(I_GPREFFN) + l * D, lane, gpre);
                for (int slab = F.vcu; slab < TL / 128; slab += F.G) {
                    { const float* md = modl + (size_t)((slab * 128) >> 13) * 6144; vec_load(md + 2048, lane, gt); vec_load(md + 3072, lane, sh); vec_load(md + 4096, lane, sc); }
                    for (int i = 0; i < 16; ++i) {
                        const int tl_ = wave * 16 + i, t = slab * 128 + tl_;
                        f32x4 x[4], y[4], h[4]; if (l == 0) row_load(INP(I_X) + (size_t)t * D, lane, x); else row_load_bf16(RS + (size_t)t * D, lane, x);
                        row_load_bf16(Y16 + (size_t)t * D, lane, y);
                        const float ry = row_rrms(y);
#pragma unroll
                        for (int j = 0; j < 4; ++j) x[j] = x[j] + gt[j] * (y[j] * ry * gpo[j]);
                        row_store_bf16(RS + (size_t)t * D, lane, x);
                        const float rx = row_rrms(x);
                        row_normmod(x, rx, gpre, sh, sc, h);
                        row_store_fp8((unsigned char*)HX + (size_t)t * D, lane, h, SC_XG);
                        float lg[8];
#pragma unroll
                        for (int e = 0; e < 8; ++e) lg[e] = 0.f;
#pragma unroll
                        for (int e = 0; e < 8; ++e)
#pragma unroll
                            for (int j = 0; j < 4; ++j) { const f32x4 w4 = wrT[e * (D / 4) + 2 * (64 * (j >> 1) + lane) + (j & 1)]; lg[e] += (h[j].x * w4.x + h[j].y * w4.y) + (h[j].z * w4.z + h[j].w * w4.w); }
#pragma unroll
                        for (int e = 0; e < 8; ++e) lg[e] = wave_sum(lg[e]) + br[e];
                        int e1 = 0; float v1 = lg[0];
#pragma unroll
                        for (int e = 1; e < 8; ++e) if (lg[e] > v1) { v1 = lg[e]; e1 = e; }
                        int e2 = -1; float v2 = -INFINITY;
#pragma unroll
                        for (int e = 0; e < 8; ++e) if (e != e1 && lg[e] > v2) { v2 = lg[e]; e2 = e; }
                        const float ex = __expf(v2 - v1), g1 = 1.0f / (1.0f + ex), g2 = ex / (1.0f + ex);
                        if (lane == 0) { sel[2 * tl_] = e1; sel[2 * tl_ + 1] = e2; TOKG[2 * (size_t)t] = g1; TOKG[2 * (size_t)t + 1] = g2; }
                    }
                    LDS_WAIT(); __syncthreads();
                    if (tid_ < 8) { int cnt = 0; for (int q = 0; q < 256; ++q) if (sel[q] == tid_) { rnk[q] = cnt; ++cnt; } SLABCNT[slab * 8 + tid_] = cnt; }
                    LDS_WAIT(); __syncthreads();
                    if (tid_ < 256) TOKER[(size_t)slab * 256 + tid_] = sel[tid_] | (rnk[tid_] << 8);
                    LDS_WAIT(); __syncthreads();
                }
            }
            GRID_BAR();
        }
        if (IN(pb + 7) && moe) {
            PHASE_ENTER();
            LAS int* scn = (LAS int*)(F.lds + RING_OFF);
            LAS int* pst = scn + 2048;
            for (int u = tid_; u < 2048; u += NWAVES * 64) scn[u] = SLABCNT[u];
            LDS_WAIT(); __syncthreads();
            if (tid_ < 8) { int run = 0; for (int q = 0; q < 256; ++q) { const int c = scn[q * 8 + tid_]; scn[q * 8 + tid_] = run; run += c; } pst[8 + tid_] = run; }
            LDS_WAIT(); __syncthreads();
            if (tid_ == 0) { int pan = 0; for (int e = 0; e < 8; ++e) { pst[e] = pan * 256; if (blockIdx.x == 0) PCUM[e] = pan; pan += (pst[8 + e] + 255) >> 8; } if (blockIdx.x == 0) PCUM[8] = pan; }
            LDS_WAIT(); __syncthreads();
            LAS int* posl = pst + 16;
            for (int slab = F.vcu; slab < TL / 128; slab += F.G) {
                if (tid_ < 256) { const int er = TOKER[(size_t)slab * 256 + tid_]; const int e = er & 255, rk = er >> 8; const int pos = pst[e] + scn[slab * 8 + e] + rk;
                    posl[tid_] = pos; TOKPOS[(size_t)slab * 256 + tid_] = pos; }
                LDS_WAIT(); __syncthreads();
                const v4u* srcb = (const v4u*)((const unsigned char*)HX + (size_t)slab * 128 * D);
#pragma unroll 4
                for (int i = 0; i < 16; ++i) { const int id = i * 512 + tid_, tk = id >> 6, chk = id & 63;
                    const v4u o = srcb[(size_t)tk * 64 + chk];
                    ((v4u*)(XG8 + (size_t)posl[2 * tk] * D))[chk] = o; ((v4u*)(XG8 + (size_t)posl[2 * tk + 1] * D))[chk] = o; }
                LDS_WAIT(); __syncthreads();
            }
            GRID_BAR();
        }
        if (IN(pb + 8) && !moe) {
            PHASE_ENTER();
            pg8::Gemm g{HX, W_GUD, rows_out, 2 * FFD, D}; pg8::StaticOrder S; S.init(rows_out, 2 * FFD, F.G, (int)blockIdx.x, MK_WGM);
#if MK_DENSE_F8 >= 2
            pg8::EpiSwiglu8T<true> E{(unsigned char*)HD, FFD, 1.0f / (SC_XG * SC_WGU), SC_H};
            pg8::gemm_phase<pg8::EpiSwiglu8T<true>, pg8::StaticOrder, PG8_ALIGN, PG8_SP2>(F.lds + RING_OFF, g, S, E, F.wv);
#elif MK_DENSE_F8 == 1
            pg8::EpiSwiglu8T<false> E{(unsigned char*)HD, FFD, 1.0f, SC_H};
            pg8::gemm_phase<pg8::EpiSwiglu8T<false>, pg8::StaticOrder, PG8_ALIGN, PG8_SP2>(F.lds + RING_OFF, g, S, E, F.wv);
#else
            pg8::EpiSwiglu E{HD, FFD};
            pg8::gemm_phase<pg8::EpiSwiglu, pg8::StaticOrder, PG8_ALIGN, PG8_SP2>(F.lds + RING_OFF, g, S, E, F.wv);
#endif
            GRID_BAR();
        }
        if (IN(pb + 9) && !moe) {
            PHASE_ENTER();
            pg8::Gemm g{HD, W_DND, rows_out, D, FFD}; pg8::StaticOrder S; S.init(rows_out, D, F.G, (int)blockIdx.x, MK_WGM);
#if MK_DENSE_F8 >= 1
            pg8::EpiBf16PS8 E{Y16, D, 1.0f / (SC_H * SC_WDN)};
            pg8::gemm_phase<pg8::EpiBf16PS8, pg8::StaticOrder, PG8_ALIGN, PG8_SP2>(F.lds + RING_OFF, g, S, E, F.wv);
#else
            pg8::EpiBf16P E{Y16, D};
            pg8::gemm_phase<pg8::EpiBf16P, pg8::StaticOrder, PG8_ALIGN, PG8_SP2>(F.lds + RING_OFF, g, S, E, F.wv);
#endif
            GRID_BAR();
        }
        if (moe) {
            for (int ck = 0; ck < NCHUNK; ++ck) {
                if (IN(pb + 10 + 2 * ck)) {
                    PHASE_ENTER();
                    pg8::MoeOrder S; S.nN = 2 * FFE / 256; S.G = F.G; S.c = F.vcu; S.p_lo = ck * PCH;
#pragma unroll
                    for (int k = 0; k < 8; ++k) S.pc[k] = __builtin_amdgcn_readfirstlane(PCUM[k]);
                    const int ptot = __builtin_amdgcn_readfirstlane(PCUM[8]); S.np = min(max(ptot - ck * PCH, 0), PCH);
                    pg8::Gemm g{(const bf16*)XG8, (const bf16*)W_GUM8, 0, 2 * FFE, D};
                    pg8::EpiSwiglu8 E{HM8, FFE, 1.0f / (SC_XG * SC_WGU), SC_H};
                    pg8::gemm_phase<pg8::EpiSwiglu8, pg8::MoeOrder, PG8_ALIGN, PG8_SP2>(F.lds + RING_OFF, g, S, E, F.wv);
                    GRID_BAR();
                }
                if (IN(pb + 11 + 2 * ck)) {
                    PHASE_ENTER();
                    pg8::MoeOrder S; S.nN = D / 256; S.G = F.G; S.c = F.vcu; S.p_lo = ck * PCH;
#pragma unroll
                    for (int k = 0; k < 8; ++k) S.pc[k] = __builtin_amdgcn_readfirstlane(PCUM[k]);
                    const int ptot = __builtin_amdgcn_readfirstlane(PCUM[8]); S.np = min(max(ptot - ck * PCH, 0), PCH);
                    pg8::Gemm g{(const bf16*)HM8, (const bf16*)W_DNM8, 0, D, FFE};
                    pg8::EpiBf16PS8 E{XG, D, 1.0f / (SC_H * SC_WDN)};
                    pg8::gemm_phase<pg8::EpiBf16PS8, pg8::MoeOrder, PG8_ALIGN, PG8_SP2>(F.lds + RING_OFF, g, S, E, F.wv);
                    GRID_BAR();
                }
            }
        }
        if (IN(pb + 16)) {
            PHASE_ENTER();
            const int chunk = (TL + NGW - 1) / NGW; const bool nextl = (l + 1 < DEPTH);
#define P9_ROW(t) do { f32x4 x[4], y[4]; row_load_bf16(RS + (size_t)(t) * D, lane, x); \
                if (!moe) row_load_bf16(Y16 + (size_t)(t) * D, lane, y); \
                else { const int p0 = TOKPOS[2 * (size_t)(t)], p1 = TOKPOS[2 * (size_t)(t) + 1]; const float g0 = TOKG[2 * (size_t)(t)], g1 = TOKG[2 * (size_t)(t) + 1]; \
                    f32x4 ya[4], yb[4]; row_load_bf16(XG + (size_t)p0 * D, lane, ya); row_load_bf16(XG + (size_t)p1 * D, lane, yb); \
                    _Pragma("unroll") for (int j = 0; j < 4; ++j) y[j] = ya[j] * g0 + yb[j] * g1; } \
                const float ry = row_rrms(y); \
                _Pragma("unroll") for (int j = 0; j < 4; ++j) x[j] = x[j] + gt[j] * (y[j] * ry * gpo[j]); \
                if (nextl) row_store_bf16(RS + (size_t)(t) * D, lane, x); else if ((t) < TL) row_store(outp + (size_t)(t) * D, lane, x); \
                if (nextl) { f32x4 h[4]; const float rx = row_rrms(x); row_normmod(x, rx, gpre, sh, sc, h); if (MK_GATE_F8 < 2) row_store_bf16(HX + (size_t)(t) * D, lane, h); if (MK_GATE_F8) row_store_fp8(HX8 + (size_t)(t) * D, lane, h, SC_XG); } } while (0)
            f32x4 gpo[4], gt[4], gpre[4], sh[4], sc[4]; vec_load(INP(I_GPOSTFFN) + l * D, lane, gpo); vec_load(INP(I_GPREMIX) + (nextl ? l + 1 : l) * D, lane, gpre);
            for (int t0 = min(gw * chunk, TL), t1 = min(TL, t0 + chunk); t0 < t1; ) { const int bb = t0 >> 13, te = min(t1, (bb + 1) << 13); const float* md = modl + (size_t)bb * 6144;
                vec_load(md + 5120, lane, gt); vec_load(md + (nextl ? 5 * 6144 : 0), lane, sh); vec_load(md + (nextl ? 5 * 6144 : 0) + 1024, lane, sc);
                for (int t = t0; t < te; ++t) P9_ROW(t);
                t0 = te; }
            if (rows_out > TL) { const float* md = modl + (size_t)4 * 6144; vec_load(md + 5120, lane, gt); vec_load(md + (nextl ? 5 * 6144 : 0), lane, sh); vec_load(md + (nextl ? 5 * 6144 : 0) + 1024, lane, sc);
                for (int t = TL + gw; t < rows_out; t += NGW) P9_ROW(t); }
#undef P9_ROW
            if (l + 1 < DEPTH) GRID_BAR();
        }
    }
#undef IN
#undef GRID_BAR
}

extern "C" void kernel_launch(void* const* d_in, const int* in_sizes, int n_in, void* d_out, int out_size, void* d_ws, size_t ws_size, hipStream_t stream) {
    static int grid = 0;
    if (grid == 0) {
        if (n_in != 23 || in_sizes[0] != TL * D || out_size != TL * D || ws_size < WS_END) { fprintf(stderr, "kernel_launch: unexpected shapes: n_in %d in0 %d out %d ws %zu (need %zu); nothing launched\n", n_in, n_in > 0 ? in_sizes[0] : -1, out_size, ws_size, (size_t)WS_END); grid = -1; return; }
        int dev = 0, cus = 0, per_cu = 0;
        if (hipGetDevice(&dev) != hipSuccess || hipDeviceGetAttribute(&cus, hipDeviceAttributeMultiprocessorCount, dev) != hipSuccess) { fprintf(stderr, "kernel_launch: device query failed\n"); grid = -1; return; }
        if (hipFuncSetAttribute((const void*)mk_fwd, hipFuncAttributeMaxDynamicSharedMemorySize, LDS_BYTES) != hipSuccess) { fprintf(stderr, "kernel_launch: hipFuncSetAttribute failed\n"); grid = -1; return; }
        if (hipOccupancyMaxActiveBlocksPerMultiprocessor(&per_cu, (const void*)mk_fwd, NWAVES * 64, LDS_BYTES) != hipSuccess || per_cu < 1) fprintf(stderr, "kernel_launch: note: occupancy query reports %d\n", per_cu);
        (void)hipGetLastError();
        grid = cus;
    }
    if (grid < 0) return;
    if (hipMemsetAsync((char*)d_ws + WS_CTL, 0, CTL_ZERO_BYTES, stream) != hipSuccess) { fprintf(stderr, "kernel_launch: memset failed\n"); return; }
    Args a{};
    for (int i = 0; i < 23; ++i) a.in[i] = (const float*)d_in[i];
    a.out = (float*)d_out; a.ws = (unsigned char*)d_ws;
#if MK_PER_PHASE
    for (int ph = 0; ph < NPHASES; ++ph) { a.ph_lo = ph; a.ph_hi = ph + 1; hipLaunchKernelGGL(mk_fwd, dim3(grid), dim3(NWAVES * 64), LDS_BYTES, stream, a); }
#else
    a.ph_lo = 0; a.ph_hi = NPHASES;
    hipLaunchKernelGGL(mk_fwd, dim3(grid), dim3(NWAVES * 64), LDS_BYTES, stream, a);
#endif
    const hipError_t le = hipPeekAtLastError();
    if (le != hipSuccess) fprintf(stderr, "kernel_launch: launch failed: %s\n", hipGetErrorName(le));
}
```

```cpp
#include <hip/hip_runtime.h>
#include <cstdio>
#include <cstdint>
#ifndef MK_GATE_U8
#define MK_GATE_U8 1
#endif
#ifndef MK_GATE_F8
#define MK_GATE_F8 1
#endif

__device__ __forceinline__ int mk_lane() { unsigned z; asm volatile("s_mov_b32 %0, 0" : "=s"(z)); return (int)__builtin_amdgcn_mbcnt_hi(~0u, __builtin_amdgcn_mbcnt_lo(~0u, z)); }
template <int CTRL, int ROWMASK = 0xf> __device__ __forceinline__ float mk_dpp(float v) { return __builtin_bit_cast(float, __builtin_amdgcn_update_dpp(0, __builtin_bit_cast(int, v), CTRL, ROWMASK, 0xf, false)); }
__device__ __forceinline__ float mk_xor32(float v, bool upper) { const auto rr = __builtin_amdgcn_permlane32_swap(__builtin_bit_cast(unsigned, v), __builtin_bit_cast(unsigned, v), false, false); return __builtin_bit_cast(float, upper ? rr[0] : rr[1]); }
__device__ __forceinline__ int mk_xor16(int v) { return __builtin_amdgcn_ds_swizzle(v, 0x401F); }

namespace pg8 {
#define PG8_LAS __attribute__((address_space(3)))
typedef unsigned short bf16_t;
typedef short bf16x8 __attribute__((ext_vector_type(8)));
typedef float f32x4 __attribute__((ext_vector_type(4)));
typedef unsigned u32x4 __attribute__((ext_vector_type(4)));
typedef unsigned u32x2 __attribute__((ext_vector_type(2)));
typedef int v8i32 __attribute__((ext_vector_type(8)));
constexpr int BM = 256, BK = 64, HALF = 128, HTB = HALF * BK * 2  , STAGE_BYTES = 8 * HTB, NXCD = 8, WGM = 8;

__host__ __device__ __forceinline__ int lds_byte(int r, int c) { const int st = (r >> 4) * 2 + (c >> 5), rr = r & 15, cc = c & 31, ob = rr * 64 + cc * 2; return st * 1024 + (ob ^ (((ob >> 9) & 1) << 5)); }
__host__ __device__ __forceinline__ void stage_rc(int b, int& R, int& C) { const int st = b / 1024, sb = b % 1024, swz = sb ^ (((sb >> 9) & 1) << 5); R = (st >> 1) * 16 + swz / 64; C = (st & 1) * 32 + (swz % 64) / 2; }
__host__ __device__ __forceinline__ int perm32(int rho) { const int n = rho >> 4, i = rho & 15; return 8 * (i >> 2) + 4 * n + (i & 3); }

struct Unit { int pm, pn, pb; };
struct Gemm { const bf16_t* A; const bf16_t* Bt; int M, N, K; };

struct StaticOrder {
    int nM, nN, nwg, G, c, wgm;
    __host__ __device__ void init(int M, int N, int G_, int c_, int wgm_ = WGM) { nM = M / BM; nN = N / BM; nwg = nM * nN; G = G_; c = c_; wgm = wgm_; }
    __host__ __device__ bool next(int i, Unit& u) const {
        const long L = (long)i * G + c; if (L >= nwg) return false;
        int wgid = (int)L; { const int q = nwg / NXCD, r = nwg % NXCD, xcd = wgid % NXCD, off = wgid / NXCD; wgid = (xcd < r ? xcd * (q + 1) : r * (q + 1) + (xcd - r) * q) + off; }
        const int nig = wgm * nN, gid = wgid / nig, fm = gid * wgm, gsz = (nM - fm) < wgm ? (nM - fm) : wgm;
        u.pm = fm + ((wgid % nig) % gsz); u.pn = (wgid % nig) / gsz; u.pb = u.pn; return true;
    }
    __device__ __forceinline__ void a_ready(const Unit&) const {}
    __device__ __forceinline__ void done(const Unit&) const {}
};

__device__ __forceinline__ unsigned cvt_pk_bf16(float lo, float hi) { unsigned r; asm volatile("v_cvt_pk_bf16_f32 %0, %1, %2" : "=v"(r) : "v"(lo), "v"(hi)); return r; }
__device__ __forceinline__ float bf_lo(unsigned w) { return __uint_as_float(w << 16); }
__device__ __forceinline__ float bf_hi(unsigned w) { return __uint_as_float(w & 0xffff0000u); }
__device__ __forceinline__ float sigmoidf_(float x) { return __builtin_amdgcn_rcpf(1.0f + __builtin_amdgcn_exp2f(x * -1.4426950408889634f)); }

template <bool OPF8> struct EpiZT {
    static constexpr bool PERM = true, AFTER_DRAIN = false, HALFN = false, F8 = OPF8, RWACC = false;
    bf16_t* ZM; bf16_t* ZG; const float* rope; int n_lat_panels; const float* bgate; int pn_off; float gs;
    __device__ __forceinline__ void operator()(const f32x4 (&acc)[2][2][4][2], const Unit& u, int wr, int wc, int fr, int fq) const {
        const int row0 = u.pm * BM + wr * 64 + fr; int colt = (u.pn + pn_off) * BM; bf16_t* base = ZM; int ldc = 3840; bool isg = false;
        if (colt >= 3840) { base = ZG; colt -= 3840; ldc = 3072; isg = true; }
        const int col0 = colt + wc * 32 + 8 * fq;
        f32x4 gb[2][2];
        if (isg) {
#pragma unroll
            for (int bj = 0; bj < 2; ++bj) { gb[bj][0] = *(const f32x4*)(bgate + col0 + bj * HALF); gb[bj][1] = *(const f32x4*)(bgate + col0 + bj * HALF + 4); } }
        const int nrope = (u.pm < n_lat_panels) ? (u.pn + pn_off < 2 ? 2 : (u.pn + pn_off == 2 ? 1 : 0)) : 0;
#pragma unroll
        for (int ai = 0; ai < 2; ++ai)
#pragma unroll
            for (int m = 0; m < 4; ++m) { const int row = row0 + ai * HALF + m * 16; bf16_t* rowp = base + (size_t)row * ldc + col0;
                f32x4 cs[4];
                if (nrope) { const int s = row & 8191, pidx = (wc & 1) ? 128 + (s & 63) : (s >> 6); const f32x4* cp = (const f32x4*)(rope + (size_t)(pidx * 16 + 8 * (fq & 1)) * 2);
                    cs[0] = cp[0]; cs[1] = cp[1]; cs[2] = cp[2]; cs[3] = cp[3]; }
#pragma unroll
                for (int bj = 0; bj < 2; ++bj) { f32x4 v0 = acc[ai][bj][m][0], v1 = acc[ai][bj][m][1];
                    if (OPF8 && !isg) { v0 *= gs; v1 *= gs; }
                    if (isg) {
#pragma unroll
                        for (int j = 0; j < 4; ++j) { v0[j] = sigmoidf_(fminf(fmaxf(v0[j] * gs + gb[bj][0][j], -30.f), 30.f)); v1[j] = sigmoidf_(fminf(fmaxf(v1[j] * gs + gb[bj][1][j], -30.f), 30.f)); } }
                    if (bj < nrope) { const float sg = (fq >> 1) ? 1.f : -1.f;
                        float v[8] = {v0[0], v0[1], v0[2], v0[3], v1[0], v1[1], v1[2], v1[3]}, o[8];
#pragma unroll
                        for (int j = 0; j < 8; ++j) { const float pv = mk_xor32(v[j], (fq >> 1) != 0); const float c_ = cs[j >> 1][(j & 1) * 2], s_ = cs[j >> 1][(j & 1) * 2 + 1]; o[j] = v[j] * c_ + sg * pv * s_; }
                        v0 = (f32x4){o[0], o[1], o[2], o[3]}; v1 = (f32x4){o[4], o[5], o[6], o[7]}; }
                    if (MK_GATE_U8 && isg) {
                        unsigned b0 = 0u, b1 = 0u;
#pragma unroll
                        for (int j = 0; j < 4; ++j) { b0 = __builtin_amdgcn_cvt_pk_u8_f32(fmaxf(v0[j] * 255.f, 1.f), j, b0); b1 = __builtin_amdgcn_cvt_pk_u8_f32(fmaxf(v1[j] * 255.f, 1.f), j, b1); }
                        u32x2 w8; w8.x = b0; w8.y = b1;
                        *(u32x2*)((unsigned char*)ZG + (size_t)row * 3072 + col0 + bj * HALF) = w8;
                        continue; }
                    u32x4 w; w.x = cvt_pk_bf16(v0[0], v0[1]); w.y = cvt_pk_bf16(v0[2], v0[3]); w.z = cvt_pk_bf16(v1[0], v1[1]); w.w = cvt_pk_bf16(v1[2], v1[3]);
                    *(u32x4*)(rowp + bj * HALF) = w; } }
    }
};
typedef EpiZT<false> EpiZ;

struct EpiZM {
    static constexpr bool PERM = true, AFTER_DRAIN = false, HALFN = false, F8 = false, RWACC = false;
    bf16_t* ZM; const PG8_LAS float* rope; int n_lat_panels;
    __device__ __forceinline__ void operator()(const f32x4 (&acc)[2][2][4][2], const Unit& u, int wr, int wc, int fr, int fq) const {
        const int row0 = u.pm * BM + wr * 64 + fr; const int col0 = u.pn * BM + wc * 32 + 8 * fq;
        const int nrope = (u.pm < n_lat_panels) ? (u.pn < 2 ? 2 : (u.pn == 2 ? 1 : 0)) : 0;
#pragma unroll
        for (int ai = 0; ai < 2; ++ai)
#pragma unroll
            for (int m = 0; m < 4; ++m) { const int row = row0 + ai * HALF + m * 16; bf16_t* rowp = ZM + (size_t)row * 3840 + col0;
                f32x4 cs[4];
                if (nrope) { const int s = row & 8191, pidx = (wc & 1) ? 128 + (s & 63) : (s >> 6); const PG8_LAS f32x4* cp = (const PG8_LAS f32x4*)(rope + (pidx * 16 + 8 * (fq & 1)) * 2);
                    cs[0] = cp[0]; cs[1] = cp[1]; cs[2] = cp[2]; cs[3] = cp[3]; }
#pragma unroll
                for (int bj = 0; bj < 2; ++bj) { f32x4 v0 = acc[ai][bj][m][0], v1 = acc[ai][bj][m][1];
                    if (bj < nrope) { const float sg = (fq >> 1) ? 1.f : -1.f;
                        float v[8] = {v0[0], v0[1], v0[2], v0[3], v1[0], v1[1], v1[2], v1[3]}, o[8];
#pragma unroll
                        for (int j = 0; j < 8; ++j) { const float pv = mk_xor32(v[j], (fq >> 1) != 0); const float c_ = cs[j >> 1][(j & 1) * 2], s_ = cs[j >> 1][(j & 1) * 2 + 1]; o[j] = v[j] * c_ + sg * pv * s_; }
                        v0 = (f32x4){o[0], o[1], o[2], o[3]}; v1 = (f32x4){o[4], o[5], o[6], o[7]}; }
                    u32x4 w; w.x = cvt_pk_bf16(v0[0], v0[1]); w.y = cvt_pk_bf16(v0[2], v0[3]); w.z = cvt_pk_bf16(v1[0], v1[1]); w.w = cvt_pk_bf16(v1[2], v1[3]);
                    *(u32x4*)(rowp + bj * HALF) = w; } }
    }
};
struct EpiZGate {
    static constexpr bool PERM = true, AFTER_DRAIN = false, HALFN = false, F8 = true, RWACC = false;
    unsigned char* ZG; const float* bgate; float gs;
    __device__ __forceinline__ void operator()(const f32x4 (&acc)[2][2][4][2], const Unit& u, int wr, int wc, int fr, int fq) const {
        const int row0 = u.pm * BM + wr * 64 + fr; const int colb = u.pn * BM + wc * 32; const int odd = fq & 1;
        f32x4 gb[2][2];
#pragma unroll
        for (int bj = 0; bj < 2; ++bj) { gb[bj][0] = *(const f32x4*)(bgate + colb + 8 * fq + bj * HALF); gb[bj][1] = *(const f32x4*)(bgate + colb + 8 * fq + bj * HALF + 4); }
#pragma unroll
        for (int ai = 0; ai < 2; ++ai)
#pragma unroll
            for (int mp = 0; mp < 2; ++mp)
#pragma unroll
                for (int bj = 0; bj < 2; ++bj) {
                    unsigned w[2][2];
#pragma unroll
                    for (int k = 0; k < 2; ++k) { const int m = 2 * mp + k; const f32x4 v0 = acc[ai][bj][m][0], v1 = acc[ai][bj][m][1]; unsigned b0 = 0u, b1 = 0u;
#pragma unroll
                        for (int j = 0; j < 4; ++j) { const float g0 = sigmoidf_(fminf(fmaxf(v0[j] * gs + gb[bj][0][j], -30.f), 30.f)), g1 = sigmoidf_(fminf(fmaxf(v1[j] * gs + gb[bj][1][j], -30.f), 30.f));
                            b0 = __builtin_amdgcn_cvt_pk_u8_f32(fmaxf(g0 * 255.f, 1.f), j, b0); b1 = __builtin_amdgcn_cvt_pk_u8_f32(fmaxf(g1 * 255.f, 1.f), j, b1); }
                        w[k][0] = b0; w[k][1] = b1; }
                    const unsigned s0 = odd ? w[0][0] : w[1][0], s1 = odd ? w[0][1] : w[1][1];
                    const unsigned r0 = (unsigned)mk_xor16((int)s0), r1 = (unsigned)mk_xor16((int)s1);
                    u32x4 st; if (odd) { st.x = r0; st.y = r1; st.z = w[1][0]; st.w = w[1][1]; } else { st.x = w[0][0]; st.y = w[0][1]; st.z = r0; st.w = r1; }
                    *(u32x4*)(ZG + (size_t)(row0 + ai * HALF + (2 * mp + odd) * 16) * 3072 + colb + 8 * (fq & 2) + bj * HALF) = st; }
    }
};
struct EpiBf16P {
    static constexpr bool PERM = true, AFTER_DRAIN = false, HALFN = false, F8 = false, RWACC = false;
    bf16_t* O; int ldc;
    __device__ __forceinline__ void operator()(const f32x4 (&acc)[2][2][4][2], const Unit& u, int wr, int wc, int fr, int fq) const {
        const int row0 = u.pm * BM + wr * 64 + fr; const int col0 = u.pn * BM + wc * 32 + 8 * fq;
#pragma unroll
        for (int ai = 0; ai < 2; ++ai)
#pragma unroll
            for (int m = 0; m < 4; ++m) { bf16_t* rowp = O + (size_t)(row0 + ai * HALF + m * 16) * ldc + col0;
#pragma unroll
                for (int bj = 0; bj < 2; ++bj) { const f32x4 v0 = acc[ai][bj][m][0], v1 = acc[ai][bj][m][1];
                    u32x4 w; w.x = cvt_pk_bf16(v0[0], v0[1]); w.y = cvt_pk_bf16(v0[2], v0[3]); w.z = cvt_pk_bf16(v1[0], v1[1]); w.w = cvt_pk_bf16(v1[2], v1[3]);
                    *(u32x4*)(rowp + bj * HALF) = w; } }
    }
};
struct EpiBranchAcc {
    static constexpr bool PERM = true, AFTER_DRAIN = false, HALFN = false, F8 = false, RWACC = true;
    bf16_t* MG; const bf16_t* ZG;
    __device__ __forceinline__ bool restart(const Unit& u) const { return u.pm >= 264; }
    __device__ __forceinline__ void rw(f32x4 (&acc)[2][2][4][2], const Unit& u, int wr, int wc, int fr, int fq) const {
        const int r = u.pm / 132, pmt = u.pm - 132 * r, rn = r < 2 ? r + 1 : r;
        const int row0 = pmt * BM + wr * 64 + fr, col0 = u.pn * BM + wc * 32 + 8 * fq;
        constexpr int PG8_GD = 4;
        u32x4 gp[PG8_GD][2], gn[PG8_GD][2];
        constexpr unsigned GB = MK_GATE_U8 ? 1u : 2u;
        const unsigned o0 = (unsigned)row0 * (3072u * GB) + (unsigned)col0 * GB;
        const char* zp = (const char*)ZG + (size_t)r * 1024 * GB; const char* zn = (const char*)ZG + (size_t)rn * 1024 * GB;
#if MK_GATE_U8
#define PG8_GLOAD(s, buf) do { const int bj_ = (s) >> 2, ai_ = ((s) >> 1) & 1, mb_ = ((s) & 1) * 2; _Pragma("unroll") for (int q_ = 0; q_ < 2; ++q_) { \
            const unsigned off_ = o0 + (unsigned)(ai_ * HALF + (mb_ + q_) * 16) * 3072u + (unsigned)(bj_ * HALF); \
            const u32x2 a_ = *(const u32x2*)(zp + off_), b_ = *(const u32x2*)(zn + off_); gp[buf][q_].x = a_.x; gp[buf][q_].y = a_.y; gn[buf][q_].x = b_.x; gn[buf][q_].y = b_.y; } } while (0)
#else
#define PG8_GLOAD(s, buf) do { const int bj_ = (s) >> 2, ai_ = ((s) >> 1) & 1, mb_ = ((s) & 1) * 2; _Pragma("unroll") for (int q_ = 0; q_ < 2; ++q_) { \
            const unsigned off_ = o0 + (unsigned)(ai_ * HALF + (mb_ + q_) * 16) * 6144u + (unsigned)(bj_ * HALF * 2); \
            gp[buf][q_] = *(const u32x4*)(zp + off_); gn[buf][q_] = *(const u32x4*)(zn + off_); } } while (0)
#endif
#pragma unroll
        for (int s = 0; s < PG8_GD - 1; ++s) PG8_GLOAD(s, s);
#pragma unroll
        for (int s = 0; s < 8; ++s) { const int bj = s >> 2, ai = (s >> 1) & 1, mb = (s & 1) * 2, col = col0 + bj * HALF;
            if (s + PG8_GD - 1 < 8) PG8_GLOAD(s + PG8_GD - 1, (s + PG8_GD - 1) % PG8_GD);
            __builtin_amdgcn_sched_barrier(0);
#pragma unroll
            for (int q = 0; q < 2; ++q) { const int m = mb + q; const size_t row = (size_t)(row0 + ai * HALF + m * 16);
                const u32x4 g0 = gp[s % PG8_GD][q], g1 = gn[s % PG8_GD][q];
#if MK_GATE_U8
#define PG8_UB(w_, k_) ((float)(((w_) >> (8 * (k_))) & 255u))
                const float x[8] = {PG8_UB(g0.x, 0), PG8_UB(g0.x, 1), PG8_UB(g0.x, 2), PG8_UB(g0.x, 3), PG8_UB(g0.y, 0), PG8_UB(g0.y, 1), PG8_UB(g0.y, 2), PG8_UB(g0.y, 3)};
#else
                const float x[8] = {bf_lo(g0.x), bf_hi(g0.x), bf_lo(g0.y), bf_hi(g0.y), bf_lo(g0.z), bf_hi(g0.z), bf_lo(g0.w), bf_hi(g0.w)};
#endif
                if (r < 2) {
#if MK_GATE_U8
                    const float y[8] = {PG8_UB(g1.x, 0), PG8_UB(g1.x, 1), PG8_UB(g1.x, 2), PG8_UB(g1.x, 3), PG8_UB(g1.y, 0), PG8_UB(g1.y, 1), PG8_UB(g1.y, 2), PG8_UB(g1.y, 3)};
#else
                    const float y[8] = {bf_lo(g1.x), bf_hi(g1.x), bf_lo(g1.y), bf_hi(g1.y), bf_lo(g1.z), bf_hi(g1.z), bf_lo(g1.w), bf_hi(g1.w)};
#endif
#pragma unroll
                    for (int j = 0; j < 8; ++j) acc[ai][bj][m][j >> 2][j & 3] *= x[j] * __builtin_amdgcn_rcpf(y[j]);
                } else {
                    float v[8];
#pragma unroll
                    for (int j = 0; j < 8; ++j) v[j] = acc[ai][bj][m][j >> 2][j & 3] * (MK_GATE_U8 ? x[j] * (1.0f / 255.0f) : x[j]);
                    u32x4 w; w.x = cvt_pk_bf16(v[0], v[1]); w.y = cvt_pk_bf16(v[2], v[3]); w.z = cvt_pk_bf16(v[4], v[5]); w.w = cvt_pk_bf16(v[6], v[7]);
                    *(u32x4*)(MG + row * 1024 + col) = w;
                } }
        }
#undef PG8_GLOAD
    }
};
struct BranchOrder3 {
    StaticOrder so;
    __device__ __forceinline__ bool next(int i, Unit& u) const {
        const int ti = i / 3, r = i - 3 * ti; if (!so.next(ti, u)) return false;
        u.pb = 4 * r + u.pn; u.pm += 132 * r; return true;
    }
    __device__ __forceinline__ void a_ready(const Unit&) const {}
    __device__ __forceinline__ void done(const Unit&) const {}
};
struct EpiSwiglu {
    static constexpr bool PERM = true, AFTER_DRAIN = false, HALFN = false, F8 = false, RWACC = false;
    bf16_t* H; int ldh;
    __device__ __forceinline__ void operator()(const f32x4 (&acc)[2][2][4][2], const Unit& u, int wr, int wc, int fr, int fq) const {
        const int row0 = u.pm * BM + wr * 64 + fr; const int col0 = u.pn * HALF + wc * 32 + 8 * fq;
#pragma unroll
        for (int ai = 0; ai < 2; ++ai)
#pragma unroll
            for (int m = 0; m < 4; ++m) { bf16_t* rowp = H + (size_t)(row0 + ai * HALF + m * 16) * ldh + col0;
                float h[8];
#pragma unroll
                for (int n = 0; n < 2; ++n)
#pragma unroll
                    for (int j = 0; j < 4; ++j) { const float g = acc[ai][0][m][n][j], uu = acc[ai][1][m][n][j]; h[n * 4 + j] = g * sigmoidf_(g) * uu; }
                u32x4 w; w.x = cvt_pk_bf16(h[0], h[1]); w.y = cvt_pk_bf16(h[2], h[3]); w.z = cvt_pk_bf16(h[4], h[5]); w.w = cvt_pk_bf16(h[6], h[7]);
                *(u32x4*)rowp = w; }
    }
};
__device__ __forceinline__ unsigned pk4_fp8(float a, float b, float c, float d) { int w = __builtin_amdgcn_cvt_pk_fp8_f32(a, b, 0, false); w = __builtin_amdgcn_cvt_pk_fp8_f32(c, d, w, true); return (unsigned)w; }
__device__ __forceinline__ float clamp_fp8(float v) { return fminf(fmaxf(v, -448.0f), 448.0f); }
template <bool OPF8> struct EpiSwiglu8T {
    static constexpr bool PERM = true, AFTER_DRAIN = false, HALFN = false, F8 = OPF8, RWACC = false;
    unsigned char* H; int ldh; float sin, sout;
    __device__ __forceinline__ void operator()(const f32x4 (&acc)[2][2][4][2], const Unit& u, int wr, int wc, int fr, int fq) const {
        const int row0 = u.pm * BM + wr * 64 + fr; const int col0 = u.pn * HALF + wc * 32 + 8 * (fq & 2); const int odd = fq & 1;
#pragma unroll
        for (int ai = 0; ai < 2; ++ai)
#pragma unroll
            for (int mp = 0; mp < 2; ++mp) {
                unsigned w[2][2];
#pragma unroll
                for (int k = 0; k < 2; ++k) { const int m = 2 * mp + k; float h[8];
#pragma unroll
                    for (int n = 0; n < 2; ++n)
#pragma unroll
                        for (int j = 0; j < 4; ++j) { const float g = acc[ai][0][m][n][j] * sin, uu = acc[ai][1][m][n][j] * sin; h[n * 4 + j] = clamp_fp8(g * sigmoidf_(g) * uu * sout); }
                    w[k][0] = pk4_fp8(h[0], h[1], h[2], h[3]); w[k][1] = pk4_fp8(h[4], h[5], h[6], h[7]); }
                const unsigned s0 = odd ? w[0][0] : w[1][0], s1 = odd ? w[0][1] : w[1][1];
                const unsigned r0 = (unsigned)mk_xor16((int)s0), r1 = (unsigned)mk_xor16((int)s1);
                u32x4 st; if (odd) { st.x = r0; st.y = r1; st.z = w[1][0]; st.w = w[1][1]; } else { st.x = w[0][0]; st.y = w[0][1]; st.z = r0; st.w = r1; }
                *(u32x4*)(H + (size_t)(row0 + ai * HALF + (2 * mp + odd) * 16) * ldh + col0) = st; }
    }
};
typedef EpiSwiglu8T<true> EpiSwiglu8;
struct EpiBf16PS8 {
    static constexpr bool PERM = true, AFTER_DRAIN = false, HALFN = false, F8 = true, RWACC = false;
    bf16_t* O; int ldc; float s;
    __device__ __forceinline__ void operator()(const f32x4 (&acc)[2][2][4][2], const Unit& u, int wr, int wc, int fr, int fq) const {
        const int row0 = u.pm * BM + wr * 64 + fr; const int col0 = u.pn * BM + wc * 32 + 8 * fq;
#pragma unroll
        for (int ai = 0; ai < 2; ++ai)
#pragma unroll
            for (int m = 0; m < 4; ++m) { bf16_t* rowp = O + (size_t)(row0 + ai * HALF + m * 16) * ldc + col0;
#pragma unroll
                for (int bj = 0; bj < 2; ++bj) { const f32x4 v0 = acc[ai][bj][m][0] * s, v1 = acc[ai][bj][m][1] * s;
                    u32x4 w; w.x = cvt_pk_bf16(v0[0], v0[1]); w.y = cvt_pk_bf16(v0[2], v0[3]); w.z = cvt_pk_bf16(v1[0], v1[1]); w.w = cvt_pk_bf16(v1[2], v1[3]);
                    *(u32x4*)(rowp + bj * HALF) = w; } }
    }
};
struct MoeOrder {
    int nN, G, c, p_lo, np; int pc[8];
    __device__ __forceinline__ bool next(int i, Unit& u) const {
        const long L = (long)i * G + c; if (L >= (long)np * nN) return false;
        const int wgid = (int)L, nig = WGM * nN, gid = wgid / nig, fm = gid * WGM, gsz = (np - fm) < WGM ? (np - fm) : WGM;
        u.pm = p_lo + fm + ((wgid % nig) % gsz); u.pn = (wgid % nig) / gsz;
        int e = 0;
#pragma unroll
        for (int k = 1; k < 8; ++k) e += (u.pm >= pc[k]) ? 1 : 0;
        u.pb = e * nN + u.pn; return true;
    }
    __device__ __forceinline__ void a_ready(const Unit&) const {}
    __device__ __forceinline__ void done(const Unit&) const {}
};

__device__ __forceinline__ void glds_s(const char* sbase, unsigned voff, unsigned lds_dst) { unsigned keep;
    asm volatile("s_mov_b32 %0, m0\n\ts_mov_b32 m0, %3\n\ts_nop 0\n\tglobal_load_lds_dwordx4 %1, %2\n\ts_mov_b32 m0, %0" : "=&s"(keep) : "v"(voff), "s"(sbase), "s"(lds_dst) : "memory"); }
__device__ __forceinline__ const char* uni_ptr(const char* p) { const unsigned long long b = (unsigned long long)(uintptr_t)p; const unsigned lo = (unsigned)__builtin_amdgcn_readfirstlane((int)(unsigned)b), hi = (unsigned)__builtin_amdgcn_readfirstlane((int)(unsigned)(b >> 32));
    return (const char*)(uintptr_t)(((unsigned long long)hi << 32) | lo); }
template <class Epi, class Sched, bool ALIGN_EPI = false, bool SP2 = false, bool RELAX = true>
__device__ __forceinline__ void gemm_phase(PG8_LAS unsigned char* lds, const Gemm g, const Sched& S, const Epi& E, int wv) {
    int tid_ = (wv << 6) | mk_lane(); asm volatile("" : "+v"(tid_));
    const int tid = tid_, wid = __builtin_amdgcn_readfirstlane(tid >> 6), lane = tid & 63, wr = wid >> 2, wc = wid & 3, fr = lane & 15, fq = lane >> 4;
    constexpr bool HN = Epi::HALFN;
    constexpr bool F8 = Epi::F8;
    constexpr int ES = F8 ? 1 : 2;
    const int K = g.K, nt = K * ES / (BK * 2);
    unsigned voffA[2], voffB[2];
#pragma unroll
    for (int i = 0; i < 2; ++i) { int R, C; stage_rc(tid * 16 + i * 8192, R, C); const int Rb = Epi::PERM ? ((R & ~31) + perm32(R & 31)) : R;
        voffA[i] = (unsigned)(R * K * ES + C * 2); voffB[i] = (unsigned)(Rb * K * ES + C * 2); }
    const size_t kstep = (size_t)(BK * 2);
    const size_t hstep = (size_t)HALF * K * ES;
    const size_t tstep = 2 * hstep;
    const unsigned ldsw = (unsigned)wid * 1024u;
    const unsigned ldsb = (unsigned)__builtin_amdgcn_readfirstlane((int)((unsigned)(uintptr_t)lds + ldsw));
    const int aoff = lds_byte(wr * 64 + fr, fq * 8), boff = lds_byte(wc * 32 + fr, fq * 8);
#define PG8_SA(b, h) (((b) * 2 + (h)) * HTB)
#define PG8_SB(b, h) ((4 + (b) * 2 + (h)) * HTB)
#define PG8_STAGE(bufoff, gbase, voff) do { _Pragma("unroll") for (int _i = 0; _i < 2; ++_i) \
        glds_s((const char*)(gbase), (voff)[_i], ldsb + (unsigned)((bufoff) + _i * 8192)); } while (0)
#define PG8_LDA(dst, b, h) do { if constexpr (F8) { _Pragma("unroll") for (int m = 0; m < 4; ++m) { const u32x4 lo_ = *(const PG8_LAS u32x4*)(lds + PG8_SA(b, h) + aoff + m * 2048), hi_ = *(const PG8_LAS u32x4*)(lds + PG8_SA(b, h) + aoff + m * 2048 + 1024); \
            dst##8[m] = __builtin_bit_cast(v8i32, __builtin_shufflevector(lo_, hi_, 0, 1, 2, 3, 4, 5, 6, 7)); } } \
        else { _Pragma("unroll") for (int m = 0; m < 4; ++m) _Pragma("unroll") for (int k = 0; k < 2; ++k) dst[m][k] = *(const PG8_LAS bf16x8*)(lds + PG8_SA(b, h) + aoff + m * 2048 + k * 1024); } } while (0)
#define PG8_LDB(dst, b, h) do { if constexpr (F8) { _Pragma("unroll") for (int n = 0; n < 2; ++n) { const u32x4 lo_ = *(const PG8_LAS u32x4*)(lds + PG8_SB(b, h) + boff + n * 2048), hi_ = *(const PG8_LAS u32x4*)(lds + PG8_SB(b, h) + boff + n * 2048 + 1024); \
            dst##8[n] = __builtin_bit_cast(v8i32, __builtin_shufflevector(lo_, hi_, 0, 1, 2, 3, 4, 5, 6, 7)); } } \
        else { _Pragma("unroll") for (int n = 0; n < 2; ++n) _Pragma("unroll") for (int k = 0; k < 2; ++k) dst[n][k] = *(const PG8_LAS bf16x8*)(lds + PG8_SB(b, h) + boff + n * 2048 + k * 1024); } } while (0)
#define PG8_MMA(ai, bj, At, Bt) do { __builtin_amdgcn_s_setprio(1); _Pragma("unroll") for (int m = 0; m < 4; ++m) _Pragma("unroll") for (int n = 0; n < 2; ++n) { \
        if constexpr (F8) { asm volatile("v_mfma_f32_16x16x128_f8f6f4 %0, %1, %2, %0" : "+v"(acc[ai][bj][m][n]) : "v"(Bt##8[n]), "v"(At##8[m])); } \
        else { _Pragma("unroll") for (int k = 0; k < 2; ++k) acc[ai][bj][m][n] = __builtin_amdgcn_mfma_f32_16x16x32_bf16(Bt[n][k], At[m][k], acc[ai][bj][m][n], 0, 0, 0); } } \
        __builtin_amdgcn_s_setprio(0); } while (0)
#define PG8_LDB1(dst, b, h) do { if constexpr (!HN) { PG8_LDB(dst, b, h); } } while (0)
#define PG8_MMA1(ai, bj, At, Bt) do { if constexpr (!HN) { PG8_MMA(ai, bj, At, Bt); } } while (0)
#define PG8_WAIT_V(n) asm volatile("s_waitcnt vmcnt(" #n ")" ::: "memory")
#define PG8_WAIT_L(n) asm volatile("s_waitcnt lgkmcnt(" #n ")" ::: "memory")
#define PG8_BAR __builtin_amdgcn_s_barrier()
#define PG8_SCHED __builtin_amdgcn_sched_barrier(0)
    Unit cur, nxt; int ui = 0;
    if (!S.next(0, cur)) return;
    f32x4 acc[2][2][4][2];
#pragma unroll
    for (int a = 0; a < 2; ++a)
#pragma unroll
        for (int b = 0; b < 2; ++b)
#pragma unroll
            for (int m = 0; m < 4; ++m)
#pragma unroll
                for (int n = 0; n < 2; ++n) acc[a][b][m][n] = (f32x4){0.f, 0.f, 0.f, 0.f};
    bf16x8 At[4][2], B0[2][2], B1[2][2];
    v8i32 At8[4], B08[2], B18[2];
    const char* cA = uni_ptr((const char*)g.A + (size_t)cur.pm * tstep); const char* cB = uni_ptr((const char*)g.Bt + (size_t)cur.pb * (HN ? hstep : tstep));
    S.a_ready(cur);
    if constexpr (SP2) {
        PG8_STAGE(PG8_SB(0, 0), cB, voffB); PG8_STAGE(PG8_SB(0, 1), cB + hstep, voffB); PG8_STAGE(PG8_SA(0, 0), cA, voffA); PG8_STAGE(PG8_SA(0, 1), cA + hstep, voffA);
        if (wr == 1) PG8_BAR;
        PG8_WAIT_V(2); PG8_BAR;
        PG8_STAGE(PG8_SB(1, 0), cB + kstep, voffB); PG8_STAGE(PG8_SA(1, 0), cA + kstep, voffA); PG8_STAGE(PG8_SB(1, 1), cB + hstep + kstep, voffB);
        if constexpr (RELAX) PG8_WAIT_V(0); else PG8_WAIT_V(6); PG8_BAR;
    } else {
        PG8_STAGE(PG8_SB(0, 0), cB, voffB); PG8_STAGE(PG8_SA(0, 0), cA, voffA); PG8_STAGE(PG8_SB(0, 1), cB + hstep, voffB); PG8_STAGE(PG8_SA(0, 1), cA + hstep, voffA);
        if (wr == 1) PG8_BAR;
        PG8_WAIT_V(4); PG8_BAR;
        PG8_STAGE(PG8_SB(1, 0), cB + kstep, voffB); PG8_STAGE(PG8_SA(1, 0), cA + kstep, voffA); PG8_STAGE(PG8_SB(1, 1), cB + hstep + kstep, voffB);
        PG8_WAIT_V(6); PG8_BAR;
    }
    for (;;) {
        const bool has_next = S.next(ui + 1, nxt);
        const char* nA = uni_ptr(has_next ? (const char*)g.A + (size_t)nxt.pm * tstep : cA); const char* nB = uni_ptr(has_next ? (const char*)g.Bt + (size_t)nxt.pb * (HN ? hstep : tstep) : cB);
        for (int t = 0; t < nt; t += 2) {
            const bool last = (t == nt - 2);
            const char* a1 = cA + (size_t)(t + 1) * kstep;
            const char* a2 = last ? nA : cA + (size_t)(t + 2) * kstep; const char* b2 = last ? nB : cB + (size_t)(t + 2) * kstep;
            const char* a3 = a2 + kstep; const char* b3 = b2 + kstep;
            if (last && has_next) S.a_ready(nxt);
            const bool rl = SP2 && RELAX && t == 0;
            if constexpr (SP2) {
            PG8_LDB(B0, 0, 0); PG8_LDB1(B1, 0, 1); PG8_SCHED; PG8_LDA(At, 0, 0); PG8_STAGE(PG8_SA(1, 1), a1 + hstep, voffA);
            if (!rl) PG8_WAIT_V(8); PG8_WAIT_L(0); PG8_BAR; PG8_MMA(0, 0, At, B0); PG8_MMA1(0, 1, At, B1); PG8_BAR; PG8_SCHED;
            PG8_LDA(At, 0, 1); PG8_STAGE(PG8_SB(0, 0), b2, voffB); PG8_STAGE(PG8_SB(0, 1), b2 + hstep, voffB); PG8_STAGE(PG8_SA(0, 0), a2, voffA);
            if (!rl) PG8_WAIT_V(8); PG8_WAIT_L(0); PG8_BAR; PG8_MMA(1, 0, At, B0); PG8_MMA1(1, 1, At, B1); PG8_BAR; PG8_SCHED;
            PG8_LDB(B0, 1, 0); PG8_LDB1(B1, 1, 1); PG8_SCHED; PG8_LDA(At, 1, 0); PG8_STAGE(PG8_SA(0, 1), a2 + hstep, voffA);
            PG8_WAIT_V(8); PG8_WAIT_L(0); PG8_BAR; PG8_MMA(0, 0, At, B0); PG8_MMA1(0, 1, At, B1); PG8_BAR; PG8_SCHED;
            PG8_LDA(At, 1, 1); PG8_STAGE(PG8_SB(1, 0), b3, voffB); PG8_STAGE(PG8_SB(1, 1), b3 + hstep, voffB); PG8_STAGE(PG8_SA(1, 0), a3, voffA);
            PG8_WAIT_V(8); PG8_WAIT_L(0); PG8_BAR; PG8_MMA(1, 0, At, B0); PG8_MMA1(1, 1, At, B1); PG8_BAR; PG8_SCHED;
            } else {
            PG8_LDB(B0, 0, 0); PG8_SCHED; PG8_LDA(At, 0, 0); PG8_STAGE(PG8_SA(1, 1), a1 + hstep, voffA);
            PG8_WAIT_L(8); PG8_BAR; PG8_WAIT_L(0); PG8_MMA(0, 0, At, B0); PG8_BAR; PG8_SCHED;
            PG8_LDB1(B1, 0, 1); PG8_STAGE(PG8_SB(0, 0), b2, voffB);
            PG8_BAR; PG8_WAIT_L(0); PG8_MMA1(0, 1, At, B1); PG8_BAR;
            PG8_LDA(At, 0, 1); PG8_STAGE(PG8_SA(0, 0), a2, voffA);
            PG8_BAR; PG8_WAIT_L(0); PG8_MMA(1, 0, At, B0); PG8_BAR; PG8_SCHED;
            PG8_STAGE(PG8_SB(0, 1), b2 + hstep, voffB);
            PG8_WAIT_V(6); PG8_BAR; PG8_MMA1(1, 1, At, B1); PG8_BAR;
            PG8_LDB(B0, 1, 0); PG8_SCHED; PG8_LDA(At, 1, 0); PG8_STAGE(PG8_SA(0, 1), a2 + hstep, voffA);
            PG8_WAIT_L(8); PG8_BAR; PG8_WAIT_L(0); PG8_MMA(0, 0, At, B0); PG8_BAR; PG8_SCHED;
            PG8_LDB1(B1, 1, 1); PG8_STAGE(PG8_SB(1, 0), b3, voffB);
            PG8_BAR; PG8_WAIT_L(0); PG8_MMA1(0, 1, At, B1); PG8_BAR;
            PG8_LDA(At, 1, 1); PG8_STAGE(PG8_SA(1, 0), a3, voffA);
            PG8_BAR; PG8_WAIT_L(0); PG8_MMA(1, 0, At, B0); PG8_BAR; PG8_SCHED;
            PG8_STAGE(PG8_SB(1, 1), b3 + hstep, voffB);
            PG8_WAIT_V(6); PG8_BAR; PG8_MMA1(1, 1, At, B1); PG8_BAR;
            }
        }
        if constexpr (F8) asm volatile("s_nop 15\n\ts_nop 15" ::: "memory");
        if constexpr (ALIGN_EPI) { if (wr == 0) PG8_BAR; }
        if constexpr (SP2 && RELAX) PG8_WAIT_V(0);
        if constexpr (Epi::RWACC) { E.rw(acc, cur, wr, wc, fr, fq); S.done(cur); }
        else if constexpr (!Epi::AFTER_DRAIN) { E(acc, cur, wr, wc, fr, fq); S.done(cur); }
        if (!has_next) break;
        bool zero_acc = true; if constexpr (Epi::RWACC) zero_acc = E.restart(cur);
        if (zero_acc)
#pragma unroll
        for (int a = 0; a < 2; ++a)
#pragma unroll
            for (int b = 0; b < 2; ++b)
#pragma unroll
                for (int m = 0; m < 4; ++m)
#pragma unroll
                    for (int n = 0; n < 2; ++n) acc[a][b][m][n] = (f32x4){0.f, 0.f, 0.f, 0.f};
        cur = nxt; cA = nA; cB = nB; ++ui;
        if constexpr (ALIGN_EPI) { if (wr == 1) PG8_BAR; }
    }
    PG8_WAIT_V(0);
    if constexpr (!ALIGN_EPI) { if (wr == 0) PG8_BAR; }
    PG8_BAR;
    if constexpr (Epi::AFTER_DRAIN) { E.fused(acc, cur, wr, wc, fr, fq, lds, wid, lane); S.done(cur); }
#undef PG8_SA
#undef PG8_SB
#undef PG8_STAGE
#undef PG8_LDA
#undef PG8_LDB
#undef PG8_MMA
#undef PG8_LDB1
#undef PG8_MMA1
#undef PG8_WAIT_V
#undef PG8_WAIT_L
#undef PG8_BAR
#undef PG8_SCHED
}
}

#ifndef PG8_SP2
#define PG8_SP2 true
#endif
#ifndef PG8_ALIGN
#define PG8_ALIGN true
#endif
#ifndef MK_WGM
#define MK_WGM 4
#endif
#ifndef MK_DENSE_F8
#define MK_DENSE_F8 1
#endif
#ifndef MK_PER_PHASE
#define MK_PER_PHASE 0
#endif

constexpr int NWAVES = 8;
constexpr int D = 1024, BATCH = 4, SEQ = 8192, CTXL = 256, DEPTH = 2;
constexpr int TL = BATCH * SEQ, TC = BATCH * CTXL, TA = TL + TC;
constexpr int INC = 6912, ZMC = 3840, ZGC = 3072, BW = 512;
constexpr int FFD = 2816, FFE = 3584, NE = 8;
constexpr int MAXPAN = 264, PCH = 264, NCHUNK = 1;
constexpr float RMS_EPS = 1e-6f;
constexpr float SC_XG = 4.0f, SC_WGU = 32.0f, SC_H = 4.0f, SC_WDN = 64.0f;
constexpr int C_QA = 0, C_KA = 512, C_VA = 640, C_UX = 768, C_GB = 1280, C_GC = 1792, C_QN = 2304, C_KN = 2816, C_VN = 3328;

constexpr size_t MiB = 1u << 20;
constexpr size_t WS_CTL = 0, CTL_ZERO_BYTES = 1 * MiB;
constexpr size_t WS_MOD = 1 * MiB;
constexpr size_t WS_ROPE = WS_MOD + 256 * 1024;
constexpr size_t WS_SLABCNT = WS_MOD + 320 * 1024;
constexpr size_t WS_PCUM = WS_MOD + 384 * 1024;
constexpr size_t WS_TOKER = WS_MOD + 512 * 1024;
constexpr size_t WS_TOKG = WS_MOD + 768 * 1024;
constexpr size_t WS_TOKPOS = WS_MOD + 1024 * 1024;
constexpr size_t WS_HCTX = 4 * MiB;
constexpr size_t WS_WIN = 8 * MiB;
constexpr size_t WS_WBR = 35 * MiB;
constexpr size_t WS_WOUT = 41 * MiB;
constexpr size_t WS_WGUD = 45 * MiB;
constexpr size_t WS_WDND = 56 * MiB;
constexpr size_t WS_WGUM = 62 * MiB;
constexpr size_t WS_WDNM = 118 * MiB;
constexpr size_t WS_RS = 146 * MiB;
constexpr size_t WS_HX = 230 * MiB;
constexpr size_t WS_ZM = 296 * MiB;
constexpr size_t WS_ZG = 544 * MiB;
constexpr size_t WS_O = 742 * MiB;
constexpr size_t WS_XG = WS_ZM;
constexpr size_t WS_HM = WS_ZM + 132 * MiB;
constexpr size_t WS_XG8 = WS_O;
constexpr size_t WS_HX8 = 841 * MiB;
constexpr size_t WS_WING8 = 874 * MiB;
constexpr size_t WS_END = 880 * MiB;
static_assert(WS_WIN + (size_t)2 * INC * D * 2 <= WS_WBR && WS_WGUD + (size_t)2 * FFD * D * 2 <= WS_WDND && WS_WDND + (size_t)D * FFD * 2 <= WS_WGUM, "ws map (weights)");
static_assert(WS_WGUM + (size_t)NE * 2 * FFE * D <= WS_WDNM && WS_WDNM + (size_t)NE * D * FFE <= WS_RS && WS_RS + (size_t)TA * D * 2 <= WS_HX, "ws map (moe weights, residual stream)");
static_assert(WS_HX + (size_t)TA * D * 2 <= WS_ZM && WS_ZM + (size_t)TA * ZMC * 2 <= WS_ZG && WS_ZG + (size_t)TA * ZGC * 2 <= WS_O && WS_O + (size_t)3 * TA * BW * 2 <= WS_END, "ws map (activations)");
static_assert(WS_HM + (size_t)MAXPAN * 256 * FFE <= WS_O && WS_XG8 + (size_t)MAXPAN * 256 * D <= WS_END && (size_t)MAXPAN * 256 * D * 2 <= 132 * MiB && (size_t)TA * D * 4 <= 132 * MiB, "ws map (moe)");
constexpr int CW_BAR = 4096;

constexpr int RING_OFF = 0, RING_BYTES = 131072;
constexpr int LDSCTL_OFF = RING_BYTES, MISC_OFF = LDSCTL_OFF + 320;
constexpr int ROPEL_OFF = RING_BYTES + 1024, ROPEL_BYTES = 192 * 16 * 2 * 4;
constexpr int LDS_BYTES = 163840;
static_assert(ROPEL_OFF + ROPEL_BYTES <= LDS_BYTES, "lds map");

#define GAS __attribute__((address_space(1)))
#define LAS __attribute__((address_space(3)))
typedef unsigned short bf16;
typedef unsigned v4u __attribute__((ext_vector_type(4)));
typedef unsigned v2u __attribute__((ext_vector_type(2)));
typedef float f32x4 __attribute__((ext_vector_type(4)));
typedef float f32x2 __attribute__((ext_vector_type(2)));
#define LDS_WAIT() asm volatile("s_waitcnt lgkmcnt(0)" ::: "memory")
#define VM_WAIT() asm volatile("s_waitcnt vmcnt(0)" ::: "memory")
__device__ __forceinline__ unsigned f2bf(float f) { unsigned u = __builtin_bit_cast(unsigned, f); return (u + 0x7fffu + ((u >> 16) & 1u)) >> 16; }
__device__ __forceinline__ unsigned pk2(float lo, float hi) { return f2bf(lo) | (f2bf(hi) << 16); }
__device__ __forceinline__ float bflo(unsigned w) { return __uint_as_float(w << 16); }
__device__ __forceinline__ float bfhi(unsigned w) { return __uint_as_float(w & 0xffff0000u); }
__device__ __forceinline__ float bf2f(bf16 b) { return __uint_as_float(((unsigned)b) << 16); }

#define XB_TMO      128
#define XB_XCNT(j)  (256  + 64 * (j))
#define XB_XSUB(j)  (1280 + 64 * (j))
#define XB_XGEN(j)  (2304 + 64 * (j))
#define XB_TOP      3328
#define XB_TOPGEN   3392
#define XCD_BAR_WORDS 3456
#define XB_SPIN_CAP (1u << 21)

__device__ __forceinline__ unsigned xb_ld(unsigned* p)              { return __hip_atomic_load(p, __ATOMIC_RELAXED, __HIP_MEMORY_SCOPE_AGENT); }
__device__ __forceinline__ unsigned xb_add(unsigned* p, unsigned v) { return __hip_atomic_fetch_add(p, v, __ATOMIC_RELAXED, __HIP_MEMORY_SCOPE_AGENT); }
__device__ __forceinline__ unsigned xb_xcc_id() { return (unsigned)__builtin_amdgcn_s_getreg((3 << 11) | 20) & 0xFu; }
#define XB_SPIN(cond, bar) do { unsigned _sp = 0; while (cond) { __builtin_amdgcn_s_sleep(1); \
    if ((++_sp & 255u) == 0u) { if (xb_ld(&(bar)[XB_TMO])) break; if (_sp > XB_SPIN_CAP) { atomicAdd(&(bar)[XB_TMO], 1u); break; } } } } while (0)

struct XcdBarrier {
    unsigned* bar; unsigned x;
    volatile LAS unsigned* st;
    int w;
};

__device__ __forceinline__ XcdBarrier xcd_barrier_post(unsigned* bar, volatile LAS unsigned* st) {
    XcdBarrier b; b.bar = bar; b.x = xb_xcc_id(); b.st = st; b.w = 0;
    if (threadIdx.x == 0) (void)xb_add(&bar[XB_XCNT(b.x)], 1u);
    return b;
}
__device__ __forceinline__ void xcd_barrier_complete(unsigned* bar, unsigned x, unsigned& nloc, unsigned& nx) {
    const unsigned G = gridDim.x * gridDim.y * gridDim.z;
    unsigned sum, cnt, mine, sp = 0u;
    for (;;) {
        sum = 0u; cnt = 0u; mine = 0u;
#pragma unroll
        for (unsigned j = 0; j < 16; ++j) { const unsigned c = xb_ld(&bar[XB_XCNT(j)]); sum += c; cnt += (c > 0u) ? 1u : 0u; mine = (j == x) ? c : mine; }
        if (sum == G) break;
        __builtin_amdgcn_s_sleep(1);
        if ((++sp & 255u) == 0u) { if (xb_ld(&bar[XB_TMO])) break; if (sp > XB_SPIN_CAP) { atomicAdd(&bar[XB_TMO], 1u); break; } }
    }
    nloc = mine > 0u ? mine : 1u; nx = cnt > 0u ? cnt : 1u;
}

__device__ __forceinline__ void xcd_barrier(const XcdBarrier& b) {
    asm volatile("s_waitcnt vmcnt(0)" ::: "memory");
    __syncthreads();
    if (b.w == 0 && mk_lane() == 0) {
        unsigned* bar = b.bar; { GAS unsigned* bg_ = (GAS unsigned*)bar; asm volatile("" : "+s"(bg_)); bar = (unsigned*)bg_; }
        __builtin_amdgcn_s_waitcnt(0);
        unsigned nloc = b.st[0], nx = b.st[1];
        if (nloc == 0u) { xcd_barrier_complete(bar, b.x, nloc, nx); b.st[0] = nloc; b.st[1] = nx; }
        const unsigned old = xb_add(&bar[XB_XSUB(b.x)], 1u);
        const unsigned gen = old / nloc;
        if (old + 1u == (gen + 1u) * nloc) {
            __builtin_amdgcn_fence(__ATOMIC_RELEASE, "agent");
            asm volatile("s_waitcnt vmcnt(0)" ::: "memory");
            const unsigned og = xb_add(&bar[XB_TOP], 1u);
            const unsigned tg = og / nx;
            if (og + 1u == (tg + 1u) * nx) xb_add(&bar[XB_TOPGEN], 1u);
            else XB_SPIN(xb_ld(&bar[XB_TOPGEN]) == tg, bar);
            __builtin_amdgcn_fence(__ATOMIC_ACQUIRE, "agent");
            xb_add(&bar[XB_XGEN(b.x)], 1u);
            asm volatile("s_waitcnt vmcnt(0)" ::: "memory");
        } else {
            XB_SPIN(xb_ld(&bar[XB_XGEN(b.x)]) == gen, bar);
            __builtin_amdgcn_fence(__ATOMIC_ACQUIRE, "agent");
            asm volatile("s_waitcnt vmcnt(0)" ::: "memory");
        }
    }
    __syncthreads();
}

struct Frame {
    LAS unsigned char* lds;
    volatile LAS unsigned* MISC;
    unsigned* ctl;
    int vcu, G;
    int wv;
};
enum { I_X = 0, I_C, I_CTX, I_CCTX, I_WADA, I_BADA, I_GPREMIX, I_GPOSTMIX, I_GPREFFN, I_GPOSTFFN, I_WIN, I_BGATE, I_SINK, I_CONVW, I_RPB, I_WBRANCH, I_WOUT, I_WGUD, I_WDND, I_WROUTER, I_BROUTER, I_WGUM, I_WDNM };

__device__ __forceinline__ float wave_sum(float v) {
    v += mk_dpp<0xB1>(v); v += mk_dpp<0x4E>(v); v += mk_dpp<0x141>(v); v += mk_dpp<0x140>(v);
    v += mk_dpp<0x142, 0xa>(v); v += mk_dpp<0x143, 0xc>(v);
    return __builtin_bit_cast(float, __builtin_amdgcn_readlane(__builtin_bit_cast(int, v), 63));
}
__device__ __forceinline__ float wave_max(float v) {
    v = fmaxf(v, mk_dpp<0xB1>(v)); v = fmaxf(v, mk_dpp<0x4E>(v)); v = fmaxf(v, mk_dpp<0x141>(v)); v = fmaxf(v, mk_dpp<0x140>(v));
    const float a = __builtin_bit_cast(float, __builtin_amdgcn_readlane(__builtin_bit_cast(int, v), 0)), b = __builtin_bit_cast(float, __builtin_amdgcn_readlane(__builtin_bit_cast(int, v), 16)),
                c = __builtin_bit_cast(float, __builtin_amdgcn_readlane(__builtin_bit_cast(int, v), 32)), d = __builtin_bit_cast(float, __builtin_amdgcn_readlane(__builtin_bit_cast(int, v), 48));
    return fmaxf(fmaxf(a, b), fmaxf(c, d));
}

__device__ __forceinline__ void row_store_fp8(unsigned char* p, int lane, const f32x4 (&h)[4], float sc) {
#pragma unroll
    for (int c = 0; c < 2; ++c) { const f32x4 a = __builtin_elementwise_min(__builtin_elementwise_max(h[2 * c] * sc, (f32x4){-448.f, -448.f, -448.f, -448.f}), (f32x4){448.f, 448.f, 448.f, 448.f}), b = __builtin_elementwise_min(__builtin_elementwise_max(h[2 * c + 1] * sc, (f32x4){-448.f, -448.f, -448.f, -448.f}), (f32x4){448.f, 448.f, 448.f, 448.f});
        v2u w; w.x = pg8::pk4_fp8(a.x, a.y, a.z, a.w); w.y = pg8::pk4_fp8(b.x, b.y, b.z, b.w);
        *(v2u*)(p + 8 * (64 * c + lane)) = w; }
}

__device__ __forceinline__ void tr_item(const float* W, int N, int k0, int n0, bf16* WT, int Kd, int drow0, LAS float* scr, int lane) {
#pragma unroll
    for (int i = 0; i < 8; ++i) { const int kk = 8 * i + (lane >> 3), c4 = 4 * (lane & 7); const f32x4 v = *(const f32x4*)(W + (size_t)(k0 + kk) * N + n0 + c4);
        LAS float* d = scr + kk * 33 + c4; d[0] = v.x; d[1] = v.y; d[2] = v.z; d[3] = v.w; }
    LDS_WAIT(); asm volatile("" ::: "memory");
    const int c = lane & 7;
#pragma unroll
    for (int j = 0; j < 4; ++j) { const int n = (lane >> 3) + 8 * j; const LAS float* s = scr + (8 * c) * 33 + n;
        v4u o; o.x = pk2(s[0 * 33], s[1 * 33]); o.y = pk2(s[2 * 33], s[3 * 33]); o.z = pk2(s[4 * 33], s[5 * 33]); o.w = pk2(s[6 * 33], s[7 * 33]);
        *(v4u*)(WT + (size_t)(drow0 + n) * Kd + k0 + 8 * c) = o; }
    LDS_WAIT(); asm volatile("" ::: "memory");
}
__device__ __forceinline__ void tr_matrix_item(const float* W, int K, int N, int ff, bf16* WT, int item, LAS float* scr, int lane) {
    const int nblk = N / 32, kb = item / nblk, nb = item % nblk, n0 = 32 * nb;
    int drow0 = n0;
    if (ff > 0) { const int isu = n0 >= ff ? 1 : 0, nn = n0 - isu * ff; drow0 = 256 * (nn >> 7) + 128 * isu + (nn & 127); }
    tr_item(W, N, 64 * kb, n0, WT, K, drow0, scr, lane);
}

__device__ __forceinline__ void tr_item8(const float* W, int N, int k0, int n0, unsigned char* WT, int Kd, int drow0, float scale, LAS float* scr, int lane) {
#pragma unroll
    for (int i = 0; i < 8; ++i) { const int kk = 8 * i + (lane >> 3), c4 = 4 * (lane & 7); const f32x4 v = *(const f32x4*)(W + (size_t)(k0 + kk) * N + n0 + c4);
        LAS float* d = scr + kk * 33 + c4; d[0] = v.x; d[1] = v.y; d[2] = v.z; d[3] = v.w; }
    LDS_WAIT(); asm volatile("" ::: "memory");
    const int n = lane >> 1, kh = lane & 1; const LAS float* s = scr + (32 * kh) * 33 + n;
    unsigned w[8];
#pragma unroll
    for (int j = 0; j < 8; ++j) w[j] = pg8::pk4_fp8(s[(4 * j) * 33] * scale, s[(4 * j + 1) * 33] * scale, s[(4 * j + 2) * 33] * scale, s[(4 * j + 3) * 33] * scale);
    v4u* dst = (v4u*)(WT + (size_t)(drow0 + n) * Kd + k0 + 32 * kh);
    dst[0] = (v4u){w[0], w[1], w[2], w[3]}; dst[1] = (v4u){w[4], w[5], w[6], w[7]};
    LDS_WAIT(); asm volatile("" ::: "memory");
}
__device__ __forceinline__ void tr_matrix_item8(const float* W, int K, int N, int ff, unsigned char* WT, float scale, int item, LAS float* scr, int lane) {
    const int nblk = N / 32, kb = item / nblk, nb = item % nblk, n0 = 32 * nb;
    int drow0 = n0;
    if (ff > 0) { const int isu = n0 >= ff ? 1 : 0, nn = n0 - isu * ff; drow0 = 256 * (nn >> 7) + 128 * isu + (nn & 127); }
    tr_item8(W, N, 64 * kb, n0, WT, K, drow0, scale, scr, lane);
}

__device__ __forceinline__ void row_load(const float* p, int lane, f32x4 (&v)[4]) {
#pragma unroll
    for (int c = 0; c < 2; ++c) { const f32x4* r = (const f32x4*)(p + 8 * (64 * c + lane)); v[2 * c] = r[0]; v[2 * c + 1] = r[1]; }
}
__device__ __forceinline__ void row_load_bf16(const bf16* p, int lane, f32x4 (&v)[4]) {
#pragma unroll
    for (int c = 0; c < 2; ++c) { const v4u w = *(const v4u*)(p + 8 * (64 * c + lane));
        v[2 * c] = (f32x4){bflo(w.x), bfhi(w.x), bflo(w.y), bfhi(w.y)}; v[2 * c + 1] = (f32x4){bflo(w.z), bfhi(w.z), bflo(w.w), bfhi(w.w)}; }
}
__device__ __forceinline__ void row_store(float* p, int lane, const f32x4 (&v)[4]) {
#pragma unroll
    for (int c = 0; c < 2; ++c) { f32x4* r = (f32x4*)(p + 8 * (64 * c + lane)); r[0] = v[2 * c]; r[1] = v[2 * c + 1]; }
}
__device__ __forceinline__ float row_rrms(const f32x4 (&v)[4]) {
    float s = 0.f;
#pragma unroll
    for (int j = 0; j < 4; ++j) s += (v[j].x * v[j].x + v[j].y * v[j].y) + (v[j].z * v[j].z + v[j].w * v[j].w);
    return 1.0f / sqrtf(wave_sum(s) * (1.0f / D) + RMS_EPS);
}
__device__ __forceinline__ void vec_load(const float* p, int lane, f32x4 (&v)[4]) { row_load(p, lane, v); }
__device__ __forceinline__ void row_normmod(const f32x4 (&x)[4], float rr, const f32x4 (&g)[4], const f32x4 (&shift)[4], const f32x4 (&scale)[4], f32x4 (&h)[4]) {
#pragma unroll
    for (int j = 0; j < 4; ++j) h[j] = (x[j] * rr * g[j]) * (scale[j] + 1.0f) + shift[j];
}
__device__ __forceinline__ void row_store_bf16(bf16* p, int lane, const f32x4 (&h)[4]) {
#pragma unroll
    for (int c = 0; c < 2; ++c) { v4u w; w.x = pk2(h[2 * c].x, h[2 * c].y); w.y = pk2(h[2 * c].z, h[2 * c].w); w.z = pk2(h[2 * c + 1].x, h[2 * c + 1].y); w.w = pk2(h[2 * c + 1].z, h[2 * c + 1].w);
        *(v4u*)(p + 8 * (64 * c + lane)) = w; }
}

namespace at {
typedef short bf16x8 __attribute__((ext_vector_type(8)));
typedef short s16x4 __attribute__((ext_vector_type(4)));
typedef short v4i16_t __attribute__((ext_vector_type(4)));
typedef float f32x16 __attribute__((ext_vector_type(16)));
constexpr int NS = 4, PF = 3, SLOT = 16384;
constexpr int LDS_TAB = NS * SLOT + 1024;
constexpr int LDS_TT = LDS_TAB + 8 * 2048 + 1024;
constexpr int MAXT = 160;
constexpr float LOG2E = 1.4426950408889634f, C2 = 0.125f * LOG2E;
__device__ __forceinline__ unsigned cvtpk(float lo, float hi) { unsigned r; asm volatile("v_cvt_pk_bf16_f32 %0, %1, %2" : "=v"(r) : "v"(lo), "v"(hi)); return r; }
__device__ __forceinline__ float hmax(float v) { auto rr = __builtin_amdgcn_permlane32_swap(__float_as_uint(v), __float_as_uint(v), false, false); return fmaxf(__uint_as_float(rr[0]), __uint_as_float(rr[1])); }
__device__ __forceinline__ float hsum(float v) { auto rr = __builtin_amdgcn_permlane32_swap(__float_as_uint(v), __float_as_uint(v), false, false); return __uint_as_float(rr[0]) + __uint_as_float(rr[1]); }

__device__ __forceinline__ void glds16(const void* gsrc, unsigned lds_dst) { unsigned keep;
    asm volatile("s_mov_b32 %0, m0\n\ts_mov_b32 m0, %2\n\ts_nop 0\n\tglobal_load_lds_dwordx4 %1, off\n\ts_mov_b32 m0, %0" : "=&s"(keep) : "v"(gsrc), "s"(lds_dst) : "memory"); }
__device__ __forceinline__ void tile_issue(LAS unsigned char* slot, const bf16* ZMp, size_t row0, int kcol, int vcol, int wid, int lane) {
    const bf16* ksrc = ZMp + (row0 + lane) * ZMC + kcol + wid * 8;
    const bf16* vsrc = ZMp + (row0 + 16 * (wid & 3) + (lane >> 2)) * ZMC + vcol + (wid >> 2) * 32 + (lane & 3) * 8;
    const unsigned dst = (unsigned)__builtin_amdgcn_readfirstlane((int)(unsigned)(uintptr_t)slot + wid * 1024);
    glds16(ksrc, dst); glds16(vsrc, dst + 8192u);
}
__device__ __forceinline__ void k_load_half(bf16x8 (&kf)[4], const LAS unsigned char* Ks, int h, int r32, int hi) {
    const LAS unsigned char* kb = Ks + hi * 1024 + r32 * 16 + h * 4096;
#pragma unroll
    for (int d0 = 0; d0 < 2; ++d0) { kf[2 * d0] = *(const LAS bf16x8*)(kb + d0 * 2048); kf[2 * d0 + 1] = *(const LAS bf16x8*)(kb + d0 * 2048 + 512); }
}
__device__ __forceinline__ void qk_tile(f32x16& p0, f32x16& p1, const LAS unsigned char* Ks, const bf16x8 (&kfa)[4], const bf16x8 (&qr)[4], int r32, int hi) {
    bf16x8 kfb[4]; k_load_half(kfb, Ks, 1, r32, hi);
    __builtin_amdgcn_sched_barrier(0);
#pragma unroll
    for (int r = 0; r < 16; ++r) { p0[r] = 0.f; p1[r] = 0.f; }
#pragma unroll
    for (int d0 = 0; d0 < 2; ++d0) {
        p0 = __builtin_amdgcn_mfma_f32_32x32x16_bf16(kfa[2 * d0], qr[d0], p0, 0, 0, 0);
        p1 = __builtin_amdgcn_mfma_f32_32x32x16_bf16(kfa[2 * d0 + 1], qr[d0], p1, 0, 0, 0);
    }
#pragma unroll
    for (int d0 = 0; d0 < 2; ++d0) {
        p0 = __builtin_amdgcn_mfma_f32_32x32x16_bf16(kfb[2 * d0], qr[2 + d0], p0, 0, 0, 0);
        p1 = __builtin_amdgcn_mfma_f32_32x32x16_bf16(kfb[2 * d0 + 1], qr[2 + d0], p1, 0, 0, 0);
    }
}
__device__ __forceinline__ s16x4 vtr(const LAS unsigned char* p) { return __builtin_bit_cast(s16x4, __builtin_amdgcn_ds_read_tr16_b64_v4i16((LAS v4i16_t*)p)); }
template <int LV> __device__ __forceinline__ constexpr bool live0(int r) { return LV == 2 ? r >= 12 : true; }
template <int LV> __device__ __forceinline__ constexpr bool live1(int r) { return LV == 1 ? r < 4 : true; }
template <bool RAW, int LV, int VAR = 0>
__device__ __forceinline__ void sm_pv(f32x16& x0, f32x16& x1, float& m, float& l, f32x16 (&o)[2], const LAS unsigned char* Vs, int lane, int hi, bf16x8 (&kfa)[4], const LAS unsigned char* Ksn, bool pre) {
    if (VAR == 2) { l += x0[0] + x1[15];
        bf16x8 pw_[4]; unsigned w_[16];
#pragma unroll
        for (int i = 0; i < 8; ++i) { w_[i] = cvtpk(x0[2 * i], x0[2 * i + 1]); w_[8 + i] = cvtpk(x1[2 * i], x1[2 * i + 1]); }
#pragma unroll
        for (int k = 0; k < 4; ++k) { typedef unsigned u32x4_ __attribute__((ext_vector_type(4))); u32x4_ t; t.x = w_[4 * k]; t.y = w_[4 * k + 1]; t.z = w_[4 * k + 2]; t.w = w_[4 * k + 3]; pw_[k] = __builtin_bit_cast(bf16x8, t); }
        const LAS unsigned char* vb_ = Vs + ((lane >> 4) & 1) * 32 + (lane & 3) * 8 + (4 * hi + ((lane & 15) >> 2)) * 64;
#pragma unroll
        for (int d0 = 0; d0 < 2; ++d0)
#pragma unroll
            for (int ks = 0; ks < 4; ++ks) { if ((LV == 1 && ks == 3) || (LV == 2 && ks == 0)) continue;
                const s16x4 lo = vtr(vb_ + d0 * 4096 + ks * 1024), hh = vtr(vb_ + d0 * 4096 + ks * 1024 + 512);
                const bf16x8 vf = (bf16x8){lo[0], lo[1], lo[2], lo[3], hh[0], hh[1], hh[2], hh[3]};
                o[d0] = __builtin_amdgcn_mfma_f32_32x32x16_bf16(vf, pw_[ks], o[d0], 0, 0, 0); }
        if (pre) k_load_half(kfa, Ksn, 0, lane & 31, hi);
        return; }
    if (VAR == 3) { if (pre) k_load_half(kfa, Ksn, 0, lane & 31, hi); l += x0[0] + x1[15] + x0[7] + x1[3]; o[0][0] += x0[1]; o[1][0] += x1[1]; return; }
    float rm = -INFINITY;
#pragma unroll
    for (int r = 0; r < 16; ++r) { if (live0<LV>(r)) rm = fmaxf(rm, x0[r]); if (live1<LV>(r)) rm = fmaxf(rm, x1[r]); }
    rm = hmax(rm);
    const float mn = fmaxf(m, RAW ? rm * C2 : rm);
    { const float sc = __builtin_amdgcn_exp2f(m - mn); l *= sc;
#pragma unroll
      for (int r = 0; r < 16; ++r) { o[0][r] *= sc; o[1][r] *= sc; } }
    m = mn;
    float sum = 0.f;
#pragma unroll
    for (int r = 0; r < 16; ++r) {
        if (live0<LV>(r)) { x0[r] = __builtin_amdgcn_exp2f(RAW ? __builtin_fmaf(x0[r], C2, -mn) : x0[r] - mn); sum += x0[r]; } else x0[r] = 0.f;
        if (live1<LV>(r)) { x1[r] = __builtin_amdgcn_exp2f(RAW ? __builtin_fmaf(x1[r], C2, -mn) : x1[r] - mn); sum += x1[r]; } else x1[r] = 0.f;
    }
    l += sum;
    bf16x8 pw[4];
    { unsigned w[16];
#pragma unroll
      for (int i = 0; i < 8; ++i) { w[i] = cvtpk(x0[2 * i], x0[2 * i + 1]); w[8 + i] = cvtpk(x1[2 * i], x1[2 * i + 1]); }
#pragma unroll
      for (int k = 0; k < 4; ++k) { typedef unsigned u32x4_ __attribute__((ext_vector_type(4))); u32x4_ t; t.x = w[4 * k]; t.y = w[4 * k + 1]; t.z = w[4 * k + 2]; t.w = w[4 * k + 3]; pw[k] = __builtin_bit_cast(bf16x8, t); } }
    if (pre) k_load_half(kfa, Ksn, 0, lane & 31, hi);
    const LAS unsigned char* vb = Vs + ((lane >> 4) & 1) * 32 + (lane & 3) * 8 + (4 * hi + ((lane & 15) >> 2)) * 64;
#pragma unroll
    for (int d0 = 0; d0 < 2; ++d0)
#pragma unroll
        for (int ks = 0; ks < 4; ++ks) {
            if ((LV == 1 && ks == 3) || (LV == 2 && ks == 0)) continue;
            const s16x4 lo = vtr(vb + d0 * 4096 + ks * 1024), hh = vtr(vb + d0 * 4096 + ks * 1024 + 512);
            const bf16x8 vf = (bf16x8){lo[0], lo[1], lo[2], lo[3], hh[0], hh[1], hh[2], hh[3]};
            o[d0] = __builtin_amdgcn_mfma_f32_32x32x16_bf16(vf, pw[ks], o[d0], 0, 0, 0);
        }
}
__device__ __forceinline__ void o_store(const f32x16 (&o)[2], float l, bf16* orow, int hi) {
    const float inv = __builtin_amdgcn_rcpf(hsum(l));
#pragma unroll
    for (int d0 = 0; d0 < 2; ++d0)
#pragma unroll
        for (int gp = 0; gp < 2; ++gp) {
            unsigned w[2][2];
#pragma unroll
            for (int k = 0; k < 2; ++k) { const int g = 2 * gp + k; w[k][0] = cvtpk(o[d0][4 * g] * inv, o[d0][4 * g + 1] * inv); w[k][1] = cvtpk(o[d0][4 * g + 2] * inv, o[d0][4 * g + 3] * inv); }
            unsigned rcv[2];
#pragma unroll
            for (int i = 0; i < 2; ++i) { const unsigned snd = hi ? w[0][i] : w[1][i];
                auto rr = __builtin_amdgcn_permlane32_swap(snd, snd, false, false); rcv[i] = hi ? rr[0] : rr[1]; }
            v4u st; if (hi) { st.x = rcv[0]; st.y = rcv[1]; st.z = w[1][0]; st.w = w[1][1]; } else { st.x = w[0][0]; st.y = w[0][1]; st.z = rcv[0]; st.w = rcv[1]; }
            *(v4u*)(orow + 32 * d0 + 16 * gp + 8 * hi) = st;
        }
}
#define AT_WAIT_BAR(N) asm volatile("s_waitcnt vmcnt(" #N ")\n\ts_barrier" ::: "memory")

struct UDesc { int kind, b, hh, blk, cq, nw, lo; };
__device__ __forceinline__ UDesc unit_desc(int i, int vcu, int UPW, bool ctx_out) {
    UDesc d; d.kind = -1; d.b = 0; d.hh = 0; d.blk = 0; d.cq = 0; d.nw = 0; d.lo = 0;
    if (i < 2 * UPW) { const int u = vcu * UPW + (i < UPW ? i : i - UPW); if (u >= 1024) return d; d.kind = i < UPW ? 0 : 1; d.b = u >> 8;
        if (d.kind == 0) { d.hh = (u >> 5) & 7; d.blk = u & 31; } else { d.hh = (u >> 7) & 1; d.blk = u & 127; } }
    else if (i == 2 * UPW) { if (!ctx_out || vcu >= 64) return d; d.cq = 1;
        if (vcu < 32) { d.kind = 1; d.b = vcu >> 3; d.hh = (vcu >> 2) & 1; d.blk = vcu & 3; } else { d.kind = 0; d.b = (vcu - 32) >> 3; d.hh = (vcu - 32) & 7; d.blk = 0; } }
    else return d;
    if (!d.cq) {
        if (d.kind == 1) { d.lo = max(0, 2 - d.blk); d.nw = min(4, 129 - d.blk) - d.lo + 1; }
        else { d.lo = min(max(4 * d.blk - 4, 0), 120); d.nw = min(max(4 * d.blk - 1, 0), 120) + 7 - d.lo + 1; }
    }
    return d;
}
__device__ __forceinline__ void tile_src(const UDesc& d, int t, int& row0, int& cols) {
    const int kcol = d.kind == 1 ? C_KA + d.hh * 64 : C_KN + d.hh * 64, vcol = d.kind == 1 ? C_VA + d.hh * 64 : C_VN + d.hh * 64;
    cols = kcol | (vcol << 16);
    if (t < d.nw) row0 = d.kind == 1 ? d.b * SEQ + 64 * d.blk - 128 + 64 * (d.lo + t) : d.b * SEQ + 64 * (d.lo + t);
    else row0 = TL + d.b * CTXL + 64 * (t - d.nw);
}
__device__ __forceinline__ size_t q_row(const UDesc& d, int wid, int r32) {
    if (d.kind == 1) { const int qrel = 32 * (wid >> 2) + r32; return d.cq ? (size_t)TL + (size_t)d.b * CTXL + 64 * d.blk + qrel : (size_t)d.b * SEQ + 64 * d.blk + qrel; }
    const int pair = wid >> 1, c = 32 * (wid & 1) + r32;
    return d.cq ? (size_t)TL + (size_t)d.b * CTXL + 64 * pair + c : (size_t)d.b * SEQ + (size_t)(4 * d.blk + pair) * 64 + c;
}
__device__ __forceinline__ void q_load(const UDesc& d, const bf16* ZMp, int wid, int r32, int hi, bf16x8 (&qr)[4]) {
    const int qcol = d.kind == 1 ? C_QA + (d.hh * 4 + (wid & 3)) * 64 : C_QN + d.hh * 64;
    const bf16* p = ZMp + q_row(d, wid, r32) * ZMC + qcol + 8 * hi;
#pragma unroll
    for (int d0 = 0; d0 < 4; ++d0) qr[d0] = *(const bf16x8*)(p + 16 * d0);
}

template <int VAR = 0>
__device__ __forceinline__ void attn_phase(LAS unsigned char* lds, const bf16* ZMp, bf16* OAp, bf16* OCp, const float* sinkp, const float* rpbl, int vcu, int G, bool ctx_out, int tid, int wid, int lane) {
    const int r32 = lane & 31, hi = lane >> 5;
    const int UPW = (1024 + G - 1) / G, NU = 2 * UPW + 1;
    LAS int* tt = (LAS int*)(lds + LDS_TT);
    int Ttot = 0;
    for (int i = 0; i < NU; ++i) { const UDesc d = unit_desc(i, vcu, UPW, ctx_out); if (d.kind < 0) continue; const int nt = d.nw + 4;
        for (int t = tid; t < nt; t += NWAVES * 64) { int row0, cols; tile_src(d, t, row0, cols); if (Ttot + t < MAXT) { tt[2 * (Ttot + t)] = row0; tt[2 * (Ttot + t) + 1] = cols; } }
        Ttot += nt; }
    if (Ttot > MAXT) Ttot = MAXT;
    if (tid < 8) ((LAS float*)(lds + LDS_TT + MAXT * 8))[tid] = sinkp[tid] * LOG2E;
    for (int u = tid; u < 8 * 480; u += NWAVES * 64) { const int h = u / 480, e = u - 480 * h, dr = e >> 5, dc = e & 31; ((LAS float*)(lds + LDS_TAB))[h * 512 + e] = dc < 31 ? rpbl[(h * 15 + dr) * 31 + dc] * LOG2E : 0.f; }
    asm volatile("s_waitcnt lgkmcnt(0)\n\ts_barrier" ::: "memory");
#define AT_ISSUE(T) do { const int row0_ = __builtin_amdgcn_readfirstlane(tt[2 * (T)]), cols_ = __builtin_amdgcn_readfirstlane(tt[2 * (T) + 1]); \
        tile_issue(lds + ((T) & (NS - 1)) * SLOT, ZMp, (size_t)row0_, cols_ & 0xffff, cols_ >> 16, wid, lane); } while (0)
    for (int T = 0; T < PF && T < Ttot; ++T) AT_ISSUE(T);
    int Tb = 0;
    bf16x8 qn[4];
    { int i0 = 0; UDesc d0 = unit_desc(0, vcu, UPW, ctx_out); while (d0.kind < 0 && i0 + 1 < NU) { ++i0; d0 = unit_desc(i0, vcu, UPW, ctx_out); } if (d0.kind >= 0) q_load(d0, ZMp, wid, r32, hi, qn); }
    for (int i = 0; i < NU; ++i) {
        const UDesc d = unit_desc(i, vcu, UPW, ctx_out); if (d.kind < 0) continue;
        bf16x8 qr[4];
#pragma unroll
        for (int k = 0; k < 4; ++k) qr[k] = qn[k];
        { int j = i + 1; UDesc dn = unit_desc(j, vcu, UPW, ctx_out); while (dn.kind < 0 && j + 1 < NU) { ++j; dn = unit_desc(j, vcu, UPW, ctx_out); } if (dn.kind < 0) dn = d; q_load(dn, ZMp, wid, r32, hi, qn); }
        const int NT = d.nw + 4;
        f32x16 o[2];
#pragma unroll
        for (int r = 0; r < 16; ++r) { o[0][r] = 0.f; o[1][r] = 0.f; }
        float m, l;
        if (d.kind == 1) {
            const int head = d.hh * 4 + (wid & 3), qrel = 32 * (wid >> 2) + r32;
            m = ((const LAS float*)(lds + LDS_TT + MAXT * 8))[head]; l = (hi == 0) ? 1.0f : 0.0f;
            bf16x8 kfa[4];
#pragma unroll
            for (int k = 0; k < 4; ++k) kfa[k] = (bf16x8){0, 0, 0, 0, 0, 0, 0, 0};
            int t = 0;
            do {
                const int T = Tb + t;
                if (T + 2 < Ttot) AT_WAIT_BAR(2); else AT_WAIT_BAR(0);
                if (t == NT - 1) asm volatile("" : "+v"(qn[0]), "+v"(qn[1]), "+v"(qn[2]), "+v"(qn[3]));
                if (VAR != 5 && T + PF < Ttot) AT_ISSUE(T + PF);
                const LAS unsigned char* sl = lds + (T & (NS - 1)) * SLOT;
                const LAS unsigned char* sln = lds + ((T + 1) & (NS - 1)) * SLOT; const bool pre = t + 1 < NT;
                if (t == 0) k_load_half(kfa, sl, 0, r32, hi);
                f32x16 x0, x1; qk_tile(x0, x1, sl, kfa, qr, r32, hi);
                const int j = d.lo + t;
                if (t < d.nw && (j == 0 || j == 4)) {
                    const int dq = qrel + 128 - 64 * j - 4 * hi;
#pragma unroll
                    for (int r = 0; r < 16; ++r) { const int dd = dq - ((r & 3) + 8 * (r >> 2));
                        x0[r] = (dd <= 128 && dd >= -128) ? x0[r] * C2 : -INFINITY; x1[r] = (dd - 32 <= 128 && dd - 32 >= -128) ? x1[r] * C2 : -INFINITY; }
                    sm_pv<false, 0, VAR>(x0, x1, m, l, o, sl + 8192, lane, hi, kfa, sln, pre);
                } else sm_pv<true, 0, VAR>(x0, x1, m, l, o, sl + 8192, lane, hi, kfa, sln, pre);
            } while (++t < NT);
            o_store(o, l, OAp + q_row(d, wid, r32) * BW + head * 64, hi);
        } else {
            const int half = wid & 1, c = 32 * half + r32, r = 4 * d.blk + (wid >> 1);
            const int r0w = min(max(r - 4, 0), 120), c0 = min(max(c - 8, 0), 48);
            const LAS float* tab = (const LAS float*)(lds + LDS_TAB + d.hh * 2048);
            unsigned vm = 0u;
#pragma unroll
            for (int r_ = 0; r_ < 16; ++r_) { const int kc = (r_ & 3) + 8 * (r_ >> 2) + 4 * hi; vm |= ((unsigned)(kc - c0) < 16u ? 1u : 0u) << r_; vm |= ((unsigned)(kc + 32 - c0) < 16u ? 1u : 0u) << (16 + r_); }
            m = -1e30f; l = 0.f;
            bf16x8 kfa[4];
#pragma unroll
            for (int k = 0; k < 4; ++k) kfa[k] = (bf16x8){0, 0, 0, 0, 0, 0, 0, 0};
            int t = 0;
            do {
                const int T = Tb + t;
                if (T + 2 < Ttot) AT_WAIT_BAR(2); else AT_WAIT_BAR(0);
                if (t == NT - 1) asm volatile("" : "+v"(qn[0]), "+v"(qn[1]), "+v"(qn[2]), "+v"(qn[3]));
                if (VAR != 5 && T + PF < Ttot) AT_ISSUE(T + PF);
                const int kr = d.lo + t;
                const bool use = !(t < d.nw && (kr < r0w || kr > r0w + 7));
                const bool usen = !(t + 1 < d.nw && (kr + 1 < r0w || kr + 1 > r0w + 7));
                const LAS unsigned char* sl = lds + (T & (NS - 1)) * SLOT; const LAS unsigned char* sln = lds + ((T + 1) & (NS - 1)) * SLOT; const bool pre = usen && t + 1 < NT;
                if (!use) { if (pre) k_load_half(kfa, sln, 0, r32, hi); continue; }
                if (t == 0) k_load_half(kfa, sl, 0, r32, hi);
                f32x16 x0, x1; qk_tile(x0, x1, sl, kfa, qr, r32, hi);
                if (t < d.nw) {
                    const LAS float* tb = tab + (kr - r + 7) * 32 + (4 * hi - c + 15);
                    if (half == 0) {
                        float b0[16], b1[4];
#pragma unroll
                        for (int r_ = 0; r_ < 16; ++r_) { const int rr = (r_ & 3) + 8 * (r_ >> 2); b0[r_] = tb[rr]; if (r_ < 4) b1[r_] = tb[rr + 32]; }
#pragma unroll
                        for (int r_ = 0; r_ < 16; ++r_) {
                            x0[r_] = ((vm >> r_) & 1u) ? __builtin_fmaf(x0[r_], C2, b0[r_]) : -INFINITY;
                            if (r_ < 4) x1[r_] = ((vm >> (16 + r_)) & 1u) ? __builtin_fmaf(x1[r_], C2, b1[r_]) : -INFINITY; }
                        sm_pv<false, 1, VAR>(x0, x1, m, l, o, sl + 8192, lane, hi, kfa, sln, pre);
                    } else {
                        float b0[4], b1[16];
#pragma unroll
                        for (int r_ = 0; r_ < 16; ++r_) { const int rr = (r_ & 3) + 8 * (r_ >> 2); if (r_ >= 12) b0[r_ - 12] = tb[rr]; b1[r_] = tb[rr + 32]; }
#pragma unroll
                        for (int r_ = 0; r_ < 16; ++r_) {
                            if (r_ >= 12) x0[r_] = ((vm >> r_) & 1u) ? __builtin_fmaf(x0[r_], C2, b0[r_ - 12]) : -INFINITY;
                            x1[r_] = ((vm >> (16 + r_)) & 1u) ? __builtin_fmaf(x1[r_], C2, b1[r_]) : -INFINITY; }
                        sm_pv<false, 2, VAR>(x0, x1, m, l, o, sl + 8192, lane, hi, kfa, sln, pre);
                    }
                } else sm_pv<true, 0, VAR>(x0, x1, m, l, o, sl + 8192, lane, hi, kfa, sln, pre);
            } while (++t < NT);
            o_store(o, l, OCp + q_row(d, wid, r32) * BW + d.hh * 64, hi);
        }
        Tb += NT;
    }
    AT_WAIT_BAR(0);
#undef AT_ISSUE
}
}

constexpr int PH_PER_LAYER = 17, NPHASES = 1 + DEPTH * PH_PER_LAYER;
struct Args { const float* in[23]; float* out; unsigned char* ws; int ph_lo, ph_hi; };
typedef __attribute__((address_space(4))) const Args CArgs;
__global__ void __launch_bounds__(NWAVES * 64, 2) mk_fwd(Args args) {
    extern __shared__ __attribute__((aligned(16))) unsigned char lds[];
    Frame F;
    F.lds = (LAS unsigned char*)lds;
    F.MISC = (volatile LAS unsigned*)(F.lds + MISC_OFF);
    F.G = gridDim.x; { const int bx = blockIdx.x; F.vcu = (F.G % 8 == 0) ? (bx % 8) * (F.G / 8) + bx / 8 : bx; }
    F.ctl = (unsigned*)(args.ws + WS_CTL);
    for (int u = threadIdx.x; u < (ROPEL_OFF - LDSCTL_OFF) / 4; u += NWAVES * 64) ((LAS unsigned*)(F.lds + LDSCTL_OFF))[u] = 0u;
    for (int u = threadIdx.x; u < 192 * 16; u += NWAVES * 64) { const int idx = u >> 4, i = u & 15; const float pos = (float)(idx < 128 ? idx : idx - 128);
        const float inv = 1.0f / powf(10000.0f, (float)(2 * i) / 32.0f); const float ang = pos * inv;
        ((LAS float*)(F.lds + ROPEL_OFF))[2 * u] = cosf(ang); ((LAS float*)(F.lds + ROPEL_OFF))[2 * u + 1] = sinf(ang); }
    { int wv_ = __builtin_amdgcn_readfirstlane((int)(threadIdx.x >> 6)); asm volatile("" : "+s"(wv_)); F.wv = wv_; }
    __syncthreads();
    const int lo = args.ph_lo, hi = args.ph_hi;
    const bool fused = (hi - lo) > 1;
    XcdBarrier bar; bar.bar = F.ctl + CW_BAR; bar.x = 0; bar.st = nullptr; bar.w = F.wv;
    if (fused) { bar = xcd_barrier_post(F.ctl + CW_BAR, F.MISC + 8); bar.w = F.wv; }
#ifndef MK_MASK
#define MK_MASK 0xFFFFFFFFu
#endif
#define SLOT(k) ((k) == 0 ? 0 : (((k) - 1) % PH_PER_LAYER) + 1)
#define IN(k) (((MK_MASK >> SLOT(k)) & 1u) && lo <= (k) && (k) < hi)
#define GRID_BAR() do { if (fused) xcd_barrier(bar); } while (0)
    const int NGW = F.G * NWAVES;
#define PHASE_ENTER() GAS unsigned char* wsg_ = (GAS unsigned char*)args.ws; asm volatile("" : "+s"(wsg_)); unsigned char* ws = (unsigned char*)wsg_; float* outp = (float*)(GAS float*)args.out; (void)outp; const CArgs* ka = (const CArgs*)__builtin_amdgcn_kernarg_segment_ptr(); asm volatile("" : "+s"(ka)); \
    int tid_ = (F.wv << 6) | mk_lane(); asm volatile("" : "+v"(tid_)); const int lane = tid_ & 63; const int wave = __builtin_amdgcn_readfirstlane(tid_ >> 6); const int gw = F.vcu * NWAVES + wave; (void)gw; (void)lane; (void)ws; (void)ka;
#define INP(i) ((const float*)(const GAS float*)ka->in[i])
#define MOD ((float*)(GAS float*)(ws + WS_MOD))
#define ROPE ((float*)(GAS float*)(ws + WS_ROPE))
#define SLABCNT ((int*)(GAS int*)(ws + WS_SLABCNT))
#define PCUM ((int*)(GAS int*)(ws + WS_PCUM))
#define TOKER ((int*)(GAS int*)(ws + WS_TOKER))
#define TOKG ((float*)(GAS float*)(ws + WS_TOKG))
#define TOKPOS ((int*)(GAS int*)(ws + WS_TOKPOS))
#define HCTX ((float*)(GAS float*)(ws + WS_HCTX))
#define RS ((bf16*)(GAS bf16*)(ws + WS_RS))
#define W_IN ((bf16*)(GAS bf16*)(ws + WS_WIN))
#define W_BR ((bf16*)(GAS bf16*)(ws + WS_WBR))
#define W_OUT ((bf16*)(GAS bf16*)(ws + WS_WOUT))
#define W_GUD ((bf16*)(GAS bf16*)(ws + WS_WGUD))
#define W_DND ((bf16*)(GAS bf16*)(ws + WS_WDND))
#define W_GUM8 ((unsigned char*)(GAS unsigned char*)(ws + WS_WGUM))
#define W_DNM8 ((unsigned char*)(GAS unsigned char*)(ws + WS_WDNM))
#define HX ((bf16*)(GAS bf16*)(ws + WS_HX))
#define ZM ((bf16*)(GAS bf16*)(ws + WS_ZM))
#define ZG ((bf16*)(GAS bf16*)(ws + WS_ZG))
#define OA ((bf16*)(GAS bf16*)(ws + WS_O))
#define OB (OA + (size_t)TA * BW)
#define OC (OA + (size_t)2 * TA * BW)
#define SB ((float*)(GAS float*)(ws + WS_ZM))
#define Y16 ((bf16*)(GAS bf16*)(ws + WS_ZG))
#define HD ((bf16*)(GAS bf16*)(ws + WS_ZM))
#define XG ((bf16*)(GAS bf16*)(ws + WS_XG))
#define HM8 ((unsigned char*)(GAS unsigned char*)(ws + WS_HM))
#define XG8 ((unsigned char*)(GAS unsigned char*)(ws + WS_XG8))
#define HX8 ((unsigned char*)(GAS unsigned char*)(ws + WS_HX8))
#define W_ING8 ((unsigned char*)(GAS unsigned char*)(ws + WS_WING8))

    if (IN(0)) {
        PHASE_ENTER();
        {
            LAS float* scv = (LAS float*)(F.lds + RING_OFF);
            LAS float* red = scv + 5 * 1024;
            for (int u = tid_; u < 5 * 1024; u += NWAVES * 64) { const int bb = u >> 10, k = u & 1023; const float cv = bb < 4 ? INP(I_C)[bb * 1024 + k] : INP(I_CCTX)[k]; scv[u] = cv / (1.0f + __expf(-cv)); }
            __syncthreads();
            for (int it = blockIdx.x; it < 2 * 96; it += F.G) {
                const int l = it / 96, n = (it % 96) * 64 + lane;
                const float* wp = INP(I_WADA) + (size_t)l * D * 6144 + n;
                float a0 = 0.f, a1 = 0.f, a2 = 0.f, a3 = 0.f, a4 = 0.f;
                const int kb = wave * 128;
#pragma unroll 16
                for (int k = 0; k < 128; ++k) { const float w = wp[(size_t)(kb + k) * 6144];
                    a0 += scv[kb + k] * w; a1 += scv[1024 + kb + k] * w; a2 += scv[2048 + kb + k] * w; a3 += scv[3072 + kb + k] * w; a4 += scv[4096 + kb + k] * w; }
                red[(wave * 5 + 0) * 64 + lane] = a0; red[(wave * 5 + 1) * 64 + lane] = a1; red[(wave * 5 + 2) * 64 + lane] = a2; red[(wave * 5 + 3) * 64 + lane] = a3; red[(wave * 5 + 4) * 64 + lane] = a4;
                __syncthreads();
                if (tid_ < 320) { const int bb = tid_ >> 6, nn = tid_ & 63; float s = 0.f;
#pragma unroll
                    for (int w = 0; w < 8; ++w) s += red[(w * 5 + bb) * 64 + nn];
                    const int col = (it % 96) * 64 + nn;
                    MOD[((size_t)l * 5 + bb) * 6144 + col] = s + INP(I_BADA)[l * 6144 + col]; }
                __syncthreads();
            }
        }
        __syncthreads();
        {
            LAS float* scr = (LAS float*)(F.lds + RING_OFF + wave * 16384);
            constexpr int I_IN = (D / 64) * (INC / 32), I_BR = (BW / 64) * (D / 32), I_OUT = (D / 64) * (D / 32), I_GUD = (D / 64) * (2 * FFD / 32), I_DND = (FFD / 64) * (D / 32),
                          I_GUM = (D / 64) * (2 * FFE / 32), I_DNM = (FFE / 64) * (D / 32);
            constexpr int NITEMS = 2 * I_IN + 6 * I_BR + 2 * I_OUT + I_GUD + I_DND + NE * I_GUM + NE * I_DNM;
            for (int it = gw; it < NITEMS; it += NGW) {
                int r = it;
                if (r < 2 * I_IN) { const int l = r / I_IN, it2 = r % I_IN, n0 = 32 * (it2 % (INC / 32));
                    if (MK_GATE_F8 == 2) { tr_item8(INP(I_WIN) + (size_t)l * D * INC, INC, 64 * (it2 / (INC / 32)), n0, (unsigned char*)W_IN + (size_t)l * INC * D, D, n0, SC_WGU, scr, lane); continue; }
                    if (!MK_GATE_F8 || n0 < ZMC) tr_matrix_item(INP(I_WIN) + (size_t)l * D * INC, D, INC, 0, W_IN + (size_t)l * INC * D, it2, scr, lane);
                    if (MK_GATE_F8 && n0 >= ZMC) tr_item8(INP(I_WIN) + (size_t)l * D * INC, INC, 64 * (it2 / (INC / 32)), n0, W_ING8 + (size_t)l * ZGC * D, D, n0 - ZMC, SC_WGU, scr, lane);
                    continue; } r -= 2 * I_IN;
                if (r < 6 * I_BR) { const int q = r / I_BR; tr_matrix_item(INP(I_WBRANCH) + (size_t)q * BW * D, BW, D, 0, W_BR + (size_t)q * D * BW, r % I_BR, scr, lane); continue; } r -= 6 * I_BR;
                if (r < 2 * I_OUT) { const int l = r / I_OUT; tr_matrix_item(INP(I_WOUT) + (size_t)l * D * D, D, D, 0, W_OUT + (size_t)l * D * D, r % I_OUT, scr, lane); continue; } r -= 2 * I_OUT;
                if (r < I_GUD) { if (MK_DENSE_F8 >= 2) tr_matrix_item8(INP(I_WGUD), D, 2 * FFD, FFD, (unsigned char*)W_GUD, SC_WGU, r, scr, lane); else tr_matrix_item(INP(I_WGUD), D, 2 * FFD, FFD, W_GUD, r, scr, lane); continue; } r -= I_GUD;
                if (r < I_DND) { if (MK_DENSE_F8 >= 1) tr_matrix_item8(INP(I_WDND), FFD, D, 0, (unsigned char*)W_DND, SC_WDN, r, scr, lane); else tr_matrix_item(INP(I_WDND), FFD, D, 0, W_DND, r, scr, lane); continue; } r -= I_DND;
                if (r < NE * I_GUM) { const int e = r / I_GUM; tr_matrix_item8(INP(I_WGUM) + (size_t)e * D * 2 * FFE, D, 2 * FFE, FFE, W_GUM8 + (size_t)e * 2 * FFE * D, SC_WGU, r % I_GUM, scr, lane); continue; } r -= NE * I_GUM;
                { const int e = r / I_DNM; tr_matrix_item8(INP(I_WDNM) + (size_t)e * FFE * D, FFE, D, 0, W_DNM8 + (size_t)e * D * FFE, SC_WDN, r % I_DNM, scr, lane); }
            }
        }
        GRID_BAR();
    }

    for (int l = 0; l < DEPTH; ++l) {
        const int pb = 1 + l * PH_PER_LAYER;
        const bool ctx_out = (l < DEPTH - 1);
        const bool moe = (l & 1) != 0;
        const int rows_out = ctx_out ? TA : TL;
#define modl (MOD + (size_t)l * 5 * 6144)
#define xsrc_lat ((l == 0) ? INP(I_X) : (const float*)outp)
#define xsrc_ctx ((l == 0) ? INP(I_CTX) : (const float*)HCTX)

        if (IN(pb + 0) && l == 0) {
            PHASE_ENTER();
            const int chunk = (TL + NGW - 1) / NGW;
#define P1_ROW(t) do { const float* xr = (t) < TL ? xsrc_lat + (size_t)(t) * D : xsrc_ctx + (size_t)((t) - TL) * D; \
                f32x4 x[4], h[4]; row_load(xr, lane, x); const float rr = row_rrms(x); row_normmod(x, rr, gpre, sh, sc, h); if (MK_GATE_F8 < 2) row_store_bf16(HX + (size_t)(t) * D, lane, h); if (MK_GATE_F8) row_store_fp8(HX8 + (size_t)(t) * D, lane, h, SC_XG); } while (0)
            f32x4 gpre[4], sh[4], sc[4]; vec_load(INP(I_GPREMIX) + l * D, lane, gpre);
            for (int t0 = min(gw * chunk, TL), t1 = min(TL, t0 + chunk); t0 < t1; ) { const int bb = t0 >> 13, te = min(t1, (bb + 1) << 13); const float* md = modl + (size_t)bb * 6144;
                vec_load(md, lane, sh); vec_load(md + 1024, lane, sc);
                for (int t = t0; t < te; ++t) P1_ROW(t);
                t0 = te; }
            { const float* md = modl + (size_t)4 * 6144; vec_load(md, lane, sh); vec_load(md + 1024, lane, sc); for (int t = TL + gw; t < TA; t += NGW) P1_ROW(t); }
#undef P1_ROW
            GRID_BAR();
        }
        if (IN(pb + 1)) {
            PHASE_ENTER();
#if MK_GATE_F8 == 2
            {
                pg8::Gemm g{(const bf16*)HX8, (const bf16*)((unsigned char*)W_IN + (size_t)l * INC * D), TA, ZMC, D}; pg8::StaticOrder S; S.init(TA, ZMC, F.G, (int)blockIdx.x, MK_WGM);
                pg8::EpiZT<true> E{ZM, ZG, ROPE, TL / 256, INP(I_BGATE) + (size_t)l * 3 * D, 0, 1.0f / (SC_XG * SC_WGU)};
                pg8::gemm_phase<pg8::EpiZT<true>, pg8::StaticOrder, PG8_ALIGN, PG8_SP2>(F.lds + RING_OFF, g, S, E, F.wv);
            }
            {
                pg8::Gemm g{(const bf16*)HX8, (const bf16*)((unsigned char*)W_IN + (size_t)l * INC * D + (size_t)ZMC * D), rows_out, ZGC, D}; pg8::StaticOrder S; S.init(rows_out, ZGC, F.G, (int)blockIdx.x, MK_WGM);
                pg8::EpiZT<true> E{ZM, ZG, ROPE, TL / 256, INP(I_BGATE) + (size_t)l * 3 * D, ZMC / 256, 1.0f / (SC_XG * SC_WGU)};
                pg8::gemm_phase<pg8::EpiZT<true>, pg8::StaticOrder, PG8_ALIGN, PG8_SP2>(F.lds + RING_OFF, g, S, E, F.wv);
            }
#elif MK_GATE_F8
            {
                pg8::Gemm g{HX, W_IN + (size_t)l * INC * D, TA, ZMC, D}; pg8::StaticOrder S; S.init(TA, ZMC, F.G, (int)blockIdx.x, MK_WGM);
                pg8::EpiZM E{ZM, (const LAS float*)(F.lds + ROPEL_OFF), TL / 256};
                pg8::gemm_phase<pg8::EpiZM, pg8::StaticOrder, PG8_ALIGN, PG8_SP2>(F.lds + RING_OFF, g, S, E, F.wv);
            }
            {
                pg8::Gemm g{(const bf16*)HX8, (const bf16*)(W_ING8 + (size_t)l * ZGC * D), rows_out, ZGC, D}; pg8::StaticOrder S; S.init(rows_out, ZGC, F.G, ((int)blockIdx.x + 68) % F.G, MK_WGM);
                pg8::EpiZGate E{(unsigned char*)ZG, INP(I_BGATE) + (size_t)l * 3 * D, 1.0f / (SC_XG * SC_WGU)};
                pg8::gemm_phase<pg8::EpiZGate, pg8::StaticOrder, PG8_ALIGN, PG8_SP2>(F.lds + RING_OFF, g, S, E, F.wv);
            }
#else
            pg8::Gemm g{HX, W_IN + (size_t)l * INC * D, TA, INC, D}; pg8::StaticOrder S; S.init(TA, INC, F.G, (int)blockIdx.x, MK_WGM);
            pg8::EpiZ E{ZM, ZG, ROPE, TL / 256, INP(I_BGATE) + (size_t)l * 3 * D, 0, 1.0f};
            pg8::gemm_phase<pg8::EpiZ, pg8::StaticOrder, PG8_ALIGN, PG8_SP2>(F.lds + RING_OFF, g, S, E, F.wv);
#endif
            GRID_BAR();
        }
        if (IN(pb + 3)) {
            PHASE_ENTER();
            const float* sinkp = INP(I_SINK) + l * 8; const float* rpbp = INP(I_RPB) + (size_t)l * 8 * 15 * 31;
            const float* cw = INP(I_CONVW) + (size_t)l * 3 * BW;
            {
                const int ch = 8 * lane;
                float cwr[3][8];
#pragma unroll
                for (int k = 0; k < 3; ++k) { const f32x4 a = *(const f32x4*)(cw + k * BW + ch), b = *(const f32x4*)(cw + k * BW + ch + 4); cwr[k][0] = a.x; cwr[k][1] = a.y; cwr[k][2] = a.z; cwr[k][3] = a.w; cwr[k][4] = b.x; cwr[k][5] = b.y; cwr[k][6] = b.z; cwr[k][7] = b.w; }
#define CONV_U(row, u) do { const bf16* zp_ = ZM + (size_t)(row) * ZMC; const v4u a_ = *(const v4u*)(zp_ + C_UX + ch), g_ = *(const v4u*)(zp_ + C_GC + ch); \
                    u[0] = bflo(a_.x) * bflo(g_.x); u[1] = bfhi(a_.x) * bfhi(g_.x); u[2] = bflo(a_.y) * bflo(g_.y); u[3] = bfhi(a_.y) * bfhi(g_.y); \
                    u[4] = bflo(a_.z) * bflo(g_.z); u[5] = bfhi(a_.z) * bfhi(g_.z); u[6] = bflo(a_.w) * bflo(g_.w); u[7] = bfhi(a_.w) * bfhi(g_.w); } while (0)
#define CONV_Z(u) do { _Pragma("unroll") for (int q_ = 0; q_ < 8; ++q_) u[q_] = 0.f; } while (0)
#define CONV_OUT(t) do { const v4u gbv = *(const v4u*)(ZM + (size_t)(t) * ZMC + C_GB + ch); \
                    const float gb[8] = {bflo(gbv.x), bfhi(gbv.x), bflo(gbv.y), bfhi(gbv.y), bflo(gbv.z), bfhi(gbv.z), bflo(gbv.w), bfhi(gbv.w)}; float o[8]; \
                    _Pragma("unroll") for (int q = 0; q < 8; ++q) o[q] = gb[q] * (cwr[0][q] * um[q] + cwr[1][q] * uc[q] + cwr[2][q] * up[q]); \
                    v4u w; w.x = pk2(o[0], o[1]); w.y = pk2(o[2], o[3]); w.z = pk2(o[4], o[5]); w.w = pk2(o[6], o[7]); \
                    *(v4u*)(OB + (size_t)(t) * BW + ch) = w; } while (0)
                const int cchunk = (TL + NGW - 1) / NGW;
                const int t0 = min(gw * cchunk, TL), t1 = min(TL, t0 + cchunk);
                if (t0 < t1) {
                    float um[8], uc[8], up[8];
                    if ((t0 & (SEQ - 1)) > 0) CONV_U(t0 - 1, um); else CONV_Z(um);
                    CONV_U(t0, uc);
                    for (int t = t0; t < t1; ++t) {
                        const int s = t & (SEQ - 1);
                        if (s == 0) CONV_Z(um);
                        if (s + 1 < SEQ) CONV_U(t + 1, up); else CONV_Z(up);
                        CONV_OUT(t);
#pragma unroll
                        for (int q = 0; q < 8; ++q) { um[q] = uc[q]; uc[q] = up[q]; }
                    }
                }
                for (int t = TL + gw; t < rows_out; t += NGW) {
                    const int s = (t - TL) & (CTXL - 1);
                    float um[8], uc[8], up[8];
                    if (s > 0) CONV_U(t - 1, um); else CONV_Z(um);
                    CONV_U(t, uc);
                    if (s + 1 < CTXL) CONV_U(t + 1, up); else CONV_Z(up);
                    CONV_OUT(t);
                }
#undef CONV_U
#undef CONV_Z
#undef CONV_OUT
            }
            at::attn_phase(F.lds + RING_OFF, ZM, OA, OC, sinkp, rpbp, F.vcu, F.G, ctx_out, tid_, wave, lane);
#ifdef MK_ATTN_PROBE
            at::attn_phase<MK_ATTN_PROBE>(F.lds + RING_OFF, ZM, (bf16*)(GAS bf16*)(ws + WS_HX), (bf16*)(GAS bf16*)(ws + WS_HX) + (size_t)TA * BW, sinkp, rpbp, F.vcu, F.G, ctx_out, tid_, wave, lane);
#endif
            GRID_BAR();
        }
        if (IN(pb + 4)) {
            PHASE_ENTER();
            pg8::Gemm g{OA, W_BR + (size_t)l * 3 * D * BW, rows_out, D, BW};
            pg8::BranchOrder3 S; S.so.init(rows_out, D, F.G, (int)blockIdx.x, MK_WGM);
            pg8::EpiBranchAcc E{HX, ZG};
            pg8::gemm_phase<pg8::EpiBranchAcc, pg8::BranchOrder3, PG8_ALIGN, PG8_SP2>(F.lds + RING_OFF, g, S, E, F.wv);
            GRID_BAR();
        }
        if (IN(pb + 5)) {
            PHASE_ENTER();
            pg8::Gemm g{HX, W_OUT + (size_t)l * D * D, rows_out, D, D}; pg8::StaticOrder S; S.init(rows_out, D, F.G, (int)blockIdx.x, MK_WGM);
            pg8::EpiBf16P E{Y16, D};
            pg8::gemm_phase<pg8::EpiBf16P, pg8::StaticOrder, PG8_ALIGN, PG8_SP2>(F.lds + RING_OFF, g, S, E, F.wv);
            GRID_BAR();
        }
        if (IN(pb + 6)) {
            PHASE_ENTER();
            if (!moe) {
                const int chunk = (TL + NGW - 1) / NGW;
#define P6_ROW(t) do { f32x4 x[4], y[4], h[4]; \
                    if (l == 0) row_load((t) < TL ? INP(I_X) + (size_t)(t) * D : INP(I_CTX) + (size_t)((t) - TL) * D, lane, x); else row_load_bf16(RS + (size_t)(t) * D, lane, x); \
                    row_load_bf16(Y16 + (size_t)(t) * D, lane, y); const float ry = row_rrms(y); \
                    _Pragma("unroll") for (int j = 0; j < 4; ++j) x[j] = x[j] + gt[j] * (y[j] * ry * gpo[j]); \
                    row_store_bf16(RS + (size_t)(t) * D, lane, x); const float rx = row_rrms(x); row_normmod(x, rx, gpre, sh, sc, h); \
                    if (MK_DENSE_F8 >= 2) row_store_fp8((unsigned char*)HX + (size_t)(t) * D, lane, h, SC_XG); else row_store_bf16(HX + (size_t)(t) * D, lane, h); } while (0)
                f32x4 gpo[4], gt[4], gpre[4], sh[4], sc[4]; vec_load(INP(I_GPOSTMIX) + l * D, lane, gpo); vec_load(INP(I_GPREFFN) + l * D, lane, gpre);
                for (int t0 = min(gw * chunk, TL), t1 = min(TL, t0 + chunk); t0 < t1; ) { const int bb = t0 >> 13, te = min(t1, (bb + 1) << 13); const float* md = modl + (size_t)bb * 6144;
                    vec_load(md + 2048, lane, gt); vec_load(md + 3072, lane, sh); vec_load(md + 4096, lane, sc);
                    for (int t = t0; t < te; ++t) P6_ROW(t);
                    t0 = te; }
                if (rows_out > TL) { const float* md = modl + (size_t)4 * 6144; vec_load(md + 2048, lane, gt); vec_load(md + 3072, lane, sh); vec_load(md + 4096, lane, sc); for (int t = TL + gw; t < rows_out; t += NGW) P6_ROW(t); }
#undef P6_ROW
            } else {
                LAS int* sel = (LAS int*)(F.lds + RING_OFF);
                LAS int* rnk = sel + 256;
                LAS f32x4* wrT = (LAS f32x4*)(F.lds + RING_OFF + 4096);
                const float* wr = INP(I_WROUTER) + (size_t)(l >> 1) * D * NE; const float* br = INP(I_BROUTER) + (l >> 1) * NE;
                for (int u = tid_; u < D * NE; u += NWAVES * 64) ((LAS float*)wrT)[(u & 7) * D + (u >> 3)] = wr[u];
                LDS_WAIT(); __syncthreads();
                f32x4 gpo[4], gt[4], gpre[4], sh[4], sc[4]; vec_load(INP(I_GPOSTMIX) + l * D, lane, gpo); vec_load(INP(I_GPREFFN) + l * D, lane, gpre);
                for (int slab = F.vcu; slab < TL / 128; slab += F.G) {
                    { const float* md = modl + (size_t)((slab * 128) >> 13) * 6144; vec_load(md + 2048, lane, gt); vec_load(md + 3072, lane, sh); vec_load(md + 4096, lane, sc); }
                    for (int i = 0; i < 16; ++i) {
                        const int tl_ = wave * 16 + i, t = slab * 128 + tl_;
                        f32x4 x[4], y[4], h[4]; if (l == 0) row_load(INP(I_X) + (size_t)t * D, lane, x); else row_load_bf16(RS + (size_t)t * D, lane, x);
                        row_load_bf16(Y16 + (size_t)t * D, lane, y);
                        const float ry = row_rrms(y);
#pragma unroll
                        for (int j = 0; j < 4; ++j) x[j] = x[j] + gt[j] * (y[j] * ry * gpo[j]);
                        row_store_bf16(RS + (size_t)t * D, lane, x);
                        const float rx = row_rrms(x);
                        row_normmod(x, rx, gpre, sh, sc, h);
                        row_store_fp8((unsigned char*)HX + (size_t)t * D, lane, h, SC_XG);
                        float lg[8];
#pragma unroll
                        for (int e = 0; e < 8; ++e) lg[e] = 0.f;
#pragma unroll
                        for (int e = 0; e < 8; ++e)
#pragma unroll
                            for (int j = 0; j < 4; ++j) { const f32x4 w4 = wrT[e * (D / 4) + 2 * (64 * (j >> 1) + lane) + (j & 1)]; lg[e] += (h[j].x * w4.x + h[j].y * w4.y) + (h[j].z * w4.z + h[j].w * w4.w); }
#pragma unroll
                        for (int e = 0; e < 8; ++e) lg[e] = wave_sum(lg[e]) + br[e];
                        int e1 = 0; float v1 = lg[0];
#pragma unroll
                        for (int e = 1; e < 8; ++e) if (lg[e] > v1) { v1 = lg[e]; e1 = e; }
                        int e2 = -1; float v2 = -INFINITY;
#pragma unroll
                        for (int e = 0; e < 8; ++e) if (e != e1 && lg[e] > v2) { v2 = lg[e]; e2 = e; }
                        const float ex = __expf(v2 - v1), g1 = 1.0f / (1.0f + ex), g2 = ex / (1.0f + ex);
                        if (lane == 0) { sel[2 * tl_] = e1; sel[2 * tl_ + 1] = e2; TOKG[2 * (size_t)t] = g1; TOKG[2 * (size_t)t + 1] = g2; }
                    }
                    LDS_WAIT(); __syncthreads();
                    if (tid_ < 8) { int cnt = 0; for (int q = 0; q < 256; ++q) if (sel[q] == tid_) { rnk[q] = cnt; ++cnt; } SLABCNT[slab * 8 + tid_] = cnt; }
                    LDS_WAIT(); __syncthreads();
                    if (tid_ < 256) TOKER[(size_t)slab * 256 + tid_] = sel[tid_] | (rnk[tid_] << 8);
                    LDS_WAIT(); __syncthreads();
                }
            }
            GRID_BAR();
        }
        if (IN(pb + 7) && moe) {
            PHASE_ENTER();
            LAS int* scn = (LAS int*)(F.lds + RING_OFF);
            LAS int* pst = scn + 2048;
            for (int u = tid_; u < 2048; u += NWAVES * 64) scn[u] = SLABCNT[u];
            LDS_WAIT(); __syncthreads();
            if (tid_ < 8) { int run = 0; for (int q = 0; q < 256; ++q) { const int c = scn[q * 8 + tid_]; scn[q * 8 + tid_] = run; run += c; } pst[8 + tid_] = run; }
            LDS_WAIT(); __syncthreads();
            if (tid_ == 0) { int pan = 0; for (int e = 0; e < 8; ++e) { pst[e] = pan * 256; if (blockIdx.x == 0) PCUM[e] = pan; pan += (pst[8 + e] + 255) >> 8; } if (blockIdx.x == 0) PCUM[8] = pan; }
            LDS_WAIT(); __syncthreads();
            LAS int* posl = pst + 16;
            for (int slab = F.vcu; slab < TL / 128; slab += F.G) {
                if (tid_ < 256) { const int er = TOKER[(size_t)slab * 256 + tid_]; const int e = er & 255, rk = er >> 8; const int pos = pst[e] + scn[slab * 8 + e] + rk;
                    posl[tid_] = pos; TOKPOS[(size_t)slab * 256 + tid_] = pos; }
                LDS_WAIT(); __syncthreads();
                const v4u* srcb = (const v4u*)((const unsigned char*)HX + (size_t)slab * 128 * D);
#pragma unroll 4
                for (int i = 0; i < 16; ++i) { const int id = i * 512 + tid_, tk = id >> 6, chk = id & 63;
                    const v4u o = srcb[(size_t)tk * 64 + chk];
                    ((v4u*)(XG8 + (size_t)posl[2 * tk] * D))[chk] = o; ((v4u*)(XG8 + (size_t)posl[2 * tk + 1] * D))[chk] = o; }
                LDS_WAIT(); __syncthreads();
            }
            GRID_BAR();
        }
        if (IN(pb + 8) && !moe) {
            PHASE_ENTER();
            pg8::Gemm g{HX, W_GUD, rows_out, 2 * FFD, D}; pg8::StaticOrder S; S.init(rows_out, 2 * FFD, F.G, (int)blockIdx.x, MK_WGM);
#if MK_DENSE_F8 >= 2
            pg8::EpiSwiglu8T<true> E{(unsigned char*)HD, FFD, 1.0f / (SC_XG * SC_WGU), SC_H};
            pg8::gemm_phase<pg8::EpiSwiglu8T<true>, pg8::StaticOrder, PG8_ALIGN, PG8_SP2>(F.lds + RING_OFF, g, S, E, F.wv);
#elif MK_DENSE_F8 == 1
            pg8::EpiSwiglu8T<false> E{(unsigned char*)HD, FFD, 1.0f, SC_H};
            pg8::gemm_phase<pg8::EpiSwiglu8T<false>, pg8::StaticOrder, PG8_ALIGN, PG8_SP2>(F.lds + RING_OFF, g, S, E, F.wv);
#else
            pg8::EpiSwiglu E{HD, FFD};
            pg8::gemm_phase<pg8::EpiSwiglu, pg8::StaticOrder, PG8_ALIGN, PG8_SP2>(F.lds + RING_OFF, g, S, E, F.wv);
#endif
            GRID_BAR();
        }
        if (IN(pb + 9) && !moe) {
            PHASE_ENTER();
            pg8::Gemm g{HD, W_DND, rows_out, D, FFD}; pg8::StaticOrder S; S.init(rows_out, D, F.G, (int)blockIdx.x, MK_WGM);
#if MK_DENSE_F8 >= 1
            pg8::EpiBf16PS8 E{Y16, D, 1.0f / (SC_H * SC_WDN)};
            pg8::gemm_phase<pg8::EpiBf16PS8, pg8::StaticOrder, PG8_ALIGN, PG8_SP2>(F.lds + RING_OFF, g, S, E, F.wv);
#else
            pg8::EpiBf16P E{Y16, D};
            pg8::gemm_phase<pg8::EpiBf16P, pg8::StaticOrder, PG8_ALIGN, PG8_SP2>(F.lds + RING_OFF, g, S, E, F.wv);
#endif
            GRID_BAR();
        }
        if (moe) {
            for (int ck = 0; ck < NCHUNK; ++ck) {
                if (IN(pb + 10 + 2 * ck)) {
                    PHASE_ENTER();
                    pg8::MoeOrder S; S.nN = 2 * FFE / 256; S.G = F.G; S.c = F.vcu; S.p_lo = ck * PCH;
#pragma unroll
                    for (int k = 0; k < 8; ++k) S.pc[k] = __builtin_amdgcn_readfirstlane(PCUM[k]);
                    const int ptot = __builtin_amdgcn_readfirstlane(PCUM[8]); S.np = min(max(ptot - ck * PCH, 0), PCH);
                    pg8::Gemm g{(const bf16*)XG8, (const bf16*)W_GUM8, 0, 2 * FFE, D};
                    pg8::EpiSwiglu8 E{HM8, FFE, 1.0f / (SC_XG * SC_WGU), SC_H};
                    pg8::gemm_phase<pg8::EpiSwiglu8, pg8::MoeOrder, PG8_ALIGN, PG8_SP2>(F.lds + RING_OFF, g, S, E, F.wv);
                    GRID_BAR();
                }
                if (IN(pb + 11 + 2 * ck)) {
                    PHASE_ENTER();
                    pg8::MoeOrder S; S.nN = D / 256; S.G = F.G; S.c = F.vcu; S.p_lo = ck * PCH;
#pragma unroll
                    for (int k = 0; k < 8; ++k) S.pc[k] = __builtin_amdgcn_readfirstlane(PCUM[k]);
                    const int ptot = __builtin_amdgcn_readfirstlane(PCUM[8]); S.np = min(max(ptot - ck * PCH, 0), PCH);
                    pg8::Gemm g{(const bf16*)HM8, (const bf16*)W_DNM8, 0, D, FFE};
                    pg8::EpiBf16PS8 E{XG, D, 1.0f / (SC_H * SC_WDN)};
                    pg8::gemm_phase<pg8::EpiBf16PS8, pg8::MoeOrder, PG8_ALIGN, PG8_SP2>(F.lds + RING_OFF, g, S, E, F.wv);
                    GRID_BAR();
                }
            }
        }
        if (IN(pb + 16)) {
            PHASE_ENTER();
            const int chunk = (TL + NGW - 1) / NGW; const bool nextl = (l + 1 < DEPTH);
#define P9_ROW(t) do { f32x4 x[4], y[4]; row_load_bf16(RS + (size_t)(t) * D, lane, x); \
                if (!moe) row_load_bf16(Y16 + (size_t)(t) * D, lane, y); \
                else { const int p0 = TOKPOS[2 * (size_t)(t)], p1 = TOKPOS[2 * (size_t)(t) + 1]; const float g0 = TOKG[2 * (size_t)(t)], g1 = TOKG[2 * (size_t)(t) + 1]; \
                    f32x4 ya[4], yb[4]; row_load_bf16(XG + (size_t)p0 * D, lane, ya); row_load_bf16(XG + (size_t)p1 * D, lane, yb); \
                    _Pragma("unroll") for (int j = 0; j < 4; ++j) y[j] = ya[j] * g0 + yb[j] * g1; } \
                const float ry = row_rrms(y); \
                _Pragma("unroll") for (int j = 0; j < 4; ++j) x[j] = x[j] + gt[j] * (y[j] * ry * gpo[j]); \
                if (nextl) row_store_bf16(RS + (size_t)(t) * D, lane, x); else if ((t) < TL) row_store(outp + (size_t)(t) * D, lane, x); \
                if (nextl) { f32x4 h[4]; const float rx = row_rrms(x); row_normmod(x, rx, gpre, sh, sc, h); if (MK_GATE_F8 < 2) row_store_bf16(HX + (size_t)(t) * D, lane, h); if (MK_GATE_F8) row_store_fp8(HX8 + (size_t)(t) * D, lane, h, SC_XG); } } while (0)
            f32x4 gpo[4], gt[4], gpre[4], sh[4], sc[4]; vec_load(INP(I_GPOSTFFN) + l * D, lane, gpo); vec_load(INP(I_GPREMIX) + (nextl ? l + 1 : l) * D, lane, gpre);
            for (int t0 = min(gw * chunk, TL), t1 = min(TL, t0 + chunk); t0 < t1; ) { const int bb = t0 >> 13, te = min(t1, (bb + 1) << 13); const float* md = modl + (size_t)bb * 6144;
                vec_load(md + 5120, lane, gt); vec_load(md + (nextl ? 5 * 6144 : 0), lane, sh); vec_load(md + (nextl ? 5 * 6144 : 0) + 1024, lane, sc);
                for (int t = t0; t < te; ++t) P9_ROW(t);
                t0 = te; }
            if (rows_out > TL) { const float* md = modl + (size_t)4 * 6144; vec_load(md + 5120, lane, gt); vec_load(md + (nextl ? 5 * 6144 : 0), lane, sh); vec_load(md + (nextl ? 5 * 6144 : 0) + 1024, lane, sc);
                for (int t = TL + gw; t < rows_out; t += NGW) P9_ROW(t); }
#undef P9_ROW
            if (l + 1 < DEPTH) GRID_BAR();
        }
    }
#undef IN
#undef GRID_BAR
}

extern "C" void kernel_launch(void* const* d_in, const int* in_sizes, int n_in, void* d_out, int out_size, void* d_ws, size_t ws_size, hipStream_t stream) {
    static int grid = 0;
    if (grid == 0) {
        if (n_in != 23 || in_sizes[0] != TL * D || out_size != TL * D || ws_size < WS_END) { fprintf(stderr, "kernel_launch: unexpected shapes: n_in %d in0 %d out %d ws %zu (need %zu); nothing launched\n", n_in, n_in > 0 ? in_sizes[0] : -1, out_size, ws_size, (size_t)WS_END); grid = -1; return; }
        int dev = 0, cus = 0, per_cu = 0;
        if (hipGetDevice(&dev) != hipSuccess || hipDeviceGetAttribute(&cus, hipDeviceAttributeMultiprocessorCount, dev) != hipSuccess) { fprintf(stderr, "kernel_launch: device query failed\n"); grid = -1; return; }
        if (hipFuncSetAttribute((const void*)mk_fwd, hipFuncAttributeMaxDynamicSharedMemorySize, LDS_BYTES) != hipSuccess) { fprintf(stderr, "kernel_launch: hipFuncSetAttribute failed\n"); grid = -1; return; }
        if (hipOccupancyMaxActiveBlocksPerMultiprocessor(&per_cu, (const void*)mk_fwd, NWAVES * 64, LDS_BYTES) != hipSuccess || per_cu < 1) fprintf(stderr, "kernel_launch: note: occupancy query reports %d\n", per_cu);
        (void)hipGetLastError();
        grid = cus;
    }
    if (grid < 0) return;
    if (hipMemsetAsync((char*)d_ws + WS_CTL, 0, CTL_ZERO_BYTES, stream) != hipSuccess) { fprintf(stderr, "kernel_launch: memset failed\n"); return; }
    Args a{};
    for (int i = 0; i < 23; ++i) a.in[i] = (const float*)d_in[i];
    a.out = (float*)d_out; a.ws = (unsigned char*)d_ws;
#if MK_PER_PHASE
    for (int ph = 0; ph < NPHASES; ++ph) { a.ph_lo = ph; a.ph_hi = ph + 1; hipLaunchKernelGGL(mk_fwd, dim3(grid), dim3(NWAVES * 64), LDS_BYTES, stream, a); }
#else
    a.ph_lo = 0; a.ph_hi = NPHASES;
    hipLaunchKernelGGL(mk_fwd, dim3(grid), dim3(NWAVES * 64), LDS_BYTES, stream, a);
#endif
    const hipError_t le = hipPeekAtLastError();
    if (le != hipSuccess) fprintf(stderr, "kernel_launch: launch failed: %s\n", hipGetErrorName(le));
}
```

```cpp
#include <hip/hip_runtime.h>
#include <cstdio>
#include <cstdint>
#ifndef MK_GATE_U8
#define MK_GATE_U8 1
#endif
#ifndef MK_GATE_F8
#define MK_GATE_F8 1
#endif

__device__ __forceinline__ int mk_lane() { unsigned z; asm volatile("s_mov_b32 %0, 0" : "=s"(z)); return (int)__builtin_amdgcn_mbcnt_hi(~0u, __builtin_amdgcn_mbcnt_lo(~0u, z)); }
template <int CTRL, int ROWMASK = 0xf> __device__ __forceinline__ float mk_dpp(float v) { return __builtin_bit_cast(float, __builtin_amdgcn_update_dpp(0, __builtin_bit_cast(int, v), CTRL, ROWMASK, 0xf, false)); }
__device__ __forceinline__ float mk_xor32(float v, bool upper) { const auto rr = __builtin_amdgcn_permlane32_swap(__builtin_bit_cast(unsigned, v), __builtin_bit_cast(unsigned, v), false, false); return __builtin_bit_cast(float, upper ? rr[0] : rr[1]); }
__device__ __forceinline__ int mk_xor16(int v) { return __builtin_amdgcn_ds_swizzle(v, 0x401F); }

namespace pg8 {
#define PG8_LAS __attribute__((address_space(3)))
typedef unsigned short bf16_t;
typedef short bf16x8 __attribute__((ext_vector_type(8)));
typedef float f32x4 __attribute__((ext_vector_type(4)));
typedef unsigned u32x4 __attribute__((ext_vector_type(4)));
typedef unsigned u32x2 __attribute__((ext_vector_type(2)));
typedef int v8i32 __attribute__((ext_vector_type(8)));
constexpr int BM = 256, BK = 64, HALF = 128, HTB = HALF * BK * 2  , STAGE_BYTES = 8 * HTB, NXCD = 8, WGM = 8;

__host__ __device__ __forceinline__ int lds_byte(int r, int c) { const int st = (r >> 4) * 2 + (c >> 5), rr = r & 15, cc = c & 31, ob = rr * 64 + cc * 2; return st * 1024 + (ob ^ (((ob >> 9) & 1) << 5)); }
__host__ __device__ __forceinline__ void stage_rc(int b, int& R, int& C) { const int st = b / 1024, sb = b % 1024, swz = sb ^ (((sb >> 9) & 1) << 5); R = (st >> 1) * 16 + swz / 64; C = (st & 1) * 32 + (swz % 64) / 2; }
__host__ __device__ __forceinline__ int perm32(int rho) { const int n = rho >> 4, i = rho & 15; return 8 * (i >> 2) + 4 * n + (i & 3); }

struct Unit { int pm, pn, pb; };
struct Gemm { const bf16_t* A; const bf16_t* Bt; int M, N, K; };

struct StaticOrder {
    int nM, nN, nwg, G, c, wgm;
    __host__ __device__ void init(int M, int N, int G_, int c_, int wgm_ = WGM) { nM = M / BM; nN = N / BM; nwg = nM * nN; G = G_; c = c_; wgm = wgm_; }
    __host__ __device__ bool next(int i, Unit& u) const {
        const long L = (long)i * G + c; if (L >= nwg) return false;
        int wgid = (int)L; { const int q = nwg / NXCD, r = nwg % NXCD, xcd = wgid % NXCD, off = wgid / NXCD; wgid = (xcd < r ? xcd * (q + 1) : r * (q + 1) + (xcd - r) * q) + off; }
        const int nig = wgm * nN, gid = wgid / nig, fm = gid * wgm, gsz = (nM - fm) < wgm ? (nM - fm) : wgm;
        u.pm = fm + ((wgid % nig) % gsz); u.pn = (wgid % nig) / gsz; u.pb = u.pn; return true;
    }
    __device__ __forceinline__ void a_ready(const Unit&) const {}
    __device__ __forceinline__ void done(const Unit&) const {}
};

__device__ __forceinline__ unsigned cvt_pk_bf16(float lo, float hi) { unsigned r; asm volatile("v_cvt_pk_bf16_f32 %0, %1, %2" : "=v"(r) : "v"(lo), "v"(hi)); return r; }
__device__ __forceinline__ float bf_lo(unsigned w) { return __uint_as_float(w << 16); }
__device__ __forceinline__ float bf_hi(unsigned w) { return __uint_as_float(w & 0xffff0000u); }
__device__ __forceinline__ float sigmoidf_(float x) { return __builtin_amdgcn_rcpf(1.0f + __builtin_amdgcn_exp2f(x * -1.4426950408889634f)); }

template <bool OPF8> struct EpiZT {
    static constexpr bool PERM = true, AFTER_DRAIN = false, HALFN = false, F8 = OPF8, RWACC = false;
    bf16_t* ZM; bf16_t* ZG; const float* rope; int n_lat_panels; const float* bgate; int pn_off; float gs;
    __device__ __forceinline__ void operator()(const f32x4 (&acc)[2][2][4][2], const Unit& u, int wr, int wc, int fr, int fq) const {
        const int row0 = u.pm * BM + wr * 64 + fr; int colt = (u.pn + pn_off) * BM; bf16_t* base = ZM; int ldc = 3840; bool isg = false;
        if (colt >= 3840) { base = ZG; colt -= 3840; ldc = 3072; isg = true; }
        const int col0 = colt + wc * 32 + 8 * fq;
        f32x4 gb[2][2];
        if (isg) {
#pragma unroll
            for (int bj = 0; bj < 2; ++bj) { gb[bj][0] = *(const f32x4*)(bgate + col0 + bj * HALF); gb[bj][1] = *(const f32x4*)(bgate + col0 + bj * HALF + 4); } }
        const int nrope = (u.pm < n_lat_panels) ? (u.pn + pn_off < 2 ? 2 : (u.pn + pn_off == 2 ? 1 : 0)) : 0;
#pragma unroll
        for (int ai = 0; ai < 2; ++ai)
#pragma unroll
            for (int m = 0; m < 4; ++m) { const int row = row0 + ai * HALF + m * 16; bf16_t* rowp = base + (size_t)row * ldc + col0;
                f32x4 cs[4];
                if (nrope) { const int s = row & 8191, pidx = (wc & 1) ? 128 + (s & 63) : (s >> 6); const f32x4* cp = (const f32x4*)(rope + (size_t)(pidx * 16 + 8 * (fq & 1)) * 2);
                    cs[0] = cp[0]; cs[1] = cp[1]; cs[2] = cp[2]; cs[3] = cp[3]; }
#pragma unroll
                for (int bj = 0; bj < 2; ++bj) { f32x4 v0 = acc[ai][bj][m][0], v1 = acc[ai][bj][m][1];
                    if (OPF8 && !isg) { v0 *= gs; v1 *= gs; }
                    if (isg) {
#pragma unroll
                        for (int j = 0; j < 4; ++j) { v0[j] = sigmoidf_(fminf(fmaxf(v0[j] * gs + gb[bj][0][j], -30.f), 30.f)); v1[j] = sigmoidf_(fminf(fmaxf(v1[j] * gs + gb[bj][1][j], -30.f), 30.f)); } }
                    if (bj < nrope) { const float sg = (fq >> 1) ? 1.f : -1.f;
                        float v[8] = {v0[0], v0[1], v0[2], v0[3], v1[0], v1[1], v1[2], v1[3]}, o[8];
#pragma unroll
                        for (int j = 0; j < 8; ++j) { const float pv = mk_xor32(v[j], (fq >> 1) != 0); const float c_ = cs[j >> 1][(j & 1) * 2], s_ = cs[j >> 1][(j & 1) * 2 + 1]; o[j] = v[j] * c_ + sg * pv * s_; }
                        v0 = (f32x4){o[0], o[1], o[2], o[3]}; v1 = (f32x4){o[4], o[5], o[6], o[7]}; }
                    if (MK_GATE_U8 && isg) {
                        unsigned b0 = 0u, b1 = 0u;
#pragma unroll
                        for (int j = 0; j < 4; ++j) { b0 = __builtin_amdgcn_cvt_pk_u8_f32(fmaxf(v0[j] * 255.f, 1.f), j, b0); b1 = __builtin_amdgcn_cvt_pk_u8_f32(fmaxf(v1[j] * 255.f, 1.f), j, b1); }
                        u32x2 w8; w8.x = b0; w8.y = b1;
                        *(u32x2*)((unsigned char*)ZG + (size_t)row * 3072 + col0 + bj * HALF) = w8;
                        continue; }
                    u32x4 w; w.x = cvt_pk_bf16(v0[0], v0[1]); w.y = cvt_pk_bf16(v0[2], v0[3]); w.z = cvt_pk_bf16(v1[0], v1[1]); w.w = cvt_pk_bf16(v1[2], v1[3]);
                    *(u32x4*)(rowp + bj * HALF) = w; } }
    }
};
typedef EpiZT<false> EpiZ;

struct EpiZM {
    static constexpr bool PERM = true, AFTER_DRAIN = false, HALFN = false, F8 = false, RWACC = false;
    bf16_t* ZM; const PG8_LAS float* rope; int n_lat_panels;
    __device__ __forceinline__ void operator()(const f32x4 (&acc)[2][2][4][2], const Unit& u, int wr, int wc, int fr, int fq) const {
        const int row0 = u.pm * BM + wr * 64 + fr; const int col0 = u.pn * BM + wc * 32 + 8 * fq;
        const int nrope = (u.pm < n_lat_panels) ? (u.pn < 2 ? 2 : (u.pn == 2 ? 1 : 0)) : 0;
#pragma unroll
        for (int ai = 0; ai < 2; ++ai)
#pragma unroll
            for (int m = 0; m < 4; ++m) { const int row = row0 + ai * HALF + m * 16; bf16_t* rowp = ZM + (size_t)row * 3840 + col0;
                f32x4 cs[4];
                if (nrope) { const int s = row & 8191, pidx = (wc & 1) ? 128 + (s & 63) : (s >> 6); const PG8_LAS f32x4* cp = (const PG8_LAS f32x4*)(rope + (pidx * 16 + 8 * (fq & 1)) * 2);
                    cs[0] = cp[0]; cs[1] = cp[1]; cs[2] = cp[2]; cs[3] = cp[3]; }
#pragma unroll
                for (int bj = 0; bj < 2; ++bj) { f32x4 v0 = acc[ai][bj][m][0], v1 = acc[ai][bj][m][1];
                    if (bj < nrope) { const float sg = (fq >> 1) ? 1.f : -1.f;
                        float v[8] = {v0[0], v0[1], v0[2], v0[3], v1[0], v1[1], v1[2], v1[3]}, o[8];
#pragma unroll
                        for (int j = 0; j < 8; ++j) { const float pv = mk_xor32(v[j], (fq >> 1) != 0); const float c_ = cs[j >> 1][(j & 1) * 2], s_ = cs[j >> 1][(j & 1) * 2 + 1]; o[j] = v[j] * c_ + sg * pv * s_; }
                        v0 = (f32x4){o[0], o[1], o[2], o[3]}; v1 = (f32x4){o[4], o[5], o[6], o[7]}; }
                    u32x4 w; w.x = cvt_pk_bf16(v0[0], v0[1]); w.y = cvt_pk_bf16(v0[2], v0[3]); w.z = cvt_pk_bf16(v1[0], v1[1]); w.w = cvt_pk_bf16(v1[2], v1[3]);
                    *(u32x4*)(rowp + bj * HALF) = w; } }
    }
};
struct EpiZGate {
    static constexpr bool PERM = true, AFTER_DRAIN = false, HALFN = false, F8 = true, RWACC = false;
    unsigned char* ZG; const float* bgate; float gs;
    __device__ __forceinline__ void operator()(const f32x4 (&acc)[2][2][4][2], const Unit& u, int wr, int wc, int fr, int fq) const {
        const int row0 = u.pm * BM + wr * 64 + fr; const int colb = u.pn * BM + wc * 32; const int odd = fq & 1;
        f32x4 gb[2][2];
#pragma unroll
        for (int bj = 0; bj < 2; ++bj) { gb[bj][0] = *(const f32x4*)(bgate + colb + 8 * fq + bj * HALF); gb[bj][1] = *(const f32x4*)(bgate + colb + 8 * fq + bj * HALF + 4); }
#pragma unroll
        for (int ai = 0; ai < 2; ++ai)
#pragma unroll
            for (int mp = 0; mp < 2; ++mp)
#pragma unroll
                for (int bj = 0; bj < 2; ++bj) {
                    unsigned w[2][2];
#pragma unroll
                    for (int k = 0; k < 2; ++k) { const int m = 2 * mp + k; const f32x4 v0 = acc[ai][bj][m][0], v1 = acc[ai][bj][m][1]; unsigned b0 = 0u, b1 = 0u;
#pragma unroll
                        for (int j = 0; j < 4; ++j) { const float g0 = sigmoidf_(fminf(fmaxf(v0[j] * gs + gb[bj][0][j], -30.f), 30.f)), g1 = sigmoidf_(fminf(fmaxf(v1[j] * gs + gb[bj][1][j], -30.f), 30.f));
                            b0 = __builtin_amdgcn_cvt_pk_u8_f32(fmaxf(g0 * 255.f, 1.f), j, b0); b1 = __builtin_amdgcn_cvt_pk_u8_f32(fmaxf(g1 * 255.f, 1.f), j, b1); }
                        w[k][0] = b0; w[k][1] = b1; }
                    const unsigned s0 = odd ? w[0][0] : w[1][0], s1 = odd ? w[0][1] : w[1][1];
                    const unsigned r0 = (unsigned)mk_xor16((int)s0), r1 = (unsigned)mk_xor16((int)s1);
                    u32x4 st; if (odd) { st.x = r0; st.y = r1; st.z = w[1][0]; st.w = w[1][1]; } else { st.x = w[0][0]; st.y = w[0][1]; st.z = r0; st.w = r1; }
                    *(u32x4*)(ZG + (size_t)(row0 + ai * HALF + (2 * mp + odd) * 16) * 3072 + colb + 8 * (fq & 2) + bj * HALF) = st; }
    }
};
struct EpiBf16P {
    static constexpr bool PERM = true, AFTER_DRAIN = false, HALFN = false, F8 = false, RWACC = false;
    bf16_t* O; int ldc;
    __device__ __forceinline__ void operator()(const f32x4 (&acc)[2][2][4][2], const Unit& u, int wr, int wc, int fr, int fq) const {
        const int row0 = u.pm * BM + wr * 64 + fr; const int col0 = u.pn * BM + wc * 32 + 8 * fq;
#pragma unroll
        for (int ai = 0; ai < 2; ++ai)
#pragma unroll
            for (int m = 0; m < 4; ++m) { bf16_t* rowp = O + (size_t)(row0 + ai * HALF + m * 16) * ldc + col0;
#pragma unroll
                for (int bj = 0; bj < 2; ++bj) { const f32x4 v0 = acc[ai][bj][m][0], v1 = acc[ai][bj][m][1];
                    u32x4 w; w.x = cvt_pk_bf16(v0[0], v0[1]); w.y = cvt_pk_bf16(v0[2], v0[3]); w.z = cvt_pk_bf16(v1[0], v1[1]); w.w = cvt_pk_bf16(v1[2], v1[3]);
                    *(u32x4*)(rowp + bj * HALF) = w; } }
    }
};
struct EpiBranchAcc {
    static constexpr bool PERM = true, AFTER_DRAIN = false, HALFN = false, F8 = false, RWACC = true;
    bf16_t* MG; const bf16_t* ZG;
    __device__ __forceinline__ bool restart(const Unit& u) const { return u.pm >= 264; }
    __device__ __forceinline__ void rw(f32x4 (&acc)[2][2][4][2], const Unit& u, int wr, int wc, int fr, int fq) const {
        const int r = u.pm / 132, pmt = u.pm - 132 * r, rn = r < 2 ? r + 1 : r;
        const int row0 = pmt * BM + wr * 64 + fr, col0 = u.pn * BM + wc * 32 + 8 * fq;
        constexpr int PG8_GD = 4;
        u32x4 gp[PG8_GD][2], gn[PG8_GD][2];
        constexpr unsigned GB = MK_GATE_U8 ? 1u : 2u;
        const unsigned o0 = (unsigned)row0 * (3072u * GB) + (unsigned)col0 * GB;
        const char* zp = (const char*)ZG + (size_t)r * 1024 * GB; const char* zn = (const char*)ZG + (size_t)rn * 1024 * GB;
#if MK_GATE_U8
#define PG8_GLOAD(s, buf) do { const int bj_ = (s) >> 2, ai_ = ((s) >> 1) & 1, mb_ = ((s) & 1) * 2; _Pragma("unroll") for (int q_ = 0; q_ < 2; ++q_) { \
            const unsigned off_ = o0 + (unsigned)(ai_ * HALF + (mb_ + q_) * 16) * 3072u + (unsigned)(bj_ * HALF); \
            const u32x2 a_ = *(const u32x2*)(zp + off_), b_ = *(const u32x2*)(zn + off_); gp[buf][q_].x = a_.x; gp[buf][q_].y = a_.y; gn[buf][q_].x = b_.x; gn[buf][q_].y = b_.y; } } while (0)
#else
#define PG8_GLOAD(s, buf) do { const int bj_ = (s) >> 2, ai_ = ((s) >> 1) & 1, mb_ = ((s) & 1) * 2; _Pragma("unroll") for (int q_ = 0; q_ < 2; ++q_) { \
            const unsigned off_ = o0 + (unsigned)(ai_ * HALF + (mb_ + q_) * 16) * 6144u + (unsigned)(bj_ * HALF * 2); \
            gp[buf][q_] = *(const u32x4*)(zp + off_); gn[buf][q_] = *(const u32x4*)(zn + off_); } } while (0)
#endif
#pragma unroll
        for (int s = 0; s < PG8_GD - 1; ++s) PG8_GLOAD(s, s);
#pragma unroll
        for (int s = 0; s < 8; ++s) { const int bj = s >> 2, ai = (s >> 1) & 1, mb = (s & 1) * 2, col = col0 + bj * HALF;
            if (s + PG8_GD - 1 < 8) PG8_GLOAD(s + PG8_GD - 1, (s + PG8_GD - 1) % PG8_GD);
            __builtin_amdgcn_sched_barrier(0);
#pragma unroll
            for (int q = 0; q < 2; ++q) { const int m = mb + q; const size_t row = (size_t)(row0 + ai * HALF + m * 16);
                const u32x4 g0 = gp[s % PG8_GD][q], g1 = gn[s % PG8_GD][q];
#if MK_GATE_U8
#define PG8_UB(w_, k_) ((float)(((w_) >> (8 * (k_))) & 255u))
                const float x[8] = {PG8_UB(g0.x, 0), PG8_UB(g0.x, 1), PG8_UB(g0.x, 2), PG8_UB(g0.x, 3), PG8_UB(g0.y, 0), PG8_UB(g0.y, 1), PG8_UB(g0.y, 2), PG8_UB(g0.y, 3)};
#else
                const float x[8] = {bf_lo(g0.x), bf_hi(g0.x), bf_lo(g0.y), bf_hi(g0.y), bf_lo(g0.z), bf_hi(g0.z), bf_lo(g0.w), bf_hi(g0.w)};
#endif
                if (r < 2) {
#if MK_GATE_U8
                    const float y[8] = {PG8_UB(g1.x, 0), PG8_UB(g1.x, 1), PG8_UB(g1.x, 2), PG8_UB(g1.x, 3), PG8_UB(g1.y, 0), PG8_UB(g1.y, 1), PG8_UB(g1.y, 2), PG8_UB(g1.y, 3)};
#else
                    const float y[8] = {bf_lo(g1.x), bf_hi(g1.x), bf_lo(g1.y), bf_hi(g1.y), bf_lo(g1.z), bf_hi(g1.z), bf_lo(g1.w), bf_hi(g1.w)};
#endif
#pragma unroll
                    for (int j = 0; j < 8; ++j) acc[ai][bj][m][j >> 2][j & 3] *= x[j] * __builtin_amdgcn_rcpf(y[j]);
                } else {
                    float v[8];
#pragma unroll
                    for (int j = 0; j < 8; ++j) v[j] = acc[ai][bj][m][j >> 2][j & 3] * (MK_GATE_U8 ? x[j] * (1.0f / 255.0f) : x[j]);
                    u32x4 w; w.x = cvt_pk_bf16(v[0], v[1]); w.y = cvt_pk_bf16(v[2], v[3]); w.z = cvt_pk_bf16(v[4], v[5]); w.w = cvt_pk_bf16(v[6], v[7]);
                    *(u32x4*)(MG + row * 1024 + col) = w;
                } }
        }
#undef PG8_GLOAD
    }
};
struct BranchOrder3 {
    StaticOrder so;
    __device__ __forceinline__ bool next(int i, Unit& u) const {
        const int ti = i / 3, r = i - 3 * ti; if (!so.next(ti, u)) return false;
        u.pb = 4 * r + u.pn; u.pm += 132 * r; return true;
    }
    __device__ __forceinline__ void a_ready(const Unit&) const {}
    __device__ __forceinline__ void done(const Unit&) const {}
};
struct EpiSwiglu {
    static constexpr bool PERM = true, AFTER_DRAIN = false, HALFN = false, F8 = false, RWACC = false;
    bf16_t* H; int ldh;
    __device__ __forceinline__ void operator()(const f32x4 (&acc)[2][2][4][2], const Unit& u, int wr, int wc, int fr, int fq) const {
        const int row0 = u.pm * BM + wr * 64 + fr; const int col0 = u.pn * HALF + wc * 32 + 8 * fq;
#pragma unroll
        for (int ai = 0; ai < 2; ++ai)
#pragma unroll
            for (int m = 0; m < 4; ++m) { bf16_t* rowp = H + (size_t)(row0 + ai * HALF + m * 16) * ldh + col0;
                float h[8];
#pragma unroll
                for (int n = 0; n < 2; ++n)
#pragma unroll
                    for (int j = 0; j < 4; ++j) { const float g = acc[ai][0][m][n][j], uu = acc[ai][1][m][n][j]; h[n * 4 + j] = g * sigmoidf_(g) * uu; }
                u32x4 w; w.x = cvt_pk_bf16(h[0], h[1]); w.y = cvt_pk_bf16(h[2], h[3]); w.z = cvt_pk_bf16(h[4], h[5]); w.w = cvt_pk_bf16(h[6], h[7]);
                *(u32x4*)rowp = w; }
    }
};
__device__ __forceinline__ unsigned pk4_fp8(float a, float b, float c, float d) { int w = __builtin_amdgcn_cvt_pk_fp8_f32(a, b, 0, false); w = __builtin_amdgcn_cvt_pk_fp8_f32(c, d, w, true); return (unsigned)w; }
__device__ __forceinline__ float clamp_fp8(float v) { return fminf(fmaxf(v, -448.0f), 448.0f); }
template <bool OPF8> struct EpiSwiglu8T {
    static constexpr bool PERM = true, AFTER_DRAIN = false, HALFN = false, F8 = OPF8, RWACC = false;
    unsigned char* H; int ldh; float sin, sout;
    __device__ __forceinline__ void operator()(const f32x4 (&acc)[2][2][4][2], const Unit& u, int wr, int wc, int fr, int fq) const {
        const int row0 = u.pm * BM + wr * 64 + fr; const int col0 = u.pn * HALF + wc * 32 + 8 * (fq & 2); const int odd = fq & 1;
#pragma unroll
        for (int ai = 0; ai < 2; ++ai)
#pragma unroll
            for (int mp = 0; mp < 2; ++mp) {
                unsigned w[2][2];
#pragma unroll
                for (int k = 0; k < 2; ++k) { const int m = 2 * mp + k; float h[8];
#pragma unroll
                    for (int n = 0; n < 2; ++n)
#pragma unroll
                        for (int j = 0; j < 4; ++j) { const float g = acc[ai][0][m][n][j] * sin, uu = acc[ai][1][m][n][j] * sin; h[n * 4 + j] = clamp_fp8(g * sigmoidf_(g) * uu * sout); }
                    w[k][0] = pk4_fp8(h[0], h[1], h[2], h[3]); w[k][1] = pk4_fp8(h[4], h[5], h[6], h[7]); }
                const unsigned s0 = odd ? w[0][0] : w[1][0], s1 = odd ? w[0][1] : w[1][1];
                const unsigned r0 = (unsigned)mk_xor16((int)s0), r1 = (unsigned)mk_xor16((int)s1);
                u32x4 st; if (odd) { st.x = r0; st.y = r1; st.z = w[1][0]; st.w = w[1][1]; } else { st.x = w[0][0]; st.y = w[0][1]; st.z = r0; st.w = r1; }
                *(u32x4*)(H + (size_t)(row0 + ai * HALF + (2 * mp + odd) * 16) * ldh + col0) = st; }
    }
};
typedef EpiSwiglu8T<true> EpiSwiglu8;
struct EpiBf16PS8 {
    static constexpr bool PERM = true, AFTER_DRAIN = false, HALFN = false, F8 = true, RWACC = false;
    bf16_t* O; int ldc; float s;
    __device__ __forceinline__ void operator()(const f32x4 (&acc)[2][2][4][2], const Unit& u, int wr, int wc, int fr, int fq) const {
        const int row0 = u.pm * BM + wr * 64 + fr; const int col0 = u.pn * BM + wc * 32 + 8 * fq;
#pragma unroll
        for (int ai = 0; ai < 2; ++ai)
#pragma unroll
            for (int m = 0; m < 4; ++m) { bf16_t* rowp = O + (size_t)(row0 + ai * HALF + m * 16) * ldc + col0;
#pragma unroll
                for (int bj = 0; bj < 2; ++bj) { const f32x4 v0 = acc[ai][bj][m][0] * s, v1 = acc[ai][bj][m][1] * s;
                    u32x4 w; w.x = cvt_pk_bf16(v0[0], v0[1]); w.y = cvt_pk_bf16(v0[2], v0[3]); w.z = cvt_pk_bf16(v1[0], v1[1]); w.w = cvt_pk_bf16(v1[2], v1[3]);
                    *(u32x4*)(rowp + bj * HALF) = w; } }
    }
};
struct MoeOrder {
    int nN, G, c, p_lo, np; int pc[8];
    __device__ __forceinline__ bool next(int i, Unit& u) const {
        const long L = (long)i * G + c; if (L >= (long)np * nN) return false;
        const int wgid = (int)L, nig = WGM * nN, gid = wgid / nig, fm = gid * WGM, gsz = (np - fm) < WGM ? (np - fm) : WGM;
        u.pm = p_lo + fm + ((wgid % nig) % gsz); u.pn = (wgid % nig) / gsz;
        int e = 0;
#pragma unroll
        for (int k = 1; k < 8; ++k) e += (u.pm >= pc[k]) ? 1 : 0;
        u.pb = e * nN + u.pn; return true;
    }
    __device__ __forceinline__ void a_ready(const Unit&) const {}
    __device__ __forceinline__ void done(const Unit&) const {}
};

__device__ __forceinline__ void glds_s(const char* sbase, unsigned voff, unsigned lds_dst) { unsigned keep;
    asm volatile("s_mov_b32 %0, m0\n\ts_mov_b32 m0, %3\n\ts_nop 0\n\tglobal_load_lds_dwordx4 %1, %2\n\ts_mov_b32 m0, %0" : "=&s"(keep) : "v"(voff), "s"(sbase), "s"(lds_dst) : "memory"); }
__device__ __forceinline__ const char* uni_ptr(const char* p) { const unsigned long long b = (unsigned long long)(uintptr_t)p; const unsigned lo = (unsigned)__builtin_amdgcn_readfirstlane((int)(unsigned)b), hi = (unsigned)__builtin_amdgcn_readfirstlane((int)(unsigned)(b >> 32));
    return (const char*)(uintptr_t)(((unsigned long long)hi << 32) | lo); }
template <class Epi, class Sched, bool ALIGN_EPI = false, bool SP2 = false, bool RELAX = true>
__device__ __forceinline__ void gemm_phase(PG8_LAS unsigned char* lds, const Gemm g, const Sched& S, const Epi& E, int wv) {
    int tid_ = (wv << 6) | mk_lane(); asm volatile("" : "+v"(tid_));
    const int tid = tid_, wid = __builtin_amdgcn_readfirstlane(tid >> 6), lane = tid & 63, wr = wid >> 2, wc = wid & 3, fr = lane & 15, fq = lane >> 4;
    constexpr bool HN = Epi::HALFN;
    constexpr bool F8 = Epi::F8;
    constexpr int ES = F8 ? 1 : 2;
    const int K = g.K, nt = K * ES / (BK * 2);
    unsigned voffA[2], voffB[2];
#pragma unroll
    for (int i = 0; i < 2; ++i) { int R, C; stage_rc(tid * 16 + i * 8192, R, C); const int Rb = Epi::PERM ? ((R & ~31) + perm32(R & 31)) : R;
        voffA[i] = (unsigned)(R * K * ES + C * 2); voffB[i] = (unsigned)(Rb * K * ES + C * 2); }
    const size_t kstep = (size_t)(BK * 2);
    const size_t hstep = (size_t)HALF * K * ES;
    const size_t tstep = 2 * hstep;
    const unsigned ldsw = (unsigned)wid * 1024u;
    const unsigned ldsb = (unsigned)__builtin_amdgcn_readfirstlane((int)((unsigned)(uintptr_t)lds + ldsw));
    const int aoff = lds_byte(wr * 64 + fr, fq * 8), boff = lds_byte(wc * 32 + fr, fq * 8);
#define PG8_SA(b, h) (((b) * 2 + (h)) * HTB)
#define PG8_SB(b, h) ((4 + (b) * 2 + (h)) * HTB)
#define PG8_STAGE(bufoff, gbase, voff) do { _Pragma("unroll") for (int _i = 0; _i < 2; ++_i) \
        glds_s((const char*)(gbase), (voff)[_i], ldsb + (unsigned)((bufoff) + _i * 8192)); } while (0)
#define PG8_LDA(dst, b, h) do { if constexpr (F8) { _Pragma("unroll") for (int m = 0; m < 4; ++m) { const u32x4 lo_ = *(const PG8_LAS u32x4*)(lds + PG8_SA(b, h) + aoff + m * 2048), hi_ = *(const PG8_LAS u32x4*)(lds + PG8_SA(b, h) + aoff + m * 2048 + 1024); \
            dst##8[m] = __builtin_bit_cast(v8i32, __builtin_shufflevector(lo_, hi_, 0, 1, 2, 3, 4, 5, 6, 7)); } } \
        else { _Pragma("unroll") for (int m = 0; m < 4; ++m) _Pragma("unroll") for (int k = 0; k < 2; ++k) dst[m][k] = *(const PG8_LAS bf16x8*)(lds + PG8_SA(b, h) + aoff + m * 2048 + k * 1024); } } while (0)
#define PG8_LDB(dst, b, h) do { if constexpr (F8) { _Pragma("unroll") for (int n = 0; n < 2; ++n) { const u32x4 lo_ = *(const PG8_LAS u32x4*)(lds + PG8_SB(b, h) + boff + n * 2048), hi_ = *(const PG8_LAS u32x4*)(lds + PG8_SB(b, h) + boff + n * 2048 + 1024); \
            dst##8[n] = __builtin_bit_cast(v8i32, __builtin_shufflevector(lo_, hi_, 0, 1, 2, 3, 4, 5, 6, 7)); } } \
        else { _Pragma("unroll") for (int n = 0; n < 2; ++n) _Pragma("unroll") for (int k = 0; k < 2; ++k) dst[n][k] = *(const PG8_LAS bf16x8*)(lds + PG8_SB(b, h) + boff + n * 2048 + k * 1024); } } while (0)
#define PG8_MMA(ai, bj, At, Bt) do { __builtin_amdgcn_s_setprio(1); _Pragma("unroll") for (int m = 0; m < 4; ++m) _Pragma("unroll") for (int n = 0; n < 2; ++n) { \
        if constexpr (F8) { asm volatile("v_mfma_f32_16x16x128_f8f6f4 %0, %1, %2, %0" : "+v"(acc[ai][bj][m][n]) : "v"(Bt##8[n]), "v"(At##8[m])); } \
        else { _Pragma("unroll") for (int k = 0; k < 2; ++k) acc[ai][bj][m][n] = __builtin_amdgcn_mfma_f32_16x16x32_bf16(Bt[n][k], At[m][k], acc[ai][bj][m][n], 0, 0, 0); } } \
        __builtin_amdgcn_s_setprio(0); } while (0)
#define PG8_LDB1(dst, b, h) do { if constexpr (!HN) { PG8_LDB(dst, b, h); } } while (0)
#define PG8_MMA1(ai, bj, At, Bt) do { if constexpr (!HN) { PG8_MMA(ai, bj, At, Bt); } } while (0)
#define PG8_WAIT_V(n) asm volatile("s_waitcnt vmcnt(" #n ")" ::: "memory")
#define PG8_WAIT_L(n) asm volatile("s_waitcnt lgkmcnt(" #n ")" ::: "memory")
#define PG8_BAR __builtin_amdgcn_s_barrier()
#define PG8_SCHED __builtin_amdgcn_sched_barrier(0)
    Unit cur, nxt; int ui = 0;
    if (!S.next(0, cur)) return;
    f32x4 acc[2][2][4][2];
#pragma unroll
    for (int a = 0; a < 2; ++a)
#pragma unroll
        for (int b = 0; b < 2; ++b)
#pragma unroll
            for (int m = 0; m < 4; ++m)
#pragma unroll
                for (int n = 0; n < 2; ++n) acc[a][b][m][n] = (f32x4){0.f, 0.f, 0.f, 0.f};
    bf16x8 At[4][2], B0[2][2], B1[2][2];
    v8i32 At8[4], B08[2], B18[2];
    const char* cA = uni_ptr((const char*)g.A + (size_t)cur.pm * tstep); const char* cB = uni_ptr((const char*)g.Bt + (size_t)cur.pb * (HN ? hstep : tstep));
    S.a_ready(cur);
    if constexpr (SP2) {
        PG8_STAGE(PG8_SB(0, 0), cB, voffB); PG8_STAGE(PG8_SB(0, 1), cB + hstep, voffB); PG8_STAGE(PG8_SA(0, 0), cA, voffA); PG8_STAGE(PG8_SA(0, 1), cA + hstep, voffA);
        if (wr == 1) PG8_BAR;
        PG8_WAIT_V(2); PG8_BAR;
        PG8_STAGE(PG8_SB(1, 0), cB + kstep, voffB); PG8_STAGE(PG8_SA(1, 0), cA + kstep, voffA); PG8_STAGE(PG8_SB(1, 1), cB + hstep + kstep, voffB);
        if constexpr (RELAX) PG8_WAIT_V(0); else PG8_WAIT_V(6); PG8_BAR;
    } else {
        PG8_STAGE(PG8_SB(0, 0), cB, voffB); PG8_STAGE(PG8_SA(0, 0), cA, voffA); PG8_STAGE(PG8_SB(0, 1), cB + hstep, voffB); PG8_STAGE(PG8_SA(0, 1), cA + hstep, voffA);
        if (wr == 1) PG8_BAR;
        PG8_WAIT_V(4); PG8_BAR;
        PG8_STAGE(PG8_SB(1, 0), cB + kstep, voffB); PG8_STAGE(PG8_SA(1, 0), cA + kstep, voffA); PG8_STAGE(PG8_SB(1, 1), cB + hstep + kstep, voffB);
        PG8_WAIT_V(6); PG8_BAR;
    }
    for (;;) {
        const bool has_next = S.next(ui + 1, nxt);
        const char* nA = uni_ptr(has_next ? (const char*)g.A + (size_t)nxt.pm * tstep : cA); const char* nB = uni_ptr(has_next ? (const char*)g.Bt + (size_t)nxt.pb * (HN ? hstep : tstep) : cB);
        for (int t = 0; t < nt; t += 2) {
            const bool last = (t == nt - 2);
            const char* a1 = cA + (size_t)(t + 1) * kstep;
            const char* a2 = last ? nA : cA + (size_t)(t + 2) * kstep; const char* b2 = last ? nB : cB + (size_t)(t + 2) * kstep;
            const char* a3 = a2 + kstep; const char* b3 = b2 + kstep;
            if (last && has_next) S.a_ready(nxt);
            const bool rl = SP2 && RELAX && t == 0;
            if constexpr (SP2) {
            PG8_LDB(B0, 0, 0); PG8_LDB1(B1, 0, 1); PG8_SCHED; PG8_LDA(At, 0, 0); PG8_STAGE(PG8_SA(1, 1), a1 + hstep, voffA);
            if (!rl) PG8_WAIT_V(8); PG8_WAIT_L(0); PG8_BAR; PG8_MMA(0, 0, At, B0); PG8_MMA1(0, 1, At, B1); PG8_BAR; PG8_SCHED;
            PG8_LDA(At, 0, 1); PG8_STAGE(PG8_SB(0, 0), b2, voffB); PG8_STAGE(PG8_SB(0, 1), b2 + hstep, voffB); PG8_STAGE(PG8_SA(0, 0), a2, voffA);
            if (!rl) PG8_WAIT_V(8); PG8_WAIT_L(0); PG8_BAR; PG8_MMA(1, 0, At, B0); PG8_MMA1(1, 1, At, B1); PG8_BAR; PG8_SCHED;
            PG8_LDB(B0, 1, 0); PG8_LDB1(B1, 1, 1); PG8_SCHED; PG8_LDA(At, 1, 0); PG8_STAGE(PG8_SA(0, 1), a2 + hstep, voffA);
            PG8_WAIT_V(8); PG8_WAIT_L(0); PG8_BAR; PG8_MMA(0, 0, At, B0); PG8_MMA1(0, 1, At, B1); PG8_BAR; PG8_SCHED;
            PG8_LDA(At, 1, 1); PG8_STAGE(PG8_SB(1, 0), b3, voffB); PG8_STAGE(PG8_SB(1, 1), b3 + hstep, voffB); PG8_STAGE(PG8_SA(1, 0), a3, voffA);
            PG8_WAIT_V(8); PG8_WAIT_L(0); PG8_BAR; PG8_MMA(1, 0, At, B0); PG8_MMA1(1, 1, At, B1); PG8_BAR; PG8_SCHED;
            } else {
            PG8_LDB(B0, 0, 0); PG8_SCHED; PG8_LDA(At, 0, 0); PG8_STAGE(PG8_SA(1, 1), a1 + hstep, voffA);
            PG8_WAIT_L(8); PG8_BAR; PG8_WAIT_L(0); PG8_MMA(0, 0, At, B0); PG8_BAR; PG8_SCHED;
            PG8_LDB1(B1, 0, 1); PG8_STAGE(PG8_SB(0, 0), b2, voffB);
            PG8_BAR; PG8_WAIT_L(0); PG8_MMA1(0, 1, At, B1); PG8_BAR;
            PG8_LDA(At, 0, 1); PG8_STAGE(PG8_SA(0, 0), a2, voffA);
            PG8_BAR; PG8_WAIT_L(0); PG8_MMA(1, 0, At, B0); PG8_BAR; PG8_SCHED;
            PG8_STAGE(PG8_SB(0, 1), b2 + hstep, voffB);
            PG8_WAIT_V(6); PG8_BAR; PG8_MMA1(1, 1, At, B1); PG8_BAR;
            PG8_LDB(B0, 1, 0); PG8_SCHED; PG8_LDA(At, 1, 0); PG8_STAGE(PG8_SA(0, 1), a2 + hstep, voffA);
            PG8_WAIT_L(8); PG8_BAR; PG8_WAIT_L(0); PG8_MMA(0, 0, At, B0); PG8_BAR; PG8_SCHED;
            PG8_LDB1(B1, 1, 1); PG8_STAGE(PG8_SB(1, 0), b3, voffB);
            PG8_BAR; PG8_WAIT_L(0); PG8_MMA1(0, 1, At, B1); PG8_BAR;
            PG8_LDA(At, 1, 1); PG8_STAGE(PG8_SA(1, 0), a3, voffA);
            PG8_BAR; PG8_WAIT_L(0); PG8_MMA(1, 0, At, B0); PG8_BAR; PG8_SCHED;
            PG8_STAGE(PG8_SB(1, 1), b3 + hstep, voffB);
            PG8_WAIT_V(6); PG8_BAR; PG8_MMA1(1, 1, At, B1); PG8_BAR;
            }
        }
        if constexpr (F8) asm volatile("s_nop 15\n\ts_nop 15" ::: "memory");
        if constexpr (ALIGN_EPI) { if (wr == 0) PG8_BAR; }
        if constexpr (SP2 && RELAX) PG8_WAIT_V(0);
        if constexpr (Epi::RWACC) { E.rw(acc, cur, wr, wc, fr, fq); S.done(cur); }
        else if constexpr (!Epi::AFTER_DRAIN) { E(acc, cur, wr, wc, fr, fq); S.done(cur); }
        if (!has_next) break;
        bool zero_acc = true; if constexpr (Epi::RWACC) zero_acc = E.restart(cur);
        if (zero_acc)
#pragma unroll
        for (int a = 0; a < 2; ++a)
#pragma unroll
            for (int b = 0; b < 2; ++b)
#pragma unroll
                for (int m = 0; m < 4; ++m)
#pragma unroll
                    for (int n = 0; n < 2; ++n) acc[a][b][m][n] = (f32x4){0.f, 0.f, 0.f, 0.f};
        cur = nxt; cA = nA; cB = nB; ++ui;
        if constexpr (ALIGN_EPI) { if (wr == 1) PG8_BAR; }
    }
    PG8_WAIT_V(0);
    if constexpr (!ALIGN_EPI) { if (wr == 0) PG8_BAR; }
    PG8_BAR;
    if constexpr (Epi::AFTER_DRAIN) { E.fused(acc, cur, wr, wc, fr, fq, lds, wid, lane); S.done(cur); }
#undef PG8_SA
#undef PG8_SB
#undef PG8_STAGE
#undef PG8_LDA
#undef PG8_LDB
#undef PG8_MMA
#undef PG8_LDB1
#undef PG8_MMA1
#undef PG8_WAIT_V
#undef PG8_WAIT_L
#undef PG8_BAR
#undef PG8_SCHED
}
}

#ifndef PG8_SP2
#define PG8_SP2 true
#endif
#ifndef PG8_ALIGN
#define PG8_ALIGN true
#endif
#ifndef MK_WGM
#define MK_WGM 4
#endif
#ifndef MK_DENSE_F8
#define MK_DENSE_F8 1
#endif
#ifndef MK_MT_A
#define MK_MT_A 22528
#endif
#ifndef MK_MT_B
#define MK_MT_B 27648
#endif
#ifndef MK_MOE_TAIL
#define MK_MOE_TAIL 1
#endif
#ifndef MK_PER_PHASE
#define MK_PER_PHASE 0
#endif

constexpr int NWAVES = 8;
constexpr int D = 1024, BATCH = 4, SEQ = 8192, CTXL = 256, DEPTH = 2;
constexpr int TL = BATCH * SEQ, TC = BATCH * CTXL, TA = TL + TC;
constexpr int INC = 6912, ZMC = 3840, ZGC = 3072, BW = 512;
constexpr int FFD = 2816, FFE = 3584, NE = 8;
constexpr int MAXPAN = 264, PCH = 264, NCHUNK = 1;
constexpr float RMS_EPS = 1e-6f;
constexpr float SC_XG = 4.0f, SC_WGU = 32.0f, SC_H = 4.0f, SC_WDN = 64.0f;
constexpr int C_QA = 0, C_KA = 512, C_VA = 640, C_UX = 768, C_GB = 1280, C_GC = 1792, C_QN = 2304, C_KN = 2816, C_VN = 3328;

constexpr size_t MiB = 1u << 20;
constexpr size_t WS_CTL = 0, CTL_ZERO_BYTES = 1 * MiB;
constexpr size_t WS_MOD = 1 * MiB;
constexpr size_t WS_ROPE = WS_MOD + 256 * 1024;
constexpr size_t WS_SLABCNT = WS_MOD + 320 * 1024;
constexpr size_t WS_PCUM = WS_MOD + 384 * 1024;
constexpr size_t WS_TOKER = WS_MOD + 512 * 1024;
constexpr size_t WS_TOKG = WS_MOD + 768 * 1024;
constexpr size_t WS_TOKPOS = WS_MOD + 1024 * 1024;
constexpr size_t WS_HCTX = 4 * MiB;
constexpr size_t WS_WIN = 8 * MiB;
constexpr size_t WS_WBR = 35 * MiB;
constexpr size_t WS_WOUT = 41 * MiB;
constexpr size_t WS_WGUD = 45 * MiB;
constexpr size_t WS_WDND = 56 * MiB;
constexpr size_t WS_WGUM = 62 * MiB;
constexpr size_t WS_WDNM = 118 * MiB;
constexpr size_t WS_RS = 146 * MiB;
constexpr size_t WS_HX = 230 * MiB;
constexpr size_t WS_ZM = 296 * MiB;
constexpr size_t WS_ZG = 544 * MiB;
constexpr size_t WS_O = 742 * MiB;
constexpr size_t WS_XG = WS_ZM;
constexpr size_t WS_HM = WS_ZM + 132 * MiB;
constexpr size_t WS_XG8 = WS_O;
constexpr size_t WS_HX8 = 841 * MiB;
constexpr size_t WS_WING8 = 874 * MiB;
constexpr size_t WS_END = 880 * MiB;
static_assert(WS_WIN + (size_t)2 * INC * D * 2 <= WS_WBR && WS_WGUD + (size_t)2 * FFD * D * 2 <= WS_WDND && WS_WDND + (size_t)D * FFD * 2 <= WS_WGUM, "ws map (weights)");
static_assert(WS_WGUM + (size_t)NE * 2 * FFE * D <= WS_WDNM && WS_WDNM + (size_t)NE * D * FFE <= WS_RS && WS_RS + (size_t)TA * D * 2 <= WS_HX, "ws map (moe weights, residual stream)");
static_assert(WS_HX + (size_t)TA * D * 2 <= WS_ZM && WS_ZM + (size_t)TA * ZMC * 2 <= WS_ZG && WS_ZG + (size_t)TA * ZGC * 2 <= WS_O && WS_O + (size_t)3 * TA * BW * 2 <= WS_END, "ws map (activations)");
static_assert(WS_HM + (size_t)MAXPAN * 256 * FFE <= WS_O && WS_XG8 + (size_t)MAXPAN * 256 * D <= WS_END && (size_t)MAXPAN * 256 * D * 2 <= 132 * MiB && (size_t)TA * D * 4 <= 132 * MiB, "ws map (moe)");
constexpr int CW_BAR = 4096;

constexpr int RING_OFF = 0, RING_BYTES = 131072;
constexpr int LDSCTL_OFF = RING_BYTES, MISC_OFF = LDSCTL_OFF + 320;
constexpr int ROPEL_OFF = RING_BYTES + 1024, ROPEL_BYTES = 192 * 16 * 2 * 4;
constexpr int LDS_BYTES = 163840;
static_assert(ROPEL_OFF + ROPEL_BYTES <= LDS_BYTES, "lds map");

#define GAS __attribute__((address_space(1)))
#define LAS __attribute__((address_space(3)))
typedef unsigned short bf16;
typedef unsigned v4u __attribute__((ext_vector_type(4)));
typedef unsigned v2u __attribute__((ext_vector_type(2)));
typedef float f32x4 __attribute__((ext_vector_type(4)));
typedef float f32x2 __attribute__((ext_vector_type(2)));
#define LDS_WAIT() asm volatile("s_waitcnt lgkmcnt(0)" ::: "memory")
#define VM_WAIT() asm volatile("s_waitcnt vmcnt(0)" ::: "memory")
__device__ __forceinline__ unsigned f2bf(float f) { unsigned u = __builtin_bit_cast(unsigned, f); return (u + 0x7fffu + ((u >> 16) & 1u)) >> 16; }
__device__ __forceinline__ unsigned pk2(float lo, float hi) { return f2bf(lo) | (f2bf(hi) << 16); }
__device__ __forceinline__ float bflo(unsigned w) { return __uint_as_float(w << 16); }
__device__ __forceinline__ float bfhi(unsigned w) { return __uint_as_float(w & 0xffff0000u); }
__device__ __forceinline__ float bf2f(bf16 b) { return __uint_as_float(((unsigned)b) << 16); }

#define XB_TMO      128
#define XB_XCNT(j)  (256  + 64 * (j))
#define XB_XSUB(j)  (1280 + 64 * (j))
#define XB_XGEN(j)  (2304 + 64 * (j))
#define XB_TOP      3328
#define XB_TOPGEN   3392
#define XCD_BAR_WORDS 3456
#define XB_SPIN_CAP (1u << 21)

__device__ __forceinline__ unsigned xb_ld(unsigned* p)              { return __hip_atomic_load(p, __ATOMIC_RELAXED, __HIP_MEMORY_SCOPE_AGENT); }
__device__ __forceinline__ unsigned xb_add(unsigned* p, unsigned v) { return __hip_atomic_fetch_add(p, v, __ATOMIC_RELAXED, __HIP_MEMORY_SCOPE_AGENT); }
__device__ __forceinline__ unsigned xb_xcc_id() { return (unsigned)__builtin_amdgcn_s_getreg((3 << 11) | 20) & 0xFu; }
#define XB_SPIN(cond, bar) do { unsigned _sp = 0; while (cond) { __builtin_amdgcn_s_sleep(1); \
    if ((++_sp & 255u) == 0u) { if (xb_ld(&(bar)[XB_TMO])) break; if (_sp > XB_SPIN_CAP) { atomicAdd(&(bar)[XB_TMO], 1u); break; } } } } while (0)

struct XcdBarrier {
    unsigned* bar; unsigned x;
    volatile LAS unsigned* st;
    int w;
};

__device__ __forceinline__ XcdBarrier xcd_barrier_post(unsigned* bar, volatile LAS unsigned* st) {
    XcdBarrier b; b.bar = bar; b.x = xb_xcc_id(); b.st = st; b.w = 0;
    if (threadIdx.x == 0) (void)xb_add(&bar[XB_XCNT(b.x)], 1u);
    return b;
}
__device__ __forceinline__ void xcd_barrier_complete(unsigned* bar, unsigned x, unsigned& nloc, unsigned& nx) {
    const unsigned G = gridDim.x * gridDim.y * gridDim.z;
    unsigned sum, cnt, mine, sp = 0u;
    for (;;) {
        sum = 0u; cnt = 0u; mine = 0u;
#pragma unroll
        for (unsigned j = 0; j < 16; ++j) { const unsigned c = xb_ld(&bar[XB_XCNT(j)]); sum += c; cnt += (c > 0u) ? 1u : 0u; mine = (j == x) ? c : mine; }
        if (sum == G) break;
        __builtin_amdgcn_s_sleep(1);
        if ((++sp & 255u) == 0u) { if (xb_ld(&bar[XB_TMO])) break; if (sp > XB_SPIN_CAP) { atomicAdd(&bar[XB_TMO], 1u); break; } }
    }
    nloc = mine > 0u ? mine : 1u; nx = cnt > 0u ? cnt : 1u;
}

__device__ __forceinline__ void xcd_barrier(const XcdBarrier& b) {
    asm volatile("s_waitcnt vmcnt(0)" ::: "memory");
    __syncthreads();
    if (b.w == 0 && mk_lane() == 0) {
        unsigned* bar = b.bar; { GAS unsigned* bg_ = (GAS unsigned*)bar; asm volatile("" : "+s"(bg_)); bar = (unsigned*)bg_; }
        __builtin_amdgcn_s_waitcnt(0);
        unsigned nloc = b.st[0], nx = b.st[1];
        if (nloc == 0u) { xcd_barrier_complete(bar, b.x, nloc, nx); b.st[0] = nloc; b.st[1] = nx; }
        const unsigned old = xb_add(&bar[XB_XSUB(b.x)], 1u);
        const unsigned gen = old / nloc;
        if (old + 1u == (gen + 1u) * nloc) {
            __builtin_amdgcn_fence(__ATOMIC_RELEASE, "agent");
            asm volatile("s_waitcnt vmcnt(0)" ::: "memory");
            const unsigned og = xb_add(&bar[XB_TOP], 1u);
            const unsigned tg = og / nx;
            if (og + 1u == (tg + 1u) * nx) xb_add(&bar[XB_TOPGEN], 1u);
            else XB_SPIN(xb_ld(&bar[XB_TOPGEN]) == tg, bar);
            __builtin_amdgcn_fence(__ATOMIC_ACQUIRE, "agent");
            xb_add(&bar[XB_XGEN(b.x)], 1u);
            asm volatile("s_waitcnt vmcnt(0)" ::: "memory");
        } else {
            XB_SPIN(xb_ld(&bar[XB_XGEN(b.x)]) == gen, bar);
            __builtin_amdgcn_fence(__ATOMIC_ACQUIRE, "agent");
            asm volatile("s_waitcnt vmcnt(0)" ::: "memory");
        }
    }
    __syncthreads();
}

struct Frame {
    LAS unsigned char* lds;
    volatile LAS unsigned* MISC;
    unsigned* ctl;
    int vcu, G;
    int wv;
};
enum { I_X = 0, I_C, I_CTX, I_CCTX, I_WADA, I_BADA, I_GPREMIX, I_GPOSTMIX, I_GPREFFN, I_GPOSTFFN, I_WIN, I_BGATE, I_SINK, I_CONVW, I_RPB, I_WBRANCH, I_WOUT, I_WGUD, I_WDND, I_WROUTER, I_BROUTER, I_WGUM, I_WDNM };

__device__ __forceinline__ float wave_sum(float v) {
    v += mk_dpp<0xB1>(v); v += mk_dpp<0x4E>(v); v += mk_dpp<0x141>(v); v += mk_dpp<0x140>(v);
    v += mk_dpp<0x142, 0xa>(v); v += mk_dpp<0x143, 0xc>(v);
    return __builtin_bit_cast(float, __builtin_amdgcn_readlane(__builtin_bit_cast(int, v), 63));
}
__device__ __forceinline__ float wave_max(float v) {
    v = fmaxf(v, mk_dpp<0xB1>(v)); v = fmaxf(v, mk_dpp<0x4E>(v)); v = fmaxf(v, mk_dpp<0x141>(v)); v = fmaxf(v, mk_dpp<0x140>(v));
    const float a = __builtin_bit_cast(float, __builtin_amdgcn_readlane(__builtin_bit_cast(int, v), 0)), b = __builtin_bit_cast(float, __builtin_amdgcn_readlane(__builtin_bit_cast(int, v), 16)),
                c = __builtin_bit_cast(float, __builtin_amdgcn_readlane(__builtin_bit_cast(int, v), 32)), d = __builtin_bit_cast(float, __builtin_amdgcn_readlane(__builtin_bit_cast(int, v), 48));
    return fmaxf(fmaxf(a, b), fmaxf(c, d));
}

__device__ __forceinline__ void row_store_fp8(unsigned char* p, int lane, const f32x4 (&h)[4], float sc) {
#pragma unroll
    for (int c = 0; c < 2; ++c) { const f32x4 a = __builtin_elementwise_min(__builtin_elementwise_max(h[2 * c] * sc, (f32x4){-448.f, -448.f, -448.f, -448.f}), (f32x4){448.f, 448.f, 448.f, 448.f}), b = __builtin_elementwise_min(__builtin_elementwise_max(h[2 * c + 1] * sc, (f32x4){-448.f, -448.f, -448.f, -448.f}), (f32x4){448.f, 448.f, 448.f, 448.f});
        v2u w; w.x = pg8::pk4_fp8(a.x, a.y, a.z, a.w); w.y = pg8::pk4_fp8(b.x, b.y, b.z, b.w);
        *(v2u*)(p + 8 * (64 * c + lane)) = w; }
}

__device__ __forceinline__ void tr_item(const float* W, int N, int k0, int n0, bf16* WT, int Kd, int drow0, LAS float* scr, int lane) {
#pragma unroll
    for (int i = 0; i < 8; ++i) { const int kk = 8 * i + (lane >> 3), c4 = 4 * (lane & 7); const f32x4 v = *(const f32x4*)(W + (size_t)(k0 + kk) * N + n0 + c4);
        LAS float* d = scr + kk * 33 + c4; d[0] = v.x; d[1] = v.y; d[2] = v.z; d[3] = v.w; }
    LDS_WAIT(); asm volatile("" ::: "memory");
    const int c = lane & 7;
#pragma unroll
    for (int j = 0; j < 4; ++j) { const int n = (lane >> 3) + 8 * j; const LAS float* s = scr + (8 * c) * 33 + n;
        v4u o; o.x = pk2(s[0 * 33], s[1 * 33]); o.y = pk2(s[2 * 33], s[3 * 33]); o.z = pk2(s[4 * 33], s[5 * 33]); o.w = pk2(s[6 * 33], s[7 * 33]);
        *(v4u*)(WT + (size_t)(drow0 + n) * Kd + k0 + 8 * c) = o; }
    LDS_WAIT(); asm volatile("" ::: "memory");
}
__device__ __forceinline__ void tr_matrix_item(const float* W, int K, int N, int ff, bf16* WT, int item, LAS float* scr, int lane) {
    const int nblk = N / 32, kb = item / nblk, nb = item % nblk, n0 = 32 * nb;
    int drow0 = n0;
    if (ff > 0) { const int isu = n0 >= ff ? 1 : 0, nn = n0 - isu * ff; drow0 = 256 * (nn >> 7) + 128 * isu + (nn & 127); }
    tr_item(W, N, 64 * kb, n0, WT, K, drow0, scr, lane);
}

__device__ __forceinline__ void tr_item8(const float* W, int N, int k0, int n0, unsigned char* WT, int Kd, int drow0, float scale, LAS float* scr, int lane) {
#pragma unroll
    for (int i = 0; i < 8; ++i) { const int kk = 8 * i + (lane >> 3), c4 = 4 * (lane & 7); const f32x4 v = *(const f32x4*)(W + (size_t)(k0 + kk) * N + n0 + c4);
        LAS float* d = scr + kk * 33 + c4; d[0] = v.x; d[1] = v.y; d[2] = v.z; d[3] = v.w; }
    LDS_WAIT(); asm volatile("" ::: "memory");
    const int n = lane >> 1, kh = lane & 1; const LAS float* s = scr + (32 * kh) * 33 + n;
    unsigned w[8];
#pragma unroll
    for (int j = 0; j < 8; ++j) w[j] = pg8::pk4_fp8(s[(4 * j) * 33] * scale, s[(4 * j + 1) * 33] * scale, s[(4 * j + 2) * 33] * scale, s[(4 * j + 3) * 33] * scale);
    v4u* dst = (v4u*)(WT + (size_t)(drow0 + n) * Kd + k0 + 32 * kh);
    dst[0] = (v4u){w[0], w[1], w[2], w[3]}; dst[1] = (v4u){w[4], w[5], w[6], w[7]};
    LDS_WAIT(); asm volatile("" ::: "memory");
}
__device__ __forceinline__ void tr_matrix_item8(const float* W, int K, int N, int ff, unsigned char* WT, float scale, int item, LAS float* scr, int lane) {
    const int nblk = N / 32, kb = item / nblk, nb = item % nblk, n0 = 32 * nb;
    int drow0 = n0;
    if (ff > 0) { const int isu = n0 >= ff ? 1 : 0, nn = n0 - isu * ff; drow0 = 256 * (nn >> 7) + 128 * isu + (nn & 127); }
    tr_item8(W, N, 64 * kb, n0, WT, K, drow0, scale, scr, lane);
}

__device__ __forceinline__ void row_load(const float* p, int lane, f32x4 (&v)[4]) {
#pragma unroll
    for (int c = 0; c < 2; ++c) { const f32x4* r = (const f32x4*)(p + 8 * (64 * c + lane)); v[2 * c] = r[0]; v[2 * c + 1] = r[1]; }
}
__device__ __forceinline__ void row_load_bf16(const bf16* p, int lane, f32x4 (&v)[4]) {
#pragma unroll
    for (int c = 0; c < 2; ++c) { const v4u w = *(const v4u*)(p + 8 * (64 * c + lane));
        v[2 * c] = (f32x4){bflo(w.x), bfhi(w.x), bflo(w.y), bfhi(w.y)}; v[2 * c + 1] = (f32x4){bflo(w.z), bfhi(w.z), bflo(w.w), bfhi(w.w)}; }
}
__device__ __forceinline__ void row_store(float* p, int lane, const f32x4 (&v)[4]) {
#pragma unroll
    for (int c = 0; c < 2; ++c) { f32x4* r = (f32x4*)(p + 8 * (64 * c + lane)); r[0] = v[2 * c]; r[1] = v[2 * c + 1]; }
}
__device__ __forceinline__ float row_rrms(const f32x4 (&v)[4]) {
    float s = 0.f;
#pragma unroll
    for (int j = 0; j < 4; ++j) s += (v[j].x * v[j].x + v[j].y * v[j].y) + (v[j].z * v[j].z + v[j].w * v[j].w);
    return 1.0f / sqrtf(wave_sum(s) * (1.0f / D) + RMS_EPS);
}
__device__ __forceinline__ void vec_load(const float* p, int lane, f32x4 (&v)[4]) { row_load(p, lane, v); }
__device__ __forceinline__ void row_normmod(const f32x4 (&x)[4], float rr, const f32x4 (&g)[4], const f32x4 (&shift)[4], const f32x4 (&scale)[4], f32x4 (&h)[4]) {
#pragma unroll
    for (int j = 0; j < 4; ++j) h[j] = (x[j] * rr * g[j]) * (scale[j] + 1.0f) + shift[j];
}
__device__ __forceinline__ void row_store_bf16(bf16* p, int lane, const f32x4 (&h)[4]) {
#pragma unroll
    for (int c = 0; c < 2; ++c) { v4u w; w.x = pk2(h[2 * c].x, h[2 * c].y); w.y = pk2(h[2 * c].z, h[2 * c].w); w.z = pk2(h[2 * c + 1].x, h[2 * c + 1].y); w.w = pk2(h[2 * c + 1].z, h[2 * c + 1].w);
        *(v4u*)(p + 8 * (64 * c + lane)) = w; }
}

namespace at {
typedef short bf16x8 __attribute__((ext_vector_type(8)));
typedef short s16x4 __attribute__((ext_vector_type(4)));
typedef short v4i16_t __attribute__((ext_vector_type(4)));
typedef float f32x16 __attribute__((ext_vector_type(16)));
constexpr int NS = 4, PF = 3, SLOT = 16384;
constexpr int LDS_TAB = NS * SLOT + 1024;
constexpr int LDS_TT = LDS_TAB + 8 * 2048 + 1024;
constexpr int MAXT = 160;
constexpr float LOG2E = 1.4426950408889634f, C2 = 0.125f * LOG2E;
__device__ __forceinline__ unsigned cvtpk(float lo, float hi) { unsigned r; asm volatile("v_cvt_pk_bf16_f32 %0, %1, %2" : "=v"(r) : "v"(lo), "v"(hi)); return r; }
__device__ __forceinline__ float hmax(float v) { auto rr = __builtin_amdgcn_permlane32_swap(__float_as_uint(v), __float_as_uint(v), false, false); return fmaxf(__uint_as_float(rr[0]), __uint_as_float(rr[1])); }
__device__ __forceinline__ float hsum(float v) { auto rr = __builtin_amdgcn_permlane32_swap(__float_as_uint(v), __float_as_uint(v), false, false); return __uint_as_float(rr[0]) + __uint_as_float(rr[1]); }

__device__ __forceinline__ void glds16(const void* gsrc, unsigned lds_dst) { unsigned keep;
    asm volatile("s_mov_b32 %0, m0\n\ts_mov_b32 m0, %2\n\ts_nop 0\n\tglobal_load_lds_dwordx4 %1, off\n\ts_mov_b32 m0, %0" : "=&s"(keep) : "v"(gsrc), "s"(lds_dst) : "memory"); }
__device__ __forceinline__ void tile_issue(LAS unsigned char* slot, const bf16* ZMp, size_t row0, int kcol, int vcol, int wid, int lane) {
    const bf16* ksrc = ZMp + (row0 + lane) * ZMC + kcol + wid * 8;
    const bf16* vsrc = ZMp + (row0 + 16 * (wid & 3) + (lane >> 2)) * ZMC + vcol + (wid >> 2) * 32 + (lane & 3) * 8;
    const unsigned dst = (unsigned)__builtin_amdgcn_readfirstlane((int)(unsigned)(uintptr_t)slot + wid * 1024);
    glds16(ksrc, dst); glds16(vsrc, dst + 8192u);
}
__device__ __forceinline__ void k_load_half(bf16x8 (&kf)[4], const LAS unsigned char* Ks, int h, int r32, int hi) {
    const LAS unsigned char* kb = Ks + hi * 1024 + r32 * 16 + h * 4096;
#pragma unroll
    for (int d0 = 0; d0 < 2; ++d0) { kf[2 * d0] = *(const LAS bf16x8*)(kb + d0 * 2048); kf[2 * d0 + 1] = *(const LAS bf16x8*)(kb + d0 * 2048 + 512); }
}
__device__ __forceinline__ void qk_tile(f32x16& p0, f32x16& p1, const LAS unsigned char* Ks, const bf16x8 (&kfa)[4], const bf16x8 (&qr)[4], int r32, int hi) {
    bf16x8 kfb[4]; k_load_half(kfb, Ks, 1, r32, hi);
    __builtin_amdgcn_sched_barrier(0);
#pragma unroll
    for (int r = 0; r < 16; ++r) { p0[r] = 0.f; p1[r] = 0.f; }
#pragma unroll
    for (int d0 = 0; d0 < 2; ++d0) {
        p0 = __builtin_amdgcn_mfma_f32_32x32x16_bf16(kfa[2 * d0], qr[d0], p0, 0, 0, 0);
        p1 = __builtin_amdgcn_mfma_f32_32x32x16_bf16(kfa[2 * d0 + 1], qr[d0], p1, 0, 0, 0);
    }
#pragma unroll
    for (int d0 = 0; d0 < 2; ++d0) {
        p0 = __builtin_amdgcn_mfma_f32_32x32x16_bf16(kfb[2 * d0], qr[2 + d0], p0, 0, 0, 0);
        p1 = __builtin_amdgcn_mfma_f32_32x32x16_bf16(kfb[2 * d0 + 1], qr[2 + d0], p1, 0, 0, 0);
    }
}
__device__ __forceinline__ s16x4 vtr(const LAS unsigned char* p) { return __builtin_bit_cast(s16x4, __builtin_amdgcn_ds_read_tr16_b64_v4i16((LAS v4i16_t*)p)); }
template <int LV> __device__ __forceinline__ constexpr bool live0(int r) { return LV == 2 ? r >= 12 : true; }
template <int LV> __device__ __forceinline__ constexpr bool live1(int r) { return LV == 1 ? r < 4 : true; }
template <bool RAW, int LV, int VAR = 0>
__device__ __forceinline__ void sm_pv(f32x16& x0, f32x16& x1, float& m, float& l, f32x16 (&o)[2], const LAS unsigned char* Vs, int lane, int hi, bf16x8 (&kfa)[4], const LAS unsigned char* Ksn, bool pre) {
    if (VAR == 2) { l += x0[0] + x1[15];
        bf16x8 pw_[4]; unsigned w_[16];
#pragma unroll
        for (int i = 0; i < 8; ++i) { w_[i] = cvtpk(x0[2 * i], x0[2 * i + 1]); w_[8 + i] = cvtpk(x1[2 * i], x1[2 * i + 1]); }
#pragma unroll
        for (int k = 0; k < 4; ++k) { typedef unsigned u32x4_ __attribute__((ext_vector_type(4))); u32x4_ t; t.x = w_[4 * k]; t.y = w_[4 * k + 1]; t.z = w_[4 * k + 2]; t.w = w_[4 * k + 3]; pw_[k] = __builtin_bit_cast(bf16x8, t); }
        const LAS unsigned char* vb_ = Vs + ((lane >> 4) & 1) * 32 + (lane & 3) * 8 + (4 * hi + ((lane & 15) >> 2)) * 64;
#pragma unroll
        for (int d0 = 0; d0 < 2; ++d0)
#pragma unroll
            for (int ks = 0; ks < 4; ++ks) { if ((LV == 1 && ks == 3) || (LV == 2 && ks == 0)) continue;
                const s16x4 lo = vtr(vb_ + d0 * 4096 + ks * 1024), hh = vtr(vb_ + d0 * 4096 + ks * 1024 + 512);
                const bf16x8 vf = (bf16x8){lo[0], lo[1], lo[2], lo[3], hh[0], hh[1], hh[2], hh[3]};
                o[d0] = __builtin_amdgcn_mfma_f32_32x32x16_bf16(vf, pw_[ks], o[d0], 0, 0, 0); }
        if (pre) k_load_half(kfa, Ksn, 0, lane & 31, hi);
        return; }
    if (VAR == 3) { if (pre) k_load_half(kfa, Ksn, 0, lane & 31, hi); l += x0[0] + x1[15] + x0[7] + x1[3]; o[0][0] += x0[1]; o[1][0] += x1[1]; return; }
    float rm = -INFINITY;
#pragma unroll
    for (int r = 0; r < 16; ++r) { if (live0<LV>(r)) rm = fmaxf(rm, x0[r]); if (live1<LV>(r)) rm = fmaxf(rm, x1[r]); }
    rm = hmax(rm);
    const float mn = fmaxf(m, RAW ? rm * C2 : rm);
    { const float sc = __builtin_amdgcn_exp2f(m - mn); l *= sc;
#pragma unroll
      for (int r = 0; r < 16; ++r) { o[0][r] *= sc; o[1][r] *= sc; } }
    m = mn;
    float sum = 0.f;
#pragma unroll
    for (int r = 0; r < 16; ++r) {
        if (live0<LV>(r)) { x0[r] = __builtin_amdgcn_exp2f(RAW ? __builtin_fmaf(x0[r], C2, -mn) : x0[r] - mn); sum += x0[r]; } else x0[r] = 0.f;
        if (live1<LV>(r)) { x1[r] = __builtin_amdgcn_exp2f(RAW ? __builtin_fmaf(x1[r], C2, -mn) : x1[r] - mn); sum += x1[r]; } else x1[r] = 0.f;
    }
    l += sum;
    bf16x8 pw[4];
    { unsigned w[16];
#pragma unroll
      for (int i = 0; i < 8; ++i) { w[i] = cvtpk(x0[2 * i], x0[2 * i + 1]); w[8 + i] = cvtpk(x1[2 * i], x1[2 * i + 1]); }
#pragma unroll
      for (int k = 0; k < 4; ++k) { typedef unsigned u32x4_ __attribute__((ext_vector_type(4))); u32x4_ t; t.x = w[4 * k]; t.y = w[4 * k + 1]; t.z = w[4 * k + 2]; t.w = w[4 * k + 3]; pw[k] = __builtin_bit_cast(bf16x8, t); } }
    if (pre) k_load_half(kfa, Ksn, 0, lane & 31, hi);
    const LAS unsigned char* vb = Vs + ((lane >> 4) & 1) * 32 + (lane & 3) * 8 + (4 * hi + ((lane & 15) >> 2)) * 64;
#pragma unroll
    for (int d0 = 0; d0 < 2; ++d0)
#pragma unroll
        for (int ks = 0; ks < 4; ++ks) {
            if ((LV == 1 && ks == 3) || (LV == 2 && ks == 0)) continue;
            const s16x4 lo = vtr(vb + d0 * 4096 + ks * 1024), hh = vtr(vb + d0 * 4096 + ks * 1024 + 512);
            const bf16x8 vf = (bf16x8){lo[0], lo[1], lo[2], lo[3], hh[0], hh[1], hh[2], hh[3]};
            o[d0] = __builtin_amdgcn_mfma_f32_32x32x16_bf16(vf, pw[ks], o[d0], 0, 0, 0);
        }
}
__device__ __forceinline__ void o_store(const f32x16 (&o)[2], float l, bf16* orow, int hi) {
    const float inv = __builtin_amdgcn_rcpf(hsum(l));
#pragma unroll
    for (int d0 = 0; d0 < 2; ++d0)
#pragma unroll
        for (int gp = 0; gp < 2; ++gp) {
            unsigned w[2][2];
#pragma unroll
            for (int k = 0; k < 2; ++k) { const int g = 2 * gp + k; w[k][0] = cvtpk(o[d0][4 * g] * inv, o[d0][4 * g + 1] * inv); w[k][1] = cvtpk(o[d0][4 * g + 2] * inv, o[d0][4 * g + 3] * inv); }
            unsigned rcv[2];
#pragma unroll
            for (int i = 0; i < 2; ++i) { const unsigned snd = hi ? w[0][i] : w[1][i];
                auto rr = __builtin_amdgcn_permlane32_swap(snd, snd, false, false); rcv[i] = hi ? rr[0] : rr[1]; }
            v4u st; if (hi) { st.x = rcv[0]; st.y = rcv[1]; st.z = w[1][0]; st.w = w[1][1]; } else { st.x = w[0][0]; st.y = w[0][1]; st.z = rcv[0]; st.w = rcv[1]; }
            *(v4u*)(orow + 32 * d0 + 16 * gp + 8 * hi) = st;
        }
}
#define AT_WAIT_BAR(N) asm volatile("s_waitcnt vmcnt(" #N ")\n\ts_barrier" ::: "memory")

struct UDesc { int kind, b, hh, blk, cq, nw, lo; };
__device__ __forceinline__ UDesc unit_desc(int i, int vcu, int UPW, bool ctx_out) {
    UDesc d; d.kind = -1; d.b = 0; d.hh = 0; d.blk = 0; d.cq = 0; d.nw = 0; d.lo = 0;
    if (i < 2 * UPW) { const int u = vcu * UPW + (i < UPW ? i : i - UPW); if (u >= 1024) return d; d.kind = i < UPW ? 0 : 1; d.b = u >> 8;
        if (d.kind == 0) { d.hh = (u >> 5) & 7; d.blk = u & 31; } else { d.hh = (u >> 7) & 1; d.blk = u & 127; } }
    else if (i == 2 * UPW) { if (!ctx_out || vcu >= 64) return d; d.cq = 1;
        if (vcu < 32) { d.kind = 1; d.b = vcu >> 3; d.hh = (vcu >> 2) & 1; d.blk = vcu & 3; } else { d.kind = 0; d.b = (vcu - 32) >> 3; d.hh = (vcu - 32) & 7; d.blk = 0; } }
    else return d;
    if (!d.cq) {
        if (d.kind == 1) { d.lo = max(0, 2 - d.blk); d.nw = min(4, 129 - d.blk) - d.lo + 1; }
        else { d.lo = min(max(4 * d.blk - 4, 0), 120); d.nw = min(max(4 * d.blk - 1, 0), 120) + 7 - d.lo + 1; }
    }
    return d;
}
__device__ __forceinline__ void tile_src(const UDesc& d, int t, int& row0, int& cols) {
    const int kcol = d.kind == 1 ? C_KA + d.hh * 64 : C_KN + d.hh * 64, vcol = d.kind == 1 ? C_VA + d.hh * 64 : C_VN + d.hh * 64;
    cols = kcol | (vcol << 16);
    if (t < d.nw) row0 = d.kind == 1 ? d.b * SEQ + 64 * d.blk - 128 + 64 * (d.lo + t) : d.b * SEQ + 64 * (d.lo + t);
    else row0 = TL + d.b * CTXL + 64 * (t - d.nw);
}
__device__ __forceinline__ size_t q_row(const UDesc& d, int wid, int r32) {
    if (d.kind == 1) { const int qrel = 32 * (wid >> 2) + r32; return d.cq ? (size_t)TL + (size_t)d.b * CTXL + 64 * d.blk + qrel : (size_t)d.b * SEQ + 64 * d.blk + qrel; }
    const int pair = wid >> 1, c = 32 * (wid & 1) + r32;
    return d.cq ? (size_t)TL + (size_t)d.b * CTXL + 64 * pair + c : (size_t)d.b * SEQ + (size_t)(4 * d.blk + pair) * 64 + c;
}
__device__ __forceinline__ void q_load(const UDesc& d, const bf16* ZMp, int wid, int r32, int hi, bf16x8 (&qr)[4]) {
    const int qcol = d.kind == 1 ? C_QA + (d.hh * 4 + (wid & 3)) * 64 : C_QN + d.hh * 64;
    const bf16* p = ZMp + q_row(d, wid, r32) * ZMC + qcol + 8 * hi;
#pragma unroll
    for (int d0 = 0; d0 < 4; ++d0) qr[d0] = *(const bf16x8*)(p + 16 * d0);
}

template <int VAR = 0>
__device__ __forceinline__ void attn_phase(LAS unsigned char* lds, const bf16* ZMp, bf16* OAp, bf16* OCp, const float* sinkp, const float* rpbl, int vcu, int G, bool ctx_out, int tid, int wid, int lane) {
    const int r32 = lane & 31, hi = lane >> 5;
    const int UPW = (1024 + G - 1) / G, NU = 2 * UPW + 1;
    LAS int* tt = (LAS int*)(lds + LDS_TT);
    int Ttot = 0;
    for (int i = 0; i < NU; ++i) { const UDesc d = unit_desc(i, vcu, UPW, ctx_out); if (d.kind < 0) continue; const int nt = d.nw + 4;
        for (int t = tid; t < nt; t += NWAVES * 64) { int row0, cols; tile_src(d, t, row0, cols); if (Ttot + t < MAXT) { tt[2 * (Ttot + t)] = row0; tt[2 * (Ttot + t) + 1] = cols; } }
        Ttot += nt; }
    if (Ttot > MAXT) Ttot = MAXT;
    if (tid < 8) ((LAS float*)(lds + LDS_TT + MAXT * 8))[tid] = sinkp[tid] * LOG2E;
    for (int u = tid; u < 8 * 480; u += NWAVES * 64) { const int h = u / 480, e = u - 480 * h, dr = e >> 5, dc = e & 31; ((LAS float*)(lds + LDS_TAB))[h * 512 + e] = dc < 31 ? rpbl[(h * 15 + dr) * 31 + dc] * LOG2E : 0.f; }
    asm volatile("s_waitcnt lgkmcnt(0)\n\ts_barrier" ::: "memory");
#define AT_ISSUE(T) do { const int row0_ = __builtin_amdgcn_readfirstlane(tt[2 * (T)]), cols_ = __builtin_amdgcn_readfirstlane(tt[2 * (T) + 1]); \
        tile_issue(lds + ((T) & (NS - 1)) * SLOT, ZMp, (size_t)row0_, cols_ & 0xffff, cols_ >> 16, wid, lane); } while (0)
    for (int T = 0; T < PF && T < Ttot; ++T) AT_ISSUE(T);
    int Tb = 0;
    bf16x8 qn[4];
    { int i0 = 0; UDesc d0 = unit_desc(0, vcu, UPW, ctx_out); while (d0.kind < 0 && i0 + 1 < NU) { ++i0; d0 = unit_desc(i0, vcu, UPW, ctx_out); } if (d0.kind >= 0) q_load(d0, ZMp, wid, r32, hi, qn); }
    for (int i = 0; i < NU; ++i) {
        const UDesc d = unit_desc(i, vcu, UPW, ctx_out); if (d.kind < 0) continue;
        bf16x8 qr[4];
#pragma unroll
        for (int k = 0; k < 4; ++k) qr[k] = qn[k];
        { int j = i + 1; UDesc dn = unit_desc(j, vcu, UPW, ctx_out); while (dn.kind < 0 && j + 1 < NU) { ++j; dn = unit_desc(j, vcu, UPW, ctx_out); } if (dn.kind < 0) dn = d; q_load(dn, ZMp, wid, r32, hi, qn); }
        const int NT = d.nw + 4;
        f32x16 o[2];
#pragma unroll
        for (int r = 0; r < 16; ++r) { o[0][r] = 0.f; o[1][r] = 0.f; }
        float m, l;
        if (d.kind == 1) {
            const int head = d.hh * 4 + (wid & 3), qrel = 32 * (wid >> 2) + r32;
            m = ((const LAS float*)(lds + LDS_TT + MAXT * 8))[head]; l = (hi == 0) ? 1.0f : 0.0f;
            bf16x8 kfa[4];
#pragma unroll
            for (int k = 0; k < 4; ++k) kfa[k] = (bf16x8){0, 0, 0, 0, 0, 0, 0, 0};
            int t = 0;
            do {
                const int T = Tb + t;
                if (T + 2 < Ttot) AT_WAIT_BAR(2); else AT_WAIT_BAR(0);
                if (t == NT - 1) asm volatile("" : "+v"(qn[0]), "+v"(qn[1]), "+v"(qn[2]), "+v"(qn[3]));
                if (VAR != 5 && T + PF < Ttot) AT_ISSUE(T + PF);
                const LAS unsigned char* sl = lds + (T & (NS - 1)) * SLOT;
                const LAS unsigned char* sln = lds + ((T + 1) & (NS - 1)) * SLOT; const bool pre = t + 1 < NT;
                if (t == 0) k_load_half(kfa, sl, 0, r32, hi);
                f32x16 x0, x1; qk_tile(x0, x1, sl, kfa, qr, r32, hi);
                const int j = d.lo + t;
                if (t < d.nw && (j == 0 || j == 4)) {
                    const int dq = qrel + 128 - 64 * j - 4 * hi;
#pragma unroll
                    for (int r = 0; r < 16; ++r) { const int dd = dq - ((r & 3) + 8 * (r >> 2));
                        x0[r] = (dd <= 128 && dd >= -128) ? x0[r] * C2 : -INFINITY; x1[r] = (dd - 32 <= 128 && dd - 32 >= -128) ? x1[r] * C2 : -INFINITY; }
                    sm_pv<false, 0, VAR>(x0, x1, m, l, o, sl + 8192, lane, hi, kfa, sln, pre);
                } else sm_pv<true, 0, VAR>(x0, x1, m, l, o, sl + 8192, lane, hi, kfa, sln, pre);
            } while (++t < NT);
            o_store(o, l, OAp + q_row(d, wid, r32) * BW + head * 64, hi);
        } else {
            const int half = wid & 1, c = 32 * half + r32, r = 4 * d.blk + (wid >> 1);
            const int r0w = min(max(r - 4, 0), 120), c0 = min(max(c - 8, 0), 48);
            const LAS float* tab = (const LAS float*)(lds + LDS_TAB + d.hh * 2048);
            unsigned vm = 0u;
#pragma unroll
            for (int r_ = 0; r_ < 16; ++r_) { const int kc = (r_ & 3) + 8 * (r_ >> 2) + 4 * hi; vm |= ((unsigned)(kc - c0) < 16u ? 1u : 0u) << r_; vm |= ((unsigned)(kc + 32 - c0) < 16u ? 1u : 0u) << (16 + r_); }
            m = -1e30f; l = 0.f;
            bf16x8 kfa[4];
#pragma unroll
            for (int k = 0; k < 4; ++k) kfa[k] = (bf16x8){0, 0, 0, 0, 0, 0, 0, 0};
            int t = 0;
            do {
                const int T = Tb + t;
                if (T + 2 < Ttot) AT_WAIT_BAR(2); else AT_WAIT_BAR(0);
                if (t == NT - 1) asm volatile("" : "+v"(qn[0]), "+v"(qn[1]), "+v"(qn[2]), "+v"(qn[3]));
                if (VAR != 5 && T + PF < Ttot) AT_ISSUE(T + PF);
                const int kr = d.lo + t;
                const bool use = !(t < d.nw && (kr < r0w || kr > r0w + 7));
                const bool usen = !(t + 1 < d.nw && (kr + 1 < r0w || kr + 1 > r0w + 7));
                const LAS unsigned char* sl = lds + (T & (NS - 1)) * SLOT; const LAS unsigned char* sln = lds + ((T + 1) & (NS - 1)) * SLOT; const bool pre = usen && t + 1 < NT;
                if (!use) { if (pre) k_load_half(kfa, sln, 0, r32, hi); continue; }
                if (t == 0) k_load_half(kfa, sl, 0, r32, hi);
                f32x16 x0, x1; qk_tile(x0, x1, sl, kfa, qr, r32, hi);
                if (t < d.nw) {
                    const LAS float* tb = tab + (kr - r + 7) * 32 + (4 * hi - c + 15);
                    if (half == 0) {
                        float b0[16], b1[4];
#pragma unroll
                        for (int r_ = 0; r_ < 16; ++r_) { const int rr = (r_ & 3) + 8 * (r_ >> 2); b0[r_] = tb[rr]; if (r_ < 4) b1[r_] = tb[rr + 32]; }
#pragma unroll
                        for (int r_ = 0; r_ < 16; ++r_) {
                            x0[r_] = ((vm >> r_) & 1u) ? __builtin_fmaf(x0[r_], C2, b0[r_]) : -INFINITY;
                            if (r_ < 4) x1[r_] = ((vm >> (16 + r_)) & 1u) ? __builtin_fmaf(x1[r_], C2, b1[r_]) : -INFINITY; }
                        sm_pv<false, 1, VAR>(x0, x1, m, l, o, sl + 8192, lane, hi, kfa, sln, pre);
                    } else {
                        float b0[4], b1[16];
#pragma unroll
                        for (int r_ = 0; r_ < 16; ++r_) { const int rr = (r_ & 3) + 8 * (r_ >> 2); if (r_ >= 12) b0[r_ - 12] = tb[rr]; b1[r_] = tb[rr + 32]; }
#pragma unroll
                        for (int r_ = 0; r_ < 16; ++r_) {
                            if (r_ >= 12) x0[r_] = ((vm >> r_) & 1u) ? __builtin_fmaf(x0[r_], C2, b0[r_ - 12]) : -INFINITY;
                            x1[r_] = ((vm >> (16 + r_)) & 1u) ? __builtin_fmaf(x1[r_], C2, b1[r_]) : -INFINITY; }
                        sm_pv<false, 2, VAR>(x0, x1, m, l, o, sl + 8192, lane, hi, kfa, sln, pre);
                    }
                } else sm_pv<true, 0, VAR>(x0, x1, m, l, o, sl + 8192, lane, hi, kfa, sln, pre);
            } while (++t < NT);
            o_store(o, l, OCp + q_row(d, wid, r32) * BW + d.hh * 64, hi);
        }
        Tb += NT;
    }
    AT_WAIT_BAR(0);
#undef AT_ISSUE
}
}

constexpr int PH_PER_LAYER = 17, NPHASES = 1 + DEPTH * PH_PER_LAYER;
struct Args { const float* in[23]; float* out; unsigned char* ws; int ph_lo, ph_hi; };
typedef __attribute__((address_space(4))) const Args CArgs;
__global__ void __launch_bounds__(NWAVES * 64, 2) mk_fwd(Args args) {
    extern __shared__ __attribute__((aligned(16))) unsigned char lds[];
    Frame F;
    F.lds = (LAS unsigned char*)lds;
    F.MISC = (volatile LAS unsigned*)(F.lds + MISC_OFF);
    F.G = gridDim.x; { const int bx = blockIdx.x; F.vcu = (F.G % 8 == 0) ? (bx % 8) * (F.G / 8) + bx / 8 : bx; }
    F.ctl = (unsigned*)(args.ws + WS_CTL);
    for (int u = threadIdx.x; u < (ROPEL_OFF - LDSCTL_OFF) / 4; u += NWAVES * 64) ((LAS unsigned*)(F.lds + LDSCTL_OFF))[u] = 0u;
    for (int u = threadIdx.x; u < 192 * 16; u += NWAVES * 64) { const int idx = u >> 4, i = u & 15; const float pos = (float)(idx < 128 ? idx : idx - 128);
        const float inv = 1.0f / powf(10000.0f, (float)(2 * i) / 32.0f); const float ang = pos * inv;
        ((LAS float*)(F.lds + ROPEL_OFF))[2 * u] = cosf(ang); ((LAS float*)(F.lds + ROPEL_OFF))[2 * u + 1] = sinf(ang); }
    { int wv_ = __builtin_amdgcn_readfirstlane((int)(threadIdx.x >> 6)); asm volatile("" : "+s"(wv_)); F.wv = wv_; }
    __syncthreads();
    const int lo = args.ph_lo, hi = args.ph_hi;
    const bool fused = (hi - lo) > 1;
    XcdBarrier bar; bar.bar = F.ctl + CW_BAR; bar.x = 0; bar.st = nullptr; bar.w = F.wv;
    if (fused) { bar = xcd_barrier_post(F.ctl + CW_BAR, F.MISC + 8); bar.w = F.wv; }
#ifndef MK_MASK
#define MK_MASK 0xFFFFFFFFu
#endif
#define SLOT(k) ((k) == 0 ? 0 : (((k) - 1) % PH_PER_LAYER) + 1)
#define IN(k) (((MK_MASK >> SLOT(k)) & 1u) && lo <= (k) && (k) < hi)
#define GRID_BAR() do { if (fused) xcd_barrier(bar); } while (0)
constexpr int MOE_I_GUM = (D / 64) * (2 * FFE / 32), MOE_I_DNM = (FFE / 64) * (D / 32), MOE_ITEMS = NE * (MOE_I_GUM + MOE_I_DNM);
#define MOE_TAIL(lo_, hi_) do { if (MK_MOE_TAIL && l == 0 && (int)blockIdx.x >= 16) { __syncthreads(); LAS float* scr_ = (LAS float*)(F.lds + RING_OFF + wave * 16384); \
        for (int r_ = (lo_) + ((int)blockIdx.x - 16) * NWAVES + wave; r_ < (hi_); r_ += (F.G - 16) * NWAVES) { \
            if (r_ < NE * MOE_I_GUM) { const int e_ = r_ / MOE_I_GUM; tr_matrix_item8(INP(I_WGUM) + (size_t)e_ * D * 2 * FFE, D, 2 * FFE, FFE, W_GUM8 + (size_t)e_ * 2 * FFE * D, SC_WGU, r_ % MOE_I_GUM, scr_, lane); } \
            else { const int q_ = r_ - NE * MOE_I_GUM, e_ = q_ / MOE_I_DNM; tr_matrix_item8(INP(I_WDNM) + (size_t)e_ * FFE * D, FFE, D, 0, W_DNM8 + (size_t)e_ * D * FFE, SC_WDN, q_ % MOE_I_DNM, scr_, lane); } } } } while (0)
    const int NGW = F.G * NWAVES;
#define PHASE_ENTER() GAS unsigned char* wsg_ = (GAS unsigned char*)args.ws; asm volatile("" : "+s"(wsg_)); unsigned char* ws = (unsigned char*)wsg_; float* outp = (float*)(GAS float*)args.out; (void)outp; const CArgs* ka = (const CArgs*)__builtin_amdgcn_kernarg_segment_ptr(); asm volatile("" : "+s"(ka)); \
    int tid_ = (F.wv << 6) | mk_lane(); asm volatile("" : "+v"(tid_)); const int lane = tid_ & 63; const int wave = __builtin_amdgcn_readfirstlane(tid_ >> 6); const int gw = F.vcu * NWAVES + wave; (void)gw; (void)lane; (void)ws; (void)ka;
#define INP(i) ((const float*)(const GAS float*)ka->in[i])
#define MOD ((float*)(GAS float*)(ws + WS_MOD))
#define ROPE ((float*)(GAS float*)(ws + WS_ROPE))
#define SLABCNT ((int*)(GAS int*)(ws + WS_SLABCNT))
#define PCUM ((int*)(GAS int*)(ws + WS_PCUM))
#define TOKER ((int*)(GAS int*)(ws + WS_TOKER))
#define TOKG ((float*)(GAS float*)(ws + WS_TOKG))
#define TOKPOS ((int*)(GAS int*)(ws + WS_TOKPOS))
#define HCTX ((float*)(GAS float*)(ws + WS_HCTX))
#define RS ((bf16*)(GAS bf16*)(ws + WS_RS))
#define W_IN ((bf16*)(GAS bf16*)(ws + WS_WIN))
#define W_BR ((bf16*)(GAS bf16*)(ws + WS_WBR))
#define W_OUT ((bf16*)(GAS bf16*)(ws + WS_WOUT))
#define W_GUD ((bf16*)(GAS bf16*)(ws + WS_WGUD))
#define W_DND ((bf16*)(GAS bf16*)(ws + WS_WDND))
#define W_GUM8 ((unsigned char*)(GAS unsigned char*)(ws + WS_WGUM))
#define W_DNM8 ((unsigned char*)(GAS unsigned char*)(ws + WS_WDNM))
#define HX ((bf16*)(GAS bf16*)(ws + WS_HX))
#define ZM ((bf16*)(GAS bf16*)(ws + WS_ZM))
#define ZG ((bf16*)(GAS bf16*)(ws + WS_ZG))
#define OA ((bf16*)(GAS bf16*)(ws + WS_O))
#define OB (OA + (size_t)TA * BW)
#define OC (OA + (size_t)2 * TA * BW)
#define SB ((float*)(GAS float*)(ws + WS_ZM))
#define Y16 ((bf16*)(GAS bf16*)(ws + WS_ZG))
#define HD ((bf16*)(GAS bf16*)(ws + WS_ZM))
#define XG ((bf16*)(GAS bf16*)(ws + WS_XG))
#define HM8 ((unsigned char*)(GAS unsigned char*)(ws + WS_HM))
#define XG8 ((unsigned char*)(GAS unsigned char*)(ws + WS_XG8))
#define HX8 ((unsigned char*)(GAS unsigned char*)(ws + WS_HX8))
#define W_ING8 ((unsigned char*)(GAS unsigned char*)(ws + WS_WING8))

    if (IN(0)) {
        PHASE_ENTER();
        {
            LAS float* scv = (LAS float*)(F.lds + RING_OFF);
            LAS float* red = scv + 5 * 1024;
            for (int u = tid_; u < 5 * 1024; u += NWAVES * 64) { const int bb = u >> 10, k = u & 1023; const float cv = bb < 4 ? INP(I_C)[bb * 1024 + k] : INP(I_CCTX)[k]; scv[u] = cv / (1.0f + __expf(-cv)); }
            __syncthreads();
            for (int it = blockIdx.x; it < 2 * 96; it += F.G) {
                const int l = it / 96, n = (it % 96) * 64 + lane;
                const float* wp = INP(I_WADA) + (size_t)l * D * 6144 + n;
                float a0 = 0.f, a1 = 0.f, a2 = 0.f, a3 = 0.f, a4 = 0.f;
                const int kb = wave * 128;
#pragma unroll 16
                for (int k = 0; k < 128; ++k) { const float w = wp[(size_t)(kb + k) * 6144];
                    a0 += scv[kb + k] * w; a1 += scv[1024 + kb + k] * w; a2 += scv[2048 + kb + k] * w; a3 += scv[3072 + kb + k] * w; a4 += scv[4096 + kb + k] * w; }
                red[(wave * 5 + 0) * 64 + lane] = a0; red[(wave * 5 + 1) * 64 + lane] = a1; red[(wave * 5 + 2) * 64 + lane] = a2; red[(wave * 5 + 3) * 64 + lane] = a3; red[(wave * 5 + 4) * 64 + lane] = a4;
                __syncthreads();
                if (tid_ < 320) { const int bb = tid_ >> 6, nn = tid_ & 63; float s = 0.f;
#pragma unroll
                    for (int w = 0; w < 8; ++w) s += red[(w * 5 + bb) * 64 + nn];
                    const int col = (it % 96) * 64 + nn;
                    MOD[((size_t)l * 5 + bb) * 6144 + col] = s + INP(I_BADA)[l * 6144 + col]; }
                __syncthreads();
            }
        }
        __syncthreads();
        {
            LAS float* scr = (LAS float*)(F.lds + RING_OFF + wave * 16384);
            constexpr int I_IN = (D / 64) * (INC / 32), I_BR = (BW / 64) * (D / 32), I_OUT = (D / 64) * (D / 32), I_GUD = (D / 64) * (2 * FFD / 32), I_DND = (FFD / 64) * (D / 32),
                          I_GUM = (D / 64) * (2 * FFE / 32), I_DNM = (FFE / 64) * (D / 32);
            constexpr int NITEMS = 2 * I_IN + 6 * I_BR + 2 * I_OUT + I_GUD + I_DND + (MK_MOE_TAIL ? 0 : NE * I_GUM + NE * I_DNM);
            for (int it = gw; it < NITEMS; it += NGW) {
                int r = it;
                if (r < 2 * I_IN) { const int l = r / I_IN, it2 = r % I_IN, n0 = 32 * (it2 % (INC / 32));
                    if (MK_GATE_F8 == 2) { tr_item8(INP(I_WIN) + (size_t)l * D * INC, INC, 64 * (it2 / (INC / 32)), n0, (unsigned char*)W_IN + (size_t)l * INC * D, D, n0, SC_WGU, scr, lane); continue; }
                    if (!MK_GATE_F8 || n0 < ZMC) tr_matrix_item(INP(I_WIN) + (size_t)l * D * INC, D, INC, 0, W_IN + (size_t)l * INC * D, it2, scr, lane);
                    if (MK_GATE_F8 && n0 >= ZMC) tr_item8(INP(I_WIN) + (size_t)l * D * INC, INC, 64 * (it2 / (INC / 32)), n0, W_ING8 + (size_t)l * ZGC * D, D, n0 - ZMC, SC_WGU, scr, lane);
                    continue; } r -= 2 * I_IN;
                if (r < 6 * I_BR) { const int q = r / I_BR; tr_matrix_item(INP(I_WBRANCH) + (size_t)q * BW * D, BW, D, 0, W_BR + (size_t)q * D * BW, r % I_BR, scr, lane); continue; } r -= 6 * I_BR;
                if (r < 2 * I_OUT) { const int l = r / I_OUT; tr_matrix_item(INP(I_WOUT) + (size_t)l * D * D, D, D, 0, W_OUT + (size_t)l * D * D, r % I_OUT, scr, lane); continue; } r -= 2 * I_OUT;
                if (r < I_GUD) { if (MK_DENSE_F8 >= 2) tr_matrix_item8(INP(I_WGUD), D, 2 * FFD, FFD, (unsigned char*)W_GUD, SC_WGU, r, scr, lane); else tr_matrix_item(INP(I_WGUD), D, 2 * FFD, FFD, W_GUD, r, scr, lane); continue; } r -= I_GUD;
                if (r < I_DND) { if (MK_DENSE_F8 >= 1) tr_matrix_item8(INP(I_WDND), FFD, D, 0, (unsigned char*)W_DND, SC_WDN, r, scr, lane); else tr_matrix_item(INP(I_WDND), FFD, D, 0, W_DND, r, scr, lane); continue; } r -= I_DND;
                if (r < NE * I_GUM) { const int e = r / I_GUM; tr_matrix_item8(INP(I_WGUM) + (size_t)e * D * 2 * FFE, D, 2 * FFE, FFE, W_GUM8 + (size_t)e * 2 * FFE * D, SC_WGU, r % I_GUM, scr, lane); continue; } r -= NE * I_GUM;
                { const int e = r / I_DNM; tr_matrix_item8(INP(I_WDNM) + (size_t)e * FFE * D, FFE, D, 0, W_DNM8 + (size_t)e * D * FFE, SC_WDN, r % I_DNM, scr, lane); }
            }
        }
        GRID_BAR();
    }

    for (int l = 0; l < DEPTH; ++l) {
        const int pb = 1 + l * PH_PER_LAYER;
        const bool ctx_out = (l < DEPTH - 1);
        const bool moe = (l & 1) != 0;
        const int rows_out = ctx_out ? TA : TL;
#define modl (MOD + (size_t)l * 5 * 6144)
#define xsrc_lat ((l == 0) ? INP(I_X) : (const float*)outp)
#define xsrc_ctx ((l == 0) ? INP(I_CTX) : (const float*)HCTX)

        if (IN(pb + 0) && l == 0) {
            PHASE_ENTER();
            const int chunk = (TL + NGW - 1) / NGW;
#define P1_ROW(t) do { const float* xr = (t) < TL ? xsrc_lat + (size_t)(t) * D : xsrc_ctx + (size_t)((t) - TL) * D; \
                f32x4 x[4], h[4]; row_load(xr, lane, x); const float rr = row_rrms(x); row_normmod(x, rr, gpre, sh, sc, h); if (MK_GATE_F8 < 2) row_store_bf16(HX + (size_t)(t) * D, lane, h); if (MK_GATE_F8) row_store_fp8(HX8 + (size_t)(t) * D, lane, h, SC_XG); } while (0)
            f32x4 gpre[4], sh[4], sc[4]; vec_load(INP(I_GPREMIX) + l * D, lane, gpre);
            for (int t0 = min(gw * chunk, TL), t1 = min(TL, t0 + chunk); t0 < t1; ) { const int bb = t0 >> 13, te = min(t1, (bb + 1) << 13); const float* md = modl + (size_t)bb * 6144;
                vec_load(md, lane, sh); vec_load(md + 1024, lane, sc);
                for (int t = t0; t < te; ++t) P1_ROW(t);
                t0 = te; }
            { const float* md = modl + (size_t)4 * 6144; vec_load(md, lane, sh); vec_load(md + 1024, lane, sc); for (int t = TL + gw; t < TA; t += NGW) P1_ROW(t); }
#undef P1_ROW
            GRID_BAR();
        }
        if (IN(pb + 1)) {
            PHASE_ENTER();
#if MK_GATE_F8 == 2
            {
                pg8::Gemm g{(const bf16*)HX8, (const bf16*)((unsigned char*)W_IN + (size_t)l * INC * D), TA, ZMC, D}; pg8::StaticOrder S; S.init(TA, ZMC, F.G, (int)blockIdx.x, MK_WGM);
                pg8::EpiZT<true> E{ZM, ZG, ROPE, TL / 256, INP(I_BGATE) + (size_t)l * 3 * D, 0, 1.0f / (SC_XG * SC_WGU)};
                pg8::gemm_phase<pg8::EpiZT<true>, pg8::StaticOrder, PG8_ALIGN, PG8_SP2>(F.lds + RING_OFF, g, S, E, F.wv);
            }
            {
                pg8::Gemm g{(const bf16*)HX8, (const bf16*)((unsigned char*)W_IN + (size_t)l * INC * D + (size_t)ZMC * D), rows_out, ZGC, D}; pg8::StaticOrder S; S.init(rows_out, ZGC, F.G, (int)blockIdx.x, MK_WGM);
                pg8::EpiZT<true> E{ZM, ZG, ROPE, TL / 256, INP(I_BGATE) + (size_t)l * 3 * D, ZMC / 256, 1.0f / (SC_XG * SC_WGU)};
                pg8::gemm_phase<pg8::EpiZT<true>, pg8::StaticOrder, PG8_ALIGN, PG8_SP2>(F.lds + RING_OFF, g, S, E, F.wv);
            }
#elif MK_GATE_F8
            {
                pg8::Gemm g{HX, W_IN + (size_t)l * INC * D, TA, ZMC, D}; pg8::StaticOrder S; S.init(TA, ZMC, F.G, (int)blockIdx.x, MK_WGM);
                pg8::EpiZM E{ZM, (const LAS float*)(F.lds + ROPEL_OFF), TL / 256};
                pg8::gemm_phase<pg8::EpiZM, pg8::StaticOrder, PG8_ALIGN, PG8_SP2>(F.lds + RING_OFF, g, S, E, F.wv);
            }
            {
                pg8::Gemm g{(const bf16*)HX8, (const bf16*)(W_ING8 + (size_t)l * ZGC * D), rows_out, ZGC, D}; pg8::StaticOrder S; S.init(rows_out, ZGC, F.G, ((int)blockIdx.x + 68) % F.G, MK_WGM);
                pg8::EpiZGate E{(unsigned char*)ZG, INP(I_BGATE) + (size_t)l * 3 * D, 1.0f / (SC_XG * SC_WGU)};
                pg8::gemm_phase<pg8::EpiZGate, pg8::StaticOrder, PG8_ALIGN, PG8_SP2>(F.lds + RING_OFF, g, S, E, F.wv);
            }
#else
            pg8::Gemm g{HX, W_IN + (size_t)l * INC * D, TA, INC, D}; pg8::StaticOrder S; S.init(TA, INC, F.G, (int)blockIdx.x, MK_WGM);
            pg8::EpiZ E{ZM, ZG, ROPE, TL / 256, INP(I_BGATE) + (size_t)l * 3 * D, 0, 1.0f};
            pg8::gemm_phase<pg8::EpiZ, pg8::StaticOrder, PG8_ALIGN, PG8_SP2>(F.lds + RING_OFF, g, S, E, F.wv);
#endif
            GRID_BAR();
        }
        if (IN(pb + 3)) {
            PHASE_ENTER();
            const float* sinkp = INP(I_SINK) + l * 8; const float* rpbp = INP(I_RPB) + (size_t)l * 8 * 15 * 31;
            const float* cw = INP(I_CONVW) + (size_t)l * 3 * BW;
            {
                const int ch = 8 * lane;
                float cwr[3][8];
#pragma unroll
                for (int k = 0; k < 3; ++k) { const f32x4 a = *(const f32x4*)(cw + k * BW + ch), b = *(const f32x4*)(cw + k * BW + ch + 4); cwr[k][0] = a.x; cwr[k][1] = a.y; cwr[k][2] = a.z; cwr[k][3] = a.w; cwr[k][4] = b.x; cwr[k][5] = b.y; cwr[k][6] = b.z; cwr[k][7] = b.w; }
#define CONV_U(row, u) do { const bf16* zp_ = ZM + (size_t)(row) * ZMC; const v4u a_ = *(const v4u*)(zp_ + C_UX + ch), g_ = *(const v4u*)(zp_ + C_GC + ch); \
                    u[0] = bflo(a_.x) * bflo(g_.x); u[1] = bfhi(a_.x) * bfhi(g_.x); u[2] = bflo(a_.y) * bflo(g_.y); u[3] = bfhi(a_.y) * bfhi(g_.y); \
                    u[4] = bflo(a_.z) * bflo(g_.z); u[5] = bfhi(a_.z) * bfhi(g_.z); u[6] = bflo(a_.w) * bflo(g_.w); u[7] = bfhi(a_.w) * bfhi(g_.w); } while (0)
#define CONV_Z(u) do { _Pragma("unroll") for (int q_ = 0; q_ < 8; ++q_) u[q_] = 0.f; } while (0)
#define CONV_OUT(t) do { const v4u gbv = *(const v4u*)(ZM + (size_t)(t) * ZMC + C_GB + ch); \
                    const float gb[8] = {bflo(gbv.x), bfhi(gbv.x), bflo(gbv.y), bfhi(gbv.y), bflo(gbv.z), bfhi(gbv.z), bflo(gbv.w), bfhi(gbv.w)}; float o[8]; \
                    _Pragma("unroll") for (int q = 0; q < 8; ++q) o[q] = gb[q] * (cwr[0][q] * um[q] + cwr[1][q] * uc[q] + cwr[2][q] * up[q]); \
                    v4u w; w.x = pk2(o[0], o[1]); w.y = pk2(o[2], o[3]); w.z = pk2(o[4], o[5]); w.w = pk2(o[6], o[7]); \
                    *(v4u*)(OB + (size_t)(t) * BW + ch) = w; } while (0)
                const int cchunk = (TL + NGW - 1) / NGW;
                const int t0 = min(gw * cchunk, TL), t1 = min(TL, t0 + cchunk);
                if (t0 < t1) {
                    float um[8], uc[8], up[8];
                    if ((t0 & (SEQ - 1)) > 0) CONV_U(t0 - 1, um); else CONV_Z(um);
                    CONV_U(t0, uc);
                    for (int t = t0; t < t1; ++t) {
                        const int s = t & (SEQ - 1);
                        if (s == 0) CONV_Z(um);
                        if (s + 1 < SEQ) CONV_U(t + 1, up); else CONV_Z(up);
                        CONV_OUT(t);
#pragma unroll
                        for (int q = 0; q < 8; ++q) { um[q] = uc[q]; uc[q] = up[q]; }
                    }
                }
                for (int t = TL + gw; t < rows_out; t += NGW) {
                    const int s = (t - TL) & (CTXL - 1);
                    float um[8], uc[8], up[8];
                    if (s > 0) CONV_U(t - 1, um); else CONV_Z(um);
                    CONV_U(t, uc);
                    if (s + 1 < CTXL) CONV_U(t + 1, up); else CONV_Z(up);
                    CONV_OUT(t);
                }
#undef CONV_U
#undef CONV_Z
#undef CONV_OUT
            }
            at::attn_phase(F.lds + RING_OFF, ZM, OA, OC, sinkp, rpbp, F.vcu, F.G, ctx_out, tid_, wave, lane);
#ifdef MK_ATTN_PROBE
            at::attn_phase<MK_ATTN_PROBE>(F.lds + RING_OFF, ZM, (bf16*)(GAS bf16*)(ws + WS_HX), (bf16*)(GAS bf16*)(ws + WS_HX) + (size_t)TA * BW, sinkp, rpbp, F.vcu, F.G, ctx_out, tid_, wave, lane);
#endif
            GRID_BAR();
        }
        if (IN(pb + 4)) {
            PHASE_ENTER();
            pg8::Gemm g{OA, W_BR + (size_t)l * 3 * D * BW, rows_out, D, BW};
            pg8::BranchOrder3 S; S.so.init(rows_out, D, F.G, (int)blockIdx.x, MK_WGM);
            pg8::EpiBranchAcc E{HX, ZG};
            pg8::gemm_phase<pg8::EpiBranchAcc, pg8::BranchOrder3, PG8_ALIGN, PG8_SP2>(F.lds + RING_OFF, g, S, E, F.wv);
            MOE_TAIL(0, MK_MT_A);
            GRID_BAR();
        }
        if (IN(pb + 5)) {
            PHASE_ENTER();
            pg8::Gemm g{HX, W_OUT + (size_t)l * D * D, rows_out, D, D}; pg8::StaticOrder S; S.init(rows_out, D, F.G, (int)blockIdx.x, MK_WGM);
            pg8::EpiBf16P E{Y16, D};
            pg8::gemm_phase<pg8::EpiBf16P, pg8::StaticOrder, PG8_ALIGN, PG8_SP2>(F.lds + RING_OFF, g, S, E, F.wv);
            GRID_BAR();
        }
        if (IN(pb + 6)) {
            PHASE_ENTER();
            if (!moe) {
                const int chunk = (TL + NGW - 1) / NGW;
#define P6_ROW(t) do { f32x4 x[4], y[4], h[4]; \
                    if (l == 0) row_load((t) < TL ? INP(I_X) + (size_t)(t) * D : INP(I_CTX) + (size_t)((t) - TL) * D, lane, x); else row_load_bf16(RS + (size_t)(t) * D, lane, x); \
                    row_load_bf16(Y16 + (size_t)(t) * D, lane, y); const float ry = row_rrms(y); \
                    _Pragma("unroll") for (int j = 0; j < 4; ++j) x[j] = x[j] + gt[j] * (y[j] * ry * gpo[j]); \
                    row_store_bf16(RS + (size_t)(t) * D, lane, x); const float rx = row_rrms(x); row_normmod(x, rx, gpre, sh, sc, h); \
                    if (MK_DENSE_F8 >= 2) row_store_fp8((unsigned char*)HX + (size_t)(t) * D, lane, h, SC_XG); else row_store_bf16(HX + (size_t)(t) * D, lane, h); } while (0)
                f32x4 gpo[4], gt[4], gpre[4], sh[4], sc[4]; vec_load(INP(I_GPOSTMIX) + l * D, lane, gpo); vec_load(INP(I_GPREFFN) + l * D, lane, gpre);
                for (int t0 = min(gw * chunk, TL), t1 = min(TL, t0 + chunk); t0 < t1; ) { const int bb = t0 >> 13, te = min(t1, (bb + 1) << 13); const float* md = modl + (size_t)bb * 6144;
                    vec_load(md + 2048, lane, gt); vec_load(md + 3072, lane, sh); vec_load(md + 4096, lane, sc);
                    for (int t = t0; t < te; ++t) P6_ROW(t);
                    t0 = te; }
                if (rows_out > TL) { const float* md = modl + (size_t)4 * 6144; vec_load(md + 2048, lane, gt); vec_load(md + 3072, lane, sh); vec_load(md + 4096, lane, sc); for (int t = TL + gw; t < rows_out; t += NGW) P6_ROW(t); }
#undef P6_ROW
            } else {
                LAS int* sel = (LAS int*)(F.lds + RING_OFF);
                LAS int* rnk = sel + 256;
                LAS f32x4* wrT = (LAS f32x4*)(F.lds + RING_OFF + 4096);
                const float* wr = INP(I_WROUTER) + (size_t)(l >> 1) * D * NE; const float* br = INP(I_BROUTER) + (l >> 1) * NE;
                for (int u = tid_; u < D * NE; u += NWAVES * 64) ((LAS float*)wrT)[(u & 7) * D + (u >> 3)] = wr[u];
                LDS_WAIT(); __syncthreads();
                f32x4 gpo[4], gt[4], gpre[4], sh[4], sc[4]; vec_load(INP(I_GPOSTMIX) + l * D, lane, gpo); vec_load(INP(I_GPREFFN) + l * D, lane, gpre);
                for (int slab = F.vcu; slab < TL / 128; slab += F.G) {
                    { const float* md = modl + (size_t)((slab * 128) >> 13) * 6144; vec_load(md + 2048, lane, gt); vec_load(md + 3072, lane, sh); vec_load(md + 4096, lane, sc); }
                    for (int i = 0; i < 16; ++i) {
                        const int tl_ = wave * 16 + i, t = slab * 128 + tl_;
                        f32x4 x[4], y[4], h[4]; if (l == 0) row_load(INP(I_X) + (size_t)t * D, lane, x); else row_load_bf16(RS + (size_t)t * D, lane, x);
                        row_load_bf16(Y16 + (size_t)t * D, lane, y);
                        const float ry = row_rrms(y);
#pragma unroll
                        for (int j = 0; j < 4; ++j) x[j] = x[j] + gt[j] * (y[j] * ry * gpo[j]);
                        row_store_bf16(RS + (size_t)t * D, lane, x);
                        const float rx = row_rrms(x);
                        row_normmod(x, rx, gpre, sh, sc, h);
                        row_store_fp8((unsigned char*)HX + (size_t)t * D, lane, h, SC_XG);
                        float lg[8];
#pragma unroll
                        for (int e = 0; e < 8; ++e) lg[e] = 0.f;
#pragma unroll
                        for (int e = 0; e < 8; ++e)
#pragma unroll
                            for (int j = 0; j < 4; ++j) { const f32x4 w4 = wrT[e * (D / 4) + 2 * (64 * (j >> 1) + lane) + (j & 1)]; lg[e] += (h[j].x * w4.x + h[j].y * w4.y) + (h[j].z * w4.z + h[j].w * w4.w); }
#pragma unroll
                        for (int e = 0; e < 8; ++e) lg[e] = wave_sum(lg[e]) + br[e];
                        int e1 = 0; float v1 = lg[0];
#pragma unroll
                        for (int e = 1; e < 8; ++e) if (lg[e] > v1) { v1 = lg[e]; e1 = e; }
                        int e2 = -1; float v2 = -INFINITY;
#pragma unroll
                        for (int e = 0; e < 8; ++e) if (e != e1 && lg[e] > v2) { v2 = lg[e]; e2 = e; }
                        const float ex = __expf(v2 - v1), g1 = 1.0f / (1.0f + ex), g2 = ex / (1.0f + ex);
                        if (lane == 0) { sel[2 * tl_] = e1; sel[2 * tl_ + 1] = e2; TOKG[2 * (size_t)t] = g1; TOKG[2 * (size_t)t + 1] = g2; }
                    }
                    LDS_WAIT(); __syncthreads();
                    if (tid_ < 8) { int cnt = 0; for (int q = 0; q < 256; ++q) if (sel[q] == tid_) { rnk[q] = cnt; ++cnt; } SLABCNT[slab * 8 + tid_] = cnt; }
                    LDS_WAIT(); __syncthreads();
                    if (tid_ < 256) TOKER[(size_t)slab * 256 + tid_] = sel[tid_] | (rnk[tid_] << 8);
                    LDS_WAIT(); __syncthreads();
                }
            }
            GRID_BAR();
        }
        if (IN(pb + 7) && moe) {
            PHASE_ENTER();
            LAS int* scn = (LAS int*)(F.lds + RING_OFF);
            LAS int* pst = scn + 2048;
            for (int u = tid_; u < 2048; u += NWAVES * 64) scn[u] = SLABCNT[u];
            LDS_WAIT(); __syncthreads();
            if (tid_ < 8) { int run = 0; for (int q = 0; q < 256; ++q) { const int c = scn[q * 8 + tid_]; scn[q * 8 + tid_] = run; run += c; } pst[8 + tid_] = run; }
            LDS_WAIT(); __syncthreads();
            if (tid_ == 0) { int pan = 0; for (int e = 0; e < 8; ++e) { pst[e] = pan * 256; if (blockIdx.x == 0) PCUM[e] = pan; pan += (pst[8 + e] + 255) >> 8; } if (blockIdx.x == 0) PCUM[8] = pan; }
            LDS_WAIT(); __syncthreads();
            LAS int* posl = pst + 16;
            for (int slab = F.vcu; slab < TL / 128; slab += F.G) {
                if (tid_ < 256) { const int er = TOKER[(size_t)slab * 256 + tid_]; const int e = er & 255, rk = er >> 8; const int pos = pst[e] + scn[slab * 8 + e] + rk;
                    posl[tid_] = pos; TOKPOS[(size_t)slab * 256 + tid_] = pos; }
                LDS_WAIT(); __syncthreads();
                const v4u* srcb = (const v4u*)((const unsigned char*)HX + (size_t)slab * 128 * D);
#pragma unroll 4
                for (int i = 0; i < 16; ++i) { const int id = i * 512 + tid_, tk = id >> 6, chk = id & 63;
                    const v4u o = srcb[(size_t)tk * 64 + chk];
                    ((v4u*)(XG8 + (size_t)posl[2 * tk] * D))[chk] = o; ((v4u*)(XG8 + (size_t)posl[2 * tk + 1] * D))[chk] = o; }
                LDS_WAIT(); __syncthreads();
            }
            GRID_BAR();
        }
        if (IN(pb + 8) && !moe) {
            PHASE_ENTER();
            pg8::Gemm g{HX, W_GUD, rows_out, 2 * FFD, D}; pg8::StaticOrder S; S.init(rows_out, 2 * FFD, F.G, (int)blockIdx.x, MK_WGM);
#if MK_DENSE_F8 >= 2
            pg8::EpiSwiglu8T<true> E{(unsigned char*)HD, FFD, 1.0f / (SC_XG * SC_WGU), SC_H};
            pg8::gemm_phase<pg8::EpiSwiglu8T<true>, pg8::StaticOrder, PG8_ALIGN, PG8_SP2>(F.lds + RING_OFF, g, S, E, F.wv);
#elif MK_DENSE_F8 == 1
            pg8::EpiSwiglu8T<false> E{(unsigned char*)HD, FFD, 1.0f, SC_H};
            pg8::gemm_phase<pg8::EpiSwiglu8T<false>, pg8::StaticOrder, PG8_ALIGN, PG8_SP2>(F.lds + RING_OFF, g, S, E, F.wv);
#else
            pg8::EpiSwiglu E{HD, FFD};
            pg8::gemm_phase<pg8::EpiSwiglu, pg8::StaticOrder, PG8_ALIGN, PG8_SP2>(F.lds + RING_OFF, g, S, E, F.wv);
#endif
            GRID_BAR();
        }
        if (IN(pb + 9) && !moe) {
            PHASE_ENTER();
            pg8::Gemm g{HD, W_DND, rows_out, D, FFD}; pg8::StaticOrder S; S.init(rows_out, D, F.G, (int)blockIdx.x, MK_WGM);
#if MK_DENSE_F8 >= 1
            pg8::EpiBf16PS8 E{Y16, D, 1.0f / (SC_H * SC_WDN)};
            pg8::gemm_phase<pg8::EpiBf16PS8, pg8::StaticOrder, PG8_ALIGN, PG8_SP2>(F.lds + RING_OFF, g, S, E, F.wv);
#else
            pg8::EpiBf16P E{Y16, D};
            pg8::gemm_phase<pg8::EpiBf16P, pg8::StaticOrder, PG8_ALIGN, PG8_SP2>(F.lds + RING_OFF, g, S, E, F.wv);
#endif
            MOE_TAIL(MK_MT_A, MOE_ITEMS);
            GRID_BAR();
        }
        if (moe) {
            for (int ck = 0; ck < NCHUNK; ++ck) {
                if (IN(pb + 10 + 2 * ck)) {
                    PHASE_ENTER();
                    pg8::MoeOrder S; S.nN = 2 * FFE / 256; S.G = F.G; S.c = F.vcu; S.p_lo = ck * PCH;
#pragma unroll
                    for (int k = 0; k < 8; ++k) S.pc[k] = __builtin_amdgcn_readfirstlane(PCUM[k]);
                    const int ptot = __builtin_amdgcn_readfirstlane(PCUM[8]); S.np = min(max(ptot - ck * PCH, 0), PCH);
                    pg8::Gemm g{(const bf16*)XG8, (const bf16*)W_GUM8, 0, 2 * FFE, D};
                    pg8::EpiSwiglu8 E{HM8, FFE, 1.0f / (SC_XG * SC_WGU), SC_H};
                    pg8::gemm_phase<pg8::EpiSwiglu8, pg8::MoeOrder, PG8_ALIGN, PG8_SP2>(F.lds + RING_OFF, g, S, E, F.wv);
                    GRID_BAR();
                }
                if (IN(pb + 11 + 2 * ck)) {
                    PHASE_ENTER();
                    pg8::MoeOrder S; S.nN = D / 256; S.G = F.G; S.c = F.vcu; S.p_lo = ck * PCH;
#pragma unroll
                    for (int k = 0; k < 8; ++k) S.pc[k] = __builtin_amdgcn_readfirstlane(PCUM[k]);
                    const int ptot = __builtin_amdgcn_readfirstlane(PCUM[8]); S.np = min(max(ptot - ck * PCH, 0), PCH);
                    pg8::Gemm g{(const bf16*)HM8, (const bf16*)W_DNM8, 0, D, FFE};
                    pg8::EpiBf16PS8 E{XG, D, 1.0f / (SC_H * SC_WDN)};
                    pg8::gemm_phase<pg8::EpiBf16PS8, pg8::MoeOrder, PG8_ALIGN, PG8_SP2>(F.lds + RING_OFF, g, S, E, F.wv);
                    GRID_BAR();
                }
            }
        }
        if (IN(pb + 16)) {
            PHASE_ENTER();
            const int chunk = (TL + NGW - 1) / NGW; const bool nextl = (l + 1 < DEPTH);
#define P9_ROW(t) do { f32x4 x[4], y[4]; row_load_bf16(RS + (size_t)(t) * D, lane, x); \
                if (!moe) row_load_bf16(Y16 + (size_t)(t) * D, lane, y); \
                else { const int p0 = TOKPOS[2 * (size_t)(t)], p1 = TOKPOS[2 * (size_t)(t) + 1]; const float g0 = TOKG[2 * (size_t)(t)], g1 = TOKG[2 * (size_t)(t) + 1]; \
                    f32x4 ya[4], yb[4]; row_load_bf16(XG + (size_t)p0 * D, lane, ya); row_load_bf16(XG + (size_t)p1 * D, lane, yb); \
                    _Pragma("unroll") for (int j = 0; j < 4; ++j) y[j] = ya[j] * g0 + yb[j] * g1; } \
                const float ry = row_rrms(y); \
                _Pragma("unroll") for (int j = 0; j < 4; ++j) x[j] = x[j] + gt[j] * (y[j] * ry * gpo[j]); \
                if (nextl) row_store_bf16(RS + (size_t)(t) * D, lane, x); else if ((t) < TL) row_store(outp + (size_t)(t) * D, lane, x); \
                if (nextl) { f32x4 h[4]; const float rx = row_rrms(x); row_normmod(x, rx, gpre, sh, sc, h); if (MK_GATE_F8 < 2) row_store_bf16(HX + (size_t)(t) * D, lane, h); if (MK_GATE_F8) row_store_fp8(HX8 + (size_t)(t) * D, lane, h, SC_XG); } } while (0)
            f32x4 gpo[4], gt[4], gpre[4], sh[4], sc[4]; vec_load(INP(I_GPOSTFFN) + l * D, lane, gpo); vec_load(INP(I_GPREMIX) + (nextl ? l + 1 : l) * D, lane, gpre);
            for (int t0 = min(gw * chunk, TL), t1 = min(TL, t0 + chunk); t0 < t1; ) { const int bb = t0 >> 13, te = min(t1, (bb + 1) << 13); const float* md = modl + (size_t)bb * 6144;
                vec_load(md + 5120, lane, gt); vec_load(md + (nextl ? 5 * 6144 : 0), lane, sh); vec_load(md + (nextl ? 5 * 6144 : 0) + 1024, lane, sc);
                for (int t = t0; t < te; ++t) P9_ROW(t);
                t0 = te; }
            if (rows_out > TL) { const float* md = modl + (size_t)4 * 6144; vec_load(md + 5120, lane, gt); vec_load(md + (nextl ? 5 * 6144 : 0), lane, sh); vec_load(md + (nextl ? 5 * 6144 : 0) + 1024, lane, sc);
                for (int t = TL + gw; t < rows_out; t += NGW) P9_ROW(t); }
#undef P9_ROW
            if (l + 1 < DEPTH) GRID_BAR();
        }
    }
#undef IN
#undef GRID_BAR
}

extern "C" void kernel_launch(void* const* d_in, const int* in_sizes, int n_in, void* d_out, int out_size, void* d_ws, size_t ws_size, hipStream_t stream) {
    static int grid = 0;
    if (grid == 0) {
        if (n_in != 23 || in_sizes[0] != TL * D || out_size != TL * D || ws_size < WS_END) { fprintf(stderr, "kernel_launch: unexpected shapes: n_in %d in0 %d out %d ws %zu (need %zu); nothing launched\n", n_in, n_in > 0 ? in_sizes[0] : -1, out_size, ws_size, (size_t)WS_END); grid = -1; return; }
        int dev = 0, cus = 0, per_cu = 0;
        if (hipGetDevice(&dev) != hipSuccess || hipDeviceGetAttribute(&cus, hipDeviceAttributeMultiprocessorCount, dev) != hipSuccess) { fprintf(stderr, "kernel_launch: device query failed\n"); grid = -1; return; }
        if (hipFuncSetAttribute((const void*)mk_fwd, hipFuncAttributeMaxDynamicSharedMemorySize, LDS_BYTES) != hipSuccess) { fprintf(stderr, "kernel_launch: hipFuncSetAttribute failed\n"); grid = -1; return; }
        if (hipOccupancyMaxActiveBlocksPerMultiprocessor(&per_cu, (const void*)mk_fwd, NWAVES * 64, LDS_BYTES) != hipSuccess || per_cu < 1) fprintf(stderr, "kernel_launch: note: occupancy query reports %d\n", per_cu);
        (void)hipGetLastError();
        grid = cus;
    }
    if (grid < 0) return;
    if (hipMemsetAsync((char*)d_ws + WS_CTL, 0, CTL_ZERO_BYTES, stream) != hipSuccess) { fprintf(stderr, "kernel_launch: memset failed\n"); return; }
    Args a{};
    for (int i = 0; i < 23; ++i) a.in[i] = (const float*)d_in[i];
    a.out = (float*)d_out; a.ws = (unsigned char*)d_ws;
#if MK_PER_PHASE
    for (int ph = 0; ph < NPHASES; ++ph) { a.ph_lo = ph; a.ph_hi = ph + 1; hipLaunchKernelGGL(mk_fwd, dim3(grid), dim3(NWAVES * 64), LDS_BYTES, stream, a); }
#else
    a.ph_lo = 0; a.ph_hi = NPHASES;
    hipLaunchKernelGGL(mk_fwd, dim3(grid), dim3(NWAVES * 64), LDS_BYTES, stream, a);
#endif
    const hipError_t le = hipPeekAtLastError();
    if (le != hipSuccess) fprintf(stderr, "kernel_launch: launch failed: %s\n", hipGetErrorName(le));
}
```

```cpp
#include <hip/hip_runtime.h>
#include <cstdio>
#include <cstdint>
#ifndef MK_GATE_U8
#define MK_GATE_U8 1
#endif
#ifndef MK_GATE_F8
#define MK_GATE_F8 1
#endif

__device__ __forceinline__ int mk_lane() { unsigned z; asm volatile("s_mov_b32 %0, 0" : "=s"(z)); return (int)__builtin_amdgcn_mbcnt_hi(~0u, __builtin_amdgcn_mbcnt_lo(~0u, z)); }
template <int CTRL, int ROWMASK = 0xf> __device__ __forceinline__ float mk_dpp(float v) { return __builtin_bit_cast(float, __builtin_amdgcn_update_dpp(0, __builtin_bit_cast(int, v), CTRL, ROWMASK, 0xf, false)); }
__device__ __forceinline__ float mk_xor32(float v, bool upper) { const auto rr = __builtin_amdgcn_permlane32_swap(__builtin_bit_cast(unsigned, v), __builtin_bit_cast(unsigned, v), false, false); return __builtin_bit_cast(float, upper ? rr[0] : rr[1]); }
__device__ __forceinline__ int mk_xor16(int v) { return __builtin_amdgcn_ds_swizzle(v, 0x401F); }

namespace pg8 {
#define PG8_LAS __attribute__((address_space(3)))
typedef unsigned short bf16_t;
typedef short bf16x8 __attribute__((ext_vector_type(8)));
typedef float f32x4 __attribute__((ext_vector_type(4)));
typedef unsigned u32x4 __attribute__((ext_vector_type(4)));
typedef unsigned u32x2 __attribute__((ext_vector_type(2)));
typedef int v8i32 __attribute__((ext_vector_type(8)));
constexpr int BM = 256, BK = 64, HALF = 128, HTB = HALF * BK * 2  , STAGE_BYTES = 8 * HTB, NXCD = 8, WGM = 8;

__host__ __device__ __forceinline__ int lds_byte(int r, int c) { const int st = (r >> 4) * 2 + (c >> 5), rr = r & 15, cc = c & 31, ob = rr * 64 + cc * 2; return st * 1024 + (ob ^ (((ob >> 9) & 1) << 5)); }
__host__ __device__ __forceinline__ void stage_rc(int b, int& R, int& C) { const int st = b / 1024, sb = b % 1024, swz = sb ^ (((sb >> 9) & 1) << 5); R = (st >> 1) * 16 + swz / 64; C = (st & 1) * 32 + (swz % 64) / 2; }
__host__ __device__ __forceinline__ int perm32(int rho) { const int n = rho >> 4, i = rho & 15; return 8 * (i >> 2) + 4 * n + (i & 3); }

struct Unit { int pm, pn, pb; };
struct Gemm { const bf16_t* A; const bf16_t* Bt; int M, N, K; };

struct StaticOrder {
    int nM, nN, nwg, G, c, wgm;
    __host__ __device__ void init(int M, int N, int G_, int c_, int wgm_ = WGM) { nM = M / BM; nN = N / BM; nwg = nM * nN; G = G_; c = c_; wgm = wgm_; }
    __host__ __device__ bool next(int i, Unit& u) const {
        const long L = (long)i * G + c; if (L >= nwg) return false;
        int wgid = (int)L; { const int q = nwg / NXCD, r = nwg % NXCD, xcd = wgid % NXCD, off = wgid / NXCD; wgid = (xcd < r ? xcd * (q + 1) : r * (q + 1) + (xcd - r) * q) + off; }
        const int nig = wgm * nN, gid = wgid / nig, fm = gid * wgm, gsz = (nM - fm) < wgm ? (nM - fm) : wgm;
        u.pm = fm + ((wgid % nig) % gsz); u.pn = (wgid % nig) / gsz; u.pb = u.pn; return true;
    }
    __device__ __forceinline__ void a_ready(const Unit&) const {}
    __device__ __forceinline__ void done(const Unit&) const {}
};

struct MapOrder {
    StaticOrder so; int cut, add;
    __device__ __forceinline__ bool next(int i, Unit& u) const { if (!so.next(i, u)) return false; u.pb = u.pn; if (u.pn >= cut) u.pn += add; return true; }
    __device__ __forceinline__ void a_ready(const Unit&) const {}
    __device__ __forceinline__ void done(const Unit&) const {}
};
__device__ __forceinline__ unsigned cvt_pk_bf16(float lo, float hi) { unsigned r; asm volatile("v_cvt_pk_bf16_f32 %0, %1, %2" : "=v"(r) : "v"(lo), "v"(hi)); return r; }
__device__ __forceinline__ float bf_lo(unsigned w) { return __uint_as_float(w << 16); }
__device__ __forceinline__ float bf_hi(unsigned w) { return __uint_as_float(w & 0xffff0000u); }
__device__ __forceinline__ unsigned pk4_fp8(float a, float b, float c, float d) { int w = __builtin_amdgcn_cvt_pk_fp8_f32(a, b, 0, false); w = __builtin_amdgcn_cvt_pk_fp8_f32(c, d, w, true); return (unsigned)w; }
__device__ __forceinline__ float clamp_fp8(float v) { return fminf(fmaxf(v, -448.0f), 448.0f); }
__device__ __forceinline__ float sigmoidf_(float x) { return __builtin_amdgcn_rcpf(1.0f + __builtin_amdgcn_exp2f(x * -1.4426950408889634f)); }

template <bool OPF8> struct EpiZT {
    static constexpr bool PERM = true, AFTER_DRAIN = false, HALFN = false, F8 = OPF8, RWACC = false;
    bf16_t* ZM; bf16_t* ZG; const float* rope; int n_lat_panels; const float* bgate; int pn_off; float gs;
    __device__ __forceinline__ void operator()(const f32x4 (&acc)[2][2][4][2], const Unit& u, int wr, int wc, int fr, int fq) const {
        const int row0 = u.pm * BM + wr * 64 + fr; int colt = (u.pn + pn_off) * BM; bf16_t* base = ZM; int ldc = 3840; bool isg = false;
        if (colt >= 3840) { base = ZG; colt -= 3840; ldc = 3072; isg = true; }
        const int col0 = colt + wc * 32 + 8 * fq;
        f32x4 gb[2][2];
        if (isg) {
#pragma unroll
            for (int bj = 0; bj < 2; ++bj) { gb[bj][0] = *(const f32x4*)(bgate + col0 + bj * HALF); gb[bj][1] = *(const f32x4*)(bgate + col0 + bj * HALF + 4); } }
        const int nrope = (u.pm < n_lat_panels) ? (u.pn + pn_off < 2 ? 2 : (u.pn + pn_off == 2 ? 1 : 0)) : 0;
#pragma unroll
        for (int ai = 0; ai < 2; ++ai)
#pragma unroll
            for (int m = 0; m < 4; ++m) { const int row = row0 + ai * HALF + m * 16; bf16_t* rowp = base + (size_t)row * ldc + col0;
                f32x4 cs[4];
                if (nrope) { const int s = row & 8191, pidx = (wc & 1) ? 128 + (s & 63) : (s >> 6); const f32x4* cp = (const f32x4*)(rope + (size_t)(pidx * 16 + 8 * (fq & 1)) * 2);
                    cs[0] = cp[0]; cs[1] = cp[1]; cs[2] = cp[2]; cs[3] = cp[3]; }
#pragma unroll
                for (int bj = 0; bj < 2; ++bj) { f32x4 v0 = acc[ai][bj][m][0], v1 = acc[ai][bj][m][1];
                    if (OPF8 && !isg) { v0 *= gs; v1 *= gs; }
                    if (isg) {
#pragma unroll
                        for (int j = 0; j < 4; ++j) { v0[j] = sigmoidf_(fminf(fmaxf(v0[j] * gs + gb[bj][0][j], -30.f), 30.f)); v1[j] = sigmoidf_(fminf(fmaxf(v1[j] * gs + gb[bj][1][j], -30.f), 30.f)); } }
                    if (bj < nrope) { const float sg = (fq >> 1) ? 1.f : -1.f;
                        float v[8] = {v0[0], v0[1], v0[2], v0[3], v1[0], v1[1], v1[2], v1[3]}, o[8];
#pragma unroll
                        for (int j = 0; j < 8; ++j) { const float pv = mk_xor32(v[j], (fq >> 1) != 0); const float c_ = cs[j >> 1][(j & 1) * 2], s_ = cs[j >> 1][(j & 1) * 2 + 1]; o[j] = v[j] * c_ + sg * pv * s_; }
                        v0 = (f32x4){o[0], o[1], o[2], o[3]}; v1 = (f32x4){o[4], o[5], o[6], o[7]}; }
                    if (MK_GATE_U8 && isg) {
                        unsigned b0 = 0u, b1 = 0u;
#pragma unroll
                        for (int j = 0; j < 4; ++j) { b0 = __builtin_amdgcn_cvt_pk_u8_f32(fmaxf(v0[j] * 255.f, 1.f), j, b0); b1 = __builtin_amdgcn_cvt_pk_u8_f32(fmaxf(v1[j] * 255.f, 1.f), j, b1); }
                        u32x2 w8; w8.x = b0; w8.y = b1;
                        *(u32x2*)((unsigned char*)ZG + (size_t)row * 3072 + col0 + bj * HALF) = w8;
                        continue; }
                    u32x4 w; w.x = cvt_pk_bf16(v0[0], v0[1]); w.y = cvt_pk_bf16(v0[2], v0[3]); w.z = cvt_pk_bf16(v1[0], v1[1]); w.w = cvt_pk_bf16(v1[2], v1[3]);
                    *(u32x4*)(rowp + bj * HALF) = w; } }
    }
};
typedef EpiZT<false> EpiZ;

template <bool OPF8> struct EpiZMT {
    static constexpr bool PERM = true, AFTER_DRAIN = false, HALFN = false, F8 = OPF8, RWACC = false;
    bf16_t* ZM; const PG8_LAS float* rope; int n_lat_panels; float gs; int pn_off;
    __device__ __forceinline__ void operator()(const f32x4 (&acc)[2][2][4][2], const Unit& u, int wr, int wc, int fr, int fq) const {
        const int pnr = u.pn + pn_off;
        const int row0 = u.pm * BM + wr * 64 + fr; const int col0 = pnr * BM + wc * 32 + 8 * fq;
        const int nrope = (u.pm < n_lat_panels) ? (pnr < 2 ? 2 : (pnr == 2 ? 1 : 0)) : 0;
#pragma unroll
        for (int ai = 0; ai < 2; ++ai)
#pragma unroll
            for (int m = 0; m < 4; ++m) { const int row = row0 + ai * HALF + m * 16; bf16_t* rowp = ZM + (size_t)row * 3840 + col0;
                f32x4 cs[4];
                if (nrope) { const int s = row & 8191, pidx = (wc & 1) ? 128 + (s & 63) : (s >> 6); const PG8_LAS f32x4* cp = (const PG8_LAS f32x4*)(rope + (pidx * 16 + 8 * (fq & 1)) * 2);
                    cs[0] = cp[0]; cs[1] = cp[1]; cs[2] = cp[2]; cs[3] = cp[3]; }
#pragma unroll
                for (int bj = 0; bj < 2; ++bj) { f32x4 v0 = acc[ai][bj][m][0], v1 = acc[ai][bj][m][1];
                    if (OPF8) { v0 *= gs; v1 *= gs; }
                    if (bj < nrope) { const float sg = (fq >> 1) ? 1.f : -1.f;
                        float v[8] = {v0[0], v0[1], v0[2], v0[3], v1[0], v1[1], v1[2], v1[3]}, o[8];
#pragma unroll
                        for (int j = 0; j < 8; ++j) { const float pv = mk_xor32(v[j], (fq >> 1) != 0); const float c_ = cs[j >> 1][(j & 1) * 2], s_ = cs[j >> 1][(j & 1) * 2 + 1]; o[j] = v[j] * c_ + sg * pv * s_; }
                        v0 = (f32x4){o[0], o[1], o[2], o[3]}; v1 = (f32x4){o[4], o[5], o[6], o[7]}; }
                    u32x4 w; w.x = cvt_pk_bf16(v0[0], v0[1]); w.y = cvt_pk_bf16(v0[2], v0[3]); w.z = cvt_pk_bf16(v1[0], v1[1]); w.w = cvt_pk_bf16(v1[2], v1[3]);
                    *(u32x4*)(rowp + bj * HALF) = w; } }
    }
};
typedef EpiZMT<false> EpiZM;
struct EpiZGate {
    static constexpr bool PERM = true, AFTER_DRAIN = false, HALFN = false, F8 = true, RWACC = false;
    unsigned char* ZG; const float* bgate; float gs;
    __device__ __forceinline__ void operator()(const f32x4 (&acc)[2][2][4][2], const Unit& u, int wr, int wc, int fr, int fq) const {
        const int row0 = u.pm * BM + wr * 64 + fr; const int colb = u.pn * BM + wc * 32; const int odd = fq & 1;
        f32x4 gb[2][2];
#pragma unroll
        for (int bj = 0; bj < 2; ++bj) { gb[bj][0] = *(const f32x4*)(bgate + colb + 8 * fq + bj * HALF); gb[bj][1] = *(const f32x4*)(bgate + colb + 8 * fq + bj * HALF + 4); }
#pragma unroll
        for (int ai = 0; ai < 2; ++ai)
#pragma unroll
            for (int mp = 0; mp < 2; ++mp)
#pragma unroll
                for (int bj = 0; bj < 2; ++bj) {
                    unsigned w[2][2];
#pragma unroll
                    for (int k = 0; k < 2; ++k) { const int m = 2 * mp + k; const f32x4 v0 = acc[ai][bj][m][0], v1 = acc[ai][bj][m][1]; unsigned b0 = 0u, b1 = 0u;
#pragma unroll
                        for (int j = 0; j < 4; ++j) { const float g0 = sigmoidf_(fminf(fmaxf(v0[j] * gs + gb[bj][0][j], -30.f), 30.f)), g1 = sigmoidf_(fminf(fmaxf(v1[j] * gs + gb[bj][1][j], -30.f), 30.f));
                            b0 = __builtin_amdgcn_cvt_pk_u8_f32(fmaxf(g0 * 255.f, 1.f), j, b0); b1 = __builtin_amdgcn_cvt_pk_u8_f32(fmaxf(g1 * 255.f, 1.f), j, b1); }
                        w[k][0] = b0; w[k][1] = b1; }
                    const unsigned s0 = odd ? w[0][0] : w[1][0], s1 = odd ? w[0][1] : w[1][1];
                    const unsigned r0 = (unsigned)mk_xor16((int)s0), r1 = (unsigned)mk_xor16((int)s1);
                    u32x4 st; if (odd) { st.x = r0; st.y = r1; st.z = w[1][0]; st.w = w[1][1]; } else { st.x = w[0][0]; st.y = w[0][1]; st.z = r0; st.w = r1; }
                    *(u32x4*)(ZG + (size_t)(row0 + ai * HALF + (2 * mp + odd) * 16) * 3072 + colb + 8 * (fq & 2) + bj * HALF) = st; }
    }
};
struct EpiBf16P {
    static constexpr bool PERM = true, AFTER_DRAIN = false, HALFN = false, F8 = false, RWACC = false;
    bf16_t* O; int ldc;
    __device__ __forceinline__ void operator()(const f32x4 (&acc)[2][2][4][2], const Unit& u, int wr, int wc, int fr, int fq) const {
        const int row0 = u.pm * BM + wr * 64 + fr; const int col0 = u.pn * BM + wc * 32 + 8 * fq;
#pragma unroll
        for (int ai = 0; ai < 2; ++ai)
#pragma unroll
            for (int m = 0; m < 4; ++m) { bf16_t* rowp = O + (size_t)(row0 + ai * HALF + m * 16) * ldc + col0;
#pragma unroll
                for (int bj = 0; bj < 2; ++bj) { const f32x4 v0 = acc[ai][bj][m][0], v1 = acc[ai][bj][m][1];
                    u32x4 w; w.x = cvt_pk_bf16(v0[0], v0[1]); w.y = cvt_pk_bf16(v0[2], v0[3]); w.z = cvt_pk_bf16(v1[0], v1[1]); w.w = cvt_pk_bf16(v1[2], v1[3]);
                    *(u32x4*)(rowp + bj * HALF) = w; } }
    }
};
template <bool OPF8> struct EpiBranchAccT {
    static constexpr bool PERM = true, AFTER_DRAIN = false, HALFN = false, F8 = OPF8, RWACC = true;
    bf16_t* MG; const bf16_t* ZG; int out8;
    __device__ __forceinline__ bool restart(const Unit& u) const { return u.pm >= 264; }
    __device__ __forceinline__ void rw(f32x4 (&acc)[2][2][4][2], const Unit& u, int wr, int wc, int fr, int fq) const {
        const int r = u.pm / 132, pmt = u.pm - 132 * r, rn = r < 2 ? r + 1 : r;
        const int row0 = pmt * BM + wr * 64 + fr, col0 = u.pn * BM + wc * 32 + 8 * fq;
        constexpr int PG8_GD = 4;
        u32x4 gp[PG8_GD][2], gn[PG8_GD][2];
        constexpr unsigned GB = MK_GATE_U8 ? 1u : 2u;
        const unsigned o0 = (unsigned)row0 * (3072u * GB) + (unsigned)col0 * GB;
        const char* zp = (const char*)ZG + (size_t)r * 1024 * GB; const char* zn = (const char*)ZG + (size_t)rn * 1024 * GB;
#if MK_GATE_U8
#define PG8_GLOAD(s, buf) do { const int bj_ = (s) >> 2, ai_ = ((s) >> 1) & 1, mb_ = ((s) & 1) * 2; _Pragma("unroll") for (int q_ = 0; q_ < 2; ++q_) { \
            const unsigned off_ = o0 + (unsigned)(ai_ * HALF + (mb_ + q_) * 16) * 3072u + (unsigned)(bj_ * HALF); \
            const u32x2 a_ = *(const u32x2*)(zp + off_), b_ = *(const u32x2*)(zn + off_); gp[buf][q_].x = a_.x; gp[buf][q_].y = a_.y; gn[buf][q_].x = b_.x; gn[buf][q_].y = b_.y; } } while (0)
#else
#define PG8_GLOAD(s, buf) do { const int bj_ = (s) >> 2, ai_ = ((s) >> 1) & 1, mb_ = ((s) & 1) * 2; _Pragma("unroll") for (int q_ = 0; q_ < 2; ++q_) { \
            const unsigned off_ = o0 + (unsigned)(ai_ * HALF + (mb_ + q_) * 16) * 6144u + (unsigned)(bj_ * HALF * 2); \
            gp[buf][q_] = *(const u32x4*)(zp + off_); gn[buf][q_] = *(const u32x4*)(zn + off_); } } while (0)
#endif
#pragma unroll
        for (int s = 0; s < PG8_GD - 1; ++s) PG8_GLOAD(s, s);
#pragma unroll
        for (int s = 0; s < 8; ++s) { const int bj = s >> 2, ai = (s >> 1) & 1, mb = (s & 1) * 2, col = col0 + bj * HALF;
            if (s + PG8_GD - 1 < 8) PG8_GLOAD(s + PG8_GD - 1, (s + PG8_GD - 1) % PG8_GD);
            __builtin_amdgcn_sched_barrier(0);
#pragma unroll
            for (int q = 0; q < 2; ++q) { const int m = mb + q; const size_t row = (size_t)(row0 + ai * HALF + m * 16);
                const u32x4 g0 = gp[s % PG8_GD][q], g1 = gn[s % PG8_GD][q];
#if MK_GATE_U8
#define PG8_UB(w_, k_) ((float)(((w_) >> (8 * (k_))) & 255u))
                const float x[8] = {PG8_UB(g0.x, 0), PG8_UB(g0.x, 1), PG8_UB(g0.x, 2), PG8_UB(g0.x, 3), PG8_UB(g0.y, 0), PG8_UB(g0.y, 1), PG8_UB(g0.y, 2), PG8_UB(g0.y, 3)};
#else
                const float x[8] = {bf_lo(g0.x), bf_hi(g0.x), bf_lo(g0.y), bf_hi(g0.y), bf_lo(g0.z), bf_hi(g0.z), bf_lo(g0.w), bf_hi(g0.w)};
#endif
                if (r < 2) {
#if MK_GATE_U8
                    const float y[8] = {PG8_UB(g1.x, 0), PG8_UB(g1.x, 1), PG8_UB(g1.x, 2), PG8_UB(g1.x, 3), PG8_UB(g1.y, 0), PG8_UB(g1.y, 1), PG8_UB(g1.y, 2), PG8_UB(g1.y, 3)};
#else
                    const float y[8] = {bf_lo(g1.x), bf_hi(g1.x), bf_lo(g1.y), bf_hi(g1.y), bf_lo(g1.z), bf_hi(g1.z), bf_lo(g1.w), bf_hi(g1.w)};
#endif
#pragma unroll
                    for (int j = 0; j < 8; ++j) acc[ai][bj][m][j >> 2][j & 3] *= x[j] * __builtin_amdgcn_rcpf(y[j]);
                } else {
                    float v[8];
#pragma unroll
                    for (int j = 0; j < 8; ++j) v[j] = acc[ai][bj][m][j >> 2][j & 3] * (MK_GATE_U8 ? x[j] * ((OPF8 ? 1.0f / (16.0f * 32.0f) : 1.0f) / 255.0f) : x[j] * (OPF8 ? 1.0f / (16.0f * 32.0f) : 1.0f));
                    if (out8) { u32x2 w8; w8.x = pk4_fp8(clamp_fp8(v[0] * 16.0f), clamp_fp8(v[1] * 16.0f), clamp_fp8(v[2] * 16.0f), clamp_fp8(v[3] * 16.0f)); w8.y = pk4_fp8(clamp_fp8(v[4] * 16.0f), clamp_fp8(v[5] * 16.0f), clamp_fp8(v[6] * 16.0f), clamp_fp8(v[7] * 16.0f));
                        *(u32x2*)((unsigned char*)MG + row * 1024 + col) = w8; }
                    else { u32x4 w; w.x = cvt_pk_bf16(v[0], v[1]); w.y = cvt_pk_bf16(v[2], v[3]); w.z = cvt_pk_bf16(v[4], v[5]); w.w = cvt_pk_bf16(v[6], v[7]);
                    *(u32x4*)(MG + row * 1024 + col) = w; }
                } }
        }
#undef PG8_GLOAD
    }
};
typedef EpiBranchAccT<false> EpiBranchAcc;
struct BranchOrder3 {
    StaticOrder so;
    __device__ __forceinline__ bool next(int i, Unit& u) const {
        const int ti = i / 3, r = i - 3 * ti; if (!so.next(ti, u)) return false;
        u.pb = 4 * r + u.pn; u.pm += 132 * r; return true;
    }
    __device__ __forceinline__ void a_ready(const Unit&) const {}
    __device__ __forceinline__ void done(const Unit&) const {}
};
struct EpiSwiglu {
    static constexpr bool PERM = true, AFTER_DRAIN = false, HALFN = false, F8 = false, RWACC = false;
    bf16_t* H; int ldh;
    __device__ __forceinline__ void operator()(const f32x4 (&acc)[2][2][4][2], const Unit& u, int wr, int wc, int fr, int fq) const {
        const int row0 = u.pm * BM + wr * 64 + fr; const int col0 = u.pn * HALF + wc * 32 + 8 * fq;
#pragma unroll
        for (int ai = 0; ai < 2; ++ai)
#pragma unroll
            for (int m = 0; m < 4; ++m) { bf16_t* rowp = H + (size_t)(row0 + ai * HALF + m * 16) * ldh + col0;
                float h[8];
#pragma unroll
                for (int n = 0; n < 2; ++n)
#pragma unroll
                    for (int j = 0; j < 4; ++j) { const float g = acc[ai][0][m][n][j], uu = acc[ai][1][m][n][j]; h[n * 4 + j] = g * sigmoidf_(g) * uu; }
                u32x4 w; w.x = cvt_pk_bf16(h[0], h[1]); w.y = cvt_pk_bf16(h[2], h[3]); w.z = cvt_pk_bf16(h[4], h[5]); w.w = cvt_pk_bf16(h[6], h[7]);
                *(u32x4*)rowp = w; }
    }
};
template <bool OPF8> struct EpiSwiglu8T {
    static constexpr bool PERM = true, AFTER_DRAIN = false, HALFN = false, F8 = OPF8, RWACC = false;
    unsigned char* H; int ldh; float sin, sout;
    __device__ __forceinline__ void operator()(const f32x4 (&acc)[2][2][4][2], const Unit& u, int wr, int wc, int fr, int fq) const {
        const int row0 = u.pm * BM + wr * 64 + fr; const int col0 = u.pn * HALF + wc * 32 + 8 * (fq & 2); const int odd = fq & 1;
#pragma unroll
        for (int ai = 0; ai < 2; ++ai)
#pragma unroll
            for (int mp = 0; mp < 2; ++mp) {
                unsigned w[2][2];
#pragma unroll
                for (int k = 0; k < 2; ++k) { const int m = 2 * mp + k; float h[8];
#pragma unroll
                    for (int n = 0; n < 2; ++n)
#pragma unroll
                        for (int j = 0; j < 4; ++j) { const float g = acc[ai][0][m][n][j] * sin, uu = acc[ai][1][m][n][j] * sin; h[n * 4 + j] = clamp_fp8(g * sigmoidf_(g) * uu * sout); }
                    w[k][0] = pk4_fp8(h[0], h[1], h[2], h[3]); w[k][1] = pk4_fp8(h[4], h[5], h[6], h[7]); }
                const unsigned s0 = odd ? w[0][0] : w[1][0], s1 = odd ? w[0][1] : w[1][1];
                const unsigned r0 = (unsigned)mk_xor16((int)s0), r1 = (unsigned)mk_xor16((int)s1);
                u32x4 st; if (odd) { st.x = r0; st.y = r1; st.z = w[1][0]; st.w = w[1][1]; } else { st.x = w[0][0]; st.y = w[0][1]; st.z = r0; st.w = r1; }
                *(u32x4*)(H + (size_t)(row0 + ai * HALF + (2 * mp + odd) * 16) * ldh + col0) = st; }
    }
};
typedef EpiSwiglu8T<true> EpiSwiglu8;
struct EpiBf16PS8 {
    static constexpr bool PERM = true, AFTER_DRAIN = false, HALFN = false, F8 = true, RWACC = false;
    bf16_t* O; int ldc; float s;
    __device__ __forceinline__ void operator()(const f32x4 (&acc)[2][2][4][2], const Unit& u, int wr, int wc, int fr, int fq) const {
        const int row0 = u.pm * BM + wr * 64 + fr; const int col0 = u.pn * BM + wc * 32 + 8 * fq;
#pragma unroll
        for (int ai = 0; ai < 2; ++ai)
#pragma unroll
            for (int m = 0; m < 4; ++m) { bf16_t* rowp = O + (size_t)(row0 + ai * HALF + m * 16) * ldc + col0;
#pragma unroll
                for (int bj = 0; bj < 2; ++bj) { const f32x4 v0 = acc[ai][bj][m][0] * s, v1 = acc[ai][bj][m][1] * s;
                    u32x4 w; w.x = cvt_pk_bf16(v0[0], v0[1]); w.y = cvt_pk_bf16(v0[2], v0[3]); w.z = cvt_pk_bf16(v1[0], v1[1]); w.w = cvt_pk_bf16(v1[2], v1[3]);
                    *(u32x4*)(rowp + bj * HALF) = w; } }
    }
};
struct MoeOrder {
    int nN, G, c, p_lo, np; int pc[8];
    __device__ __forceinline__ bool next(int i, Unit& u) const {
        const long L = (long)i * G + c; if (L >= (long)np * nN) return false;
        const int wgid = (int)L, nig = WGM * nN, gid = wgid / nig, fm = gid * WGM, gsz = (np - fm) < WGM ? (np - fm) : WGM;
        u.pm = p_lo + fm + ((wgid % nig) % gsz); u.pn = (wgid % nig) / gsz;
        int e = 0;
#pragma unroll
        for (int k = 1; k < 8; ++k) e += (u.pm >= pc[k]) ? 1 : 0;
        u.pb = e * nN + u.pn; return true;
    }
    __device__ __forceinline__ void a_ready(const Unit&) const {}
    __device__ __forceinline__ void done(const Unit&) const {}
};

__device__ __forceinline__ void glds_s(const char* sbase, unsigned voff, unsigned lds_dst) { unsigned keep;
    asm volatile("s_mov_b32 %0, m0\n\ts_mov_b32 m0, %3\n\ts_nop 0\n\tglobal_load_lds_dwordx4 %1, %2\n\ts_mov_b32 m0, %0" : "=&s"(keep) : "v"(voff), "s"(sbase), "s"(lds_dst) : "memory"); }
__device__ __forceinline__ const char* uni_ptr(const char* p) { const unsigned long long b = (unsigned long long)(uintptr_t)p; const unsigned lo = (unsigned)__builtin_amdgcn_readfirstlane((int)(unsigned)b), hi = (unsigned)__builtin_amdgcn_readfirstlane((int)(unsigned)(b >> 32));
    return (const char*)(uintptr_t)(((unsigned long long)hi << 32) | lo); }
template <class Epi, class Sched, bool ALIGN_EPI = false, bool SP2 = false, bool RELAX = true>
__device__ __forceinline__ void gemm_phase(PG8_LAS unsigned char* lds, const Gemm g, const Sched& S, const Epi& E, int wv) {
    int tid_ = (wv << 6) | mk_lane(); asm volatile("" : "+v"(tid_));
    const int tid = tid_, wid = __builtin_amdgcn_readfirstlane(tid >> 6), lane = tid & 63, wr = wid >> 2, wc = wid & 3, fr = lane & 15, fq = lane >> 4;
    constexpr bool HN = Epi::HALFN;
    constexpr bool F8 = Epi::F8;
    constexpr int ES = F8 ? 1 : 2;
    const int K = g.K, nt = K * ES / (BK * 2);
    unsigned voffA[2], voffB[2];
#pragma unroll
    for (int i = 0; i < 2; ++i) { int R, C; stage_rc(tid * 16 + i * 8192, R, C); const int Rb = Epi::PERM ? ((R & ~31) + perm32(R & 31)) : R;
        voffA[i] = (unsigned)(R * K * ES + C * 2); voffB[i] = (unsigned)(Rb * K * ES + C * 2); }
    const size_t kstep = (size_t)(BK * 2);
    const size_t hstep = (size_t)HALF * K * ES;
    const size_t tstep = 2 * hstep;
    const unsigned ldsw = (unsigned)wid * 1024u;
    const unsigned ldsb = (unsigned)__builtin_amdgcn_readfirstlane((int)((unsigned)(uintptr_t)lds + ldsw));
    const int aoff = lds_byte(wr * 64 + fr, fq * 8), boff = lds_byte(wc * 32 + fr, fq * 8);
#define PG8_SA(b, h) (((b) * 2 + (h)) * HTB)
#define PG8_SB(b, h) ((4 + (b) * 2 + (h)) * HTB)
#define PG8_STAGE(bufoff, gbase, voff) do { _Pragma("unroll") for (int _i = 0; _i < 2; ++_i) \
        glds_s((const char*)(gbase), (voff)[_i], ldsb + (unsigned)((bufoff) + _i * 8192)); } while (0)
#define PG8_LDA(dst, b, h) do { if constexpr (F8) { _Pragma("unroll") for (int m = 0; m < 4; ++m) { const u32x4 lo_ = *(const PG8_LAS u32x4*)(lds + PG8_SA(b, h) + aoff + m * 2048), hi_ = *(const PG8_LAS u32x4*)(lds + PG8_SA(b, h) + aoff + m * 2048 + 1024); \
            dst##8[m] = __builtin_bit_cast(v8i32, __builtin_shufflevector(lo_, hi_, 0, 1, 2, 3, 4, 5, 6, 7)); } } \
        else { _Pragma("unroll") for (int m = 0; m < 4; ++m) _Pragma("unroll") for (int k = 0; k < 2; ++k) dst[m][k] = *(const PG8_LAS bf16x8*)(lds + PG8_SA(b, h) + aoff + m * 2048 + k * 1024); } } while (0)
#define PG8_LDB(dst, b, h) do { if constexpr (F8) { _Pragma("unroll") for (int n = 0; n < 2; ++n) { const u32x4 lo_ = *(const PG8_LAS u32x4*)(lds + PG8_SB(b, h) + boff + n * 2048), hi_ = *(const PG8_LAS u32x4*)(lds + PG8_SB(b, h) + boff + n * 2048 + 1024); \
            dst##8[n] = __builtin_bit_cast(v8i32, __builtin_shufflevector(lo_, hi_, 0, 1, 2, 3, 4, 5, 6, 7)); } } \
        else { _Pragma("unroll") for (int n = 0; n < 2; ++n) _Pragma("unroll") for (int k = 0; k < 2; ++k) dst[n][k] = *(const PG8_LAS bf16x8*)(lds + PG8_SB(b, h) + boff + n * 2048 + k * 1024); } } while (0)
#define PG8_MMA(ai, bj, At, Bt) do { __builtin_amdgcn_s_setprio(1); _Pragma("unroll") for (int m = 0; m < 4; ++m) _Pragma("unroll") for (int n = 0; n < 2; ++n) { \
        if constexpr (F8) { asm volatile("v_mfma_f32_16x16x128_f8f6f4 %0, %1, %2, %0" : "+v"(acc[ai][bj][m][n]) : "v"(Bt##8[n]), "v"(At##8[m])); } \
        else { _Pragma("unroll") for (int k = 0; k < 2; ++k) acc[ai][bj][m][n] = __builtin_amdgcn_mfma_f32_16x16x32_bf16(Bt[n][k], At[m][k], acc[ai][bj][m][n], 0, 0, 0); } } \
        __builtin_amdgcn_s_setprio(0); } while (0)
#define PG8_LDB1(dst, b, h) do { if constexpr (!HN) { PG8_LDB(dst, b, h); } } while (0)
#define PG8_MMA1(ai, bj, At, Bt) do { if constexpr (!HN) { PG8_MMA(ai, bj, At, Bt); } } while (0)
#define PG8_WAIT_V(n) asm volatile("s_waitcnt vmcnt(" #n ")" ::: "memory")
#define PG8_WAIT_L(n) asm volatile("s_waitcnt lgkmcnt(" #n ")" ::: "memory")
#define PG8_BAR __builtin_amdgcn_s_barrier()
#define PG8_SCHED __builtin_amdgcn_sched_barrier(0)
    Unit cur, nxt; int ui = 0;
    if (!S.next(0, cur)) return;
    f32x4 acc[2][2][4][2];
#pragma unroll
    for (int a = 0; a < 2; ++a)
#pragma unroll
        for (int b = 0; b < 2; ++b)
#pragma unroll
            for (int m = 0; m < 4; ++m)
#pragma unroll
                for (int n = 0; n < 2; ++n) acc[a][b][m][n] = (f32x4){0.f, 0.f, 0.f, 0.f};
    bf16x8 At[4][2], B0[2][2], B1[2][2];
    v8i32 At8[4], B08[2], B18[2];
    const char* cA = uni_ptr((const char*)g.A + (size_t)cur.pm * tstep); const char* cB = uni_ptr((const char*)g.Bt + (size_t)cur.pb * (HN ? hstep : tstep));
    S.a_ready(cur);
    if constexpr (SP2) {
        PG8_STAGE(PG8_SB(0, 0), cB, voffB); PG8_STAGE(PG8_SB(0, 1), cB + hstep, voffB); PG8_STAGE(PG8_SA(0, 0), cA, voffA); PG8_STAGE(PG8_SA(0, 1), cA + hstep, voffA);
        if (wr == 1) PG8_BAR;
        PG8_WAIT_V(2); PG8_BAR;
        static_assert(RELAX, "the balanced staging order below is written for RELAX only");
        PG8_STAGE(PG8_SB(1, 0), cB + kstep, voffB); PG8_STAGE(PG8_SB(1, 1), cB + hstep + kstep, voffB);
        PG8_WAIT_V(0); PG8_BAR;
    } else {
        PG8_STAGE(PG8_SB(0, 0), cB, voffB); PG8_STAGE(PG8_SA(0, 0), cA, voffA); PG8_STAGE(PG8_SB(0, 1), cB + hstep, voffB); PG8_STAGE(PG8_SA(0, 1), cA + hstep, voffA);
        if (wr == 1) PG8_BAR;
        PG8_WAIT_V(4); PG8_BAR;
        PG8_STAGE(PG8_SB(1, 0), cB + kstep, voffB); PG8_STAGE(PG8_SA(1, 0), cA + kstep, voffA); PG8_STAGE(PG8_SB(1, 1), cB + hstep + kstep, voffB);
        PG8_WAIT_V(6); PG8_BAR;
    }
    for (;;) {
        const bool has_next = S.next(ui + 1, nxt);
        const char* nA = uni_ptr(has_next ? (const char*)g.A + (size_t)nxt.pm * tstep : cA); const char* nB = uni_ptr(has_next ? (const char*)g.Bt + (size_t)nxt.pb * (HN ? hstep : tstep) : cB);
        for (int t = 0; t < nt; t += 2) {
            const bool last = (t == nt - 2);
            const char* a1 = cA + (size_t)(t + 1) * kstep;
            const char* a2 = last ? nA : cA + (size_t)(t + 2) * kstep; const char* b2 = last ? nB : cB + (size_t)(t + 2) * kstep;
            const char* a3 = a2 + kstep; const char* b3 = b2 + kstep;
            if (last && has_next) S.a_ready(nxt);
            const bool rl = SP2 && RELAX && t == 0;
            if constexpr (SP2) {
            PG8_LDB(B0, 0, 0); PG8_LDB1(B1, 0, 1); PG8_SCHED; PG8_LDA(At, 0, 0); PG8_STAGE(PG8_SA(1, 0), a1, voffA); PG8_STAGE(PG8_SA(1, 1), a1 + hstep, voffA);
            if (!rl) PG8_WAIT_V(8); PG8_WAIT_L(0); PG8_BAR; PG8_MMA(0, 0, At, B0); PG8_MMA1(0, 1, At, B1); PG8_BAR; PG8_SCHED;
            PG8_LDA(At, 0, 1); PG8_STAGE(PG8_SB(0, 0), b2, voffB); PG8_STAGE(PG8_SB(0, 1), b2 + hstep, voffB);
            PG8_WAIT_V(6); PG8_WAIT_L(0); PG8_BAR; PG8_MMA(1, 0, At, B0); PG8_MMA1(1, 1, At, B1); PG8_BAR; PG8_SCHED;
            PG8_LDB(B0, 1, 0); PG8_LDB1(B1, 1, 1); PG8_SCHED; PG8_LDA(At, 1, 0); PG8_STAGE(PG8_SA(0, 0), a2, voffA); PG8_STAGE(PG8_SA(0, 1), a2 + hstep, voffA);
            PG8_WAIT_V(8); PG8_WAIT_L(0); PG8_BAR; PG8_MMA(0, 0, At, B0); PG8_MMA1(0, 1, At, B1); PG8_BAR; PG8_SCHED;
            PG8_LDA(At, 1, 1); PG8_STAGE(PG8_SB(1, 0), b3, voffB); PG8_STAGE(PG8_SB(1, 1), b3 + hstep, voffB);
            PG8_WAIT_V(6); PG8_WAIT_L(0); PG8_BAR; PG8_MMA(1, 0, At, B0); PG8_MMA1(1, 1, At, B1); PG8_BAR; PG8_SCHED;
            } else {
            PG8_LDB(B0, 0, 0); PG8_SCHED; PG8_LDA(At, 0, 0); PG8_STAGE(PG8_SA(1, 1), a1 + hstep, voffA);
            PG8_WAIT_L(8); PG8_BAR; PG8_WAIT_L(0); PG8_MMA(0, 0, At, B0); PG8_BAR; PG8_SCHED;
            PG8_LDB1(B1, 0, 1); PG8_STAGE(PG8_SB(0, 0), b2, voffB);
            PG8_BAR; PG8_WAIT_L(0); PG8_MMA1(0, 1, At, B1); PG8_BAR;
            PG8_LDA(At, 0, 1); PG8_STAGE(PG8_SA(0, 0), a2, voffA);
            PG8_BAR; PG8_WAIT_L(0); PG8_MMA(1, 0, At, B0); PG8_BAR; PG8_SCHED;
            PG8_STAGE(PG8_SB(0, 1), b2 + hstep, voffB);
            PG8_WAIT_V(6); PG8_BAR; PG8_MMA1(1, 1, At, B1); PG8_BAR;
            PG8_LDB(B0, 1, 0); PG8_SCHED; PG8_LDA(At, 1, 0); PG8_STAGE(PG8_SA(0, 1), a2 + hstep, voffA);
            PG8_WAIT_L(8); PG8_BAR; PG8_WAIT_L(0); PG8_MMA(0, 0, At, B0); PG8_BAR; PG8_SCHED;
            PG8_LDB1(B1, 1, 1); PG8_STAGE(PG8_SB(1, 0), b3, voffB);
            PG8_BAR; PG8_WAIT_L(0); PG8_MMA1(0, 1, At, B1); PG8_BAR;
            PG8_LDA(At, 1, 1); PG8_STAGE(PG8_SA(1, 0), a3, voffA);
            PG8_BAR; PG8_WAIT_L(0); PG8_MMA(1, 0, At, B0); PG8_BAR; PG8_SCHED;
            PG8_STAGE(PG8_SB(1, 1), b3 + hstep, voffB);
            PG8_WAIT_V(6); PG8_BAR; PG8_MMA1(1, 1, At, B1); PG8_BAR;
            }
        }
        if constexpr (F8) asm volatile("s_nop 15\n\ts_nop 15" ::: "memory");
        if constexpr (ALIGN_EPI) { if (wr == 0) PG8_BAR; }
        if constexpr (SP2 && RELAX) PG8_WAIT_V(0);
        if constexpr (Epi::RWACC) { E.rw(acc, cur, wr, wc, fr, fq); S.done(cur); }
        else if constexpr (!Epi::AFTER_DRAIN) { E(acc, cur, wr, wc, fr, fq); S.done(cur); }
        if (!has_next) break;
        bool zero_acc = true; if constexpr (Epi::RWACC) zero_acc = E.restart(cur);
        if (zero_acc)
#pragma unroll
        for (int a = 0; a < 2; ++a)
#pragma unroll
            for (int b = 0; b < 2; ++b)
#pragma unroll
                for (int m = 0; m < 4; ++m)
#pragma unroll
                    for (int n = 0; n < 2; ++n) acc[a][b][m][n] = (f32x4){0.f, 0.f, 0.f, 0.f};
        cur = nxt; cA = nA; cB = nB; ++ui;
        if constexpr (ALIGN_EPI) { if (wr == 1) PG8_BAR; }
    }
    PG8_WAIT_V(0);
    if constexpr (!ALIGN_EPI) { if (wr == 0) PG8_BAR; }
    PG8_BAR;
    if constexpr (Epi::AFTER_DRAIN) { E.fused(acc, cur, wr, wc, fr, fq, lds, wid, lane); S.done(cur); }
#undef PG8_SA
#undef PG8_SB
#undef PG8_STAGE
#undef PG8_LDA
#undef PG8_LDB
#undef PG8_MMA
#undef PG8_LDB1
#undef PG8_MMA1
#undef PG8_WAIT_V
#undef PG8_WAIT_L
#undef PG8_BAR
#undef PG8_SCHED
}
}

#ifndef PG8_SP2
#define PG8_SP2 true
#endif
#ifndef PG8_ALIGN
#define PG8_ALIGN true
#endif
#ifndef MK_WGM
#define MK_WGM 4
#endif
#ifndef MK_DENSE_F8
#define MK_DENSE_F8 1
#endif
#ifndef MK_MT_A
#define MK_MT_A 9472
#endif
#ifndef MK_MT_B
#define MK_MT_B 20096
#endif
#ifndef MK_MT_C
#define MK_MT_C 28544
#endif
#ifndef MK_MOE_TAIL
#define MK_MOE_TAIL 1
#endif
#ifndef MK_L1_F8
#define MK_L1_F8 1
#endif
#ifndef MK_L1_ALLF8
#define MK_L1_ALLF8 0
#endif
#ifndef MK_P4_F8
#define MK_P4_F8 1
#endif
#ifndef MK_P5L1_F8
#define MK_P5L1_F8 1
#endif
#ifndef MK_PER_PHASE
#define MK_PER_PHASE 0
#endif

constexpr int NWAVES = 8;
constexpr int D = 1024, BATCH = 4, SEQ = 8192, CTXL = 256, DEPTH = 2;
constexpr int TL = BATCH * SEQ, TC = BATCH * CTXL, TA = TL + TC;
constexpr int INC = 6912, ZMC = 3840, ZGC = 3072, BW = 512;
constexpr int FFD = 2816, FFE = 3584, NE = 8;
constexpr int MAXPAN = 264, PCH = 264, NCHUNK = 1;
constexpr float RMS_EPS = 1e-6f;
constexpr float SC_XG = 4.0f, SC_WGU = 32.0f, SC_H = 4.0f, SC_WDN = 64.0f, SC_O = 16.0f, SC_WBR = 32.0f;
constexpr int C_QA = 0, C_KA = 512, C_VA = 640, C_UX = 768, C_GB = 1280, C_GC = 1792, C_QN = 2304, C_KN = 2816, C_VN = 3328;

constexpr size_t MiB = 1u << 20;
constexpr size_t WS_CTL = 0, CTL_ZERO_BYTES = 1 * MiB;
constexpr size_t WS_MOD = 1 * MiB;
constexpr size_t WS_ROPE = WS_MOD + 256 * 1024;
constexpr size_t WS_SLABCNT = WS_MOD + 320 * 1024;
constexpr size_t WS_PCUM = WS_MOD + 384 * 1024;
constexpr size_t WS_TOKER = WS_MOD + 512 * 1024;
constexpr size_t WS_TOKG = WS_MOD + 768 * 1024;
constexpr size_t WS_TOKPOS = WS_MOD + 1024 * 1024;
constexpr size_t WS_HCTX = 4 * MiB;
constexpr size_t WS_WIN = 8 * MiB;
constexpr size_t WS_WBR = 35 * MiB;
constexpr size_t WS_WOUT = 41 * MiB;
constexpr size_t WS_WGUD = 45 * MiB;
constexpr size_t WS_WDND = 56 * MiB;
constexpr size_t WS_WGUM = 62 * MiB;
constexpr size_t WS_WDNM = 118 * MiB;
constexpr size_t WS_RS = 146 * MiB;
constexpr size_t WS_HX = 230 * MiB;
constexpr size_t WS_ZM = 296 * MiB;
constexpr size_t WS_ZG = 544 * MiB;
constexpr size_t WS_O = 742 * MiB;
constexpr size_t WS_XG = WS_ZM;
constexpr size_t WS_HM = WS_ZM + 132 * MiB;
constexpr size_t WS_XG8 = WS_O;
constexpr size_t WS_HX8 = 841 * MiB;
constexpr size_t WS_WING8 = 874 * MiB;
constexpr size_t WS_END = 880 * MiB;
static_assert(WS_WIN + (size_t)2 * INC * D * 2 <= WS_WBR && WS_WGUD + (size_t)2 * FFD * D * 2 <= WS_WDND && WS_WDND + (size_t)D * FFD * 2 <= WS_WGUM, "ws map (weights)");
static_assert(WS_WGUM + (size_t)NE * 2 * FFE * D <= WS_WDNM && WS_WDNM + (size_t)NE * D * FFE <= WS_RS && WS_RS + (size_t)TA * D * 2 <= WS_HX, "ws map (moe weights, residual stream)");
static_assert(WS_HX + (size_t)TA * D * 2 <= WS_ZM && WS_ZM + (size_t)TA * ZMC * 2 <= WS_ZG && WS_ZG + (size_t)TA * ZGC * 2 <= WS_O && WS_O + (size_t)3 * TA * BW * 2 <= WS_END, "ws map (activations)");
static_assert(WS_HM + (size_t)MAXPAN * 256 * FFE <= WS_O && WS_XG8 + (size_t)MAXPAN * 256 * D <= WS_END && (size_t)MAXPAN * 256 * D * 2 <= 132 * MiB && (size_t)TA * D * 4 <= 132 * MiB, "ws map (moe)");
constexpr int CW_BAR = 4096;

constexpr int RING_OFF = 0, RING_BYTES = 131072;
constexpr int LDSCTL_OFF = RING_BYTES, MISC_OFF = LDSCTL_OFF + 320;
constexpr int ROPEL_OFF = RING_BYTES + 1024, ROPEL_BYTES = 192 * 16 * 2 * 4;
constexpr int LDS_BYTES = 163840;
static_assert(ROPEL_OFF + ROPEL_BYTES <= LDS_BYTES, "lds map");

#define GAS __attribute__((address_space(1)))
#define LAS __attribute__((address_space(3)))
typedef unsigned short bf16;
typedef unsigned v4u __attribute__((ext_vector_type(4)));
typedef unsigned v2u __attribute__((ext_vector_type(2)));
typedef float f32x4 __attribute__((ext_vector_type(4)));
typedef float f32x2 __attribute__((ext_vector_type(2)));
#define LDS_WAIT() asm volatile("s_waitcnt lgkmcnt(0)" ::: "memory")
#define VM_WAIT() asm volatile("s_waitcnt vmcnt(0)" ::: "memory")
__device__ __forceinline__ unsigned f2bf(float f) { unsigned u = __builtin_bit_cast(unsigned, f); return (u + 0x7fffu + ((u >> 16) & 1u)) >> 16; }
__device__ __forceinline__ unsigned pk2(float lo, float hi) { return f2bf(lo) | (f2bf(hi) << 16); }
__device__ __forceinline__ float bflo(unsigned w) { return __uint_as_float(w << 16); }
__device__ __forceinline__ float bfhi(unsigned w) { return __uint_as_float(w & 0xffff0000u); }
__device__ __forceinline__ float bf2f(bf16 b) { return __uint_as_float(((unsigned)b) << 16); }

#define XB_TMO      128
#define XB_XCNT(j)  (256  + 64 * (j))
#define XB_XSUB(j)  (1280 + 64 * (j))
#define XB_XGEN(j)  (2304 + 64 * (j))
#define XB_TOP      3328
#define XB_TOPGEN   3392
#define XCD_BAR_WORDS 3456
#define XB_SPIN_CAP (1u << 21)

__device__ __forceinline__ unsigned xb_ld(unsigned* p)              { return __hip_atomic_load(p, __ATOMIC_RELAXED, __HIP_MEMORY_SCOPE_AGENT); }
__device__ __forceinline__ unsigned xb_add(unsigned* p, unsigned v) { return __hip_atomic_fetch_add(p, v, __ATOMIC_RELAXED, __HIP_MEMORY_SCOPE_AGENT); }
__device__ __forceinline__ unsigned xb_xcc_id() { return (unsigned)__builtin_amdgcn_s_getreg((3 << 11) | 20) & 0xFu; }
#define XB_SPIN(cond, bar) do { unsigned _sp = 0; while (cond) { __builtin_amdgcn_s_sleep(1); \
    if ((++_sp & 255u) == 0u) { if (xb_ld(&(bar)[XB_TMO])) break; if (_sp > XB_SPIN_CAP) { atomicAdd(&(bar)[XB_TMO], 1u); break; } } } } while (0)

struct XcdBarrier {
    unsigned* bar; unsigned x;
    volatile LAS unsigned* st;
    int w;
};

__device__ __forceinline__ XcdBarrier xcd_barrier_post(unsigned* bar, volatile LAS unsigned* st) {
    XcdBarrier b; b.bar = bar; b.x = xb_xcc_id(); b.st = st; b.w = 0;
    if (threadIdx.x == 0) (void)xb_add(&bar[XB_XCNT(b.x)], 1u);
    return b;
}
__device__ __forceinline__ void xcd_barrier_complete(unsigned* bar, unsigned x, unsigned& nloc, unsigned& nx) {
    const unsigned G = gridDim.x * gridDim.y * gridDim.z;
    unsigned sum, cnt, mine, sp = 0u;
    for (;;) {
        sum = 0u; cnt = 0u; mine = 0u;
#pragma unroll
        for (unsigned j = 0; j < 16; ++j) { const unsigned c = xb_ld(&bar[XB_XCNT(j)]); sum += c; cnt += (c > 0u) ? 1u : 0u; mine = (j == x) ? c : mine; }
        if (sum == G) break;
        __builtin_amdgcn_s_sleep(1);
        if ((++sp & 255u) == 0u) { if (xb_ld(&bar[XB_TMO])) break; if (sp > XB_SPIN_CAP) { atomicAdd(&bar[XB_TMO], 1u); break; } }
    }
    nloc = mine > 0u ? mine : 1u; nx = cnt > 0u ? cnt : 1u;
}

__device__ __forceinline__ void xcd_barrier(const XcdBarrier& b) {
    asm volatile("s_waitcnt vmcnt(0)" ::: "memory");
    __syncthreads();
    if (b.w == 0 && mk_lane() == 0) {
        unsigned* bar = b.bar; { GAS unsigned* bg_ = (GAS unsigned*)bar; asm volatile("" : "+s"(bg_)); bar = (unsigned*)bg_; }
        __builtin_amdgcn_s_waitcnt(0);
        unsigned nloc = b.st[0], nx = b.st[1];
        if (nloc == 0u) { xcd_barrier_complete(bar, b.x, nloc, nx); b.st[0] = nloc; b.st[1] = nx; }
        const unsigned old = xb_add(&bar[XB_XSUB(b.x)], 1u);
        const unsigned gen = old / nloc;
        if (old + 1u == (gen + 1u) * nloc) {
            __builtin_amdgcn_fence(__ATOMIC_RELEASE, "agent");
            asm volatile("s_waitcnt vmcnt(0)" ::: "memory");
            const unsigned og = xb_add(&bar[XB_TOP], 1u);
            const unsigned tg = og / nx;
            if (og + 1u == (tg + 1u) * nx) xb_add(&bar[XB_TOPGEN], 1u);
            else XB_SPIN(xb_ld(&bar[XB_TOPGEN]) == tg, bar);
            __builtin_amdgcn_fence(__ATOMIC_ACQUIRE, "agent");
            xb_add(&bar[XB_XGEN(b.x)], 1u);
            asm volatile("s_waitcnt vmcnt(0)" ::: "memory");
        } else {
            XB_SPIN(xb_ld(&bar[XB_XGEN(b.x)]) == gen, bar);
            __builtin_amdgcn_fence(__ATOMIC_ACQUIRE, "agent");
            asm volatile("s_waitcnt vmcnt(0)" ::: "memory");
        }
    }
    __syncthreads();
}

struct Frame {
    LAS unsigned char* lds;
    volatile LAS unsigned* MISC;
    unsigned* ctl;
    int vcu, G;
    int wv;
};
enum { I_X = 0, I_C, I_CTX, I_CCTX, I_WADA, I_BADA, I_GPREMIX, I_GPOSTMIX, I_GPREFFN, I_GPOSTFFN, I_WIN, I_BGATE, I_SINK, I_CONVW, I_RPB, I_WBRANCH, I_WOUT, I_WGUD, I_WDND, I_WROUTER, I_BROUTER, I_WGUM, I_WDNM };

__device__ __forceinline__ float wave_sum(float v) {
    v += mk_dpp<0xB1>(v); v += mk_dpp<0x4E>(v); v += mk_dpp<0x141>(v); v += mk_dpp<0x140>(v);
    v += mk_dpp<0x142, 0xa>(v); v += mk_dpp<0x143, 0xc>(v);
    return __builtin_bit_cast(float, __builtin_amdgcn_readlane(__builtin_bit_cast(int, v), 63));
}
__device__ __forceinline__ float wave_max(float v) {
    v = fmaxf(v, mk_dpp<0xB1>(v)); v = fmaxf(v, mk_dpp<0x4E>(v)); v = fmaxf(v, mk_dpp<0x141>(v)); v = fmaxf(v, mk_dpp<0x140>(v));
    const float a = __builtin_bit_cast(float, __builtin_amdgcn_readlane(__builtin_bit_cast(int, v), 0)), b = __builtin_bit_cast(float, __builtin_amdgcn_readlane(__builtin_bit_cast(int, v), 16)),
                c = __builtin_bit_cast(float, __builtin_amdgcn_readlane(__builtin_bit_cast(int, v), 32)), d = __builtin_bit_cast(float, __builtin_amdgcn_readlane(__builtin_bit_cast(int, v), 48));
    return fmaxf(fmaxf(a, b), fmaxf(c, d));
}

__device__ __forceinline__ void row_store_fp8(unsigned char* p, int lane, const f32x4 (&h)[4], float sc) {
#pragma unroll
    for (int c = 0; c < 2; ++c) { const f32x4 a = __builtin_elementwise_min(__builtin_elementwise_max(h[2 * c] * sc, (f32x4){-448.f, -448.f, -448.f, -448.f}), (f32x4){448.f, 448.f, 448.f, 448.f}), b = __builtin_elementwise_min(__builtin_elementwise_max(h[2 * c + 1] * sc, (f32x4){-448.f, -448.f, -448.f, -448.f}), (f32x4){448.f, 448.f, 448.f, 448.f});
        v2u w; w.x = pg8::pk4_fp8(a.x, a.y, a.z, a.w); w.y = pg8::pk4_fp8(b.x, b.y, b.z, b.w);
        *(v2u*)(p + 8 * (64 * c + lane)) = w; }
}

__device__ __forceinline__ void tr_item(const float* W, int N, int k0, int n0, bf16* WT, int Kd, int drow0, LAS float* scr, int lane) {
#pragma unroll
    for (int i = 0; i < 8; ++i) { const int kk = 8 * i + (lane >> 3), c4 = 4 * (lane & 7); const f32x4 v = *(const f32x4*)(W + (size_t)(k0 + kk) * N + n0 + c4);
        LAS float* d = scr + kk * 33 + c4; d[0] = v.x; d[1] = v.y; d[2] = v.z; d[3] = v.w; }
    LDS_WAIT(); asm volatile("" ::: "memory");
    const int c = lane & 7;
#pragma unroll
    for (int j = 0; j < 4; ++j) { const int n = (lane >> 3) + 8 * j; const LAS float* s = scr + (8 * c) * 33 + n;
        v4u o; o.x = pk2(s[0 * 33], s[1 * 33]); o.y = pk2(s[2 * 33], s[3 * 33]); o.z = pk2(s[4 * 33], s[5 * 33]); o.w = pk2(s[6 * 33], s[7 * 33]);
        *(v4u*)(WT + (size_t)(drow0 + n) * Kd + k0 + 8 * c) = o; }
    LDS_WAIT(); asm volatile("" ::: "memory");
}
__device__ __forceinline__ void tr_matrix_item(const float* W, int K, int N, int ff, bf16* WT, int item, LAS float* scr, int lane) {
    const int nblk = N / 32, kb = item / nblk, nb = item % nblk, n0 = 32 * nb;
    int drow0 = n0;
    if (ff > 0) { const int isu = n0 >= ff ? 1 : 0, nn = n0 - isu * ff; drow0 = 256 * (nn >> 7) + 128 * isu + (nn & 127); }
    tr_item(W, N, 64 * kb, n0, WT, K, drow0, scr, lane);
}

__device__ __forceinline__ void tr_item8(const float* W, int N, int k0, int n0, unsigned char* WT, int Kd, int drow0, float scale, LAS float* scr, int lane) {
#pragma unroll
    for (int i = 0; i < 8; ++i) { const int kk = 8 * i + (lane >> 3), c4 = 4 * (lane & 7); const f32x4 v = *(const f32x4*)(W + (size_t)(k0 + kk) * N + n0 + c4);
        LAS float* d = scr + kk * 33 + c4; d[0] = v.x; d[1] = v.y; d[2] = v.z; d[3] = v.w; }
    LDS_WAIT(); asm volatile("" ::: "memory");
    const int n = lane >> 1, kh = lane & 1; const LAS float* s = scr + (32 * kh) * 33 + n;
    unsigned w[8];
#pragma unroll
    for (int j = 0; j < 8; ++j) w[j] = pg8::pk4_fp8(s[(4 * j) * 33] * scale, s[(4 * j + 1) * 33] * scale, s[(4 * j + 2) * 33] * scale, s[(4 * j + 3) * 33] * scale);
    v4u* dst = (v4u*)(WT + (size_t)(drow0 + n) * Kd + k0 + 32 * kh);
    dst[0] = (v4u){w[0], w[1], w[2], w[3]}; dst[1] = (v4u){w[4], w[5], w[6], w[7]};
    LDS_WAIT(); asm volatile("" ::: "memory");
}
__device__ __forceinline__ void tr_matrix_item8(const float* W, int K, int N, int ff, unsigned char* WT, float scale, int item, LAS float* scr, int lane) {
    const int nblk = N / 32, kb = item / nblk, nb = item % nblk, n0 = 32 * nb;
    int drow0 = n0;
    if (ff > 0) { const int isu = n0 >= ff ? 1 : 0, nn = n0 - isu * ff; drow0 = 256 * (nn >> 7) + 128 * isu + (nn & 127); }
    tr_item8(W, N, 64 * kb, n0, WT, K, drow0, scale, scr, lane);
}

__device__ __forceinline__ void row_load(const float* p, int lane, f32x4 (&v)[4]) {
#pragma unroll
    for (int c = 0; c < 2; ++c) { const f32x4* r = (const f32x4*)(p + 8 * (64 * c + lane)); v[2 * c] = r[0]; v[2 * c + 1] = r[1]; }
}
__device__ __forceinline__ void row_load_bf16(const bf16* p, int lane, f32x4 (&v)[4]) {
#pragma unroll
    for (int c = 0; c < 2; ++c) { const v4u w = *(const v4u*)(p + 8 * (64 * c + lane));
        v[2 * c] = (f32x4){bflo(w.x), bfhi(w.x), bflo(w.y), bfhi(w.y)}; v[2 * c + 1] = (f32x4){bflo(w.z), bfhi(w.z), bflo(w.w), bfhi(w.w)}; }
}
__device__ __forceinline__ void row_store(float* p, int lane, const f32x4 (&v)[4]) {
#pragma unroll
    for (int c = 0; c < 2; ++c) { f32x4* r = (f32x4*)(p + 8 * (64 * c + lane)); r[0] = v[2 * c]; r[1] = v[2 * c + 1]; }
}
__device__ __forceinline__ float row_rrms(const f32x4 (&v)[4]) {
    float s = 0.f;
#pragma unroll
    for (int j = 0; j < 4; ++j) s += (v[j].x * v[j].x + v[j].y * v[j].y) + (v[j].z * v[j].z + v[j].w * v[j].w);
    return 1.0f / sqrtf(wave_sum(s) * (1.0f / D) + RMS_EPS);
}
__device__ __forceinline__ void vec_load(const float* p, int lane, f32x4 (&v)[4]) { row_load(p, lane, v); }
__device__ __forceinline__ void row_normmod(const f32x4 (&x)[4], float rr, const f32x4 (&g)[4], const f32x4 (&shift)[4], const f32x4 (&scale)[4], f32x4 (&h)[4]) {
#pragma unroll
    for (int j = 0; j < 4; ++j) h[j] = (x[j] * rr * g[j]) * (scale[j] + 1.0f) + shift[j];
}
__device__ __forceinline__ void row_store_bf16(bf16* p, int lane, const f32x4 (&h)[4]) {
#pragma unroll
    for (int c = 0; c < 2; ++c) { v4u w; w.x = pk2(h[2 * c].x, h[2 * c].y); w.y = pk2(h[2 * c].z, h[2 * c].w); w.z = pk2(h[2 * c + 1].x, h[2 * c + 1].y); w.w = pk2(h[2 * c + 1].z, h[2 * c + 1].w);
        *(v4u*)(p + 8 * (64 * c + lane)) = w; }
}

namespace at {
typedef short bf16x8 __attribute__((ext_vector_type(8)));
typedef short s16x4 __attribute__((ext_vector_type(4)));
typedef short v4i16_t __attribute__((ext_vector_type(4)));
typedef float f32x16 __attribute__((ext_vector_type(16)));
constexpr int NS = 4, PF = 3, SLOT = 16384;
constexpr int LDS_TAB = NS * SLOT + 1024;
constexpr int LDS_TT = LDS_TAB + 8 * 2048 + 1024;
constexpr int MAXT = 160;
constexpr float LOG2E = 1.4426950408889634f, C2 = 0.125f * LOG2E;
__device__ __forceinline__ unsigned cvtpk(float lo, float hi) { unsigned r; asm volatile("v_cvt_pk_bf16_f32 %0, %1, %2" : "=v"(r) : "v"(lo), "v"(hi)); return r; }
__device__ __forceinline__ float hmax(float v) { auto rr = __builtin_amdgcn_permlane32_swap(__float_as_uint(v), __float_as_uint(v), false, false); return fmaxf(__uint_as_float(rr[0]), __uint_as_float(rr[1])); }
__device__ __forceinline__ float hsum(float v) { auto rr = __builtin_amdgcn_permlane32_swap(__float_as_uint(v), __float_as_uint(v), false, false); return __uint_as_float(rr[0]) + __uint_as_float(rr[1]); }

__device__ __forceinline__ void glds16(const void* gsrc, unsigned lds_dst) { unsigned keep;
    asm volatile("s_mov_b32 %0, m0\n\ts_mov_b32 m0, %2\n\ts_nop 0\n\tglobal_load_lds_dwordx4 %1, off\n\ts_mov_b32 m0, %0" : "=&s"(keep) : "v"(gsrc), "s"(lds_dst) : "memory"); }
__device__ __forceinline__ void tile_issue(LAS unsigned char* slot, const bf16* ZMp, size_t row0, int kcol, int vcol, int wid, int lane) {
    const bf16* ksrc = ZMp + (row0 + lane) * ZMC + kcol + wid * 8;
    const bf16* vsrc = ZMp + (row0 + 16 * (wid & 3) + (lane >> 2)) * ZMC + vcol + (wid >> 2) * 32 + (lane & 3) * 8;
    const unsigned dst = (unsigned)__builtin_amdgcn_readfirstlane((int)(unsigned)(uintptr_t)slot + wid * 1024);
    glds16(ksrc, dst); glds16(vsrc, dst + 8192u);
}
__device__ __forceinline__ void k_load_half(bf16x8 (&kf)[4], const LAS unsigned char* Ks, int h, int r32, int hi) {
    const LAS unsigned char* kb = Ks + hi * 1024 + r32 * 16 + h * 4096;
#pragma unroll
    for (int d0 = 0; d0 < 2; ++d0) { kf[2 * d0] = *(const LAS bf16x8*)(kb + d0 * 2048); kf[2 * d0 + 1] = *(const LAS bf16x8*)(kb + d0 * 2048 + 512); }
}
__device__ __forceinline__ void qk_tile(f32x16& p0, f32x16& p1, const LAS unsigned char* Ks, const bf16x8 (&kfa)[4], const bf16x8 (&qr)[4], int r32, int hi) {
    bf16x8 kfb[4]; k_load_half(kfb, Ks, 1, r32, hi);
    __builtin_amdgcn_sched_barrier(0);
#pragma unroll
    for (int r = 0; r < 16; ++r) { p0[r] = 0.f; p1[r] = 0.f; }
#pragma unroll
    for (int d0 = 0; d0 < 2; ++d0) {
        p0 = __builtin_amdgcn_mfma_f32_32x32x16_bf16(kfa[2 * d0], qr[d0], p0, 0, 0, 0);
        p1 = __builtin_amdgcn_mfma_f32_32x32x16_bf16(kfa[2 * d0 + 1], qr[d0], p1, 0, 0, 0);
    }
#pragma unroll
    for (int d0 = 0; d0 < 2; ++d0) {
        p0 = __builtin_amdgcn_mfma_f32_32x32x16_bf16(kfb[2 * d0], qr[2 + d0], p0, 0, 0, 0);
        p1 = __builtin_amdgcn_mfma_f32_32x32x16_bf16(kfb[2 * d0 + 1], qr[2 + d0], p1, 0, 0, 0);
    }
}
__device__ __forceinline__ s16x4 vtr(const LAS unsigned char* p) { return __builtin_bit_cast(s16x4, __builtin_amdgcn_ds_read_tr16_b64_v4i16((LAS v4i16_t*)p)); }
template <int LV> __device__ __forceinline__ constexpr bool live0(int r) { return LV == 2 ? r >= 12 : true; }
template <int LV> __device__ __forceinline__ constexpr bool live1(int r) { return LV == 1 ? r < 4 : true; }
template <bool RAW, int LV, int VAR = 0>
__device__ __forceinline__ void sm_pv(f32x16& x0, f32x16& x1, float& m, float& l, f32x16 (&o)[2], const LAS unsigned char* Vs, int lane, int hi, bf16x8 (&kfa)[4], const LAS unsigned char* Ksn, bool pre) {
    if (VAR == 2) { l += x0[0] + x1[15];
        bf16x8 pw_[4]; unsigned w_[16];
#pragma unroll
        for (int i = 0; i < 8; ++i) { w_[i] = cvtpk(x0[2 * i], x0[2 * i + 1]); w_[8 + i] = cvtpk(x1[2 * i], x1[2 * i + 1]); }
#pragma unroll
        for (int k = 0; k < 4; ++k) { typedef unsigned u32x4_ __attribute__((ext_vector_type(4))); u32x4_ t; t.x = w_[4 * k]; t.y = w_[4 * k + 1]; t.z = w_[4 * k + 2]; t.w = w_[4 * k + 3]; pw_[k] = __builtin_bit_cast(bf16x8, t); }
        const LAS unsigned char* vb_ = Vs + ((lane >> 4) & 1) * 32 + (lane & 3) * 8 + (4 * hi + ((lane & 15) >> 2)) * 64;
#pragma unroll
        for (int d0 = 0; d0 < 2; ++d0)
#pragma unroll
            for (int ks = 0; ks < 4; ++ks) { if ((LV == 1 && ks == 3) || (LV == 2 && ks == 0)) continue;
                const s16x4 lo = vtr(vb_ + d0 * 4096 + ks * 1024), hh = vtr(vb_ + d0 * 4096 + ks * 1024 + 512);
                const bf16x8 vf = (bf16x8){lo[0], lo[1], lo[2], lo[3], hh[0], hh[1], hh[2], hh[3]};
                o[d0] = __builtin_amdgcn_mfma_f32_32x32x16_bf16(vf, pw_[ks], o[d0], 0, 0, 0); }
        if (pre) k_load_half(kfa, Ksn, 0, lane & 31, hi);
        return; }
    if (VAR == 3) { if (pre) k_load_half(kfa, Ksn, 0, lane & 31, hi); l += x0[0] + x1[15] + x0[7] + x1[3]; o[0][0] += x0[1]; o[1][0] += x1[1]; return; }
    float rm = -INFINITY;
#pragma unroll
    for (int r = 0; r < 16; ++r) { if (live0<LV>(r)) rm = fmaxf(rm, x0[r]); if (live1<LV>(r)) rm = fmaxf(rm, x1[r]); }
    rm = hmax(rm);
    const float mn = fmaxf(m, RAW ? rm * C2 : rm);
    { const float sc = __builtin_amdgcn_exp2f(m - mn); l *= sc;
#pragma unroll
      for (int r = 0; r < 16; ++r) { o[0][r] *= sc; o[1][r] *= sc; } }
    m = mn;
    float sum = 0.f;
#pragma unroll
    for (int r = 0; r < 16; ++r) {
        if (live0<LV>(r)) { x0[r] = __builtin_amdgcn_exp2f(RAW ? __builtin_fmaf(x0[r], C2, -mn) : x0[r] - mn); sum += x0[r]; } else x0[r] = 0.f;
        if (live1<LV>(r)) { x1[r] = __builtin_amdgcn_exp2f(RAW ? __builtin_fmaf(x1[r], C2, -mn) : x1[r] - mn); sum += x1[r]; } else x1[r] = 0.f;
    }
    l += sum;
    bf16x8 pw[4];
    { unsigned w[16];
#pragma unroll
      for (int i = 0; i < 8; ++i) { w[i] = cvtpk(x0[2 * i], x0[2 * i + 1]); w[8 + i] = cvtpk(x1[2 * i], x1[2 * i + 1]); }
#pragma unroll
      for (int k = 0; k < 4; ++k) { typedef unsigned u32x4_ __attribute__((ext_vector_type(4))); u32x4_ t; t.x = w[4 * k]; t.y = w[4 * k + 1]; t.z = w[4 * k + 2]; t.w = w[4 * k + 3]; pw[k] = __builtin_bit_cast(bf16x8, t); } }
    if (pre) k_load_half(kfa, Ksn, 0, lane & 31, hi);
    const LAS unsigned char* vb = Vs + ((lane >> 4) & 1) * 32 + (lane & 3) * 8 + (4 * hi + ((lane & 15) >> 2)) * 64;
#pragma unroll
    for (int d0 = 0; d0 < 2; ++d0)
#pragma unroll
        for (int ks = 0; ks < 4; ++ks) {
            if ((LV == 1 && ks == 3) || (LV == 2 && ks == 0)) continue;
            const s16x4 lo = vtr(vb + d0 * 4096 + ks * 1024), hh = vtr(vb + d0 * 4096 + ks * 1024 + 512);
            const bf16x8 vf = (bf16x8){lo[0], lo[1], lo[2], lo[3], hh[0], hh[1], hh[2], hh[3]};
            o[d0] = __builtin_amdgcn_mfma_f32_32x32x16_bf16(vf, pw[ks], o[d0], 0, 0, 0);
        }
}
__device__ __forceinline__ void o_store(const f32x16 (&o)[2], float l, bf16* orow, int hi) {
    const float inv = __builtin_amdgcn_rcpf(hsum(l));
#pragma unroll
    for (int d0 = 0; d0 < 2; ++d0)
#pragma unroll
        for (int gp = 0; gp < 2; ++gp) {
            unsigned w[2][2];
#pragma unroll
            for (int k = 0; k < 2; ++k) { const int g = 2 * gp + k; w[k][0] = cvtpk(o[d0][4 * g] * inv, o[d0][4 * g + 1] * inv); w[k][1] = cvtpk(o[d0][4 * g + 2] * inv, o[d0][4 * g + 3] * inv); }
            unsigned rcv[2];
#pragma unroll
            for (int i = 0; i < 2; ++i) { const unsigned snd = hi ? w[0][i] : w[1][i];
                auto rr = __builtin_amdgcn_permlane32_swap(snd, snd, false, false); rcv[i] = hi ? rr[0] : rr[1]; }
            v4u st; if (hi) { st.x = rcv[0]; st.y = rcv[1]; st.z = w[1][0]; st.w = w[1][1]; } else { st.x = w[0][0]; st.y = w[0][1]; st.z = rcv[0]; st.w = rcv[1]; }
            *(v4u*)(orow + 32 * d0 + 16 * gp + 8 * hi) = st;
        }
}
__device__ __forceinline__ void o_store8(const f32x16 (&o)[2], float l, unsigned char* orow, int hi) {
    const float inv = __builtin_amdgcn_rcpf(hsum(l)) * 16.0f;
#pragma unroll
    for (int d0 = 0; d0 < 2; ++d0) {
        unsigned p[4];
#pragma unroll
        for (int g = 0; g < 4; ++g) p[g] = pg8::pk4_fp8(pg8::clamp_fp8(o[d0][4 * g] * inv), pg8::clamp_fp8(o[d0][4 * g + 1] * inv), pg8::clamp_fp8(o[d0][4 * g + 2] * inv), pg8::clamp_fp8(o[d0][4 * g + 3] * inv));
#pragma unroll
        for (int gp = 0; gp < 2; ++gp) { const unsigned snd = hi ? p[2 * gp] : p[2 * gp + 1];
            auto rr = __builtin_amdgcn_permlane32_swap(snd, snd, false, false); const unsigned rcv = hi ? rr[0] : rr[1];
            v2u st; if (hi) { st.x = rcv; st.y = p[2 * gp + 1]; } else { st.x = p[2 * gp]; st.y = rcv; }
            *(v2u*)(orow + 32 * d0 + 16 * gp + 8 * hi) = st; }
    }
}
#define AT_WAIT_BAR(N) asm volatile("s_waitcnt vmcnt(" #N ")\n\ts_barrier" ::: "memory")

struct UDesc { int kind, b, hh, blk, cq, nw, lo; };
__device__ __forceinline__ UDesc unit_desc(int i, int vcu, int UPW, bool ctx_out) {
    UDesc d; d.kind = -1; d.b = 0; d.hh = 0; d.blk = 0; d.cq = 0; d.nw = 0; d.lo = 0;
    if (i < 2 * UPW) { const int u = vcu * UPW + (i < UPW ? i : i - UPW); if (u >= 1024) return d; d.kind = i < UPW ? 0 : 1; d.b = u >> 8;
        if (d.kind == 0) { d.hh = (u >> 5) & 7; d.blk = u & 31; } else { d.hh = (u >> 7) & 1; d.blk = u & 127; } }
    else if (i == 2 * UPW) { if (!ctx_out || vcu >= 64) return d; d.cq = 1;
        if (vcu < 32) { d.kind = 1; d.b = vcu >> 3; d.hh = (vcu >> 2) & 1; d.blk = vcu & 3; } else { d.kind = 0; d.b = (vcu - 32) >> 3; d.hh = (vcu - 32) & 7; d.blk = 0; } }
    else return d;
    if (!d.cq) {
        if (d.kind == 1) { d.lo = max(0, 2 - d.blk); d.nw = min(4, 129 - d.blk) - d.lo + 1; }
        else { d.lo = min(max(4 * d.blk - 4, 0), 120); d.nw = min(max(4 * d.blk - 1, 0), 120) + 7 - d.lo + 1; }
    }
    return d;
}
__device__ __forceinline__ void tile_src(const UDesc& d, int t, int& row0, int& cols) {
    const int kcol = d.kind == 1 ? C_KA + d.hh * 64 : C_KN + d.hh * 64, vcol = d.kind == 1 ? C_VA + d.hh * 64 : C_VN + d.hh * 64;
    cols = kcol | (vcol << 16);
    if (t < d.nw) row0 = d.kind == 1 ? d.b * SEQ + 64 * d.blk - 128 + 64 * (d.lo + t) : d.b * SEQ + 64 * (d.lo + t);
    else row0 = TL + d.b * CTXL + 64 * (t - d.nw);
}
__device__ __forceinline__ size_t q_row(const UDesc& d, int wid, int r32) {
    if (d.kind == 1) { const int qrel = 32 * (wid >> 2) + r32; return d.cq ? (size_t)TL + (size_t)d.b * CTXL + 64 * d.blk + qrel : (size_t)d.b * SEQ + 64 * d.blk + qrel; }
    const int pair = wid >> 1, c = 32 * (wid & 1) + r32;
    return d.cq ? (size_t)TL + (size_t)d.b * CTXL + 64 * pair + c : (size_t)d.b * SEQ + (size_t)(4 * d.blk + pair) * 64 + c;
}
__device__ __forceinline__ void q_load(const UDesc& d, const bf16* ZMp, int wid, int r32, int hi, bf16x8 (&qr)[4]) {
    const int qcol = d.kind == 1 ? C_QA + (d.hh * 4 + (wid & 3)) * 64 : C_QN + d.hh * 64;
    const bf16* p = ZMp + q_row(d, wid, r32) * ZMC + qcol + 8 * hi;
#pragma unroll
    for (int d0 = 0; d0 < 4; ++d0) qr[d0] = *(const bf16x8*)(p + 16 * d0);
}

template <int VAR = 0>
__device__ __forceinline__ void attn_phase(LAS unsigned char* lds, const bf16* ZMp, bf16* OAp, bf16* OCp, const float* sinkp, const float* rpbl, int vcu, int G, bool ctx_out, int tid, int wid, int lane) {
    const int r32 = lane & 31, hi = lane >> 5;
    const int UPW = (1024 + G - 1) / G, NU = 2 * UPW + 1;
    LAS int* tt = (LAS int*)(lds + LDS_TT);
    int Ttot = 0;
    for (int i = 0; i < NU; ++i) { const UDesc d = unit_desc(i, vcu, UPW, ctx_out); if (d.kind < 0) continue; const int nt = d.nw + 4;
        for (int t = tid; t < nt; t += NWAVES * 64) { int row0, cols; tile_src(d, t, row0, cols); if (Ttot + t < MAXT) { tt[2 * (Ttot + t)] = row0; tt[2 * (Ttot + t) + 1] = cols; } }
        Ttot += nt; }
    if (Ttot > MAXT) Ttot = MAXT;
    if (tid < 8) ((LAS float*)(lds + LDS_TT + MAXT * 8))[tid] = sinkp[tid] * LOG2E;
    for (int u = tid; u < 8 * 480; u += NWAVES * 64) { const int h = u / 480, e = u - 480 * h, dr = e >> 5, dc = e & 31; ((LAS float*)(lds + LDS_TAB))[h * 512 + e] = dc < 31 ? rpbl[(h * 15 + dr) * 31 + dc] * LOG2E : 0.f; }
    asm volatile("s_waitcnt lgkmcnt(0)\n\ts_barrier" ::: "memory");
#define AT_ISSUE(T) do { const int row0_ = __builtin_amdgcn_readfirstlane(tt[2 * (T)]), cols_ = __builtin_amdgcn_readfirstlane(tt[2 * (T) + 1]); \
        tile_issue(lds + ((T) & (NS - 1)) * SLOT, ZMp, (size_t)row0_, cols_ & 0xffff, cols_ >> 16, wid, lane); } while (0)
    for (int T = 0; T < PF && T < Ttot; ++T) AT_ISSUE(T);
    int Tb = 0;
    bf16x8 qn[4];
    { int i0 = 0; UDesc d0 = unit_desc(0, vcu, UPW, ctx_out); while (d0.kind < 0 && i0 + 1 < NU) { ++i0; d0 = unit_desc(i0, vcu, UPW, ctx_out); } if (d0.kind >= 0) q_load(d0, ZMp, wid, r32, hi, qn); }
    for (int i = 0; i < NU; ++i) {
        const UDesc d = unit_desc(i, vcu, UPW, ctx_out); if (d.kind < 0) continue;
        const int lane_u = mk_lane(), r32 = lane_u & 31, hi = lane_u >> 5;
        bf16x8 qr[4];
#pragma unroll
        for (int k = 0; k < 4; ++k) qr[k] = qn[k];
        { int j = i + 1; UDesc dn = unit_desc(j, vcu, UPW, ctx_out); while (dn.kind < 0 && j + 1 < NU) { ++j; dn = unit_desc(j, vcu, UPW, ctx_out); } if (dn.kind < 0) dn = d; q_load(dn, ZMp, wid, r32, hi, qn); }
        const int NT = d.nw + 4;
        f32x16 o[2];
#pragma unroll
        for (int r = 0; r < 16; ++r) { o[0][r] = 0.f; o[1][r] = 0.f; }
        float m, l;
        if (d.kind == 1) {
            const int head = d.hh * 4 + (wid & 3), qrel = 32 * (wid >> 2) + r32;
            m = ((const LAS float*)(lds + LDS_TT + MAXT * 8))[head]; l = (hi == 0) ? 1.0f : 0.0f;
            bf16x8 kfa[4];
#pragma unroll
            for (int k = 0; k < 4; ++k) kfa[k] = (bf16x8){0, 0, 0, 0, 0, 0, 0, 0};
            int t = 0;
            do {
                const int T = Tb + t;
                if (T + 2 < Ttot) AT_WAIT_BAR(2); else AT_WAIT_BAR(0);
                if (t == NT - 1) asm volatile("" : "+v"(qn[0]), "+v"(qn[1]), "+v"(qn[2]), "+v"(qn[3]));
                if (VAR != 5 && T + PF < Ttot) AT_ISSUE(T + PF);
                const LAS unsigned char* sl = lds + (T & (NS - 1)) * SLOT;
                const LAS unsigned char* sln = lds + ((T + 1) & (NS - 1)) * SLOT; const bool pre = t + 1 < NT;
                if (t == 0) k_load_half(kfa, sl, 0, r32, hi);
                f32x16 x0, x1; qk_tile(x0, x1, sl, kfa, qr, r32, hi);
                const int j = d.lo + t;
                if (t < d.nw && (j == 0 || j == 4)) {
                    const int dq = qrel + 128 - 64 * j - 4 * hi;
#pragma unroll
                    for (int r = 0; r < 16; ++r) { const int dd = dq - ((r & 3) + 8 * (r >> 2));
                        x0[r] = (dd <= 128 && dd >= -128) ? x0[r] * C2 : -INFINITY; x1[r] = (dd - 32 <= 128 && dd - 32 >= -128) ? x1[r] * C2 : -INFINITY; }
                    sm_pv<false, 0, VAR>(x0, x1, m, l, o, sl + 8192, lane, hi, kfa, sln, pre);
                } else sm_pv<true, 0, VAR>(x0, x1, m, l, o, sl + 8192, lane, hi, kfa, sln, pre);
            } while (++t < NT);
            if (MK_P4_F8) o_store8(o, l, (unsigned char*)OAp + q_row(d, wid, r32) * BW + head * 64, hi); else o_store(o, l, OAp + q_row(d, wid, r32) * BW + head * 64, hi);
        } else {
            const int half = wid & 1, c = 32 * half + r32, r = 4 * d.blk + (wid >> 1);
            const int r0w = min(max(r - 4, 0), 120), c0 = min(max(c - 8, 0), 48);
            const LAS float* tab = (const LAS float*)(lds + LDS_TAB + d.hh * 2048);
            unsigned vm = 0u;
#pragma unroll
            for (int r_ = 0; r_ < 16; ++r_) { const int kc = (r_ & 3) + 8 * (r_ >> 2) + 4 * hi; vm |= ((unsigned)(kc - c0) < 16u ? 1u : 0u) << r_; vm |= ((unsigned)(kc + 32 - c0) < 16u ? 1u : 0u) << (16 + r_); }
            m = -1e30f; l = 0.f;
            bf16x8 kfa[4];
#pragma unroll
            for (int k = 0; k < 4; ++k) kfa[k] = (bf16x8){0, 0, 0, 0, 0, 0, 0, 0};
            int t = 0;
            do {
                const int T = Tb + t;
                if (T + 2 < Ttot) AT_WAIT_BAR(2); else AT_WAIT_BAR(0);
                if (t == NT - 1) asm volatile("" : "+v"(qn[0]), "+v"(qn[1]), "+v"(qn[2]), "+v"(qn[3]));
                if (VAR != 5 && T + PF < Ttot) AT_ISSUE(T + PF);
                const int kr = d.lo + t;
                const bool use = !(t < d.nw && (kr < r0w || kr > r0w + 7));
                const bool usen = !(t + 1 < d.nw && (kr + 1 < r0w || kr + 1 > r0w + 7));
                const LAS unsigned char* sl = lds + (T & (NS - 1)) * SLOT; const LAS unsigned char* sln = lds + ((T + 1) & (NS - 1)) * SLOT; const bool pre = usen && t + 1 < NT;
                if (!use) { if (pre) k_load_half(kfa, sln, 0, r32, hi); continue; }
                if (t == 0) k_load_half(kfa, sl, 0, r32, hi);
                f32x16 x0, x1; qk_tile(x0, x1, sl, kfa, qr, r32, hi);
                if (t < d.nw) {
                    const LAS float* tb = tab + (kr - r + 7) * 32 + (4 * hi - c + 15);
                    if (half == 0) {
                        float b0[16], b1[4];
#pragma unroll
                        for (int r_ = 0; r_ < 16; ++r_) { const int rr = (r_ & 3) + 8 * (r_ >> 2); b0[r_] = tb[rr]; if (r_ < 4) b1[r_] = tb[rr + 32]; }
#pragma unroll
                        for (int r_ = 0; r_ < 16; ++r_) {
                            x0[r_] = ((vm >> r_) & 1u) ? __builtin_fmaf(x0[r_], C2, b0[r_]) : -INFINITY;
                            if (r_ < 4) x1[r_] = ((vm >> (16 + r_)) & 1u) ? __builtin_fmaf(x1[r_], C2, b1[r_]) : -INFINITY; }
                        sm_pv<false, 1, VAR>(x0, x1, m, l, o, sl + 8192, lane, hi, kfa, sln, pre);
                    } else {
                        float b0[4], b1[16];
#pragma unroll
                        for (int r_ = 0; r_ < 16; ++r_) { const int rr = (r_ & 3) + 8 * (r_ >> 2); if (r_ >= 12) b0[r_ - 12] = tb[rr]; b1[r_] = tb[rr + 32]; }
#pragma unroll
                        for (int r_ = 0; r_ < 16; ++r_) {
                            if (r_ >= 12) x0[r_] = ((vm >> r_) & 1u) ? __builtin_fmaf(x0[r_], C2, b0[r_ - 12]) : -INFINITY;
                            x1[r_] = ((vm >> (16 + r_)) & 1u) ? __builtin_fmaf(x1[r_], C2, b1[r_]) : -INFINITY; }
                        sm_pv<false, 2, VAR>(x0, x1, m, l, o, sl + 8192, lane, hi, kfa, sln, pre);
                    }
                } else sm_pv<true, 0, VAR>(x0, x1, m, l, o, sl + 8192, lane, hi, kfa, sln, pre);
            } while (++t < NT);
            if (MK_P4_F8) o_store8(o, l, (unsigned char*)OCp + q_row(d, wid, r32) * BW + d.hh * 64, hi); else o_store(o, l, OCp + q_row(d, wid, r32) * BW + d.hh * 64, hi);
        }
        Tb += NT;
    }
    AT_WAIT_BAR(0);
#undef AT_ISSUE
}
}

constexpr int PH_PER_LAYER = 17, NPHASES = 1 + DEPTH * PH_PER_LAYER;
struct Args { const float* in[23]; float* out; unsigned char* ws; int ph_lo, ph_hi; };
typedef __attribute__((address_space(4))) const Args CArgs;
__global__ void __launch_bounds__(NWAVES * 64, 2) mk_fwd(Args args) {
    extern __shared__ __attribute__((aligned(16))) unsigned char lds[];
    Frame F;
    F.lds = (LAS unsigned char*)lds;
    F.MISC = (volatile LAS unsigned*)(F.lds + MISC_OFF);
    F.G = gridDim.x; { const int bx = blockIdx.x; F.vcu = (F.G % 8 == 0) ? (bx % 8) * (F.G / 8) + bx / 8 : bx; }
    F.ctl = (unsigned*)(args.ws + WS_CTL);
    for (int u = threadIdx.x; u < (ROPEL_OFF - LDSCTL_OFF) / 4; u += NWAVES * 64) ((LAS unsigned*)(F.lds + LDSCTL_OFF))[u] = 0u;
    for (int u = threadIdx.x; u < 192 * 16; u += NWAVES * 64) { const int idx = u >> 4, i = u & 15; const float pos = (float)(idx < 128 ? idx : idx - 128);
        const float inv = 1.0f / powf(10000.0f, (float)(2 * i) / 32.0f); const float ang = pos * inv;
        ((LAS float*)(F.lds + ROPEL_OFF))[2 * u] = cosf(ang); ((LAS float*)(F.lds + ROPEL_OFF))[2 * u + 1] = sinf(ang); }
    { int wv_ = __builtin_amdgcn_readfirstlane((int)(threadIdx.x >> 6)); asm volatile("" : "+s"(wv_)); F.wv = wv_; }
    __syncthreads();
    const int lo = args.ph_lo, hi = args.ph_hi;
    const bool fused = (hi - lo) > 1;
    XcdBarrier bar; bar.bar = F.ctl + CW_BAR; bar.x = 0; bar.st = nullptr; bar.w = F.wv;
    if (fused) { bar = xcd_barrier_post(F.ctl + CW_BAR, F.MISC + 8); bar.w = F.wv; }
#ifndef MK_MASK
#define MK_MASK 0xFFFFFFFFu
#endif
#define SLOT(k) ((k) == 0 ? 0 : (((k) - 1) % PH_PER_LAYER) + 1)
#define IN(k) (((MK_MASK >> SLOT(k)) & 1u) && lo <= (k) && (k) < hi)
#define GRID_BAR() do { if (fused) xcd_barrier(bar); } while (0)
constexpr int MOE_I_GUM = (D / 64) * (2 * FFE / 32), MOE_I_DNM = (FFE / 64) * (D / 32), MOE_ITEMS = NE * (MOE_I_GUM + MOE_I_DNM);
#define MOE_TAIL(lo_, hi_, first_) do { if (MK_MOE_TAIL && l == 0 && (int)blockIdx.x >= (first_)) { __syncthreads(); LAS float* scr_ = (LAS float*)(F.lds + RING_OFF + wave * 16384); \
        for (int r_ = (lo_) + ((int)blockIdx.x - (first_)) * NWAVES + wave; r_ < (hi_); r_ += (F.G - (first_)) * NWAVES) { \
            if (r_ < NE * MOE_I_GUM) { const int e_ = r_ / MOE_I_GUM; tr_matrix_item8(INP(I_WGUM) + (size_t)e_ * D * 2 * FFE, D, 2 * FFE, FFE, W_GUM8 + (size_t)e_ * 2 * FFE * D, SC_WGU, r_ % MOE_I_GUM, scr_, lane); } \
            else { const int q_ = r_ - NE * MOE_I_GUM, e_ = q_ / MOE_I_DNM; tr_matrix_item8(INP(I_WDNM) + (size_t)e_ * FFE * D, FFE, D, 0, W_DNM8 + (size_t)e_ * D * FFE, SC_WDN, q_ % MOE_I_DNM, scr_, lane); } } } } while (0)
    const int NGW = F.G * NWAVES;
#define PHASE_ENTER() GAS unsigned char* wsg_ = (GAS unsigned char*)args.ws; asm volatile("" : "+s"(wsg_)); unsigned char* ws = (unsigned char*)wsg_; float* outp = (float*)(GAS float*)args.out; (void)outp; const CArgs* ka = (const CArgs*)__builtin_amdgcn_kernarg_segment_ptr(); asm volatile("" : "+s"(ka)); \
    int tid_ = (F.wv << 6) | mk_lane(); asm volatile("" : "+v"(tid_)); const int lane = tid_ & 63; const int wave = __builtin_amdgcn_readfirstlane(tid_ >> 6); const int gw = F.vcu * NWAVES + wave; (void)gw; (void)lane; (void)ws; (void)ka;
#define INP(i) ((const float*)(const GAS float*)ka->in[i])
#define MOD ((float*)(GAS float*)(ws + WS_MOD))
#define ROPE ((float*)(GAS float*)(ws + WS_ROPE))
#define SLABCNT ((int*)(GAS int*)(ws + WS_SLABCNT))
#define PCUM ((int*)(GAS int*)(ws + WS_PCUM))
#define TOKER ((int*)(GAS int*)(ws + WS_TOKER))
#define TOKG ((float*)(GAS float*)(ws + WS_TOKG))
#define TOKPOS ((int*)(GAS int*)(ws + WS_TOKPOS))
#define HCTX ((float*)(GAS float*)(ws + WS_HCTX))
#define RS ((bf16*)(GAS bf16*)(ws + WS_RS))
#define W_IN ((bf16*)(GAS bf16*)(ws + WS_WIN))
#define W_BR ((bf16*)(GAS bf16*)(ws + WS_WBR))
#define W_OUT ((bf16*)(GAS bf16*)(ws + WS_WOUT))
#define W_GUD ((bf16*)(GAS bf16*)(ws + WS_WGUD))
#define W_DND ((bf16*)(GAS bf16*)(ws + WS_WDND))
#define W_GUM8 ((unsigned char*)(GAS unsigned char*)(ws + WS_WGUM))
#define W_DNM8 ((unsigned char*)(GAS unsigned char*)(ws + WS_WDNM))
#define HX ((bf16*)(GAS bf16*)(ws + WS_HX))
#define ZM ((bf16*)(GAS bf16*)(ws + WS_ZM))
#define ZG ((bf16*)(GAS bf16*)(ws + WS_ZG))
#define OA ((bf16*)(GAS bf16*)(ws + WS_O))
#define OB (OA + (size_t)TA * BW)
#define OC (OA + (size_t)2 * TA * BW)
#define SB ((float*)(GAS float*)(ws + WS_ZM))
#define Y16 ((bf16*)(GAS bf16*)(ws + WS_ZG))
#define HD ((bf16*)(GAS bf16*)(ws + WS_ZM))
#define XG ((bf16*)(GAS bf16*)(ws + WS_XG))
#define HM8 ((unsigned char*)(GAS unsigned char*)(ws + WS_HM))
#define XG8 ((unsigned char*)(GAS unsigned char*)(ws + WS_XG8))
#define HX8 ((unsigned char*)(GAS unsigned char*)(ws + WS_HX8))
#define W_ING8 ((unsigned char*)(GAS unsigned char*)(ws + WS_WING8))

    if (IN(0)) {
        PHASE_ENTER();
        {
            LAS float* scv = (LAS float*)(F.lds + RING_OFF);
            LAS float* red = scv + 5 * 1024;
            for (int u = tid_; u < 5 * 1024; u += NWAVES * 64) { const int bb = u >> 10, k = u & 1023; const float cv = bb < 4 ? INP(I_C)[bb * 1024 + k] : INP(I_CCTX)[k]; scv[u] = cv / (1.0f + __expf(-cv)); }
            __syncthreads();
            for (int it = blockIdx.x; it < 2 * 96; it += F.G) {
                const int l = it / 96, n = (it % 96) * 64 + lane;
                const float* wp = INP(I_WADA) + (size_t)l * D * 6144 + n;
                float a0 = 0.f, a1 = 0.f, a2 = 0.f, a3 = 0.f, a4 = 0.f;
                const int kb = wave * 128;
#pragma unroll 16
                for (int k = 0; k < 128; ++k) { const float w = wp[(size_t)(kb + k) * 6144];
                    a0 += scv[kb + k] * w; a1 += scv[1024 + kb + k] * w; a2 += scv[2048 + kb + k] * w; a3 += scv[3072 + kb + k] * w; a4 += scv[4096 + kb + k] * w; }
                red[(wave * 5 + 0) * 64 + lane] = a0; red[(wave * 5 + 1) * 64 + lane] = a1; red[(wave * 5 + 2) * 64 + lane] = a2; red[(wave * 5 + 3) * 64 + lane] = a3; red[(wave * 5 + 4) * 64 + lane] = a4;
                __syncthreads();
                if (tid_ < 320) { const int bb = tid_ >> 6, nn = tid_ & 63; float s = 0.f;
#pragma unroll
                    for (int w = 0; w < 8; ++w) s += red[(w * 5 + bb) * 64 + nn];
                    const int col = (it % 96) * 64 + nn;
                    MOD[((size_t)l * 5 + bb) * 6144 + col] = s + INP(I_BADA)[l * 6144 + col]; }
                __syncthreads();
            }
        }
        __syncthreads();
        {
            LAS float* scr = (LAS float*)(F.lds + RING_OFF + wave * 16384);
            constexpr int I_IN = (D / 64) * (INC / 32), I_BR = (BW / 64) * (D / 32), I_OUT = (D / 64) * (D / 32), I_GUD = (D / 64) * (2 * FFD / 32), I_DND = (FFD / 64) * (D / 32),
                          I_GUM = (D / 64) * (2 * FFE / 32), I_DNM = (FFE / 64) * (D / 32);
            constexpr int NITEMS = 2 * I_IN + 6 * I_BR + 2 * I_OUT + I_GUD + I_DND + (MK_MOE_TAIL ? 0 : NE * I_GUM + NE * I_DNM);
            for (int it = gw; it < NITEMS; it += NGW) {
                int r = it;
                if (r < 2 * I_IN) { const int l = r / I_IN, it2 = r % I_IN, n0 = 32 * (it2 % (INC / 32));
                    if (MK_GATE_F8 == 2) { tr_item8(INP(I_WIN) + (size_t)l * D * INC, INC, 64 * (it2 / (INC / 32)), n0, (unsigned char*)W_IN + (size_t)l * INC * D, D, n0, SC_WGU, scr, lane); continue; }
                    if (MK_L1_ALLF8 && l == DEPTH - 1 && n0 < ZMC) tr_item8(INP(I_WIN) + (size_t)l * D * INC, INC, 64 * (it2 / (INC / 32)), n0, (unsigned char*)(W_IN + (size_t)l * INC * D), D, n0, SC_WGU, scr, lane);
                    else if (MK_L1_F8 && n0 < ZMC && (n0 < 768 || n0 >= 2304)) tr_item8(INP(I_WIN) + (size_t)l * D * INC, INC, 64 * (it2 / (INC / 32)), n0, (unsigned char*)(W_IN + (size_t)l * INC * D) + (size_t)ZMC * D * 2, D, n0 < 768 ? n0 : n0 - 1536, SC_WGU, scr, lane);
                    else if (!MK_GATE_F8 || n0 < ZMC) tr_matrix_item(INP(I_WIN) + (size_t)l * D * INC, D, INC, 0, W_IN + (size_t)l * INC * D, it2, scr, lane);
                    if (MK_GATE_F8 && n0 >= ZMC) tr_item8(INP(I_WIN) + (size_t)l * D * INC, INC, 64 * (it2 / (INC / 32)), n0, W_ING8 + (size_t)l * ZGC * D, D, n0 - ZMC, SC_WGU, scr, lane);
                    continue; } r -= 2 * I_IN;
                if (r < 6 * I_BR) { const int q = r / I_BR; if (MK_P4_F8) tr_matrix_item8(INP(I_WBRANCH) + (size_t)q * BW * D, BW, D, 0, (unsigned char*)W_BR + (size_t)q * D * BW, SC_WBR, r % I_BR, scr, lane);
                    else tr_matrix_item(INP(I_WBRANCH) + (size_t)q * BW * D, BW, D, 0, W_BR + (size_t)q * D * BW, r % I_BR, scr, lane); continue; } r -= 6 * I_BR;
                if (r < 2 * I_OUT) { const int l = r / I_OUT; if (MK_P5L1_F8 && MK_P4_F8 && l == DEPTH - 1) tr_matrix_item8(INP(I_WOUT) + (size_t)l * D * D, D, D, 0, (unsigned char*)(W_OUT + (size_t)l * D * D), SC_WGU, r % I_OUT, scr, lane);
                    else tr_matrix_item(INP(I_WOUT) + (size_t)l * D * D, D, D, 0, W_OUT + (size_t)l * D * D, r % I_OUT, scr, lane); continue; } r -= 2 * I_OUT;
                if (r < I_GUD) { if (MK_DENSE_F8 >= 2) tr_matrix_item8(INP(I_WGUD), D, 2 * FFD, FFD, (unsigned char*)W_GUD, SC_WGU, r, scr, lane); else tr_matrix_item(INP(I_WGUD), D, 2 * FFD, FFD, W_GUD, r, scr, lane); continue; } r -= I_GUD;
                if (r < I_DND) { if (MK_DENSE_F8 >= 1) tr_matrix_item8(INP(I_WDND), FFD, D, 0, (unsigned char*)W_DND, SC_WDN, r, scr, lane); else tr_matrix_item(INP(I_WDND), FFD, D, 0, W_DND, r, scr, lane); continue; } r -= I_DND;
                if (r < NE * I_GUM) { const int e = r / I_GUM; tr_matrix_item8(INP(I_WGUM) + (size_t)e * D * 2 * FFE, D, 2 * FFE, FFE, W_GUM8 + (size_t)e * 2 * FFE * D, SC_WGU, r % I_GUM, scr, lane); continue; } r -= NE * I_GUM;
                { const int e = r / I_DNM; tr_matrix_item8(INP(I_WDNM) + (size_t)e * FFE * D, FFE, D, 0, W_DNM8 + (size_t)e * D * FFE, SC_WDN, r % I_DNM, scr, lane); }
            }
        }
        GRID_BAR();
    }

    for (int l = 0; l < DEPTH; ++l) {
        const int pb = 1 + l * PH_PER_LAYER;
        const bool ctx_out = (l < DEPTH - 1);
        const bool moe = (l & 1) != 0;
        const int rows_out = ctx_out ? TA : TL;
#define modl (MOD + (size_t)l * 5 * 6144)
#define xsrc_lat ((l == 0) ? INP(I_X) : (const float*)outp)
#define xsrc_ctx ((l == 0) ? INP(I_CTX) : (const float*)HCTX)

        if (IN(pb + 0) && l == 0) {
            PHASE_ENTER();
            const int chunk = (TL + NGW - 1) / NGW;
#define P1_ROW(t) do { const float* xr = (t) < TL ? xsrc_lat + (size_t)(t) * D : xsrc_ctx + (size_t)((t) - TL) * D; \
                f32x4 x[4], h[4]; row_load(xr, lane, x); const float rr = row_rrms(x); row_normmod(x, rr, gpre, sh, sc, h); if (MK_GATE_F8 < 2) row_store_bf16(HX + (size_t)(t) * D, lane, h); if (MK_GATE_F8) row_store_fp8(HX8 + (size_t)(t) * D, lane, h, SC_XG); } while (0)
            f32x4 gpre[4], sh[4], sc[4]; vec_load(INP(I_GPREMIX) + l * D, lane, gpre);
            for (int t0 = min(gw * chunk, TL), t1 = min(TL, t0 + chunk); t0 < t1; ) { const int bb = t0 >> 13, te = min(t1, (bb + 1) << 13); const float* md = modl + (size_t)bb * 6144;
                vec_load(md, lane, sh); vec_load(md + 1024, lane, sc);
                for (int t = t0; t < te; ++t) P1_ROW(t);
                t0 = te; }
            { const float* md = modl + (size_t)4 * 6144; vec_load(md, lane, sh); vec_load(md + 1024, lane, sc); for (int t = TL + gw; t < TA; t += NGW) P1_ROW(t); }
#undef P1_ROW
            GRID_BAR();
        }
        if (IN(pb + 1)) {
            PHASE_ENTER();
#if MK_GATE_F8 == 2
            {
                pg8::Gemm g{(const bf16*)HX8, (const bf16*)((unsigned char*)W_IN + (size_t)l * INC * D), TA, ZMC, D}; pg8::StaticOrder S; S.init(TA, ZMC, F.G, (int)blockIdx.x, MK_WGM);
                pg8::EpiZT<true> E{ZM, ZG, ROPE, TL / 256, INP(I_BGATE) + (size_t)l * 3 * D, 0, 1.0f / (SC_XG * SC_WGU)};
                pg8::gemm_phase<pg8::EpiZT<true>, pg8::StaticOrder, PG8_ALIGN, PG8_SP2>(F.lds + RING_OFF, g, S, E, F.wv);
            }
            {
                pg8::Gemm g{(const bf16*)HX8, (const bf16*)((unsigned char*)W_IN + (size_t)l * INC * D + (size_t)ZMC * D), rows_out, ZGC, D}; pg8::StaticOrder S; S.init(rows_out, ZGC, F.G, (int)blockIdx.x, MK_WGM);
                pg8::EpiZT<true> E{ZM, ZG, ROPE, TL / 256, INP(I_BGATE) + (size_t)l * 3 * D, ZMC / 256, 1.0f / (SC_XG * SC_WGU)};
                pg8::gemm_phase<pg8::EpiZT<true>, pg8::StaticOrder, PG8_ALIGN, PG8_SP2>(F.lds + RING_OFF, g, S, E, F.wv);
            }
#elif MK_GATE_F8
            {
                if (MK_L1_ALLF8 && l == DEPTH - 1) {
                    pg8::MapOrder S; S.so.init(TA, ZMC, F.G, (int)blockIdx.x, MK_WGM); S.cut = 99; S.add = 0;
                    pg8::Gemm g{(const bf16*)HX8, (const bf16*)(W_IN + (size_t)l * INC * D), TA, ZMC, D};
                    pg8::EpiZMT<true> E{ZM, (const LAS float*)(F.lds + ROPEL_OFF), TL / 256, 1.0f / (SC_XG * SC_WGU), 0};
                    pg8::gemm_phase<pg8::EpiZMT<true>, pg8::MapOrder, PG8_ALIGN, PG8_SP2>(F.lds + RING_OFF, g, S, E, F.wv);
                } else {
                    {   pg8::StaticOrder S; S.init(TA, 6 * 256, F.G, (int)blockIdx.x, MK_WGM);
                        pg8::Gemm g{HX, W_IN + (size_t)l * INC * D + (size_t)3 * 256 * D, TA, 6 * 256, D};
                        pg8::EpiZM E{ZM, (const LAS float*)(F.lds + ROPEL_OFF), TL / 256, 1.0f, 3};
                        pg8::gemm_phase<pg8::EpiZM, pg8::StaticOrder, PG8_ALIGN, PG8_SP2>(F.lds + RING_OFF, g, S, E, F.wv); }
                    {   pg8::MapOrder S; S.so.init(TA, 9 * 256, F.G, ((int)blockIdx.x + F.G - 24) % F.G, MK_WGM); S.cut = 3; S.add = 6;
                        pg8::Gemm g{(const bf16*)HX8, (const bf16*)((unsigned char*)(W_IN + (size_t)l * INC * D) + (size_t)ZMC * D * 2), TA, 9 * 256, D};
                        pg8::EpiZMT<true> E{ZM, (const LAS float*)(F.lds + ROPEL_OFF), TL / 256, 1.0f / (SC_XG * SC_WGU), 0};
                        pg8::gemm_phase<pg8::EpiZMT<true>, pg8::MapOrder, PG8_ALIGN, PG8_SP2>(F.lds + RING_OFF, g, S, E, F.wv); }
                }
            }
            {
                pg8::Gemm g{(const bf16*)HX8, (const bf16*)(W_ING8 + (size_t)l * ZGC * D), rows_out, ZGC, D}; pg8::StaticOrder S; S.init(rows_out, ZGC, F.G, ((int)blockIdx.x + 68) % F.G, MK_WGM);
                pg8::EpiZGate E{(unsigned char*)ZG, INP(I_BGATE) + (size_t)l * 3 * D, 1.0f / (SC_XG * SC_WGU)};
                pg8::gemm_phase<pg8::EpiZGate, pg8::StaticOrder, PG8_ALIGN, PG8_SP2>(F.lds + RING_OFF, g, S, E, F.wv);
            }
#else
            pg8::Gemm g{HX, W_IN + (size_t)l * INC * D, TA, INC, D}; pg8::StaticOrder S; S.init(TA, INC, F.G, (int)blockIdx.x, MK_WGM);
            pg8::EpiZ E{ZM, ZG, ROPE, TL / 256, INP(I_BGATE) + (size_t)l * 3 * D, 0, 1.0f};
            pg8::gemm_phase<pg8::EpiZ, pg8::StaticOrder, PG8_ALIGN, PG8_SP2>(F.lds + RING_OFF, g, S, E, F.wv);
#endif
            GRID_BAR();
        }
        if (IN(pb + 3)) {
            PHASE_ENTER();
            const float* sinkp = INP(I_SINK) + l * 8; const float* rpbp = INP(I_RPB) + (size_t)l * 8 * 15 * 31;
            const float* cw = INP(I_CONVW) + (size_t)l * 3 * BW;
            {
                const int ch = 8 * lane;
                float cwr[3][8];
#pragma unroll
                for (int k = 0; k < 3; ++k) { const f32x4 a = *(const f32x4*)(cw + k * BW + ch), b = *(const f32x4*)(cw + k * BW + ch + 4); cwr[k][0] = a.x; cwr[k][1] = a.y; cwr[k][2] = a.z; cwr[k][3] = a.w; cwr[k][4] = b.x; cwr[k][5] = b.y; cwr[k][6] = b.z; cwr[k][7] = b.w; }
#define CONV_U(row, u) do { const bf16* zp_ = ZM + (size_t)(row) * ZMC; const v4u a_ = *(const v4u*)(zp_ + C_UX + ch), g_ = *(const v4u*)(zp_ + C_GC + ch); \
                    u[0] = bflo(a_.x) * bflo(g_.x); u[1] = bfhi(a_.x) * bfhi(g_.x); u[2] = bflo(a_.y) * bflo(g_.y); u[3] = bfhi(a_.y) * bfhi(g_.y); \
                    u[4] = bflo(a_.z) * bflo(g_.z); u[5] = bfhi(a_.z) * bfhi(g_.z); u[6] = bflo(a_.w) * bflo(g_.w); u[7] = bfhi(a_.w) * bfhi(g_.w); } while (0)
#define CONV_Z(u) do { _Pragma("unroll") for (int q_ = 0; q_ < 8; ++q_) u[q_] = 0.f; } while (0)
#define CONV_OUT(t) do { const v4u gbv = *(const v4u*)(ZM + (size_t)(t) * ZMC + C_GB + ch); \
                    const float gb[8] = {bflo(gbv.x), bfhi(gbv.x), bflo(gbv.y), bfhi(gbv.y), bflo(gbv.z), bfhi(gbv.z), bflo(gbv.w), bfhi(gbv.w)}; float o[8]; \
                    _Pragma("unroll") for (int q = 0; q < 8; ++q) o[q] = gb[q] * (cwr[0][q] * um[q] + cwr[1][q] * uc[q] + cwr[2][q] * up[q]); \
                    if (MK_P4_F8) { v2u w8; w8.x = pg8::pk4_fp8(pg8::clamp_fp8(o[0] * SC_O), pg8::clamp_fp8(o[1] * SC_O), pg8::clamp_fp8(o[2] * SC_O), pg8::clamp_fp8(o[3] * SC_O)); \
                        w8.y = pg8::pk4_fp8(pg8::clamp_fp8(o[4] * SC_O), pg8::clamp_fp8(o[5] * SC_O), pg8::clamp_fp8(o[6] * SC_O), pg8::clamp_fp8(o[7] * SC_O)); \
                        *(v2u*)((unsigned char*)(GAS unsigned char*)(ws + WS_O) + (size_t)TA * BW + (size_t)(t) * BW + ch) = w8; } \
                    else { v4u w; w.x = pk2(o[0], o[1]); w.y = pk2(o[2], o[3]); w.z = pk2(o[4], o[5]); w.w = pk2(o[6], o[7]); \
                    *(v4u*)(OB + (size_t)(t) * BW + ch) = w; } } while (0)
                const int cchunk = (TL + NGW - 1) / NGW;
                const int t0 = min(gw * cchunk, TL), t1 = min(TL, t0 + cchunk);
                if (t0 < t1) {
                    float um[8], uc[8], up[8];
                    if ((t0 & (SEQ - 1)) > 0) CONV_U(t0 - 1, um); else CONV_Z(um);
                    CONV_U(t0, uc);
                    for (int t = t0; t < t1; ++t) {
                        const int s = t & (SEQ - 1);
                        if (s == 0) CONV_Z(um);
                        if (s + 1 < SEQ) CONV_U(t + 1, up); else CONV_Z(up);
                        CONV_OUT(t);
#pragma unroll
                        for (int q = 0; q < 8; ++q) { um[q] = uc[q]; uc[q] = up[q]; }
                    }
                }
                for (int t = TL + gw; t < rows_out; t += NGW) {
                    const int s = (t - TL) & (CTXL - 1);
                    float um[8], uc[8], up[8];
                    if (s > 0) CONV_U(t - 1, um); else CONV_Z(um);
                    CONV_U(t, uc);
                    if (s + 1 < CTXL) CONV_U(t + 1, up); else CONV_Z(up);
                    CONV_OUT(t);
                }
#undef CONV_U
#undef CONV_Z
#undef CONV_OUT
            }
            if (MK_P4_F8) at::attn_phase(F.lds + RING_OFF, ZM, (bf16*)(GAS bf16*)(ws + WS_O), (bf16*)(GAS bf16*)(ws + WS_O + (size_t)2 * TA * BW), sinkp, rpbp, F.vcu, F.G, ctx_out, tid_, wave, lane);
            else at::attn_phase(F.lds + RING_OFF, ZM, OA, OC, sinkp, rpbp, F.vcu, F.G, ctx_out, tid_, wave, lane);
#ifdef MK_ATTN_PROBE
            at::attn_phase<MK_ATTN_PROBE>(F.lds + RING_OFF, ZM, (bf16*)(GAS bf16*)(ws + WS_HX), (bf16*)(GAS bf16*)(ws + WS_HX) + (size_t)TA * BW, sinkp, rpbp, F.vcu, F.G, ctx_out, tid_, wave, lane);
#endif
            GRID_BAR();
        }
        if (IN(pb + 4)) {
            PHASE_ENTER();
            pg8::BranchOrder3 S; S.so.init(rows_out, D, F.G, (int)blockIdx.x, MK_WGM);
#if MK_P4_F8
            pg8::Gemm g{(const bf16*)(GAS bf16*)(ws + WS_O), (const bf16*)((unsigned char*)W_BR + (size_t)l * 3 * D * BW), rows_out, D, BW};
            pg8::EpiBranchAccT<true> E{HX, ZG, (MK_P5L1_F8 && l == DEPTH - 1) ? 1 : 0};
            pg8::gemm_phase<pg8::EpiBranchAccT<true>, pg8::BranchOrder3, PG8_ALIGN, PG8_SP2>(F.lds + RING_OFF, g, S, E, F.wv);
#else
            pg8::Gemm g{OA, W_BR + (size_t)l * 3 * D * BW, rows_out, D, BW};
            pg8::EpiBranchAcc E{HX, ZG, 0};
            pg8::gemm_phase<pg8::EpiBranchAcc, pg8::BranchOrder3, PG8_ALIGN, PG8_SP2>(F.lds + RING_OFF, g, S, E, F.wv);
#endif
            MOE_TAIL(0, MK_MT_A, 16);
            GRID_BAR();
        }
        if (IN(pb + 5)) {
            PHASE_ENTER();
            pg8::StaticOrder S; S.init(rows_out, D, F.G, (int)blockIdx.x, MK_WGM);
            if (MK_P5L1_F8 && MK_P4_F8 && l == DEPTH - 1) {
                pg8::Gemm g{HX, (const bf16*)(W_OUT + (size_t)l * D * D), rows_out, D, D};
                pg8::EpiBf16PS8 E{Y16, D, 1.0f / (16.0f * SC_WGU)};
                pg8::gemm_phase<pg8::EpiBf16PS8, pg8::StaticOrder, PG8_ALIGN, PG8_SP2>(F.lds + RING_OFF, g, S, E, F.wv);
            } else {
                pg8::Gemm g{HX, W_OUT + (size_t)l * D * D, rows_out, D, D};
                pg8::EpiBf16P E{Y16, D};
                pg8::gemm_phase<pg8::EpiBf16P, pg8::StaticOrder, PG8_ALIGN, PG8_SP2>(F.lds + RING_OFF, g, S, E, F.wv);
            }
            MOE_TAIL(MK_MT_A, MK_MT_B, 16);
            GRID_BAR();
        }
        if (IN(pb + 6)) {
            PHASE_ENTER();
            if (!moe) {
                const int chunk = (TL + NGW - 1) / NGW;
#define P6_ROW(t) do { f32x4 x[4], y[4], h[4]; \
                    if (l == 0) row_load((t) < TL ? INP(I_X) + (size_t)(t) * D : INP(I_CTX) + (size_t)((t) - TL) * D, lane, x); else row_load_bf16(RS + (size_t)(t) * D, lane, x); \
                    row_load_bf16(Y16 + (size_t)(t) * D, lane, y); const float ry = row_rrms(y); \
                    _Pragma("unroll") for (int j = 0; j < 4; ++j) x[j] = x[j] + gt[j] * (y[j] * ry * gpo[j]); \
                    row_store_bf16(RS + (size_t)(t) * D, lane, x); const float rx = row_rrms(x); row_normmod(x, rx, gpre, sh, sc, h); \
                    if (MK_DENSE_F8 >= 2) row_store_fp8((unsigned char*)HX + (size_t)(t) * D, lane, h, SC_XG); else row_store_bf16(HX + (size_t)(t) * D, lane, h); } while (0)
                f32x4 gpo[4], gt[4], gpre[4], sh[4], sc[4]; vec_load(INP(I_GPOSTMIX) + l * D, lane, gpo); vec_load(INP(I_GPREFFN) + l * D, lane, gpre);
                for (int t0 = min(gw * chunk, TL), t1 = min(TL, t0 + chunk); t0 < t1; ) { const int bb = t0 >> 13, te = min(t1, (bb + 1) << 13); const float* md = modl + (size_t)bb * 6144;
                    vec_load(md + 2048, lane, gt); vec_load(md + 3072, lane, sh); vec_load(md + 4096, lane, sc);
                    for (int t = t0; t < te; ++t) P6_ROW(t);
                    t0 = te; }
                if (rows_out > TL) { const float* md = modl + (size_t)4 * 6144; vec_load(md + 2048, lane, gt); vec_load(md + 3072, lane, sh); vec_load(md + 4096, lane, sc); for (int t = TL + gw; t < rows_out; t += NGW) P6_ROW(t); }
#undef P6_ROW
            } else {
                LAS int* sel = (LAS int*)(F.lds + RING_OFF);
                LAS int* rnk = sel + 256;
                LAS f32x4* wrT = (LAS f32x4*)(F.lds + RING_OFF + 4096);
                const float* wr = INP(I_WROUTER) + (size_t)(l >> 1) * D * NE; const float* br = INP(I_BROUTER) + (l >> 1) * NE;
                for (int u = tid_; u < D * NE; u += NWAVES * 64) ((LAS float*)wrT)[(u & 7) * D + (u >> 3)] = wr[u];
                LDS_WAIT(); __syncthreads();
                f32x4 gpo[4], gt[4], gpre[4], sh[4], sc[4]; vec_load(INP(I_GPOSTMIX) + l * D, lane, gpo); vec_load(INP(I_GPREFFN) + l * D, lane, gpre);
                for (int slab = F.vcu; slab < TL / 128; slab += F.G) {
                    { const float* md = modl + (size_t)((slab * 128) >> 13) * 6144; vec_load(md + 2048, lane, gt); vec_load(md + 3072, lane, sh); vec_load(md + 4096, lane, sc); }
                    for (int i = 0; i < 16; ++i) {
                        const int tl_ = wave * 16 + i, t = slab * 128 + tl_;
                        f32x4 x[4], y[4], h[4]; if (l == 0) row_load(INP(I_X) + (size_t)t * D, lane, x); else row_load_bf16(RS + (size_t)t * D, lane, x);
                        row_load_bf16(Y16 + (size_t)t * D, lane, y);
                        const float ry = row_rrms(y);
#pragma unroll
                        for (int j = 0; j < 4; ++j) x[j] = x[j] + gt[j] * (y[j] * ry * gpo[j]);
                        row_store_bf16(RS + (size_t)t * D, lane, x);
                        const float rx = row_rrms(x);
                        row_normmod(x, rx, gpre, sh, sc, h);
                        row_store_fp8((unsigned char*)HX + (size_t)t * D, lane, h, SC_XG);
                        float lg[8];
#pragma unroll
                        for (int e = 0; e < 8; ++e) lg[e] = 0.f;
#pragma unroll
                        for (int e = 0; e < 8; ++e)
#pragma unroll
                            for (int j = 0; j < 4; ++j) { const f32x4 w4 = wrT[e * (D / 4) + 2 * (64 * (j >> 1) + lane) + (j & 1)]; lg[e] += (h[j].x * w4.x + h[j].y * w4.y) + (h[j].z * w4.z + h[j].w * w4.w); }
#pragma unroll
                        for (int e = 0; e < 8; ++e) lg[e] = wave_sum(lg[e]) + br[e];
                        int e1 = 0; float v1 = lg[0];
#pragma unroll
                        for (int e = 1; e < 8; ++e) if (lg[e] > v1) { v1 = lg[e]; e1 = e; }
                        int e2 = -1; float v2 = -INFINITY;
#pragma unroll
                        for (int e = 0; e < 8; ++e) if (e != e1 && lg[e] > v2) { v2 = lg[e]; e2 = e; }
                        const float ex = __expf(v2 - v1), g1 = 1.0f / (1.0f + ex), g2 = ex / (1.0f + ex);
                        if (lane == 0) { sel[2 * tl_] = e1; sel[2 * tl_ + 1] = e2; TOKG[2 * (size_t)t] = g1; TOKG[2 * (size_t)t + 1] = g2; }
                    }
                    LDS_WAIT(); __syncthreads();
                    if (tid_ < 8) { int cnt = 0; for (int q = 0; q < 256; ++q) if (sel[q] == tid_) { rnk[q] = cnt; ++cnt; } SLABCNT[slab * 8 + tid_] = cnt; }
                    LDS_WAIT(); __syncthreads();
                    if (tid_ < 256) TOKER[(size_t)slab * 256 + tid_] = sel[tid_] | (rnk[tid_] << 8);
                    LDS_WAIT(); __syncthreads();
                }
            }
            GRID_BAR();
        }
        if (IN(pb + 7) && moe) {
            PHASE_ENTER();
            LAS int* scn = (LAS int*)(F.lds + RING_OFF);
            LAS int* pst = scn + 2048;
            for (int u = tid_; u < 2048; u += NWAVES * 64) scn[u] = SLABCNT[u];
            LDS_WAIT(); __syncthreads();
            if (tid_ < 8) { int run = 0; for (int q = 0; q < 256; ++q) { const int c = scn[q * 8 + tid_]; scn[q * 8 + tid_] = run; run += c; } pst[8 + tid_] = run; }
            LDS_WAIT(); __syncthreads();
            if (tid_ == 0) { int pan = 0; for (int e = 0; e < 8; ++e) { pst[e] = pan * 256; if (blockIdx.x == 0) PCUM[e] = pan; pan += (pst[8 + e] + 255) >> 8; } if (blockIdx.x == 0) PCUM[8] = pan; }
            LDS_WAIT(); __syncthreads();
            LAS int* posl = pst + 16;
            for (int slab = F.vcu; slab < TL / 128; slab += F.G) {
                if (tid_ < 256) { const int er = TOKER[(size_t)slab * 256 + tid_]; const int e = er & 255, rk = er >> 8; const int pos = pst[e] + scn[slab * 8 + e] + rk;
                    posl[tid_] = pos; TOKPOS[(size_t)slab * 256 + tid_] = pos; }
                LDS_WAIT(); __syncthreads();
                const v4u* srcb = (const v4u*)((const unsigned char*)HX + (size_t)slab * 128 * D);
#pragma unroll 4
                for (int i = 0; i < 16; ++i) { const int id = i * 512 + tid_, tk = id >> 6, chk = id & 63;
                    const v4u o = srcb[(size_t)tk * 64 + chk];
                    ((v4u*)(XG8 + (size_t)posl[2 * tk] * D))[chk] = o; ((v4u*)(XG8 + (size_t)posl[2 * tk + 1] * D))[chk] = o; }
                LDS_WAIT(); __syncthreads();
            }
            GRID_BAR();
        }
        if (IN(pb + 8) && !moe) {
            PHASE_ENTER();
            pg8::Gemm g{HX, W_GUD, rows_out, 2 * FFD, D}; pg8::StaticOrder S; S.init(rows_out, 2 * FFD, F.G, (int)blockIdx.x, MK_WGM);
#if MK_DENSE_F8 >= 2
            pg8::EpiSwiglu8T<true> E{(unsigned char*)HD, FFD, 1.0f / (SC_XG * SC_WGU), SC_H};
            pg8::gemm_phase<pg8::EpiSwiglu8T<true>, pg8::StaticOrder, PG8_ALIGN, PG8_SP2>(F.lds + RING_OFF, g, S, E, F.wv);
#elif MK_DENSE_F8 == 1
            pg8::EpiSwiglu8T<false> E{(unsigned char*)HD, FFD, 1.0f, SC_H};
            pg8::gemm_phase<pg8::EpiSwiglu8T<false>, pg8::StaticOrder, PG8_ALIGN, PG8_SP2>(F.lds + RING_OFF, g, S, E, F.wv);
#else
            pg8::EpiSwiglu E{HD, FFD};
            pg8::gemm_phase<pg8::EpiSwiglu, pg8::StaticOrder, PG8_ALIGN, PG8_SP2>(F.lds + RING_OFF, g, S, E, F.wv);
#endif
            MOE_TAIL(MK_MT_B, MK_MT_C, 88);
            GRID_BAR();
        }
        if (IN(pb + 9) && !moe) {
            PHASE_ENTER();
            pg8::Gemm g{HD, W_DND, rows_out, D, FFD}; pg8::StaticOrder S; S.init(rows_out, D, F.G, (int)blockIdx.x, MK_WGM);
#if MK_DENSE_F8 >= 1
            pg8::EpiBf16PS8 E{Y16, D, 1.0f / (SC_H * SC_WDN)};
            pg8::gemm_phase<pg8::EpiBf16PS8, pg8::StaticOrder, PG8_ALIGN, PG8_SP2>(F.lds + RING_OFF, g, S, E, F.wv);
#else
            pg8::EpiBf16P E{Y16, D};
            pg8::gemm_phase<pg8::EpiBf16P, pg8::StaticOrder, PG8_ALIGN, PG8_SP2>(F.lds + RING_OFF, g, S, E, F.wv);
#endif
            MOE_TAIL(MK_MT_C, MOE_ITEMS, 16);
            GRID_BAR();
        }
        if (moe) {
            for (int ck = 0; ck < NCHUNK; ++ck) {
                if (IN(pb + 10 + 2 * ck)) {
                    PHASE_ENTER();
                    pg8::MoeOrder S; S.nN = 2 * FFE / 256; S.G = F.G; S.c = F.vcu; S.p_lo = ck * PCH;
#pragma unroll
                    for (int k = 0; k < 8; ++k) S.pc[k] = __builtin_amdgcn_readfirstlane(PCUM[k]);
                    const int ptot = __builtin_amdgcn_readfirstlane(PCUM[8]); S.np = min(max(ptot - ck * PCH, 0), PCH);
                    pg8::Gemm g{(const bf16*)XG8, (const bf16*)W_GUM8, 0, 2 * FFE, D};
                    pg8::EpiSwiglu8 E{HM8, FFE, 1.0f / (SC_XG * SC_WGU), SC_H};
                    pg8::gemm_phase<pg8::EpiSwiglu8, pg8::MoeOrder, PG8_ALIGN, PG8_SP2>(F.lds + RING_OFF, g, S, E, F.wv);
                    GRID_BAR();
                }
                if (IN(pb + 11 + 2 * ck)) {
                    PHASE_ENTER();
                    pg8::MoeOrder S; S.nN = D / 256; S.G = F.G; S.c = F.vcu; S.p_lo = ck * PCH;
#pragma unroll
                    for (int k = 0; k < 8; ++k) S.pc[k] = __builtin_amdgcn_readfirstlane(PCUM[k]);
                    const int ptot = __builtin_amdgcn_readfirstlane(PCUM[8]); S.np = min(max(ptot - ck * PCH, 0), PCH);
                    pg8::Gemm g{(const bf16*)HM8, (const bf16*)W_DNM8, 0, D, FFE};
                    pg8::EpiBf16PS8 E{XG, D, 1.0f / (SC_H * SC_WDN)};
                    pg8::gemm_phase<pg8::EpiBf16PS8, pg8::MoeOrder, PG8_ALIGN, PG8_SP2>(F.lds + RING_OFF, g, S, E, F.wv);
                    GRID_BAR();
                }
            }
        }
        if (IN(pb + 16)) {
            PHASE_ENTER();
            const int chunk = (TL + NGW - 1) / NGW; const bool nextl = (l + 1 < DEPTH);
#define P9_ROW(t) do { f32x4 x[4], y[4]; row_load_bf16(RS + (size_t)(t) * D, lane, x); \
                if (!moe) row_load_bf16(Y16 + (size_t)(t) * D, lane, y); \
                else { const int p0 = TOKPOS[2 * (size_t)(t)], p1 = TOKPOS[2 * (size_t)(t) + 1]; const float g0 = TOKG[2 * (size_t)(t)], g1 = TOKG[2 * (size_t)(t) + 1]; \
                    f32x4 ya[4], yb[4]; row_load_bf16(XG + (size_t)p0 * D, lane, ya); row_load_bf16(XG + (size_t)p1 * D, lane, yb); \
                    _Pragma("unroll") for (int j = 0; j < 4; ++j) y[j] = ya[j] * g0 + yb[j] * g1; } \
                const float ry = row_rrms(y); \
                _Pragma("unroll") for (int j = 0; j < 4; ++j) x[j] = x[j] + gt[j] * (y[j] * ry * gpo[j]); \
                if (nextl) row_store_bf16(RS + (size_t)(t) * D, lane, x); else if ((t) < TL) row_store(outp + (size_t)(t) * D, lane, x); \
                if (nextl) { f32x4 h[4]; const float rx = row_rrms(x); row_normmod(x, rx, gpre, sh, sc, h); if (MK_GATE_F8 < 2 && !(MK_L1_ALLF8 && l + 1 == DEPTH - 1)) row_store_bf16(HX + (size_t)(t) * D, lane, h); if (MK_GATE_F8) row_store_fp8(HX8 + (size_t)(t) * D, lane, h, SC_XG); } } while (0)
            f32x4 gpo[4], gt[4], gpre[4], sh[4], sc[4]; vec_load(INP(I_GPOSTFFN) + l * D, lane, gpo); vec_load(INP(I_GPREMIX) + (nextl ? l + 1 : l) * D, lane, gpre);
            for (int t0 = min(gw * chunk, TL), t1 = min(TL, t0 + chunk); t0 < t1; ) { const int bb = t0 >> 13, te = min(t1, (bb + 1) << 13); const float* md = modl + (size_t)bb * 6144;
                vec_load(md + 5120, lane, gt); vec_load(md + (nextl ? 5 * 6144 : 0), lane, sh); vec_load(md + (nextl ? 5 * 6144 : 0) + 1024, lane, sc);
                for (int t = t0; t < te; ++t) P9_ROW(t);
                t0 = te; }
            if (rows_out > TL) { const float* md = modl + (size_t)4 * 6144; vec_load(md + 5120, lane, gt); vec_load(md + (nextl ? 5 * 6144 : 0), lane, sh); vec_load(md + (nextl ? 5 * 6144 : 0) + 1024, lane, sc);
                for (int t = TL + gw; t < rows_out; t += NGW) P9_ROW(t); }
#undef P9_ROW
            if (l + 1 < DEPTH) GRID_BAR();
        }
    }
#undef IN
#undef GRID_BAR
}

extern "C" void kernel_launch(void* const* d_in, const int* in_sizes, int n_in, void* d_out, int out_size, void* d_ws, size_t ws_size, hipStream_t stream) {
    static int grid = 0;
    if (grid == 0) {
        if (n_in != 23 || in_sizes[0] != TL * D || out_size != TL * D || ws_size < WS_END) { fprintf(stderr, "kernel_launch: unexpected shapes: n_in %d in0 %d out %d ws %zu (need %zu); nothing launched\n", n_in, n_in > 0 ? in_sizes[0] : -1, out_size, ws_size, (size_t)WS_END); grid = -1; return; }
        int dev = 0, cus = 0, per_cu = 0;
        if (hipGetDevice(&dev) != hipSuccess || hipDeviceGetAttribute(&cus, hipDeviceAttributeMultiprocessorCount, dev) != hipSuccess) { fprintf(stderr, "kernel_launch: device query failed\n"); grid = -1; return; }
        if (hipFuncSetAttribute((const void*)mk_fwd, hipFuncAttributeMaxDynamicSharedMemorySize, LDS_BYTES) != hipSuccess) { fprintf(stderr, "kernel_launch: hipFuncSetAttribute failed\n"); grid = -1; return; }
        if (hipOccupancyMaxActiveBlocksPerMultiprocessor(&per_cu, (const void*)mk_fwd, NWAVES * 64, LDS_BYTES) != hipSuccess || per_cu < 1) fprintf(stderr, "kernel_launch: note: occupancy query reports %d\n", per_cu);
        (void)hipGetLastError();
        grid = cus;
    }
    if (grid < 0) return;
    if (hipMemsetAsync((char*)d_ws + WS_CTL, 0, CTL_ZERO_BYTES, stream) != hipSuccess) { fprintf(stderr, "kernel_launch: memset failed\n"); return; }
    Args a{};
    for (int i = 0; i < 23; ++i) a.in[i] = (const float*)d_in[i];
    a.out = (float*)d_out; a.ws = (unsigned char*)d_ws;
#if MK_PER_PHASE
    for (int ph = 0; ph < NPHASES; ++ph) { a.ph_lo = ph; a.ph_hi = ph + 1; hipLaunchKernelGGL(mk_fwd, dim3(grid), dim3(NWAVES * 64), LDS_BYTES, stream, a); }
#else
    a.ph_lo = 0; a.ph_hi = NPHASES;
    hipLaunchKernelGGL(mk_fwd, dim3(grid), dim3(NWAVES * 64), LDS_BYTES, stream, a);
#endif
    const hipError_t le = hipPeekAtLastError();
    if (le != hipSuccess) fprintf(stderr, "kernel_launch: launch failed: %s\n", hipGetErrorName(le));
}
```
